# Optimizing an MI355X kernel written in HIP

```python
import jax
import jax.numpy as jnp
from jax import lax
import numpy as np

D_MODEL = 1024
BATCH = 4
SEQ = 8192
DEPTH = 1
DEC_BATCH = 32
DEC_SEQ = 1
PAST_LEN = 16384
PAGE_SIZE = 128

CONV_CH = D_MODEL // 2
CONV_W = 3
N_HEADS = 8
HEAD_DIM = (D_MODEL - CONV_CH) // N_HEADS
ATTN_W = N_HEADS * HEAD_DIM
N_KV_HEADS = 2
GROUP = N_HEADS // N_KV_HEADS
N_BRANCH = 3
CMP_BLK = 32
SEL_BLK = 64
SEL_PER_CMP = SEL_BLK // CMP_BLK
N_SEL = 16
WINDOW = 512
Q_BLK = 128
ROPE_THETA = 10000.0
NORM_EPS = 1e-6
FORCE_BONUS = 1e4
KV_W = N_BRANCH * 2 * N_KV_HEADS * HEAD_DIM
IN_SPLITS = (CONV_CH, CONV_CH, CONV_CH, CONV_CH, ATTN_W, KV_W, N_HEADS * N_BRANCH, ATTN_W)
IN_W = sum(IN_SPLITS)
MIX_W = CONV_CH + ATTN_W

kernel_name = "hymba_shortconv_nsa_decode_step"


def rms_norm(x, g):
    xf = x.astype(jnp.float32)
    xf = xf * lax.rsqrt(jnp.mean(xf * xf, axis=-1, keepdims=True) + NORM_EPS)
    return (xf * g.astype(jnp.float32)).astype(x.dtype)


def rope(x, pos):
    half = HEAD_DIM // 2
    inv = ROPE_THETA ** (-jnp.arange(half, dtype=jnp.float32) / half)
    ang = pos.astype(jnp.float32)[:, None] * inv[None, :]
    shape = (1, pos.shape[0]) + (1,) * (x.ndim - 3) + (half,)
    cos = jnp.cos(ang).reshape(shape)
    sin = jnp.sin(ang).reshape(shape)
    xf = x.astype(jnp.float32)
    x1, x2 = xf[..., :half], xf[..., half:]
    return jnp.concatenate([x1 * cos - x2 * sin, x2 * cos + x1 * sin], axis=-1).astype(x.dtype)


def masked_softmax(s, mask):
    s = jnp.where(mask, s.astype(jnp.float32), -jnp.inf)
    m = jnp.max(s, axis=-1, keepdims=True)
    m = jnp.where(jnp.isfinite(m), m, 0.0)
    p = jnp.exp(s - m)
    return p / jnp.maximum(jnp.sum(p, axis=-1, keepdims=True), 1e-30)


def short_conv(u_ext, w, bias):
    t = u_ext.shape[1] - (CONV_W - 1)
    out = w[0] * u_ext[:, 0:t]
    for k in range(1, CONV_W):
        out = out + w[k] * u_ext[:, k:k + t]
    return out + bias


def compress_blocks(kv, cmp_pe, cmp_w):
    b, l = kv.shape[:2]
    nc = l // CMP_BLK
    blocks = kv[:, :nc * CMP_BLK].reshape(b, nc, CMP_BLK, 2, N_KV_HEADS, HEAD_DIM)
    blocks = blocks + cmp_pe[None, None, :, :, None, :]
    return jnp.einsum('bcrjgd,rjde->bcjge', blocks, cmp_w)


def to_sel_blocks(kv):
    b, l = kv.shape[:2]
    ns = -(-l // SEL_BLK)
    kv = jnp.pad(kv, ((0, 0), (0, ns * SEL_BLK - l), (0, 0), (0, 0), (0, 0)))
    return kv.reshape(b, ns, SEL_BLK, 2, N_KV_HEADS, HEAD_DIM).transpose(0, 4, 1, 2, 3, 5)


def nsa_block(q, q_pos, gate, kv_cmp, sel_blocks, kv_win, win_pos):
    b, tq = q.shape[:2]
    nc = kv_cmp.shape[1]
    ns = sel_blocks.shape[2]
    qp = q_pos[:, None]
    s_cmp = jnp.einsum('bqgnd,bcgd->bqgnc', q, kv_cmp[:, :, 0])
    cmp_end = (jnp.arange(nc, dtype=jnp.int32) + 1) * CMP_BLK - 1
    p_cmp = masked_softmax(s_cmp, (cmp_end[None, :] <= qp)[None, :, None, None, :])
    o_cmp = jnp.einsum('bqgnc,bcgd->bqgnd', p_cmp.astype(q.dtype), kv_cmp[:, :, 1])
    imp = jnp.sum(p_cmp, axis=3)
    imp = jnp.pad(imp, ((0, 0), (0, 0), (0, 0), (0, ns * SEL_PER_CMP - nc)))
    imp = imp.reshape(b, tq, N_KV_HEADS, ns, SEL_PER_CMP).sum(-1)
    blk = jnp.arange(ns, dtype=jnp.int32)[None, :]
    q_blk = (q_pos // SEL_BLK)[:, None]
    valid = blk * SEL_BLK <= qp
    forced = (blk == 0) | (blk == q_blk) | (blk == q_blk - 1)
    bonus = jnp.where(forced, FORCE_BONUS, 0.0).astype(jnp.float32)
    score = jnp.where(valid[None, :, None, :], imp + bonus[None, :, None, :], -jnp.inf)
    _, idx = lax.top_k(score, min(N_SEL, ns))
    bi = jnp.arange(b)[:, None, None, None]
    gi = jnp.arange(N_KV_HEADS)[None, None, :, None]
    sel = sel_blocks[bi, gi, idx]
    n_keys = idx.shape[-1] * SEL_BLK
    sel = sel.reshape(b, tq, N_KV_HEADS, n_keys, 2, HEAD_DIM)
    sel_pos = (idx[..., None] * SEL_BLK + jnp.arange(SEL_BLK, dtype=jnp.int32)).reshape(b, tq, N_KV_HEADS, n_keys)
    s_slc = jnp.einsum('bqgnd,bqgkd->bqgnk', q, sel[..., 0, :])
    m_slc = (sel_pos <= q_pos[None, :, None, None])[:, :, :, None, :]
    p_slc = masked_softmax(s_slc, m_slc)
    o_slc = jnp.einsum('bqgnk,bqgkd->bqgnd', p_slc.astype(q.dtype), sel[..., 1, :])
    s_win = jnp.einsum('bqgnd,bkgd->bqgnk', q, kv_win[:, :, 0])
    wp = win_pos[None, :]
    m_win = (wp <= qp) & (wp > qp - WINDOW) & (wp >= 0)
    p_win = masked_softmax(s_win, m_win[None, :, None, None, :])
    o_win = jnp.einsum('bqgnk,bkgd->bqgnd', p_win.astype(q.dtype), kv_win[:, :, 1])
    o = gate[..., 0:1] * o_cmp + gate[..., 1:2] * o_slc + gate[..., 2:3] * o_win
    return o.reshape(b, tq, N_HEADS, HEAD_DIM)


def mixer_inputs(x, pos, norm_g, w_in, q_gain, k_gain):
    bsz, t = x.shape[:2]
    h = rms_norm(x, norm_g)
    proj = h @ w_in
    offs = np.cumsum(IN_SPLITS)[:-1].tolist()
    b_gate, c_gate, conv_in, z_conv, q, kv, gate_logits, z_attn = jnp.split(proj, offs, axis=-1)
    q = q.reshape(bsz, t, N_HEADS, HEAD_DIM)
    q = rope(rms_norm(q, q_gain), pos) * (HEAD_DIM ** -0.5)
    q = q.reshape(bsz, t, N_KV_HEADS, GROUP, HEAD_DIM)
    kv = kv.reshape(bsz, t, N_BRANCH, 2, N_KV_HEADS, HEAD_DIM)
    k = rope(rms_norm(kv[:, :, :, 0], k_gain[:, None, :]), pos)
    kv = jnp.stack([k, kv[:, :, :, 1]], axis=3)
    gate = jax.nn.sigmoid(gate_logits.reshape(bsz, t, N_KV_HEADS, GROUP, N_BRANCH))
    u = c_gate * conv_in
    return u, b_gate, z_conv, q, kv, gate, z_attn


def mixer_output(x, conv_y, b_gate, z_conv, attn_o, z_attn, w_out):
    bsz, t = x.shape[:2]
    conv_branch = b_gate * conv_y * jax.nn.silu(z_conv)
    attn_branch = attn_o.reshape(bsz, t, ATTN_W) * jax.nn.silu(z_attn)
    return x + jnp.concatenate([conv_branch, attn_branch], axis=-1) @ w_out


def prompt_layer(x, norm_g, w_in, conv_w, conv_b, q_gain, k_gain, cmp_pe, cmp_w, w_out):
    bsz, t = x.shape[:2]
    pos = jnp.arange(t, dtype=jnp.int32)
    u, b_gate, z_conv, q, kv, gate, z_attn = mixer_inputs(x, pos, norm_g, w_in, q_gain, k_gain)
    conv_y = short_conv(jnp.pad(u, ((0, 0), (CONV_W - 1, 0), (0, 0))), conv_w, conv_b)
    kv_cmp_rows, kv_slc_rows, kv_win_rows = kv[:, :, 0], kv[:, :, 1], kv[:, :, 2]
    kv_cmp = compress_blocks(kv_cmp_rows, cmp_pe, cmp_w)
    sel_blocks = to_sel_blocks(kv_slc_rows)
    win_pad = jnp.pad(kv_win_rows, ((0, 0), (WINDOW, 0), (0, 0), (0, 0), (0, 0)))

    def q_block(i):
        s = i * Q_BLK
        q_b = lax.dynamic_slice_in_dim(q, s, Q_BLK, axis=1)
        g_b = lax.dynamic_slice_in_dim(gate, s, Q_BLK, axis=1)
        kv_w = lax.dynamic_slice_in_dim(win_pad, s, WINDOW + Q_BLK, axis=1)
        q_pos = s + jnp.arange(Q_BLK, dtype=jnp.int32)
        w_pos = s - WINDOW + jnp.arange(WINDOW + Q_BLK, dtype=jnp.int32)
        return nsa_block(q_b, q_pos, g_b, kv_cmp, sel_blocks, kv_w, w_pos)

    o = lax.map(q_block, jnp.arange(t // Q_BLK, dtype=jnp.int32))
    o = jnp.moveaxis(o, 0, 1).reshape(bsz, t, N_HEADS, HEAD_DIM)
    y = mixer_output(x, conv_y, b_gate, z_conv, o, z_attn, w_out)
    w_keep = min(WINDOW, t)
    return y, kv_cmp_rows, kv_slc_rows, kv_win_rows[:, t - w_keep:], u[:, t - (CONV_W - 1):]


def sample_layer(x, cache_cmp, cache_slc, win_buf, conv_buf, page_table,
                 norm_g, w_in, conv_w, conv_b, q_gain, k_gain, cmp_pe, cmp_w, w_out):
    bsz, t = x.shape[:2]
    past = page_table.shape[1] * PAGE_SIZE
    pos = past + jnp.arange(t, dtype=jnp.int32)
    u, b_gate, z_conv, q, kv, gate, z_attn = mixer_inputs(x, pos, norm_g, w_in, q_gain, k_gain)
    u_ext = jnp.concatenate([conv_buf.astype(u.dtype), u], axis=1)
    conv_y = short_conv(u_ext, conv_w, conv_b)

    def gather_past(pool):
        return pool[page_table].reshape(bsz, past, 2, N_KV_HEADS, HEAD_DIM)

    full_cmp = jnp.concatenate([gather_past(cache_cmp).astype(kv.dtype), kv[:, :, 0]], axis=1)
    full_slc = jnp.concatenate([gather_past(cache_slc).astype(kv.dtype), kv[:, :, 1]], axis=1)
    kv_cmp = compress_blocks(full_cmp, cmp_pe, cmp_w)
    sel_blocks = to_sel_blocks(full_slc)
    w_buf = win_buf.shape[1]
    kv_w = jnp.concatenate([win_buf.astype(kv.dtype), kv[:, :, 2]], axis=1)
    w_pos = past - w_buf + jnp.arange(w_buf + t, dtype=jnp.int32)
    o = nsa_block(q, pos, gate, kv_cmp, sel_blocks, kv_w, w_pos)
    y = mixer_output(x, conv_y, b_gate, z_conv, o, z_attn, w_out)
    return y, kv[:, :, 0], kv[:, :, 1], kv_w[:, t:], u_ext[:, t:]


def setup_inputs(seed: int = 0) -> dict:
    key = jax.random.key(seed)
    ks = jax.random.split(key, 16)
    n_pages = PAST_LEN // PAGE_SIZE
    n_used = DEC_BATCH * n_pages
    n_pool = n_used + max(1, n_used // 4)
    w_buf = min(WINDOW, PAST_LEN)
    f32 = jnp.float32
    nrm = lambda k, s: jax.random.normal(k, s, f32)
    page_table = jax.random.permutation(ks[6], n_pool)[:n_used].reshape(DEC_BATCH, n_pages).astype(jnp.int32)
    return {
        "x_prompt": nrm(ks[0], (BATCH, SEQ, D_MODEL)),
        "x_sample": nrm(ks[1], (DEC_BATCH, DEC_SEQ, D_MODEL)),
        "cache_cmp_kv": nrm(ks[2], (DEPTH, n_pool, PAGE_SIZE, 2, N_KV_HEADS, HEAD_DIM)),
        "cache_slc_kv": nrm(ks[3], (DEPTH, n_pool, PAGE_SIZE, 2, N_KV_HEADS, HEAD_DIM)),
        "state_win_kv": nrm(ks[4], (DEPTH, DEC_BATCH, w_buf, 2, N_KV_HEADS, HEAD_DIM)),
        "state_conv": nrm(ks[5], (DEPTH, DEC_BATCH, CONV_W - 1, CONV_CH)),
        "page_table": page_table,
        "norm_g": 1.0 + 0.02 * nrm(ks[7], (DEPTH, D_MODEL)),
        "w_in": nrm(ks[8], (DEPTH, D_MODEL, IN_W)) * D_MODEL ** -0.5,
        "conv_w": nrm(ks[9], (DEPTH, CONV_W, CONV_CH)) * CONV_W ** -0.5,
        "conv_b": 0.02 * nrm(ks[10], (DEPTH, CONV_CH)),
        "q_gain": 1.0 + 0.02 * nrm(ks[11], (DEPTH, HEAD_DIM)),
        "k_gain": 1.0 + 0.02 * nrm(ks[12], (DEPTH, N_BRANCH, HEAD_DIM)),
        "cmp_pe": 0.1 * nrm(ks[13], (DEPTH, CMP_BLK, 2, HEAD_DIM)),
        "cmp_w": nrm(ks[14], (DEPTH, CMP_BLK, 2, HEAD_DIM, HEAD_DIM)) * (CMP_BLK * HEAD_DIM) ** -0.5,
        "w_out": nrm(ks[15], (DEPTH, MIX_W, D_MODEL)) * MIX_W ** -0.5,
    }


def reference(x_prompt, x_sample, cache_cmp_kv, cache_slc_kv, state_win_kv, state_conv, page_table,
              norm_g, w_in, conv_w, conv_b, q_gain, k_gain, cmp_pe, cmp_w, w_out):
    yp, ys = x_prompt, x_sample
    p_cmp, p_slc, p_win, p_conv = [], [], [], []
    s_cmp, s_slc, s_win, s_conv = [], [], [], []
    for layer in range(DEPTH):
        params = (norm_g[layer], w_in[layer], conv_w[layer], conv_b[layer], q_gain[layer],
                  k_gain[layer], cmp_pe[layer], cmp_w[layer], w_out[layer])
        yp, a, b, c, d = prompt_layer(yp, *params)
        p_cmp.append(a); p_slc.append(b); p_win.append(c); p_conv.append(d)
        ys, a, b, c, d = sample_layer(ys, cache_cmp_kv[layer], cache_slc_kv[layer], state_win_kv[layer],
                                      state_conv[layer], page_table, *params)
        s_cmp.append(a); s_slc.append(b); s_win.append(c); s_conv.append(d)
    return (yp, ys, jnp.stack(p_cmp), jnp.stack(p_slc), jnp.stack(p_win), jnp.stack(p_conv),
            jnp.stack(s_cmp), jnp.stack(s_slc), jnp.stack(s_win), jnp.stack(s_conv))
```

```cpp
#include <hip/hip_runtime.h>
#include <cstdio>
#include <cstdint>
#define GAS __attribute__((address_space(1)))
#define LAS __attribute__((address_space(3)))
typedef unsigned short bf16;
typedef unsigned v4u __attribute__((ext_vector_type(4)));
typedef unsigned v2u __attribute__((ext_vector_type(2)));
typedef float f32x2 __attribute__((ext_vector_type(2)));
typedef float f32x16 __attribute__((ext_vector_type(16)));
typedef GAS unsigned gu32;
typedef GAS unsigned long long gu64;
#define RLX_AGENT __ATOMIC_RELAXED, __HIP_MEMORY_SCOPE_AGENT
#define LDS_WAIT() asm volatile("s_waitcnt lgkmcnt(0)" ::: "memory")
#define VM_WAIT() asm volatile("s_waitcnt vmcnt(0)" ::: "memory")
#define MK_N_LAUNCHES 1
namespace pg8 {
#define PG8_LAS __attribute__((address_space(3)))
typedef unsigned short bf16_t;
typedef short bf16x8 __attribute__((ext_vector_type(8)));
typedef float f32x4 __attribute__((ext_vector_type(4)));
typedef unsigned u32x4 __attribute__((ext_vector_type(4)));
constexpr int BM = 256, BK = 64, HALF = 128, HTB = HALF * BK * 2  , STAGE_BYTES = 8 * HTB, NXCD = 8, WGM = 8;

__host__ __device__ __forceinline__ int lds_byte(int r, int c) { const int st = (r >> 4) * 2 + (c >> 5), rr = r & 15, cc = c & 31, ob = rr * 64 + cc * 2; return st * 1024 + (ob ^ (((ob >> 9) & 1) << 5)); }
__host__ __device__ __forceinline__ void stage_rc(int b, int& R, int& C) { const int st = b / 1024, sb = b % 1024, swz = sb ^ (((sb >> 9) & 1) << 5); R = (st >> 1) * 16 + swz / 64; C = (st & 1) * 32 + (swz % 64) / 2; }
__host__ __device__ __forceinline__ int perm32(int rho) { const int n = rho >> 4, i = rho & 15; return 8 * (i >> 2) + 4 * n + (i & 3); }

struct Unit { int pm, pn; };
struct Gemm { const bf16_t* A; const bf16_t* Bt; int M, N, K; };

struct StaticOrder {
    int nM, nN, nwg, G, c;
    __host__ __device__ void init(int M, int N, int G_, int c_) { nM = M / BM; nN = N / BM; nwg = nM * nN; G = G_; c = c_; }
    __host__ __device__ bool next(int i, Unit& u) const {
        const long L = (long)i * G + c; if (L >= nwg) return false;
        int wgid = (int)L; { const int q = nwg / NXCD, r = nwg % NXCD, xcd = wgid % NXCD, off = wgid / NXCD; wgid = (xcd < r ? xcd * (q + 1) : r * (q + 1) + (xcd - r) * q) + off; }
        const int nig = WGM * nN, gid = wgid / nig, fm = gid * WGM, gsz = (nM - fm) < WGM ? (nM - fm) : WGM;
        u.pm = fm + ((wgid % nig) % gsz); u.pn = (wgid % nig) / gsz; return true;
    }
    __device__ __forceinline__ void a_ready(const Unit&) const {}
    __device__ __forceinline__ void done(const Unit&) const {}
};


template <class Epi, class Sched, bool ALIGN_EPI = false, bool SP2 = false>
__device__ __forceinline__ void gemm_phase(PG8_LAS unsigned char* lds, const Gemm g, const Sched& S, const Epi& E) {
    const int tid = threadIdx.x, wid = __builtin_amdgcn_readfirstlane(tid >> 6), lane = tid & 63, wr = wid >> 2, wc = wid & 3, fr = lane & 15, fq = lane >> 4;
    const int K = g.K, nt = K / BK;
    unsigned voffA[2], voffB[2];
#pragma unroll
    for (int i = 0; i < 2; ++i) { int R, C; stage_rc(tid * 16 + i * 8192, R, C); const int Rb = Epi::PERM ? ((R & ~31) + perm32(R & 31)) : R;
        voffA[i] = (unsigned)(R * K + C) * 2u; voffB[i] = (unsigned)(Rb * K + C) * 2u; }
    const size_t kstep = (size_t)(BK * 2);
    const size_t hstep = (size_t)HALF * K * 2;
    const size_t tstep = 2 * hstep;
    const unsigned ldsw = (unsigned)wid * 1024u;
    const int aoff = lds_byte(wr * 64 + fr, fq * 8), boff = lds_byte(wc * 32 + fr, fq * 8);
#define PG8_SA(b, h) (((b) * 2 + (h)) * HTB)
#define PG8_SB(b, h) ((4 + (b) * 2 + (h)) * HTB)
#define PG8_STAGE(bufoff, gbase, voff) do { _Pragma("unroll") for (int _i = 0; _i < 2; ++_i) \
        __builtin_amdgcn_global_load_lds((const unsigned*)((const char*)(gbase) + (voff)[_i]), (PG8_LAS unsigned*)(lds + (bufoff) + ldsw + _i * 8192), 16, 0, 0); } while (0)
#define PG8_LDA(dst, b, h) do { _Pragma("unroll") for (int m = 0; m < 4; ++m) _Pragma("unroll") for (int k = 0; k < 2; ++k) dst[m][k] = *(const PG8_LAS bf16x8*)(lds + PG8_SA(b, h) + aoff + m * 2048 + k * 1024); } while (0)
#define PG8_LDB(dst, b, h) do { _Pragma("unroll") for (int n = 0; n < 2; ++n) _Pragma("unroll") for (int k = 0; k < 2; ++k) dst[n][k] = *(const PG8_LAS bf16x8*)(lds + PG8_SB(b, h) + boff + n * 2048 + k * 1024); } while (0)
#define PG8_MMA(ai, bj, At, Bt) do { __builtin_amdgcn_s_setprio(1); _Pragma("unroll") for (int m = 0; m < 4; ++m) _Pragma("unroll") for (int n = 0; n < 2; ++n) _Pragma("unroll") for (int k = 0; k < 2; ++k) \
        acc[ai][bj][m][n] = __builtin_amdgcn_mfma_f32_16x16x32_bf16(Bt[n][k], At[m][k], acc[ai][bj][m][n], 0, 0, 0); __builtin_amdgcn_s_setprio(0); } while (0)
#define PG8_WAIT_V(n) asm volatile("s_waitcnt vmcnt(" #n ")" ::: "memory")
#define PG8_WAIT_L(n) asm volatile("s_waitcnt lgkmcnt(" #n ")" ::: "memory")
#define PG8_BAR __builtin_amdgcn_s_barrier()
#define PG8_SCHED __builtin_amdgcn_sched_barrier(0)
    Unit cur, nxt; int ui = 0;
    if (!S.next(0, cur)) return;
    f32x4 acc[2][2][4][2];
#pragma unroll
    for (int a = 0; a < 2; ++a)
#pragma unroll
        for (int b = 0; b < 2; ++b)
#pragma unroll
            for (int m = 0; m < 4; ++m)
#pragma unroll
                for (int n = 0; n < 2; ++n) acc[a][b][m][n] = (f32x4){0.f, 0.f, 0.f, 0.f};
    bf16x8 At[4][2], B0[2][2], B1[2][2];
    const char* cA = (const char*)g.A + (size_t)cur.pm * tstep; const char* cB = (const char*)g.Bt + (size_t)cur.pn * tstep;
    S.a_ready(cur);
    if constexpr (SP2) {
        PG8_STAGE(PG8_SB(0, 0), cB, voffB); PG8_STAGE(PG8_SB(0, 1), cB + hstep, voffB); PG8_STAGE(PG8_SA(0, 0), cA, voffA); PG8_STAGE(PG8_SA(0, 1), cA + hstep, voffA);
        if (wr == 1) PG8_BAR;
        PG8_WAIT_V(2); PG8_BAR;
        PG8_STAGE(PG8_SB(1, 0), cB + kstep, voffB); PG8_STAGE(PG8_SA(1, 0), cA + kstep, voffA); PG8_STAGE(PG8_SB(1, 1), cB + hstep + kstep, voffB);
        PG8_WAIT_V(6); PG8_BAR;
    } else {
        PG8_STAGE(PG8_SB(0, 0), cB, voffB); PG8_STAGE(PG8_SA(0, 0), cA, voffA); PG8_STAGE(PG8_SB(0, 1), cB + hstep, voffB); PG8_STAGE(PG8_SA(0, 1), cA + hstep, voffA);
        if (wr == 1) PG8_BAR;
        PG8_WAIT_V(4); PG8_BAR;
        PG8_STAGE(PG8_SB(1, 0), cB + kstep, voffB); PG8_STAGE(PG8_SA(1, 0), cA + kstep, voffA); PG8_STAGE(PG8_SB(1, 1), cB + hstep + kstep, voffB);
        PG8_WAIT_V(6); PG8_BAR;
    }
    for (;;) {
        const bool has_next = S.next(ui + 1, nxt);
        const char* nA = has_next ? (const char*)g.A + (size_t)nxt.pm * tstep : cA; const char* nB = has_next ? (const char*)g.Bt + (size_t)nxt.pn * tstep : cB;
        for (int t = 0; t < nt; t += 2) {
            const bool last = (t == nt - 2);
            const char* a1 = cA + (size_t)(t + 1) * kstep;
            const char* a2 = last ? nA : cA + (size_t)(t + 2) * kstep; const char* b2 = last ? nB : cB + (size_t)(t + 2) * kstep;
            const char* a3 = a2 + kstep; const char* b3 = b2 + kstep;
            if (last && has_next) S.a_ready(nxt);
            if constexpr (SP2) {
            PG8_LDB(B0, 0, 0); PG8_LDB(B1, 0, 1); PG8_SCHED; PG8_LDA(At, 0, 0); PG8_STAGE(PG8_SA(1, 1), a1 + hstep, voffA);
            PG8_WAIT_V(8); PG8_WAIT_L(0); PG8_BAR; PG8_MMA(0, 0, At, B0); PG8_MMA(0, 1, At, B1); PG8_BAR; PG8_SCHED;
            PG8_LDA(At, 0, 1); PG8_STAGE(PG8_SB(0, 0), b2, voffB); PG8_STAGE(PG8_SB(0, 1), b2 + hstep, voffB); PG8_STAGE(PG8_SA(0, 0), a2, voffA);
            PG8_WAIT_V(8); PG8_WAIT_L(0); PG8_BAR; PG8_MMA(1, 0, At, B0); PG8_MMA(1, 1, At, B1); PG8_BAR; PG8_SCHED;
            PG8_LDB(B0, 1, 0); PG8_LDB(B1, 1, 1); PG8_SCHED; PG8_LDA(At, 1, 0); PG8_STAGE(PG8_SA(0, 1), a2 + hstep, voffA);
            PG8_WAIT_V(8); PG8_WAIT_L(0); PG8_BAR; PG8_MMA(0, 0, At, B0); PG8_MMA(0, 1, At, B1); PG8_BAR; PG8_SCHED;
            PG8_LDA(At, 1, 1); PG8_STAGE(PG8_SB(1, 0), b3, voffB); PG8_STAGE(PG8_SB(1, 1), b3 + hstep, voffB); PG8_STAGE(PG8_SA(1, 0), a3, voffA);
            PG8_WAIT_V(8); PG8_WAIT_L(0); PG8_BAR; PG8_MMA(1, 0, At, B0); PG8_MMA(1, 1, At, B1); PG8_BAR; PG8_SCHED;
            } else {
            PG8_LDB(B0, 0, 0); PG8_SCHED; PG8_LDA(At, 0, 0); PG8_STAGE(PG8_SA(1, 1), a1 + hstep, voffA);
            PG8_WAIT_L(8); PG8_BAR; PG8_WAIT_L(0); PG8_MMA(0, 0, At, B0); PG8_BAR; PG8_SCHED;
            PG8_LDB(B1, 0, 1); PG8_STAGE(PG8_SB(0, 0), b2, voffB);
            PG8_BAR; PG8_WAIT_L(0); PG8_MMA(0, 1, At, B1); PG8_BAR;
            PG8_LDA(At, 0, 1); PG8_STAGE(PG8_SA(0, 0), a2, voffA);
            PG8_BAR; PG8_WAIT_L(0); PG8_MMA(1, 0, At, B0); PG8_BAR; PG8_SCHED;
            PG8_STAGE(PG8_SB(0, 1), b2 + hstep, voffB);
            PG8_WAIT_V(6); PG8_BAR; PG8_MMA(1, 1, At, B1); PG8_BAR;
            PG8_LDB(B0, 1, 0); PG8_SCHED; PG8_LDA(At, 1, 0); PG8_STAGE(PG8_SA(0, 1), a2 + hstep, voffA);
            PG8_WAIT_L(8); PG8_BAR; PG8_WAIT_L(0); PG8_MMA(0, 0, At, B0); PG8_BAR; PG8_SCHED;
            PG8_LDB(B1, 1, 1); PG8_STAGE(PG8_SB(1, 0), b3, voffB);
            PG8_BAR; PG8_WAIT_L(0); PG8_MMA(0, 1, At, B1); PG8_BAR;
            PG8_LDA(At, 1, 1); PG8_STAGE(PG8_SA(1, 0), a3, voffA);
            PG8_BAR; PG8_WAIT_L(0); PG8_MMA(1, 0, At, B0); PG8_BAR; PG8_SCHED;
            PG8_STAGE(PG8_SB(1, 1), b3 + hstep, voffB);
            PG8_WAIT_V(6); PG8_BAR; PG8_MMA(1, 1, At, B1); PG8_BAR;
            }
        }
        if constexpr (ALIGN_EPI) { if (wr == 0) PG8_BAR; }
        if constexpr (!Epi::AFTER_DRAIN) { E(acc, cur, wr, wc, fr, fq); S.done(cur); }
        if (!has_next) break;
#pragma unroll
        for (int a = 0; a < 2; ++a)
#pragma unroll
            for (int b = 0; b < 2; ++b)
#pragma unroll
                for (int m = 0; m < 4; ++m)
#pragma unroll
                    for (int n = 0; n < 2; ++n) acc[a][b][m][n] = (f32x4){0.f, 0.f, 0.f, 0.f};
        cur = nxt; cA = nA; cB = nB; ++ui;
        if constexpr (ALIGN_EPI) { if (wr == 1) PG8_BAR; }
    }
    PG8_WAIT_V(0);
    if constexpr (!ALIGN_EPI) { if (wr == 0) PG8_BAR; }
    PG8_BAR;
    if constexpr (Epi::AFTER_DRAIN) { E.fused(acc, cur, wr, wc, fr, fq, lds, wid, lane); S.done(cur); }
#undef PG8_SA
#undef PG8_SB
#undef PG8_STAGE
#undef PG8_LDA
#undef PG8_LDB
#undef PG8_MMA
#undef PG8_WAIT_V
#undef PG8_WAIT_L
#undef PG8_BAR
#undef PG8_SCHED
}
}
#define XB_TMO      128
#define XB_XCNT(j)  (256  + 64 * (j))
#define XB_XSUB(j)  (1280 + 64 * (j))
#define XB_XGEN(j)  (2304 + 64 * (j))
#define XB_TOP      3328
#define XB_TOPGEN   3392
#define XCD_BAR_WORDS 3456
#define XB_SPIN_CAP (1u << 18)

__device__ __forceinline__ unsigned xb_ld(unsigned* p)              { return __hip_atomic_load(p, __ATOMIC_RELAXED, __HIP_MEMORY_SCOPE_AGENT); }
__device__ __forceinline__ unsigned xb_add(unsigned* p, unsigned v) { return __hip_atomic_fetch_add(p, v, __ATOMIC_RELAXED, __HIP_MEMORY_SCOPE_AGENT); }
__device__ __forceinline__ unsigned xb_xcc_id() { return (unsigned)__builtin_amdgcn_s_getreg((3 << 11) | 20) & 0xFu; }
#define XB_SPIN(cond, bar) do { unsigned _sp = 0; while (cond) { __builtin_amdgcn_s_sleep(1); \
    if ((++_sp & 255u) == 0u) { if (xb_ld(&(bar)[XB_TMO])) break; if (_sp > XB_SPIN_CAP) { atomicAdd(&(bar)[XB_TMO], 1u); break; } } } } while (0)

struct XcdBarrier {
    unsigned* bar; unsigned x;
    volatile LAS unsigned* st;
};

__device__ __forceinline__ XcdBarrier xcd_barrier_post(unsigned* bar, volatile LAS unsigned* st) {
    XcdBarrier b; b.bar = bar; b.x = xb_xcc_id(); b.st = st;
    if (threadIdx.x == 0) (void)xb_add(&bar[XB_XCNT(b.x)], 1u);
    return b;
}
__device__ __forceinline__ void xcd_barrier_complete(unsigned* bar, unsigned x, unsigned& nloc, unsigned& nx) {
    const unsigned G = gridDim.x * gridDim.y * gridDim.z;
    unsigned sum, cnt, mine, sp = 0u;
    for (;;) {
        sum = 0u; cnt = 0u; mine = 0u;
#pragma unroll
        for (unsigned j = 0; j < 16; ++j) { const unsigned c = xb_ld(&bar[XB_XCNT(j)]); sum += c; cnt += (c > 0u) ? 1u : 0u; mine = (j == x) ? c : mine; }
        if (sum == G) break;
        __builtin_amdgcn_s_sleep(1);
        if ((++sp & 255u) == 0u) { if (xb_ld(&bar[XB_TMO])) break; if (sp > XB_SPIN_CAP) { atomicAdd(&bar[XB_TMO], 1u); break; } }
    }
    nloc = mine > 0u ? mine : 1u; nx = cnt > 0u ? cnt : 1u;
}

__device__ __forceinline__ void xcd_barrier(const XcdBarrier& b) {
    asm volatile("s_waitcnt vmcnt(0)" ::: "memory");
    __syncthreads();
    if (threadIdx.x == 0) {
        unsigned* bar = b.bar;
        __builtin_amdgcn_s_waitcnt(0);
        unsigned nloc = b.st[0], nx = b.st[1];
        if (nloc == 0u) { xcd_barrier_complete(bar, b.x, nloc, nx); b.st[0] = nloc; b.st[1] = nx; }
        const unsigned old = xb_add(&bar[XB_XSUB(b.x)], 1u);
        const unsigned gen = old / nloc;
        if (old + 1u == (gen + 1u) * nloc) {
            __builtin_amdgcn_fence(__ATOMIC_RELEASE, "agent");
            asm volatile("s_waitcnt vmcnt(0)" ::: "memory");
            const unsigned og = xb_add(&bar[XB_TOP], 1u);
            const unsigned tg = og / nx;
            if (og + 1u == (tg + 1u) * nx) xb_add(&bar[XB_TOPGEN], 1u);
            else XB_SPIN(xb_ld(&bar[XB_TOPGEN]) == tg, bar);
            __builtin_amdgcn_fence(__ATOMIC_ACQUIRE, "agent");
            xb_add(&bar[XB_XGEN(b.x)], 1u);
            asm volatile("s_waitcnt vmcnt(0)" ::: "memory");
        } else {
            XB_SPIN(xb_ld(&bar[XB_XGEN(b.x)]) == gen, bar);
            __builtin_amdgcn_fence(__ATOMIC_ACQUIRE, "agent");
            asm volatile("s_waitcnt vmcnt(0)" ::: "memory");
        }
    }
    __syncthreads();
}
using pg8::f32x4; using pg8::bf16x8;
constexpr int NWAVES = 8;
constexpr int BATCH = 4, T = 8192, D = 1024, M = BATCH * T, NP = 4096, INW = 3864;
constexpr int DECB = 32, PAST = 16384, NPAGES = 128, NCS = 512  ;
constexpr float NORM_EPS = 1e-6f;
constexpr float LOG2E = 1.4426950408889634f;
constexpr float QSCALE = 0.125f * LOG2E;
constexpr size_t O_Y = 0, O_YS = 33554432, O_PCMP = 33587200, O_PSLC = 41975808, O_PWIN = 50364416, O_PCONV = 50888704,
                 O_SCMP = 50892800, O_SSLC = 50900992, O_SWIN = 50909184, O_SCONV = 55103488, O_END = 55136256;
constexpr int C_BG = 0, C_CG = 512, C_CI = 1024, C_ZC = 1536, C_Q = 2048, C_KV = 2560, C_GL = 3328, C_ZA = 3352;

constexpr size_t MiB = 1u << 20, KiB = 1u << 10;
constexpr size_t WS_CTL = 0, CTL_ZERO_BYTES = 1 * MiB;
constexpr size_t WS_BT1 = 2 * MiB;
constexpr size_t WS_BT2 = 10 * MiB;
constexpr size_t WS_BTC = 12 * MiB;
constexpr size_t WS_CBIAS = 12 * MiB + 512 * KiB;
constexpr size_t WS_CONST = WS_CBIAS + 4 * KiB;
constexpr size_t WS_ROPE = 13 * MiB;
constexpr size_t WS_RSTD = 16 * MiB;
constexpr size_t WS_XSB = 16 * MiB + 256 * KiB;
constexpr size_t WS_RSTDS = WS_XSB + 64 * KiB;
constexpr size_t WS_GATE = 17 * MiB;
constexpr size_t WS_KC = 20 * MiB;
constexpr size_t WS_VCT = WS_KC + 256 * KiB;
constexpr size_t WS_PROJS = 21 * MiB;
constexpr size_t WS_QS = 22 * MiB;
constexpr size_t WS_KVN = WS_QS + 64 * KiB;
constexpr size_t WS_GS = WS_KVN + 96 * KiB;
constexpr size_t WS_ZAS = WS_GS + 4 * KiB;
constexpr size_t WS_MIXS = WS_ZAS + 64 * KiB;
constexpr size_t WS_KCS = 24 * MiB;
constexpr size_t WS_KS = 40 * MiB, WS_VTS = 48 * MiB, WS_KW = 56 * MiB, WS_VTW = 64 * MiB;
constexpr size_t WS_XB = 72 * MiB;
constexpr size_t WS_CG = 136 * MiB, WS_U = 168 * MiB, WS_ZA = 200 * MiB, WS_Q = 232 * MiB;
constexpr size_t WS_MIX = 264 * MiB;
constexpr size_t WS_END = 328 * MiB;
constexpr int CW_TMO = 0, CW_CODE = 1;
constexpr int CW_BAR = 4096;
constexpr int CW_QUEUE = 16384;
constexpr int CW_KCMAX = 20480;

constexpr int RING_OFF = 0, RING_BYTES = 131072;
constexpr int LDSCTL_OFF = RING_BYTES, MISC_OFF = LDSCTL_OFF + 320;
constexpr int LDS_BYTES = 147456;

__device__ __forceinline__ unsigned f2bf(float f) { unsigned u = __builtin_bit_cast(unsigned, f); return (u + 0x7fffu + ((u >> 16) & 1u)) >> 16; }
__device__ __forceinline__ unsigned pk2(float lo, float hi) { return f2bf(lo) | (f2bf(hi) << 16); }
__device__ __forceinline__ float bf2f(unsigned h) { return __builtin_bit_cast(float, h << 16); }
__device__ __forceinline__ float wave_sum(float v) {
#pragma unroll
    for (int o = 1; o < 64; o <<= 1) v += __shfl_xor(v, o);
    return v;
}
__device__ __forceinline__ float fast_exp2(float x) { return __builtin_amdgcn_exp2f(x); }
__device__ __forceinline__ float sigmoidf(float x) { return __builtin_amdgcn_rcpf(1.0f + fast_exp2(-x * LOG2E)); }
__device__ __forceinline__ int perm16(int kk) { return 8 * ((kk >> 2) & 1) + 4 * (kk >> 3) + (kk & 3); }

struct Ptrs {
    const float *xp, *xs, *cache_cmp, *cache_slc, *st_win, *st_conv; const int* page_table;
    const float *norm_g, *w_in, *conv_w, *conv_b, *q_gain, *k_gain, *cmp_pe, *cmp_w, *w_out;
    float* out; unsigned char* ws;
};
struct Frame {
    LAS unsigned char* lds;
    volatile LAS unsigned* MISC;
    gu32* ctl;
    int tid, lane, wave, G, gw, NGW;
};
__device__ __forceinline__ int bt1_src(int dg, int& nvalid) {
    const int pn = dg >> 3, gi = dg & 7, bj = gi >> 2, wc = gi & 3; nvalid = 32;
    if (pn < 4) return (bj ? C_ZC : C_BG) + 128 * pn + 32 * wc;
    if (pn < 8) return (bj ? C_CI : C_CG) + 128 * (pn - 4) + 32 * wc;
    if (pn < 10) return C_Q + (4 * (pn - 8) + wc) * 64 + 32 * bj;
    if (pn < 13) return C_KV + (pn - 10) * 256 + wc * 64 + 32 * bj;
    if (pn < 15) return C_ZA + 256 * (pn - 13) + 32 * gi;
    nvalid = (gi == 0) ? 24 : 0; return C_GL;
}
__device__ __forceinline__ void p0_transpose_item(const float* W, int ldw, int k0, int src0, int nvalid, const float* ksc, bf16* WT, int ldt, int drow0, LAS float* scr, int lane) {
    const int nn = lane & 31;
#pragma unroll 8
    for (int i = 0; i < 32; ++i) { const int kk = 2 * i + (lane >> 5); float v = 0.f;
        if (nn < nvalid) { v = W[(size_t)(k0 + kk) * ldw + src0 + nn]; if (ksc) v *= ksc[k0 + kk]; }
        scr[kk * 33 + nn] = v; }
    LDS_WAIT(); asm volatile("" ::: "memory");
    const int c = lane & 7;
#pragma unroll
    for (int j = 0; j < 4; ++j) { const int n = (lane >> 3) + 8 * j; const LAS float* s = scr + (8 * c) * 33 + n;
        v4u o; o.x = pk2(s[0 * 33], s[1 * 33]); o.y = pk2(s[2 * 33], s[3 * 33]); o.z = pk2(s[4 * 33], s[5 * 33]); o.w = pk2(s[6 * 33], s[7 * 33]);
        *(GAS v4u*)(WT + (size_t)(drow0 + n) * ldt + k0 + 8 * c) = o; }
    LDS_WAIT(); asm volatile("" ::: "memory");
}
__device__ __forceinline__ void x_row_to_bf16(const float* xrow, bf16* orow, float* rstd_out, int lane) {
    const GAS f32x4* xr = (const GAS f32x4*)xrow + lane;
    f32x4 v[4]; float s = 0.f;
#pragma unroll
    for (int j = 0; j < 4; ++j) { v[j] = xr[64 * j]; s += (v[j].x * v[j].x + v[j].y * v[j].y) + (v[j].z * v[j].z + v[j].w * v[j].w); }
    const float tot = wave_sum(s);
    GAS unsigned long long* o8 = (GAS unsigned long long*)orow + lane;
#pragma unroll
    for (int j = 0; j < 4; ++j) o8[64 * j] = (unsigned long long)pk2(v[j].x, v[j].y) | ((unsigned long long)pk2(v[j].z, v[j].w) << 32);
    if (lane == 0) *rstd_out = 1.0f / sqrtf(tot * (1.0f / D) + NORM_EPS);
}
template <bool SAMPLE>
__device__ __forceinline__ void compress_unit(const Ptrs& P, int b, int c0, int lane) {
    const int rho = lane & 15, kq = lane >> 4;
    const float* rp[2];
#pragma unroll
    for (int rt = 0; rt < 2; ++rt) { const int c = c0 + 8 * rt + (rho >> 1), g = rho & 1; const float* base;
        if (SAMPLE) { const int page = P.page_table[b * NPAGES + (c >> 2)]; base = P.cache_cmp + ((size_t)page * 128 + (c & 3) * 32) * 256; }
        else base = P.out + O_PCMP + ((size_t)b * T + c * 32) * 256;
        rp[rt] = base + g * 64 + 8 * kq; }
    f32x4 acc[2][2][4];
#pragma unroll
    for (int a = 0; a < 2; ++a)
#pragma unroll
        for (int j = 0; j < 2; ++j)
#pragma unroll
            for (int e = 0; e < 4; ++e) acc[a][j][e] = (f32x4){0.f, 0.f, 0.f, 0.f};
    const GAS v4u* bfr = (const GAS v4u*)(P.ws + WS_BTC) + lane;
#pragma unroll 2
    for (int r = 0; r < 32; ++r) {
#pragma unroll
        for (int dh = 0; dh < 2; ++dh)
#pragma unroll
            for (int j = 0; j < 2; ++j) {
                bf16x8 a[2], bb[4];
#pragma unroll
                for (int rt = 0; rt < 2; ++rt) { const f32x4 lo = *(const GAS f32x4*)(rp[rt] + r * 256 + j * 128 + dh * 32), hi = *(const GAS f32x4*)(rp[rt] + r * 256 + j * 128 + dh * 32 + 4);
                    v4u w; w.x = pk2(lo.x, lo.y); w.y = pk2(lo.z, lo.w); w.z = pk2(hi.x, hi.y); w.w = pk2(hi.z, hi.w); a[rt] = __builtin_bit_cast(bf16x8, w); }
#pragma unroll
                for (int et = 0; et < 4; ++et) bb[et] = __builtin_bit_cast(bf16x8, bfr[(size_t)((((j * 32 + r) * 2 + dh) * 4 + et) * 64)]);
#pragma unroll
                for (int rt = 0; rt < 2; ++rt)
#pragma unroll
                    for (int et = 0; et < 4; ++et) acc[rt][j][et] = __builtin_amdgcn_mfma_f32_16x16x32_bf16(a[rt], bb[et], acc[rt][j][et], 0, 0, 0);
            }
    }
    const float* cbias = (const float*)(P.ws + WS_CBIAS);
    float nmax = 0.f;
#pragma unroll
    for (int rt = 0; rt < 2; ++rt)
#pragma unroll
        for (int i = 0; i < 4; ++i) { float q = 0.f;
#pragma unroll
            for (int et = 0; et < 4; ++et) { const float v = acc[rt][0][et][i] + cbias[16 * et + rho]; q += v * v; }
            q += __shfl_xor(q, 1); q += __shfl_xor(q, 2); q += __shfl_xor(q, 4); q += __shfl_xor(q, 8); nmax = fmaxf(nmax, q); }
    nmax = fmaxf(nmax, __shfl_xor(nmax, 16)); nmax = fmaxf(nmax, __shfl_xor(nmax, 32));
    if (lane == 0) atomicMax((unsigned*)(P.ws + WS_CTL) + CW_KCMAX + (SAMPLE ? 64 : 0), __builtin_bit_cast(unsigned, nmax));
#pragma unroll
    for (int rt = 0; rt < 2; ++rt)
#pragma unroll
        for (int j = 0; j < 2; ++j)
#pragma unroll
            for (int et = 0; et < 4; ++et) { const int e = 16 * et + rho; const float bs = cbias[j * 64 + e];
#pragma unroll
                for (int i = 0; i < 4; ++i) { const int row = 4 * kq + i, c = c0 + 8 * rt + (row >> 1), g = row & 1; const float val = acc[rt][j][et][i] + bs;
                    if (SAMPLE) ((float*)(P.ws + WS_KCS))[((size_t)((b * 2 + g) * 2 + j) * NCS + c) * 64 + e] = val;
                    else if (j == 0) ((bf16*)(P.ws + WS_KC))[((size_t)(b * 2 + g) * 256 + c) * 64 + e] = (bf16)f2bf(val);
                    else ((bf16*)(P.ws + WS_VCT))[((size_t)(b * 2 + g) * 64 + e) * 256 + (c & ~15) + perm16(c & 15)] = (bf16)f2bf(val); } }
}
__device__ __forceinline__ void p0a_small(const Ptrs& P, Frame& F) {
    const int lane = F.lane, gw = F.gw, NGW = F.NGW;
    for (int it = gw * 64 + lane; it < 2 * 32 * 2 * 4 * 64; it += NGW * 64) { const int l = it & 63, et = (it >> 6) & 3, dh = (it >> 8) & 1, r = (it >> 9) & 31, j = it >> 14;
        const float* w = P.cmp_w + ((size_t)(r * 2 + j) * 64 + 32 * dh + 8 * (l >> 4)) * 64 + 16 * et + (l & 15);
        v4u o; o.x = pk2(w[0], w[64]); o.y = pk2(w[128], w[192]); o.z = pk2(w[256], w[320]); o.w = pk2(w[384], w[448]);
        ((GAS v4u*)(P.ws + WS_BTC))[it] = o; }
    for (int it = gw; it < 128; it += NGW) { const int j = it >> 6, e = it & 63; float s = 0.f;
        for (int k = lane; k < 2048; k += 64) { const int r = k >> 6, d = k & 63; s += P.cmp_pe[(r * 2 + j) * 64 + d] * P.cmp_w[((size_t)(r * 2 + j) * 64 + d) * 64 + e]; }
        s = wave_sum(s); if (lane == 0) ((float*)(P.ws + WS_CBIAS))[it] = s; }
    if (gw == NGW - 1) { float qm = fabsf(P.q_gain[lane]), k1 = fabsf(P.k_gain[64 + lane]), k2 = fabsf(P.k_gain[128 + lane]);
#pragma unroll
        for (int o = 1; o < 64; o <<= 1) { qm = fmaxf(qm, __shfl_xor(qm, o)); k1 = fmaxf(k1, __shfl_xor(k1, o)); k2 = fmaxf(k2, __shfl_xor(k2, o)); }
        if (lane == 0) { float* cst = (float*)(P.ws + WS_CONST); cst[0] = qm; cst[1] = 8.0f * qm * k1 * LOG2E * 1.001f; cst[2] = 8.0f * qm * k2 * LOG2E * 1.001f; } }
    for (int it = gw * 64 + lane; it < 8193 * 32; it += NGW * 64) { const int p = it >> 5, i = it & 31; const int pos = (p == 8192) ? PAST : p;
        const float inv = (float)pow(10000.0, -(double)i / 32.0); const float ang = (float)pos * inv;
        float* rt = (float*)(P.ws + WS_ROPE) + (size_t)p * 64; rt[i] = (float)cos((double)ang); rt[32 + i] = (float)sin((double)ang); }
}
__device__ __forceinline__ void p0b_big(const Ptrs& P, Frame& F) {
    LAS float* scr = (LAS float*)(F.lds + RING_OFF + F.wave * 16384);
    const int lane = F.lane;
    if (F.wave < 4) {
        for (int u = blockIdx.x * 4 + F.wave; u < DECB * (NCS / 16); u += F.G * 4) compress_unit<true>(P, u >> 5, (u & 31) * 16, lane);
        return;
    }
    const int gw = blockIdx.x * 4 + (F.wave - 4), NGW = F.G * 4;
    for (int it = gw; it < 16 * 128; it += NGW) { const int kb = it >> 7, dg = it & 127; int nv; const int src0 = bt1_src(dg, nv);
        p0_transpose_item(P.w_in, INW, 64 * kb, src0, nv, P.norm_g, (bf16*)(P.ws + WS_BT1), D, 32 * dg, scr, lane); }
    for (int it = gw; it < 16 * 32; it += NGW) { const int kb = it >> 5, nb = it & 31;
        p0_transpose_item(P.w_out, D, 64 * kb, 32 * nb, 32, nullptr, (bf16*)(P.ws + WS_BT2), D, 32 * nb, scr, lane); }
    for (int m = gw; m < M; m += NGW) x_row_to_bf16(P.xp + (size_t)m * D, (bf16*)(P.ws + WS_XB) + (size_t)m * D, (float*)(P.ws + WS_RSTD) + m, lane);
    for (int m = gw; m < DECB; m += NGW) x_row_to_bf16(P.xs + (size_t)m * D, (bf16*)(P.ws + WS_XSB) + (size_t)m * D, (float*)(P.ws + WS_RSTDS) + m, lane);
    for (int it = gw; it < DECB * 511; it += NGW) { const int b = it / 511, i = it - b * 511;
        const GAS f32x4* s = (const GAS f32x4*)(P.st_win + ((size_t)b * 512 + i + 1) * 256) + lane; *((GAS f32x4*)(P.out + O_SWIN + ((size_t)b * 512 + i) * 256) + lane) = *s; }
    for (int it = gw * 64 + lane; it < DECB * 512; it += NGW * 64) { const int b = it >> 9, ch = it & 511; P.out[O_SCONV + (size_t)b * 1024 + ch] = P.st_conv[(size_t)b * 1024 + 512 + ch]; }
}
struct EpiIn {
    static constexpr bool PERM = false, AFTER_DRAIN = false;
    const float *rstd, *rope, *qg, *kg; float* out; unsigned char* ws;
    __device__ __forceinline__ void operator()(const f32x4 (&acc)[2][2][4][2], const pg8::Unit& u, int wr, int wc, int fr, int fq) const {
        const int pn = u.pn; const int rbase = u.pm * 256 + wr * 64 + fr;
        if (pn < 8) {
            const bool bz = pn < 4; bf16* dst = (bf16*)(ws + (bz ? WS_CG : WS_U)); const int col0 = 128 * (pn & 3) + 32 * wc + 4 * fq;
#pragma unroll
            for (int ai = 0; ai < 2; ++ai)
#pragma unroll
                for (int m = 0; m < 4; ++m) { const int row = rbase + ai * 128 + m * 16; const float rs = rstd[row];
#pragma unroll
                    for (int n = 0; n < 2; ++n) { const f32x4 a = acc[ai][0][m][n] * rs, z = acc[ai][1][m][n] * rs; f32x4 o;
                        if (bz) { o.x = a.x * z.x * sigmoidf(z.x); o.y = a.y * z.y * sigmoidf(z.y); o.z = a.z * z.z * sigmoidf(z.z); o.w = a.w * z.w * sigmoidf(z.w); }
                        else o = a * z;
                        v2u w; w.x = pk2(o.x, o.y); w.y = pk2(o.z, o.w);
                        *(GAS v2u*)(dst + (size_t)row * 512 + col0 + 16 * n) = w;
                        if (!bz) { const int t = row & (T - 1); if (t >= T - 2) *(GAS f32x4*)(out + O_PCONV + ((size_t)(row >> 13) * 2 + (t - (T - 2))) * 512 + col0 + 16 * n) = o; } } }
        } else if (pn < 13) {
            const bool isq = pn < 10; const int br = pn - 10; const bool isk = !isq && wc < 2;
            if (isq || isk) {
                const float* gain = isq ? qg : kg + br * 64; float g1[2][4], g2[2][4];
#pragma unroll
                for (int n = 0; n < 2; ++n)
#pragma unroll
                    for (int e = 0; e < 4; ++e) { g1[n][e] = gain[16 * n + 4 * fq + e]; g2[n][e] = gain[32 + 16 * n + 4 * fq + e]; }
#pragma unroll
                for (int ai = 0; ai < 2; ++ai)
#pragma unroll
                    for (int m = 0; m < 4; ++m) { const int row = rbase + ai * 128 + m * 16; const float rs = rstd[row]; const int t = row & (T - 1), b = row >> 13;
                        f32x4 x1[2], x2[2]; float ss = 0.f;
#pragma unroll
                        for (int n = 0; n < 2; ++n) { x1[n] = acc[ai][0][m][n] * rs; x2[n] = acc[ai][1][m][n] * rs;
                            ss += (x1[n].x * x1[n].x + x1[n].y * x1[n].y) + (x1[n].z * x1[n].z + x1[n].w * x1[n].w) + (x2[n].x * x2[n].x + x2[n].y * x2[n].y) + (x2[n].z * x2[n].z + x2[n].w * x2[n].w); }
                        ss += __shfl_xor(ss, 16); ss += __shfl_xor(ss, 32);
                        const float inv = 1.0f / sqrtf(ss * (1.0f / 64.0f) + NORM_EPS);
                        const float* rp = rope + (size_t)t * 64 + 4 * fq;
#pragma unroll
                        for (int n = 0; n < 2; ++n) { const f32x4 cs = *(const GAS f32x4*)(rp + 16 * n), sn = *(const GAS f32x4*)(rp + 32 + 16 * n); f32x4 o1, o2;
#pragma unroll
                            for (int e = 0; e < 4; ++e) { const float a = x1[n][e] * inv * g1[n][e], c = x2[n][e] * inv * g2[n][e]; o1[e] = a * cs[e] - c * sn[e]; o2[e] = c * cs[e] + a * sn[e]; }
                            const int d1 = 16 * n + 4 * fq;
                            if (isq) { o1 = o1 * QSCALE; o2 = o2 * QSCALE; bf16* q = (bf16*)(ws + WS_Q) + (size_t)row * 512 + (4 * (pn - 8) + wc) * 64 + d1;
                                v2u w; w.x = pk2(o1.x, o1.y); w.y = pk2(o1.z, o1.w); *(GAS v2u*)q = w; w.x = pk2(o2.x, o2.y); w.y = pk2(o2.z, o2.w); *(GAS v2u*)(q + 32) = w; }
                            else { const int g = wc;
                                if (br > 0) { bf16* k = (bf16*)(ws + (br == 1 ? WS_KS : WS_KW)) + ((size_t)(b * 2 + g) * T + t) * 64 + d1;
                                    v2u w; w.x = pk2(o1.x, o1.y); w.y = pk2(o1.z, o1.w); *(GAS v2u*)k = w; w.x = pk2(o2.x, o2.y); w.y = pk2(o2.z, o2.w); *(GAS v2u*)(k + 32) = w; }
                                if (br < 2) { float* o = out + (br == 0 ? O_PCMP : O_PSLC) + (size_t)row * 256 + g * 64 + d1; *(GAS f32x4*)o = o1; *(GAS f32x4*)(o + 32) = o2; }
                                else if (t >= T - 512) { float* o = out + O_PWIN + ((size_t)b * 512 + (t - (T - 512))) * 256 + g * 64 + d1; *(GAS f32x4*)o = o1; *(GAS f32x4*)(o + 32) = o2; } } } }
            } else {
                const int g = wc - 2;
#pragma unroll
                for (int ai = 0; ai < 2; ++ai)
#pragma unroll
                    for (int m = 0; m < 4; ++m) { const int row = rbase + ai * 128 + m * 16; const float rs = rstd[row]; const int t = row & (T - 1), b = row >> 13;
                        const int tk = t & 63, vpos = (tk & ~15) + perm16(tk & 15);
                        bf16* vt = (br > 0) ? (bf16*)(ws + (br == 1 ? WS_VTS : WS_VTW)) + ((size_t)((b * 2 + g) * 128 + (t >> 6)) * 64) * 64 + vpos : nullptr;
#pragma unroll
                        for (int bj = 0; bj < 2; ++bj)
#pragma unroll
                            for (int n = 0; n < 2; ++n) { const f32x4 v = acc[ai][bj][m][n] * rs; const int d1 = 32 * bj + 16 * n + 4 * fq;
                                if (br > 0) {
#pragma unroll
                                    for (int e = 0; e < 4; ++e) vt[(size_t)(d1 + e) * 64] = (bf16)f2bf(v[e]); }
                                if (br < 2) *(GAS f32x4*)(out + (br == 0 ? O_PCMP : O_PSLC) + (size_t)row * 256 + 128 + g * 64 + d1) = v;
                                else if (t >= T - 512) *(GAS f32x4*)(out + O_PWIN + ((size_t)b * 512 + (t - (T - 512))) * 256 + 128 + g * 64 + d1) = v; } }
            }
        } else if (pn < 15) {
            bf16* dst = (bf16*)(ws + WS_ZA);
#pragma unroll
            for (int ai = 0; ai < 2; ++ai)
#pragma unroll
                for (int m = 0; m < 4; ++m) { const int row = rbase + ai * 128 + m * 16; const float rs = rstd[row];
#pragma unroll
                    for (int bj = 0; bj < 2; ++bj)
#pragma unroll
                        for (int n = 0; n < 2; ++n) { const f32x4 z = acc[ai][bj][m][n] * rs; v2u w; w.x = pk2(z.x * sigmoidf(z.x), z.y * sigmoidf(z.y)); w.y = pk2(z.z * sigmoidf(z.z), z.w * sigmoidf(z.w));
                            *(GAS v2u*)(dst + (size_t)row * 512 + 256 * (pn - 13) + 128 * bj + 32 * wc + 16 * n + 4 * fq) = w; } }
        } else {
            if (wc == 0) { float* dst = (float*)(ws + WS_GATE);
#pragma unroll
                for (int ai = 0; ai < 2; ++ai)
#pragma unroll
                    for (int m = 0; m < 4; ++m) { const int row = rbase + ai * 128 + m * 16; const float rs = rstd[row];
#pragma unroll
                        for (int n = 0; n < 2; ++n) { const int c0 = 16 * n + 4 * fq; if (c0 < 24) { const f32x4 z = acc[ai][0][m][n] * rs;
                            *(GAS f32x4*)(dst + (size_t)row * 24 + c0) = (f32x4){sigmoidf(z.x), sigmoidf(z.y), sigmoidf(z.z), sigmoidf(z.w)}; } } } }
        }
    }
};
struct EpiOut {
    static constexpr bool PERM = false, AFTER_DRAIN = false;
    const float* x; float* y;
    __device__ __forceinline__ void operator()(const f32x4 (&acc)[2][2][4][2], const pg8::Unit& u, int wr, int wc, int fr, int fq) const {
#pragma unroll
        for (int ai = 0; ai < 2; ++ai)
#pragma unroll
            for (int m = 0; m < 4; ++m) { const size_t row = (size_t)u.pm * 256 + ai * 128 + wr * 64 + m * 16 + fr;
#pragma unroll
                for (int bj = 0; bj < 2; ++bj)
#pragma unroll
                    for (int n = 0; n < 2; ++n) { const size_t off = row * D + u.pn * 256 + 128 * bj + 32 * wc + 16 * n + 4 * fq;
                        *(GAS f32x4*)(y + off) = *(const GAS f32x4*)(x + off) + acc[ai][bj][m][n]; } }
    }
};
template <int MODE>
__device__ __forceinline__ void small_gemm_tile(const Ptrs& P, const bf16* A, const bf16* Bt, int ct, int lane) {
    const int rho = lane & 15, kq = lane >> 4;
    f32x4 acc[2] = {(f32x4){0.f, 0.f, 0.f, 0.f}, (f32x4){0.f, 0.f, 0.f, 0.f}};
    const GAS v4u* a0 = (const GAS v4u*)(A + (size_t)rho * D + 8 * kq); const GAS v4u* a1 = (const GAS v4u*)(A + (size_t)(16 + rho) * D + 8 * kq);
    const GAS v4u* bp = (const GAS v4u*)(Bt + (size_t)(16 * ct + rho) * D + 8 * kq);
#pragma unroll 8
    for (int ks = 0; ks < 32; ++ks) { const bf16x8 bb = __builtin_bit_cast(bf16x8, bp[ks * 4]);
        acc[0] = __builtin_amdgcn_mfma_f32_16x16x32_bf16(bb, __builtin_bit_cast(bf16x8, a0[ks * 4]), acc[0], 0, 0, 0);
        acc[1] = __builtin_amdgcn_mfma_f32_16x16x32_bf16(bb, __builtin_bit_cast(bf16x8, a1[ks * 4]), acc[1], 0, 0, 0); }
#pragma unroll
    for (int rt = 0; rt < 2; ++rt) { const int b = 16 * rt + rho; const int col = 16 * ct + 4 * kq;
        if (MODE == 0) { const float rs = ((const float*)(P.ws + WS_RSTDS))[b]; *(GAS f32x4*)((float*)(P.ws + WS_PROJS) + (size_t)b * NP + col) = acc[rt] * rs; }
        else *(GAS f32x4*)(P.out + O_YS + (size_t)b * D + col) = *(const GAS f32x4*)(P.xs + (size_t)b * D + col) + acc[rt]; }
}
__device__ __forceinline__ int projs_col(int pn, int wc, int d) { return 256 * pn + 128 * (d >> 5) + 32 * wc + (d & 31); }
__device__ __forceinline__ void p2_sample_item(const Ptrs& P, int it, int lane) {
    const int b = it / 37, ty = it - b * 37;
    const float* pr = (const float*)(P.ws + WS_PROJS) + (size_t)b * NP;
    const float* ropes = (const float*)(P.ws + WS_ROPE) + (size_t)8192 * 64;
    float* kvn = (float*)(P.ws + WS_KVN) + (size_t)b * 768;
    if (ty < 14) {
        const bool isq = ty < 8; const int br = isq ? 0 : (ty - 8) >> 1, g = (ty - 8) & 1;
        const int pn = isq ? 8 + (ty >> 2) : 10 + br, wc = isq ? (ty & 3) : g;
        const float v = pr[projs_col(pn, wc, lane)];
        const float ss = wave_sum(v * v); const float inv = 1.0f / sqrtf(ss * (1.0f / 64.0f) + NORM_EPS);
        const float gn = isq ? P.q_gain[lane] : P.k_gain[br * 64 + lane];
        const float xn = v * inv * gn; const float xo = __shfl_xor(xn, 32);
        const int i = lane & 31; const float cs = ropes[i], sn = ropes[32 + i];
        const float o = (lane < 32) ? xn * cs - xo * sn : xn * cs + xo * sn;
        if (isq) ((float*)(P.ws + WS_QS))[(size_t)b * 512 + ty * 64 + lane] = o * QSCALE;
        else { kvn[(br * 2 + 0) * 128 + g * 64 + lane] = o;
            if (br == 0) P.out[O_SCMP + (size_t)b * 256 + g * 64 + lane] = o; else if (br == 1) P.out[O_SSLC + (size_t)b * 256 + g * 64 + lane] = o;
            else P.out[O_SWIN + ((size_t)b * 512 + 511) * 256 + g * 64 + lane] = o; }
    } else if (ty < 20) {
        const int br = (ty - 14) >> 1, g = (ty - 14) & 1; const float v = pr[projs_col(10 + br, 2 + g, lane)];
        kvn[(br * 2 + 1) * 128 + g * 64 + lane] = v;
        if (br == 0) P.out[O_SCMP + (size_t)b * 256 + 128 + g * 64 + lane] = v; else if (br == 1) P.out[O_SSLC + (size_t)b * 256 + 128 + g * 64 + lane] = v;
        else P.out[O_SWIN + ((size_t)b * 512 + 511) * 256 + 128 + g * 64 + lane] = v;
    } else if (ty == 20) {
        if (lane < 24) ((float*)(P.ws + WS_GS))[b * 24 + lane] = sigmoidf(pr[256 * 15 + lane]);
    } else if (ty < 29) {
        const int ch = (ty - 21) * 64 + lane; const int pnb = ch >> 7, tc = ch & 127;
        const float bg = pr[256 * pnb + tc], zc = pr[256 * pnb + 128 + tc], cg = pr[256 * (4 + pnb) + tc], ci = pr[256 * (4 + pnb) + 128 + tc];
        const float u = cg * ci; const float s0 = P.st_conv[(size_t)b * 1024 + ch], s1 = P.st_conv[(size_t)b * 1024 + 512 + ch];
        const float cy = P.conv_w[ch] * s0 + P.conv_w[512 + ch] * s1 + P.conv_w[1024 + ch] * u + P.conv_b[ch];
        ((bf16*)(P.ws + WS_MIXS))[(size_t)b * 1024 + ch] = (bf16)f2bf(bg * cy * zc * sigmoidf(zc));
        P.out[O_SCONV + (size_t)b * 1024 + 512 + ch] = u;
    } else {
        const int col = (ty - 29) * 64 + lane; const float z = pr[256 * (13 + (col >> 8)) + (col & 255)];
        ((float*)(P.ws + WS_ZAS))[(size_t)b * 512 + col] = z * sigmoidf(z);
    }
}
__device__ __forceinline__ void p2_phase(const Ptrs& P, Frame& F) {
    for (int it = F.gw; it < BATCH * 16 + DECB * 37; it += F.NGW) {
        if (it < BATCH * 16) compress_unit<false>(P, it >> 4, (it & 15) * 16, F.lane);
        else p2_sample_item(P, it - BATCH * 16, F.lane);
    }
}
#define MFMA32(a, b, c) __builtin_amdgcn_mfma_f32_32x32x16_bf16(a, b, c, 0, 0, 0)
constexpr int IMP_OFF = 0;
constexpr int P3_MISC = 32768;
constexpr int SM_Q = 36864, SM_P = 40960, SM_RED = 57344, SM_IMP = 66048, SM_L = 67200, SM_SEL = 67328, SM_O = 67584;

__device__ __forceinline__ void attend_block(const bf16* K, const bf16* VT, int vstride, const bf16x8 (&qf)[4], f32x16 (&O)[2], float& lsum, float shift, float scale,
                                             int kbase, int lo, int hi, int lane, bool want_pv, f32x16 (*Sout)[2] = nullptr) {
    const int r = lane & 31, hh = lane >> 5;
    f32x16 S[2];
#pragma unroll
    for (int kt = 0; kt < 2; ++kt) {
        bf16x8 kf[4];
#pragma unroll
        for (int s = 0; s < 4; ++s) kf[s] = __builtin_bit_cast(bf16x8, *(const GAS v4u*)(K + (size_t)(32 * kt + r) * 64 + 16 * s + 8 * hh));
        f32x16 acc;
#pragma unroll
        for (int i = 0; i < 16; ++i) acc[i] = 0.f;
#pragma unroll
        for (int s = 0; s < 4; ++s) acc = MFMA32(kf[s], qf[s], acc);
        S[kt] = acc;
    }
    bf16x8 pf[4];
#pragma unroll
    for (int kt = 0; kt < 2; ++kt) {
#pragma unroll
        for (int i = 0; i < 16; ++i) { const int kp = kbase + 32 * kt + (i & 3) + 8 * (i >> 2) + 4 * hh;
            float p = fast_exp2(S[kt][i] - shift) * scale; p = (kp >= lo && kp <= hi) ? p : 0.f; S[kt][i] = p; lsum += p; }
#pragma unroll
        for (int sp = 0; sp < 2; ++sp) { v4u w; w.x = pk2(S[kt][8 * sp + 0], S[kt][8 * sp + 1]); w.y = pk2(S[kt][8 * sp + 2], S[kt][8 * sp + 3]);
            w.z = pk2(S[kt][8 * sp + 4], S[kt][8 * sp + 5]); w.w = pk2(S[kt][8 * sp + 6], S[kt][8 * sp + 7]); pf[2 * kt + sp] = __builtin_bit_cast(bf16x8, w); }
    }
    if (Sout) { (*Sout)[0] = S[0]; (*Sout)[1] = S[1]; }
    if (want_pv) {
#pragma unroll
        for (int dt = 0; dt < 2; ++dt) {
            bf16x8 vf[4];
#pragma unroll
            for (int ks = 0; ks < 4; ++ks) vf[ks] = __builtin_bit_cast(bf16x8, *(const GAS v4u*)(VT + (size_t)(32 * dt + r) * vstride + 16 * ks + 8 * hh));
#pragma unroll
            for (int ks = 0; ks < 4; ++ks) O[dt] = MFMA32(vf[ks], pf[ks], O[dt]);
        }
    }
}
__device__ __forceinline__ void wave_topk(const LAS float* imp, int jmax, int nsel, int lane, unsigned long long& my0, unsigned long long& my1, unsigned long long& u0, unsigned long long& u1) {
    my0 = 0ull; my1 = 0ull; u0 = 0ull; u1 = 0ull;
    if (jmax < 1) return;
    const int myq = (lane & 31) >> 2;
    for (int qi = 0; qi < 8; ++qi) {
        const bool c0 = lane >= 1 && lane <= jmax, c1 = 64 + lane <= jmax;
        const unsigned k0 = c0 ? __builtin_bit_cast(unsigned, imp[qi * 128 + lane]) + 1u : 0u, k1 = c1 ? __builtin_bit_cast(unsigned, imp[qi * 128 + 64 + lane]) + 1u : 0u;
        unsigned long long m0, m1;
        if (jmax <= nsel) { m0 = __ballot(c0); m1 = __ballot(c1); }
        else {
            unsigned Tv = 0u;
            for (int bit = 30; bit >= 0; --bit) { const unsigned cand = Tv | (1u << bit);
                const int cnt = __popcll(__ballot(k0 >= cand)) + __popcll(__ballot(k1 >= cand)); if (cnt >= nsel) Tv = cand; }
            const unsigned long long g0 = __ballot(k0 > Tv), g1 = __ballot(k1 > Tv), e0 = __ballot(k0 == Tv), e1 = __ballot(k1 == Tv);
            const int need = nsel - __popcll(g0) - __popcll(g1);
            const unsigned long long below = (lane == 0) ? 0ull : (~0ull >> (64 - lane));
            const int rk0 = __popcll(e0 & below), rk1 = __popcll(e0) + __popcll(e1 & below);
            m0 = g0 | __ballot(k0 == Tv && rk0 < need); m1 = g1 | __ballot(k1 == Tv && rk1 < need);
        }
        if (myq == qi) { my0 = m0; my1 = m1; }
        u0 |= m0; u1 |= m1;
    }
}
__device__ __forceinline__ void p3_prompt_unit(const Ptrs& P, Frame& F, int b, int t, int g, float sh_cmp, float sh_slc, float sh_win) {
    const int lane = F.lane, w = F.wave, col = lane & 31, hh = lane >> 5, qi = col >> 2, h = col & 3;
    const int tok = 64 * t + 8 * w + qi; const size_t row = (size_t)b * T + tok; const int qpos = tok;
    bf16x8 qf[4];
    { const bf16* q = (const bf16*)(P.ws + WS_Q) + row * 512 + (g * 4 + h) * 64 + 8 * hh;
#pragma unroll
      for (int s = 0; s < 4; ++s) qf[s] = __builtin_bit_cast(bf16x8, *(const GAS v4u*)(q + 16 * s)); }
    const float* gate = (const float*)(P.ws + WS_GATE) + row * 24 + (g * 4 + h) * 3;
    const float g_cmp = gate[0], g_slc = gate[1], g_win = gate[2];
    f32x16 tot[2], O[2];
#pragma unroll
    for (int i = 0; i < 16; ++i) { tot[0][i] = 0.f; tot[1][i] = 0.f; }
    const int nvis = (qpos + 1) >> 5, nck = (2 * t + 2 + 63) >> 6;
    const bf16* KC = (const bf16*)(P.ws + WS_KC) + (size_t)(b * 2 + g) * 256 * 64; const bf16* VCT = (const bf16*)(P.ws + WS_VCT) + (size_t)(b * 2 + g) * 64 * 256;
    float lsum = 0.f;
    for (int ck = 0; ck < nck; ++ck) attend_block(KC + (size_t)ck * 64 * 64, VCT + ck * 64, 256, qf, O, lsum, sh_cmp, 1.0f, 64 * ck, 0, nvis - 1, lane, false);
    lsum += __shfl_xor(lsum, 32);
    const float rl = lsum > 0.f ? 1.0f / lsum : 0.f;
    LAS float* imp = (LAS float*)(F.lds + IMP_OFF) + w * 1024;
    for (int i = lane; i < 1024; i += 64) imp[i] = 0.f;
#pragma unroll
    for (int i = 0; i < 16; ++i) { O[0][i] = 0.f; O[1][i] = 0.f; }
    { float dummy = 0.f;
      for (int ck = 0; ck < nck; ++ck) { f32x16 Sn[2];
        attend_block(KC + (size_t)ck * 64 * 64, VCT + ck * 64, 256, qf, O, dummy, sh_cmp, rl, 64 * ck, 0, nvis - 1, lane, true, &Sn);
#pragma unroll
        for (int kt = 0; kt < 2; ++kt)
#pragma unroll
            for (int i2 = 0; i2 < 8; ++i2) { float v = Sn[kt][2 * i2] + Sn[kt][2 * i2 + 1]; v += __shfl_xor(v, 1); v += __shfl_xor(v, 2);
                if (h == 0) imp[qi * 128 + 32 * ck + 16 * kt + (i2 & 1) + 4 * (i2 >> 1) + 2 * hh] = v; } } }
#pragma unroll
    for (int i = 0; i < 16; ++i) { tot[0][i] = O[0][i] * g_cmp; tot[1][i] = O[1][i] * g_cmp; O[0][i] = 0.f; O[1][i] = 0.f; }
    LDS_WAIT(); asm volatile("" ::: "memory");
    unsigned long long my0, my1, u0, u1;
    wave_topk(imp, t - 2, 13, lane, my0, my1, u0, u1);
    const bf16* KS = (const bf16*)(P.ws + WS_KS) + (size_t)(b * 2 + g) * T * 64; const bf16* VTS = (const bf16*)(P.ws + WS_VTS) + (size_t)(b * 2 + g) * 128 * 4096;
    lsum = 0.f;
    attend_block(KS + (size_t)t * 4096, VTS + (size_t)t * 4096, 64, qf, O, lsum, sh_slc, 1.0f, 64 * t, 0, qpos, lane, true);
    if (t >= 1) attend_block(KS, VTS, 64, qf, O, lsum, sh_slc, 1.0f, 0, 0, 0x7fffffff, lane, true);
    if (t >= 2) attend_block(KS + (size_t)(t - 1) * 4096, VTS + (size_t)(t - 1) * 4096, 64, qf, O, lsum, sh_slc, 1.0f, 0, 0, 0x7fffffff, lane, true);
    for (int half = 0; half < 2; ++half) { unsigned long long um = half ? u1 : u0; const unsigned long long mym = half ? my1 : my0;
        while (um) { const int bit = __builtin_ctzll(um); um &= um - 1; const int j = 64 * half + bit; const bool on = (mym >> bit) & 1ull;
            attend_block(KS + (size_t)j * 4096, VTS + (size_t)j * 4096, 64, qf, O, lsum, sh_slc, 1.0f, 0, on ? 0 : 1, on ? 0x7fffffff : 0, lane, true); } }
    lsum += __shfl_xor(lsum, 32);
    { const float sc = g_slc / fmaxf(lsum, 1e-30f);
#pragma unroll
      for (int i = 0; i < 16; ++i) { tot[0][i] += O[0][i] * sc; tot[1][i] += O[1][i] * sc; O[0][i] = 0.f; O[1][i] = 0.f; } }
    const bf16* KW = (const bf16*)(P.ws + WS_KW) + (size_t)(b * 2 + g) * T * 64; const bf16* VTW = (const bf16*)(P.ws + WS_VTW) + (size_t)(b * 2 + g) * 128 * 4096;
    lsum = 0.f;
    for (int j = (t >= 8 ? t - 8 : 0); j <= t; ++j) attend_block(KW + (size_t)j * 4096, VTW + (size_t)j * 4096, 64, qf, O, lsum, sh_win, 1.0f, 64 * j, qpos - 511, qpos, lane, true);
    lsum += __shfl_xor(lsum, 32);
    { const float sc = g_win / fmaxf(lsum, 1e-30f);
#pragma unroll
      for (int i = 0; i < 16; ++i) { tot[0][i] += O[0][i] * sc; tot[1][i] += O[1][i] * sc; } }
    const bf16* za = (const bf16*)(P.ws + WS_ZA) + row * 512 + (g * 4 + h) * 64; bf16* mx = (bf16*)(P.ws + WS_MIX) + row * 1024 + 512 + (g * 4 + h) * 64;
#pragma unroll
    for (int dt = 0; dt < 2; ++dt)
#pragma unroll
        for (int i4 = 0; i4 < 4; ++i4) { const int d = 32 * dt + 8 * i4 + 4 * hh; const v2u z = *(const GAS v2u*)(za + d);
            v2u o; o.x = pk2(tot[dt][4 * i4] * bf2f(z.x & 0xffffu), tot[dt][4 * i4 + 1] * bf2f(z.x >> 16)); o.y = pk2(tot[dt][4 * i4 + 2] * bf2f(z.y & 0xffffu), tot[dt][4 * i4 + 3] * bf2f(z.y >> 16));
            *(GAS v2u*)(mx + d) = o; }
    if (g == 0) { const int ch = F.tid; const float w0 = P.conv_w[ch], w1 = P.conv_w[512 + ch], w2 = P.conv_w[1024 + ch], cb = P.conv_b[ch];
        const size_t r0 = (size_t)b * T + 64 * t; const bf16* U = (const bf16*)(P.ws + WS_U) + ch; const bf16* CGp = (const bf16*)(P.ws + WS_CG) + ch; bf16* mo = (bf16*)(P.ws + WS_MIX) + ch;
        float um2 = (t > 0) ? bf2f(U[(r0 - 2) * 512]) : 0.f, um1 = (t > 0) ? bf2f(U[(r0 - 1) * 512]) : 0.f;
#pragma unroll 4
        for (int i = 0; i < 64; ++i) { const float uc = bf2f(U[(r0 + i) * 512]); const float cy = w0 * um2 + w1 * um1 + w2 * uc + cb;
            mo[(r0 + i) * 1024] = (bf16)f2bf(bf2f(CGp[(r0 + i) * 512]) * cy); um2 = um1; um1 = uc; } }
}
template <class KeyFn>
__device__ __forceinline__ void sample_branch(Frame& F, int nslots, float shift, const KeyFn& key, LAS float* obr) {
    LAS float* q = (LAS float*)(F.lds + SM_Q); LAS float* Pb = (LAS float*)(F.lds + SM_P); LAS float* red = (LAS float*)(F.lds + SM_RED); LAS float* lsm = (LAS float*)(F.lds + SM_L);
    float lacc[4] = {0.f, 0.f, 0.f, 0.f};
    for (int s = F.tid; s < nslots; s += 512) { const float* kp; const float* vp; const bool valid = key(s, kp, vp);
        float sc[4] = {0.f, 0.f, 0.f, 0.f};
        if (valid) {
#pragma unroll 4
            for (int d4 = 0; d4 < 16; ++d4) { const f32x4 kv = *(const GAS f32x4*)(kp + 4 * d4);
#pragma unroll
                for (int hq = 0; hq < 4; ++hq) { const f32x4 qv = *(const LAS f32x4*)(q + hq * 64 + 4 * d4); sc[hq] += (kv.x * qv.x + kv.y * qv.y) + (kv.z * qv.z + kv.w * qv.w); } } }
        f32x4 p;
#pragma unroll
        for (int hq = 0; hq < 4; ++hq) { p[hq] = valid ? fast_exp2(sc[hq] - shift) : 0.f; lacc[hq] += p[hq]; }
        *(LAS f32x4*)(Pb + 4 * s) = p; }
#pragma unroll
    for (int hq = 0; hq < 4; ++hq) { lacc[hq] = wave_sum(lacc[hq]); if (F.lane == 0) red[F.wave * 4 + hq] = lacc[hq]; }
    __syncthreads();
    if (F.tid < 4) { float s = 0.f; for (int ww = 0; ww < 8; ++ww) s += red[ww * 4 + F.tid]; lsm[F.tid] = s; }
    __syncthreads();
    float oa[4] = {0.f, 0.f, 0.f, 0.f};
    const int per = nslots / 8;
    for (int s = F.wave * per; s < (F.wave + 1) * per; ++s) { const float* kp; const float* vp; const bool valid = key(s, kp, vp);
        if (valid) { const float v = vp[F.lane]; const f32x4 p = *(const LAS f32x4*)(Pb + 4 * s); oa[0] += p.x * v; oa[1] += p.y * v; oa[2] += p.z * v; oa[3] += p.w * v; } }
#pragma unroll
    for (int hq = 0; hq < 4; ++hq) red[64 + (F.wave * 4 + hq) * 64 + F.lane] = oa[hq];
    __syncthreads();
    if (F.tid < 256) { float s = 0.f; for (int ww = 0; ww < 8; ++ww) s += red[64 + (ww * 4 + (F.tid >> 6)) * 64 + (F.tid & 63)]; obr[F.tid] = s; }
    __syncthreads();
}
__device__ __forceinline__ void p3_sample_unit(const Ptrs& P, Frame& F, int b, int g) {
    LAS float* q = (LAS float*)(F.lds + SM_Q); LAS float* Pb = (LAS float*)(F.lds + SM_P); LAS float* imp = (LAS float*)(F.lds + SM_IMP); LAS float* lsm = (LAS float*)(F.lds + SM_L);
    LAS int* sel = (LAS int*)(F.lds + SM_SEL); LAS float* osm = (LAS float*)(F.lds + SM_O);
    const float* cst = (const float*)(P.ws + WS_CONST);
    const float kcmax = __builtin_bit_cast(float, __hip_atomic_load((unsigned*)(P.ws + WS_CTL) + CW_KCMAX + 64, RLX_AGENT));
    const float sh_cmp = cst[0] * sqrtf(kcmax) * LOG2E * 1.001f, sh_slc = cst[1], sh_win = cst[2];
    if (F.tid < 256) q[F.tid] = ((const float*)(P.ws + WS_QS))[(size_t)b * 512 + g * 256 + F.tid];
    __syncthreads();
    const float* kcs = (const float*)(P.ws + WS_KCS) + (size_t)(b * 2 + g) * 2 * NCS * 64;
    sample_branch(F, NCS, sh_cmp, [&](int s, const float*& kp, const float*& vp) { kp = kcs + (size_t)s * 64; vp = kcs + (size_t)(NCS + s) * 64; return true; }, osm);
    { const f32x4 p = *(const LAS f32x4*)(Pb + 4 * F.tid); float v = p.x / lsm[0] + p.y / lsm[1] + p.z / lsm[2] + p.w / lsm[3]; v += __shfl_xor(v, 1);
      if ((F.tid & 1) == 0) imp[F.tid >> 1] = v; if (F.tid < 4) imp[256 + F.tid] = 0.f; }
    if (F.tid < 256) osm[F.tid] = osm[F.tid] / lsm[F.tid >> 6];
    __syncthreads();
    if (F.wave == 0) { const int lane = F.lane; unsigned k[4];
#pragma unroll
        for (int i = 0; i < 4; ++i) { const int j = lane + 64 * i; k[i] = (j >= 1 && j <= 254) ? __builtin_bit_cast(unsigned, imp[j]) + 1u : 0u; }
        unsigned Tv = 0u;
        for (int bit = 30; bit >= 0; --bit) { const unsigned cand = Tv | (1u << bit); int cnt = 0;
#pragma unroll
            for (int i = 0; i < 4; ++i) cnt += __popcll(__ballot(k[i] >= cand));
            if (cnt >= 13) Tv = cand; }
        int ngt = 0;
#pragma unroll
        for (int i = 0; i < 4; ++i) ngt += __popcll(__ballot(k[i] > Tv));
        const int need = 13 - ngt; const unsigned long long below = (lane == 0) ? 0ull : (~0ull >> (64 - lane));
        int base = 3, eqbase = 0;
        if (lane == 0) { sel[0] = 0; sel[1] = 255; sel[2] = 256; }
#pragma unroll
        for (int i = 0; i < 4; ++i) { const unsigned long long e = __ballot(k[i] == Tv); const int rk = eqbase + __popcll(e & below); const bool on = k[i] > Tv || (k[i] == Tv && rk < need);
            const unsigned long long m = __ballot(on); if (on) sel[base + __popcll(m & below)] = lane + 64 * i; base += __popcll(m); eqbase += __popcll(e); } }
    __syncthreads();
    const float* kvn = (const float*)(P.ws + WS_KVN) + (size_t)b * 768;
    const int* pt = P.page_table + b * NPAGES; const float* cs = P.cache_slc;
    sample_branch(F, 1024, sh_slc, [&](int s, const float*& kp, const float*& vp) { const int j = sel[s >> 6], rr = s & 63;
        if (j == 256) { kp = kvn + (1 * 2 + 0) * 128 + g * 64; vp = kvn + (1 * 2 + 1) * 128 + g * 64; return rr == 0; }
        const float* rowp = cs + ((size_t)pt[j >> 1] * 128 + (j & 1) * 64 + rr) * 256 + g * 64; kp = rowp; vp = rowp + 128; return true; }, osm + 256);
    if (F.tid < 256) osm[256 + F.tid] = osm[256 + F.tid] / lsm[F.tid >> 6];
    __syncthreads();
    const float* stw = P.st_win + (size_t)b * 512 * 256;
    sample_branch(F, 512, sh_win, [&](int s, const float*& kp, const float*& vp) {
        if (s == 511) { kp = kvn + (2 * 2 + 0) * 128 + g * 64; vp = kvn + (2 * 2 + 1) * 128 + g * 64; return true; }
        const float* rowp = stw + (size_t)(s + 1) * 256 + g * 64; kp = rowp; vp = rowp + 128; return true; }, osm + 512);
    if (F.tid < 256) { const int hq = F.tid >> 6, d = F.tid & 63; const float* gs = (const float*)(P.ws + WS_GS) + b * 24 + (g * 4 + hq) * 3;
        const float o = gs[0] * osm[F.tid] + gs[1] * osm[256 + F.tid] + gs[2] * osm[512 + F.tid] / lsm[hq];
        ((bf16*)(P.ws + WS_MIXS))[(size_t)b * 1024 + 512 + (g * 4 + hq) * 64 + d] = (bf16)f2bf(o * ((const float*)(P.ws + WS_ZAS))[(size_t)b * 512 + (g * 4 + hq) * 64 + d]); }
    __syncthreads();
}
__device__ __forceinline__ void p3_phase(const Ptrs& P, Frame& F) {
    const float* cst = (const float*)(P.ws + WS_CONST);
    const float kcmax = __builtin_bit_cast(float, __hip_atomic_load((unsigned*)(P.ws + WS_CTL) + CW_KCMAX, RLX_AGENT));
    const float sh_cmp = cst[0] * sqrtf(kcmax) * LOG2E * 1.001f, sh_slc = cst[1], sh_win = cst[2];
    volatile LAS int* qw = (volatile LAS int*)(F.lds + P3_MISC);
    constexpr int NU = 64 + BATCH * 128 * 2;
    for (;;) {
        __syncthreads();
        if (F.tid == 0) qw[0] = (int)__hip_atomic_fetch_add((unsigned*)(F.ctl + CW_QUEUE), 1u, RLX_AGENT);
        __syncthreads();
        const int idx = qw[0];
        if (idx >= NU) break;
        if (idx < 64) p3_sample_unit(P, F, idx >> 1, idx & 1);
        else { const int u = idx - 64; const int t = 127 - (u >> 3), b = (u >> 1) & 3, g = u & 1; p3_prompt_unit(P, F, b, t, g, sh_cmp, sh_slc, sh_win); }
    }
}
#ifndef MK_N_LAUNCHES
#define MK_N_LAUNCHES 1
#endif
constexpr int N_PHASES = 6;
constexpr int N_LAUNCHES = MK_N_LAUNCHES;
struct Args { Ptrs p; int ph_lo, ph_hi; };
__global__ void __launch_bounds__(NWAVES * 64, 2) nsa_fwd(Args args) {
    extern __shared__ __attribute__((aligned(16))) unsigned char lds[];
    const Ptrs& P = args.p;
    Frame F;
    F.lds = (LAS unsigned char*)lds;
    F.MISC = (volatile LAS unsigned*)(F.lds + MISC_OFF);
    F.tid = threadIdx.x; F.lane = F.tid & 63; F.wave = __builtin_amdgcn_readfirstlane(F.tid >> 6);
    F.G = gridDim.x; F.gw = blockIdx.x * NWAVES + F.wave; F.NGW = F.G * NWAVES;
    F.ctl = (gu32*)(P.ws + WS_CTL);
    for (int u = F.tid; u < (LDS_BYTES - LDSCTL_OFF) / 4; u += NWAVES * 64) ((LAS unsigned*)(F.lds + LDSCTL_OFF))[u] = 0u;
    __syncthreads();
    XcdBarrier bar; bar.bar = (unsigned*)(F.ctl + CW_BAR); bar.x = 0; bar.st = nullptr;
    if (N_LAUNCHES == 1) bar = xcd_barrier_post((unsigned*)(F.ctl + CW_BAR), F.MISC + 8);
    const int lo = args.ph_lo, hi = args.ph_hi;
#define IN(k) (lo <= (k) && (k) < hi)
#define SEAM(k) do { if (IN(k) && IN((k) + 1)) xcd_barrier(bar); } while (0)

    if (IN(0)) { p0a_small(P, F); } SEAM(0);
    if (IN(1)) { p0b_big(P, F); } SEAM(1);
    if (IN(2)) {
        pg8::Gemm g{(const pg8::bf16_t*)(P.ws + WS_XB), (const pg8::bf16_t*)(P.ws + WS_BT1), M, NP, D}; pg8::StaticOrder S; S.init(M, NP, F.G, (int)blockIdx.x);
        EpiIn E{(const float*)(P.ws + WS_RSTD), (const float*)(P.ws + WS_ROPE), P.q_gain, P.k_gain, P.out, P.ws};
        pg8::gemm_phase<EpiIn, pg8::StaticOrder, true, true>(F.lds + RING_OFF, g, S, E);
        for (int ct = F.gw; ct < NP / 16; ct += F.NGW) small_gemm_tile<0>(P, (const bf16*)(P.ws + WS_XSB), (const bf16*)(P.ws + WS_BT1), ct, F.lane);
    } SEAM(2);
    if (IN(3)) { p2_phase(P, F); } SEAM(3);
    if (IN(4)) { p3_phase(P, F); } SEAM(4);
    if (IN(5)) {
        pg8::Gemm g{(const pg8::bf16_t*)(P.ws + WS_MIX), (const pg8::bf16_t*)(P.ws + WS_BT2), M, D, D}; pg8::StaticOrder S; S.init(M, D, F.G, (int)blockIdx.x);
        EpiOut E{P.xp, P.out + O_Y};
        pg8::gemm_phase<EpiOut, pg8::StaticOrder, true, true>(F.lds + RING_OFF, g, S, E);
        for (int ct = F.gw; ct < D / 16; ct += F.NGW) small_gemm_tile<1>(P, (const bf16*)(P.ws + WS_MIXS), (const bf16*)(P.ws + WS_BT2), ct, F.lane);
    }
#undef IN
#undef SEAM
}

extern "C" void kernel_launch(void* const* d_in, const int* in_sizes, int n_in, void* d_out, int out_size, void* d_ws, size_t ws_size, hipStream_t stream) {
    static int grid = 0;
    if (grid == 0) {
        if (n_in != 16 || out_size != (int)O_END || ws_size < WS_END) { fprintf(stderr, "kernel_launch: unexpected shapes (n_in %d, out %d, ws %zu)\n", n_in, out_size, ws_size); grid = -1; return; }
        int dev = 0, cus = 0, per_cu = 0;
        if (hipGetDevice(&dev) != hipSuccess || hipDeviceGetAttribute(&cus, hipDeviceAttributeMultiprocessorCount, dev) != hipSuccess) { grid = -1; return; }
        if (hipFuncSetAttribute((const void*)nsa_fwd, hipFuncAttributeMaxDynamicSharedMemorySize, LDS_BYTES) != hipSuccess) { fprintf(stderr, "kernel_launch: hipFuncSetAttribute failed\n"); grid = -1; return; }
        if (hipOccupancyMaxActiveBlocksPerMultiprocessor(&per_cu, (const void*)nsa_fwd, NWAVES * 64, LDS_BYTES) != hipSuccess || per_cu < 1)
            fprintf(stderr, "kernel_launch: note: occupancy query reports %d workgroups per CU\n", per_cu);
        (void)hipGetLastError();
        grid = cus;
    }
    if (grid < 0) return;
    if (hipMemsetAsync((char*)d_ws + WS_CTL, 0, CTL_ZERO_BYTES, stream) != hipSuccess) return;
    Args a{};
    a.p.xp = (const float*)d_in[0]; a.p.xs = (const float*)d_in[1]; a.p.cache_cmp = (const float*)d_in[2]; a.p.cache_slc = (const float*)d_in[3];
    a.p.st_win = (const float*)d_in[4]; a.p.st_conv = (const float*)d_in[5]; a.p.page_table = (const int*)d_in[6]; a.p.norm_g = (const float*)d_in[7];
    a.p.w_in = (const float*)d_in[8]; a.p.conv_w = (const float*)d_in[9]; a.p.conv_b = (const float*)d_in[10]; a.p.q_gain = (const float*)d_in[11];
    a.p.k_gain = (const float*)d_in[12]; a.p.cmp_pe = (const float*)d_in[13]; a.p.cmp_w = (const float*)d_in[14]; a.p.w_out = (const float*)d_in[15];
    a.p.out = (float*)d_out; a.p.ws = (unsigned char*)d_ws;
    for (int li = 0; li < N_LAUNCHES; ++li) {
        a.ph_lo = (N_LAUNCHES == 1) ? 0 : li; a.ph_hi = (N_LAUNCHES == 1) ? N_PHASES : li + 1;
        hipLaunchKernelGGL(nsa_fwd, dim3(grid), dim3(NWAVES * 64), LDS_BYTES, stream, a);
        const hipError_t le = hipPeekAtLastError();
        if (le != hipSuccess) { fprintf(stderr, "kernel_launch: launch %d failed: %s\n", li, hipGetErrorName(le)); break; }
    }
}
```

```cpp
#include <hip/hip_runtime.h>
#include <cstdio>
#include <cstdint>
#define GAS __attribute__((address_space(1)))
#define LAS __attribute__((address_space(3)))
typedef unsigned short bf16;
typedef unsigned v4u __attribute__((ext_vector_type(4)));
typedef unsigned v2u __attribute__((ext_vector_type(2)));
typedef float f32x2 __attribute__((ext_vector_type(2)));
typedef float f32x16 __attribute__((ext_vector_type(16)));
typedef GAS unsigned gu32;
typedef GAS unsigned long long gu64;
#define RLX_AGENT __ATOMIC_RELAXED, __HIP_MEMORY_SCOPE_AGENT
#define LDS_WAIT() asm volatile("s_waitcnt lgkmcnt(0)" ::: "memory")
#define VM_WAIT() asm volatile("s_waitcnt vmcnt(0)" ::: "memory")
#define MK_N_LAUNCHES 1
#define PROBE_DUP -1
namespace pg8 {
#define PG8_LAS __attribute__((address_space(3)))
typedef unsigned short bf16_t;
typedef short bf16x8 __attribute__((ext_vector_type(8)));
typedef float f32x4 __attribute__((ext_vector_type(4)));
typedef unsigned u32x4 __attribute__((ext_vector_type(4)));
constexpr int BM = 256, BK = 64, HALF = 128, HTB = HALF * BK * 2  , STAGE_BYTES = 8 * HTB, NXCD = 8, WGM = 8;

__host__ __device__ __forceinline__ int lds_byte(int r, int c) { const int st = (r >> 4) * 2 + (c >> 5), rr = r & 15, cc = c & 31, ob = rr * 64 + cc * 2; return st * 1024 + (ob ^ (((ob >> 9) & 1) << 5)); }
__host__ __device__ __forceinline__ void stage_rc(int b, int& R, int& C) { const int st = b / 1024, sb = b % 1024, swz = sb ^ (((sb >> 9) & 1) << 5); R = (st >> 1) * 16 + swz / 64; C = (st & 1) * 32 + (swz % 64) / 2; }
__host__ __device__ __forceinline__ int perm32(int rho) { const int n = rho >> 4, i = rho & 15; return 8 * (i >> 2) + 4 * n + (i & 3); }

struct Unit { int pm, pn; };
struct Gemm { const bf16_t* A; const bf16_t* Bt; int M, N, K; };

struct StaticOrder {
    int nM, nN, nwg, G, c;
    __host__ __device__ void init(int M, int N, int G_, int c_) { nM = M / BM; nN = N / BM; nwg = nM * nN; G = G_; c = c_; }
    __host__ __device__ bool next(int i, Unit& u) const {
        const long L = (long)i * G + c; if (L >= nwg) return false;
        int wgid = (int)L; { const int q = nwg / NXCD, r = nwg % NXCD, xcd = wgid % NXCD, off = wgid / NXCD; wgid = (xcd < r ? xcd * (q + 1) : r * (q + 1) + (xcd - r) * q) + off; }
        const int nig = WGM * nN, gid = wgid / nig, fm = gid * WGM, gsz = (nM - fm) < WGM ? (nM - fm) : WGM;
        u.pm = fm + ((wgid % nig) % gsz); u.pn = (wgid % nig) / gsz; return true;
    }
    __device__ __forceinline__ void a_ready(const Unit&) const {}
    __device__ __forceinline__ void done(const Unit&) const {}
};


template <class Epi, class Sched, bool ALIGN_EPI = false, bool SP2 = false>
__device__ __forceinline__ void gemm_phase(PG8_LAS unsigned char* lds, const Gemm g, const Sched& S, const Epi& E) {
    const int tid = threadIdx.x, wid = __builtin_amdgcn_readfirstlane(tid >> 6), lane = tid & 63, wr = wid >> 2, wc = wid & 3, fr = lane & 15, fq = lane >> 4;
    const int K = g.K, nt = K / BK;
    unsigned voffA[2], voffB[2];
#pragma unroll
    for (int i = 0; i < 2; ++i) { int R, C; stage_rc(tid * 16 + i * 8192, R, C); const int Rb = Epi::PERM ? ((R & ~31) + perm32(R & 31)) : R;
        voffA[i] = (unsigned)(R * K + C) * 2u; voffB[i] = (unsigned)(Rb * K + C) * 2u; }
    const size_t kstep = (size_t)(BK * 2);
    const size_t hstep = (size_t)HALF * K * 2;
    const size_t tstep = 2 * hstep;
    const unsigned ldsw = (unsigned)wid * 1024u;
    const int aoff = lds_byte(wr * 64 + fr, fq * 8), boff = lds_byte(wc * 32 + fr, fq * 8);
#define PG8_SA(b, h) (((b) * 2 + (h)) * HTB)
#define PG8_SB(b, h) ((4 + (b) * 2 + (h)) * HTB)
#define PG8_STAGE(bufoff, gbase, voff) do { _Pragma("unroll") for (int _i = 0; _i < 2; ++_i) \
        __builtin_amdgcn_global_load_lds((const unsigned*)((const char*)(gbase) + (voff)[_i]), (PG8_LAS unsigned*)(lds + (bufoff) + ldsw + _i * 8192), 16, 0, 0); } while (0)
#define PG8_LDA(dst, b, h) do { _Pragma("unroll") for (int m = 0; m < 4; ++m) _Pragma("unroll") for (int k = 0; k < 2; ++k) dst[m][k] = *(const PG8_LAS bf16x8*)(lds + PG8_SA(b, h) + aoff + m * 2048 + k * 1024); } while (0)
#define PG8_LDB(dst, b, h) do { _Pragma("unroll") for (int n = 0; n < 2; ++n) _Pragma("unroll") for (int k = 0; k < 2; ++k) dst[n][k] = *(const PG8_LAS bf16x8*)(lds + PG8_SB(b, h) + boff + n * 2048 + k * 1024); } while (0)
#define PG8_MMA(ai, bj, At, Bt) do { __builtin_amdgcn_s_setprio(1); _Pragma("unroll") for (int m = 0; m < 4; ++m) _Pragma("unroll") for (int n = 0; n < 2; ++n) _Pragma("unroll") for (int k = 0; k < 2; ++k) \
        acc[ai][bj][m][n] = __builtin_amdgcn_mfma_f32_16x16x32_bf16(Bt[n][k], At[m][k], acc[ai][bj][m][n], 0, 0, 0); __builtin_amdgcn_s_setprio(0); } while (0)
#define PG8_WAIT_V(n) asm volatile("s_waitcnt vmcnt(" #n ")" ::: "memory")
#define PG8_WAIT_L(n) asm volatile("s_waitcnt lgkmcnt(" #n ")" ::: "memory")
#define PG8_BAR __builtin_amdgcn_s_barrier()
#define PG8_SCHED __builtin_amdgcn_sched_barrier(0)
    Unit cur, nxt; int ui = 0;
    if (!S.next(0, cur)) return;
    f32x4 acc[2][2][4][2];
#pragma unroll
    for (int a = 0; a < 2; ++a)
#pragma unroll
        for (int b = 0; b < 2; ++b)
#pragma unroll
            for (int m = 0; m < 4; ++m)
#pragma unroll
                for (int n = 0; n < 2; ++n) acc[a][b][m][n] = (f32x4){0.f, 0.f, 0.f, 0.f};
    bf16x8 At[4][2], B0[2][2], B1[2][2];
    const char* cA = (const char*)g.A + (size_t)cur.pm * tstep; const char* cB = (const char*)g.Bt + (size_t)cur.pn * tstep;
    S.a_ready(cur);
    if constexpr (SP2) {
        PG8_STAGE(PG8_SB(0, 0), cB, voffB); PG8_STAGE(PG8_SB(0, 1), cB + hstep, voffB); PG8_STAGE(PG8_SA(0, 0), cA, voffA); PG8_STAGE(PG8_SA(0, 1), cA + hstep, voffA);
        if (wr == 1) PG8_BAR;
        PG8_WAIT_V(2); PG8_BAR;
        PG8_STAGE(PG8_SB(1, 0), cB + kstep, voffB); PG8_STAGE(PG8_SA(1, 0), cA + kstep, voffA); PG8_STAGE(PG8_SB(1, 1), cB + hstep + kstep, voffB);
        PG8_WAIT_V(6); PG8_BAR;
    } else {
        PG8_STAGE(PG8_SB(0, 0), cB, voffB); PG8_STAGE(PG8_SA(0, 0), cA, voffA); PG8_STAGE(PG8_SB(0, 1), cB + hstep, voffB); PG8_STAGE(PG8_SA(0, 1), cA + hstep, voffA);
        if (wr == 1) PG8_BAR;
        PG8_WAIT_V(4); PG8_BAR;
        PG8_STAGE(PG8_SB(1, 0), cB + kstep, voffB); PG8_STAGE(PG8_SA(1, 0), cA + kstep, voffA); PG8_STAGE(PG8_SB(1, 1), cB + hstep + kstep, voffB);
        PG8_WAIT_V(6); PG8_BAR;
    }
    for (;;) {
        const bool has_next = S.next(ui + 1, nxt);
        const char* nA = has_next ? (const char*)g.A + (size_t)nxt.pm * tstep : cA; const char* nB = has_next ? (const char*)g.Bt + (size_t)nxt.pn * tstep : cB;
        for (int t = 0; t < nt; t += 2) {
            const bool last = (t == nt - 2);
            const char* a1 = cA + (size_t)(t + 1) * kstep;
            const char* a2 = last ? nA : cA + (size_t)(t + 2) * kstep; const char* b2 = last ? nB : cB + (size_t)(t + 2) * kstep;
            const char* a3 = a2 + kstep; const char* b3 = b2 + kstep;
            if (last && has_next) S.a_ready(nxt);
            if constexpr (SP2) {
            PG8_LDB(B0, 0, 0); PG8_LDB(B1, 0, 1); PG8_SCHED; PG8_LDA(At, 0, 0); PG8_STAGE(PG8_SA(1, 1), a1 + hstep, voffA);
            PG8_WAIT_V(8); PG8_WAIT_L(0); PG8_BAR; PG8_MMA(0, 0, At, B0); PG8_MMA(0, 1, At, B1); PG8_BAR; PG8_SCHED;
            PG8_LDA(At, 0, 1); PG8_STAGE(PG8_SB(0, 0), b2, voffB); PG8_STAGE(PG8_SB(0, 1), b2 + hstep, voffB); PG8_STAGE(PG8_SA(0, 0), a2, voffA);
            PG8_WAIT_V(8); PG8_WAIT_L(0); PG8_BAR; PG8_MMA(1, 0, At, B0); PG8_MMA(1, 1, At, B1); PG8_BAR; PG8_SCHED;
            PG8_LDB(B0, 1, 0); PG8_LDB(B1, 1, 1); PG8_SCHED; PG8_LDA(At, 1, 0); PG8_STAGE(PG8_SA(0, 1), a2 + hstep, voffA);
            PG8_WAIT_V(8); PG8_WAIT_L(0); PG8_BAR; PG8_MMA(0, 0, At, B0); PG8_MMA(0, 1, At, B1); PG8_BAR; PG8_SCHED;
            PG8_LDA(At, 1, 1); PG8_STAGE(PG8_SB(1, 0), b3, voffB); PG8_STAGE(PG8_SB(1, 1), b3 + hstep, voffB); PG8_STAGE(PG8_SA(1, 0), a3, voffA);
            PG8_WAIT_V(8); PG8_WAIT_L(0); PG8_BAR; PG8_MMA(1, 0, At, B0); PG8_MMA(1, 1, At, B1); PG8_BAR; PG8_SCHED;
            } else {
            PG8_LDB(B0, 0, 0); PG8_SCHED; PG8_LDA(At, 0, 0); PG8_STAGE(PG8_SA(1, 1), a1 + hstep, voffA);
            PG8_WAIT_L(8); PG8_BAR; PG8_WAIT_L(0); PG8_MMA(0, 0, At, B0); PG8_BAR; PG8_SCHED;
            PG8_LDB(B1, 0, 1); PG8_STAGE(PG8_SB(0, 0), b2, voffB);
            PG8_BAR; PG8_WAIT_L(0); PG8_MMA(0, 1, At, B1); PG8_BAR;
            PG8_LDA(At, 0, 1); PG8_STAGE(PG8_SA(0, 0), a2, voffA);
            PG8_BAR; PG8_WAIT_L(0); PG8_MMA(1, 0, At, B0); PG8_BAR; PG8_SCHED;
            PG8_STAGE(PG8_SB(0, 1), b2 + hstep, voffB);
            PG8_WAIT_V(6); PG8_BAR; PG8_MMA(1, 1, At, B1); PG8_BAR;
            PG8_LDB(B0, 1, 0); PG8_SCHED; PG8_LDA(At, 1, 0); PG8_STAGE(PG8_SA(0, 1), a2 + hstep, voffA);
            PG8_WAIT_L(8); PG8_BAR; PG8_WAIT_L(0); PG8_MMA(0, 0, At, B0); PG8_BAR; PG8_SCHED;
            PG8_LDB(B1, 1, 1); PG8_STAGE(PG8_SB(1, 0), b3, voffB);
            PG8_BAR; PG8_WAIT_L(0); PG8_MMA(0, 1, At, B1); PG8_BAR;
            PG8_LDA(At, 1, 1); PG8_STAGE(PG8_SA(1, 0), a3, voffA);
            PG8_BAR; PG8_WAIT_L(0); PG8_MMA(1, 0, At, B0); PG8_BAR; PG8_SCHED;
            PG8_STAGE(PG8_SB(1, 1), b3 + hstep, voffB);
            PG8_WAIT_V(6); PG8_BAR; PG8_MMA(1, 1, At, B1); PG8_BAR;
            }
        }
        if constexpr (ALIGN_EPI) { if (wr == 0) PG8_BAR; }
        if constexpr (!Epi::AFTER_DRAIN) { E(acc, cur, wr, wc, fr, fq); S.done(cur); }
        if (!has_next) break;
#pragma unroll
        for (int a = 0; a < 2; ++a)
#pragma unroll
            for (int b = 0; b < 2; ++b)
#pragma unroll
                for (int m = 0; m < 4; ++m)
#pragma unroll
                    for (int n = 0; n < 2; ++n) acc[a][b][m][n] = (f32x4){0.f, 0.f, 0.f, 0.f};
        cur = nxt; cA = nA; cB = nB; ++ui;
        if constexpr (ALIGN_EPI) { if (wr == 1) PG8_BAR; }
    }
    PG8_WAIT_V(0);
    if constexpr (!ALIGN_EPI) { if (wr == 0) PG8_BAR; }
    PG8_BAR;
    if constexpr (Epi::AFTER_DRAIN) { E.fused(acc, cur, wr, wc, fr, fq, lds, wid, lane); S.done(cur); }
#undef PG8_SA
#undef PG8_SB
#undef PG8_STAGE
#undef PG8_LDA
#undef PG8_LDB
#undef PG8_MMA
#undef PG8_WAIT_V
#undef PG8_WAIT_L
#undef PG8_BAR
#undef PG8_SCHED
}
}
#define XB_TMO      128
#define XB_XCNT(j)  (256  + 64 * (j))
#define XB_XSUB(j)  (1280 + 64 * (j))
#define XB_XGEN(j)  (2304 + 64 * (j))
#define XB_TOP      3328
#define XB_TOPGEN   3392
#define XCD_BAR_WORDS 3456
#define XB_SPIN_CAP (1u << 18)

__device__ __forceinline__ unsigned xb_ld(unsigned* p)              { return __hip_atomic_load(p, __ATOMIC_RELAXED, __HIP_MEMORY_SCOPE_AGENT); }
__device__ __forceinline__ unsigned xb_add(unsigned* p, unsigned v) { return __hip_atomic_fetch_add(p, v, __ATOMIC_RELAXED, __HIP_MEMORY_SCOPE_AGENT); }
__device__ __forceinline__ unsigned xb_xcc_id() { return (unsigned)__builtin_amdgcn_s_getreg((3 << 11) | 20) & 0xFu; }
#define XB_SPIN(cond, bar) do { unsigned _sp = 0; while (cond) { __builtin_amdgcn_s_sleep(1); \
    if ((++_sp & 255u) == 0u) { if (xb_ld(&(bar)[XB_TMO])) break; if (_sp > XB_SPIN_CAP) { atomicAdd(&(bar)[XB_TMO], 1u); break; } } } } while (0)

struct XcdBarrier {
    unsigned* bar; unsigned x;
    volatile LAS unsigned* st;
};

__device__ __forceinline__ XcdBarrier xcd_barrier_post(unsigned* bar, volatile LAS unsigned* st) {
    XcdBarrier b; b.bar = bar; b.x = xb_xcc_id(); b.st = st;
    if (threadIdx.x == 0) (void)xb_add(&bar[XB_XCNT(b.x)], 1u);
    return b;
}
__device__ __forceinline__ void xcd_barrier_complete(unsigned* bar, unsigned x, unsigned& nloc, unsigned& nx) {
    const unsigned G = gridDim.x * gridDim.y * gridDim.z;
    unsigned sum, cnt, mine, sp = 0u;
    for (;;) {
        sum = 0u; cnt = 0u; mine = 0u;
#pragma unroll
        for (unsigned j = 0; j < 16; ++j) { const unsigned c = xb_ld(&bar[XB_XCNT(j)]); sum += c; cnt += (c > 0u) ? 1u : 0u; mine = (j == x) ? c : mine; }
        if (sum == G) break;
        __builtin_amdgcn_s_sleep(1);
        if ((++sp & 255u) == 0u) { if (xb_ld(&bar[XB_TMO])) break; if (sp > XB_SPIN_CAP) { atomicAdd(&bar[XB_TMO], 1u); break; } }
    }
    nloc = mine > 0u ? mine : 1u; nx = cnt > 0u ? cnt : 1u;
}

__device__ __forceinline__ void xcd_barrier(const XcdBarrier& b) {
    asm volatile("s_waitcnt vmcnt(0)" ::: "memory");
    __syncthreads();
    if (threadIdx.x == 0) {
        unsigned* bar = b.bar;
        __builtin_amdgcn_s_waitcnt(0);
        unsigned nloc = b.st[0], nx = b.st[1];
        if (nloc == 0u) { xcd_barrier_complete(bar, b.x, nloc, nx); b.st[0] = nloc; b.st[1] = nx; }
        const unsigned old = xb_add(&bar[XB_XSUB(b.x)], 1u);
        const unsigned gen = old / nloc;
        if (old + 1u == (gen + 1u) * nloc) {
            __builtin_amdgcn_fence(__ATOMIC_RELEASE, "agent");
            asm volatile("s_waitcnt vmcnt(0)" ::: "memory");
            const unsigned og = xb_add(&bar[XB_TOP], 1u);
            const unsigned tg = og / nx;
            if (og + 1u == (tg + 1u) * nx) xb_add(&bar[XB_TOPGEN], 1u);
            else XB_SPIN(xb_ld(&bar[XB_TOPGEN]) == tg, bar);
            __builtin_amdgcn_fence(__ATOMIC_ACQUIRE, "agent");
            xb_add(&bar[XB_XGEN(b.x)], 1u);
            asm volatile("s_waitcnt vmcnt(0)" ::: "memory");
        } else {
            XB_SPIN(xb_ld(&bar[XB_XGEN(b.x)]) == gen, bar);
            __builtin_amdgcn_fence(__ATOMIC_ACQUIRE, "agent");
            asm volatile("s_waitcnt vmcnt(0)" ::: "memory");
        }
    }
    __syncthreads();
}
using pg8::f32x4; using pg8::bf16x8;
constexpr int NWAVES = 8;
constexpr int BATCH = 4, T = 8192, D = 1024, M = BATCH * T, NP = 4096, INW = 3864;
constexpr int DECB = 32, PAST = 16384, NPAGES = 128, NCS = 512  ;
constexpr float NORM_EPS = 1e-6f;
constexpr float LOG2E = 1.4426950408889634f;
constexpr float QSCALE = 0.125f * LOG2E;
constexpr size_t O_Y = 0, O_YS = 33554432, O_PCMP = 33587200, O_PSLC = 41975808, O_PWIN = 50364416, O_PCONV = 50888704,
                 O_SCMP = 50892800, O_SSLC = 50900992, O_SWIN = 50909184, O_SCONV = 55103488, O_END = 55136256;
constexpr int C_BG = 0, C_CG = 512, C_CI = 1024, C_ZC = 1536, C_Q = 2048, C_KV = 2560, C_GL = 3328, C_ZA = 3352;

constexpr size_t MiB = 1u << 20, KiB = 1u << 10;
constexpr size_t WS_CTL = 0, CTL_ZERO_BYTES = 1 * MiB;
constexpr size_t WS_BT1 = 2 * MiB;
constexpr size_t WS_BT2 = 10 * MiB;
constexpr size_t WS_BTC = 12 * MiB;
constexpr size_t WS_CBIAS = 12 * MiB + 512 * KiB;
constexpr size_t WS_CONST = WS_CBIAS + 4 * KiB;
constexpr size_t WS_ROPE = 13 * MiB;
constexpr size_t WS_RSTD = 16 * MiB;
constexpr size_t WS_XSB = 16 * MiB + 256 * KiB;
constexpr size_t WS_RSTDS = WS_XSB + 64 * KiB;
constexpr size_t WS_GATE = 17 * MiB;
constexpr size_t WS_KC = 20 * MiB;
constexpr size_t WS_VCT = WS_KC + 256 * KiB;
constexpr size_t WS_PROJS = 21 * MiB;
constexpr size_t WS_QS = 22 * MiB;
constexpr size_t WS_KVN = WS_QS + 64 * KiB;
constexpr size_t WS_GS = WS_KVN + 96 * KiB;
constexpr size_t WS_ZAS = WS_GS + 4 * KiB;
constexpr size_t WS_MIXS = WS_ZAS + 64 * KiB;
constexpr size_t WS_KCS = 24 * MiB;
constexpr size_t WS_KS = 40 * MiB, WS_VTS = 48 * MiB, WS_KW = 56 * MiB, WS_VTW = 64 * MiB;
constexpr size_t WS_XB = 72 * MiB;
constexpr size_t WS_CG = 136 * MiB, WS_U = 168 * MiB, WS_ZA = 200 * MiB, WS_Q = 232 * MiB;
constexpr size_t WS_MIX = 264 * MiB;
constexpr size_t WS_END = 328 * MiB;
constexpr int CW_TMO = 0, CW_CODE = 1;
constexpr int CW_BAR = 4096;
constexpr int CW_QUEUE = 16384;
constexpr int CW_KCMAX = 20480;

constexpr int RING_OFF = 0, RING_BYTES = 131072;
constexpr int LDSCTL_OFF = RING_BYTES, MISC_OFF = LDSCTL_OFF + 320;
constexpr int LDS_BYTES = 147456;

__device__ __forceinline__ unsigned f2bf(float f) { unsigned u = __builtin_bit_cast(unsigned, f); return (u + 0x7fffu + ((u >> 16) & 1u)) >> 16; }
typedef __bf16 bf16x2_t __attribute__((ext_vector_type(2)));
__device__ __forceinline__ unsigned pk2(float lo, float hi) { return __builtin_bit_cast(unsigned, __builtin_convertvector((f32x2){lo, hi}, bf16x2_t)); }
__device__ __forceinline__ float bf2f(unsigned h) { return __builtin_bit_cast(float, h << 16); }
__device__ __forceinline__ float wave_sum(float v) {
#pragma unroll
    for (int o = 1; o < 64; o <<= 1) v += __shfl_xor(v, o);
    return v;
}
__device__ __forceinline__ float fast_exp2(float x) { return __builtin_amdgcn_exp2f(x); }
__device__ __forceinline__ float sigmoidf(float x) { return __builtin_amdgcn_rcpf(1.0f + fast_exp2(-x * LOG2E)); }
__device__ __forceinline__ int perm16(int kk) { return 8 * ((kk >> 2) & 1) + 4 * (kk >> 3) + (kk & 3); }

struct Ptrs {
    const float *xp, *xs, *cache_cmp, *cache_slc, *st_win, *st_conv; const int* page_table;
    const float *norm_g, *w_in, *conv_w, *conv_b, *q_gain, *k_gain, *cmp_pe, *cmp_w, *w_out;
    float* out; unsigned char* ws;
};
struct Frame {
    LAS unsigned char* lds;
    volatile LAS unsigned* MISC;
    gu32* ctl;
    int tid, lane, wave, G, gw, NGW;
};
__device__ __forceinline__ int bt1_src(int dg, int& nvalid) {
    const int pn = dg >> 3, gi = dg & 7, bj = gi >> 2, wc = gi & 3; nvalid = 32;
    if (pn < 4) return (bj ? C_ZC : C_BG) + 128 * pn + 32 * wc;
    if (pn < 8) return (bj ? C_CI : C_CG) + 128 * (pn - 4) + 32 * wc;
    if (pn < 10) return C_Q + (4 * (pn - 8) + wc) * 64 + 32 * bj;
    if (pn < 13) return C_KV + (pn - 10) * 256 + wc * 64 + 32 * bj;
    if (pn < 15) return C_ZA + 256 * (pn - 13) + 32 * gi;
    nvalid = (gi == 0) ? 24 : 0; return C_GL;
}
__device__ __forceinline__ void p0_transpose_item(const float* W, int ldw, int k0, int src0, int nvalid, const float* ksc, bf16* WT, int ldt, int drow0, LAS float* scr, int lane) {
    const int nn = lane & 31;
#pragma unroll 8
    for (int i = 0; i < 32; ++i) { const int kk = 2 * i + (lane >> 5); float v = 0.f;
        if (nn < nvalid) { v = W[(size_t)(k0 + kk) * ldw + src0 + nn]; if (ksc) v *= ksc[k0 + kk]; }
        scr[kk * 33 + nn] = v; }
    LDS_WAIT(); asm volatile("" ::: "memory");
    const int c = lane & 7;
#pragma unroll
    for (int j = 0; j < 4; ++j) { const int n = (lane >> 3) + 8 * j; const LAS float* s = scr + (8 * c) * 33 + n;
        v4u o; o.x = pk2(s[0 * 33], s[1 * 33]); o.y = pk2(s[2 * 33], s[3 * 33]); o.z = pk2(s[4 * 33], s[5 * 33]); o.w = pk2(s[6 * 33], s[7 * 33]);
        *(GAS v4u*)(WT + (size_t)(drow0 + n) * ldt + k0 + 8 * c) = o; }
    LDS_WAIT(); asm volatile("" ::: "memory");
}
__device__ __forceinline__ void x_row_to_bf16(const float* xrow, bf16* orow, float* rstd_out, int lane) {
    const GAS f32x4* xr = (const GAS f32x4*)xrow + lane;
    f32x4 v[4]; float s = 0.f;
#pragma unroll
    for (int j = 0; j < 4; ++j) { v[j] = xr[64 * j]; s += (v[j].x * v[j].x + v[j].y * v[j].y) + (v[j].z * v[j].z + v[j].w * v[j].w); }
    const float tot = wave_sum(s);
    GAS unsigned long long* o8 = (GAS unsigned long long*)orow + lane;
#pragma unroll
    for (int j = 0; j < 4; ++j) o8[64 * j] = (unsigned long long)pk2(v[j].x, v[j].y) | ((unsigned long long)pk2(v[j].z, v[j].w) << 32);
    if (lane == 0) *rstd_out = 1.0f / sqrtf(tot * (1.0f / D) + NORM_EPS);
}
template <bool SAMPLE>
__device__ __forceinline__ const float* cmp_rowbase(const Ptrs& P, int unit, int rho) {
    const int b = SAMPLE ? unit >> 6 : unit >> 5, c = (SAMPLE ? (unit & 63) : (unit & 31)) * 8 + (rho >> 1), g = rho & 1;
    if (SAMPLE) { const int page = P.page_table[b * NPAGES + (c >> 2)]; return P.cache_cmp + ((size_t)page * 128 + (c & 3) * 32) * 256 + g * 64; }
    return P.out + O_PCMP + ((size_t)b * T + c * 32) * 256 + g * 64;
}
template <bool SAMPLE>
__device__ __forceinline__ void compress_units(const Ptrs& P, Frame& F, LAS float* part  ) {
    constexpr int NUNITS = SAMPLE ? DECB * (NCS / 8) : BATCH * 32;
    const int lane = F.lane, w = F.wave, rho = lane & 15, kq = lane >> 4;
    const GAS v4u* bfr = (const GAS v4u*)(P.ws + WS_BTC) + lane;
    const float* cbias = (const float*)(P.ws + WS_CBIAS);
    int unit = blockIdx.x;
    if (unit >= NUNITS) return;
    f32x4 a_cur[8], a_nxt[8];
    const float* rb = cmp_rowbase<SAMPLE>(P, unit, rho) + 8 * kq;
#define CMP_LOAD(dst, base, r) do { _Pragma("unroll") for (int q_ = 0; q_ < 4; ++q_) { dst[2 * q_] = *(const GAS f32x4*)((base) + (r) * 256 + (q_ >> 1) * 128 + (q_ & 1) * 32); dst[2 * q_ + 1] = *(const GAS f32x4*)((base) + (r) * 256 + (q_ >> 1) * 128 + (q_ & 1) * 32 + 4); } } while (0)
    CMP_LOAD(a_cur, rb, 4 * w);
    for (;;) {
        f32x4 acc[2][4];
#pragma unroll
        for (int j = 0; j < 2; ++j)
#pragma unroll
            for (int e = 0; e < 4; ++e) acc[j][e] = (f32x4){0.f, 0.f, 0.f, 0.f};
        const int nunit = unit + F.G; const bool has_next = nunit < NUNITS;
        const float* rbn = has_next ? cmp_rowbase<SAMPLE>(P, nunit, rho) + 8 * kq : rb;
#pragma unroll
        for (int rr = 0; rr < 4; ++rr) {
            const int r = 4 * w + rr;
            if (rr < 3) CMP_LOAD(a_nxt, rb, r + 1); else CMP_LOAD(a_nxt, rbn, 4 * w);
#pragma unroll
            for (int q_ = 0; q_ < 4; ++q_) { const int j = q_ >> 1, dh = q_ & 1;
                v4u wv; wv.x = pk2(a_cur[2 * q_].x, a_cur[2 * q_].y); wv.y = pk2(a_cur[2 * q_].z, a_cur[2 * q_].w); wv.z = pk2(a_cur[2 * q_ + 1].x, a_cur[2 * q_ + 1].y); wv.w = pk2(a_cur[2 * q_ + 1].z, a_cur[2 * q_ + 1].w);
                const bf16x8 af = __builtin_bit_cast(bf16x8, wv);
#pragma unroll
                for (int et = 0; et < 4; ++et) acc[j][et] = __builtin_amdgcn_mfma_f32_16x16x32_bf16(af, __builtin_bit_cast(bf16x8, bfr[(size_t)((((j * 32 + r) * 2 + dh) * 4 + et) * 64)]), acc[j][et], 0, 0, 0); }
#pragma unroll
            for (int q_ = 0; q_ < 8; ++q_) a_cur[q_] = a_nxt[q_];
        }
#pragma unroll
        for (int j = 0; j < 2; ++j)
#pragma unroll
            for (int et = 0; et < 4; ++et) *(LAS f32x4*)(part + ((w * 8 + j * 4 + et) * 64 + lane) * 4) = acc[j][et];
        __syncthreads();
        { const int j = w >> 2, et = w & 3, e = 16 * et + rho; f32x4 sum = *(const LAS f32x4*)(part + ((0 * 8 + w) * 64 + lane) * 4);
#pragma unroll
          for (int ww = 1; ww < 8; ++ww) sum = sum + *(const LAS f32x4*)(part + ((ww * 8 + w) * 64 + lane) * 4);
          const float bs = cbias[j * 64 + e]; const int b = SAMPLE ? unit >> 6 : unit >> 5, c0 = (SAMPLE ? (unit & 63) : (unit & 31)) * 8;
          float nmax = 0.f;
#pragma unroll
          for (int i = 0; i < 4; ++i) { const int row = 4 * kq + i, c = c0 + (row >> 1), g = row & 1; const float val = sum[i] + bs;
              float q2 = val * val; q2 += __shfl_xor(q2, 1); q2 += __shfl_xor(q2, 2); q2 += __shfl_xor(q2, 4); q2 += __shfl_xor(q2, 8); nmax = fmaxf(nmax, q2);
              if (SAMPLE) ((float*)(P.ws + WS_KCS))[((size_t)((b * 2 + g) * 2 + j) * NCS + c) * 64 + e] = val;
              else if (j == 0) ((bf16*)(P.ws + WS_KC))[((size_t)(b * 2 + g) * 256 + c) * 64 + e] = (bf16)f2bf(val);
              else ((bf16*)(P.ws + WS_VCT))[((size_t)(b * 2 + g) * 64 + e) * 256 + (c & ~15) + perm16(c & 15)] = (bf16)f2bf(val); }
          if (j == 0) { nmax = fmaxf(nmax, __shfl_xor(nmax, 16)); nmax = fmaxf(nmax, __shfl_xor(nmax, 32));
              if (lane == 0) atomicMax((unsigned*)(P.ws + WS_CTL) + CW_KCMAX + (SAMPLE ? 64 : 0) + et, __builtin_bit_cast(unsigned, nmax)); } }
        __syncthreads();
        if (!has_next) break;
        unit = nunit; rb = rbn;
    }
#undef CMP_LOAD
}
__device__ __forceinline__ void p0a_small(const Ptrs& P, Frame& F) {
    const int lane = F.lane, gw = F.gw, NGW = F.NGW;
    for (int it = gw * 64 + lane; it < 2 * 32 * 2 * 4 * 64; it += NGW * 64) { const int l = it & 63, et = (it >> 6) & 3, dh = (it >> 8) & 1, r = (it >> 9) & 31, j = it >> 14;
        const float* w = P.cmp_w + ((size_t)(r * 2 + j) * 64 + 32 * dh + 8 * (l >> 4)) * 64 + 16 * et + (l & 15);
        v4u o; o.x = pk2(w[0], w[64]); o.y = pk2(w[128], w[192]); o.z = pk2(w[256], w[320]); o.w = pk2(w[384], w[448]);
        ((GAS v4u*)(P.ws + WS_BTC))[it] = o; }
    for (int it = gw; it < 128; it += NGW) { const int j = it >> 6, e = it & 63; float s = 0.f;
        for (int k = lane; k < 2048; k += 64) { const int r = k >> 6, d = k & 63; s += P.cmp_pe[(r * 2 + j) * 64 + d] * P.cmp_w[((size_t)(r * 2 + j) * 64 + d) * 64 + e]; }
        s = wave_sum(s); if (lane == 0) ((float*)(P.ws + WS_CBIAS))[it] = s; }
    if (gw == NGW - 1) { float qm = fabsf(P.q_gain[lane]), k1 = fabsf(P.k_gain[64 + lane]), k2 = fabsf(P.k_gain[128 + lane]);
#pragma unroll
        for (int o = 1; o < 64; o <<= 1) { qm = fmaxf(qm, __shfl_xor(qm, o)); k1 = fmaxf(k1, __shfl_xor(k1, o)); k2 = fmaxf(k2, __shfl_xor(k2, o)); }
        if (lane == 0) { float* cst = (float*)(P.ws + WS_CONST); cst[0] = qm; cst[1] = 8.0f * qm * k1 * LOG2E * 1.001f; cst[2] = 8.0f * qm * k2 * LOG2E * 1.001f; } }
    for (int it = gw * 64 + lane; it < 8193 * 32; it += NGW * 64) { const int p = it >> 5, i = it & 31; const int pos = (p == 8192) ? PAST : p;
        const float inv = (float)pow(10000.0, -(double)i / 32.0); const float ang = (float)pos * inv;
        float* rt = (float*)(P.ws + WS_ROPE) + (size_t)p * 64; rt[i] = (float)cos((double)ang); rt[32 + i] = (float)sin((double)ang); }
}
__device__ __forceinline__ void p0b_big(const Ptrs& P, Frame& F) {
    LAS float* scr = (LAS float*)(F.lds + RING_OFF + F.wave * 16384);
    const int lane = F.lane;
    compress_units<true>(P, F, (LAS float*)(F.lds + RING_OFF));
    __syncthreads();
    const int gw = F.gw, NGW = F.NGW;
    for (int it = gw; it < 16 * 128; it += NGW) { const int kb = it >> 7, dg = it & 127; int nv; const int src0 = bt1_src(dg, nv);
        p0_transpose_item(P.w_in, INW, 64 * kb, src0, nv, P.norm_g, (bf16*)(P.ws + WS_BT1), D, 32 * dg, scr, lane); }
    for (int it = gw; it < 16 * 32; it += NGW) { const int kb = it >> 5, nb = it & 31;
        p0_transpose_item(P.w_out, D, 64 * kb, 32 * nb, 32, nullptr, (bf16*)(P.ws + WS_BT2), D, 32 * nb, scr, lane); }
    for (int m = gw; m < M; m += NGW) x_row_to_bf16(P.xp + (size_t)m * D, (bf16*)(P.ws + WS_XB) + (size_t)m * D, (float*)(P.ws + WS_RSTD) + m, lane);
    for (int m = gw; m < DECB; m += NGW) x_row_to_bf16(P.xs + (size_t)m * D, (bf16*)(P.ws + WS_XSB) + (size_t)m * D, (float*)(P.ws + WS_RSTDS) + m, lane);
    for (int it = gw; it < DECB * 511; it += NGW) { const int b = it / 511, i = it - b * 511;
        const GAS f32x4* s = (const GAS f32x4*)(P.st_win + ((size_t)b * 512 + i + 1) * 256) + lane; *((GAS f32x4*)(P.out + O_SWIN + ((size_t)b * 512 + i) * 256) + lane) = *s; }
    for (int it = gw * 64 + lane; it < DECB * 512; it += NGW * 64) { const int b = it >> 9, ch = it & 511; P.out[O_SCONV + (size_t)b * 1024 + ch] = P.st_conv[(size_t)b * 1024 + 512 + ch]; }
}
struct EpiIn {
    static constexpr bool PERM = false, AFTER_DRAIN = false;
    const float *rstd, *rope, *qg, *kg; float* out; unsigned char* ws;
    __device__ __forceinline__ void operator()(const f32x4 (&acc)[2][2][4][2], const pg8::Unit& u, int wr, int wc, int fr, int fq) const {
        const int pn = u.pn; const int rbase = u.pm * 256 + wr * 64 + fr;
        if (pn < 8) {
            const bool bz = pn < 4; bf16* dst = (bf16*)(ws + (bz ? WS_CG : WS_U)); const int col0 = 128 * (pn & 3) + 32 * wc + 4 * fq;
#pragma unroll
            for (int ai = 0; ai < 2; ++ai)
#pragma unroll
                for (int m = 0; m < 4; ++m) { const int row = rbase + ai * 128 + m * 16; const float rs = rstd[row];
#pragma unroll
                    for (int n = 0; n < 2; ++n) { const f32x4 a = acc[ai][0][m][n] * rs, z = acc[ai][1][m][n] * rs; f32x4 o;
                        if (bz) { o.x = a.x * z.x * sigmoidf(z.x); o.y = a.y * z.y * sigmoidf(z.y); o.z = a.z * z.z * sigmoidf(z.z); o.w = a.w * z.w * sigmoidf(z.w); }
                        else o = a * z;
                        v2u w; w.x = pk2(o.x, o.y); w.y = pk2(o.z, o.w);
                        *(GAS v2u*)(dst + (size_t)row * 512 + col0 + 16 * n) = w;
                        if (!bz) { const int t = row & (T - 1); if (t >= T - 2) *(GAS f32x4*)(out + O_PCONV + ((size_t)(row >> 13) * 2 + (t - (T - 2))) * 512 + col0 + 16 * n) = o; } } }
        } else if (pn < 13) {
            const bool isq = pn < 10; const int br = pn - 10; const bool isk = !isq && wc < 2;
            if (isq || isk) {
                const float* gain = isq ? qg : kg + br * 64; float g1[2][4], g2[2][4];
#pragma unroll
                for (int n = 0; n < 2; ++n)
#pragma unroll
                    for (int e = 0; e < 4; ++e) { g1[n][e] = gain[16 * n + 4 * fq + e]; g2[n][e] = gain[32 + 16 * n + 4 * fq + e]; }
#pragma unroll
                for (int ai = 0; ai < 2; ++ai)
#pragma unroll
                    for (int m = 0; m < 4; ++m) { const int row = rbase + ai * 128 + m * 16; const float rs = rstd[row]; const int t = row & (T - 1), b = row >> 13;
                        f32x4 x1[2], x2[2]; float ss = 0.f;
#pragma unroll
                        for (int n = 0; n < 2; ++n) { x1[n] = acc[ai][0][m][n] * rs; x2[n] = acc[ai][1][m][n] * rs;
                            ss += (x1[n].x * x1[n].x + x1[n].y * x1[n].y) + (x1[n].z * x1[n].z + x1[n].w * x1[n].w) + (x2[n].x * x2[n].x + x2[n].y * x2[n].y) + (x2[n].z * x2[n].z + x2[n].w * x2[n].w); }
                        ss += __shfl_xor(ss, 16); ss += __shfl_xor(ss, 32);
                        const float inv = 1.0f / sqrtf(ss * (1.0f / 64.0f) + NORM_EPS);
                        const float* rp = rope + (size_t)t * 64 + 4 * fq;
#pragma unroll
                        for (int n = 0; n < 2; ++n) { const f32x4 cs = *(const GAS f32x4*)(rp + 16 * n), sn = *(const GAS f32x4*)(rp + 32 + 16 * n); f32x4 o1, o2;
#pragma unroll
                            for (int e = 0; e < 4; ++e) { const float a = x1[n][e] * inv * g1[n][e], c = x2[n][e] * inv * g2[n][e]; o1[e] = a * cs[e] - c * sn[e]; o2[e] = c * cs[e] + a * sn[e]; }
                            const int d1 = 16 * n + 4 * fq;
                            if (isq) { o1 = o1 * QSCALE; o2 = o2 * QSCALE; bf16* q = (bf16*)(ws + WS_Q) + (size_t)row * 512 + (4 * (pn - 8) + wc) * 64 + d1;
                                v2u w; w.x = pk2(o1.x, o1.y); w.y = pk2(o1.z, o1.w); *(GAS v2u*)q = w; w.x = pk2(o2.x, o2.y); w.y = pk2(o2.z, o2.w); *(GAS v2u*)(q + 32) = w; }
                            else { const int g = wc;
                                if (br > 0) { bf16* k = (bf16*)(ws + (br == 1 ? WS_KS : WS_KW)) + ((size_t)(b * 2 + g) * T + t) * 64 + d1;
                                    v2u w; w.x = pk2(o1.x, o1.y); w.y = pk2(o1.z, o1.w); *(GAS v2u*)k = w; w.x = pk2(o2.x, o2.y); w.y = pk2(o2.z, o2.w); *(GAS v2u*)(k + 32) = w; }
                                if (br < 2) { float* o = out + (br == 0 ? O_PCMP : O_PSLC) + (size_t)row * 256 + g * 64 + d1; *(GAS f32x4*)o = o1; *(GAS f32x4*)(o + 32) = o2; }
                                else if (t >= T - 512) { float* o = out + O_PWIN + ((size_t)b * 512 + (t - (T - 512))) * 256 + g * 64 + d1; *(GAS f32x4*)o = o1; *(GAS f32x4*)(o + 32) = o2; } } } }
            } else {
                const int g = wc - 2;
#pragma unroll
                for (int ai = 0; ai < 2; ++ai)
#pragma unroll
                    for (int m = 0; m < 4; ++m) { const int row = rbase + ai * 128 + m * 16; const float rs = rstd[row]; const int t = row & (T - 1), b = row >> 13;
                        const int tk = t & 63, vpos = (tk & ~15) + perm16(tk & 15);
                        bf16* vt = (br > 0) ? (bf16*)(ws + (br == 1 ? WS_VTS : WS_VTW)) + ((size_t)((b * 2 + g) * 128 + (t >> 6)) * 64) * 64 + vpos : nullptr;
#pragma unroll
                        for (int bj = 0; bj < 2; ++bj)
#pragma unroll
                            for (int n = 0; n < 2; ++n) { const f32x4 v = acc[ai][bj][m][n] * rs; const int d1 = 32 * bj + 16 * n + 4 * fq;
                                if (br > 0) {
#pragma unroll
                                    for (int e = 0; e < 4; ++e) vt[(size_t)(d1 + e) * 64] = (bf16)f2bf(v[e]); }
                                if (br < 2) *(GAS f32x4*)(out + (br == 0 ? O_PCMP : O_PSLC) + (size_t)row * 256 + 128 + g * 64 + d1) = v;
                                else if (t >= T - 512) *(GAS f32x4*)(out + O_PWIN + ((size_t)b * 512 + (t - (T - 512))) * 256 + 128 + g * 64 + d1) = v; } }
            }
        } else if (pn < 15) {
            bf16* dst = (bf16*)(ws + WS_ZA);
#pragma unroll
            for (int ai = 0; ai < 2; ++ai)
#pragma unroll
                for (int m = 0; m < 4; ++m) { const int row = rbase + ai * 128 + m * 16; const float rs = rstd[row];
#pragma unroll
                    for (int bj = 0; bj < 2; ++bj)
#pragma unroll
                        for (int n = 0; n < 2; ++n) { const f32x4 z = acc[ai][bj][m][n] * rs; v2u w; w.x = pk2(z.x * sigmoidf(z.x), z.y * sigmoidf(z.y)); w.y = pk2(z.z * sigmoidf(z.z), z.w * sigmoidf(z.w));
                            *(GAS v2u*)(dst + (size_t)row * 512 + 256 * (pn - 13) + 128 * bj + 32 * wc + 16 * n + 4 * fq) = w; } }
        } else {
            if (wc == 0) { float* dst = (float*)(ws + WS_GATE);
#pragma unroll
                for (int ai = 0; ai < 2; ++ai)
#pragma unroll
                    for (int m = 0; m < 4; ++m) { const int row = rbase + ai * 128 + m * 16; const float rs = rstd[row];
#pragma unroll
                        for (int n = 0; n < 2; ++n) { const int c0 = 16 * n + 4 * fq; if (c0 < 24) { const f32x4 z = acc[ai][0][m][n] * rs;
                            *(GAS f32x4*)(dst + (size_t)row * 24 + c0) = (f32x4){sigmoidf(z.x), sigmoidf(z.y), sigmoidf(z.z), sigmoidf(z.w)}; } } } }
        }
    }
};
struct EpiOut {
    static constexpr bool PERM = false, AFTER_DRAIN = false;
    const float* x; float* y;
    __device__ __forceinline__ void operator()(const f32x4 (&acc)[2][2][4][2], const pg8::Unit& u, int wr, int wc, int fr, int fq) const {
#pragma unroll
        for (int ai = 0; ai < 2; ++ai)
#pragma unroll
            for (int m = 0; m < 4; ++m) { const size_t row = (size_t)u.pm * 256 + ai * 128 + wr * 64 + m * 16 + fr;
#pragma unroll
                for (int bj = 0; bj < 2; ++bj)
#pragma unroll
                    for (int n = 0; n < 2; ++n) { const size_t off = row * D + u.pn * 256 + 128 * bj + 32 * wc + 16 * n + 4 * fq;
                        *(GAS f32x4*)(y + off) = *(const GAS f32x4*)(x + off) + acc[ai][bj][m][n]; } }
    }
};
template <int MODE>
__device__ __forceinline__ void small_gemm_tile(const Ptrs& P, const bf16* A, const bf16* Bt, int ct, int lane) {
    const int rho = lane & 15, kq = lane >> 4;
    f32x4 acc[2] = {(f32x4){0.f, 0.f, 0.f, 0.f}, (f32x4){0.f, 0.f, 0.f, 0.f}};
    const GAS v4u* a0 = (const GAS v4u*)(A + (size_t)rho * D + 8 * kq); const GAS v4u* a1 = (const GAS v4u*)(A + (size_t)(16 + rho) * D + 8 * kq);
    const GAS v4u* bp = (const GAS v4u*)(Bt + (size_t)(16 * ct + rho) * D + 8 * kq);
#pragma unroll 8
    for (int ks = 0; ks < 32; ++ks) { const bf16x8 bb = __builtin_bit_cast(bf16x8, bp[ks * 4]);
        acc[0] = __builtin_amdgcn_mfma_f32_16x16x32_bf16(bb, __builtin_bit_cast(bf16x8, a0[ks * 4]), acc[0], 0, 0, 0);
        acc[1] = __builtin_amdgcn_mfma_f32_16x16x32_bf16(bb, __builtin_bit_cast(bf16x8, a1[ks * 4]), acc[1], 0, 0, 0); }
#pragma unroll
    for (int rt = 0; rt < 2; ++rt) { const int b = 16 * rt + rho; const int col = 16 * ct + 4 * kq;
        if (MODE == 0) { const float rs = ((const float*)(P.ws + WS_RSTDS))[b]; *(GAS f32x4*)((float*)(P.ws + WS_PROJS) + (size_t)b * NP + col) = acc[rt] * rs; }
        else *(GAS f32x4*)(P.out + O_YS + (size_t)b * D + col) = *(const GAS f32x4*)(P.xs + (size_t)b * D + col) + acc[rt]; }
}
__device__ __forceinline__ int projs_col(int pn, int wc, int d) { return 256 * pn + 128 * (d >> 5) + 32 * wc + (d & 31); }
__device__ __forceinline__ void p2_sample_item(const Ptrs& P, int it, int lane) {
    const int b = it / 37, ty = it - b * 37;
    const float* pr = (const float*)(P.ws + WS_PROJS) + (size_t)b * NP;
    const float* ropes = (const float*)(P.ws + WS_ROPE) + (size_t)8192 * 64;
    float* kvn = (float*)(P.ws + WS_KVN) + (size_t)b * 768;
    if (ty < 14) {
        const bool isq = ty < 8; const int br = isq ? 0 : (ty - 8) >> 1, g = (ty - 8) & 1;
        const int pn = isq ? 8 + (ty >> 2) : 10 + br, wc = isq ? (ty & 3) : g;
        const float v = pr[projs_col(pn, wc, lane)];
        const float ss = wave_sum(v * v); const float inv = 1.0f / sqrtf(ss * (1.0f / 64.0f) + NORM_EPS);
        const float gn = isq ? P.q_gain[lane] : P.k_gain[br * 64 + lane];
        const float xn = v * inv * gn; const float xo = __shfl_xor(xn, 32);
        const int i = lane & 31; const float cs = ropes[i], sn = ropes[32 + i];
        const float o = (lane < 32) ? xn * cs - xo * sn : xn * cs + xo * sn;
        if (isq) ((float*)(P.ws + WS_QS))[(size_t)b * 512 + ty * 64 + lane] = o * QSCALE;
        else { kvn[(br * 2 + 0) * 128 + g * 64 + lane] = o;
            if (br == 0) P.out[O_SCMP + (size_t)b * 256 + g * 64 + lane] = o; else if (br == 1) P.out[O_SSLC + (size_t)b * 256 + g * 64 + lane] = o;
            else P.out[O_SWIN + ((size_t)b * 512 + 511) * 256 + g * 64 + lane] = o; }
    } else if (ty < 20) {
        const int br = (ty - 14) >> 1, g = (ty - 14) & 1; const float v = pr[projs_col(10 + br, 2 + g, lane)];
        kvn[(br * 2 + 1) * 128 + g * 64 + lane] = v;
        if (br == 0) P.out[O_SCMP + (size_t)b * 256 + 128 + g * 64 + lane] = v; else if (br == 1) P.out[O_SSLC + (size_t)b * 256 + 128 + g * 64 + lane] = v;
        else P.out[O_SWIN + ((size_t)b * 512 + 511) * 256 + 128 + g * 64 + lane] = v;
    } else if (ty == 20) {
        if (lane < 24) ((float*)(P.ws + WS_GS))[b * 24 + lane] = sigmoidf(pr[256 * 15 + lane]);
    } else if (ty < 29) {
        const int ch = (ty - 21) * 64 + lane; const int pnb = ch >> 7, tc = ch & 127;
        const float bg = pr[256 * pnb + tc], zc = pr[256 * pnb + 128 + tc], cg = pr[256 * (4 + pnb) + tc], ci = pr[256 * (4 + pnb) + 128 + tc];
        const float u = cg * ci; const float s0 = P.st_conv[(size_t)b * 1024 + ch], s1 = P.st_conv[(size_t)b * 1024 + 512 + ch];
        const float cy = P.conv_w[ch] * s0 + P.conv_w[512 + ch] * s1 + P.conv_w[1024 + ch] * u + P.conv_b[ch];
        ((bf16*)(P.ws + WS_MIXS))[(size_t)b * 1024 + ch] = (bf16)f2bf(bg * cy * zc * sigmoidf(zc));
        P.out[O_SCONV + (size_t)b * 1024 + 512 + ch] = u;
    } else {
        const int col = (ty - 29) * 64 + lane; const float z = pr[256 * (13 + (col >> 8)) + (col & 255)];
        ((float*)(P.ws + WS_ZAS))[(size_t)b * 512 + col] = z * sigmoidf(z);
    }
}
__device__ __forceinline__ void p2_phase(const Ptrs& P, Frame& F) {
    compress_units<false>(P, F, (LAS float*)(F.lds + RING_OFF));
    for (int it = F.gw; it < DECB * 37; it += F.NGW) p2_sample_item(P, it, F.lane);
}
#define MFMA32(a, b, c) __builtin_amdgcn_mfma_f32_32x32x16_bf16(a, b, c, 0, 0, 0)
constexpr int P3_RING = 65536;
constexpr int P3_MISC = 114688;
constexpr int SM_Q = 36864, SM_P = 40960, SM_RED = 57344, SM_IMP = 66048, SM_L = 67200, SM_SEL = 67328, SM_O = 67584;

template <int MODE>
__device__ __forceinline__ void attend_lds(const LAS unsigned char* blk, const bf16x8 (&qf)[4], f32x16 (&O)[2], float& lsum, float shift,
                                           int kbase, int lo, int hi, int lane, bool want_pv, f32x16 (*Sout)[2] = nullptr) {
    const int r = lane & 31, hh = lane >> 5, swz = (r >> 1) & 7;
    const LAS unsigned char* kb = blk + r * 128; const LAS unsigned char* vb = blk + 8192 + r * 128;
    f32x16 S[2];
#pragma unroll
    for (int kt = 0; kt < 2; ++kt) {
        bf16x8 kf[4];
#pragma unroll
        for (int s = 0; s < 4; ++s) kf[s] = *(const LAS bf16x8*)(kb + kt * 4096 + (((2 * s + hh) ^ swz) << 4));
        f32x16 acc;
#pragma unroll
        for (int i = 0; i < 16; ++i) acc[i] = 0.f;
#pragma unroll
        for (int s = 0; s < 4; ++s) acc = MFMA32(kf[s], qf[s], acc);
        S[kt] = acc;
    }
    bf16x8 pf[4];
#pragma unroll
    for (int kt = 0; kt < 2; ++kt) {
#pragma unroll
        for (int i = 0; i < 16; ++i) { float p = fast_exp2(S[kt][i] - shift);
            if (MODE == 1) p = (lo == 0) ? p : 0.f;
            if (MODE == 2) { const int kp = kbase + 32 * kt + (i & 3) + 8 * (i >> 2) + 4 * hh; p = (kp >= lo && kp <= hi) ? p : 0.f; }
            S[kt][i] = p; lsum += p; }
#pragma unroll
        for (int sp = 0; sp < 2; ++sp) { v4u w; w.x = pk2(S[kt][8 * sp + 0], S[kt][8 * sp + 1]); w.y = pk2(S[kt][8 * sp + 2], S[kt][8 * sp + 3]);
            w.z = pk2(S[kt][8 * sp + 4], S[kt][8 * sp + 5]); w.w = pk2(S[kt][8 * sp + 6], S[kt][8 * sp + 7]); pf[2 * kt + sp] = __builtin_bit_cast(bf16x8, w); }
    }
    if (Sout) { (*Sout)[0] = S[0]; (*Sout)[1] = S[1]; }
    if (want_pv) {
#pragma unroll
        for (int dt = 0; dt < 2; ++dt) {
            bf16x8 vf[4];
#pragma unroll
            for (int ks = 0; ks < 4; ++ks) vf[ks] = *(const LAS bf16x8*)(vb + dt * 4096 + (((2 * ks + hh) ^ swz) << 4));
#pragma unroll
            for (int ks = 0; ks < 4; ++ks) O[dt] = MFMA32(vf[ks], pf[ks], O[dt]);
        }
    }
}
__device__ __forceinline__ void wave_topk(const LAS float* imp, int jmax, int nsel, int lane, unsigned long long& my0, unsigned long long& my1, unsigned long long& u0, unsigned long long& u1) {
    my0 = 0ull; my1 = 0ull; u0 = 0ull; u1 = 0ull;
    if (jmax < 1) return;
    const int myq = (lane & 31) >> 2;
    for (int qi = 0; qi < 8; ++qi) {
        const bool c0 = lane >= 1 && lane <= jmax, c1 = 64 + lane <= jmax;
        const unsigned k0 = c0 ? __builtin_bit_cast(unsigned, imp[qi * 128 + lane]) + 1u : 0u, k1 = c1 ? __builtin_bit_cast(unsigned, imp[qi * 128 + 64 + lane]) + 1u : 0u;
        unsigned long long m0, m1;
        if (jmax <= nsel) { m0 = __ballot(c0); m1 = __ballot(c1); }
        else {
            unsigned Tv = 0u;
            for (int bit = 30; bit >= 0; --bit) { const unsigned cand = Tv | (1u << bit);
                const int cnt = __popcll(__ballot(k0 >= cand)) + __popcll(__ballot(k1 >= cand)); if (cnt >= nsel) Tv = cand; }
            const unsigned long long g0 = __ballot(k0 > Tv), g1 = __ballot(k1 > Tv), e0 = __ballot(k0 == Tv), e1 = __ballot(k1 == Tv);
            const int need = nsel - __popcll(g0) - __popcll(g1);
            const unsigned long long below = (lane == 0) ? 0ull : (~0ull >> (64 - lane));
            const int rk0 = __popcll(e0 & below), rk1 = __popcll(e0) + __popcll(e1 & below);
            m0 = g0 | __ballot(k0 == Tv && rk0 < need); m1 = g1 | __ballot(k1 == Tv && rk1 < need);
        }
        if (myq == qi) { my0 = m0; my1 = m1; }
        u0 |= m0; u1 |= m1;
    }
}
struct BlkSrc { const bf16* k; const bf16* v; int vstride; };
__device__ __forceinline__ void p3_prompt_unit(const Ptrs& P, Frame& F, int b, int t, int g, float sh_cmp, float sh_slc, float sh_win) {
    int lane = F.lane, w = F.wave, tid = F.tid; asm volatile("" : "+v"(lane), "+s"(w), "+v"(tid));
    const int col = lane & 31, hh = lane >> 5, qi = col >> 2, h = col & 3;
    const int tok = 64 * t + 8 * w + qi; const size_t row = (size_t)b * T + tok; const int qpos = tok;
    const int nck = (2 * t + 2 + 63) >> 6, nf = t >= 2 ? 3 : t + 1, ns = t >= 2 ? t - 2 : 0, nw = t >= 8 ? 9 : t + 1;
    const int n1 = nck, n2 = 2 * nck, n3 = n2 + nf, n4 = n3 + ns, N = n4 + nw;
    const bf16* KC = (const bf16*)(P.ws + WS_KC) + (size_t)(b * 2 + g) * 256 * 64; const bf16* VCT = (const bf16*)(P.ws + WS_VCT) + (size_t)(b * 2 + g) * 64 * 256;
    const bf16* KS = (const bf16*)(P.ws + WS_KS) + (size_t)(b * 2 + g) * T * 64; const bf16* VTS = (const bf16*)(P.ws + WS_VTS) + (size_t)(b * 2 + g) * 128 * 4096;
    const bf16* KW = (const bf16*)(P.ws + WS_KW) + (size_t)(b * 2 + g) * T * 64; const bf16* VTW = (const bf16*)(P.ws + WS_VTW) + (size_t)(b * 2 + g) * 128 * 4096;
    auto src = [&](int n) -> BlkSrc {
        if (n < n2) { const int ck = n < n1 ? n : n - n1; return BlkSrc{KC + (size_t)ck * 4096, VCT + ck * 64, 256}; }
        if (n < n3) { const int f = n - n2; const int j = f == 0 ? t : (f == 1 ? 0 : t - 1); return BlkSrc{KS + (size_t)j * 4096, VTS + (size_t)j * 4096, 64}; }
        if (n < n4) { const int j = 1 + (n - n3); return BlkSrc{KS + (size_t)j * 4096, VTS + (size_t)j * 4096, 64}; }
        const int j = (t >= 8 ? t - 8 : 0) + (n - n4); return BlkSrc{KW + (size_t)j * 4096, VTW + (size_t)j * 4096, 64}; };
    const int srow = tid >> 3, sch = tid & 7; const int sdst = srow * 128 + ((sch ^ ((srow >> 1) & 7)) << 4);
    LAS unsigned char* ring = F.lds + P3_RING;
    v4u stk, stv;
#define ST_ISSUE(n) do { const BlkSrc bs_ = src(n); stk = *(const GAS v4u*)(bs_.k + tid * 8); stv = *(const GAS v4u*)(bs_.v + (size_t)srow * bs_.vstride + sch * 8); } while (0)
#define ST_COMMIT(n) do { LAS unsigned char* d_ = ring + ((n) % 3) * 16384 + sdst; *(LAS v4u*)d_ = stk; *(LAS v4u*)(d_ + 8192) = stv; } while (0)
#define BLK(n) (ring + ((n) % 3) * 16384)
#define STEP_BEGIN(n) do { if ((n) + 2 < N) ST_ISSUE((n) + 2); } while (0)
#define STEP_END(n) do { if ((n) + 2 < N) ST_COMMIT((n) + 2); __syncthreads(); } while (0)
    __syncthreads();
    ST_ISSUE(0); ST_COMMIT(0); if (N > 1) { ST_ISSUE(1); ST_COMMIT(1); }
    bf16x8 qf[4];
    { const bf16* q = (const bf16*)(P.ws + WS_Q) + row * 512 + (g * 4 + h) * 64 + 8 * hh;
#pragma unroll
      for (int s = 0; s < 4; ++s) qf[s] = __builtin_bit_cast(bf16x8, *(const GAS v4u*)(q + 16 * s)); }
    const float* gate = (const float*)(P.ws + WS_GATE) + row * 24 + (g * 4 + h) * 3;
    const float g_cmp = gate[0], g_slc = gate[1], g_win = gate[2];
    __syncthreads();
    f32x16 O[2];
    LAS float* wl = (LAS float*)(F.lds + w * 8192);
    LAS float* totl = wl + lane;
    int n = 0;
    const int nvis = (qpos + 1) >> 5;
    float lsum = 0.f;
    for (; n < n1; ++n) { STEP_BEGIN(n); attend_lds<2>(BLK(n), qf, O, lsum, sh_cmp, 64 * n, 0, nvis - 1, lane, false); STEP_END(n); }
    lsum += __shfl_xor(lsum, 32);
    const float shn = lsum > 0.f ? sh_cmp + __builtin_amdgcn_logf(lsum) : sh_cmp;
    for (int i = lane; i < 1024; i += 64) wl[i] = 0.f;
#pragma unroll
    for (int i = 0; i < 16; ++i) { O[0][i] = 0.f; O[1][i] = 0.f; }
    { float dummy = 0.f;
      for (; n < n2; ++n) { STEP_BEGIN(n); const int ck = n - n1; f32x16 Sn[2];
        attend_lds<2>(BLK(n), qf, O, dummy, shn, 64 * ck, 0, nvis - 1, lane, true, &Sn);
#pragma unroll
        for (int kt = 0; kt < 2; ++kt)
#pragma unroll
            for (int i2 = 0; i2 < 8; ++i2) { float v = Sn[kt][2 * i2] + Sn[kt][2 * i2 + 1]; v += __shfl_xor(v, 1); v += __shfl_xor(v, 2);
                if (h == 0) wl[qi * 128 + 32 * ck + 16 * kt + (i2 & 1) + 4 * (i2 >> 1) + 2 * hh] = v; }
        STEP_END(n); } }
    LDS_WAIT(); asm volatile("" ::: "memory");
    unsigned long long my0, my1, u0, u1;
    wave_topk(wl, t - 2, 13, lane, my0, my1, u0, u1);
    LDS_WAIT(); asm volatile("" ::: "memory");
#pragma unroll
    for (int i = 0; i < 16; ++i) { totl[i * 64] = O[0][i] * g_cmp; totl[(16 + i) * 64] = O[1][i] * g_cmp; O[0][i] = 0.f; O[1][i] = 0.f; }
    lsum = 0.f;
    for (; n < n3; ++n) { STEP_BEGIN(n);
        if (n == n2) attend_lds<2>(BLK(n), qf, O, lsum, sh_slc, 64 * t, 0, qpos, lane, true);
        else attend_lds<0>(BLK(n), qf, O, lsum, sh_slc, 0, 0, 0, lane, true);
        STEP_END(n); }
    for (; n < n4; ++n) { STEP_BEGIN(n); const int j = 1 + (n - n3);
        const bool any = ((j < 64 ? u0 >> j : u1 >> (j - 64)) & 1ull) != 0ull;
        if (any) { const bool on = ((j < 64 ? my0 >> j : my1 >> (j - 64)) & 1ull) != 0ull; attend_lds<1>(BLK(n), qf, O, lsum, sh_slc, 0, on ? 0 : 1, 0, lane, true); }
        STEP_END(n); }
    lsum += __shfl_xor(lsum, 32);
    { const float sc = g_slc / fmaxf(lsum, 1e-30f);
#pragma unroll
      for (int i = 0; i < 16; ++i) { totl[i * 64] += O[0][i] * sc; totl[(16 + i) * 64] += O[1][i] * sc; O[0][i] = 0.f; O[1][i] = 0.f; } }
    lsum = 0.f;
    for (; n < N; ++n) { STEP_BEGIN(n); const int j = (t >= 8 ? t - 8 : 0) + (n - n4);
        if (j == t || j + 8 == t) attend_lds<2>(BLK(n), qf, O, lsum, sh_win, 64 * j, qpos - 511, qpos, lane, true);
        else attend_lds<0>(BLK(n), qf, O, lsum, sh_win, 0, 0, 0, lane, true);
        STEP_END(n); }
    lsum += __shfl_xor(lsum, 32);
    { const float sc = g_win / fmaxf(lsum, 1e-30f);
#pragma unroll
      for (int i = 0; i < 16; ++i) { O[0][i] = totl[i * 64] + O[0][i] * sc; O[1][i] = totl[(16 + i) * 64] + O[1][i] * sc; } }
#undef ST_ISSUE
#undef ST_COMMIT
#undef BLK
#undef STEP_BEGIN
#undef STEP_END
    const bf16* za = (const bf16*)(P.ws + WS_ZA) + row * 512 + (g * 4 + h) * 64; bf16* mx = (bf16*)(P.ws + WS_MIX) + row * 1024 + 512 + (g * 4 + h) * 64;
#pragma unroll
    for (int dt = 0; dt < 2; ++dt)
#pragma unroll
        for (int i4 = 0; i4 < 4; ++i4) { const int d = 32 * dt + 8 * i4 + 4 * hh; const v2u z = *(const GAS v2u*)(za + d);
            v2u o; o.x = pk2(O[dt][4 * i4] * bf2f(z.x & 0xffffu), O[dt][4 * i4 + 1] * bf2f(z.x >> 16)); o.y = pk2(O[dt][4 * i4 + 2] * bf2f(z.y & 0xffffu), O[dt][4 * i4 + 3] * bf2f(z.y >> 16));
            *(GAS v2u*)(mx + d) = o; }
    if (g == 0) { const int ch = tid; const float w0 = P.conv_w[ch], w1 = P.conv_w[512 + ch], w2 = P.conv_w[1024 + ch], cb = P.conv_b[ch];
        const size_t r0 = (size_t)b * T + 64 * t; const bf16* U = (const bf16*)(P.ws + WS_U) + ch; const bf16* CGp = (const bf16*)(P.ws + WS_CG) + ch; bf16* mo = (bf16*)(P.ws + WS_MIX) + ch;
        float um2 = (t > 0) ? bf2f(U[(r0 - 2) * 512]) : 0.f, um1 = (t > 0) ? bf2f(U[(r0 - 1) * 512]) : 0.f;
#pragma unroll 4
        for (int i = 0; i < 64; ++i) { const float uc = bf2f(U[(r0 + i) * 512]); const float cy = w0 * um2 + w1 * um1 + w2 * uc + cb;
            mo[(r0 + i) * 1024] = (bf16)f2bf(bf2f(CGp[(r0 + i) * 512]) * cy); um2 = um1; um1 = uc; } }
}
template <class KeyFn>
__device__ __forceinline__ void sample_branch(Frame& F, int nslots, float shift, const KeyFn& key, LAS float* obr) {
    LAS float* q = (LAS float*)(F.lds + SM_Q); LAS float* Pb = (LAS float*)(F.lds + SM_P); LAS float* red = (LAS float*)(F.lds + SM_RED); LAS float* lsm = (LAS float*)(F.lds + SM_L);
    float lacc[4] = {0.f, 0.f, 0.f, 0.f};
    for (int s = F.tid; s < nslots; s += 512) { const float* kp; const float* vp; const bool valid = key(s, kp, vp);
        float sc[4] = {0.f, 0.f, 0.f, 0.f};
        if (valid) {
#pragma unroll 4
            for (int d4 = 0; d4 < 16; ++d4) { const f32x4 kv = *(const GAS f32x4*)(kp + 4 * d4);
#pragma unroll
                for (int hq = 0; hq < 4; ++hq) { const f32x4 qv = *(const LAS f32x4*)(q + hq * 64 + 4 * d4); sc[hq] += (kv.x * qv.x + kv.y * qv.y) + (kv.z * qv.z + kv.w * qv.w); } } }
        f32x4 p;
#pragma unroll
        for (int hq = 0; hq < 4; ++hq) { p[hq] = valid ? fast_exp2(sc[hq] - shift) : 0.f; lacc[hq] += p[hq]; }
        *(LAS f32x4*)(Pb + 4 * s) = p; }
#pragma unroll
    for (int hq = 0; hq < 4; ++hq) { lacc[hq] = wave_sum(lacc[hq]); if (F.lane == 0) red[F.wave * 4 + hq] = lacc[hq]; }
    __syncthreads();
    if (F.tid < 4) { float s = 0.f; for (int ww = 0; ww < 8; ++ww) s += red[ww * 4 + F.tid]; lsm[F.tid] = s; }
    __syncthreads();
    float oa[4] = {0.f, 0.f, 0.f, 0.f};
    const int per = nslots / 8;
    for (int s = F.wave * per; s < (F.wave + 1) * per; ++s) { const float* kp; const float* vp; const bool valid = key(s, kp, vp);
        if (valid) { const float v = vp[F.lane]; const f32x4 p = *(const LAS f32x4*)(Pb + 4 * s); oa[0] += p.x * v; oa[1] += p.y * v; oa[2] += p.z * v; oa[3] += p.w * v; } }
#pragma unroll
    for (int hq = 0; hq < 4; ++hq) red[64 + (F.wave * 4 + hq) * 64 + F.lane] = oa[hq];
    __syncthreads();
    if (F.tid < 256) { float s = 0.f; for (int ww = 0; ww < 8; ++ww) s += red[64 + (ww * 4 + (F.tid >> 6)) * 64 + (F.tid & 63)]; obr[F.tid] = s; }
    __syncthreads();
}
__device__ __forceinline__ void p3_sample_unit(const Ptrs& P, Frame& F, int b, int g) {
    LAS float* q = (LAS float*)(F.lds + SM_Q); LAS float* Pb = (LAS float*)(F.lds + SM_P); LAS float* imp = (LAS float*)(F.lds + SM_IMP); LAS float* lsm = (LAS float*)(F.lds + SM_L);
    LAS int* sel = (LAS int*)(F.lds + SM_SEL); LAS float* osm = (LAS float*)(F.lds + SM_O);
    const float* cst = (const float*)(P.ws + WS_CONST);
    float kcmax = 0.f; for (int e_ = 0; e_ < 4; ++e_) kcmax += __builtin_bit_cast(float, __hip_atomic_load((unsigned*)(P.ws + WS_CTL) + CW_KCMAX + 64 + e_, RLX_AGENT));
    const float sh_cmp = cst[0] * sqrtf(kcmax) * LOG2E * 1.001f, sh_slc = cst[1], sh_win = cst[2];
    if (F.tid < 256) q[F.tid] = ((const float*)(P.ws + WS_QS))[(size_t)b * 512 + g * 256 + F.tid];
    __syncthreads();
    const float* kcs = (const float*)(P.ws + WS_KCS) + (size_t)(b * 2 + g) * 2 * NCS * 64;
    sample_branch(F, NCS, sh_cmp, [&](int s, const float*& kp, const float*& vp) { kp = kcs + (size_t)s * 64; vp = kcs + (size_t)(NCS + s) * 64; return true; }, osm);
    { const f32x4 p = *(const LAS f32x4*)(Pb + 4 * F.tid); float v = p.x / lsm[0] + p.y / lsm[1] + p.z / lsm[2] + p.w / lsm[3]; v += __shfl_xor(v, 1);
      if ((F.tid & 1) == 0) imp[F.tid >> 1] = v; if (F.tid < 4) imp[256 + F.tid] = 0.f; }
    if (F.tid < 256) osm[F.tid] = osm[F.tid] / lsm[F.tid >> 6];
    __syncthreads();
    if (F.wave == 0) { const int lane = F.lane; unsigned k[4];
#pragma unroll
        for (int i = 0; i < 4; ++i) { const int j = lane + 64 * i; k[i] = (j >= 1 && j <= 254) ? __builtin_bit_cast(unsigned, imp[j]) + 1u : 0u; }
        unsigned Tv = 0u;
        for (int bit = 30; bit >= 0; --bit) { const unsigned cand = Tv | (1u << bit); int cnt = 0;
#pragma unroll
            for (int i = 0; i < 4; ++i) cnt += __popcll(__ballot(k[i] >= cand));
            if (cnt >= 13) Tv = cand; }
        int ngt = 0;
#pragma unroll
        for (int i = 0; i < 4; ++i) ngt += __popcll(__ballot(k[i] > Tv));
        const int need = 13 - ngt; const unsigned long long below = (lane == 0) ? 0ull : (~0ull >> (64 - lane));
        int base = 3, eqbase = 0;
        if (lane == 0) { sel[0] = 0; sel[1] = 255; sel[2] = 256; }
#pragma unroll
        for (int i = 0; i < 4; ++i) { const unsigned long long e = __ballot(k[i] == Tv); const int rk = eqbase + __popcll(e & below); const bool on = k[i] > Tv || (k[i] == Tv && rk < need);
            const unsigned long long m = __ballot(on); if (on) sel[base + __popcll(m & below)] = lane + 64 * i; base += __popcll(m); eqbase += __popcll(e); } }
    __syncthreads();
    const float* kvn = (const float*)(P.ws + WS_KVN) + (size_t)b * 768;
    const int* pt = P.page_table + b * NPAGES; const float* cs = P.cache_slc;
    sample_branch(F, 1024, sh_slc, [&](int s, const float*& kp, const float*& vp) { const int j = sel[s >> 6], rr = s & 63;
        if (j == 256) { kp = kvn + (1 * 2 + 0) * 128 + g * 64; vp = kvn + (1 * 2 + 1) * 128 + g * 64; return rr == 0; }
        const float* rowp = cs + ((size_t)pt[j >> 1] * 128 + (j & 1) * 64 + rr) * 256 + g * 64; kp = rowp; vp = rowp + 128; return true; }, osm + 256);
    if (F.tid < 256) osm[256 + F.tid] = osm[256 + F.tid] / lsm[F.tid >> 6];
    __syncthreads();
    const float* stw = P.st_win + (size_t)b * 512 * 256;
    sample_branch(F, 512, sh_win, [&](int s, const float*& kp, const float*& vp) {
        if (s == 511) { kp = kvn + (2 * 2 + 0) * 128 + g * 64; vp = kvn + (2 * 2 + 1) * 128 + g * 64; return true; }
        const float* rowp = stw + (size_t)(s + 1) * 256 + g * 64; kp = rowp; vp = rowp + 128; return true; }, osm + 512);
    if (F.tid < 256) { const int hq = F.tid >> 6, d = F.tid & 63; const float* gs = (const float*)(P.ws + WS_GS) + b * 24 + (g * 4 + hq) * 3;
        const float o = gs[0] * osm[F.tid] + gs[1] * osm[256 + F.tid] + gs[2] * osm[512 + F.tid] / lsm[hq];
        ((bf16*)(P.ws + WS_MIXS))[(size_t)b * 1024 + 512 + (g * 4 + hq) * 64 + d] = (bf16)f2bf(o * ((const float*)(P.ws + WS_ZAS))[(size_t)b * 512 + (g * 4 + hq) * 64 + d]); }
    __syncthreads();
}
__device__ __forceinline__ void p3_phase(const Ptrs& P, Frame& F, int rep) {
    const float* cst = (const float*)(P.ws + WS_CONST);
    float kcmax = 0.f; for (int e_ = 0; e_ < 4; ++e_) kcmax += __builtin_bit_cast(float, __hip_atomic_load((unsigned*)(P.ws + WS_CTL) + CW_KCMAX + e_, RLX_AGENT));
    const float sh_cmp = cst[0] * sqrtf(kcmax) * LOG2E * 1.001f, sh_slc = cst[1], sh_win = cst[2];
    volatile LAS int* qw = (volatile LAS int*)(F.lds + P3_MISC);
    constexpr int NQ = 8 + 128;
    const int x0 = (int)(xb_xcc_id() & 7u);
    for (int xi = 0; xi < 8; ++xi) {
        const int x = (x0 + xi) & 7;
        for (;;) {
            __syncthreads();
            if (F.tid == 0) qw[0] = (int)__hip_atomic_fetch_add((unsigned*)(F.ctl + CW_QUEUE + 64 * (x + 8 * rep)), 1u, RLX_AGENT);
            __syncthreads();
            const int idx = qw[0];
            if (idx >= NQ) break;
            if (idx < 8) p3_sample_unit(P, F, x * 4 + (idx >> 1), idx & 1);
            else p3_prompt_unit(P, F, x >> 1, 127 - (idx - 8), x & 1, sh_cmp, sh_slc, sh_win);
        }
    }
}
#ifndef MK_N_LAUNCHES
#define MK_N_LAUNCHES 1
#endif
constexpr int N_PHASES = 6;
constexpr int N_LAUNCHES = MK_N_LAUNCHES;
struct Args { Ptrs p; int ph_lo, ph_hi, rep, pad; };
__global__ void __launch_bounds__(NWAVES * 64, 2) nsa_fwd(Args args) {
    extern __shared__ __attribute__((aligned(16))) unsigned char lds[];
    const Ptrs& P = args.p;
    Frame F;
    F.lds = (LAS unsigned char*)lds;
    F.MISC = (volatile LAS unsigned*)(F.lds + MISC_OFF);
    F.tid = threadIdx.x; F.lane = F.tid & 63; F.wave = __builtin_amdgcn_readfirstlane(F.tid >> 6);
    F.G = gridDim.x; F.gw = blockIdx.x * NWAVES + F.wave; F.NGW = F.G * NWAVES;
    F.ctl = (gu32*)(P.ws + WS_CTL);
    for (int u = F.tid; u < (LDS_BYTES - LDSCTL_OFF) / 4; u += NWAVES * 64) ((LAS unsigned*)(F.lds + LDSCTL_OFF))[u] = 0u;
    __syncthreads();
    XcdBarrier bar; bar.bar = (unsigned*)(F.ctl + CW_BAR); bar.x = 0; bar.st = nullptr;
    if (N_LAUNCHES == 1) bar = xcd_barrier_post((unsigned*)(F.ctl + CW_BAR), F.MISC + 8);
    const int lo = args.ph_lo, hi = args.ph_hi;
#define IN(k) (lo <= (k) && (k) < hi)
#define SEAM(k) do { if (IN(k) && IN((k) + 1)) xcd_barrier(bar); } while (0)

    if (IN(0)) { p0a_small(P, F); } SEAM(0);
    if (IN(1)) { p0b_big(P, F); } SEAM(1);
    if (IN(2)) {
        pg8::Gemm g{(const pg8::bf16_t*)(P.ws + WS_XB), (const pg8::bf16_t*)(P.ws + WS_BT1), M, NP, D}; pg8::StaticOrder S; S.init(M, NP, F.G, (int)blockIdx.x);
        EpiIn E{(const float*)(P.ws + WS_RSTD), (const float*)(P.ws + WS_ROPE), P.q_gain, P.k_gain, P.out, P.ws};
        pg8::gemm_phase<EpiIn, pg8::StaticOrder, true, true>(F.lds + RING_OFF, g, S, E);
        for (int ct = F.gw; ct < NP / 16; ct += F.NGW) small_gemm_tile<0>(P, (const bf16*)(P.ws + WS_XSB), (const bf16*)(P.ws + WS_BT1), ct, F.lane);
    } SEAM(2);
    if (IN(3)) { p2_phase(P, F); } SEAM(3);
    if (IN(4)) { p3_phase(P, F, args.rep); } SEAM(4);
    if (IN(5)) {
        pg8::Gemm g{(const pg8::bf16_t*)(P.ws + WS_MIX), (const pg8::bf16_t*)(P.ws + WS_BT2), M, D, D}; pg8::StaticOrder S; S.init(M, D, F.G, (int)blockIdx.x);
        EpiOut E{P.xp, P.out + O_Y};
        pg8::gemm_phase<EpiOut, pg8::StaticOrder, true, true>(F.lds + RING_OFF, g, S, E);
        for (int ct = F.gw; ct < D / 16; ct += F.NGW) small_gemm_tile<1>(P, (const bf16*)(P.ws + WS_MIXS), (const bf16*)(P.ws + WS_BT2), ct, F.lane);
    }
#undef IN
#undef SEAM
}

extern "C" void kernel_launch(void* const* d_in, const int* in_sizes, int n_in, void* d_out, int out_size, void* d_ws, size_t ws_size, hipStream_t stream) {
    static int grid = 0;
    if (grid == 0) {
        if (n_in != 16 || out_size != (int)O_END || ws_size < WS_END) { fprintf(stderr, "kernel_launch: unexpected shapes (n_in %d, out %d, ws %zu)\n", n_in, out_size, ws_size); grid = -1; return; }
        int dev = 0, cus = 0, per_cu = 0;
        if (hipGetDevice(&dev) != hipSuccess || hipDeviceGetAttribute(&cus, hipDeviceAttributeMultiprocessorCount, dev) != hipSuccess) { grid = -1; return; }
        if (hipFuncSetAttribute((const void*)nsa_fwd, hipFuncAttributeMaxDynamicSharedMemorySize, LDS_BYTES) != hipSuccess) { fprintf(stderr, "kernel_launch: hipFuncSetAttribute failed\n"); grid = -1; return; }
        if (hipOccupancyMaxActiveBlocksPerMultiprocessor(&per_cu, (const void*)nsa_fwd, NWAVES * 64, LDS_BYTES) != hipSuccess || per_cu < 1)
            fprintf(stderr, "kernel_launch: note: occupancy query reports %d workgroups per CU\n", per_cu);
        (void)hipGetLastError();
        grid = cus;
    }
    if (grid < 0) return;
    if (hipMemsetAsync((char*)d_ws + WS_CTL, 0, CTL_ZERO_BYTES, stream) != hipSuccess) return;
    Args a{};
    a.p.xp = (const float*)d_in[0]; a.p.xs = (const float*)d_in[1]; a.p.cache_cmp = (const float*)d_in[2]; a.p.cache_slc = (const float*)d_in[3];
    a.p.st_win = (const float*)d_in[4]; a.p.st_conv = (const float*)d_in[5]; a.p.page_table = (const int*)d_in[6]; a.p.norm_g = (const float*)d_in[7];
    a.p.w_in = (const float*)d_in[8]; a.p.conv_w = (const float*)d_in[9]; a.p.conv_b = (const float*)d_in[10]; a.p.q_gain = (const float*)d_in[11];
    a.p.k_gain = (const float*)d_in[12]; a.p.cmp_pe = (const float*)d_in[13]; a.p.cmp_w = (const float*)d_in[14]; a.p.w_out = (const float*)d_in[15];
    a.p.out = (float*)d_out; a.p.ws = (unsigned char*)d_ws;
#ifndef PROBE_DUP
#define PROBE_DUP -1
#endif
    for (int li = 0; li < N_LAUNCHES; ++li) {
        a.ph_lo = (N_LAUNCHES == 1) ? 0 : li; a.ph_hi = (N_LAUNCHES == 1) ? N_PHASES : li + 1;
        for (int rep = 0; rep < ((N_LAUNCHES > 1 && li == PROBE_DUP) ? 2 : 1); ++rep) {
            a.rep = rep;
            hipLaunchKernelGGL(nsa_fwd, dim3(grid), dim3(NWAVES * 64), LDS_BYTES, stream, a);
            const hipError_t le = hipPeekAtLastError();
            if (le != hipSuccess) { fprintf(stderr, "kernel_launch: launch %d failed: %s\n", li, hipGetErrorName(le)); break; }
        }
    }
}
```

```cpp
#include <hip/hip_runtime.h>
#include <cstdio>
#include <cstdint>
#define GAS __attribute__((address_space(1)))
#define LAS __attribute__((address_space(3)))
typedef unsigned short bf16;
typedef unsigned v4u __attribute__((ext_vector_type(4)));
typedef unsigned v2u __attribute__((ext_vector_type(2)));
typedef float f32x2 __attribute__((ext_vector_type(2)));
typedef float f32x16 __attribute__((ext_vector_type(16)));
typedef GAS unsigned gu32;
typedef GAS unsigned long long gu64;
#define RLX_AGENT __ATOMIC_RELAXED, __HIP_MEMORY_SCOPE_AGENT
#define LDS_WAIT() asm volatile("s_waitcnt lgkmcnt(0)" ::: "memory")
#define VM_WAIT() asm volatile("s_waitcnt vmcnt(0)" ::: "memory")
#define MK_N_LAUNCHES 1
#define PROBE_DUP -1
#define PROBE_P3 0
#define PROBE_SEG 0
namespace pg8 {
#define PG8_LAS __attribute__((address_space(3)))
typedef unsigned short bf16_t;
typedef short bf16x8 __attribute__((ext_vector_type(8)));
typedef float f32x4 __attribute__((ext_vector_type(4)));
typedef unsigned u32x4 __attribute__((ext_vector_type(4)));
constexpr int BM = 256, BK = 64, HALF = 128, HTB = HALF * BK * 2  , STAGE_BYTES = 8 * HTB, NXCD = 8, WGM = 8;

__host__ __device__ __forceinline__ int lds_byte(int r, int c) { const int st = (r >> 4) * 2 + (c >> 5), rr = r & 15, cc = c & 31, ob = rr * 64 + cc * 2; return st * 1024 + (ob ^ (((ob >> 9) & 1) << 5)); }
__host__ __device__ __forceinline__ void stage_rc(int b, int& R, int& C) { const int st = b / 1024, sb = b % 1024, swz = sb ^ (((sb >> 9) & 1) << 5); R = (st >> 1) * 16 + swz / 64; C = (st & 1) * 32 + (swz % 64) / 2; }
__host__ __device__ __forceinline__ int perm32(int rho) { const int n = rho >> 4, i = rho & 15; return 8 * (i >> 2) + 4 * n + (i & 3); }

struct Unit { int pm, pn; };
struct Gemm { const bf16_t* A; const bf16_t* Bt; int M, N, K; };

struct StaticOrder {
    int nM, nN, nwg, G, c;
    __host__ __device__ void init(int M, int N, int G_, int c_) { nM = M / BM; nN = N / BM; nwg = nM * nN; G = G_; c = c_; }
    __host__ __device__ bool next(int i, Unit& u) const {
        const long L = (long)i * G + c; if (L >= nwg) return false;
        int wgid = (int)L; { const int q = nwg / NXCD, r = nwg % NXCD, xcd = wgid % NXCD, off = wgid / NXCD; wgid = (xcd < r ? xcd * (q + 1) : r * (q + 1) + (xcd - r) * q) + off; }
        const int nig = WGM * nN, gid = wgid / nig, fm = gid * WGM, gsz = (nM - fm) < WGM ? (nM - fm) : WGM;
        u.pm = fm + ((wgid % nig) % gsz); u.pn = (wgid % nig) / gsz; return true;
    }
    __device__ __forceinline__ void a_ready(const Unit&) const {}
    __device__ __forceinline__ void done(const Unit&) const {}
};


template <class Epi, class Sched, bool ALIGN_EPI = false, bool SP2 = false>
__device__ __forceinline__ void gemm_phase(PG8_LAS unsigned char* lds, const Gemm g, const Sched& S, const Epi& E, int wave_id  , unsigned long long& tacc_  ) {
    const int lane = (int)__builtin_amdgcn_mbcnt_hi(~0u, __builtin_amdgcn_mbcnt_lo(~0u, 0u)), wid = wave_id, tid = wid * 64 + lane, wr = wid >> 2, wc = wid & 3, fr = lane & 15, fq = lane >> 4;
    const int K = g.K, nt = K / BK;
    unsigned voffA[2], voffB[2];
#pragma unroll
    for (int i = 0; i < 2; ++i) { int R, C; stage_rc(tid * 16 + i * 8192, R, C); const int Rb = Epi::PERM ? ((R & ~31) + perm32(R & 31)) : R;
        voffA[i] = (unsigned)(R * K + C) * 2u; voffB[i] = (unsigned)(Rb * K + C) * 2u; }
    const size_t kstep = (size_t)(BK * 2);
    const size_t hstep = (size_t)HALF * K * 2;
    const size_t tstep = 2 * hstep;
    const unsigned ldsw = (unsigned)wid * 1024u;
    const int aoff = lds_byte(wr * 64 + fr, fq * 8), boff = lds_byte(wc * 32 + fr, fq * 8);
#define PG8_SA(b, h) (((b) * 2 + (h)) * HTB)
#define PG8_SB(b, h) ((4 + (b) * 2 + (h)) * HTB)
#define PG8_STAGE(bufoff, gbase, voff) do { _Pragma("unroll") for (int _i = 0; _i < 2; ++_i) \
        __builtin_amdgcn_global_load_lds((const unsigned*)((const char*)(gbase) + (voff)[_i]), (PG8_LAS unsigned*)(lds + (bufoff) + ldsw + _i * 8192), 16, 0, 0); } while (0)
#define PG8_LDA(dst, b, h) do { _Pragma("unroll") for (int m = 0; m < 4; ++m) _Pragma("unroll") for (int k = 0; k < 2; ++k) dst[m][k] = *(const PG8_LAS bf16x8*)(lds + PG8_SA(b, h) + aoff + m * 2048 + k * 1024); } while (0)
#define PG8_LDB(dst, b, h) do { _Pragma("unroll") for (int n = 0; n < 2; ++n) _Pragma("unroll") for (int k = 0; k < 2; ++k) dst[n][k] = *(const PG8_LAS bf16x8*)(lds + PG8_SB(b, h) + boff + n * 2048 + k * 1024); } while (0)
#define PG8_MMA(ai, bj, At, Bt) do { __builtin_amdgcn_s_setprio(1); _Pragma("unroll") for (int m = 0; m < 4; ++m) _Pragma("unroll") for (int n = 0; n < 2; ++n) _Pragma("unroll") for (int k = 0; k < 2; ++k) \
        acc[ai][bj][m][n] = __builtin_amdgcn_mfma_f32_16x16x32_bf16(Bt[n][k], At[m][k], acc[ai][bj][m][n], 0, 0, 0); __builtin_amdgcn_s_setprio(0); } while (0)
#define PG8_WAIT_V(n) asm volatile("s_waitcnt vmcnt(" #n ")" ::: "memory")
#define PG8_WAIT_L(n) asm volatile("s_waitcnt lgkmcnt(" #n ")" ::: "memory")
#define PG8_BAR __builtin_amdgcn_s_barrier()
#define PG8_SCHED __builtin_amdgcn_sched_barrier(0)
    Unit cur, nxt; int ui = 0;
    if (!S.next(0, cur)) return;
    f32x4 acc[2][2][4][2];
#pragma unroll
    for (int a = 0; a < 2; ++a)
#pragma unroll
        for (int b = 0; b < 2; ++b)
#pragma unroll
            for (int m = 0; m < 4; ++m)
#pragma unroll
                for (int n = 0; n < 2; ++n) acc[a][b][m][n] = (f32x4){0.f, 0.f, 0.f, 0.f};
    bf16x8 At[4][2], B0[2][2], B1[2][2];
    const char* cA = (const char*)g.A + (size_t)cur.pm * tstep; const char* cB = (const char*)g.Bt + (size_t)cur.pn * tstep;
    S.a_ready(cur);
    if constexpr (SP2) {
        PG8_STAGE(PG8_SB(0, 0), cB, voffB); PG8_STAGE(PG8_SB(0, 1), cB + hstep, voffB); PG8_STAGE(PG8_SA(0, 0), cA, voffA); PG8_STAGE(PG8_SA(0, 1), cA + hstep, voffA);
        if (wr == 1) PG8_BAR;
        PG8_WAIT_V(2); PG8_BAR;
        PG8_STAGE(PG8_SB(1, 0), cB + kstep, voffB); PG8_STAGE(PG8_SA(1, 0), cA + kstep, voffA); PG8_STAGE(PG8_SB(1, 1), cB + hstep + kstep, voffB);
        PG8_WAIT_V(6); PG8_BAR;
    } else {
        PG8_STAGE(PG8_SB(0, 0), cB, voffB); PG8_STAGE(PG8_SA(0, 0), cA, voffA); PG8_STAGE(PG8_SB(0, 1), cB + hstep, voffB); PG8_STAGE(PG8_SA(0, 1), cA + hstep, voffA);
        if (wr == 1) PG8_BAR;
        PG8_WAIT_V(4); PG8_BAR;
        PG8_STAGE(PG8_SB(1, 0), cB + kstep, voffB); PG8_STAGE(PG8_SA(1, 0), cA + kstep, voffA); PG8_STAGE(PG8_SB(1, 1), cB + hstep + kstep, voffB);
        PG8_WAIT_V(6); PG8_BAR;
    }
    for (;;) {
        const bool has_next = S.next(ui + 1, nxt);
        const char* nA = has_next ? (const char*)g.A + (size_t)nxt.pm * tstep : cA; const char* nB = has_next ? (const char*)g.Bt + (size_t)nxt.pn * tstep : cB;
        for (int t = 0; t < nt; t += 2) {
            const bool last = (t == nt - 2);
            const char* a1 = cA + (size_t)(t + 1) * kstep;
            const char* a2 = last ? nA : cA + (size_t)(t + 2) * kstep; const char* b2 = last ? nB : cB + (size_t)(t + 2) * kstep;
            const char* a3 = a2 + kstep; const char* b3 = b2 + kstep;
            if (last && has_next) S.a_ready(nxt);
            if constexpr (SP2) {
            PG8_LDB(B0, 0, 0); PG8_LDB(B1, 0, 1); PG8_SCHED; PG8_LDA(At, 0, 0); PG8_STAGE(PG8_SA(1, 1), a1 + hstep, voffA);
            PG8_WAIT_V(8); PG8_WAIT_L(0); PG8_BAR; PG8_MMA(0, 0, At, B0); PG8_MMA(0, 1, At, B1); PG8_BAR; PG8_SCHED;
            PG8_LDA(At, 0, 1); PG8_STAGE(PG8_SB(0, 0), b2, voffB); PG8_STAGE(PG8_SB(0, 1), b2 + hstep, voffB); PG8_STAGE(PG8_SA(0, 0), a2, voffA);
            PG8_WAIT_V(8); PG8_WAIT_L(0); PG8_BAR; PG8_MMA(1, 0, At, B0); PG8_MMA(1, 1, At, B1); PG8_BAR; PG8_SCHED;
            PG8_LDB(B0, 1, 0); PG8_LDB(B1, 1, 1); PG8_SCHED; PG8_LDA(At, 1, 0); PG8_STAGE(PG8_SA(0, 1), a2 + hstep, voffA);
            PG8_WAIT_V(8); PG8_WAIT_L(0); PG8_BAR; PG8_MMA(0, 0, At, B0); PG8_MMA(0, 1, At, B1); PG8_BAR; PG8_SCHED;
            PG8_LDA(At, 1, 1); PG8_STAGE(PG8_SB(1, 0), b3, voffB); PG8_STAGE(PG8_SB(1, 1), b3 + hstep, voffB); PG8_STAGE(PG8_SA(1, 0), a3, voffA);
            PG8_WAIT_V(8); PG8_WAIT_L(0); PG8_BAR; PG8_MMA(1, 0, At, B0); PG8_MMA(1, 1, At, B1); PG8_BAR; PG8_SCHED;
            } else {
            PG8_LDB(B0, 0, 0); PG8_SCHED; PG8_LDA(At, 0, 0); PG8_STAGE(PG8_SA(1, 1), a1 + hstep, voffA);
            PG8_WAIT_L(8); PG8_BAR; PG8_WAIT_L(0); PG8_MMA(0, 0, At, B0); PG8_BAR; PG8_SCHED;
            PG8_LDB(B1, 0, 1); PG8_STAGE(PG8_SB(0, 0), b2, voffB);
            PG8_BAR; PG8_WAIT_L(0); PG8_MMA(0, 1, At, B1); PG8_BAR;
            PG8_LDA(At, 0, 1); PG8_STAGE(PG8_SA(0, 0), a2, voffA);
            PG8_BAR; PG8_WAIT_L(0); PG8_MMA(1, 0, At, B0); PG8_BAR; PG8_SCHED;
            PG8_STAGE(PG8_SB(0, 1), b2 + hstep, voffB);
            PG8_WAIT_V(6); PG8_BAR; PG8_MMA(1, 1, At, B1); PG8_BAR;
            PG8_LDB(B0, 1, 0); PG8_SCHED; PG8_LDA(At, 1, 0); PG8_STAGE(PG8_SA(0, 1), a2 + hstep, voffA);
            PG8_WAIT_L(8); PG8_BAR; PG8_WAIT_L(0); PG8_MMA(0, 0, At, B0); PG8_BAR; PG8_SCHED;
            PG8_LDB(B1, 1, 1); PG8_STAGE(PG8_SB(1, 0), b3, voffB);
            PG8_BAR; PG8_WAIT_L(0); PG8_MMA(0, 1, At, B1); PG8_BAR;
            PG8_LDA(At, 1, 1); PG8_STAGE(PG8_SA(1, 0), a3, voffA);
            PG8_BAR; PG8_WAIT_L(0); PG8_MMA(1, 0, At, B0); PG8_BAR; PG8_SCHED;
            PG8_STAGE(PG8_SB(1, 1), b3 + hstep, voffB);
            PG8_WAIT_V(6); PG8_BAR; PG8_MMA(1, 1, At, B1); PG8_BAR;
            }
        }
        if constexpr (ALIGN_EPI) { if (wr == 0) PG8_BAR; }
#ifdef PROBE_EPI
        { const unsigned long long t0_ = __builtin_readcyclecounter(); E(acc, cur, wr, wc, fr, fq); asm volatile("s_waitcnt vmcnt(0)" ::: "memory"); tacc_ += __builtin_readcyclecounter() - t0_; S.done(cur); }
#else
        if constexpr (!Epi::AFTER_DRAIN) { E(acc, cur, wr, wc, fr, fq); S.done(cur); }
#endif
        if (!has_next) break;
#pragma unroll
        for (int a = 0; a < 2; ++a)
#pragma unroll
            for (int b = 0; b < 2; ++b)
#pragma unroll
                for (int m = 0; m < 4; ++m)
#pragma unroll
                    for (int n = 0; n < 2; ++n) acc[a][b][m][n] = (f32x4){0.f, 0.f, 0.f, 0.f};
        cur = nxt; cA = nA; cB = nB; ++ui;
        if constexpr (ALIGN_EPI) { if (wr == 1) PG8_BAR; }
    }
    PG8_WAIT_V(0);
    if constexpr (!ALIGN_EPI) { if (wr == 0) PG8_BAR; }
    PG8_BAR;
    if constexpr (Epi::AFTER_DRAIN) { E.fused(acc, cur, wr, wc, fr, fq, lds, wid, lane); S.done(cur); }
#undef PG8_SA
#undef PG8_SB
#undef PG8_STAGE
#undef PG8_LDA
#undef PG8_LDB
#undef PG8_MMA
#undef PG8_WAIT_V
#undef PG8_WAIT_L
#undef PG8_BAR
#undef PG8_SCHED
}
}
#define XB_TMO      128
#define XB_XCNT(j)  (256  + 64 * (j))
#define XB_XSUB(j)  (1280 + 64 * (j))
#define XB_XGEN(j)  (2304 + 64 * (j))
#define XB_TOP      3328
#define XB_TOPGEN   3392
#define XCD_BAR_WORDS 3456
#define XB_SPIN_CAP (1u << 18)

__device__ __forceinline__ unsigned xb_ld(unsigned* p)              { return __hip_atomic_load(p, __ATOMIC_RELAXED, __HIP_MEMORY_SCOPE_AGENT); }
__device__ __forceinline__ unsigned xb_add(unsigned* p, unsigned v) { return __hip_atomic_fetch_add(p, v, __ATOMIC_RELAXED, __HIP_MEMORY_SCOPE_AGENT); }
__device__ __forceinline__ unsigned xb_xcc_id() { return (unsigned)__builtin_amdgcn_s_getreg((3 << 11) | 20) & 0xFu; }
#define XB_SPIN(cond, bar) do { unsigned _sp = 0; while (cond) { __builtin_amdgcn_s_sleep(1); \
    if ((++_sp & 255u) == 0u) { if (xb_ld(&(bar)[XB_TMO])) break; if (_sp > XB_SPIN_CAP) { atomicAdd(&(bar)[XB_TMO], 1u); break; } } } } while (0)

struct XcdBarrier {
    unsigned* bar; unsigned x;
    volatile LAS unsigned* st;
};

__device__ __forceinline__ XcdBarrier xcd_barrier_post(unsigned* bar, volatile LAS unsigned* st) {
    XcdBarrier b; b.bar = bar; b.x = xb_xcc_id(); b.st = st;
    if (threadIdx.x == 0) (void)xb_add(&bar[XB_XCNT(b.x)], 1u);
    return b;
}
__device__ __forceinline__ void xcd_barrier_complete(unsigned* bar, unsigned x, unsigned& nloc, unsigned& nx) {
    const unsigned G = gridDim.x * gridDim.y * gridDim.z;
    unsigned sum, cnt, mine, sp = 0u;
    for (;;) {
        sum = 0u; cnt = 0u; mine = 0u;
#pragma unroll
        for (unsigned j = 0; j < 16; ++j) { const unsigned c = xb_ld(&bar[XB_XCNT(j)]); sum += c; cnt += (c > 0u) ? 1u : 0u; mine = (j == x) ? c : mine; }
        if (sum == G) break;
        __builtin_amdgcn_s_sleep(1);
        if ((++sp & 255u) == 0u) { if (xb_ld(&bar[XB_TMO])) break; if (sp > XB_SPIN_CAP) { atomicAdd(&bar[XB_TMO], 1u); break; } }
    }
    nloc = mine > 0u ? mine : 1u; nx = cnt > 0u ? cnt : 1u;
}

__device__ __forceinline__ void xcd_barrier(const XcdBarrier& b, bool leader  ) {
    asm volatile("s_waitcnt vmcnt(0)" ::: "memory");
    __syncthreads();
    if (leader) {
        unsigned* bar = b.bar;
        __builtin_amdgcn_s_waitcnt(0);
        unsigned nloc = b.st[0], nx = b.st[1];
        if (nloc == 0u) { xcd_barrier_complete(bar, b.x, nloc, nx); b.st[0] = nloc; b.st[1] = nx; }
        const unsigned old = xb_add(&bar[XB_XSUB(b.x)], 1u);
        const unsigned gen = old / nloc;
        if (old + 1u == (gen + 1u) * nloc) {
            __builtin_amdgcn_fence(__ATOMIC_RELEASE, "agent");
            asm volatile("s_waitcnt vmcnt(0)" ::: "memory");
            const unsigned og = xb_add(&bar[XB_TOP], 1u);
            const unsigned tg = og / nx;
            if (og + 1u == (tg + 1u) * nx) xb_add(&bar[XB_TOPGEN], 1u);
            else XB_SPIN(xb_ld(&bar[XB_TOPGEN]) == tg, bar);
            __builtin_amdgcn_fence(__ATOMIC_ACQUIRE, "agent");
            xb_add(&bar[XB_XGEN(b.x)], 1u);
            asm volatile("s_waitcnt vmcnt(0)" ::: "memory");
        } else {
            XB_SPIN(xb_ld(&bar[XB_XGEN(b.x)]) == gen, bar);
            __builtin_amdgcn_fence(__ATOMIC_ACQUIRE, "agent");
            asm volatile("s_waitcnt vmcnt(0)" ::: "memory");
        }
    }
    __syncthreads();
}
using pg8::f32x4; using pg8::bf16x8;
constexpr int NWAVES = 8;
constexpr int BATCH = 4, T = 8192, D = 1024, M = BATCH * T, NP = 4096, INW = 3864;
constexpr int DECB = 32, PAST = 16384, NPAGES = 128, NCS = 512  ;
constexpr float NORM_EPS = 1e-6f;
constexpr float LOG2E = 1.4426950408889634f;
constexpr float QSCALE = 0.125f * LOG2E;
constexpr size_t O_Y = 0, O_YS = 33554432, O_PCMP = 33587200, O_PSLC = 41975808, O_PWIN = 50364416, O_PCONV = 50888704,
                 O_SCMP = 50892800, O_SSLC = 50900992, O_SWIN = 50909184, O_SCONV = 55103488, O_END = 55136256;
constexpr int C_BG = 0, C_CG = 512, C_CI = 1024, C_ZC = 1536, C_Q = 2048, C_KV = 2560, C_GL = 3328, C_ZA = 3352;

constexpr size_t MiB = 1u << 20, KiB = 1u << 10;
constexpr size_t WS_CTL = 0, CTL_ZERO_BYTES = 1 * MiB;
constexpr size_t WS_BT1 = 2 * MiB;
constexpr size_t WS_BT2 = 10 * MiB;
constexpr size_t WS_BTC = 12 * MiB;
constexpr size_t WS_CBIAS = 12 * MiB + 512 * KiB;
constexpr size_t WS_CONST = WS_CBIAS + 4 * KiB;
constexpr size_t WS_ROPE = 13 * MiB;
constexpr size_t WS_RSTD = 16 * MiB;
constexpr size_t WS_XSB = 16 * MiB + 256 * KiB;
constexpr size_t WS_RSTDS = WS_XSB + 64 * KiB;
constexpr size_t WS_GATE = 17 * MiB;
constexpr size_t WS_KC = 20 * MiB;
constexpr size_t WS_VCT = WS_KC + 256 * KiB;
constexpr size_t WS_PROJS = 21 * MiB;
constexpr size_t WS_QS = 22 * MiB;
constexpr size_t WS_KVN = WS_QS + 64 * KiB;
constexpr size_t WS_GS = WS_KVN + 96 * KiB;
constexpr size_t WS_ZAS = WS_GS + 4 * KiB;
constexpr size_t WS_MIXS = WS_ZAS + 64 * KiB;
constexpr size_t WS_KCS = 24 * MiB;
constexpr size_t WS_KS = 40 * MiB, WS_VTS = 48 * MiB, WS_KW = 56 * MiB, WS_VTW = 64 * MiB;
constexpr size_t WS_XB = 72 * MiB;
constexpr size_t WS_CG = 136 * MiB, WS_U = 168 * MiB, WS_ZA = 200 * MiB, WS_Q = 232 * MiB;
constexpr size_t WS_MIX = 264 * MiB;
constexpr size_t WS_TOT = 328 * MiB;
constexpr size_t WS_END = 344 * MiB;
constexpr int CW_TMO = 0, CW_CODE = 1;
constexpr int CW_BAR = 4096;
constexpr int CW_QUEUE = 16384;
constexpr int CW_P0CNT = 18432;
constexpr int CW_KCMAX = 20480;

constexpr int RING_OFF = 0, RING_BYTES = 131072;
constexpr int LDSCTL_OFF = RING_BYTES, MISC_OFF = LDSCTL_OFF + 320;
constexpr int LDS_BYTES = 147456;

__device__ __forceinline__ unsigned f2bf(float f) { unsigned u = __builtin_bit_cast(unsigned, f); return (u + 0x7fffu + ((u >> 16) & 1u)) >> 16; }
typedef __bf16 bf16x2_t __attribute__((ext_vector_type(2)));
__device__ __forceinline__ unsigned pk2(float lo, float hi) { return __builtin_bit_cast(unsigned, __builtin_convertvector((f32x2){lo, hi}, bf16x2_t)); }
__device__ __forceinline__ float bf2f(unsigned h) { return __builtin_bit_cast(float, h << 16); }
__device__ __forceinline__ float wave_sum(float v) {
#pragma unroll
    for (int o = 1; o < 64; o <<= 1) v += __shfl_xor(v, o);
    return v;
}
__device__ __forceinline__ float fast_exp2(float x) { return __builtin_amdgcn_exp2f(x); }
__device__ __forceinline__ float sigmoidf(float x) { return __builtin_amdgcn_rcpf(1.0f + fast_exp2(-x * LOG2E)); }
__device__ __forceinline__ int perm16(int kk) { return 8 * ((kk >> 2) & 1) + 4 * (kk >> 3) + (kk & 3); }

struct Ptrs {
    const float *xp, *xs, *cache_cmp, *cache_slc, *st_win, *st_conv; const int* page_table;
    const float *norm_g, *w_in, *conv_w, *conv_b, *q_gain, *k_gain, *cmp_pe, *cmp_w, *w_out;
    float* out; unsigned char* ws;
};
struct Frame {
    LAS unsigned char* lds;
    volatile LAS unsigned* MISC;
    gu32* ctl;
    int tid, lane, wave, G, gw, NGW;
};
__device__ __forceinline__ int bt1_src(int dg, int& nvalid) {
    const int pn = dg >> 3, gi = dg & 7, bj = gi >> 2, wc = gi & 3; nvalid = 32;
    if (pn < 4) return (bj ? C_ZC : C_BG) + 128 * pn + 32 * wc;
    if (pn < 8) return (bj ? C_CI : C_CG) + 128 * (pn - 4) + 32 * wc;
    if (pn < 10) return C_Q + (4 * (pn - 8) + wc) * 64 + 32 * bj;
    if (pn < 13) return C_KV + (pn - 10) * 256 + wc * 64 + 32 * bj;
    if (pn < 15) return C_ZA + 256 * (pn - 13) + 32 * gi;
    nvalid = (gi == 0) ? 24 : 0; return C_GL;
}
__device__ __forceinline__ void p0_transpose_item(const float* W, int ldw, int k0, int src0, int nvalid, const float* ksc, bf16* WT, int ldt, int drow0, LAS float* scr, int lane) {
    const int nn = lane & 31;
#pragma unroll 8
    for (int i = 0; i < 32; ++i) { const int kk = 2 * i + (lane >> 5); float v = 0.f;
        if (nn < nvalid) { v = W[(size_t)(k0 + kk) * ldw + src0 + nn]; if (ksc) v *= ksc[k0 + kk]; }
        scr[kk * 33 + nn] = v; }
    LDS_WAIT(); asm volatile("" ::: "memory");
    const int c = lane & 7;
#pragma unroll
    for (int j = 0; j < 4; ++j) { const int n = (lane >> 3) + 8 * j; const LAS float* s = scr + (8 * c) * 33 + n;
        v4u o; o.x = pk2(s[0 * 33], s[1 * 33]); o.y = pk2(s[2 * 33], s[3 * 33]); o.z = pk2(s[4 * 33], s[5 * 33]); o.w = pk2(s[6 * 33], s[7 * 33]);
        *(GAS v4u*)(WT + (size_t)(drow0 + n) * ldt + k0 + 8 * c) = o; }
    LDS_WAIT(); asm volatile("" ::: "memory");
}
template <int NR>
__device__ __forceinline__ void x_rows_to_bf16(const float* xrow, bf16* orow, float* rstd_out, int lane) {
    f32x4 v[NR][4]; float s[NR];
#pragma unroll
    for (int r = 0; r < NR; ++r)
#pragma unroll
        for (int j = 0; j < 4; ++j) v[r][j] = ((const GAS f32x4*)(xrow + (size_t)r * D) + lane)[64 * j];
#pragma unroll
    for (int r = 0; r < NR; ++r) { s[r] = 0.f;
#pragma unroll
        for (int j = 0; j < 4; ++j) s[r] += (v[r][j].x * v[r][j].x + v[r][j].y * v[r][j].y) + (v[r][j].z * v[r][j].z + v[r][j].w * v[r][j].w); }
#pragma unroll
    for (int o = 1; o < 64; o <<= 1)
#pragma unroll
        for (int r = 0; r < NR; ++r) s[r] += __shfl_xor(s[r], o);
#pragma unroll
    for (int r = 0; r < NR; ++r) { GAS unsigned long long* o8 = (GAS unsigned long long*)(orow + (size_t)r * D) + lane;
#pragma unroll
        for (int j = 0; j < 4; ++j) o8[64 * j] = (unsigned long long)pk2(v[r][j].x, v[r][j].y) | ((unsigned long long)pk2(v[r][j].z, v[r][j].w) << 32);
        if (lane == 0) rstd_out[r] = 1.0f / sqrtf(s[r] * (1.0f / D) + NORM_EPS); }
}
template <bool SAMPLE>
__device__ __forceinline__ const float* cmp_rowbase(const Ptrs& P, int unit, int rho) {
    const int b = SAMPLE ? unit >> 6 : unit >> 5, c = (SAMPLE ? (unit & 63) : (unit & 31)) * 8 + (rho >> 1), g = rho & 1;
    if (SAMPLE) { const int page = P.page_table[b * NPAGES + (c >> 2)]; return P.cache_cmp + ((size_t)page * 128 + (c & 3) * 32) * 256 + g * 64; }
    return P.out + O_PCMP + ((size_t)b * T + c * 32) * 256 + g * 64;
}
template <bool SAMPLE>
__device__ __forceinline__ void compress_units(const Ptrs& P, Frame& F, LAS float* part  ) {
    constexpr int NUNITS = SAMPLE ? DECB * (NCS / 8) : BATCH * 32;
    const int lane = F.lane, w = F.wave, rho = lane & 15, kq = lane >> 4;
    const GAS v4u* bfr = (const GAS v4u*)(P.ws + WS_BTC) + lane;
    const float* cbias = (const float*)(P.ws + WS_CBIAS);
    int unit = blockIdx.x;
    if (unit >= NUNITS) return;
    f32x4 a_cur[8], a_n1[8], a_n2[8];
    const float* rb = cmp_rowbase<SAMPLE>(P, unit, rho) + 8 * kq;
#define CMP_LOAD(dst, base, r) do { _Pragma("unroll") for (int q_ = 0; q_ < 4; ++q_) { dst[2 * q_] = *(const GAS f32x4*)((base) + (r) * 256 + (q_ >> 1) * 128 + (q_ & 1) * 32); dst[2 * q_ + 1] = *(const GAS f32x4*)((base) + (r) * 256 + (q_ >> 1) * 128 + (q_ & 1) * 32 + 4); } } while (0)
    CMP_LOAD(a_cur, rb, 4 * w); CMP_LOAD(a_n1, rb, 4 * w + 1);
    for (;;) {
        f32x4 acc[2][4];
#pragma unroll
        for (int j = 0; j < 2; ++j)
#pragma unroll
            for (int e = 0; e < 4; ++e) acc[j][e] = (f32x4){0.f, 0.f, 0.f, 0.f};
        const int nunit = unit + F.G; const bool has_next = nunit < NUNITS;
        const float* rbn = has_next ? cmp_rowbase<SAMPLE>(P, nunit, rho) + 8 * kq : rb;
#pragma unroll 1
        for (int rr = 0; rr < 4; ++rr) {
            const int r = 4 * w + rr;
            bf16x8 bb[16];
#pragma unroll
            for (int q_ = 0; q_ < 4; ++q_)
#pragma unroll
                for (int et = 0; et < 4; ++et) bb[q_ * 4 + et] = __builtin_bit_cast(bf16x8, bfr[(size_t)(((((q_ >> 1) * 32 + r) * 2 + (q_ & 1)) * 4 + et) * 64)]);
            __builtin_amdgcn_sched_barrier(0);
            { const float* nb_ = rr < 2 ? rb : rbn; const int nr_ = rr < 2 ? r + 2 : 4 * w + (rr - 2); CMP_LOAD(a_n2, nb_, nr_); }
            __builtin_amdgcn_sched_barrier(0);
#pragma unroll
            for (int q_ = 0; q_ < 4; ++q_) { const int j = q_ >> 1;
                v4u wv; wv.x = pk2(a_cur[2 * q_].x, a_cur[2 * q_].y); wv.y = pk2(a_cur[2 * q_].z, a_cur[2 * q_].w); wv.z = pk2(a_cur[2 * q_ + 1].x, a_cur[2 * q_ + 1].y); wv.w = pk2(a_cur[2 * q_ + 1].z, a_cur[2 * q_ + 1].w);
                const bf16x8 af = __builtin_bit_cast(bf16x8, wv);
#pragma unroll
                for (int et = 0; et < 4; ++et) acc[j][et] = __builtin_amdgcn_mfma_f32_16x16x32_bf16(af, bb[q_ * 4 + et], acc[j][et], 0, 0, 0); }
#pragma unroll
            for (int q_ = 0; q_ < 8; ++q_) { a_cur[q_] = a_n1[q_]; a_n1[q_] = a_n2[q_]; }
        }
#pragma unroll
        for (int j = 0; j < 2; ++j)
#pragma unroll
            for (int et = 0; et < 4; ++et) *(LAS f32x4*)(part + ((w * 8 + j * 4 + et) * 64 + lane) * 4) = acc[j][et];
        __syncthreads();
        { const int j = w >> 2, et = w & 3, e = 16 * et + rho; f32x4 sum = *(const LAS f32x4*)(part + ((0 * 8 + w) * 64 + lane) * 4);
#pragma unroll
          for (int ww = 1; ww < 8; ++ww) sum = sum + *(const LAS f32x4*)(part + ((ww * 8 + w) * 64 + lane) * 4);
          const float bs = cbias[j * 64 + e]; const int b = SAMPLE ? unit >> 6 : unit >> 5, c0 = (SAMPLE ? (unit & 63) : (unit & 31)) * 8;
          float nmax = 0.f;
#pragma unroll
          for (int i = 0; i < 4; ++i) { const int row = 4 * kq + i, c = c0 + (row >> 1), g = row & 1; const float val = sum[i] + bs;
              float q2 = val * val; q2 += __shfl_xor(q2, 1); q2 += __shfl_xor(q2, 2); q2 += __shfl_xor(q2, 4); q2 += __shfl_xor(q2, 8); nmax = fmaxf(nmax, q2);
              if (SAMPLE) ((float*)(P.ws + WS_KCS))[((size_t)((b * 2 + g) * 2 + j) * NCS + c) * 64 + e] = val;
              else if (j == 0) ((bf16*)(P.ws + WS_KC))[((size_t)(b * 2 + g) * 256 + c) * 64 + e] = (bf16)f2bf(val);
              else ((bf16*)(P.ws + WS_VCT))[((size_t)(b * 2 + g) * 64 + e) * 256 + (c & ~15) + perm16(c & 15)] = (bf16)f2bf(val); }
          if (j == 0) { nmax = fmaxf(nmax, __shfl_xor(nmax, 16)); nmax = fmaxf(nmax, __shfl_xor(nmax, 32));
              if (lane == 0) atomicMax((unsigned*)(P.ws + WS_CTL) + CW_KCMAX + (SAMPLE ? 64 : 0) + et, __builtin_bit_cast(unsigned, nmax)); } }
        __syncthreads();
        if (!has_next) break;
        unit = nunit; rb = rbn;
    }
#undef CMP_LOAD
}
__device__ __forceinline__ void compress_sample_pass(const Ptrs& P, Frame& F, LAS unsigned char* bl  ) {
    const int lane = F.lane, w = F.wave, tid = F.tid, rho = lane & 15, kq = lane >> 4;
    for (int pass = blockIdx.x; pass < DECB * 8; pass += F.G) {
    __syncthreads();
    const int b = pass >> 3, c0 = (pass & 7) * 64 + w * 8;
    const float* rb; { const int c = c0 + (rho >> 1), g = rho & 1; const int page = P.page_table[b * NPAGES + (c >> 2)]; rb = P.cache_cmp + ((size_t)page * 128 + (c & 3) * 32) * 256 + g * 64 + 8 * kq; }
    const GAS v4u* bsrc = (const GAS v4u*)(P.ws + WS_BTC);
    const int sf = tid >> 5, sj = sf >> 3, sdh = (sf >> 2) & 1, set_ = sf & 3, sl = (tid & 31) * 2;
#define B_SRC(r) (bsrc + (size_t)((((sj * 32 + (r)) * 2 + sdh) * 4 + set_) * 64 + sl))
    LAS v4u* bdst = (LAS v4u*)bl + sf * 64 + sl;
    f32x4 a_cur[8], a_n1[8], a_n2[8];
#define CMP_LOAD(dst, base, r) do { _Pragma("unroll") for (int q_ = 0; q_ < 4; ++q_) { dst[2 * q_] = *(const GAS f32x4*)((base) + (r) * 256 + (q_ >> 1) * 128 + (q_ & 1) * 32); dst[2 * q_ + 1] = *(const GAS f32x4*)((base) + (r) * 256 + (q_ >> 1) * 128 + (q_ & 1) * 32 + 4); } } while (0)
    { const v4u b0 = B_SRC(0)[0], b1 = B_SRC(0)[1]; bdst[0] = b0; bdst[1] = b1; }
    CMP_LOAD(a_cur, rb, 0); CMP_LOAD(a_n1, rb, 1);
    f32x4 acc[2][4];
#pragma unroll
    for (int j = 0; j < 2; ++j)
#pragma unroll
        for (int e = 0; e < 4; ++e) acc[j][e] = (f32x4){0.f, 0.f, 0.f, 0.f};
    __syncthreads();
#pragma unroll 1
    for (int r = 0; r < 32; ++r) {
        const int rn = r + 1 < 32 ? r + 1 : 31, r2 = r + 2 < 32 ? r + 2 : 31;
        const v4u b0 = B_SRC(rn)[0], b1 = B_SRC(rn)[1];
        __builtin_amdgcn_sched_barrier(0);
        CMP_LOAD(a_n2, rb, r2);
        __builtin_amdgcn_sched_barrier(0);
        const LAS v4u* bf = (const LAS v4u*)bl + (r & 1) * 1024 + lane;
#pragma unroll
        for (int q_ = 0; q_ < 4; ++q_) { const int j = q_ >> 1;
            v4u wv; wv.x = pk2(a_cur[2 * q_].x, a_cur[2 * q_].y); wv.y = pk2(a_cur[2 * q_].z, a_cur[2 * q_].w); wv.z = pk2(a_cur[2 * q_ + 1].x, a_cur[2 * q_ + 1].y); wv.w = pk2(a_cur[2 * q_ + 1].z, a_cur[2 * q_ + 1].w);
            const bf16x8 af = __builtin_bit_cast(bf16x8, wv);
#pragma unroll
            for (int et = 0; et < 4; ++et) acc[j][et] = __builtin_amdgcn_mfma_f32_16x16x32_bf16(af, __builtin_bit_cast(bf16x8, bf[(q_ * 4 + et) * 64]), acc[j][et], 0, 0, 0); }
        { LAS v4u* d_ = bdst + ((r + 1) & 1) * 1024; d_[0] = b0; d_[1] = b1; }
#pragma unroll
        for (int q_ = 0; q_ < 8; ++q_) { a_cur[q_] = a_n1[q_]; a_n1[q_] = a_n2[q_]; }
        __syncthreads();
    }
#undef CMP_LOAD
#undef B_SRC
    const float* cbias = (const float*)(P.ws + WS_CBIAS);
    float nmax = 0.f;
#pragma unroll
    for (int i = 0; i < 4; ++i) { const int row = 4 * kq + i, c = c0 + (row >> 1), g = row & 1; float q2 = 0.f;
#pragma unroll
        for (int j = 0; j < 2; ++j)
#pragma unroll
            for (int et = 0; et < 4; ++et) { const int e = 16 * et + rho; const float val = acc[j][et][i] + cbias[j * 64 + e]; if (j == 0) q2 += val * val;
                ((float*)(P.ws + WS_KCS))[((size_t)((b * 2 + g) * 2 + j) * NCS + c) * 64 + e] = val; }
        q2 += __shfl_xor(q2, 1); q2 += __shfl_xor(q2, 2); q2 += __shfl_xor(q2, 4); q2 += __shfl_xor(q2, 8); nmax = fmaxf(nmax, q2); }
    nmax = fmaxf(nmax, __shfl_xor(nmax, 16)); nmax = fmaxf(nmax, __shfl_xor(nmax, 32));
    if (lane == 0) atomicMax((unsigned*)(P.ws + WS_CTL) + CW_KCMAX + 64, __builtin_bit_cast(unsigned, nmax));
    }
}
constexpr int P0_PRODUCERS = 641;
__device__ __forceinline__ void p0_small_items(const Ptrs& P, Frame& F) {
    const int lane = F.lane, gw = F.gw;
    if (gw >= P0_PRODUCERS && F.NGW >= P0_PRODUCERS) return;
    for (int item = gw; item < P0_PRODUCERS; item += F.NGW) {
        if (item < 512) { const int it = item * 64 + lane; const int l = it & 63, et = (it >> 6) & 3, dh = (it >> 8) & 1, r = (it >> 9) & 31, j = it >> 14;
            const float* w = P.cmp_w + ((size_t)(r * 2 + j) * 64 + 32 * dh + 8 * (l >> 4)) * 64 + 16 * et + (l & 15);
            v4u o; o.x = pk2(w[0], w[64]); o.y = pk2(w[128], w[192]); o.z = pk2(w[256], w[320]); o.w = pk2(w[384], w[448]);
            __builtin_amdgcn_raw_buffer_store_b128(o, __builtin_amdgcn_make_buffer_rsrc((void*)(P.ws + WS_BTC), 0, 512 * 1024, 0x00020000), it * 16, 0, 16);
        } else if (item < 640) { const int it = item - 512, j = it >> 6, e = it & 63; float s = 0.f;
            for (int k = lane; k < 2048; k += 64) { const int r = k >> 6, d = k & 63; s += P.cmp_pe[(r * 2 + j) * 64 + d] * P.cmp_w[((size_t)(r * 2 + j) * 64 + d) * 64 + e]; }
            s = wave_sum(s); if (lane == 0) __hip_atomic_store((float*)(P.ws + WS_CBIAS) + it, s, RLX_AGENT);
        } else { float qm = fabsf(P.q_gain[lane]), k1 = fabsf(P.k_gain[64 + lane]), k2 = fabsf(P.k_gain[128 + lane]);
#pragma unroll
            for (int o = 1; o < 64; o <<= 1) { qm = fmaxf(qm, __shfl_xor(qm, o)); k1 = fmaxf(k1, __shfl_xor(k1, o)); k2 = fmaxf(k2, __shfl_xor(k2, o)); }
            if (lane == 0) { float* cst = (float*)(P.ws + WS_CONST); __hip_atomic_store(cst + 0, qm, RLX_AGENT); __hip_atomic_store(cst + 1, 8.0f * qm * k1 * LOG2E * 1.001f, RLX_AGENT); __hip_atomic_store(cst + 2, 8.0f * qm * k2 * LOG2E * 1.001f, RLX_AGENT); } }
        asm volatile("s_waitcnt vmcnt(0)" ::: "memory");
        if (lane == 0) __hip_atomic_fetch_add((unsigned*)(F.ctl + CW_P0CNT), 1u, RLX_AGENT);
    }
}
__device__ __forceinline__ void p0_rope(const Ptrs& P, Frame& F) {
    const int lane = F.lane, gw = F.gw, NGW = F.NGW; const int i = lane & 31;
    const float inv = (float)pow(10000.0, -(double)i / 32.0);
    for (int it = gw * 64 + lane; it < 8193 * 32; it += NGW * 64) { const int p = it >> 5; const int pos = (p == 8192) ? PAST : p;
        const float ang = (float)pos * inv; const double rev = (double)ang * 0.15915494309189535; const float fr = (float)(rev - __builtin_rint(rev));
        float* rt = (float*)(P.ws + WS_ROPE) + (size_t)p * 64; rt[i] = __builtin_amdgcn_cosf(fr); rt[32 + i] = __builtin_amdgcn_sinf(fr); }
}
__device__ __forceinline__ void p0_phase(const Ptrs& P, Frame& F) {
    LAS float* scr = (LAS float*)(F.lds + RING_OFF + F.wave * 16384);
    const int lane = F.lane;
    p0_small_items(P, F);
    p0_rope(P, F);
    const int gw = F.gw, NGW = F.NGW;
    for (int it = gw; it < 16 * 128; it += NGW) { const int kb = it >> 7, dg = it & 127; int nv; const int src0 = bt1_src(dg, nv);
        p0_transpose_item(P.w_in, INW, 64 * kb, src0, nv, P.norm_g, (bf16*)(P.ws + WS_BT1), D, 32 * dg, scr, lane); }
    for (int it = gw; it < 16 * 32; it += NGW) { const int kb = it >> 5, nb = it & 31;
        p0_transpose_item(P.w_out, D, 64 * kb, 32 * nb, 32, nullptr, (bf16*)(P.ws + WS_BT2), D, 32 * nb, scr, lane); }
    for (int m = gw * 4; m < M; m += NGW * 4) x_rows_to_bf16<4>(P.xp + (size_t)m * D, (bf16*)(P.ws + WS_XB) + (size_t)m * D, (float*)(P.ws + WS_RSTD) + m, lane);
    for (int m = gw; m < DECB; m += NGW) x_rows_to_bf16<1>(P.xs + (size_t)m * D, (bf16*)(P.ws + WS_XSB) + (size_t)m * D, (float*)(P.ws + WS_RSTDS) + m, lane);
    { constexpr int PERB = 511 * 64, TOTAL = DECB * PERB; const GAS f32x4* src = (const GAS f32x4*)P.st_win; GAS f32x4* dst = (GAS f32x4*)(P.out + O_SWIN);
      for (int i0 = gw * 64 + lane; i0 < TOTAL; i0 += NGW * 64 * 8) { f32x4 t[8];
#pragma unroll
        for (int u = 0; u < 8; ++u) { const int i = i0 + u * NGW * 64; if (i < TOTAL) { const int b = i / PERB; t[u] = src[i + 64 * b + 64]; } }
#pragma unroll
        for (int u = 0; u < 8; ++u) { const int i = i0 + u * NGW * 64; if (i < TOTAL) { const int b = i / PERB; dst[i + 64 * b] = t[u]; } } } }
    for (int it = gw * 64 + lane; it < DECB * 512; it += NGW * 64) { const int b = it >> 9, ch = it & 511; P.out[O_SCONV + (size_t)b * 1024 + ch] = P.st_conv[(size_t)b * 1024 + 512 + ch]; }
    if (F.wave == 0) { if (lane == 0) { unsigned sp = 0u; while (__hip_atomic_load((unsigned*)(F.ctl + CW_P0CNT), RLX_AGENT) < (unsigned)P0_PRODUCERS) { __builtin_amdgcn_s_sleep(2); if (++sp > (1u << 22)) break; } }
        __builtin_amdgcn_fence(__ATOMIC_ACQUIRE, "agent"); asm volatile("s_waitcnt vmcnt(0)" ::: "memory"); }
    __syncthreads();
    compress_sample_pass(P, F, F.lds + RING_OFF);
}
struct EpiIn {
    static constexpr bool PERM = false, AFTER_DRAIN = false;
    const float *rstd, *rope, *qg, *kg; float* out; unsigned char* ws;
    __device__ __forceinline__ void operator()(const f32x4 (&acc)[2][2][4][2], const pg8::Unit& u, int wr, int wc, int fr, int fq) const {
        asm volatile("" : "+v"(fr), "+v"(fq));
        const int pn = u.pn; const int rbase = u.pm * 256 + wr * 64 + fr;
        if (pn < 8) {
            const bool bz = pn < 4; bf16* dst = (bf16*)(ws + (bz ? WS_CG : WS_U)); const int col0 = 128 * (pn & 3) + 32 * wc + 4 * fq;
#pragma unroll
            for (int ai = 0; ai < 2; ++ai)
#pragma unroll
                for (int m = 0; m < 4; ++m) { const int row = rbase + ai * 128 + m * 16; const float rs = rstd[row];
#pragma unroll
                    for (int n = 0; n < 2; ++n) { const f32x4 a = acc[ai][0][m][n] * rs, z = acc[ai][1][m][n] * rs; f32x4 o;
                        if (bz) { o.x = a.x * z.x * sigmoidf(z.x); o.y = a.y * z.y * sigmoidf(z.y); o.z = a.z * z.z * sigmoidf(z.z); o.w = a.w * z.w * sigmoidf(z.w); }
                        else o = a * z;
                        v2u w; w.x = pk2(o.x, o.y); w.y = pk2(o.z, o.w);
                        *(GAS v2u*)(dst + (size_t)row * 512 + col0 + 16 * n) = w;
                        if (!bz) { const int t = row & (T - 1); if (t >= T - 2) *(GAS f32x4*)(out + O_PCONV + ((size_t)(row >> 13) * 2 + (t - (T - 2))) * 512 + col0 + 16 * n) = o; } } }
        } else if (pn < 13) {
            const bool isq = pn < 10; const int br = pn - 10; const bool isk = !isq && wc < 2;
            if (isq || isk) {
                const float* gain = isq ? qg : kg + br * 64; float g1[2][4], g2[2][4];
#pragma unroll
                for (int n = 0; n < 2; ++n)
#pragma unroll
                    for (int e = 0; e < 4; ++e) { g1[n][e] = gain[16 * n + 4 * fq + e]; g2[n][e] = gain[32 + 16 * n + 4 * fq + e]; }
#pragma unroll
                for (int ai = 0; ai < 2; ++ai)
#pragma unroll
                    for (int m = 0; m < 4; ++m) { const int row = rbase + ai * 128 + m * 16; const float rs = rstd[row]; const int t = row & (T - 1), b = row >> 13;
                        f32x4 x1[2], x2[2]; float ss = 0.f;
#pragma unroll
                        for (int n = 0; n < 2; ++n) { x1[n] = acc[ai][0][m][n] * rs; x2[n] = acc[ai][1][m][n] * rs;
                            ss += (x1[n].x * x1[n].x + x1[n].y * x1[n].y) + (x1[n].z * x1[n].z + x1[n].w * x1[n].w) + (x2[n].x * x2[n].x + x2[n].y * x2[n].y) + (x2[n].z * x2[n].z + x2[n].w * x2[n].w); }
                        ss += __shfl_xor(ss, 16); ss += __shfl_xor(ss, 32);
                        const float inv = 1.0f / sqrtf(ss * (1.0f / 64.0f) + NORM_EPS);
                        const float* rp = rope + (size_t)t * 64 + 4 * fq;
#pragma unroll
                        for (int n = 0; n < 2; ++n) { const f32x4 cs = *(const GAS f32x4*)(rp + 16 * n), sn = *(const GAS f32x4*)(rp + 32 + 16 * n); f32x4 o1, o2;
#pragma unroll
                            for (int e = 0; e < 4; ++e) { const float a = x1[n][e] * inv * g1[n][e], c = x2[n][e] * inv * g2[n][e]; o1[e] = a * cs[e] - c * sn[e]; o2[e] = c * cs[e] + a * sn[e]; }
                            const int d1 = 16 * n + 4 * fq;
                            if (isq) { o1 = o1 * QSCALE; o2 = o2 * QSCALE; bf16* q = (bf16*)(ws + WS_Q) + (size_t)row * 512 + (4 * (pn - 8) + wc) * 64 + d1;
                                v2u w; w.x = pk2(o1.x, o1.y); w.y = pk2(o1.z, o1.w); *(GAS v2u*)q = w; w.x = pk2(o2.x, o2.y); w.y = pk2(o2.z, o2.w); *(GAS v2u*)(q + 32) = w; }
                            else { const int g = wc;
                                if (br > 0) { bf16* k = (bf16*)(ws + (br == 1 ? WS_KS : WS_KW)) + ((size_t)(b * 2 + g) * T + t) * 64 + d1;
                                    v2u w; w.x = pk2(o1.x, o1.y); w.y = pk2(o1.z, o1.w); *(GAS v2u*)k = w; w.x = pk2(o2.x, o2.y); w.y = pk2(o2.z, o2.w); *(GAS v2u*)(k + 32) = w; }
                                if (br < 2) { float* o = out + (br == 0 ? O_PCMP : O_PSLC) + (size_t)row * 256 + g * 64 + d1; *(GAS f32x4*)o = o1; *(GAS f32x4*)(o + 32) = o2; }
                                else if (t >= T - 512) { float* o = out + O_PWIN + ((size_t)b * 512 + (t - (T - 512))) * 256 + g * 64 + d1; *(GAS f32x4*)o = o1; *(GAS f32x4*)(o + 32) = o2; } } } }
            } else {
                const int g = wc - 2;
#pragma unroll
                for (int ai = 0; ai < 2; ++ai)
#pragma unroll
                    for (int m = 0; m < 4; ++m) { const int row = rbase + ai * 128 + m * 16; const float rs = rstd[row]; const int t = row & (T - 1), b = row >> 13;
                        const int tk = t & 63, vpos = (tk & ~15) + perm16(tk & 15);
                        bf16* vt = (br > 0) ? (bf16*)(ws + (br == 1 ? WS_VTS : WS_VTW)) + ((size_t)((b * 2 + g) * 128 + (t >> 6)) * 64) * 64 + vpos : nullptr;
#pragma unroll
                        for (int bj = 0; bj < 2; ++bj)
#pragma unroll
                            for (int n = 0; n < 2; ++n) { const f32x4 v = acc[ai][bj][m][n] * rs; const int d1 = 32 * bj + 16 * n + 4 * fq;
                                if (br > 0) {
#pragma unroll
                                    for (int e = 0; e < 4; ++e) vt[(size_t)(d1 + e) * 64] = (bf16)f2bf(v[e]); }
                                if (br < 2) *(GAS f32x4*)(out + (br == 0 ? O_PCMP : O_PSLC) + (size_t)row * 256 + 128 + g * 64 + d1) = v;
                                else if (t >= T - 512) *(GAS f32x4*)(out + O_PWIN + ((size_t)b * 512 + (t - (T - 512))) * 256 + 128 + g * 64 + d1) = v; } }
            }
        } else if (pn < 15) {
            bf16* dst = (bf16*)(ws + WS_ZA);
#pragma unroll
            for (int ai = 0; ai < 2; ++ai)
#pragma unroll
                for (int m = 0; m < 4; ++m) { const int row = rbase + ai * 128 + m * 16; const float rs = rstd[row];
#pragma unroll
                    for (int bj = 0; bj < 2; ++bj)
#pragma unroll
                        for (int n = 0; n < 2; ++n) { const f32x4 z = acc[ai][bj][m][n] * rs; v2u w; w.x = pk2(z.x * sigmoidf(z.x), z.y * sigmoidf(z.y)); w.y = pk2(z.z * sigmoidf(z.z), z.w * sigmoidf(z.w));
                            *(GAS v2u*)(dst + (size_t)row * 512 + 256 * (pn - 13) + 128 * bj + 32 * wc + 16 * n + 4 * fq) = w; } }
        } else {
            if (wc == 0) { float* dst = (float*)(ws + WS_GATE);
#pragma unroll
                for (int ai = 0; ai < 2; ++ai)
#pragma unroll
                    for (int m = 0; m < 4; ++m) { const int row = rbase + ai * 128 + m * 16; const float rs = rstd[row];
#pragma unroll
                        for (int n = 0; n < 2; ++n) { const int c0 = 16 * n + 4 * fq; if (c0 < 24) { const f32x4 z = acc[ai][0][m][n] * rs;
                            *(GAS f32x4*)(dst + (size_t)row * 24 + c0) = (f32x4){sigmoidf(z.x), sigmoidf(z.y), sigmoidf(z.z), sigmoidf(z.w)}; } } } }
        }
    }
};
struct EpiOut {
    static constexpr bool PERM = false, AFTER_DRAIN = false;
    const float* x; float* y;
    __device__ __forceinline__ void operator()(const f32x4 (&acc)[2][2][4][2], const pg8::Unit& u, int wr, int wc, int fr, int fq) const {
        asm volatile("" : "+v"(fr), "+v"(fq));
#pragma unroll
        for (int ai = 0; ai < 2; ++ai)
#pragma unroll
            for (int m = 0; m < 4; ++m) { const size_t row = (size_t)u.pm * 256 + ai * 128 + wr * 64 + m * 16 + fr;
#pragma unroll
                for (int bj = 0; bj < 2; ++bj)
#pragma unroll
                    for (int n = 0; n < 2; ++n) { const size_t off = row * D + u.pn * 256 + 128 * bj + 32 * wc + 16 * n + 4 * fq;
                        *(GAS f32x4*)(y + off) = *(const GAS f32x4*)(x + off) + acc[ai][bj][m][n]; } }
    }
};
template <int MODE>
__device__ __forceinline__ void small_gemm_tile(const Ptrs& P, const bf16* A, const bf16* Bt, int ct, int lane) {
    const int rho = lane & 15, kq = lane >> 4;
    f32x4 acc[2] = {(f32x4){0.f, 0.f, 0.f, 0.f}, (f32x4){0.f, 0.f, 0.f, 0.f}};
    const GAS v4u* a0 = (const GAS v4u*)(A + (size_t)rho * D + 8 * kq); const GAS v4u* a1 = (const GAS v4u*)(A + (size_t)(16 + rho) * D + 8 * kq);
    const GAS v4u* bp = (const GAS v4u*)(Bt + (size_t)(16 * ct + rho) * D + 8 * kq);
#pragma unroll 8
    for (int ks = 0; ks < 32; ++ks) { const bf16x8 bb = __builtin_bit_cast(bf16x8, bp[ks * 4]);
        acc[0] = __builtin_amdgcn_mfma_f32_16x16x32_bf16(bb, __builtin_bit_cast(bf16x8, a0[ks * 4]), acc[0], 0, 0, 0);
        acc[1] = __builtin_amdgcn_mfma_f32_16x16x32_bf16(bb, __builtin_bit_cast(bf16x8, a1[ks * 4]), acc[1], 0, 0, 0); }
#pragma unroll
    for (int rt = 0; rt < 2; ++rt) { const int b = 16 * rt + rho; const int col = 16 * ct + 4 * kq;
        if (MODE == 0) { const float rs = ((const float*)(P.ws + WS_RSTDS))[b]; *(GAS f32x4*)((float*)(P.ws + WS_PROJS) + (size_t)b * NP + col) = acc[rt] * rs; }
        else *(GAS f32x4*)(P.out + O_YS + (size_t)b * D + col) = *(const GAS f32x4*)(P.xs + (size_t)b * D + col) + acc[rt]; }
}
__device__ __forceinline__ int projs_col(int pn, int wc, int d) { return 256 * pn + 128 * (d >> 5) + 32 * wc + (d & 31); }
__device__ __forceinline__ void p2_sample_item(const Ptrs& P, int it, int lane) {
    const int b = it / 37, ty = it - b * 37;
    const float* pr = (const float*)(P.ws + WS_PROJS) + (size_t)b * NP;
    const float* ropes = (const float*)(P.ws + WS_ROPE) + (size_t)8192 * 64;
    float* kvn = (float*)(P.ws + WS_KVN) + (size_t)b * 768;
    if (ty < 14) {
        const bool isq = ty < 8; const int br = isq ? 0 : (ty - 8) >> 1, g = (ty - 8) & 1;
        const int pn = isq ? 8 + (ty >> 2) : 10 + br, wc = isq ? (ty & 3) : g;
        const float v = pr[projs_col(pn, wc, lane)];
        const float ss = wave_sum(v * v); const float inv = 1.0f / sqrtf(ss * (1.0f / 64.0f) + NORM_EPS);
        const float gn = isq ? P.q_gain[lane] : P.k_gain[br * 64 + lane];
        const float xn = v * inv * gn; const float xo = __shfl_xor(xn, 32);
        const int i = lane & 31; const float cs = ropes[i], sn = ropes[32 + i];
        const float o = (lane < 32) ? xn * cs - xo * sn : xn * cs + xo * sn;
        if (isq) ((float*)(P.ws + WS_QS))[(size_t)b * 512 + ty * 64 + lane] = o * QSCALE;
        else { kvn[(br * 2 + 0) * 128 + g * 64 + lane] = o;
            if (br == 0) P.out[O_SCMP + (size_t)b * 256 + g * 64 + lane] = o; else if (br == 1) P.out[O_SSLC + (size_t)b * 256 + g * 64 + lane] = o;
            else P.out[O_SWIN + ((size_t)b * 512 + 511) * 256 + g * 64 + lane] = o; }
    } else if (ty < 20) {
        const int br = (ty - 14) >> 1, g = (ty - 14) & 1; const float v = pr[projs_col(10 + br, 2 + g, lane)];
        kvn[(br * 2 + 1) * 128 + g * 64 + lane] = v;
        if (br == 0) P.out[O_SCMP + (size_t)b * 256 + 128 + g * 64 + lane] = v; else if (br == 1) P.out[O_SSLC + (size_t)b * 256 + 128 + g * 64 + lane] = v;
        else P.out[O_SWIN + ((size_t)b * 512 + 511) * 256 + 128 + g * 64 + lane] = v;
    } else if (ty == 20) {
        if (lane < 24) ((float*)(P.ws + WS_GS))[b * 24 + lane] = sigmoidf(pr[256 * 15 + lane]);
    } else if (ty < 29) {
        const int ch = (ty - 21) * 64 + lane; const int pnb = ch >> 7, tc = ch & 127;
        const float bg = pr[256 * pnb + tc], zc = pr[256 * pnb + 128 + tc], cg = pr[256 * (4 + pnb) + tc], ci = pr[256 * (4 + pnb) + 128 + tc];
        const float u = cg * ci; const float s0 = P.st_conv[(size_t)b * 1024 + ch], s1 = P.st_conv[(size_t)b * 1024 + 512 + ch];
        const float cy = P.conv_w[ch] * s0 + P.conv_w[512 + ch] * s1 + P.conv_w[1024 + ch] * u + P.conv_b[ch];
        ((bf16*)(P.ws + WS_MIXS))[(size_t)b * 1024 + ch] = (bf16)f2bf(bg * cy * zc * sigmoidf(zc));
        P.out[O_SCONV + (size_t)b * 1024 + 512 + ch] = u;
    } else {
        const int col = (ty - 29) * 64 + lane; const float z = pr[256 * (13 + (col >> 8)) + (col & 255)];
        ((float*)(P.ws + WS_ZAS))[(size_t)b * 512 + col] = z * sigmoidf(z);
    }
}
__device__ __forceinline__ void p2_phase(const Ptrs& P, Frame& F) {
    compress_units<false>(P, F, (LAS float*)(F.lds + RING_OFF));
    for (int it = F.gw; it < DECB * 37; it += F.NGW) p2_sample_item(P, it, F.lane);
}
#define MFMA32(a, b, c) __builtin_amdgcn_mfma_f32_32x32x16_bf16(a, b, c, 0, 0, 0)
constexpr int P3_IMP = 0, P3_QL = 32768;
constexpr int P3_NEXT = LDSCTL_OFF + 512, P3_CNT = LDSCTL_OFF + 1024, P3_LISTS = LDSCTL_OFF + 2048, P3_LACC = LDSCTL_OFF + 10240;
constexpr int P3_RING = 65536;
constexpr int P3_MISC = MISC_OFF + 64;
constexpr int SM_Q = 36864, SM_P = 40960, SM_RED = 57344, SM_IMP = 66048, SM_L = 67200, SM_SEL = 67328, SM_O = 67584, SM_VP = 71680  , SM_RED2 = 79872  ;

template <bool MASK>
__device__ __forceinline__ void attend_lds(const LAS unsigned char* blk, const bf16x8 (&qf)[4], f32x16 (&O)[2], float& lsum,
                                           int kbase, int lo, int hi, int lane, bool want_pv, f32x16 (*Sout)[2] = nullptr) {
    const int r = lane & 31, hh = lane >> 5, swz = (r >> 1) & 7;
    const LAS unsigned char* kb = blk + r * 128; const LAS unsigned char* vb = blk + 8192 + r * 128;
#pragma unroll
    for (int kt = 0; kt < 2; ++kt) {
        f32x16 S;
        { bf16x8 kf[4];
#pragma unroll
          for (int s = 0; s < 4; ++s) kf[s] = *(const LAS bf16x8*)(kb + kt * 4096 + (((2 * s + hh) ^ swz) << 4));
#pragma unroll
          for (int i = 0; i < 16; ++i) S[i] = 0.f;
#pragma unroll
          for (int s = 0; s < 4; ++s) S = MFMA32(kf[s], qf[s], S); }
#pragma unroll
        for (int i = 0; i < 16; ++i) { float p = fast_exp2(S[i]);
            if (MASK) { const int kp = kbase + 32 * kt + (i & 3) + 8 * (i >> 2) + 4 * hh; p = (kp >= lo && kp <= hi) ? p : 0.f; }
            S[i] = p; lsum += p; }
        if (Sout) (*Sout)[kt] = S;
        if (want_pv) {
            bf16x8 pf[2];
#pragma unroll
            for (int sp = 0; sp < 2; ++sp) { v4u w; w.x = pk2(S[8 * sp + 0], S[8 * sp + 1]); w.y = pk2(S[8 * sp + 2], S[8 * sp + 3]);
                w.z = pk2(S[8 * sp + 4], S[8 * sp + 5]); w.w = pk2(S[8 * sp + 6], S[8 * sp + 7]); pf[sp] = __builtin_bit_cast(bf16x8, w); }
#pragma unroll
            for (int dt = 0; dt < 2; ++dt)
#pragma unroll
                for (int sp = 0; sp < 2; ++sp) { const bf16x8 vf = *(const LAS bf16x8*)(vb + dt * 4096 + (((2 * (2 * kt + sp) + hh) ^ swz) << 4));
                    O[dt] = MFMA32(vf, pf[sp], O[dt]); }
        }
    }
}
__device__ __forceinline__ void wave_topk(const LAS float* imp, int jmax, int nsel, int lane, int qbase, LAS unsigned* cnt, LAS unsigned char* lists) {
    if (jmax < 1) return;
    const bool c0 = lane >= 1 && lane <= jmax, c1 = 64 + lane <= jmax;
    unsigned k0[8], k1[8], Tv[8];
#pragma unroll
    for (int qi = 0; qi < 8; ++qi) { k0[qi] = c0 ? ((__builtin_bit_cast(unsigned, imp[qi * 128 + lane]) + 0x800u) & ~0x7ffu) : 0u; k1[qi] = c1 ? ((__builtin_bit_cast(unsigned, imp[qi * 128 + 64 + lane]) + 0x800u) & ~0x7ffu) : 0u; Tv[qi] = 0u; }
    if (jmax > nsel) {
        for (int bit = 30; bit >= 11; --bit) {
#pragma unroll
            for (int qi = 0; qi < 8; ++qi) { const unsigned cand = Tv[qi] | (1u << bit);
                const int cn = __popcll(__ballot(k0[qi] >= cand)) + __popcll(__ballot(k1[qi] >= cand)); Tv[qi] = cn >= nsel ? cand : Tv[qi]; } }
    }
    const unsigned long long below = (lane == 0) ? 0ull : (~0ull >> (64 - lane));
#pragma unroll
    for (int qi = 0; qi < 8; ++qi) {
        bool s0, s1;
        if (jmax > nsel) {
            const unsigned long long g0 = __ballot(k0[qi] > Tv[qi]), g1 = __ballot(k1[qi] > Tv[qi]), e0 = __ballot(k0[qi] == Tv[qi]), e1 = __ballot(k1[qi] == Tv[qi]);
            const int need = nsel - __popcll(g0) - __popcll(g1);
            const int rk0 = __popcll(e0 & below), rk1 = __popcll(e0) + __popcll(e1 & below);
            s0 = k0[qi] > Tv[qi] || (k0[qi] == Tv[qi] && rk0 < need); s1 = k1[qi] > Tv[qi] || (k1[qi] == Tv[qi] && rk1 < need);
        } else { s0 = c0; s1 = c1; }
        if (s0) { const unsigned pos = __hip_atomic_fetch_add(cnt + lane, 1u, __ATOMIC_RELAXED, __HIP_MEMORY_SCOPE_WORKGROUP); lists[lane * 64 + pos] = (unsigned char)(qbase + qi); }
        if (s1) { const unsigned pos = __hip_atomic_fetch_add(cnt + 64 + lane, 1u, __ATOMIC_RELAXED, __HIP_MEMORY_SCOPE_WORKGROUP); lists[(64 + lane) * 64 + pos] = (unsigned char)(qbase + qi); }
    }
}
struct BlkSrc { const bf16* k; const bf16* v; int vstride; };
#ifndef PROBE_SEG
#define PROBE_SEG 0
#endif
#define T_BEGIN(id) do { if (PROBE_SEG == (id)) tacc -= __builtin_readcyclecounter(); } while (0)
#define T_END(id) do { if (PROBE_SEG == (id)) tacc += __builtin_readcyclecounter(); } while (0)
__device__ __forceinline__ void p3_prompt_unit(const Ptrs& P, Frame& F, int b, int t, int g, float sh_cmp, float sh_slc, float sh_win, unsigned long long& tacc) {
    int lane = F.lane, w = F.wave, tid = F.tid; asm volatile("" : "+v"(lane), "+s"(w), "+v"(tid));
    const int col = lane & 31, hh = lane >> 5, qi = col >> 2, h = col & 3;
    const int tok = 64 * t + 8 * w + qi; const size_t row = (size_t)b * T + tok; const int qpos = tok;
    const int nck = (2 * t + 2 + 63) >> 6, nf = t >= 2 ? 3 : t + 1, nw = t >= 8 ? 9 : t + 1;
    const int n1 = nck, n2 = 2 * nck, N1 = n2 + nf;
    const bf16* KC = (const bf16*)(P.ws + WS_KC) + (size_t)(b * 2 + g) * 256 * 64; const bf16* VCT = (const bf16*)(P.ws + WS_VCT) + (size_t)(b * 2 + g) * 64 * 256;
    const bf16* KS = (const bf16*)(P.ws + WS_KS) + (size_t)(b * 2 + g) * T * 64; const bf16* VTS = (const bf16*)(P.ws + WS_VTS) + (size_t)(b * 2 + g) * 128 * 4096;
    const bf16* KW = (const bf16*)(P.ws + WS_KW) + (size_t)(b * 2 + g) * T * 64; const bf16* VTW = (const bf16*)(P.ws + WS_VTW) + (size_t)(b * 2 + g) * 128 * 4096;
    auto src1 = [&](int n) -> BlkSrc {
        if (n < n2) { const int ck = n < n1 ? n : n - n1; return BlkSrc{KC + (size_t)ck * 4096, VCT + ck * 64, 256}; }
        const int f = n - n2; const int j = f == 0 ? t : (f == 1 ? 0 : t - 1); return BlkSrc{KS + (size_t)j * 4096, VTS + (size_t)j * 4096, 64}; };
    auto src2 = [&](int n) -> BlkSrc { const int j = (t >= 8 ? t - 8 : 0) + n; return BlkSrc{KW + (size_t)j * 4096, VTW + (size_t)j * 4096, 64}; };
    const int srow = 8 * w + (lane >> 3), sch = (lane & 7) ^ ((srow >> 1) & 7);
    LAS unsigned char* ring = F.lds + P3_RING;
#define ST_DMA(bs_, n) do { LAS unsigned char* d_ = ring + ((n) & 3) * 16384 + w * 1024; \
        __builtin_amdgcn_global_load_lds((const unsigned*)((bs_).k + srow * 64 + sch * 8), (LAS unsigned*)d_, 16, 0, 0); \
        __builtin_amdgcn_global_load_lds((const unsigned*)((bs_).v + (size_t)srow * (bs_).vstride + sch * 8), (LAS unsigned*)(d_ + 8192), 16, 0, 0); } while (0)
#define BLK(n) (ring + ((n) & 3) * 16384)
#define STEP_BEGIN(SRC, n, NN) do { if (((n) & 1) == 0) { if ((n) + 2 < (NN)) { const BlkSrc b_ = SRC((n) + 2); ST_DMA(b_, (n) + 2); } if ((n) + 3 < (NN)) { const BlkSrc b_ = SRC((n) + 3); ST_DMA(b_, (n) + 3); } } } while (0)
#define STEP_END(n, NN) do { if (((n) & 1) == 1 || (n) == (NN) - 1) { asm volatile("s_waitcnt vmcnt(0)" ::: "memory"); __syncthreads(); } } while (0)
    LAS unsigned* cnt = (LAS unsigned*)(F.lds + P3_CNT); LAS unsigned char* lists = F.lds + P3_LISTS; LAS unsigned* nextb = (LAS unsigned*)(F.lds + P3_NEXT);
    LAS int* oacc = (LAS int*)ring; LAS float* lacc = (LAS float*)(F.lds + P3_LACC);
    const float FXS = fast_exp2(18.0f - sh_slc), FXI = 1.0f / FXS;
    LAS unsigned char* ql = F.lds + P3_QL;
    T_BEGIN(1); T_BEGIN(8);
    __syncthreads();
    if (tid < 128) cnt[tid] = 0u; if (tid == 128) nextb[0] = 0u;
    { const BlkSrc b0 = src1(0); ST_DMA(b0, 0); if (N1 > 1) { const BlkSrc b1 = src1(1); ST_DMA(b1, 1); } }
    { const bf16* qg = (const bf16*)(P.ws + WS_Q) + ((size_t)b * T + 64 * t) * 512 + g * 256;
      v4u tq[4];
#pragma unroll
      for (int k = 0; k < 4; ++k) { const int c = tid + 512 * k, rq = c >> 3, ch = c & 7; tq[k] = *(const GAS v4u*)(qg + (size_t)(rq >> 2) * 512 + (rq & 3) * 64 + ch * 8); }
#pragma unroll
      for (int k = 0; k < 4; ++k) { const int c = tid + 512 * k, rq = c >> 3, ch = c & 7; *(LAS v4u*)(ql + rq * 128 + ((ch ^ ((rq >> 1) & 7)) << 4)) = tq[k]; } }
    bf16x8 qf[4];
    { const bf16* q = (const bf16*)(P.ws + WS_Q) + row * 512 + (g * 4 + h) * 64 + 8 * hh;
#pragma unroll
      for (int s = 0; s < 4; ++s) qf[s] = __builtin_bit_cast(bf16x8, *(const GAS v4u*)(q + 16 * s)); }
    const float* gate = (const float*)(P.ws + WS_GATE) + row * 24 + (g * 4 + h) * 3;
    const float g_cmp = gate[0], g_slc = gate[1], g_win = gate[2];
    asm volatile("s_waitcnt vmcnt(0)" ::: "memory"); __syncthreads();
    T_END(1); T_BEGIN(2);
    f32x16 O[2];
    LAS float* wl = (LAS float*)(F.lds + P3_IMP + w * 4096);
    float* totg = (float*)(P.ws + WS_TOT) + ((size_t)blockIdx.x * 8 + w) * 2048 + lane;
    const int nvis = (qpos + 1) >> 5;
    int n = 0;
    float lsum = 0.f;
    for (; n < n1; ++n) { STEP_BEGIN(src1, n, N1); attend_lds<true>(BLK(n), qf, O, lsum, 64 * n, 0, nvis - 1, lane, false); STEP_END(n, N1); }
    lsum += __shfl_xor(lsum, 32);
    const float rl = lsum > 0.f ? 1.0f / lsum : 0.f;
    for (int i = lane; i < 1024; i += 64) wl[i] = 0.f;
#pragma unroll
    for (int i = 0; i < 16; ++i) { O[0][i] = 0.f; O[1][i] = 0.f; }
    { float dummy = 0.f;
      for (; n < n2; ++n) { STEP_BEGIN(src1, n, N1); const int ck = n - n1; f32x16 Sn[2];
        attend_lds<true>(BLK(n), qf, O, dummy, 64 * ck, 0, nvis - 1, lane, true, &Sn);
#pragma unroll
        for (int kt = 0; kt < 2; ++kt)
#pragma unroll
            for (int i2 = 0; i2 < 8; ++i2) { float v = (Sn[kt][2 * i2] + Sn[kt][2 * i2 + 1]) * rl; v += __shfl_xor(v, 1); v += __shfl_xor(v, 2);
                if (h == 0) wl[qi * 128 + 32 * ck + 16 * kt + (i2 & 1) + 4 * (i2 >> 1) + 2 * hh] = v; }
        STEP_END(n, N1); } }
    LDS_WAIT(); asm volatile("" ::: "memory");
    T_END(2); T_BEGIN(3);
    wave_topk(wl, t - 2, 13, lane, 8 * w, cnt, lists);
#pragma unroll
    for (int i = 0; i < 16; ++i) { totg[i * 64] = O[0][i] * (g_cmp * rl); totg[(16 + i) * 64] = O[1][i] * (g_cmp * rl); O[0][i] = 0.f; O[1][i] = 0.f; }
    T_END(3); T_BEGIN(4);
    lsum = 0.f;
    for (; n < N1; ++n) { STEP_BEGIN(src1, n, N1);
        if (n == n2) attend_lds<true>(BLK(n), qf, O, lsum, 64 * t, 0, qpos, lane, true);
        else attend_lds<false>(BLK(n), qf, O, lsum, 0, 0, 0, lane, true);
        STEP_END(n, N1); }
    lsum += __shfl_xor(lsum, 32);
#pragma unroll
    for (int dt = 0; dt < 2; ++dt)
#pragma unroll
        for (int i = 0; i < 16; ++i) oacc[(32 * dt + (i & 3) + 8 * (i >> 2) + 4 * hh) * 256 + 32 * w + col] = __float2int_rn(O[dt][i] * FXS);
    if (hh == 0) lacc[32 * w + col] = lsum;
    __syncthreads();
    T_END(4); T_BEGIN(5);
    if (t > 2) {
        const int r = lane & 31;
#define NEXT_BLOCK(jv_, nq_) do { for (;;) { unsigned t_ = 0u; if (lane == 0) t_ = __hip_atomic_fetch_add(nextb, 1u, __ATOMIC_RELAXED, __HIP_MEMORY_SCOPE_WORKGROUP); \
            jv_ = 1 + (int)__builtin_amdgcn_readfirstlane(t_); if (jv_ > t - 2) { nq_ = 0; break; } nq_ = (int)__builtin_amdgcn_readfirstlane(cnt[jv_]); if (nq_ > 0) break; } } while (0)
#define LOAD_FRAGS(kd_, vd_, jv_) do { const bf16* kp_ = KS + (size_t)(jv_) * 4096 + r * 64 + 8 * hh; const bf16* vp_ = VTS + (size_t)(jv_) * 4096 + r * 64 + 8 * hh; \
            _Pragma("unroll") for (int a_ = 0; a_ < 2; ++a_) _Pragma("unroll") for (int b_ = 0; b_ < 4; ++b_) { kd_[a_][b_] = __builtin_bit_cast(bf16x8, *(const GAS v4u*)(kp_ + a_ * 2048 + 16 * b_)); \
                vd_[a_][b_] = __builtin_bit_cast(bf16x8, *(const GAS v4u*)(vp_ + a_ * 2048 + 16 * b_)); } } while (0)
        bf16x8 kf[2][4], vf[2][4], kn[2][4], vn[2][4];
        int j, nq; NEXT_BLOCK(j, nq);
        if (j <= t - 2) LOAD_FRAGS(kf, vf, j);
        while (j <= t - 2) {
            int jn, nqn; NEXT_BLOCK(jn, nqn);
            if (jn <= t - 2) LOAD_FRAGS(kn, vn, jn);
#pragma unroll
            for (int a_ = 0; a_ < 2; ++a_)
#pragma unroll
                for (int b_ = 0; b_ < 4; ++b_) asm volatile("" : "+v"(kf[a_][b_]), "+v"(vf[a_][b_]));
            for (int c0 = 0; c0 < nq; c0 += 8) {
                const int sl = c0 + qi; const bool valid = sl < nq;
                const int rowq = (int)lists[j * 64 + (valid ? sl : nq - 1)] * 4 + h;
                const LAS unsigned char* qp = ql + rowq * 128; const int qsw = (rowq >> 1) & 7;
                bf16x8 q2[4];
#pragma unroll
                for (int s = 0; s < 4; ++s) q2[s] = *(const LAS bf16x8*)(qp + (((2 * s + hh) ^ qsw) << 4));
                float l2 = 0.f; bf16x8 pf[4];
#pragma unroll
                for (int kt = 0; kt < 2; ++kt) { f32x16 S;
#pragma unroll
                    for (int i = 0; i < 16; ++i) S[i] = 0.f;
#pragma unroll
                    for (int s = 0; s < 4; ++s) S = MFMA32(kf[kt][s], q2[s], S);
#pragma unroll
                    for (int i = 0; i < 16; ++i) { S[i] = fast_exp2(S[i]); l2 += S[i]; }
#pragma unroll
                    for (int sp = 0; sp < 2; ++sp) { v4u wv; wv.x = pk2(S[8 * sp + 0], S[8 * sp + 1]); wv.y = pk2(S[8 * sp + 2], S[8 * sp + 3]);
                        wv.z = pk2(S[8 * sp + 4], S[8 * sp + 5]); wv.w = pk2(S[8 * sp + 6], S[8 * sp + 7]); pf[2 * kt + sp] = __builtin_bit_cast(bf16x8, wv); } }
                l2 += __shfl_xor(l2, 32);
                T_BEGIN(9);
#pragma unroll
                for (int dt = 0; dt < 2; ++dt) { f32x16 O2;
#pragma unroll
                    for (int i = 0; i < 16; ++i) O2[i] = 0.f;
#pragma unroll
                    for (int ks = 0; ks < 4; ++ks) O2 = MFMA32(vf[dt][ks], pf[ks], O2);
                    if (valid) {
#pragma unroll
                        for (int i = 0; i < 16; ++i) (void)__hip_atomic_fetch_add(oacc + (32 * dt + (i & 3) + 8 * (i >> 2) + 4 * hh) * 256 + rowq, __float2int_rn(O2[i] * FXS), __ATOMIC_RELAXED, __HIP_MEMORY_SCOPE_WORKGROUP); } }
                if (valid) {
                    if (hh == 0) (void)__hip_atomic_fetch_add(lacc + rowq, l2, __ATOMIC_RELAXED, __HIP_MEMORY_SCOPE_WORKGROUP); }
                LDS_WAIT(); T_END(9);
            }
            j = jn; nq = nqn;
#pragma unroll
            for (int a_ = 0; a_ < 2; ++a_)
#pragma unroll
                for (int b_ = 0; b_ < 4; ++b_) { kf[a_][b_] = kn[a_][b_]; vf[a_][b_] = vn[a_][b_]; }
        }
#undef NEXT_BLOCK
#undef LOAD_FRAGS
    }
    __syncthreads();
    T_END(5); T_BEGIN(6);
    LAS float* x0 = (LAS float*)(F.lds + P3_IMP + w * 4096) + lane; LAS float* x1 = (LAS float*)(F.lds + P3_QL + w * 4096) + lane;
    { const float sc = g_slc / fmaxf(lacc[32 * w + col], 1e-30f);
#pragma unroll
      for (int i = 0; i < 16; ++i) { const int dr = (i & 3) + 8 * (i >> 2) + 4 * hh;
          x0[i * 64] = totg[i * 64] + (float)oacc[dr * 256 + 32 * w + col] * (FXI * sc); x1[i * 64] = totg[(16 + i) * 64] + (float)oacc[(32 + dr) * 256 + 32 * w + col] * (FXI * sc); O[0][i] = 0.f; O[1][i] = 0.f; } }
    LDS_WAIT(); __syncthreads();
    { const BlkSrc b0 = src2(0); ST_DMA(b0, 0); if (nw > 1) { const BlkSrc b1 = src2(1); ST_DMA(b1, 1); } }
    { asm volatile("" : "+v"(lane));
      const bf16* q = (const bf16*)(P.ws + WS_Q) + row * 512 + (g * 4 + h) * 64 + 8 * hh;
#pragma unroll
      for (int s = 0; s < 4; ++s) qf[s] = __builtin_bit_cast(bf16x8, *(const GAS v4u*)(q + 16 * s)); }
    asm volatile("s_waitcnt vmcnt(0)" ::: "memory"); __syncthreads();
    lsum = 0.f;
    for (n = 0; n < nw; ++n) { STEP_BEGIN(src2, n, nw); const int j = (t >= 8 ? t - 8 : 0) + n;
        if (j == t || j + 8 == t) attend_lds<true>(BLK(n), qf, O, lsum, 64 * j, qpos - 511, qpos, lane, true);
        else attend_lds<false>(BLK(n), qf, O, lsum, 0, 0, 0, lane, true);
        STEP_END(n, nw); }
    lsum += __shfl_xor(lsum, 32);
    { const float sc = g_win / fmaxf(lsum, 1e-30f);
#pragma unroll
      for (int i = 0; i < 16; ++i) { O[0][i] = x0[i * 64] + O[0][i] * sc; O[1][i] = x1[i * 64] + O[1][i] * sc; } }
#undef ST_DMA
#undef BLK
#undef STEP_BEGIN
#undef STEP_END
    T_END(6); T_BEGIN(7);
    asm volatile("" : "+v"(lane));
    const int col_ = lane & 31, hh_ = lane >> 5, h_ = col_ & 3; const size_t row_ = (size_t)b * T + 64 * t + 8 * w + (col_ >> 2);
    const bf16* za = (const bf16*)(P.ws + WS_ZA) + row_ * 512 + (g * 4 + h_) * 64; bf16* mx = (bf16*)(P.ws + WS_MIX) + row_ * 1024 + 512 + (g * 4 + h_) * 64;
#pragma unroll
    for (int dt = 0; dt < 2; ++dt)
#pragma unroll
        for (int i4 = 0; i4 < 4; ++i4) { const int d = 32 * dt + 8 * i4 + 4 * hh_; const v2u z = *(const GAS v2u*)(za + d);
            v2u o; o.x = pk2(O[dt][4 * i4] * bf2f(z.x & 0xffffu), O[dt][4 * i4 + 1] * bf2f(z.x >> 16)); o.y = pk2(O[dt][4 * i4 + 2] * bf2f(z.y & 0xffffu), O[dt][4 * i4 + 3] * bf2f(z.y >> 16));
            *(GAS v2u*)(mx + d) = o; }
    if (g == 0) { const int tq = w, c8 = lane * 8; const size_t r0 = (size_t)b * T + 64 * t + 8 * tq;
        const bf16* U = (const bf16*)(P.ws + WS_U) + c8; const bf16* CGp = (const bf16*)(P.ws + WS_CG) + c8; bf16* mo = (bf16*)(P.ws + WS_MIX) + c8;
        v4u ur[10], cr[8];
        const bool has_prev = (t > 0) || (tq > 0);
#pragma unroll
        for (int i = 0; i < 10; ++i) ur[i] = (i >= 2 || has_prev) ? *(const GAS v4u*)(U + (r0 + i - 2) * 512) : (v4u){0u, 0u, 0u, 0u};
#pragma unroll
        for (int i = 0; i < 8; ++i) cr[i] = *(const GAS v4u*)(CGp + (r0 + i) * 512);
        float w0[8], w1[8], w2[8], cb[8];
#pragma unroll
        for (int e = 0; e < 8; ++e) { w0[e] = P.conv_w[c8 + e]; w1[e] = P.conv_w[512 + c8 + e]; w2[e] = P.conv_w[1024 + c8 + e]; cb[e] = P.conv_b[c8 + e]; }
#pragma unroll
        for (int i = 0; i < 8; ++i) { float o[8];
#pragma unroll
            for (int e = 0; e < 8; ++e) { const int sh_ = (e & 1) * 16; const float a = bf2f((ur[i][e >> 1] >> sh_) & 0xffffu), bb = bf2f((ur[i + 1][e >> 1] >> sh_) & 0xffffu), c = bf2f((ur[i + 2][e >> 1] >> sh_) & 0xffffu);
                o[e] = bf2f((cr[i][e >> 1] >> sh_) & 0xffffu) * (w0[e] * a + w1[e] * bb + w2[e] * c + cb[e]); }
            v4u ov; ov.x = pk2(o[0], o[1]); ov.y = pk2(o[2], o[3]); ov.z = pk2(o[4], o[5]); ov.w = pk2(o[6], o[7]);
            *(GAS v4u*)(mo + (r0 + i) * 1024) = ov; } }
    T_END(7); T_END(8);
}
template <class KeyFn>
__device__ __forceinline__ void sample_branch(Frame& F, int nslots, float shift, const KeyFn& key, LAS float* obr) {
    LAS float* q = (LAS float*)(F.lds + SM_Q); LAS float* Pb = (LAS float*)(F.lds + SM_P); LAS float* red = (LAS float*)(F.lds + SM_RED); LAS float* lsm = (LAS float*)(F.lds + SM_L);
    LAS unsigned long long* vptr = (LAS unsigned long long*)(F.lds + SM_VP);
    float lacc[4] = {0.f, 0.f, 0.f, 0.f};
    for (int s = F.tid; s < nslots; s += 512) { const float* kp; const float* vp; const bool valid = key(s, kp, vp);
        float sc[4] = {0.f, 0.f, 0.f, 0.f};
        if (valid) {
#pragma unroll 4
            for (int d4 = 0; d4 < 16; ++d4) { const f32x4 kv = *(const GAS f32x4*)(kp + 4 * d4);
#pragma unroll
                for (int hq = 0; hq < 4; ++hq) { const f32x4 qv = *(const LAS f32x4*)(q + hq * 64 + 4 * d4); sc[hq] += (kv.x * qv.x + kv.y * qv.y) + (kv.z * qv.z + kv.w * qv.w); } } }
        f32x4 p;
#pragma unroll
        for (int hq = 0; hq < 4; ++hq) { p[hq] = valid ? fast_exp2(sc[hq] - shift) : 0.f; lacc[hq] += p[hq]; }
        *(LAS f32x4*)(Pb + 4 * s) = p; vptr[s] = (unsigned long long)(uintptr_t)vp; }
#pragma unroll
    for (int hq = 0; hq < 4; ++hq) { lacc[hq] = wave_sum(lacc[hq]); if (F.lane == 0) red[F.wave * 4 + hq] = lacc[hq]; }
    __syncthreads();
    if (F.tid < 4) { float s = 0.f; for (int ww = 0; ww < 8; ++ww) s += red[ww * 4 + F.tid]; lsm[F.tid] = s; }
    const int sg = F.tid >> 4, d4 = F.tid & 15;
    f32x4 oa[4];
#pragma unroll
    for (int hq = 0; hq < 4; ++hq) oa[hq] = (f32x4){0.f, 0.f, 0.f, 0.f};
    for (int s0 = sg; s0 < nslots; s0 += 256) {
        f32x4 vv[8], pp[8];
#pragma unroll
        for (int u = 0; u < 8; ++u) { const int s = s0 + 32 * u; const float* vp = (const float*)(uintptr_t)vptr[s]; vv[u] = *(const GAS f32x4*)(vp + 4 * d4); pp[u] = *(const LAS f32x4*)(Pb + 4 * s); }
#pragma unroll
        for (int u = 0; u < 8; ++u) { oa[0] = oa[0] + vv[u] * pp[u].x; oa[1] = oa[1] + vv[u] * pp[u].y; oa[2] = oa[2] + vv[u] * pp[u].z; oa[3] = oa[3] + vv[u] * pp[u].w; } }
    __syncthreads();
    LAS float* red2 = (LAS float*)(F.lds + SM_RED2);
#pragma unroll
    for (int hq = 0; hq < 4; ++hq) *(LAS f32x4*)(red2 + (sg * 4 + hq) * 64 + 4 * d4) = oa[hq];
    __syncthreads();
    if (F.tid < 256) { float s = 0.f;
#pragma unroll 8
        for (int g2 = 0; g2 < 32; ++g2) s += red2[g2 * 256 + F.tid]; obr[F.tid] = s; }
    __syncthreads();
}
__device__ __forceinline__ void p3_sample_unit(const Ptrs& P, Frame& F, int b, int g) {
    asm volatile("" : "+v"(F.tid), "+v"(F.lane), "+s"(F.wave));
    LAS float* q = (LAS float*)(F.lds + SM_Q); LAS float* Pb = (LAS float*)(F.lds + SM_P); LAS float* imp = (LAS float*)(F.lds + SM_IMP); LAS float* lsm = (LAS float*)(F.lds + SM_L);
    LAS int* sel = (LAS int*)(F.lds + SM_SEL); LAS float* osm = (LAS float*)(F.lds + SM_O);
    const float* cst = (const float*)(P.ws + WS_CONST);
    float kcmax = 0.f; for (int e_ = 0; e_ < 4; ++e_) kcmax += __builtin_bit_cast(float, __hip_atomic_load((unsigned*)(P.ws + WS_CTL) + CW_KCMAX + 64 + e_, RLX_AGENT));
    const float sh_cmp = cst[0] * sqrtf(kcmax) * LOG2E * 1.001f, sh_slc = cst[1], sh_win = cst[2];
    if (F.tid < 256) q[F.tid] = ((const float*)(P.ws + WS_QS))[(size_t)b * 512 + g * 256 + F.tid];
    __syncthreads();
    const float* kcs = (const float*)(P.ws + WS_KCS) + (size_t)(b * 2 + g) * 2 * NCS * 64;
    sample_branch(F, NCS, sh_cmp, [&](int s, const float*& kp, const float*& vp) { kp = kcs + (size_t)s * 64; vp = kcs + (size_t)(NCS + s) * 64; return true; }, osm);
    { const f32x4 p = *(const LAS f32x4*)(Pb + 4 * F.tid); float v = p.x / lsm[0] + p.y / lsm[1] + p.z / lsm[2] + p.w / lsm[3]; v += __shfl_xor(v, 1);
      if ((F.tid & 1) == 0) imp[F.tid >> 1] = v; if (F.tid < 4) imp[256 + F.tid] = 0.f; }
    if (F.tid < 256) osm[F.tid] = osm[F.tid] / lsm[F.tid >> 6];
    __syncthreads();
    if (F.wave == 0) { const int lane = F.lane; unsigned k[4];
#pragma unroll
        for (int i = 0; i < 4; ++i) { const int j = lane + 64 * i; k[i] = (j >= 1 && j <= 254) ? __builtin_bit_cast(unsigned, imp[j]) + 1u : 0u; }
        unsigned Tv = 0u;
        for (int bit = 30; bit >= 0; --bit) { const unsigned cand = Tv | (1u << bit); int cnt = 0;
#pragma unroll
            for (int i = 0; i < 4; ++i) cnt += __popcll(__ballot(k[i] >= cand));
            if (cnt >= 13) Tv = cand; }
        int ngt = 0;
#pragma unroll
        for (int i = 0; i < 4; ++i) ngt += __popcll(__ballot(k[i] > Tv));
        const int need = 13 - ngt; const unsigned long long below = (lane == 0) ? 0ull : (~0ull >> (64 - lane));
        int base = 3, eqbase = 0;
        if (lane == 0) { int z_ = 0; asm volatile("" : "+v"(z_)); sel[0] = z_; sel[1] = z_ + 255; sel[2] = z_ + 256; }
#pragma unroll
        for (int i = 0; i < 4; ++i) { const unsigned long long e = __ballot(k[i] == Tv); const int rk = eqbase + __popcll(e & below); const bool on = k[i] > Tv || (k[i] == Tv && rk < need);
            const unsigned long long m = __ballot(on); if (on) sel[base + __popcll(m & below)] = lane + 64 * i; base += __popcll(m); eqbase += __popcll(e); } }
    __syncthreads();
    const float* kvn = (const float*)(P.ws + WS_KVN) + (size_t)b * 768;
    const int* pt = P.page_table + b * NPAGES; const float* cs = P.cache_slc;
    sample_branch(F, 1024, sh_slc, [&](int s, const float*& kp, const float*& vp) { const int j = sel[s >> 6], rr = s & 63;
        if (j == 256) { kp = kvn + (1 * 2 + 0) * 128 + g * 64; vp = kvn + (1 * 2 + 1) * 128 + g * 64; return rr == 0; }
        const float* rowp = cs + ((size_t)pt[j >> 1] * 128 + (j & 1) * 64 + rr) * 256 + g * 64; kp = rowp; vp = rowp + 128; return true; }, osm + 256);
    if (F.tid < 256) osm[256 + F.tid] = osm[256 + F.tid] / lsm[F.tid >> 6];
    __syncthreads();
    const float* stw = P.st_win + (size_t)b * 512 * 256;
    sample_branch(F, 512, sh_win, [&](int s, const float*& kp, const float*& vp) {
        if (s == 511) { kp = kvn + (2 * 2 + 0) * 128 + g * 64; vp = kvn + (2 * 2 + 1) * 128 + g * 64; return true; }
        const float* rowp = stw + (size_t)(s + 1) * 256 + g * 64; kp = rowp; vp = rowp + 128; return true; }, osm + 512);
    if (F.tid < 256) { const int hq = F.tid >> 6, d = F.tid & 63; const float* gs = (const float*)(P.ws + WS_GS) + b * 24 + (g * 4 + hq) * 3;
        const float o = gs[0] * osm[F.tid] + gs[1] * osm[256 + F.tid] + gs[2] * osm[512 + F.tid] / lsm[hq];
        ((bf16*)(P.ws + WS_MIXS))[(size_t)b * 1024 + 512 + (g * 4 + hq) * 64 + d] = (bf16)f2bf(o * ((const float*)(P.ws + WS_ZAS))[(size_t)b * 512 + (g * 4 + hq) * 64 + d]); }
    __syncthreads();
}
__device__ __forceinline__ void p3_phase(const Ptrs& P, Frame& F, int rep) {
    const float* cst = (const float*)(P.ws + WS_CONST);
    float kcmax = 0.f; for (int e_ = 0; e_ < 4; ++e_) kcmax += __builtin_bit_cast(float, __hip_atomic_load((unsigned*)(P.ws + WS_CTL) + CW_KCMAX + e_, RLX_AGENT));
    const float sh_cmp = cst[0] * sqrtf(kcmax) * LOG2E * 1.001f, sh_slc = cst[1], sh_win = cst[2];
    unsigned long long tacc = 0ull;
    volatile LAS int* qw = (volatile LAS int*)(F.lds + P3_MISC);
#ifndef PROBE_P3
#define PROBE_P3 0
#endif
    constexpr int NS_ = PROBE_P3 == 1 ? 16 : 8, PSH_ = PROBE_P3 == 2 ? 1 : 0;
    constexpr int NQ = NS_ + (128 << PSH_);
    const int x0 = (int)(xb_xcc_id() & 7u);
    for (int xi = 0; xi < 8; ++xi) {
        const int x = (x0 + xi) & 7;
        for (;;) {
            __syncthreads();
            if (F.tid == 0) qw[0] = (int)__hip_atomic_fetch_add((unsigned*)(F.ctl + CW_QUEUE + 64 * (x + 8 * rep)), 1u, RLX_AGENT);
            __syncthreads();
            const int idx = qw[0];
            if (idx >= NQ) break;
            if (idx < NS_) p3_sample_unit(P, F, x * 4 + ((idx & 7) >> 1), idx & 1);
            else p3_prompt_unit(P, F, x >> 1, 127 - ((idx - NS_) >> PSH_), x & 1, sh_cmp, sh_slc, sh_win, tacc);
        }
    }
    if (PROBE_SEG != 0 && blockIdx.x == 0) { const unsigned long long t0_ = __builtin_readcyclecounter(); while (__builtin_readcyclecounter() - t0_ < tacc) __builtin_amdgcn_s_sleep(8); }
}
#ifndef MK_N_LAUNCHES
#define MK_N_LAUNCHES 1
#endif
constexpr int N_PHASES = 5;
constexpr int N_LAUNCHES = MK_N_LAUNCHES;
struct Args { Ptrs p; int ph_lo, ph_hi, rep, mode; };
__global__ void __launch_bounds__(NWAVES * 64, 2) nsa_fwd(Args args) {
    extern __shared__ __attribute__((aligned(16))) unsigned char lds[];
    const Ptrs& P = args.p;
    Frame F;
    F.lds = (LAS unsigned char*)lds;
    F.MISC = (volatile LAS unsigned*)(F.lds + MISC_OFF);
    F.tid = threadIdx.x; F.lane = F.tid & 63; F.wave = __builtin_amdgcn_readfirstlane(F.tid >> 6);
    F.G = gridDim.x; F.gw = blockIdx.x * NWAVES + F.wave; F.NGW = F.G * NWAVES;
    F.ctl = (gu32*)(P.ws + WS_CTL);
    for (int u = F.tid; u < (LDS_BYTES - LDSCTL_OFF) / 4; u += NWAVES * 64) ((LAS unsigned*)(F.lds + LDSCTL_OFF))[u] = 0u;
    __syncthreads();
    XcdBarrier bar; bar.bar = (unsigned*)(F.ctl + CW_BAR); bar.x = 0; bar.st = nullptr;
    if (N_LAUNCHES == 1) bar = xcd_barrier_post((unsigned*)(F.ctl + CW_BAR), F.MISC + 8);
    const int lo = args.ph_lo, hi = args.ph_hi;
    unsigned long long tprobe = 0ull;
#define IN(k) (lo <= (k) && (k) < hi)
#define FENCE() do { asm volatile("" : "+s"(F.wave), "+s"(F.gw)); F.lane = (int)__builtin_amdgcn_mbcnt_hi(~0u, __builtin_amdgcn_mbcnt_lo(~0u, 0u)); F.tid = F.wave * 64 + F.lane; asm volatile("" : "+v"(F.tid), "+v"(F.lane)); } while (0)
#define SEAM(k) do { if (IN(k) && IN((k) + 1)) xcd_barrier(bar, F.wave == 0 && (int)__builtin_amdgcn_mbcnt_hi(~0u, __builtin_amdgcn_mbcnt_lo(~0u, 0u)) == 0); } while (0)

    if (IN(0)) { FENCE(); p0_phase(P, F); } SEAM(0);
    if (IN(1)) { FENCE();
        pg8::Gemm g{(const pg8::bf16_t*)(P.ws + WS_XB), (const pg8::bf16_t*)(P.ws + WS_BT1), M, NP, D}; pg8::StaticOrder S; S.init(M, NP, F.G, (int)blockIdx.x);
        EpiIn E{(const float*)(P.ws + WS_RSTD), (const float*)(P.ws + WS_ROPE), P.q_gain, P.k_gain, P.out, P.ws};
        pg8::gemm_phase<EpiIn, pg8::StaticOrder, true, true>(F.lds + RING_OFF, g, S, E, F.wave, tprobe);
        FENCE();
        for (int ct = F.gw; ct < NP / 16; ct += F.NGW) small_gemm_tile<0>(P, (const bf16*)(P.ws + WS_XSB), (const bf16*)(P.ws + WS_BT1), ct, F.lane);
#if defined(PROBE_EPI)
        if (PROBE_EPI == 1 && blockIdx.x == 0) { const unsigned long long t0_ = __builtin_readcyclecounter(); while (__builtin_readcyclecounter() - t0_ < tprobe) __builtin_amdgcn_s_sleep(8); }
        tprobe = 0ull;
#endif
    } SEAM(1);
    if (IN(2)) { FENCE(); p2_phase(P, F); } SEAM(2);
    if (IN(3)) { FENCE(); p3_phase(P, F, args.rep); } SEAM(3);
    if (IN(4)) { FENCE();
        pg8::Gemm g{(const pg8::bf16_t*)(P.ws + WS_MIX), (const pg8::bf16_t*)(P.ws + WS_BT2), M, D, D}; pg8::StaticOrder S; S.init(M, D, F.G, (int)blockIdx.x);
        EpiOut E{P.xp, P.out + O_Y};
        pg8::gemm_phase<EpiOut, pg8::StaticOrder, true, true>(F.lds + RING_OFF, g, S, E, F.wave, tprobe);
        FENCE();
        for (int ct = F.gw; ct < D / 16; ct += F.NGW) small_gemm_tile<1>(P, (const bf16*)(P.ws + WS_MIXS), (const bf16*)(P.ws + WS_BT2), ct, F.lane);
#if defined(PROBE_EPI)
        if (PROBE_EPI == 2 && blockIdx.x == 0) { const unsigned long long t0_ = __builtin_readcyclecounter(); while (__builtin_readcyclecounter() - t0_ < tprobe) __builtin_amdgcn_s_sleep(8); }
#endif
    }
#undef IN
#undef SEAM
}

extern "C" void kernel_launch(void* const* d_in, const int* in_sizes, int n_in, void* d_out, int out_size, void* d_ws, size_t ws_size, hipStream_t stream) {
    static int grid = 0;
    if (grid == 0) {
        if (n_in != 16 || out_size != (int)O_END || ws_size < WS_END) { fprintf(stderr, "kernel_launch: unexpected shapes (n_in %d, out %d, ws %zu)\n", n_in, out_size, ws_size); grid = -1; return; }
        int dev = 0, cus = 0, per_cu = 0;
        if (hipGetDevice(&dev) != hipSuccess || hipDeviceGetAttribute(&cus, hipDeviceAttributeMultiprocessorCount, dev) != hipSuccess) { grid = -1; return; }
        if (hipFuncSetAttribute((const void*)nsa_fwd, hipFuncAttributeMaxDynamicSharedMemorySize, LDS_BYTES) != hipSuccess) { fprintf(stderr, "kernel_launch: hipFuncSetAttribute failed\n"); grid = -1; return; }
        if (hipOccupancyMaxActiveBlocksPerMultiprocessor(&per_cu, (const void*)nsa_fwd, NWAVES * 64, LDS_BYTES) != hipSuccess || per_cu < 1)
            fprintf(stderr, "kernel_launch: note: occupancy query reports %d workgroups per CU\n", per_cu);
        (void)hipGetLastError();
        grid = cus;
    }
    if (grid < 0) return;
    if (hipMemsetAsync((char*)d_ws + WS_CTL, 0, CTL_ZERO_BYTES, stream) != hipSuccess) return;
    Args a{}; a.mode = 3;
    a.p.xp = (const float*)d_in[0]; a.p.xs = (const float*)d_in[1]; a.p.cache_cmp = (const float*)d_in[2]; a.p.cache_slc = (const float*)d_in[3];
    a.p.st_win = (const float*)d_in[4]; a.p.st_conv = (const float*)d_in[5]; a.p.page_table = (const int*)d_in[6]; a.p.norm_g = (const float*)d_in[7];
    a.p.w_in = (const float*)d_in[8]; a.p.conv_w = (const float*)d_in[9]; a.p.conv_b = (const float*)d_in[10]; a.p.q_gain = (const float*)d_in[11];
    a.p.k_gain = (const float*)d_in[12]; a.p.cmp_pe = (const float*)d_in[13]; a.p.cmp_w = (const float*)d_in[14]; a.p.w_out = (const float*)d_in[15];
    a.p.out = (float*)d_out; a.p.ws = (unsigned char*)d_ws;
#ifndef PROBE_DUP
#define PROBE_DUP -1
#endif
    for (int li = 0; li < N_LAUNCHES; ++li) {
        a.ph_lo = (N_LAUNCHES == 1) ? 0 : li; a.ph_hi = (N_LAUNCHES == 1) ? N_PHASES : li + 1;
        for (int rep = 0; rep < ((N_LAUNCHES > 1 && li == PROBE_DUP) ? 2 : 1); ++rep) {
            a.rep = rep;
            hipLaunchKernelGGL(nsa_fwd, dim3(grid), dim3(NWAVES * 64), LDS_BYTES, stream, a);
            const hipError_t le = hipPeekAtLastError();
            if (le != hipSuccess) { fprintf(stderr, "kernel_launch: launch %d failed: %s\n", li, hipGetErrorName(le)); break; }
        }
    }
}
```

```cpp
#include <hip/hip_runtime.h>
#include <cstdio>
#include <cstdint>
#define GAS __attribute__((address_space(1)))
#define LAS __attribute__((address_space(3)))
typedef unsigned short bf16;
typedef unsigned v4u __attribute__((ext_vector_type(4)));
typedef unsigned v2u __attribute__((ext_vector_type(2)));
typedef float f32x2 __attribute__((ext_vector_type(2)));
typedef float f32x16 __attribute__((ext_vector_type(16)));
typedef GAS unsigned gu32;
typedef GAS unsigned long long gu64;
#define RLX_AGENT __ATOMIC_RELAXED, __HIP_MEMORY_SCOPE_AGENT
#define LDS_WAIT() asm volatile("s_waitcnt lgkmcnt(0)" ::: "memory")
#define VM_WAIT() asm volatile("s_waitcnt vmcnt(0)" ::: "memory")
#define MK_N_LAUNCHES 1
#define PROBE_DUP -1
#define PROBE_P3 0
#define PROBE_SEG 0
namespace pg8 {
#define PG8_LAS __attribute__((address_space(3)))
typedef unsigned short bf16_t;
typedef short bf16x8 __attribute__((ext_vector_type(8)));
typedef float f32x4 __attribute__((ext_vector_type(4)));
typedef unsigned u32x4 __attribute__((ext_vector_type(4)));
constexpr int BM = 256, BK = 64, HALF = 128, HTB = HALF * BK * 2  , STAGE_BYTES = 8 * HTB, NXCD = 8, WGM = 8;

__host__ __device__ __forceinline__ int lds_byte(int r, int c) { const int st = (r >> 4) * 2 + (c >> 5), rr = r & 15, cc = c & 31, ob = rr * 64 + cc * 2; return st * 1024 + (ob ^ (((ob >> 9) & 1) << 5)); }
__host__ __device__ __forceinline__ void stage_rc(int b, int& R, int& C) { const int st = b / 1024, sb = b % 1024, swz = sb ^ (((sb >> 9) & 1) << 5); R = (st >> 1) * 16 + swz / 64; C = (st & 1) * 32 + (swz % 64) / 2; }
__host__ __device__ __forceinline__ int perm32(int rho) { const int n = rho >> 4, i = rho & 15; return 8 * (i >> 2) + 4 * n + (i & 3); }

struct Unit { int pm, pn; };
struct Gemm { const bf16_t* A; const bf16_t* Bt; int M, N, K; };

struct StaticOrder {
    int nM, nN, nwg, G, c;
    __host__ __device__ void init(int M, int N, int G_, int c_) { nM = M / BM; nN = N / BM; nwg = nM * nN; G = G_; c = c_; }
    __host__ __device__ bool next(int i, Unit& u) const {
        const long L = (long)i * G + c; if (L >= nwg) return false;
        int wgid = (int)L; { const int q = nwg / NXCD, r = nwg % NXCD, xcd = wgid % NXCD, off = wgid / NXCD; wgid = (xcd < r ? xcd * (q + 1) : r * (q + 1) + (xcd - r) * q) + off; }
        const int nig = WGM * nN, gid = wgid / nig, fm = gid * WGM, gsz = (nM - fm) < WGM ? (nM - fm) : WGM;
        u.pm = fm + ((wgid % nig) % gsz); u.pn = (wgid % nig) / gsz; return true;
    }
    __device__ __forceinline__ void a_ready(const Unit&) const {}
    __device__ __forceinline__ void done(const Unit&) const {}
};


template <class Epi, class Sched, bool ALIGN_EPI = false, bool SP2 = false>
__device__ __forceinline__ void gemm_phase(PG8_LAS unsigned char* lds, const Gemm g, const Sched& S, const Epi& E, int wave_id  , unsigned long long& tacc_  ) {
    const int lane = (int)__builtin_amdgcn_mbcnt_hi(~0u, __builtin_amdgcn_mbcnt_lo(~0u, 0u)), wid = wave_id, tid = wid * 64 + lane, wr = wid >> 2, wc = wid & 3, fr = lane & 15, fq = lane >> 4;
    const int K = g.K, nt = K / BK;
    unsigned voffA[2], voffB[2];
#pragma unroll
    for (int i = 0; i < 2; ++i) { int R, C; stage_rc(tid * 16 + i * 8192, R, C); const int Rb = Epi::PERM ? ((R & ~31) + perm32(R & 31)) : R;
        voffA[i] = (unsigned)(R * K + C) * 2u; voffB[i] = (unsigned)(Rb * K + C) * 2u; }
    const size_t kstep = (size_t)(BK * 2);
    const size_t hstep = (size_t)HALF * K * 2;
    const size_t tstep = 2 * hstep;
    const unsigned ldsw = (unsigned)wid * 1024u;
    const int aoff = lds_byte(wr * 64 + fr, fq * 8), boff = lds_byte(wc * 32 + fr, fq * 8);
#define PG8_SA(b, h) (((b) * 2 + (h)) * HTB)
#define PG8_SB(b, h) ((4 + (b) * 2 + (h)) * HTB)
#define PG8_STAGE(bufoff, gbase, voff) do { _Pragma("unroll") for (int _i = 0; _i < 2; ++_i) \
        __builtin_amdgcn_global_load_lds((const unsigned*)((const char*)(gbase) + (voff)[_i]), (PG8_LAS unsigned*)(lds + (bufoff) + ldsw + _i * 8192), 16, 0, 0); } while (0)
#define PG8_LDA(dst, b, h) do { _Pragma("unroll") for (int m = 0; m < 4; ++m) _Pragma("unroll") for (int k = 0; k < 2; ++k) dst[m][k] = *(const PG8_LAS bf16x8*)(lds + PG8_SA(b, h) + aoff + m * 2048 + k * 1024); } while (0)
#define PG8_LDB(dst, b, h) do { _Pragma("unroll") for (int n = 0; n < 2; ++n) _Pragma("unroll") for (int k = 0; k < 2; ++k) dst[n][k] = *(const PG8_LAS bf16x8*)(lds + PG8_SB(b, h) + boff + n * 2048 + k * 1024); } while (0)
#define PG8_MMA(ai, bj, At, Bt) do { __builtin_amdgcn_s_setprio(1); _Pragma("unroll") for (int m = 0; m < 4; ++m) _Pragma("unroll") for (int n = 0; n < 2; ++n) _Pragma("unroll") for (int k = 0; k < 2; ++k) \
        acc[ai][bj][m][n] = __builtin_amdgcn_mfma_f32_16x16x32_bf16(Bt[n][k], At[m][k], acc[ai][bj][m][n], 0, 0, 0); __builtin_amdgcn_s_setprio(0); } while (0)
#define PG8_WAIT_V(n) asm volatile("s_waitcnt vmcnt(" #n ")" ::: "memory")
#define PG8_WAIT_L(n) asm volatile("s_waitcnt lgkmcnt(" #n ")" ::: "memory")
#define PG8_BAR __builtin_amdgcn_s_barrier()
#define PG8_SCHED __builtin_amdgcn_sched_barrier(0)
    Unit cur, nxt; int ui = 0;
    if (!S.next(0, cur)) return;
    f32x4 acc[2][2][4][2];
#pragma unroll
    for (int a = 0; a < 2; ++a)
#pragma unroll
        for (int b = 0; b < 2; ++b)
#pragma unroll
            for (int m = 0; m < 4; ++m)
#pragma unroll
                for (int n = 0; n < 2; ++n) acc[a][b][m][n] = (f32x4){0.f, 0.f, 0.f, 0.f};
    bf16x8 At[4][2], B0[2][2], B1[2][2];
    const char* cA = (const char*)g.A + (size_t)cur.pm * tstep; const char* cB = (const char*)g.Bt + (size_t)cur.pn * tstep;
    S.a_ready(cur);
    if constexpr (SP2) {
        PG8_STAGE(PG8_SB(0, 0), cB, voffB); PG8_STAGE(PG8_SB(0, 1), cB + hstep, voffB); PG8_STAGE(PG8_SA(0, 0), cA, voffA); PG8_STAGE(PG8_SA(0, 1), cA + hstep, voffA);
        if (wr == 1) PG8_BAR;
        PG8_WAIT_V(2); PG8_BAR;
        PG8_STAGE(PG8_SB(1, 0), cB + kstep, voffB); PG8_STAGE(PG8_SA(1, 0), cA + kstep, voffA); PG8_STAGE(PG8_SB(1, 1), cB + hstep + kstep, voffB);
        PG8_WAIT_V(6); PG8_BAR;
    } else {
        PG8_STAGE(PG8_SB(0, 0), cB, voffB); PG8_STAGE(PG8_SA(0, 0), cA, voffA); PG8_STAGE(PG8_SB(0, 1), cB + hstep, voffB); PG8_STAGE(PG8_SA(0, 1), cA + hstep, voffA);
        if (wr == 1) PG8_BAR;
        PG8_WAIT_V(4); PG8_BAR;
        PG8_STAGE(PG8_SB(1, 0), cB + kstep, voffB); PG8_STAGE(PG8_SA(1, 0), cA + kstep, voffA); PG8_STAGE(PG8_SB(1, 1), cB + hstep + kstep, voffB);
        PG8_WAIT_V(6); PG8_BAR;
    }
    for (;;) {
        const bool has_next = S.next(ui + 1, nxt);
        const char* nA = has_next ? (const char*)g.A + (size_t)nxt.pm * tstep : cA; const char* nB = has_next ? (const char*)g.Bt + (size_t)nxt.pn * tstep : cB;
        for (int t = 0; t < nt; t += 2) {
            const bool last = (t == nt - 2);
            const char* a1 = cA + (size_t)(t + 1) * kstep;
            const char* a2 = last ? nA : cA + (size_t)(t + 2) * kstep; const char* b2 = last ? nB : cB + (size_t)(t + 2) * kstep;
            const char* a3 = a2 + kstep; const char* b3 = b2 + kstep;
            if (last && has_next) S.a_ready(nxt);
            if constexpr (SP2) {
            PG8_LDB(B0, 0, 0); PG8_LDB(B1, 0, 1); PG8_SCHED; PG8_LDA(At, 0, 0); PG8_STAGE(PG8_SA(1, 1), a1 + hstep, voffA);
            PG8_WAIT_V(8); PG8_WAIT_L(0); PG8_BAR; PG8_MMA(0, 0, At, B0); PG8_MMA(0, 1, At, B1); PG8_BAR; PG8_SCHED;
            PG8_LDA(At, 0, 1); PG8_STAGE(PG8_SB(0, 0), b2, voffB); PG8_STAGE(PG8_SB(0, 1), b2 + hstep, voffB); PG8_STAGE(PG8_SA(0, 0), a2, voffA);
            PG8_WAIT_V(8); PG8_WAIT_L(0); PG8_BAR; PG8_MMA(1, 0, At, B0); PG8_MMA(1, 1, At, B1); PG8_BAR; PG8_SCHED;
            PG8_LDB(B0, 1, 0); PG8_LDB(B1, 1, 1); PG8_SCHED; PG8_LDA(At, 1, 0); PG8_STAGE(PG8_SA(0, 1), a2 + hstep, voffA);
            PG8_WAIT_V(8); PG8_WAIT_L(0); PG8_BAR; PG8_MMA(0, 0, At, B0); PG8_MMA(0, 1, At, B1); PG8_BAR; PG8_SCHED;
            PG8_LDA(At, 1, 1); PG8_STAGE(PG8_SB(1, 0), b3, voffB); PG8_STAGE(PG8_SB(1, 1), b3 + hstep, voffB); PG8_STAGE(PG8_SA(1, 0), a3, voffA);
            PG8_WAIT_V(8); PG8_WAIT_L(0); PG8_BAR; PG8_MMA(1, 0, At, B0); PG8_MMA(1, 1, At, B1); PG8_BAR; PG8_SCHED;
            } else {
            PG8_LDB(B0, 0, 0); PG8_SCHED; PG8_LDA(At, 0, 0); PG8_STAGE(PG8_SA(1, 1), a1 + hstep, voffA);
            PG8_WAIT_L(8); PG8_BAR; PG8_WAIT_L(0); PG8_MMA(0, 0, At, B0); PG8_BAR; PG8_SCHED;
            PG8_LDB(B1, 0, 1); PG8_STAGE(PG8_SB(0, 0), b2, voffB);
            PG8_BAR; PG8_WAIT_L(0); PG8_MMA(0, 1, At, B1); PG8_BAR;
            PG8_LDA(At, 0, 1); PG8_STAGE(PG8_SA(0, 0), a2, voffA);
            PG8_BAR; PG8_WAIT_L(0); PG8_MMA(1, 0, At, B0); PG8_BAR; PG8_SCHED;
            PG8_STAGE(PG8_SB(0, 1), b2 + hstep, voffB);
            PG8_WAIT_V(6); PG8_BAR; PG8_MMA(1, 1, At, B1); PG8_BAR;
            PG8_LDB(B0, 1, 0); PG8_SCHED; PG8_LDA(At, 1, 0); PG8_STAGE(PG8_SA(0, 1), a2 + hstep, voffA);
            PG8_WAIT_L(8); PG8_BAR; PG8_WAIT_L(0); PG8_MMA(0, 0, At, B0); PG8_BAR; PG8_SCHED;
            PG8_LDB(B1, 1, 1); PG8_STAGE(PG8_SB(1, 0), b3, voffB);
            PG8_BAR; PG8_WAIT_L(0); PG8_MMA(0, 1, At, B1); PG8_BAR;
            PG8_LDA(At, 1, 1); PG8_STAGE(PG8_SA(1, 0), a3, voffA);
            PG8_BAR; PG8_WAIT_L(0); PG8_MMA(1, 0, At, B0); PG8_BAR; PG8_SCHED;
            PG8_STAGE(PG8_SB(1, 1), b3 + hstep, voffB);
            PG8_WAIT_V(6); PG8_BAR; PG8_MMA(1, 1, At, B1); PG8_BAR;
            }
        }
        if constexpr (ALIGN_EPI) { if (wr == 0) PG8_BAR; }
#ifdef PROBE_EPI
        { const unsigned long long t0_ = __builtin_readcyclecounter(); E(acc, cur, wr, wc, fr, fq); asm volatile("s_waitcnt vmcnt(0)" ::: "memory"); tacc_ += __builtin_readcyclecounter() - t0_; S.done(cur); }
#else
        if constexpr (!Epi::AFTER_DRAIN) { E(acc, cur, wr, wc, fr, fq); S.done(cur); }
#endif
        if (!has_next) break;
#pragma unroll
        for (int a = 0; a < 2; ++a)
#pragma unroll
            for (int b = 0; b < 2; ++b)
#pragma unroll
                for (int m = 0; m < 4; ++m)
#pragma unroll
                    for (int n = 0; n < 2; ++n) acc[a][b][m][n] = (f32x4){0.f, 0.f, 0.f, 0.f};
        cur = nxt; cA = nA; cB = nB; ++ui;
        if constexpr (ALIGN_EPI) { if (wr == 1) PG8_BAR; }
    }
    PG8_WAIT_V(0);
    if constexpr (!ALIGN_EPI) { if (wr == 0) PG8_BAR; }
    PG8_BAR;
    if constexpr (Epi::AFTER_DRAIN) { E.fused(acc, cur, wr, wc, fr, fq, lds, wid, lane); S.done(cur); }
#undef PG8_SA
#undef PG8_SB
#undef PG8_STAGE
#undef PG8_LDA
#undef PG8_LDB
#undef PG8_MMA
#undef PG8_WAIT_V
#undef PG8_WAIT_L
#undef PG8_BAR
#undef PG8_SCHED
}
}
#define XB_TMO      128
#define XB_XCNT(j)  (256  + 64 * (j))
#define XB_XSUB(j)  (1280 + 64 * (j))
#define XB_XGEN(j)  (2304 + 64 * (j))
#define XB_TOP      3328
#define XB_TOPGEN   3392
#define XCD_BAR_WORDS 3456
#define XB_SPIN_CAP (1u << 18)

__device__ __forceinline__ unsigned xb_ld(unsigned* p)              { return __hip_atomic_load(p, __ATOMIC_RELAXED, __HIP_MEMORY_SCOPE_AGENT); }
__device__ __forceinline__ unsigned xb_add(unsigned* p, unsigned v) { return __hip_atomic_fetch_add(p, v, __ATOMIC_RELAXED, __HIP_MEMORY_SCOPE_AGENT); }
__device__ __forceinline__ unsigned xb_xcc_id() { return (unsigned)__builtin_amdgcn_s_getreg((3 << 11) | 20) & 0xFu; }
#define XB_SPIN(cond, bar) do { unsigned _sp = 0; while (cond) { __builtin_amdgcn_s_sleep(1); \
    if ((++_sp & 255u) == 0u) { if (xb_ld(&(bar)[XB_TMO])) break; if (_sp > XB_SPIN_CAP) { atomicAdd(&(bar)[XB_TMO], 1u); break; } } } } while (0)

struct XcdBarrier {
    unsigned* bar; unsigned x;
    volatile LAS unsigned* st;
};

__device__ __forceinline__ XcdBarrier xcd_barrier_post(unsigned* bar, volatile LAS unsigned* st) {
    XcdBarrier b; b.bar = bar; b.x = xb_xcc_id(); b.st = st;
    if (threadIdx.x == 0) (void)xb_add(&bar[XB_XCNT(b.x)], 1u);
    return b;
}
__device__ __forceinline__ void xcd_barrier_complete(unsigned* bar, unsigned x, unsigned& nloc, unsigned& nx) {
    const unsigned G = gridDim.x * gridDim.y * gridDim.z;
    unsigned sum, cnt, mine, sp = 0u;
    for (;;) {
        sum = 0u; cnt = 0u; mine = 0u;
#pragma unroll
        for (unsigned j = 0; j < 16; ++j) { const unsigned c = xb_ld(&bar[XB_XCNT(j)]); sum += c; cnt += (c > 0u) ? 1u : 0u; mine = (j == x) ? c : mine; }
        if (sum == G) break;
        __builtin_amdgcn_s_sleep(1);
        if ((++sp & 255u) == 0u) { if (xb_ld(&bar[XB_TMO])) break; if (sp > XB_SPIN_CAP) { atomicAdd(&bar[XB_TMO], 1u); break; } }
    }
    nloc = mine > 0u ? mine : 1u; nx = cnt > 0u ? cnt : 1u;
}

__device__ __forceinline__ void xcd_barrier(const XcdBarrier& b, bool leader  ) {
    asm volatile("s_waitcnt vmcnt(0)" ::: "memory");
    __syncthreads();
    if (leader) {
        unsigned* bar = b.bar;
        __builtin_amdgcn_s_waitcnt(0);
        unsigned nloc = b.st[0], nx = b.st[1];
        if (nloc == 0u) { xcd_barrier_complete(bar, b.x, nloc, nx); b.st[0] = nloc; b.st[1] = nx; }
        const unsigned old = xb_add(&bar[XB_XSUB(b.x)], 1u);
        const unsigned gen = old / nloc;
        if (old + 1u == (gen + 1u) * nloc) {
            __builtin_amdgcn_fence(__ATOMIC_RELEASE, "agent");
            asm volatile("s_waitcnt vmcnt(0)" ::: "memory");
            const unsigned og = xb_add(&bar[XB_TOP], 1u);
            const unsigned tg = og / nx;
            if (og + 1u == (tg + 1u) * nx) xb_add(&bar[XB_TOPGEN], 1u);
            else XB_SPIN(xb_ld(&bar[XB_TOPGEN]) == tg, bar);
            __builtin_amdgcn_fence(__ATOMIC_ACQUIRE, "agent");
            xb_add(&bar[XB_XGEN(b.x)], 1u);
            asm volatile("s_waitcnt vmcnt(0)" ::: "memory");
        } else {
            XB_SPIN(xb_ld(&bar[XB_XGEN(b.x)]) == gen, bar);
            __builtin_amdgcn_fence(__ATOMIC_ACQUIRE, "agent");
            asm volatile("s_waitcnt vmcnt(0)" ::: "memory");
        }
    }
    __syncthreads();
}
using pg8::f32x4; using pg8::bf16x8;
constexpr int NWAVES = 8;
constexpr int BATCH = 4, T = 8192, D = 1024, M = BATCH * T, NP = 4096, INW = 3864;
constexpr int DECB = 32, PAST = 16384, NPAGES = 128, NCS = 512  ;
constexpr float NORM_EPS = 1e-6f;
constexpr float LOG2E = 1.4426950408889634f;
constexpr float QSCALE = 0.125f * LOG2E;
constexpr size_t O_Y = 0, O_YS = 33554432, O_PCMP = 33587200, O_PSLC = 41975808, O_PWIN = 50364416, O_PCONV = 50888704,
                 O_SCMP = 50892800, O_SSLC = 50900992, O_SWIN = 50909184, O_SCONV = 55103488, O_END = 55136256;
constexpr int C_BG = 0, C_CG = 512, C_CI = 1024, C_ZC = 1536, C_Q = 2048, C_KV = 2560, C_GL = 3328, C_ZA = 3352;

constexpr size_t MiB = 1u << 20, KiB = 1u << 10;
constexpr size_t WS_CTL = 0, CTL_ZERO_BYTES = 1 * MiB;
constexpr size_t WS_BT1 = 2 * MiB;
constexpr size_t WS_BT2 = 10 * MiB;
constexpr size_t WS_BTC = 12 * MiB;
constexpr size_t WS_CBIAS = 12 * MiB + 512 * KiB;
constexpr size_t WS_CONST = WS_CBIAS + 4 * KiB;
constexpr size_t WS_ROPE = 13 * MiB;
constexpr size_t WS_RSTD = 16 * MiB;
constexpr size_t WS_XSB = 16 * MiB + 256 * KiB;
constexpr size_t WS_RSTDS = WS_XSB + 64 * KiB;
constexpr size_t WS_GATE = 17 * MiB;
constexpr size_t WS_KC = 20 * MiB;
constexpr size_t WS_VCT = WS_KC + 256 * KiB;
constexpr size_t WS_PROJS = 21 * MiB;
constexpr size_t WS_QS = 22 * MiB;
constexpr size_t WS_KVN = WS_QS + 64 * KiB;
constexpr size_t WS_GS = WS_KVN + 96 * KiB;
constexpr size_t WS_ZAS = WS_GS + 4 * KiB;
constexpr size_t WS_MIXS = WS_ZAS + 64 * KiB;
constexpr size_t WS_KCS = 24 * MiB;
constexpr size_t WS_KS = 40 * MiB, WS_VTS = 48 * MiB, WS_KW = 56 * MiB, WS_VTW = 64 * MiB;
constexpr size_t WS_XB = 72 * MiB;
constexpr size_t WS_CG = 136 * MiB, WS_U = 168 * MiB, WS_ZA = 200 * MiB, WS_Q = 232 * MiB;
constexpr size_t WS_MIX = 264 * MiB;
constexpr size_t WS_TOT = 328 * MiB;
constexpr size_t WS_END = 344 * MiB;
constexpr int CW_TMO = 0, CW_CODE = 1;
constexpr int CW_BAR = 4096;
constexpr int CW_QUEUE = 16384;
constexpr int CW_P0CNT = 18432;
constexpr int CW_KCMAX = 20480;

constexpr int RING_OFF = 0, RING_BYTES = 131072;
constexpr int LDSCTL_OFF = RING_BYTES, MISC_OFF = LDSCTL_OFF + 320;
constexpr int LDS_BYTES = 147456;

__device__ __forceinline__ unsigned f2bf(float f) { unsigned u = __builtin_bit_cast(unsigned, f); return (u + 0x7fffu + ((u >> 16) & 1u)) >> 16; }
typedef __bf16 bf16x2_t __attribute__((ext_vector_type(2)));
__device__ __forceinline__ unsigned pk2(float lo, float hi) { return __builtin_bit_cast(unsigned, __builtin_convertvector((f32x2){lo, hi}, bf16x2_t)); }
__device__ __forceinline__ float bf2f(unsigned h) { return __builtin_bit_cast(float, h << 16); }
__device__ __forceinline__ float wave_sum(float v) {
#pragma unroll
    for (int o = 1; o < 64; o <<= 1) v += __shfl_xor(v, o);
    return v;
}
__device__ __forceinline__ float fast_exp2(float x) { return __builtin_amdgcn_exp2f(x); }
__device__ __forceinline__ float sigmoidf(float x) { return __builtin_amdgcn_rcpf(1.0f + fast_exp2(-x * LOG2E)); }
__device__ __forceinline__ int perm16(int kk) { return 8 * ((kk >> 2) & 1) + 4 * (kk >> 3) + (kk & 3); }

struct Ptrs {
    const float *xp, *xs, *cache_cmp, *cache_slc, *st_win, *st_conv; const int* page_table;
    const float *norm_g, *w_in, *conv_w, *conv_b, *q_gain, *k_gain, *cmp_pe, *cmp_w, *w_out;
    float* out; unsigned char* ws;
};
struct Frame {
    LAS unsigned char* lds;
    volatile LAS unsigned* MISC;
    gu32* ctl;
    int tid, lane, wave, G, gw, NGW;
};
__device__ __forceinline__ int bt1_src(int dg, int& nvalid) {
    const int pn = dg >> 3, gi = dg & 7, bj = gi >> 2, wc = gi & 3; nvalid = 32;
    if (pn < 4) return (bj ? C_ZC : C_BG) + 128 * pn + 32 * wc;
    if (pn < 8) return (bj ? C_CI : C_CG) + 128 * (pn - 4) + 32 * wc;
    if (pn < 10) return C_Q + (4 * (pn - 8) + wc) * 64 + 32 * bj;
    if (pn < 13) return C_KV + (pn - 10) * 256 + wc * 64 + 32 * bj;
    if (pn < 15) return C_ZA + 256 * (pn - 13) + 32 * gi;
    nvalid = (gi == 0) ? 24 : 0; return C_GL;
}
__device__ __forceinline__ void p0_transpose_item(const float* W, int ldw, int k0, int src0, int nvalid, const float* ksc, bf16* WT, int ldt, int drow0, LAS float* scr, int lane) {
    const int nn = lane & 31;
#pragma unroll 8
    for (int i = 0; i < 32; ++i) { const int kk = 2 * i + (lane >> 5); float v = 0.f;
        if (nn < nvalid) { v = W[(size_t)(k0 + kk) * ldw + src0 + nn]; if (ksc) v *= ksc[k0 + kk]; }
        scr[kk * 33 + nn] = v; }
    LDS_WAIT(); asm volatile("" ::: "memory");
    const int c = lane & 7;
#pragma unroll
    for (int j = 0; j < 4; ++j) { const int n = (lane >> 3) + 8 * j; const LAS float* s = scr + (8 * c) * 33 + n;
        v4u o; o.x = pk2(s[0 * 33], s[1 * 33]); o.y = pk2(s[2 * 33], s[3 * 33]); o.z = pk2(s[4 * 33], s[5 * 33]); o.w = pk2(s[6 * 33], s[7 * 33]);
        *(GAS v4u*)(WT + (size_t)(drow0 + n) * ldt + k0 + 8 * c) = o; }
    LDS_WAIT(); asm volatile("" ::: "memory");
}
template <int NR>
__device__ __forceinline__ void x_rows_to_bf16(const float* xrow, bf16* orow, float* rstd_out, int lane) {
    f32x4 v[NR][4]; float s[NR];
#pragma unroll
    for (int r = 0; r < NR; ++r)
#pragma unroll
        for (int j = 0; j < 4; ++j) v[r][j] = ((const GAS f32x4*)(xrow + (size_t)r * D) + lane)[64 * j];
#pragma unroll
    for (int r = 0; r < NR; ++r) { s[r] = 0.f;
#pragma unroll
        for (int j = 0; j < 4; ++j) s[r] += (v[r][j].x * v[r][j].x + v[r][j].y * v[r][j].y) + (v[r][j].z * v[r][j].z + v[r][j].w * v[r][j].w); }
#pragma unroll
    for (int o = 1; o < 64; o <<= 1)
#pragma unroll
        for (int r = 0; r < NR; ++r) s[r] += __shfl_xor(s[r], o);
#pragma unroll
    for (int r = 0; r < NR; ++r) { GAS unsigned long long* o8 = (GAS unsigned long long*)(orow + (size_t)r * D) + lane;
#pragma unroll
        for (int j = 0; j < 4; ++j) o8[64 * j] = (unsigned long long)pk2(v[r][j].x, v[r][j].y) | ((unsigned long long)pk2(v[r][j].z, v[r][j].w) << 32);
        if (lane == 0) rstd_out[r] = 1.0f / sqrtf(s[r] * (1.0f / D) + NORM_EPS); }
}
template <bool SAMPLE>
__device__ __forceinline__ const float* cmp_rowbase(const Ptrs& P, int unit, int rho) {
    const int b = SAMPLE ? unit >> 6 : unit >> 5, c = (SAMPLE ? (unit & 63) : (unit & 31)) * 8 + (rho >> 1), g = rho & 1;
    if (SAMPLE) { const int page = P.page_table[b * NPAGES + (c >> 2)]; return P.cache_cmp + ((size_t)page * 128 + (c & 3) * 32) * 256 + g * 64; }
    return P.out + O_PCMP + ((size_t)b * T + c * 32) * 256 + g * 64;
}
template <bool SAMPLE>
__device__ __forceinline__ void compress_units(const Ptrs& P, Frame& F, LAS float* part  ) {
    constexpr int NUNITS = SAMPLE ? DECB * (NCS / 8) : BATCH * 32;
    const int lane = F.lane, w = F.wave, rho = lane & 15, kq = lane >> 4;
    const GAS v4u* bfr = (const GAS v4u*)(P.ws + WS_BTC) + lane;
    const float* cbias = (const float*)(P.ws + WS_CBIAS);
    int unit = blockIdx.x;
    if (unit >= NUNITS) return;
    f32x4 a_cur[8], a_n1[8], a_n2[8];
    const float* rb = cmp_rowbase<SAMPLE>(P, unit, rho) + 4 * kq;
#define CMP_LOAD(dst, base, r) do { _Pragma("unroll") for (int q_ = 0; q_ < 4; ++q_) { dst[2 * q_] = *(const GAS f32x4*)((base) + (r) * 256 + (q_ >> 1) * 128 + (q_ & 1) * 32); dst[2 * q_ + 1] = *(const GAS f32x4*)((base) + (r) * 256 + (q_ >> 1) * 128 + (q_ & 1) * 32 + 16); } } while (0)
    CMP_LOAD(a_cur, rb, 4 * w); CMP_LOAD(a_n1, rb, 4 * w + 1);
    for (;;) {
        f32x4 acc[2][4];
#pragma unroll
        for (int j = 0; j < 2; ++j)
#pragma unroll
            for (int e = 0; e < 4; ++e) acc[j][e] = (f32x4){0.f, 0.f, 0.f, 0.f};
        const int nunit = unit + F.G; const bool has_next = nunit < NUNITS;
        const float* rbn = has_next ? cmp_rowbase<SAMPLE>(P, nunit, rho) + 4 * kq : rb;
#pragma unroll 1
        for (int rr = 0; rr < 4; ++rr) {
            const int r = 4 * w + rr;
            bf16x8 bb[16];
#pragma unroll
            for (int q_ = 0; q_ < 4; ++q_)
#pragma unroll
                for (int et = 0; et < 4; ++et) bb[q_ * 4 + et] = __builtin_bit_cast(bf16x8, bfr[(size_t)(((((q_ >> 1) * 32 + r) * 2 + (q_ & 1)) * 4 + et) * 64)]);
            __builtin_amdgcn_sched_barrier(0);
            { const float* nb_ = rr < 2 ? rb : rbn; const int nr_ = rr < 2 ? r + 2 : 4 * w + (rr - 2); CMP_LOAD(a_n2, nb_, nr_); }
            __builtin_amdgcn_sched_barrier(0);
#pragma unroll
            for (int q_ = 0; q_ < 4; ++q_) { const int j = q_ >> 1;
                v4u wv; wv.x = pk2(a_cur[2 * q_].x, a_cur[2 * q_].y); wv.y = pk2(a_cur[2 * q_].z, a_cur[2 * q_].w); wv.z = pk2(a_cur[2 * q_ + 1].x, a_cur[2 * q_ + 1].y); wv.w = pk2(a_cur[2 * q_ + 1].z, a_cur[2 * q_ + 1].w);
                const bf16x8 af = __builtin_bit_cast(bf16x8, wv);
#pragma unroll
                for (int et = 0; et < 4; ++et) acc[j][et] = __builtin_amdgcn_mfma_f32_16x16x32_bf16(af, bb[q_ * 4 + et], acc[j][et], 0, 0, 0); }
#pragma unroll
            for (int q_ = 0; q_ < 8; ++q_) { a_cur[q_] = a_n1[q_]; a_n1[q_] = a_n2[q_]; }
        }
#pragma unroll
        for (int j = 0; j < 2; ++j)
#pragma unroll
            for (int et = 0; et < 4; ++et) *(LAS f32x4*)(part + ((w * 8 + j * 4 + et) * 64 + lane) * 4) = acc[j][et];
        __syncthreads();
        { const int j = w >> 2, et = w & 3, e = 16 * et + rho; f32x4 sum = *(const LAS f32x4*)(part + ((0 * 8 + w) * 64 + lane) * 4);
#pragma unroll
          for (int ww = 1; ww < 8; ++ww) sum = sum + *(const LAS f32x4*)(part + ((ww * 8 + w) * 64 + lane) * 4);
          const float bs = cbias[j * 64 + e]; const int b = SAMPLE ? unit >> 6 : unit >> 5, c0 = (SAMPLE ? (unit & 63) : (unit & 31)) * 8;
          float nmax = 0.f;
#pragma unroll
          for (int i = 0; i < 4; ++i) { const int row = 4 * kq + i, c = c0 + (row >> 1), g = row & 1; const float val = sum[i] + bs;
              float q2 = val * val; q2 += __shfl_xor(q2, 1); q2 += __shfl_xor(q2, 2); q2 += __shfl_xor(q2, 4); q2 += __shfl_xor(q2, 8); nmax = fmaxf(nmax, q2);
              if (SAMPLE) ((float*)(P.ws + WS_KCS))[((size_t)((b * 2 + g) * 2 + j) * NCS + c) * 64 + e] = val;
              else if (j == 0) ((bf16*)(P.ws + WS_KC))[((size_t)(b * 2 + g) * 256 + c) * 64 + e] = (bf16)f2bf(val);
              else ((bf16*)(P.ws + WS_VCT))[((size_t)(b * 2 + g) * 64 + e) * 256 + (c & ~15) + perm16(c & 15)] = (bf16)f2bf(val); }
          if (j == 0) { nmax = fmaxf(nmax, __shfl_xor(nmax, 16)); nmax = fmaxf(nmax, __shfl_xor(nmax, 32));
              if (lane == 0) atomicMax((unsigned*)(P.ws + WS_CTL) + CW_KCMAX + (SAMPLE ? 64 : 0) + et, __builtin_bit_cast(unsigned, nmax)); } }
        __syncthreads();
        if (!has_next) break;
        unit = nunit; rb = rbn;
    }
#undef CMP_LOAD
}
__device__ __forceinline__ void compress_sample_pass(const Ptrs& P, Frame& F, LAS unsigned char* bl  ) {
    const int lane = F.lane, w = F.wave, tid = F.tid, rho = lane & 15, kq = lane >> 4;
    for (int pass = blockIdx.x; pass < DECB * 8; pass += F.G) {
    __syncthreads();
    const int b = pass >> 3, c0 = (pass & 7) * 64 + w * 8;
    const float* rb; { const int c = c0 + (rho >> 1), g = rho & 1; const int page = P.page_table[b * NPAGES + (c >> 2)]; rb = P.cache_cmp + ((size_t)page * 128 + (c & 3) * 32) * 256 + g * 64 + 4 * kq; }
    const GAS v4u* bsrc = (const GAS v4u*)(P.ws + WS_BTC);
    const int sf = tid >> 5, sj = sf >> 3, sdh = (sf >> 2) & 1, set_ = sf & 3, sl = (tid & 31) * 2;
#define B_SRC(r) (bsrc + (size_t)((((sj * 32 + (r)) * 2 + sdh) * 4 + set_) * 64 + sl))
    LAS v4u* bdst = (LAS v4u*)bl + sf * 64 + sl;
    f32x4 a_cur[8], a_n1[8], a_n2[8];
#define CMP_LOAD(dst, base, r) do { _Pragma("unroll") for (int q_ = 0; q_ < 4; ++q_) { dst[2 * q_] = *(const GAS f32x4*)((base) + (r) * 256 + (q_ >> 1) * 128 + (q_ & 1) * 32); dst[2 * q_ + 1] = *(const GAS f32x4*)((base) + (r) * 256 + (q_ >> 1) * 128 + (q_ & 1) * 32 + 16); } } while (0)
    { const v4u b0 = B_SRC(0)[0], b1 = B_SRC(0)[1]; bdst[0] = b0; bdst[1] = b1; }
    CMP_LOAD(a_cur, rb, 0); CMP_LOAD(a_n1, rb, 1);
    f32x4 acc[2][4];
#pragma unroll
    for (int j = 0; j < 2; ++j)
#pragma unroll
        for (int e = 0; e < 4; ++e) acc[j][e] = (f32x4){0.f, 0.f, 0.f, 0.f};
    __syncthreads();
#pragma unroll 1
    for (int r = 0; r < 32; ++r) {
        const int rn = r + 1 < 32 ? r + 1 : 31, r2 = r + 2 < 32 ? r + 2 : 31;
        const v4u b0 = B_SRC(rn)[0], b1 = B_SRC(rn)[1];
        __builtin_amdgcn_sched_barrier(0);
        CMP_LOAD(a_n2, rb, r2);
        __builtin_amdgcn_sched_barrier(0);
        const LAS v4u* bf = (const LAS v4u*)bl + (r & 1) * 1024 + lane;
#pragma unroll
        for (int q_ = 0; q_ < 4; ++q_) { const int j = q_ >> 1;
            v4u wv; wv.x = pk2(a_cur[2 * q_].x, a_cur[2 * q_].y); wv.y = pk2(a_cur[2 * q_].z, a_cur[2 * q_].w); wv.z = pk2(a_cur[2 * q_ + 1].x, a_cur[2 * q_ + 1].y); wv.w = pk2(a_cur[2 * q_ + 1].z, a_cur[2 * q_ + 1].w);
            const bf16x8 af = __builtin_bit_cast(bf16x8, wv);
#pragma unroll
            for (int et = 0; et < 4; ++et) acc[j][et] = __builtin_amdgcn_mfma_f32_16x16x32_bf16(af, __builtin_bit_cast(bf16x8, bf[(q_ * 4 + et) * 64]), acc[j][et], 0, 0, 0); }
        { LAS v4u* d_ = bdst + ((r + 1) & 1) * 1024; d_[0] = b0; d_[1] = b1; }
#pragma unroll
        for (int q_ = 0; q_ < 8; ++q_) { a_cur[q_] = a_n1[q_]; a_n1[q_] = a_n2[q_]; }
        __syncthreads();
    }
#undef CMP_LOAD
#undef B_SRC
    const float* cbias = (const float*)(P.ws + WS_CBIAS);
    float nmax = 0.f;
#pragma unroll
    for (int i = 0; i < 4; ++i) { const int row = 4 * kq + i, c = c0 + (row >> 1), g = row & 1; float q2 = 0.f;
#pragma unroll
        for (int j = 0; j < 2; ++j)
#pragma unroll
            for (int et = 0; et < 4; ++et) { const int e = 16 * et + rho; const float val = acc[j][et][i] + cbias[j * 64 + e]; if (j == 0) q2 += val * val;
                ((float*)(P.ws + WS_KCS))[((size_t)((b * 2 + g) * 2 + j) * NCS + c) * 64 + e] = val; }
        q2 += __shfl_xor(q2, 1); q2 += __shfl_xor(q2, 2); q2 += __shfl_xor(q2, 4); q2 += __shfl_xor(q2, 8); nmax = fmaxf(nmax, q2); }
    nmax = fmaxf(nmax, __shfl_xor(nmax, 16)); nmax = fmaxf(nmax, __shfl_xor(nmax, 32));
    if (lane == 0) atomicMax((unsigned*)(P.ws + WS_CTL) + CW_KCMAX + 64, __builtin_bit_cast(unsigned, nmax));
    }
}
constexpr int P0_PRODUCERS = 641;
__device__ __forceinline__ void p0_small_items(const Ptrs& P, Frame& F) {
    const int lane = F.lane, gw = F.gw;
    if (gw >= P0_PRODUCERS && F.NGW >= P0_PRODUCERS) return;
    for (int item = gw; item < P0_PRODUCERS; item += F.NGW) {
        if (item < 512) { const int it = item * 64 + lane; const int l = it & 63, et = (it >> 6) & 3, dh = (it >> 8) & 1, r = (it >> 9) & 31, j = it >> 14;
            const float* w = P.cmp_w + ((size_t)(r * 2 + j) * 64 + 32 * dh + 4 * (l >> 4)) * 64 + 16 * et + (l & 15);
            v4u o; o.x = pk2(w[0], w[64]); o.y = pk2(w[128], w[192]); o.z = pk2(w[16 * 64], w[17 * 64]); o.w = pk2(w[18 * 64], w[19 * 64]);
            __builtin_amdgcn_raw_buffer_store_b128(o, __builtin_amdgcn_make_buffer_rsrc((void*)(P.ws + WS_BTC), 0, 512 * 1024, 0x00020000), it * 16, 0, 16);
        } else if (item < 640) { const int it = item - 512, j = it >> 6, e = it & 63; float s = 0.f;
            for (int k = lane; k < 2048; k += 64) { const int r = k >> 6, d = k & 63; s += P.cmp_pe[(r * 2 + j) * 64 + d] * P.cmp_w[((size_t)(r * 2 + j) * 64 + d) * 64 + e]; }
            s = wave_sum(s); if (lane == 0) __hip_atomic_store((float*)(P.ws + WS_CBIAS) + it, s, RLX_AGENT);
        } else { float qm = fabsf(P.q_gain[lane]), k1 = fabsf(P.k_gain[64 + lane]), k2 = fabsf(P.k_gain[128 + lane]);
#pragma unroll
            for (int o = 1; o < 64; o <<= 1) { qm = fmaxf(qm, __shfl_xor(qm, o)); k1 = fmaxf(k1, __shfl_xor(k1, o)); k2 = fmaxf(k2, __shfl_xor(k2, o)); }
            if (lane == 0) { float* cst = (float*)(P.ws + WS_CONST); __hip_atomic_store(cst + 0, qm, RLX_AGENT); __hip_atomic_store(cst + 1, 8.0f * qm * k1 * LOG2E * 1.001f, RLX_AGENT); __hip_atomic_store(cst + 2, 8.0f * qm * k2 * LOG2E * 1.001f, RLX_AGENT); } }
        asm volatile("s_waitcnt vmcnt(0)" ::: "memory");
        if (lane == 0) __hip_atomic_fetch_add((unsigned*)(F.ctl + CW_P0CNT), 1u, RLX_AGENT);
    }
}
__device__ __forceinline__ void p0_rope(const Ptrs& P, Frame& F) {
    const int lane = F.lane, gw = F.gw, NGW = F.NGW; const int i = lane & 31;
    const float inv = (float)pow(10000.0, -(double)i / 32.0);
    for (int it = gw * 64 + lane; it < 8193 * 32; it += NGW * 64) { const int p = it >> 5; const int pos = (p == 8192) ? PAST : p;
        const float ang = (float)pos * inv; const double rev = (double)ang * 0.15915494309189535; const float fr = (float)(rev - __builtin_rint(rev));
        float* rt = (float*)(P.ws + WS_ROPE) + (size_t)p * 64; rt[i] = __builtin_amdgcn_cosf(fr); rt[32 + i] = __builtin_amdgcn_sinf(fr); }
}
__device__ __forceinline__ void p0_phase(const Ptrs& P, Frame& F) {
    LAS float* scr = (LAS float*)(F.lds + RING_OFF + F.wave * 16384);
    const int lane = F.lane;
    p0_small_items(P, F);
    p0_rope(P, F);
    const int gw = F.gw, NGW = F.NGW;
    for (int it = gw; it < 16 * 128; it += NGW) { const int kb = it >> 7, dg = it & 127; int nv; const int src0 = bt1_src(dg, nv);
        p0_transpose_item(P.w_in, INW, 64 * kb, src0, nv, P.norm_g, (bf16*)(P.ws + WS_BT1), D, 32 * dg, scr, lane); }
    for (int it = gw; it < 16 * 32; it += NGW) { const int kb = it >> 5, nb = it & 31;
        p0_transpose_item(P.w_out, D, 64 * kb, 32 * nb, 32, nullptr, (bf16*)(P.ws + WS_BT2), D, 32 * nb, scr, lane); }
    for (int m = gw * 4; m < M; m += NGW * 4) x_rows_to_bf16<4>(P.xp + (size_t)m * D, (bf16*)(P.ws + WS_XB) + (size_t)m * D, (float*)(P.ws + WS_RSTD) + m, lane);
    for (int m = gw; m < DECB; m += NGW) x_rows_to_bf16<1>(P.xs + (size_t)m * D, (bf16*)(P.ws + WS_XSB) + (size_t)m * D, (float*)(P.ws + WS_RSTDS) + m, lane);
    { constexpr int PERB = 511 * 64, TOTAL = DECB * PERB; const GAS f32x4* src = (const GAS f32x4*)P.st_win; GAS f32x4* dst = (GAS f32x4*)(P.out + O_SWIN);
      for (int i0 = gw * 64 + lane; i0 < TOTAL; i0 += NGW * 64 * 8) { f32x4 t[8];
#pragma unroll
        for (int u = 0; u < 8; ++u) { const int i = i0 + u * NGW * 64; if (i < TOTAL) { const int b = i / PERB; t[u] = src[i + 64 * b + 64]; } }
#pragma unroll
        for (int u = 0; u < 8; ++u) { const int i = i0 + u * NGW * 64; if (i < TOTAL) { const int b = i / PERB; dst[i + 64 * b] = t[u]; } } } }
    for (int it = gw * 64 + lane; it < DECB * 512; it += NGW * 64) { const int b = it >> 9, ch = it & 511; P.out[O_SCONV + (size_t)b * 1024 + ch] = P.st_conv[(size_t)b * 1024 + 512 + ch]; }
    if (F.wave == 0) { if (lane == 0) { unsigned sp = 0u; while (__hip_atomic_load((unsigned*)(F.ctl + CW_P0CNT), RLX_AGENT) < (unsigned)P0_PRODUCERS) { __builtin_amdgcn_s_sleep(2); if (++sp > (1u << 22)) break; } }
        __builtin_amdgcn_fence(__ATOMIC_ACQUIRE, "agent"); asm volatile("s_waitcnt vmcnt(0)" ::: "memory"); }
    __syncthreads();
    compress_sample_pass(P, F, F.lds + RING_OFF);
}
struct EpiIn {
    static constexpr bool PERM = false, AFTER_DRAIN = false;
    const float *rstd, *rope, *qg, *kg; float* out; unsigned char* ws;
    __device__ __forceinline__ void operator()(const f32x4 (&acc)[2][2][4][2], const pg8::Unit& u, int wr, int wc, int fr, int fq) const {
        asm volatile("" : "+v"(fr), "+v"(fq));
        const int pn = u.pn; const int rbase = u.pm * 256 + wr * 64 + fr;
        if (pn < 8) {
            const bool bz = pn < 4; bf16* dst = (bf16*)(ws + (bz ? WS_CG : WS_U)); const int col0 = 128 * (pn & 3) + 32 * wc + 4 * fq;
#pragma unroll
            for (int ai = 0; ai < 2; ++ai)
#pragma unroll
                for (int m = 0; m < 4; ++m) { const int row = rbase + ai * 128 + m * 16; const float rs = rstd[row];
#pragma unroll
                    for (int n = 0; n < 2; ++n) { const f32x4 a = acc[ai][0][m][n] * rs, z = acc[ai][1][m][n] * rs; f32x4 o;
                        if (bz) { o.x = a.x * z.x * sigmoidf(z.x); o.y = a.y * z.y * sigmoidf(z.y); o.z = a.z * z.z * sigmoidf(z.z); o.w = a.w * z.w * sigmoidf(z.w); }
                        else o = a * z;
                        v2u w; w.x = pk2(o.x, o.y); w.y = pk2(o.z, o.w);
                        *(GAS v2u*)(dst + (size_t)row * 512 + col0 + 16 * n) = w;
                        if (!bz) { const int t = row & (T - 1); if (t >= T - 2) *(GAS f32x4*)(out + O_PCONV + ((size_t)(row >> 13) * 2 + (t - (T - 2))) * 512 + col0 + 16 * n) = o; } } }
        } else if (pn < 13) {
            const bool isq = pn < 10; const int br = pn - 10; const bool isk = !isq && wc < 2;
            if (isq || isk) {
                const float* gain = isq ? qg : kg + br * 64; float g1[2][4], g2[2][4];
#pragma unroll
                for (int n = 0; n < 2; ++n)
#pragma unroll
                    for (int e = 0; e < 4; ++e) { g1[n][e] = gain[16 * n + 4 * fq + e]; g2[n][e] = gain[32 + 16 * n + 4 * fq + e]; }
#pragma unroll
                for (int ai = 0; ai < 2; ++ai)
#pragma unroll
                    for (int m = 0; m < 4; ++m) { const int row = rbase + ai * 128 + m * 16; const float rs = rstd[row]; const int t = row & (T - 1), b = row >> 13;
                        f32x4 x1[2], x2[2]; float ss = 0.f;
#pragma unroll
                        for (int n = 0; n < 2; ++n) { x1[n] = acc[ai][0][m][n] * rs; x2[n] = acc[ai][1][m][n] * rs;
                            ss += (x1[n].x * x1[n].x + x1[n].y * x1[n].y) + (x1[n].z * x1[n].z + x1[n].w * x1[n].w) + (x2[n].x * x2[n].x + x2[n].y * x2[n].y) + (x2[n].z * x2[n].z + x2[n].w * x2[n].w); }
                        ss += __shfl_xor(ss, 16); ss += __shfl_xor(ss, 32);
                        const float inv = 1.0f / sqrtf(ss * (1.0f / 64.0f) + NORM_EPS);
                        const float* rp = rope + (size_t)t * 64 + 4 * fq;
#pragma unroll
                        for (int n = 0; n < 2; ++n) { const f32x4 cs = *(const GAS f32x4*)(rp + 16 * n), sn = *(const GAS f32x4*)(rp + 32 + 16 * n); f32x4 o1, o2;
#pragma unroll
                            for (int e = 0; e < 4; ++e) { const float a = x1[n][e] * inv * g1[n][e], c = x2[n][e] * inv * g2[n][e]; o1[e] = a * cs[e] - c * sn[e]; o2[e] = c * cs[e] + a * sn[e]; }
                            const int d1 = 16 * n + 4 * fq;
                            if (isq) { o1 = o1 * QSCALE; o2 = o2 * QSCALE; bf16* q = (bf16*)(ws + WS_Q) + (size_t)row * 512 + (4 * (pn - 8) + wc) * 64 + d1;
                                v2u w; w.x = pk2(o1.x, o1.y); w.y = pk2(o1.z, o1.w); *(GAS v2u*)q = w; w.x = pk2(o2.x, o2.y); w.y = pk2(o2.z, o2.w); *(GAS v2u*)(q + 32) = w; }
                            else { const int g = wc;
                                if (br > 0) { bf16* k = (bf16*)(ws + (br == 1 ? WS_KS : WS_KW)) + ((size_t)(b * 2 + g) * T + t) * 64 + d1;
                                    v2u w; w.x = pk2(o1.x, o1.y); w.y = pk2(o1.z, o1.w); *(GAS v2u*)k = w; w.x = pk2(o2.x, o2.y); w.y = pk2(o2.z, o2.w); *(GAS v2u*)(k + 32) = w; }
                                if (br < 2) { float* o = out + (br == 0 ? O_PCMP : O_PSLC) + (size_t)row * 256 + g * 64 + d1; *(GAS f32x4*)o = o1; *(GAS f32x4*)(o + 32) = o2; }
                                else if (t >= T - 512) { float* o = out + O_PWIN + ((size_t)b * 512 + (t - (T - 512))) * 256 + g * 64 + d1; *(GAS f32x4*)o = o1; *(GAS f32x4*)(o + 32) = o2; } } } }
            } else {
                const int g = wc - 2;
#pragma unroll
                for (int ai = 0; ai < 2; ++ai)
#pragma unroll
                    for (int m = 0; m < 4; ++m) { const int row = rbase + ai * 128 + m * 16; const float rs = rstd[row]; const int t = row & (T - 1), b = row >> 13;
                        const int tk = t & 63, vpos = (tk & ~15) + perm16(tk & 15);
                        bf16* vt = (br > 0) ? (bf16*)(ws + (br == 1 ? WS_VTS : WS_VTW)) + ((size_t)((b * 2 + g) * 128 + (t >> 6)) * 64) * 64 + vpos : nullptr;
#pragma unroll
                        for (int bj = 0; bj < 2; ++bj)
#pragma unroll
                            for (int n = 0; n < 2; ++n) { const f32x4 v = acc[ai][bj][m][n] * rs; const int d1 = 32 * bj + 16 * n + 4 * fq;
                                if (br > 0) {
#pragma unroll
                                    for (int e = 0; e < 4; ++e) vt[(size_t)(d1 + e) * 64] = (bf16)f2bf(v[e]); }
                                if (br < 2) *(GAS f32x4*)(out + (br == 0 ? O_PCMP : O_PSLC) + (size_t)row * 256 + 128 + g * 64 + d1) = v;
                                else if (t >= T - 512) *(GAS f32x4*)(out + O_PWIN + ((size_t)b * 512 + (t - (T - 512))) * 256 + 128 + g * 64 + d1) = v; } }
            }
        } else if (pn < 15) {
            bf16* dst = (bf16*)(ws + WS_ZA);
#pragma unroll
            for (int ai = 0; ai < 2; ++ai)
#pragma unroll
                for (int m = 0; m < 4; ++m) { const int row = rbase + ai * 128 + m * 16; const float rs = rstd[row];
#pragma unroll
                    for (int bj = 0; bj < 2; ++bj)
#pragma unroll
                        for (int n = 0; n < 2; ++n) { const f32x4 z = acc[ai][bj][m][n] * rs; v2u w; w.x = pk2(z.x * sigmoidf(z.x), z.y * sigmoidf(z.y)); w.y = pk2(z.z * sigmoidf(z.z), z.w * sigmoidf(z.w));
                            *(GAS v2u*)(dst + (size_t)row * 512 + 256 * (pn - 13) + 128 * bj + 32 * wc + 16 * n + 4 * fq) = w; } }
        } else {
            if (wc == 0) { float* dst = (float*)(ws + WS_GATE);
#pragma unroll
                for (int ai = 0; ai < 2; ++ai)
#pragma unroll
                    for (int m = 0; m < 4; ++m) { const int row = rbase + ai * 128 + m * 16; const float rs = rstd[row];
#pragma unroll
                        for (int n = 0; n < 2; ++n) { const int c0 = 16 * n + 4 * fq; if (c0 < 24) { const f32x4 z = acc[ai][0][m][n] * rs;
                            *(GAS f32x4*)(dst + (size_t)row * 24 + c0) = (f32x4){sigmoidf(z.x), sigmoidf(z.y), sigmoidf(z.z), sigmoidf(z.w)}; } } } }
        }
    }
};
struct EpiOut {
    static constexpr bool PERM = false, AFTER_DRAIN = false;
    const float* x; float* y;
    __device__ __forceinline__ void operator()(const f32x4 (&acc)[2][2][4][2], const pg8::Unit& u, int wr, int wc, int fr, int fq) const {
        asm volatile("" : "+v"(fr), "+v"(fq));
#pragma unroll
        for (int ai = 0; ai < 2; ++ai)
#pragma unroll
            for (int m = 0; m < 4; ++m) { const size_t row = (size_t)u.pm * 256 + ai * 128 + wr * 64 + m * 16 + fr;
#pragma unroll
                for (int bj = 0; bj < 2; ++bj)
#pragma unroll
                    for (int n = 0; n < 2; ++n) { const size_t off = row * D + u.pn * 256 + 128 * bj + 32 * wc + 16 * n + 4 * fq;
                        *(GAS f32x4*)(y + off) = *(const GAS f32x4*)(x + off) + acc[ai][bj][m][n]; } }
    }
};
template <int MODE>
__device__ __forceinline__ void small_gemm_tile(const Ptrs& P, const bf16* A, const bf16* Bt, int ct, int lane) {
    const int rho = lane & 15, kq = lane >> 4;
    f32x4 acc[2] = {(f32x4){0.f, 0.f, 0.f, 0.f}, (f32x4){0.f, 0.f, 0.f, 0.f}};
    const GAS v4u* a0 = (const GAS v4u*)(A + (size_t)rho * D + 8 * kq); const GAS v4u* a1 = (const GAS v4u*)(A + (size_t)(16 + rho) * D + 8 * kq);
    const GAS v4u* bp = (const GAS v4u*)(Bt + (size_t)(16 * ct + rho) * D + 8 * kq);
#pragma unroll 8
    for (int ks = 0; ks < 32; ++ks) { const bf16x8 bb = __builtin_bit_cast(bf16x8, bp[ks * 4]);
        acc[0] = __builtin_amdgcn_mfma_f32_16x16x32_bf16(bb, __builtin_bit_cast(bf16x8, a0[ks * 4]), acc[0], 0, 0, 0);
        acc[1] = __builtin_amdgcn_mfma_f32_16x16x32_bf16(bb, __builtin_bit_cast(bf16x8, a1[ks * 4]), acc[1], 0, 0, 0); }
#pragma unroll
    for (int rt = 0; rt < 2; ++rt) { const int b = 16 * rt + rho; const int col = 16 * ct + 4 * kq;
        if (MODE == 0) { const float rs = ((const float*)(P.ws + WS_RSTDS))[b]; *(GAS f32x4*)((float*)(P.ws + WS_PROJS) + (size_t)b * NP + col) = acc[rt] * rs; }
        else *(GAS f32x4*)(P.out + O_YS + (size_t)b * D + col) = *(const GAS f32x4*)(P.xs + (size_t)b * D + col) + acc[rt]; }
}
__device__ __forceinline__ int projs_col(int pn, int wc, int d) { return 256 * pn + 128 * (d >> 5) + 32 * wc + (d & 31); }
__device__ __forceinline__ void p2_sample_item(const Ptrs& P, int it, int lane) {
    const int b = it / 37, ty = it - b * 37;
    const float* pr = (const float*)(P.ws + WS_PROJS) + (size_t)b * NP;
    const float* ropes = (const float*)(P.ws + WS_ROPE) + (size_t)8192 * 64;
    float* kvn = (float*)(P.ws + WS_KVN) + (size_t)b * 768;
    if (ty < 14) {
        const bool isq = ty < 8; const int br = isq ? 0 : (ty - 8) >> 1, g = (ty - 8) & 1;
        const int pn = isq ? 8 + (ty >> 2) : 10 + br, wc = isq ? (ty & 3) : g;
        const float v = pr[projs_col(pn, wc, lane)];
        const float ss = wave_sum(v * v); const float inv = 1.0f / sqrtf(ss * (1.0f / 64.0f) + NORM_EPS);
        const float gn = isq ? P.q_gain[lane] : P.k_gain[br * 64 + lane];
        const float xn = v * inv * gn; const float xo = __shfl_xor(xn, 32);
        const int i = lane & 31; const float cs = ropes[i], sn = ropes[32 + i];
        const float o = (lane < 32) ? xn * cs - xo * sn : xn * cs + xo * sn;
        if (isq) ((float*)(P.ws + WS_QS))[(size_t)b * 512 + ty * 64 + lane] = o * QSCALE;
        else { kvn[(br * 2 + 0) * 128 + g * 64 + lane] = o;
            if (br == 0) P.out[O_SCMP + (size_t)b * 256 + g * 64 + lane] = o; else if (br == 1) P.out[O_SSLC + (size_t)b * 256 + g * 64 + lane] = o;
            else P.out[O_SWIN + ((size_t)b * 512 + 511) * 256 + g * 64 + lane] = o; }
    } else if (ty < 20) {
        const int br = (ty - 14) >> 1, g = (ty - 14) & 1; const float v = pr[projs_col(10 + br, 2 + g, lane)];
        kvn[(br * 2 + 1) * 128 + g * 64 + lane] = v;
        if (br == 0) P.out[O_SCMP + (size_t)b * 256 + 128 + g * 64 + lane] = v; else if (br == 1) P.out[O_SSLC + (size_t)b * 256 + 128 + g * 64 + lane] = v;
        else P.out[O_SWIN + ((size_t)b * 512 + 511) * 256 + 128 + g * 64 + lane] = v;
    } else if (ty == 20) {
        if (lane < 24) ((float*)(P.ws + WS_GS))[b * 24 + lane] = sigmoidf(pr[256 * 15 + lane]);
    } else if (ty < 29) {
        const int ch = (ty - 21) * 64 + lane; const int pnb = ch >> 7, tc = ch & 127;
        const float bg = pr[256 * pnb + tc], zc = pr[256 * pnb + 128 + tc], cg = pr[256 * (4 + pnb) + tc], ci = pr[256 * (4 + pnb) + 128 + tc];
        const float u = cg * ci; const float s0 = P.st_conv[(size_t)b * 1024 + ch], s1 = P.st_conv[(size_t)b * 1024 + 512 + ch];
        const float cy = P.conv_w[ch] * s0 + P.conv_w[512 + ch] * s1 + P.conv_w[1024 + ch] * u + P.conv_b[ch];
        ((bf16*)(P.ws + WS_MIXS))[(size_t)b * 1024 + ch] = (bf16)f2bf(bg * cy * zc * sigmoidf(zc));
        P.out[O_SCONV + (size_t)b * 1024 + 512 + ch] = u;
    } else {
        const int col = (ty - 29) * 64 + lane; const float z = pr[256 * (13 + (col >> 8)) + (col & 255)];
        ((float*)(P.ws + WS_ZAS))[(size_t)b * 512 + col] = z * sigmoidf(z);
    }
}
__device__ __forceinline__ void p2_phase(const Ptrs& P, Frame& F) {
    compress_units<false>(P, F, (LAS float*)(F.lds + RING_OFF));
    for (int it = F.gw; it < DECB * 37; it += F.NGW) p2_sample_item(P, it, F.lane);
}
#define MFMA32(a, b, c) __builtin_amdgcn_mfma_f32_32x32x16_bf16(a, b, c, 0, 0, 0)
constexpr int P3_IMP = 0, P3_QL = 32768;
constexpr int P3_NEXT = LDSCTL_OFF + 512, P3_CNT = LDSCTL_OFF + 1024, P3_LISTS = LDSCTL_OFF + 2048, P3_LACC = LDSCTL_OFF + 10240;
constexpr int P3_RING = 65536;
constexpr int P3_MISC = MISC_OFF + 64;
constexpr int SM_Q = 36864, SM_P = 40960, SM_RED = 57344, SM_IMP = 66048, SM_L = 67200, SM_SEL = 67328, SM_O = 67584, SM_VP = 71680  , SM_RED2 = 79872  ;

template <bool MASK>
__device__ __forceinline__ void attend_lds(const LAS unsigned char* blk, const bf16x8 (&qf)[4], f32x16 (&O)[2], float& lsum,
                                           int kbase, int lo, int hi, int lane, bool want_pv, f32x16 (*Sout)[2] = nullptr) {
    const int r = lane & 31, hh = lane >> 5, swz = (r >> 1) & 7;
    const LAS unsigned char* kb = blk + r * 128; const LAS unsigned char* vb = blk + 8192 + r * 128;
#pragma unroll
    for (int kt = 0; kt < 2; ++kt) {
        f32x16 S;
        { bf16x8 kf[4];
#pragma unroll
          for (int s = 0; s < 4; ++s) kf[s] = *(const LAS bf16x8*)(kb + kt * 4096 + (((2 * s + hh) ^ swz) << 4));
#pragma unroll
          for (int i = 0; i < 16; ++i) S[i] = 0.f;
#pragma unroll
          for (int s = 0; s < 4; ++s) S = MFMA32(kf[s], qf[s], S); }
#pragma unroll
        for (int i = 0; i < 16; ++i) { float p = fast_exp2(S[i]);
            if (MASK) { const int kp = kbase + 32 * kt + (i & 3) + 8 * (i >> 2) + 4 * hh; p = (kp >= lo && kp <= hi) ? p : 0.f; }
            S[i] = p; lsum += p; }
        if (Sout) (*Sout)[kt] = S;
        if (want_pv) {
            bf16x8 pf[2];
#pragma unroll
            for (int sp = 0; sp < 2; ++sp) { v4u w; w.x = pk2(S[8 * sp + 0], S[8 * sp + 1]); w.y = pk2(S[8 * sp + 2], S[8 * sp + 3]);
                w.z = pk2(S[8 * sp + 4], S[8 * sp + 5]); w.w = pk2(S[8 * sp + 6], S[8 * sp + 7]); pf[sp] = __builtin_bit_cast(bf16x8, w); }
#pragma unroll
            for (int dt = 0; dt < 2; ++dt)
#pragma unroll
                for (int sp = 0; sp < 2; ++sp) { const bf16x8 vf = *(const LAS bf16x8*)(vb + dt * 4096 + (((2 * (2 * kt + sp) + hh) ^ swz) << 4));
                    O[dt] = MFMA32(vf, pf[sp], O[dt]); }
        }
    }
}
__device__ __forceinline__ void wave_topk(const LAS float* imp, int jmax, int nsel, int lane, int qbase, LAS unsigned* cnt, LAS unsigned char* lists) {
    if (jmax < 1) return;
    const bool c0 = lane >= 1 && lane <= jmax, c1 = 64 + lane <= jmax;
    unsigned k0[8], k1[8], Tv[8];
#pragma unroll
    for (int qi = 0; qi < 8; ++qi) { k0[qi] = c0 ? ((__builtin_bit_cast(unsigned, imp[qi * 128 + lane]) + 0x800u) & ~0x7ffu) : 0u; k1[qi] = c1 ? ((__builtin_bit_cast(unsigned, imp[qi * 128 + 64 + lane]) + 0x800u) & ~0x7ffu) : 0u; Tv[qi] = 0u; }
    if (jmax > nsel) {
        for (int bit = 30; bit >= 11; --bit) {
#pragma unroll
            for (int qi = 0; qi < 8; ++qi) { const unsigned cand = Tv[qi] | (1u << bit);
                const int cn = __popcll(__ballot(k0[qi] >= cand)) + __popcll(__ballot(k1[qi] >= cand)); Tv[qi] = cn >= nsel ? cand : Tv[qi]; } }
    }
    const unsigned long long below = (lane == 0) ? 0ull : (~0ull >> (64 - lane));
#pragma unroll
    for (int qi = 0; qi < 8; ++qi) {
        bool s0, s1;
        if (jmax > nsel) {
            const unsigned long long g0 = __ballot(k0[qi] > Tv[qi]), g1 = __ballot(k1[qi] > Tv[qi]), e0 = __ballot(k0[qi] == Tv[qi]), e1 = __ballot(k1[qi] == Tv[qi]);
            const int need = nsel - __popcll(g0) - __popcll(g1);
            const int rk0 = __popcll(e0 & below), rk1 = __popcll(e0) + __popcll(e1 & below);
            s0 = k0[qi] > Tv[qi] || (k0[qi] == Tv[qi] && rk0 < need); s1 = k1[qi] > Tv[qi] || (k1[qi] == Tv[qi] && rk1 < need);
        } else { s0 = c0; s1 = c1; }
        if (s0) { const unsigned pos = __hip_atomic_fetch_add(cnt + lane, 1u, __ATOMIC_RELAXED, __HIP_MEMORY_SCOPE_WORKGROUP); lists[lane * 64 + pos] = (unsigned char)(qbase + qi); }
        if (s1) { const unsigned pos = __hip_atomic_fetch_add(cnt + 64 + lane, 1u, __ATOMIC_RELAXED, __HIP_MEMORY_SCOPE_WORKGROUP); lists[(64 + lane) * 64 + pos] = (unsigned char)(qbase + qi); }
    }
}
struct BlkSrc { const bf16* k; const bf16* v; int vstride; };
#ifndef PROBE_SEG
#define PROBE_SEG 0
#endif
#define T_BEGIN(id) do { if (PROBE_SEG == (id)) tacc -= __builtin_readcyclecounter(); } while (0)
#define T_END(id) do { if (PROBE_SEG == (id)) tacc += __builtin_readcyclecounter(); } while (0)
__device__ __forceinline__ void p3_prompt_unit(const Ptrs& P, Frame& F, int b, int t, int g, float sh_cmp, float sh_slc, float sh_win, unsigned long long& tacc) {
    int lane = F.lane, w = F.wave, tid = F.tid; asm volatile("" : "+v"(lane), "+s"(w), "+v"(tid));
    const int col = lane & 31, hh = lane >> 5, qi = col >> 2, h = col & 3;
    const int tok = 64 * t + 8 * w + qi; const size_t row = (size_t)b * T + tok; const int qpos = tok;
    const int nck = (2 * t + 2 + 63) >> 6, nf = t >= 2 ? 3 : t + 1, nw = t >= 8 ? 9 : t + 1;
    const int n1 = nck, n2 = 2 * nck, N1 = n2 + nf;
    const bf16* KC = (const bf16*)(P.ws + WS_KC) + (size_t)(b * 2 + g) * 256 * 64; const bf16* VCT = (const bf16*)(P.ws + WS_VCT) + (size_t)(b * 2 + g) * 64 * 256;
    const bf16* KS = (const bf16*)(P.ws + WS_KS) + (size_t)(b * 2 + g) * T * 64; const bf16* VTS = (const bf16*)(P.ws + WS_VTS) + (size_t)(b * 2 + g) * 128 * 4096;
    const bf16* KW = (const bf16*)(P.ws + WS_KW) + (size_t)(b * 2 + g) * T * 64; const bf16* VTW = (const bf16*)(P.ws + WS_VTW) + (size_t)(b * 2 + g) * 128 * 4096;
    auto src1 = [&](int n) -> BlkSrc {
        if (n < n2) { const int ck = n < n1 ? n : n - n1; return BlkSrc{KC + (size_t)ck * 4096, VCT + ck * 64, 256}; }
        const int f = n - n2; const int j = f == 0 ? t : (f == 1 ? 0 : t - 1); return BlkSrc{KS + (size_t)j * 4096, VTS + (size_t)j * 4096, 64}; };
    auto src2 = [&](int n) -> BlkSrc { const int j = (t >= 8 ? t - 8 : 0) + n; return BlkSrc{KW + (size_t)j * 4096, VTW + (size_t)j * 4096, 64}; };
    const int srow = 8 * w + (lane >> 3), sch = (lane & 7) ^ ((srow >> 1) & 7);
    LAS unsigned char* ring = F.lds + P3_RING;
#define ST_DMA(bs_, n) do { LAS unsigned char* d_ = ring + ((n) & 3) * 16384 + w * 1024; \
        __builtin_amdgcn_global_load_lds((const unsigned*)((bs_).k + srow * 64 + sch * 8), (LAS unsigned*)d_, 16, 0, 0); \
        __builtin_amdgcn_global_load_lds((const unsigned*)((bs_).v + (size_t)srow * (bs_).vstride + sch * 8), (LAS unsigned*)(d_ + 8192), 16, 0, 0); } while (0)
#define BLK(n) (ring + ((n) & 3) * 16384)
#define STEP_BEGIN(SRC, n, NN) do { if (((n) & 1) == 0) { if ((n) + 2 < (NN)) { const BlkSrc b_ = SRC((n) + 2); ST_DMA(b_, (n) + 2); } if ((n) + 3 < (NN)) { const BlkSrc b_ = SRC((n) + 3); ST_DMA(b_, (n) + 3); } } } while (0)
#define STEP_END(n, NN) do { if (((n) & 1) == 1 || (n) == (NN) - 1) { asm volatile("s_waitcnt vmcnt(0)" ::: "memory"); __syncthreads(); } } while (0)
    LAS unsigned* cnt = (LAS unsigned*)(F.lds + P3_CNT); LAS unsigned char* lists = F.lds + P3_LISTS; LAS unsigned* nextb = (LAS unsigned*)(F.lds + P3_NEXT);
    LAS int* oacc = (LAS int*)ring; LAS float* lacc = (LAS float*)(F.lds + P3_LACC);
    const float FXS = fast_exp2(18.0f - sh_slc), FXI = 1.0f / FXS;
    LAS unsigned char* ql = F.lds + P3_QL;
    T_BEGIN(1); T_BEGIN(8);
    __syncthreads();
    if (tid < 128) cnt[tid] = 0u; if (tid == 128) nextb[0] = 0u;
    { const BlkSrc b0 = src1(0); ST_DMA(b0, 0); if (N1 > 1) { const BlkSrc b1 = src1(1); ST_DMA(b1, 1); } }
    { const bf16* qg = (const bf16*)(P.ws + WS_Q) + ((size_t)b * T + 64 * t) * 512 + g * 256;
      v4u tq[4];
#pragma unroll
      for (int k = 0; k < 4; ++k) { const int c = tid + 512 * k, rq = c >> 3, ch = c & 7; tq[k] = *(const GAS v4u*)(qg + (size_t)(rq >> 2) * 512 + (rq & 3) * 64 + ch * 8); }
#pragma unroll
      for (int k = 0; k < 4; ++k) { const int c = tid + 512 * k, rq = c >> 3, ch = c & 7; *(LAS v4u*)(ql + rq * 128 + ((ch ^ ((rq >> 1) & 7)) << 4)) = tq[k]; } }
    bf16x8 qf[4];
    { const bf16* q = (const bf16*)(P.ws + WS_Q) + row * 512 + (g * 4 + h) * 64 + 8 * hh;
#pragma unroll
      for (int s = 0; s < 4; ++s) qf[s] = __builtin_bit_cast(bf16x8, *(const GAS v4u*)(q + 16 * s)); }
    const float* gate = (const float*)(P.ws + WS_GATE) + row * 24 + (g * 4 + h) * 3;
    const float g_cmp = gate[0], g_slc = gate[1], g_win = gate[2];
    asm volatile("s_waitcnt vmcnt(0)" ::: "memory"); __syncthreads();
    T_END(1); T_BEGIN(2);
    f32x16 O[2];
    LAS float* wl = (LAS float*)(F.lds + P3_IMP + w * 4096);
    float* totg = (float*)(P.ws + WS_TOT) + ((size_t)blockIdx.x * 8 + w) * 2048 + lane;
    const int nvis = (qpos + 1) >> 5;
    int n = 0;
    float lsum = 0.f;
    for (; n < n1; ++n) { STEP_BEGIN(src1, n, N1); attend_lds<true>(BLK(n), qf, O, lsum, 64 * n, 0, nvis - 1, lane, false); STEP_END(n, N1); }
    lsum += __shfl_xor(lsum, 32);
    const float rl = lsum > 0.f ? 1.0f / lsum : 0.f;
    for (int i = lane; i < 1024; i += 64) wl[i] = 0.f;
#pragma unroll
    for (int i = 0; i < 16; ++i) { O[0][i] = 0.f; O[1][i] = 0.f; }
    { float dummy = 0.f;
      for (; n < n2; ++n) { STEP_BEGIN(src1, n, N1); const int ck = n - n1; f32x16 Sn[2];
        attend_lds<true>(BLK(n), qf, O, dummy, 64 * ck, 0, nvis - 1, lane, true, &Sn);
#pragma unroll
        for (int kt = 0; kt < 2; ++kt)
#pragma unroll
            for (int i2 = 0; i2 < 8; ++i2) { float v = (Sn[kt][2 * i2] + Sn[kt][2 * i2 + 1]) * rl; v += __shfl_xor(v, 1); v += __shfl_xor(v, 2);
                if (h == 0) wl[qi * 128 + 32 * ck + 16 * kt + (i2 & 1) + 4 * (i2 >> 1) + 2 * hh] = v; }
        STEP_END(n, N1); } }
    LDS_WAIT(); asm volatile("" ::: "memory");
    T_END(2); T_BEGIN(3);
    wave_topk(wl, t - 2, 13, lane, 8 * w, cnt, lists);
#pragma unroll
    for (int i = 0; i < 16; ++i) { totg[i * 64] = O[0][i] * (g_cmp * rl); totg[(16 + i) * 64] = O[1][i] * (g_cmp * rl); O[0][i] = 0.f; O[1][i] = 0.f; }
    T_END(3); T_BEGIN(4);
    lsum = 0.f;
    for (; n < N1; ++n) { STEP_BEGIN(src1, n, N1);
        if (n == n2) attend_lds<true>(BLK(n), qf, O, lsum, 64 * t, 0, qpos, lane, true);
        else attend_lds<false>(BLK(n), qf, O, lsum, 0, 0, 0, lane, true);
        STEP_END(n, N1); }
    lsum += __shfl_xor(lsum, 32);
#pragma unroll
    for (int dt = 0; dt < 2; ++dt)
#pragma unroll
        for (int i = 0; i < 16; ++i) oacc[(32 * dt + (i & 3) + 8 * (i >> 2) + 4 * hh) * 256 + 32 * w + col] = __float2int_rn(O[dt][i] * FXS);
    if (hh == 0) lacc[32 * w + col] = lsum;
    __syncthreads();
    T_END(4); T_BEGIN(5);
    if (t > 2) {
        const int r = lane & 31;
#define NEXT_BLOCK(jv_, nq_) do { for (;;) { unsigned t_ = 0u; if (lane == 0) t_ = __hip_atomic_fetch_add(nextb, 1u, __ATOMIC_RELAXED, __HIP_MEMORY_SCOPE_WORKGROUP); \
            jv_ = 1 + (int)__builtin_amdgcn_readfirstlane(t_); if (jv_ > t - 2) { nq_ = 0; break; } nq_ = (int)__builtin_amdgcn_readfirstlane(cnt[jv_]); if (nq_ > 0) break; } } while (0)
#define LOAD_FRAGS(kd_, vd_, jv_) do { const bf16* kp_ = KS + (size_t)(jv_) * 4096 + r * 64 + 8 * hh; const bf16* vp_ = VTS + (size_t)(jv_) * 4096 + r * 64 + 8 * hh; \
            _Pragma("unroll") for (int a_ = 0; a_ < 2; ++a_) _Pragma("unroll") for (int b_ = 0; b_ < 4; ++b_) { kd_[a_][b_] = __builtin_bit_cast(bf16x8, *(const GAS v4u*)(kp_ + a_ * 2048 + 16 * b_)); \
                vd_[a_][b_] = __builtin_bit_cast(bf16x8, *(const GAS v4u*)(vp_ + a_ * 2048 + 16 * b_)); } } while (0)
        bf16x8 kf[2][4], vf[2][4], kn[2][4], vn[2][4];
        int j, nq; NEXT_BLOCK(j, nq);
        if (j <= t - 2) LOAD_FRAGS(kf, vf, j);
        while (j <= t - 2) {
            int jn, nqn; NEXT_BLOCK(jn, nqn);
            if (jn <= t - 2) LOAD_FRAGS(kn, vn, jn);
#pragma unroll
            for (int a_ = 0; a_ < 2; ++a_)
#pragma unroll
                for (int b_ = 0; b_ < 4; ++b_) asm volatile("" : "+v"(kf[a_][b_]), "+v"(vf[a_][b_]));
            for (int c0 = 0; c0 < nq; c0 += 8) {
                const int sl = c0 + qi; const bool valid = sl < nq;
                const int rowq = (int)lists[j * 64 + (valid ? sl : nq - 1)] * 4 + h;
                const LAS unsigned char* qp = ql + rowq * 128; const int qsw = (rowq >> 1) & 7;
                bf16x8 q2[4];
#pragma unroll
                for (int s = 0; s < 4; ++s) q2[s] = *(const LAS bf16x8*)(qp + (((2 * s + hh) ^ qsw) << 4));
                float l2 = 0.f; bf16x8 pf[4];
#pragma unroll
                for (int kt = 0; kt < 2; ++kt) { f32x16 S;
#pragma unroll
                    for (int i = 0; i < 16; ++i) S[i] = 0.f;
#pragma unroll
                    for (int s = 0; s < 4; ++s) S = MFMA32(kf[kt][s], q2[s], S);
#pragma unroll
                    for (int i = 0; i < 16; ++i) { S[i] = fast_exp2(S[i]); l2 += S[i]; }
#pragma unroll
                    for (int sp = 0; sp < 2; ++sp) { v4u wv; wv.x = pk2(S[8 * sp + 0], S[8 * sp + 1]); wv.y = pk2(S[8 * sp + 2], S[8 * sp + 3]);
                        wv.z = pk2(S[8 * sp + 4], S[8 * sp + 5]); wv.w = pk2(S[8 * sp + 6], S[8 * sp + 7]); pf[2 * kt + sp] = __builtin_bit_cast(bf16x8, wv); } }
                l2 += __shfl_xor(l2, 32);
                T_BEGIN(9);
#pragma unroll
                for (int dt = 0; dt < 2; ++dt) { f32x16 O2;
#pragma unroll
                    for (int i = 0; i < 16; ++i) O2[i] = 0.f;
#pragma unroll
                    for (int ks = 0; ks < 4; ++ks) O2 = MFMA32(vf[dt][ks], pf[ks], O2);
                    if (valid) {
#pragma unroll
                        for (int i = 0; i < 16; ++i) (void)__hip_atomic_fetch_add(oacc + (32 * dt + (i & 3) + 8 * (i >> 2) + 4 * hh) * 256 + rowq, __float2int_rn(O2[i] * FXS), __ATOMIC_RELAXED, __HIP_MEMORY_SCOPE_WORKGROUP); } }
                if (valid) {
                    if (hh == 0) (void)__hip_atomic_fetch_add(lacc + rowq, l2, __ATOMIC_RELAXED, __HIP_MEMORY_SCOPE_WORKGROUP); }
                LDS_WAIT(); T_END(9);
            }
            j = jn; nq = nqn;
#pragma unroll
            for (int a_ = 0; a_ < 2; ++a_)
#pragma unroll
                for (int b_ = 0; b_ < 4; ++b_) { kf[a_][b_] = kn[a_][b_]; vf[a_][b_] = vn[a_][b_]; }
        }
#undef NEXT_BLOCK
#undef LOAD_FRAGS
    }
    __syncthreads();
    T_END(5); T_BEGIN(6);
    LAS float* x0 = (LAS float*)(F.lds + P3_IMP + w * 4096) + lane; LAS float* x1 = (LAS float*)(F.lds + P3_QL + w * 4096) + lane;
    { const float sc = g_slc / fmaxf(lacc[32 * w + col], 1e-30f);
#pragma unroll
      for (int i = 0; i < 16; ++i) { const int dr = (i & 3) + 8 * (i >> 2) + 4 * hh;
          x0[i * 64] = totg[i * 64] + (float)oacc[dr * 256 + 32 * w + col] * (FXI * sc); x1[i * 64] = totg[(16 + i) * 64] + (float)oacc[(32 + dr) * 256 + 32 * w + col] * (FXI * sc); O[0][i] = 0.f; O[1][i] = 0.f; } }
    LDS_WAIT(); __syncthreads();
    { const BlkSrc b0 = src2(0); ST_DMA(b0, 0); if (nw > 1) { const BlkSrc b1 = src2(1); ST_DMA(b1, 1); } }
    { asm volatile("" : "+v"(lane));
      const bf16* q = (const bf16*)(P.ws + WS_Q) + row * 512 + (g * 4 + h) * 64 + 8 * hh;
#pragma unroll
      for (int s = 0; s < 4; ++s) qf[s] = __builtin_bit_cast(bf16x8, *(const GAS v4u*)(q + 16 * s)); }
    asm volatile("s_waitcnt vmcnt(0)" ::: "memory"); __syncthreads();
    lsum = 0.f;
    for (n = 0; n < nw; ++n) { STEP_BEGIN(src2, n, nw); const int j = (t >= 8 ? t - 8 : 0) + n;
        if (j == t || j + 8 == t) attend_lds<true>(BLK(n), qf, O, lsum, 64 * j, qpos - 511, qpos, lane, true);
        else attend_lds<false>(BLK(n), qf, O, lsum, 0, 0, 0, lane, true);
        STEP_END(n, nw); }
    lsum += __shfl_xor(lsum, 32);
    { const float sc = g_win / fmaxf(lsum, 1e-30f);
#pragma unroll
      for (int i = 0; i < 16; ++i) { O[0][i] = x0[i * 64] + O[0][i] * sc; O[1][i] = x1[i * 64] + O[1][i] * sc; } }
#undef ST_DMA
#undef BLK
#undef STEP_BEGIN
#undef STEP_END
    T_END(6); T_BEGIN(7);
    asm volatile("" : "+v"(lane));
    const int col_ = lane & 31, hh_ = lane >> 5, h_ = col_ & 3; const size_t row_ = (size_t)b * T + 64 * t + 8 * w + (col_ >> 2);
    const bf16* za = (const bf16*)(P.ws + WS_ZA) + row_ * 512 + (g * 4 + h_) * 64; bf16* mx = (bf16*)(P.ws + WS_MIX) + row_ * 1024 + 512 + (g * 4 + h_) * 64;
#pragma unroll
    for (int dt = 0; dt < 2; ++dt)
#pragma unroll
        for (int i4 = 0; i4 < 4; ++i4) { const int d = 32 * dt + 8 * i4 + 4 * hh_; const v2u z = *(const GAS v2u*)(za + d);
            v2u o; o.x = pk2(O[dt][4 * i4] * bf2f(z.x & 0xffffu), O[dt][4 * i4 + 1] * bf2f(z.x >> 16)); o.y = pk2(O[dt][4 * i4 + 2] * bf2f(z.y & 0xffffu), O[dt][4 * i4 + 3] * bf2f(z.y >> 16));
            *(GAS v2u*)(mx + d) = o; }
    if (g == 0) { const int tq = w, c8 = lane * 8; const size_t r0 = (size_t)b * T + 64 * t + 8 * tq;
        const bf16* U = (const bf16*)(P.ws + WS_U) + c8; const bf16* CGp = (const bf16*)(P.ws + WS_CG) + c8; bf16* mo = (bf16*)(P.ws + WS_MIX) + c8;
        v4u ur[10], cr[8];
        const bool has_prev = (t > 0) || (tq > 0);
#pragma unroll
        for (int i = 0; i < 10; ++i) ur[i] = (i >= 2 || has_prev) ? *(const GAS v4u*)(U + (r0 + i - 2) * 512) : (v4u){0u, 0u, 0u, 0u};
#pragma unroll
        for (int i = 0; i < 8; ++i) cr[i] = *(const GAS v4u*)(CGp + (r0 + i) * 512);
        float w0[8], w1[8], w2[8], cb[8];
#pragma unroll
        for (int e = 0; e < 8; ++e) { w0[e] = P.conv_w[c8 + e]; w1[e] = P.conv_w[512 + c8 + e]; w2[e] = P.conv_w[1024 + c8 + e]; cb[e] = P.conv_b[c8 + e]; }
#pragma unroll
        for (int i = 0; i < 8; ++i) { float o[8];
#pragma unroll
            for (int e = 0; e < 8; ++e) { const int sh_ = (e & 1) * 16; const float a = bf2f((ur[i][e >> 1] >> sh_) & 0xffffu), bb = bf2f((ur[i + 1][e >> 1] >> sh_) & 0xffffu), c = bf2f((ur[i + 2][e >> 1] >> sh_) & 0xffffu);
                o[e] = bf2f((cr[i][e >> 1] >> sh_) & 0xffffu) * (w0[e] * a + w1[e] * bb + w2[e] * c + cb[e]); }
            v4u ov; ov.x = pk2(o[0], o[1]); ov.y = pk2(o[2], o[3]); ov.z = pk2(o[4], o[5]); ov.w = pk2(o[6], o[7]);
            *(GAS v4u*)(mo + (r0 + i) * 1024) = ov; } }
    T_END(7); T_END(8);
}
template <class KeyFn>
__device__ __forceinline__ void sample_branch(Frame& F, int nslots, float shift, const KeyFn& key, LAS float* obr) {
    LAS float* q = (LAS float*)(F.lds + SM_Q); LAS float* Pb = (LAS float*)(F.lds + SM_P); LAS float* red = (LAS float*)(F.lds + SM_RED); LAS float* lsm = (LAS float*)(F.lds + SM_L);
    LAS unsigned long long* vptr = (LAS unsigned long long*)(F.lds + SM_VP);
    float lacc[4] = {0.f, 0.f, 0.f, 0.f};
    for (int s = F.tid; s < nslots; s += 512) { const float* kp; const float* vp; const bool valid = key(s, kp, vp);
        float sc[4] = {0.f, 0.f, 0.f, 0.f};
        if (valid) {
#pragma unroll 4
            for (int d4 = 0; d4 < 16; ++d4) { const f32x4 kv = *(const GAS f32x4*)(kp + 4 * d4);
#pragma unroll
                for (int hq = 0; hq < 4; ++hq) { const f32x4 qv = *(const LAS f32x4*)(q + hq * 64 + 4 * d4); sc[hq] += (kv.x * qv.x + kv.y * qv.y) + (kv.z * qv.z + kv.w * qv.w); } } }
        f32x4 p;
#pragma unroll
        for (int hq = 0; hq < 4; ++hq) { p[hq] = valid ? fast_exp2(sc[hq] - shift) : 0.f; lacc[hq] += p[hq]; }
        *(LAS f32x4*)(Pb + 4 * s) = p; vptr[s] = (unsigned long long)(uintptr_t)vp; }
#pragma unroll
    for (int hq = 0; hq < 4; ++hq) { lacc[hq] = wave_sum(lacc[hq]); if (F.lane == 0) red[F.wave * 4 + hq] = lacc[hq]; }
    __syncthreads();
    if (F.tid < 4) { float s = 0.f; for (int ww = 0; ww < 8; ++ww) s += red[ww * 4 + F.tid]; lsm[F.tid] = s; }
    const int sg = F.tid >> 4, d4 = F.tid & 15;
    f32x4 oa[4];
#pragma unroll
    for (int hq = 0; hq < 4; ++hq) oa[hq] = (f32x4){0.f, 0.f, 0.f, 0.f};
    for (int s0 = sg; s0 < nslots; s0 += 256) {
        f32x4 vv[8], pp[8];
#pragma unroll
        for (int u = 0; u < 8; ++u) { const int s = s0 + 32 * u; const float* vp = (const float*)(uintptr_t)vptr[s]; vv[u] = *(const GAS f32x4*)(vp + 4 * d4); pp[u] = *(const LAS f32x4*)(Pb + 4 * s); }
#pragma unroll
        for (int u = 0; u < 8; ++u) { oa[0] = oa[0] + vv[u] * pp[u].x; oa[1] = oa[1] + vv[u] * pp[u].y; oa[2] = oa[2] + vv[u] * pp[u].z; oa[3] = oa[3] + vv[u] * pp[u].w; } }
    __syncthreads();
    LAS float* red2 = (LAS float*)(F.lds + SM_RED2);
#pragma unroll
    for (int hq = 0; hq < 4; ++hq) *(LAS f32x4*)(red2 + (sg * 4 + hq) * 64 + 4 * d4) = oa[hq];
    __syncthreads();
    if (F.tid < 256) { float s = 0.f;
#pragma unroll 8
        for (int g2 = 0; g2 < 32; ++g2) s += red2[g2 * 256 + F.tid]; obr[F.tid] = s; }
    __syncthreads();
}
__device__ __forceinline__ void p3_sample_unit(const Ptrs& P, Frame& F, int b, int g) {
    asm volatile("" : "+v"(F.tid), "+v"(F.lane), "+s"(F.wave));
    LAS float* q = (LAS float*)(F.lds + SM_Q); LAS float* Pb = (LAS float*)(F.lds + SM_P); LAS float* imp = (LAS float*)(F.lds + SM_IMP); LAS float* lsm = (LAS float*)(F.lds + SM_L);
    LAS int* sel = (LAS int*)(F.lds + SM_SEL); LAS float* osm = (LAS float*)(F.lds + SM_O);
    const float* cst = (const float*)(P.ws + WS_CONST);
    float kcmax = 0.f; for (int e_ = 0; e_ < 4; ++e_) kcmax += __builtin_bit_cast(float, __hip_atomic_load((unsigned*)(P.ws + WS_CTL) + CW_KCMAX + 64 + e_, RLX_AGENT));
    const float sh_cmp = cst[0] * sqrtf(kcmax) * LOG2E * 1.001f, sh_slc = cst[1], sh_win = cst[2];
    if (F.tid < 256) q[F.tid] = ((const float*)(P.ws + WS_QS))[(size_t)b * 512 + g * 256 + F.tid];
    __syncthreads();
    const float* kcs = (const float*)(P.ws + WS_KCS) + (size_t)(b * 2 + g) * 2 * NCS * 64;
    sample_branch(F, NCS, sh_cmp, [&](int s, const float*& kp, const float*& vp) { kp = kcs + (size_t)s * 64; vp = kcs + (size_t)(NCS + s) * 64; return true; }, osm);
    { const f32x4 p = *(const LAS f32x4*)(Pb + 4 * F.tid); float v = p.x / lsm[0] + p.y / lsm[1] + p.z / lsm[2] + p.w / lsm[3]; v += __shfl_xor(v, 1);
      if ((F.tid & 1) == 0) imp[F.tid >> 1] = v; if (F.tid < 4) imp[256 + F.tid] = 0.f; }
    if (F.tid < 256) osm[F.tid] = osm[F.tid] / lsm[F.tid >> 6];
    __syncthreads();
    if (F.wave == 0) { const int lane = F.lane; unsigned k[4];
#pragma unroll
        for (int i = 0; i < 4; ++i) { const int j = lane + 64 * i; k[i] = (j >= 1 && j <= 254) ? __builtin_bit_cast(unsigned, imp[j]) + 1u : 0u; }
        unsigned Tv = 0u;
        for (int bit = 30; bit >= 0; --bit) { const unsigned cand = Tv | (1u << bit); int cnt = 0;
#pragma unroll
            for (int i = 0; i < 4; ++i) cnt += __popcll(__ballot(k[i] >= cand));
            if (cnt >= 13) Tv = cand; }
        int ngt = 0;
#pragma unroll
        for (int i = 0; i < 4; ++i) ngt += __popcll(__ballot(k[i] > Tv));
        const int need = 13 - ngt; const unsigned long long below = (lane == 0) ? 0ull : (~0ull >> (64 - lane));
        int base = 3, eqbase = 0;
        if (lane == 0) { int z_ = 0; asm volatile("" : "+v"(z_)); sel[0] = z_; sel[1] = z_ + 255; sel[2] = z_ + 256; }
#pragma unroll
        for (int i = 0; i < 4; ++i) { const unsigned long long e = __ballot(k[i] == Tv); const int rk = eqbase + __popcll(e & below); const bool on = k[i] > Tv || (k[i] == Tv && rk < need);
            const unsigned long long m = __ballot(on); if (on) sel[base + __popcll(m & below)] = lane + 64 * i; base += __popcll(m); eqbase += __popcll(e); } }
    __syncthreads();
    const float* kvn = (const float*)(P.ws + WS_KVN) + (size_t)b * 768;
    const int* pt = P.page_table + b * NPAGES; const float* cs = P.cache_slc;
    sample_branch(F, 1024, sh_slc, [&](int s, const float*& kp, const float*& vp) { const int j = sel[s >> 6], rr = s & 63;
        if (j == 256) { kp = kvn + (1 * 2 + 0) * 128 + g * 64; vp = kvn + (1 * 2 + 1) * 128 + g * 64; return rr == 0; }
        const float* rowp = cs + ((size_t)pt[j >> 1] * 128 + (j & 1) * 64 + rr) * 256 + g * 64; kp = rowp; vp = rowp + 128; return true; }, osm + 256);
    if (F.tid < 256) osm[256 + F.tid] = osm[256 + F.tid] / lsm[F.tid >> 6];
    __syncthreads();
    const float* stw = P.st_win + (size_t)b * 512 * 256;
    sample_branch(F, 512, sh_win, [&](int s, const float*& kp, const float*& vp) {
        if (s == 511) { kp = kvn + (2 * 2 + 0) * 128 + g * 64; vp = kvn + (2 * 2 + 1) * 128 + g * 64; return true; }
        const float* rowp = stw + (size_t)(s + 1) * 256 + g * 64; kp = rowp; vp = rowp + 128; return true; }, osm + 512);
    if (F.tid < 256) { const int hq = F.tid >> 6, d = F.tid & 63; const float* gs = (const float*)(P.ws + WS_GS) + b * 24 + (g * 4 + hq) * 3;
        const float o = gs[0] * osm[F.tid] + gs[1] * osm[256 + F.tid] + gs[2] * osm[512 + F.tid] / lsm[hq];
        ((bf16*)(P.ws + WS_MIXS))[(size_t)b * 1024 + 512 + (g * 4 + hq) * 64 + d] = (bf16)f2bf(o * ((const float*)(P.ws + WS_ZAS))[(size_t)b * 512 + (g * 4 + hq) * 64 + d]); }
    __syncthreads();
}
__device__ __forceinline__ void p3_phase(const Ptrs& P, Frame& F, int rep) {
    const float* cst = (const float*)(P.ws + WS_CONST);
    float kcmax = 0.f; for (int e_ = 0; e_ < 4; ++e_) kcmax += __builtin_bit_cast(float, __hip_atomic_load((unsigned*)(P.ws + WS_CTL) + CW_KCMAX + e_, RLX_AGENT));
    const float sh_cmp = cst[0] * sqrtf(kcmax) * LOG2E * 1.001f, sh_slc = cst[1], sh_win = cst[2];
    unsigned long long tacc = 0ull;
    volatile LAS int* qw = (volatile LAS int*)(F.lds + P3_MISC);
#ifndef PROBE_P3
#define PROBE_P3 0
#endif
    constexpr int NS_ = PROBE_P3 == 1 ? 16 : 8, PSH_ = PROBE_P3 == 2 ? 1 : 0;
    constexpr int NQ = NS_ + (128 << PSH_);
    const int x0 = (int)(xb_xcc_id() & 7u);
    for (int xi = 0; xi < 8; ++xi) {
        const int x = (x0 + xi) & 7;
        for (;;) {
            __syncthreads();
            if (F.tid == 0) qw[0] = (int)__hip_atomic_fetch_add((unsigned*)(F.ctl + CW_QUEUE + 64 * (x + 8 * rep)), 1u, RLX_AGENT);
            __syncthreads();
            const int idx = qw[0];
            if (idx >= NQ) break;
            if (idx < NS_) p3_sample_unit(P, F, x * 4 + ((idx & 7) >> 1), idx & 1);
            else p3_prompt_unit(P, F, x >> 1, 127 - ((idx - NS_) >> PSH_), x & 1, sh_cmp, sh_slc, sh_win, tacc);
        }
    }
    if (PROBE_SEG != 0 && blockIdx.x == 0) { const unsigned long long t0_ = __builtin_readcyclecounter(); while (__builtin_readcyclecounter() - t0_ < tacc) __builtin_amdgcn_s_sleep(8); }
}
#ifndef MK_N_LAUNCHES
#define MK_N_LAUNCHES 1
#endif
constexpr int N_PHASES = 5;
constexpr int N_LAUNCHES = MK_N_LAUNCHES;
struct Args { Ptrs p; int ph_lo, ph_hi, rep, mode; };
__global__ void __launch_bounds__(NWAVES * 64, 2) nsa_fwd(Args args) {
    extern __shared__ __attribute__((aligned(16))) unsigned char lds[];
    const Ptrs& P = args.p;
    Frame F;
    F.lds = (LAS unsigned char*)lds;
    F.MISC = (volatile LAS unsigned*)(F.lds + MISC_OFF);
    F.tid = threadIdx.x; F.lane = F.tid & 63; F.wave = __builtin_amdgcn_readfirstlane(F.tid >> 6);
    F.G = gridDim.x; F.gw = blockIdx.x * NWAVES + F.wave; F.NGW = F.G * NWAVES;
    F.ctl = (gu32*)(P.ws + WS_CTL);
    for (int u = F.tid; u < (LDS_BYTES - LDSCTL_OFF) / 4; u += NWAVES * 64) ((LAS unsigned*)(F.lds + LDSCTL_OFF))[u] = 0u;
    __syncthreads();
    XcdBarrier bar; bar.bar = (unsigned*)(F.ctl + CW_BAR); bar.x = 0; bar.st = nullptr;
    if (N_LAUNCHES == 1) bar = xcd_barrier_post((unsigned*)(F.ctl + CW_BAR), F.MISC + 8);
    const int lo = args.ph_lo, hi = args.ph_hi;
    unsigned long long tprobe = 0ull;
#define IN(k) (lo <= (k) && (k) < hi)
#define FENCE() do { asm volatile("" : "+s"(F.wave), "+s"(F.gw)); F.lane = (int)__builtin_amdgcn_mbcnt_hi(~0u, __builtin_amdgcn_mbcnt_lo(~0u, 0u)); F.tid = F.wave * 64 + F.lane; asm volatile("" : "+v"(F.tid), "+v"(F.lane)); } while (0)
#define SEAM(k) do { if (IN(k) && IN((k) + 1)) xcd_barrier(bar, F.wave == 0 && (int)__builtin_amdgcn_mbcnt_hi(~0u, __builtin_amdgcn_mbcnt_lo(~0u, 0u)) == 0); } while (0)

    if (IN(0)) { FENCE(); p0_phase(P, F); } SEAM(0);
    if (IN(1)) { FENCE();
        pg8::Gemm g{(const pg8::bf16_t*)(P.ws + WS_XB), (const pg8::bf16_t*)(P.ws + WS_BT1), M, NP, D}; pg8::StaticOrder S; S.init(M, NP, F.G, (int)blockIdx.x);
        EpiIn E{(const float*)(P.ws + WS_RSTD), (const float*)(P.ws + WS_ROPE), P.q_gain, P.k_gain, P.out, P.ws};
        pg8::gemm_phase<EpiIn, pg8::StaticOrder, true, true>(F.lds + RING_OFF, g, S, E, F.wave, tprobe);
        FENCE();
        for (int ct = F.gw; ct < NP / 16; ct += F.NGW) small_gemm_tile<0>(P, (const bf16*)(P.ws + WS_XSB), (const bf16*)(P.ws + WS_BT1), ct, F.lane);
#if defined(PROBE_EPI)
        if (PROBE_EPI == 1 && blockIdx.x == 0) { const unsigned long long t0_ = __builtin_readcyclecounter(); while (__builtin_readcyclecounter() - t0_ < tprobe) __builtin_amdgcn_s_sleep(8); }
        tprobe = 0ull;
#endif
    } SEAM(1);
    if (IN(2)) { FENCE(); p2_phase(P, F); } SEAM(2);
    if (IN(3)) { FENCE(); p3_phase(P, F, args.rep); } SEAM(3);
    if (IN(4)) { FENCE();
        pg8::Gemm g{(const pg8::bf16_t*)(P.ws + WS_MIX), (const pg8::bf16_t*)(P.ws + WS_BT2), M, D, D}; pg8::StaticOrder S; S.init(M, D, F.G, (int)blockIdx.x);
        EpiOut E{P.xp, P.out + O_Y};
        pg8::gemm_phase<EpiOut, pg8::StaticOrder, true, true>(F.lds + RING_OFF, g, S, E, F.wave, tprobe);
        FENCE();
        for (int ct = F.gw; ct < D / 16; ct += F.NGW) small_gemm_tile<1>(P, (const bf16*)(P.ws + WS_MIXS), (const bf16*)(P.ws + WS_BT2), ct, F.lane);
#if defined(PROBE_EPI)
        if (PROBE_EPI == 2 && blockIdx.x == 0) { const unsigned long long t0_ = __builtin_readcyclecounter(); while (__builtin_readcyclecounter() - t0_ < tprobe) __builtin_amdgcn_s_sleep(8); }
#endif
    }
#undef IN
#undef SEAM
}

extern "C" void kernel_launch(void* const* d_in, const int* in_sizes, int n_in, void* d_out, int out_size, void* d_ws, size_t ws_size, hipStream_t stream) {
    static int grid = 0;
    if (grid == 0) {
        if (n_in != 16 || out_size != (int)O_END || ws_size < WS_END) { fprintf(stderr, "kernel_launch: unexpected shapes (n_in %d, out %d, ws %zu)\n", n_in, out_size, ws_size); grid = -1; return; }
        int dev = 0, cus = 0, per_cu = 0;
        if (hipGetDevice(&dev) != hipSuccess || hipDeviceGetAttribute(&cus, hipDeviceAttributeMultiprocessorCount, dev) != hipSuccess) { grid = -1; return; }
        if (hipFuncSetAttribute((const void*)nsa_fwd, hipFuncAttributeMaxDynamicSharedMemorySize, LDS_BYTES) != hipSuccess) { fprintf(stderr, "kernel_launch: hipFuncSetAttribute failed\n"); grid = -1; return; }
        if (hipOccupancyMaxActiveBlocksPerMultiprocessor(&per_cu, (const void*)nsa_fwd, NWAVES * 64, LDS_BYTES) != hipSuccess || per_cu < 1)
            fprintf(stderr, "kernel_launch: note: occupancy query reports %d workgroups per CU\n", per_cu);
        (void)hipGetLastError();
        grid = cus;
    }
    if (grid < 0) return;
    if (hipMemsetAsync((char*)d_ws + WS_CTL, 0, CTL_ZERO_BYTES, stream) != hipSuccess) return;
    Args a{}; a.mode = 3;
    a.p.xp = (const float*)d_in[0]; a.p.xs = (const float*)d_in[1]; a.p.cache_cmp = (const float*)d_in[2]; a.p.cache_slc = (const float*)d_in[3];
    a.p.st_win = (const float*)d_in[4]; a.p.st_conv = (const float*)d_in[5]; a.p.page_table = (const int*)d_in[6]; a.p.norm_g = (const float*)d_in[7];
    a.p.w_in = (const float*)d_in[8]; a.p.conv_w = (const float*)d_in[9]; a.p.conv_b = (const float*)d_in[10]; a.p.q_gain = (const float*)d_in[11];
    a.p.k_gain = (const float*)d_in[12]; a.p.cmp_pe = (const float*)d_in[13]; a.p.cmp_w = (const float*)d_in[14]; a.p.w_out = (const float*)d_in[15];
    a.p.out = (float*)d_out; a.p.ws = (unsigned char*)d_ws;
#ifndef PROBE_DUP
#define PROBE_DUP -1
#endif
    for (int li = 0; li < N_LAUNCHES; ++li) {
        a.ph_lo = (N_LAUNCHES == 1) ? 0 : li; a.ph_hi = (N_LAUNCHES == 1) ? N_PHASES : li + 1;
        for (int rep = 0; rep < ((N_LAUNCHES > 1 && li == PROBE_DUP) ? 2 : 1); ++rep) {
            a.rep = rep;
            hipLaunchKernelGGL(nsa_fwd, dim3(grid), dim3(NWAVES * 64), LDS_BYTES, stream, a);
            const hipError_t le = hipPeekAtLastError();
            if (le != hipSuccess) { fprintf(stderr, "kernel_launch: launch %d failed: %s\n", li, hipGetErrorName(le)); break; }
        }
    }
}
```

```cpp
#include <hip/hip_runtime.h>
#include <cstdio>
#include <cstdint>
#define GAS __attribute__((address_space(1)))
#define LAS __attribute__((address_space(3)))
typedef unsigned short bf16;
typedef unsigned v4u __attribute__((ext_vector_type(4)));
typedef unsigned v2u __attribute__((ext_vector_type(2)));
typedef float f32x2 __attribute__((ext_vector_type(2)));
typedef float f32x16 __attribute__((ext_vector_type(16)));
typedef GAS unsigned gu32;
typedef GAS unsigned long long gu64;
#define RLX_AGENT __ATOMIC_RELAXED, __HIP_MEMORY_SCOPE_AGENT
#define LDS_WAIT() asm volatile("s_waitcnt lgkmcnt(0)" ::: "memory")
#define VM_WAIT() asm volatile("s_waitcnt vmcnt(0)" ::: "memory")
#define MK_N_LAUNCHES 1
#define PROBE_DUP -1
#define PROBE_P3 0
#define PROBE_SEG 0
namespace pg8 {
#define PG8_LAS __attribute__((address_space(3)))
typedef unsigned short bf16_t;
typedef short bf16x8 __attribute__((ext_vector_type(8)));
typedef float f32x4 __attribute__((ext_vector_type(4)));
typedef unsigned u32x4 __attribute__((ext_vector_type(4)));
constexpr int BM = 256, BK = 64, HALF = 128, HTB = HALF * BK * 2  , STAGE_BYTES = 8 * HTB, NXCD = 8, WGM = 8;

__host__ __device__ __forceinline__ int lds_byte(int r, int c) { const int st = (r >> 4) * 2 + (c >> 5), rr = r & 15, cc = c & 31, ob = rr * 64 + cc * 2; return st * 1024 + (ob ^ (((ob >> 9) & 1) << 5)); }
__host__ __device__ __forceinline__ void stage_rc(int b, int& R, int& C) { const int st = b / 1024, sb = b % 1024, swz = sb ^ (((sb >> 9) & 1) << 5); R = (st >> 1) * 16 + swz / 64; C = (st & 1) * 32 + (swz % 64) / 2; }
__host__ __device__ __forceinline__ int perm32(int rho) { const int n = rho >> 4, i = rho & 15; return 8 * (i >> 2) + 4 * n + (i & 3); }

struct Unit { int pm, pn; };
struct Gemm { const bf16_t* A; const bf16_t* Bt; int M, N, K; };

struct StaticOrder {
    int nM, nN, nwg, G, c;
    __host__ __device__ void init(int M, int N, int G_, int c_) { nM = M / BM; nN = N / BM; nwg = nM * nN; G = G_; c = c_; }
    __host__ __device__ bool next(int i, Unit& u) const {
        const long L = (long)i * G + c; if (L >= nwg) return false;
        int wgid = (int)L; { const int q = nwg / NXCD, r = nwg % NXCD, xcd = wgid % NXCD, off = wgid / NXCD; wgid = (xcd < r ? xcd * (q + 1) : r * (q + 1) + (xcd - r) * q) + off; }
        const int nig = WGM * nN, gid = wgid / nig, fm = gid * WGM, gsz = (nM - fm) < WGM ? (nM - fm) : WGM;
        u.pm = fm + ((wgid % nig) % gsz); u.pn = (wgid % nig) / gsz; return true;
    }
    __device__ __forceinline__ void a_ready(const Unit&) const {}
    __device__ __forceinline__ void done(const Unit&) const {}
};


template <class Epi, class Sched, bool ALIGN_EPI = false, bool SP2 = false>
__device__ __forceinline__ void gemm_phase(PG8_LAS unsigned char* lds, const Gemm g, const Sched& S, const Epi& E, int wave_id  , unsigned long long& tacc_  ) {
    const int lane = (int)__builtin_amdgcn_mbcnt_hi(~0u, __builtin_amdgcn_mbcnt_lo(~0u, 0u)), wid = wave_id, tid = wid * 64 + lane, wr = wid >> 2, wc = wid & 3, fr = lane & 15, fq = lane >> 4;
    const int K = g.K, nt = K / BK;
    unsigned voffA[2], voffB[2];
#pragma unroll
    for (int i = 0; i < 2; ++i) { int R, C; stage_rc(tid * 16 + i * 8192, R, C); const int Rb = Epi::PERM ? ((R & ~31) + perm32(R & 31)) : R;
        voffA[i] = (unsigned)(R * K + C) * 2u; voffB[i] = (unsigned)(Rb * K + C) * 2u; }
    const size_t kstep = (size_t)(BK * 2);
    const size_t hstep = (size_t)HALF * K * 2;
    const size_t tstep = 2 * hstep;
    const unsigned ldsw = (unsigned)wid * 1024u;
    const int aoff = lds_byte(wr * 64 + fr, fq * 8), boff = lds_byte(wc * 32 + fr, fq * 8);
#define PG8_SA(b, h) (((b) * 2 + (h)) * HTB)
#define PG8_SB(b, h) ((4 + (b) * 2 + (h)) * HTB)
#define PG8_STAGE(bufoff, gbase, voff) do { _Pragma("unroll") for (int _i = 0; _i < 2; ++_i) \
        __builtin_amdgcn_global_load_lds((const unsigned*)((const char*)(gbase) + (voff)[_i]), (PG8_LAS unsigned*)(lds + (bufoff) + ldsw + _i * 8192), 16, 0, 0); } while (0)
#define PG8_LDA(dst, b, h) do { _Pragma("unroll") for (int m = 0; m < 4; ++m) _Pragma("unroll") for (int k = 0; k < 2; ++k) dst[m][k] = *(const PG8_LAS bf16x8*)(lds + PG8_SA(b, h) + aoff + m * 2048 + k * 1024); } while (0)
#define PG8_LDB(dst, b, h) do { _Pragma("unroll") for (int n = 0; n < 2; ++n) _Pragma("unroll") for (int k = 0; k < 2; ++k) dst[n][k] = *(const PG8_LAS bf16x8*)(lds + PG8_SB(b, h) + boff + n * 2048 + k * 1024); } while (0)
#define PG8_MMA(ai, bj, At, Bt) do { __builtin_amdgcn_s_setprio(1); _Pragma("unroll") for (int m = 0; m < 4; ++m) _Pragma("unroll") for (int n = 0; n < 2; ++n) _Pragma("unroll") for (int k = 0; k < 2; ++k) \
        acc[ai][bj][m][n] = __builtin_amdgcn_mfma_f32_16x16x32_bf16(Bt[n][k], At[m][k], acc[ai][bj][m][n], 0, 0, 0); __builtin_amdgcn_s_setprio(0); } while (0)
#define PG8_WAIT_V(n) asm volatile("s_waitcnt vmcnt(" #n ")" ::: "memory")
#define PG8_WAIT_L(n) asm volatile("s_waitcnt lgkmcnt(" #n ")" ::: "memory")
#define PG8_BAR __builtin_amdgcn_s_barrier()
#define PG8_SCHED __builtin_amdgcn_sched_barrier(0)
    Unit cur, nxt; int ui = 0;
    if (!S.next(0, cur)) return;
    f32x4 acc[2][2][4][2];
#pragma unroll
    for (int a = 0; a < 2; ++a)
#pragma unroll
        for (int b = 0; b < 2; ++b)
#pragma unroll
            for (int m = 0; m < 4; ++m)
#pragma unroll
                for (int n = 0; n < 2; ++n) acc[a][b][m][n] = (f32x4){0.f, 0.f, 0.f, 0.f};
    bf16x8 At[4][2], B0[2][2], B1[2][2];
    const char* cA = (const char*)g.A + (size_t)cur.pm * tstep; const char* cB = (const char*)g.Bt + (size_t)cur.pn * tstep;
    S.a_ready(cur);
    if constexpr (SP2) {
        PG8_STAGE(PG8_SB(0, 0), cB, voffB); PG8_STAGE(PG8_SB(0, 1), cB + hstep, voffB); PG8_STAGE(PG8_SA(0, 0), cA, voffA); PG8_STAGE(PG8_SA(0, 1), cA + hstep, voffA);
        if (wr == 1) PG8_BAR;
        PG8_WAIT_V(2); PG8_BAR;
        PG8_STAGE(PG8_SB(1, 0), cB + kstep, voffB); PG8_STAGE(PG8_SA(1, 0), cA + kstep, voffA); PG8_STAGE(PG8_SB(1, 1), cB + hstep + kstep, voffB);
        PG8_WAIT_V(6); PG8_BAR;
    } else {
        PG8_STAGE(PG8_SB(0, 0), cB, voffB); PG8_STAGE(PG8_SA(0, 0), cA, voffA); PG8_STAGE(PG8_SB(0, 1), cB + hstep, voffB); PG8_STAGE(PG8_SA(0, 1), cA + hstep, voffA);
        if (wr == 1) PG8_BAR;
        PG8_WAIT_V(4); PG8_BAR;
        PG8_STAGE(PG8_SB(1, 0), cB + kstep, voffB); PG8_STAGE(PG8_SA(1, 0), cA + kstep, voffA); PG8_STAGE(PG8_SB(1, 1), cB + hstep + kstep, voffB);
        PG8_WAIT_V(6); PG8_BAR;
    }
    for (;;) {
        const bool has_next = S.next(ui + 1, nxt);
        const char* nA = has_next ? (const char*)g.A + (size_t)nxt.pm * tstep : cA; const char* nB = has_next ? (const char*)g.Bt + (size_t)nxt.pn * tstep : cB;
        for (int t = 0; t < nt; t += 2) {
            const bool last = (t == nt - 2);
            const char* a1 = cA + (size_t)(t + 1) * kstep;
            const char* a2 = last ? nA : cA + (size_t)(t + 2) * kstep; const char* b2 = last ? nB : cB + (size_t)(t + 2) * kstep;
            const char* a3 = a2 + kstep; const char* b3 = b2 + kstep;
            if (last && has_next) S.a_ready(nxt);
            if constexpr (SP2) {
            PG8_LDB(B0, 0, 0); PG8_LDB(B1, 0, 1); PG8_SCHED; PG8_LDA(At, 0, 0); PG8_STAGE(PG8_SA(1, 1), a1 + hstep, voffA);
            PG8_WAIT_V(8); PG8_WAIT_L(0); PG8_BAR; PG8_MMA(0, 0, At, B0); PG8_MMA(0, 1, At, B1); PG8_BAR; PG8_SCHED;
            PG8_LDA(At, 0, 1); PG8_STAGE(PG8_SB(0, 0), b2, voffB); PG8_STAGE(PG8_SB(0, 1), b2 + hstep, voffB); PG8_STAGE(PG8_SA(0, 0), a2, voffA);
            PG8_WAIT_V(8); PG8_WAIT_L(0); PG8_BAR; PG8_MMA(1, 0, At, B0); PG8_MMA(1, 1, At, B1); PG8_BAR; PG8_SCHED;
            PG8_LDB(B0, 1, 0); PG8_LDB(B1, 1, 1); PG8_SCHED; PG8_LDA(At, 1, 0); PG8_STAGE(PG8_SA(0, 1), a2 + hstep, voffA);
            PG8_WAIT_V(8); PG8_WAIT_L(0); PG8_BAR; PG8_MMA(0, 0, At, B0); PG8_MMA(0, 1, At, B1); PG8_BAR; PG8_SCHED;
            PG8_LDA(At, 1, 1); PG8_STAGE(PG8_SB(1, 0), b3, voffB); PG8_STAGE(PG8_SB(1, 1), b3 + hstep, voffB); PG8_STAGE(PG8_SA(1, 0), a3, voffA);
            PG8_WAIT_V(8); PG8_WAIT_L(0); PG8_BAR; PG8_MMA(1, 0, At, B0); PG8_MMA(1, 1, At, B1); PG8_BAR; PG8_SCHED;
            } else {
            PG8_LDB(B0, 0, 0); PG8_SCHED; PG8_LDA(At, 0, 0); PG8_STAGE(PG8_SA(1, 1), a1 + hstep, voffA);
            PG8_WAIT_L(8); PG8_BAR; PG8_WAIT_L(0); PG8_MMA(0, 0, At, B0); PG8_BAR; PG8_SCHED;
            PG8_LDB(B1, 0, 1); PG8_STAGE(PG8_SB(0, 0), b2, voffB);
            PG8_BAR; PG8_WAIT_L(0); PG8_MMA(0, 1, At, B1); PG8_BAR;
            PG8_LDA(At, 0, 1); PG8_STAGE(PG8_SA(0, 0), a2, voffA);
            PG8_BAR; PG8_WAIT_L(0); PG8_MMA(1, 0, At, B0); PG8_BAR; PG8_SCHED;
            PG8_STAGE(PG8_SB(0, 1), b2 + hstep, voffB);
            PG8_WAIT_V(6); PG8_BAR; PG8_MMA(1, 1, At, B1); PG8_BAR;
            PG8_LDB(B0, 1, 0); PG8_SCHED; PG8_LDA(At, 1, 0); PG8_STAGE(PG8_SA(0, 1), a2 + hstep, voffA);
            PG8_WAIT_L(8); PG8_BAR; PG8_WAIT_L(0); PG8_MMA(0, 0, At, B0); PG8_BAR; PG8_SCHED;
            PG8_LDB(B1, 1, 1); PG8_STAGE(PG8_SB(1, 0), b3, voffB);
            PG8_BAR; PG8_WAIT_L(0); PG8_MMA(0, 1, At, B1); PG8_BAR;
            PG8_LDA(At, 1, 1); PG8_STAGE(PG8_SA(1, 0), a3, voffA);
            PG8_BAR; PG8_WAIT_L(0); PG8_MMA(1, 0, At, B0); PG8_BAR; PG8_SCHED;
            PG8_STAGE(PG8_SB(1, 1), b3 + hstep, voffB);
            PG8_WAIT_V(6); PG8_BAR; PG8_MMA(1, 1, At, B1); PG8_BAR;
            }
        }
        if constexpr (ALIGN_EPI) { if (wr == 0) PG8_BAR; }
#ifdef PROBE_EPI
        { const unsigned long long t0_ = __builtin_readcyclecounter(); E(acc, cur, wr, wc, fr, fq); asm volatile("s_waitcnt vmcnt(0)" ::: "memory"); tacc_ += __builtin_readcyclecounter() - t0_; S.done(cur); }
#else
        if constexpr (!Epi::AFTER_DRAIN) { E(acc, cur, wr, wc, fr, fq); S.done(cur); }
#endif
        if (!has_next) break;
#pragma unroll
        for (int a = 0; a < 2; ++a)
#pragma unroll
            for (int b = 0; b < 2; ++b)
#pragma unroll
                for (int m = 0; m < 4; ++m)
#pragma unroll
                    for (int n = 0; n < 2; ++n) acc[a][b][m][n] = (f32x4){0.f, 0.f, 0.f, 0.f};
        cur = nxt; cA = nA; cB = nB; ++ui;
        if constexpr (ALIGN_EPI) { if (wr == 1) PG8_BAR; }
    }
    PG8_WAIT_V(0);
    if constexpr (!ALIGN_EPI) { if (wr == 0) PG8_BAR; }
    PG8_BAR;
    if constexpr (Epi::AFTER_DRAIN) { E.fused(acc, cur, wr, wc, fr, fq, lds, wid, lane); S.done(cur); }
#undef PG8_SA
#undef PG8_SB
#undef PG8_STAGE
#undef PG8_LDA
#undef PG8_LDB
#undef PG8_MMA
#undef PG8_WAIT_V
#undef PG8_WAIT_L
#undef PG8_BAR
#undef PG8_SCHED
}
}
#define XB_TMO      128
#define XB_XCNT(j)  (256  + 64 * (j))
#define XB_XSUB(j)  (1280 + 64 * (j))
#define XB_XGEN(j)  (2304 + 64 * (j))
#define XB_TOP      3328
#define XB_TOPGEN   3392
#define XCD_BAR_WORDS 3456
#define XB_SPIN_CAP (1u << 18)

__device__ __forceinline__ unsigned xb_ld(unsigned* p)              { return __hip_atomic_load(p, __ATOMIC_RELAXED, __HIP_MEMORY_SCOPE_AGENT); }
__device__ __forceinline__ unsigned xb_add(unsigned* p, unsigned v) { return __hip_atomic_fetch_add(p, v, __ATOMIC_RELAXED, __HIP_MEMORY_SCOPE_AGENT); }
__device__ __forceinline__ unsigned xb_xcc_id() { return (unsigned)__builtin_amdgcn_s_getreg((3 << 11) | 20) & 0xFu; }
#define XB_SPIN(cond, bar) do { unsigned _sp = 0; while (cond) { __builtin_amdgcn_s_sleep(1); \
    if ((++_sp & 255u) == 0u) { if (xb_ld(&(bar)[XB_TMO])) break; if (_sp > XB_SPIN_CAP) { atomicAdd(&(bar)[XB_TMO], 1u); break; } } } } while (0)

struct XcdBarrier {
    unsigned* bar; unsigned x;
    volatile LAS unsigned* st;
};

__device__ __forceinline__ XcdBarrier xcd_barrier_post(unsigned* bar, volatile LAS unsigned* st) {
    XcdBarrier b; b.bar = bar; b.x = xb_xcc_id(); b.st = st;
    if (threadIdx.x == 0) (void)xb_add(&bar[XB_XCNT(b.x)], 1u);
    return b;
}
__device__ __forceinline__ void xcd_barrier_complete(unsigned* bar, unsigned x, unsigned& nloc, unsigned& nx) {
    const unsigned G = gridDim.x * gridDim.y * gridDim.z;
    unsigned sum, cnt, mine, sp = 0u;
    for (;;) {
        sum = 0u; cnt = 0u; mine = 0u;
#pragma unroll
        for (unsigned j = 0; j < 16; ++j) { const unsigned c = xb_ld(&bar[XB_XCNT(j)]); sum += c; cnt += (c > 0u) ? 1u : 0u; mine = (j == x) ? c : mine; }
        if (sum == G) break;
        __builtin_amdgcn_s_sleep(1);
        if ((++sp & 255u) == 0u) { if (xb_ld(&bar[XB_TMO])) break; if (sp > XB_SPIN_CAP) { atomicAdd(&bar[XB_TMO], 1u); break; } }
    }
    nloc = mine > 0u ? mine : 1u; nx = cnt > 0u ? cnt : 1u;
}

__device__ __forceinline__ void xcd_barrier(const XcdBarrier& b, bool leader  ) {
    asm volatile("s_waitcnt vmcnt(0)" ::: "memory");
    __syncthreads();
    if (leader) {
        unsigned* bar = b.bar;
        __builtin_amdgcn_s_waitcnt(0);
        unsigned nloc = b.st[0], nx = b.st[1];
        if (nloc == 0u) { xcd_barrier_complete(bar, b.x, nloc, nx); b.st[0] = nloc; b.st[1] = nx; }
        const unsigned old = xb_add(&bar[XB_XSUB(b.x)], 1u);
        const unsigned gen = old / nloc;
        if (old + 1u == (gen + 1u) * nloc) {
            __builtin_amdgcn_fence(__ATOMIC_RELEASE, "agent");
            asm volatile("s_waitcnt vmcnt(0)" ::: "memory");
            const unsigned og = xb_add(&bar[XB_TOP], 1u);
            const unsigned tg = og / nx;
            if (og + 1u == (tg + 1u) * nx) xb_add(&bar[XB_TOPGEN], 1u);
            else XB_SPIN(xb_ld(&bar[XB_TOPGEN]) == tg, bar);
            __builtin_amdgcn_fence(__ATOMIC_ACQUIRE, "agent");
            xb_add(&bar[XB_XGEN(b.x)], 1u);
            asm volatile("s_waitcnt vmcnt(0)" ::: "memory");
        } else {
            XB_SPIN(xb_ld(&bar[XB_XGEN(b.x)]) == gen, bar);
            __builtin_amdgcn_fence(__ATOMIC_ACQUIRE, "agent");
            asm volatile("s_waitcnt vmcnt(0)" ::: "memory");
        }
    }
    __syncthreads();
}
using pg8::f32x4; using pg8::bf16x8;
constexpr int NWAVES = 8;
constexpr int BATCH = 4, T = 8192, D = 1024, M = BATCH * T, NP = 4096, INW = 3864;
constexpr int DECB = 32, PAST = 16384, NPAGES = 128, NCS = 512  ;
constexpr float NORM_EPS = 1e-6f;
constexpr float LOG2E = 1.4426950408889634f;
constexpr float QSCALE = 0.125f * LOG2E;
constexpr size_t O_Y = 0, O_YS = 33554432, O_PCMP = 33587200, O_PSLC = 41975808, O_PWIN = 50364416, O_PCONV = 50888704,
                 O_SCMP = 50892800, O_SSLC = 50900992, O_SWIN = 50909184, O_SCONV = 55103488, O_END = 55136256;
constexpr int C_BG = 0, C_CG = 512, C_CI = 1024, C_ZC = 1536, C_Q = 2048, C_KV = 2560, C_GL = 3328, C_ZA = 3352;

constexpr size_t MiB = 1u << 20, KiB = 1u << 10;
constexpr size_t WS_CTL = 0, CTL_ZERO_BYTES = 1 * MiB;
constexpr size_t WS_BT1 = 2 * MiB;
constexpr size_t WS_BT2 = 10 * MiB;
constexpr size_t WS_BTC = 12 * MiB;
constexpr size_t WS_CBIAS = 12 * MiB + 512 * KiB;
constexpr size_t WS_CONST = WS_CBIAS + 4 * KiB;
constexpr size_t WS_ROPE = 13 * MiB;
constexpr size_t WS_RSTD = 16 * MiB;
constexpr size_t WS_XSB = 16 * MiB + 256 * KiB;
constexpr size_t WS_RSTDS = WS_XSB + 64 * KiB;
constexpr size_t WS_GATE = 17 * MiB;
constexpr size_t WS_KC = 20 * MiB;
constexpr size_t WS_VCT = WS_KC + 256 * KiB;
constexpr size_t WS_PROJS = 21 * MiB;
constexpr size_t WS_QS = 22 * MiB;
constexpr size_t WS_KVN = WS_QS + 64 * KiB;
constexpr size_t WS_GS = WS_KVN + 96 * KiB;
constexpr size_t WS_ZAS = WS_GS + 4 * KiB;
constexpr size_t WS_MIXS = WS_ZAS + 64 * KiB;
constexpr size_t WS_KCS = 24 * MiB;
constexpr size_t WS_KS = 40 * MiB, WS_VTS = 48 * MiB, WS_KW = 56 * MiB, WS_VTW = 64 * MiB;
constexpr size_t WS_XB = 72 * MiB;
constexpr size_t WS_CG = 136 * MiB, WS_U = 168 * MiB, WS_ZA = 200 * MiB, WS_Q = 232 * MiB;
constexpr size_t WS_MIX = 264 * MiB;
constexpr size_t WS_TOT = 328 * MiB;
constexpr size_t WS_END = 344 * MiB;
constexpr int CW_TMO = 0, CW_CODE = 1;
constexpr int CW_BAR = 4096;
constexpr int CW_QUEUE = 16384;
constexpr int CW_P0CNT = 18432;
constexpr int CW_KCMAX = 20480;

constexpr int RING_OFF = 0, RING_BYTES = 131072;
constexpr int LDSCTL_OFF = RING_BYTES, MISC_OFF = LDSCTL_OFF + 320;
constexpr int LDS_BYTES = 147456;

__device__ __forceinline__ unsigned f2bf(float f) { unsigned u = __builtin_bit_cast(unsigned, f); return (u + 0x7fffu + ((u >> 16) & 1u)) >> 16; }
typedef __bf16 bf16x2_t __attribute__((ext_vector_type(2)));
__device__ __forceinline__ unsigned pk2(float lo, float hi) { return __builtin_bit_cast(unsigned, __builtin_convertvector((f32x2){lo, hi}, bf16x2_t)); }
__device__ __forceinline__ float bf2f(unsigned h) { return __builtin_bit_cast(float, h << 16); }
__device__ __forceinline__ float wave_sum(float v) {
#pragma unroll
    for (int o = 1; o < 64; o <<= 1) v += __shfl_xor(v, o);
    return v;
}
__device__ __forceinline__ float quad_sum(float v) {
    v += __builtin_bit_cast(float, __builtin_amdgcn_update_dpp(0, __builtin_bit_cast(int, v), 0xB1, 0xF, 0xF, true));
    v += __builtin_bit_cast(float, __builtin_amdgcn_update_dpp(0, __builtin_bit_cast(int, v), 0x4E, 0xF, 0xF, true));
    return v;
}
__device__ __forceinline__ float fast_exp2(float x) { return __builtin_amdgcn_exp2f(x); }
__device__ __forceinline__ float sigmoidf(float x) { return __builtin_amdgcn_rcpf(1.0f + fast_exp2(-x * LOG2E)); }
__device__ __forceinline__ int perm16(int kk) { return 8 * ((kk >> 2) & 1) + 4 * (kk >> 3) + (kk & 3); }

struct Ptrs {
    const float *xp, *xs, *cache_cmp, *cache_slc, *st_win, *st_conv; const int* page_table;
    const float *norm_g, *w_in, *conv_w, *conv_b, *q_gain, *k_gain, *cmp_pe, *cmp_w, *w_out;
    float* out; unsigned char* ws;
};
struct Frame {
    LAS unsigned char* lds;
    volatile LAS unsigned* MISC;
    gu32* ctl;
    int tid, lane, wave, G, gw, NGW;
};
__device__ __forceinline__ int bt1_src(int dg, int& nvalid) {
    const int pn = dg >> 3, gi = dg & 7, bj = gi >> 2, wc = gi & 3; nvalid = 32;
    if (pn < 4) return (bj ? C_ZC : C_BG) + 128 * pn + 32 * wc;
    if (pn < 8) return (bj ? C_CI : C_CG) + 128 * (pn - 4) + 32 * wc;
    if (pn < 10) return C_Q + (4 * (pn - 8) + wc) * 64 + 32 * bj;
    if (pn < 13) return C_KV + (pn - 10) * 256 + wc * 64 + 32 * bj;
    if (pn < 15) return C_ZA + 256 * (pn - 13) + 32 * gi;
    nvalid = (gi == 0) ? 24 : 0; return C_GL;
}
__device__ __forceinline__ void p0_transpose_item(const float* W, int ldw, int k0, int src0, int nvalid, const float* ksc, bf16* WT, int ldt, int drow0, LAS float* scr, int lane) {
    const int nn = lane & 31;
#pragma unroll 8
    for (int i = 0; i < 32; ++i) { const int kk = 2 * i + (lane >> 5); float v = 0.f;
        if (nn < nvalid) { v = W[(size_t)(k0 + kk) * ldw + src0 + nn]; if (ksc) v *= ksc[k0 + kk]; }
        scr[kk * 33 + nn] = v; }
    LDS_WAIT(); asm volatile("" ::: "memory");
    const int c = lane & 7;
#pragma unroll
    for (int j = 0; j < 4; ++j) { const int n = (lane >> 3) + 8 * j; const LAS float* s = scr + (8 * c) * 33 + n;
        v4u o; o.x = pk2(s[0 * 33], s[1 * 33]); o.y = pk2(s[2 * 33], s[3 * 33]); o.z = pk2(s[4 * 33], s[5 * 33]); o.w = pk2(s[6 * 33], s[7 * 33]);
        *(GAS v4u*)(WT + (size_t)(drow0 + n) * ldt + k0 + 8 * c) = o; }
    LDS_WAIT(); asm volatile("" ::: "memory");
}
template <int NR>
__device__ __forceinline__ void x_rows_to_bf16(const float* xrow, bf16* orow, float* rstd_out, int lane) {
    f32x4 v[NR][4]; float s[NR];
#pragma unroll
    for (int r = 0; r < NR; ++r)
#pragma unroll
        for (int j = 0; j < 4; ++j) v[r][j] = ((const GAS f32x4*)(xrow + (size_t)r * D) + lane)[64 * j];
#pragma unroll
    for (int r = 0; r < NR; ++r) { s[r] = 0.f;
#pragma unroll
        for (int j = 0; j < 4; ++j) s[r] += (v[r][j].x * v[r][j].x + v[r][j].y * v[r][j].y) + (v[r][j].z * v[r][j].z + v[r][j].w * v[r][j].w); }
#pragma unroll
    for (int o = 1; o < 64; o <<= 1)
#pragma unroll
        for (int r = 0; r < NR; ++r) s[r] += __shfl_xor(s[r], o);
#pragma unroll
    for (int r = 0; r < NR; ++r) { GAS unsigned long long* o8 = (GAS unsigned long long*)(orow + (size_t)r * D) + lane;
#pragma unroll
        for (int j = 0; j < 4; ++j) o8[64 * j] = (unsigned long long)pk2(v[r][j].x, v[r][j].y) | ((unsigned long long)pk2(v[r][j].z, v[r][j].w) << 32);
        if (lane == 0) rstd_out[r] = 1.0f / sqrtf(s[r] * (1.0f / D) + NORM_EPS); }
}
template <bool SAMPLE>
__device__ __forceinline__ const float* cmp_rowbase(const Ptrs& P, int unit, int rho) {
    const int b = SAMPLE ? unit >> 6 : unit >> 5, c = (SAMPLE ? (unit & 63) : (unit & 31)) * 8 + (rho >> 1), g = rho & 1;
    if (SAMPLE) { const int page = P.page_table[b * NPAGES + (c >> 2)]; return P.cache_cmp + ((size_t)page * 128 + (c & 3) * 32) * 256 + g * 64; }
    return P.out + O_PCMP + ((size_t)b * T + c * 32) * 256 + g * 64;
}
template <bool SAMPLE>
__device__ __forceinline__ void compress_units(const Ptrs& P, Frame& F, LAS float* part  ) {
    constexpr int NUNITS = SAMPLE ? DECB * (NCS / 8) : BATCH * 32;
    const int lane = F.lane, w = F.wave, rho = lane & 15, kq = lane >> 4;
    const GAS v4u* bfr = (const GAS v4u*)(P.ws + WS_BTC) + lane;
    const float* cbias = (const float*)(P.ws + WS_CBIAS);
    int unit = blockIdx.x;
    if (unit >= NUNITS) return;
    f32x4 a_cur[8], a_n1[8], a_n2[8];
    const float* rb = cmp_rowbase<SAMPLE>(P, unit, rho) + 4 * kq;
#define CMP_LOAD(dst, base, r) do { _Pragma("unroll") for (int q_ = 0; q_ < 4; ++q_) { dst[2 * q_] = *(const GAS f32x4*)((base) + (r) * 256 + (q_ >> 1) * 128 + (q_ & 1) * 32); dst[2 * q_ + 1] = *(const GAS f32x4*)((base) + (r) * 256 + (q_ >> 1) * 128 + (q_ & 1) * 32 + 16); } } while (0)
    CMP_LOAD(a_cur, rb, 4 * w); CMP_LOAD(a_n1, rb, 4 * w + 1);
    for (;;) {
        f32x4 acc[2][4];
#pragma unroll
        for (int j = 0; j < 2; ++j)
#pragma unroll
            for (int e = 0; e < 4; ++e) acc[j][e] = (f32x4){0.f, 0.f, 0.f, 0.f};
        const int nunit = unit + F.G; const bool has_next = nunit < NUNITS;
        const float* rbn = has_next ? cmp_rowbase<SAMPLE>(P, nunit, rho) + 4 * kq : rb;
#pragma unroll 1
        for (int rr = 0; rr < 4; ++rr) {
            const int r = 4 * w + rr;
            bf16x8 bb[16];
#pragma unroll
            for (int q_ = 0; q_ < 4; ++q_)
#pragma unroll
                for (int et = 0; et < 4; ++et) bb[q_ * 4 + et] = __builtin_bit_cast(bf16x8, bfr[(size_t)(((((q_ >> 1) * 32 + r) * 2 + (q_ & 1)) * 4 + et) * 64)]);
            __builtin_amdgcn_sched_barrier(0);
            { const float* nb_ = rr < 2 ? rb : rbn; const int nr_ = rr < 2 ? r + 2 : 4 * w + (rr - 2); CMP_LOAD(a_n2, nb_, nr_); }
            __builtin_amdgcn_sched_barrier(0);
#pragma unroll
            for (int q_ = 0; q_ < 4; ++q_) { const int j = q_ >> 1;
                v4u wv; wv.x = pk2(a_cur[2 * q_].x, a_cur[2 * q_].y); wv.y = pk2(a_cur[2 * q_].z, a_cur[2 * q_].w); wv.z = pk2(a_cur[2 * q_ + 1].x, a_cur[2 * q_ + 1].y); wv.w = pk2(a_cur[2 * q_ + 1].z, a_cur[2 * q_ + 1].w);
                const bf16x8 af = __builtin_bit_cast(bf16x8, wv);
#pragma unroll
                for (int et = 0; et < 4; ++et) acc[j][et] = __builtin_amdgcn_mfma_f32_16x16x32_bf16(af, bb[q_ * 4 + et], acc[j][et], 0, 0, 0); }
#pragma unroll
            for (int q_ = 0; q_ < 8; ++q_) { a_cur[q_] = a_n1[q_]; a_n1[q_] = a_n2[q_]; }
        }
#pragma unroll
        for (int j = 0; j < 2; ++j)
#pragma unroll
            for (int et = 0; et < 4; ++et) *(LAS f32x4*)(part + ((w * 8 + j * 4 + et) * 64 + lane) * 4) = acc[j][et];
        __syncthreads();
        { const int j = w >> 2, et = w & 3, e = 16 * et + rho; f32x4 sum = *(const LAS f32x4*)(part + ((0 * 8 + w) * 64 + lane) * 4);
#pragma unroll
          for (int ww = 1; ww < 8; ++ww) sum = sum + *(const LAS f32x4*)(part + ((ww * 8 + w) * 64 + lane) * 4);
          const float bs = cbias[j * 64 + e]; const int b = SAMPLE ? unit >> 6 : unit >> 5, c0 = (SAMPLE ? (unit & 63) : (unit & 31)) * 8;
          float nmax = 0.f;
#pragma unroll
          for (int i = 0; i < 4; ++i) { const int row = 4 * kq + i, c = c0 + (row >> 1), g = row & 1; const float val = sum[i] + bs;
              float q2 = val * val; q2 += __shfl_xor(q2, 1); q2 += __shfl_xor(q2, 2); q2 += __shfl_xor(q2, 4); q2 += __shfl_xor(q2, 8); nmax = fmaxf(nmax, q2);
              if (SAMPLE) ((float*)(P.ws + WS_KCS))[((size_t)((b * 2 + g) * 2 + j) * NCS + c) * 64 + e] = val;
              else if (j == 0) ((bf16*)(P.ws + WS_KC))[((size_t)(b * 2 + g) * 256 + c) * 64 + e] = (bf16)f2bf(val);
              else ((bf16*)(P.ws + WS_VCT))[((size_t)(b * 2 + g) * 64 + e) * 256 + (c & ~15) + perm16(c & 15)] = (bf16)f2bf(val); }
          if (j == 0) { nmax = fmaxf(nmax, __shfl_xor(nmax, 16)); nmax = fmaxf(nmax, __shfl_xor(nmax, 32));
              if (lane == 0) atomicMax((unsigned*)(P.ws + WS_CTL) + CW_KCMAX + (SAMPLE ? 64 : 0) + et, __builtin_bit_cast(unsigned, nmax)); } }
        __syncthreads();
        if (!has_next) break;
        unit = nunit; rb = rbn;
    }
#undef CMP_LOAD
}
__device__ __forceinline__ void compress_sample_pass(const Ptrs& P, Frame& F, LAS unsigned char* bl  ) {
    const int lane = F.lane, w = F.wave, tid = F.tid, rho = lane & 15, kq = lane >> 4;
    for (int pass = blockIdx.x; pass < DECB * 8; pass += F.G) {
    __syncthreads();
    const int b = pass >> 3, c0 = (pass & 7) * 64 + w * 8;
    const float* rb; { const int c = c0 + (rho >> 1), g = rho & 1; const int page = P.page_table[b * NPAGES + (c >> 2)]; rb = P.cache_cmp + ((size_t)page * 128 + (c & 3) * 32) * 256 + g * 64 + 4 * kq; }
    const GAS v4u* bsrc = (const GAS v4u*)(P.ws + WS_BTC);
    const int sf = tid >> 5, sj = sf >> 3, sdh = (sf >> 2) & 1, set_ = sf & 3, sl = (tid & 31) * 2;
#define B_SRC(r) (bsrc + (size_t)((((sj * 32 + (r)) * 2 + sdh) * 4 + set_) * 64 + sl))
    LAS v4u* bdst = (LAS v4u*)bl + sf * 64 + sl;
    f32x4 a_cur[8], a_n1[8], a_n2[8];
#define CMP_LOAD(dst, base, r) do { _Pragma("unroll") for (int q_ = 0; q_ < 4; ++q_) { dst[2 * q_] = *(const GAS f32x4*)((base) + (r) * 256 + (q_ >> 1) * 128 + (q_ & 1) * 32); dst[2 * q_ + 1] = *(const GAS f32x4*)((base) + (r) * 256 + (q_ >> 1) * 128 + (q_ & 1) * 32 + 16); } } while (0)
    { const v4u b0 = B_SRC(0)[0], b1 = B_SRC(0)[1]; bdst[0] = b0; bdst[1] = b1; }
    CMP_LOAD(a_cur, rb, 0); CMP_LOAD(a_n1, rb, 1);
    f32x4 acc[2][4];
#pragma unroll
    for (int j = 0; j < 2; ++j)
#pragma unroll
        for (int e = 0; e < 4; ++e) acc[j][e] = (f32x4){0.f, 0.f, 0.f, 0.f};
    __syncthreads();
#pragma unroll 1
    for (int r = 0; r < 32; ++r) {
        const int rn = r + 1 < 32 ? r + 1 : 31, r2 = r + 2 < 32 ? r + 2 : 31;
        const v4u b0 = B_SRC(rn)[0], b1 = B_SRC(rn)[1];
        __builtin_amdgcn_sched_barrier(0);
        CMP_LOAD(a_n2, rb, r2);
        __builtin_amdgcn_sched_barrier(0);
        const LAS v4u* bf = (const LAS v4u*)bl + (r & 1) * 1024 + lane;
#pragma unroll
        for (int q_ = 0; q_ < 4; ++q_) { const int j = q_ >> 1;
            v4u wv; wv.x = pk2(a_cur[2 * q_].x, a_cur[2 * q_].y); wv.y = pk2(a_cur[2 * q_].z, a_cur[2 * q_].w); wv.z = pk2(a_cur[2 * q_ + 1].x, a_cur[2 * q_ + 1].y); wv.w = pk2(a_cur[2 * q_ + 1].z, a_cur[2 * q_ + 1].w);
            const bf16x8 af = __builtin_bit_cast(bf16x8, wv);
#pragma unroll
            for (int et = 0; et < 4; ++et) acc[j][et] = __builtin_amdgcn_mfma_f32_16x16x32_bf16(af, __builtin_bit_cast(bf16x8, bf[(q_ * 4 + et) * 64]), acc[j][et], 0, 0, 0); }
        { LAS v4u* d_ = bdst + ((r + 1) & 1) * 1024; d_[0] = b0; d_[1] = b1; }
#pragma unroll
        for (int q_ = 0; q_ < 8; ++q_) { a_cur[q_] = a_n1[q_]; a_n1[q_] = a_n2[q_]; }
        __syncthreads();
    }
#undef CMP_LOAD
#undef B_SRC
    const float* cbias = (const float*)(P.ws + WS_CBIAS);
    float nmax = 0.f;
#pragma unroll
    for (int i = 0; i < 4; ++i) { const int row = 4 * kq + i, c = c0 + (row >> 1), g = row & 1; float q2 = 0.f;
#pragma unroll
        for (int j = 0; j < 2; ++j)
#pragma unroll
            for (int et = 0; et < 4; ++et) { const int e = 16 * et + rho; const float val = acc[j][et][i] + cbias[j * 64 + e]; if (j == 0) q2 += val * val;
                ((float*)(P.ws + WS_KCS))[((size_t)((b * 2 + g) * 2 + j) * NCS + c) * 64 + e] = val; }
        q2 += __shfl_xor(q2, 1); q2 += __shfl_xor(q2, 2); q2 += __shfl_xor(q2, 4); q2 += __shfl_xor(q2, 8); nmax = fmaxf(nmax, q2); }
    nmax = fmaxf(nmax, __shfl_xor(nmax, 16)); nmax = fmaxf(nmax, __shfl_xor(nmax, 32));
    if (lane == 0) atomicMax((unsigned*)(P.ws + WS_CTL) + CW_KCMAX + 64, __builtin_bit_cast(unsigned, nmax));
    }
}
constexpr int P0_PRODUCERS = 641;
__device__ __forceinline__ void p0_small_items(const Ptrs& P, Frame& F) {
    const int lane = F.lane, gw = F.gw;
    if (gw >= P0_PRODUCERS && F.NGW >= P0_PRODUCERS) return;
    for (int item = gw; item < P0_PRODUCERS; item += F.NGW) {
        if (item < 512) { const int it = item * 64 + lane; const int l = it & 63, et = (it >> 6) & 3, dh = (it >> 8) & 1, r = (it >> 9) & 31, j = it >> 14;
            const float* w = P.cmp_w + ((size_t)(r * 2 + j) * 64 + 32 * dh + 4 * (l >> 4)) * 64 + 16 * et + (l & 15);
            v4u o; o.x = pk2(w[0], w[64]); o.y = pk2(w[128], w[192]); o.z = pk2(w[16 * 64], w[17 * 64]); o.w = pk2(w[18 * 64], w[19 * 64]);
            __builtin_amdgcn_raw_buffer_store_b128(o, __builtin_amdgcn_make_buffer_rsrc((void*)(P.ws + WS_BTC), 0, 512 * 1024, 0x00020000), it * 16, 0, 16);
        } else if (item < 640) { const int it = item - 512, j = it >> 6, e = it & 63; float s = 0.f;
            for (int k = lane; k < 2048; k += 64) { const int r = k >> 6, d = k & 63; s += P.cmp_pe[(r * 2 + j) * 64 + d] * P.cmp_w[((size_t)(r * 2 + j) * 64 + d) * 64 + e]; }
            s = wave_sum(s); if (lane == 0) __hip_atomic_store((float*)(P.ws + WS_CBIAS) + it, s, RLX_AGENT);
        } else { float qm = fabsf(P.q_gain[lane]), k1 = fabsf(P.k_gain[64 + lane]), k2 = fabsf(P.k_gain[128 + lane]);
#pragma unroll
            for (int o = 1; o < 64; o <<= 1) { qm = fmaxf(qm, __shfl_xor(qm, o)); k1 = fmaxf(k1, __shfl_xor(k1, o)); k2 = fmaxf(k2, __shfl_xor(k2, o)); }
            if (lane == 0) { float* cst = (float*)(P.ws + WS_CONST); __hip_atomic_store(cst + 0, qm, RLX_AGENT); __hip_atomic_store(cst + 1, 8.0f * qm * k1 * LOG2E * 1.001f, RLX_AGENT); __hip_atomic_store(cst + 2, 8.0f * qm * k2 * LOG2E * 1.001f, RLX_AGENT); } }
        asm volatile("s_waitcnt vmcnt(0)" ::: "memory");
        if (lane == 0) __hip_atomic_fetch_add((unsigned*)(F.ctl + CW_P0CNT), 1u, RLX_AGENT);
    }
}
__device__ __forceinline__ void p0_rope(const Ptrs& P, Frame& F) {
    const int lane = F.lane, gw = F.gw, NGW = F.NGW; const int i = lane & 31;
    const float inv = (float)pow(10000.0, -(double)i / 32.0);
    for (int it = gw * 64 + lane; it < 8193 * 32; it += NGW * 64) { const int p = it >> 5; const int pos = (p == 8192) ? PAST : p;
        const float ang = (float)pos * inv; const double rev = (double)ang * 0.15915494309189535; const float fr = (float)(rev - __builtin_rint(rev));
        float* rt = (float*)(P.ws + WS_ROPE) + (size_t)p * 64; rt[i] = __builtin_amdgcn_cosf(fr); rt[32 + i] = __builtin_amdgcn_sinf(fr); }
}
__device__ __forceinline__ void p0_phase(const Ptrs& P, Frame& F) {
    LAS float* scr = (LAS float*)(F.lds + RING_OFF + F.wave * 16384);
    const int lane = F.lane;
    p0_small_items(P, F);
    p0_rope(P, F);
    const int gw = F.gw, NGW = F.NGW;
    for (int it = gw; it < 16 * 128; it += NGW) { const int kb = it >> 7, dg = it & 127; int nv; const int src0 = bt1_src(dg, nv);
        p0_transpose_item(P.w_in, INW, 64 * kb, src0, nv, P.norm_g, (bf16*)(P.ws + WS_BT1), D, 32 * dg, scr, lane); }
    for (int it = gw; it < 16 * 32; it += NGW) { const int kb = it >> 5, nb = it & 31;
        p0_transpose_item(P.w_out, D, 64 * kb, 32 * nb, 32, nullptr, (bf16*)(P.ws + WS_BT2), D, 32 * nb, scr, lane); }
    for (int m = gw * 4; m < M; m += NGW * 4) x_rows_to_bf16<4>(P.xp + (size_t)m * D, (bf16*)(P.ws + WS_XB) + (size_t)m * D, (float*)(P.ws + WS_RSTD) + m, lane);
    for (int m = gw; m < DECB; m += NGW) x_rows_to_bf16<1>(P.xs + (size_t)m * D, (bf16*)(P.ws + WS_XSB) + (size_t)m * D, (float*)(P.ws + WS_RSTDS) + m, lane);
    { constexpr int PERB = 511 * 64, TOTAL = DECB * PERB; const GAS f32x4* src = (const GAS f32x4*)P.st_win; GAS f32x4* dst = (GAS f32x4*)(P.out + O_SWIN);
      for (int i0 = gw * 64 + lane; i0 < TOTAL; i0 += NGW * 64 * 8) { f32x4 t[8];
#pragma unroll
        for (int u = 0; u < 8; ++u) { const int i = i0 + u * NGW * 64; if (i < TOTAL) { const int b = i / PERB; t[u] = src[i + 64 * b + 64]; } }
#pragma unroll
        for (int u = 0; u < 8; ++u) { const int i = i0 + u * NGW * 64; if (i < TOTAL) { const int b = i / PERB; dst[i + 64 * b] = t[u]; } } } }
    for (int it = gw * 64 + lane; it < DECB * 512; it += NGW * 64) { const int b = it >> 9, ch = it & 511; P.out[O_SCONV + (size_t)b * 1024 + ch] = P.st_conv[(size_t)b * 1024 + 512 + ch]; }
    if (F.wave == 0) { if (lane == 0) { unsigned sp = 0u; while (__hip_atomic_load((unsigned*)(F.ctl + CW_P0CNT), RLX_AGENT) < (unsigned)P0_PRODUCERS) { __builtin_amdgcn_s_sleep(2); if (++sp > (1u << 22)) break; } }
        __builtin_amdgcn_fence(__ATOMIC_ACQUIRE, "agent"); asm volatile("s_waitcnt vmcnt(0)" ::: "memory"); }
    __syncthreads();
    compress_sample_pass(P, F, F.lds + RING_OFF);
}
struct EpiIn {
    static constexpr bool PERM = false, AFTER_DRAIN = false;
    const float *rstd, *rope, *qg, *kg; float* out; unsigned char* ws;
    __device__ __forceinline__ void operator()(const f32x4 (&acc)[2][2][4][2], const pg8::Unit& u, int wr, int wc, int fr, int fq) const {
        asm volatile("" : "+v"(fr), "+v"(fq));
        const int pn = u.pn; const int rbase = u.pm * 256 + wr * 64 + fr;
        if (pn < 8) {
            const bool bz = pn < 4; bf16* dst = (bf16*)(ws + (bz ? WS_CG : WS_U)); const int col0 = 128 * (pn & 3) + 32 * wc + 4 * fq;
#pragma unroll
            for (int ai = 0; ai < 2; ++ai)
#pragma unroll
                for (int m = 0; m < 4; ++m) { const int row = rbase + ai * 128 + m * 16; const float rs = rstd[row];
#pragma unroll
                    for (int n = 0; n < 2; ++n) { const f32x4 a = acc[ai][0][m][n] * rs, z = acc[ai][1][m][n] * rs; f32x4 o;
                        if (bz) { o.x = a.x * z.x * sigmoidf(z.x); o.y = a.y * z.y * sigmoidf(z.y); o.z = a.z * z.z * sigmoidf(z.z); o.w = a.w * z.w * sigmoidf(z.w); }
                        else o = a * z;
                        v2u w; w.x = pk2(o.x, o.y); w.y = pk2(o.z, o.w);
                        *(GAS v2u*)(dst + (size_t)row * 512 + col0 + 16 * n) = w;
                        if (!bz) { const int t = row & (T - 1); if (t >= T - 2) *(GAS f32x4*)(out + O_PCONV + ((size_t)(row >> 13) * 2 + (t - (T - 2))) * 512 + col0 + 16 * n) = o; } } }
        } else if (pn < 13) {
            const bool isq = pn < 10; const int br = pn - 10; const bool isk = !isq && wc < 2;
            if (isq || isk) {
                const float* gain = isq ? qg : kg + br * 64; float g1[2][4], g2[2][4];
#pragma unroll
                for (int n = 0; n < 2; ++n)
#pragma unroll
                    for (int e = 0; e < 4; ++e) { g1[n][e] = gain[16 * n + 4 * fq + e]; g2[n][e] = gain[32 + 16 * n + 4 * fq + e]; }
#pragma unroll
                for (int ai = 0; ai < 2; ++ai)
#pragma unroll
                    for (int m = 0; m < 4; ++m) { const int row = rbase + ai * 128 + m * 16; const float rs = rstd[row]; const int t = row & (T - 1), b = row >> 13;
                        f32x4 x1[2], x2[2]; float ss = 0.f;
#pragma unroll
                        for (int n = 0; n < 2; ++n) { x1[n] = acc[ai][0][m][n] * rs; x2[n] = acc[ai][1][m][n] * rs;
                            ss += (x1[n].x * x1[n].x + x1[n].y * x1[n].y) + (x1[n].z * x1[n].z + x1[n].w * x1[n].w) + (x2[n].x * x2[n].x + x2[n].y * x2[n].y) + (x2[n].z * x2[n].z + x2[n].w * x2[n].w); }
                        ss += __shfl_xor(ss, 16); ss += __shfl_xor(ss, 32);
                        const float inv = 1.0f / sqrtf(ss * (1.0f / 64.0f) + NORM_EPS);
                        const float* rp = rope + (size_t)t * 64 + 4 * fq;
#pragma unroll
                        for (int n = 0; n < 2; ++n) { const f32x4 cs = *(const GAS f32x4*)(rp + 16 * n), sn = *(const GAS f32x4*)(rp + 32 + 16 * n); f32x4 o1, o2;
#pragma unroll
                            for (int e = 0; e < 4; ++e) { const float a = x1[n][e] * inv * g1[n][e], c = x2[n][e] * inv * g2[n][e]; o1[e] = a * cs[e] - c * sn[e]; o2[e] = c * cs[e] + a * sn[e]; }
                            const int d1 = 16 * n + 4 * fq;
                            if (isq) { o1 = o1 * QSCALE; o2 = o2 * QSCALE; bf16* q = (bf16*)(ws + WS_Q) + (size_t)row * 512 + (4 * (pn - 8) + wc) * 64 + d1;
                                v2u w; w.x = pk2(o1.x, o1.y); w.y = pk2(o1.z, o1.w); *(GAS v2u*)q = w; w.x = pk2(o2.x, o2.y); w.y = pk2(o2.z, o2.w); *(GAS v2u*)(q + 32) = w; }
                            else { const int g = wc;
                                if (br > 0) { bf16* k = (bf16*)(ws + (br == 1 ? WS_KS : WS_KW)) + ((size_t)(b * 2 + g) * T + t) * 64 + d1;
                                    v2u w; w.x = pk2(o1.x, o1.y); w.y = pk2(o1.z, o1.w); *(GAS v2u*)k = w; w.x = pk2(o2.x, o2.y); w.y = pk2(o2.z, o2.w); *(GAS v2u*)(k + 32) = w; }
                                if (br < 2) { float* o = out + (br == 0 ? O_PCMP : O_PSLC) + (size_t)row * 256 + g * 64 + d1; *(GAS f32x4*)o = o1; *(GAS f32x4*)(o + 32) = o2; }
                                else if (t >= T - 512) { float* o = out + O_PWIN + ((size_t)b * 512 + (t - (T - 512))) * 256 + g * 64 + d1; *(GAS f32x4*)o = o1; *(GAS f32x4*)(o + 32) = o2; } } } }
            } else {
                const int g = wc - 2;
#pragma unroll
                for (int ai = 0; ai < 2; ++ai)
#pragma unroll
                    for (int m = 0; m < 4; ++m) { const int row = rbase + ai * 128 + m * 16; const float rs = rstd[row]; const int t = row & (T - 1), b = row >> 13;
                        const int tk = t & 63, vpos = (tk & ~15) + perm16(tk & 15);
                        bf16* vt = (br > 0) ? (bf16*)(ws + (br == 1 ? WS_VTS : WS_VTW)) + ((size_t)((b * 2 + g) * 128 + (t >> 6)) * 64) * 64 + vpos : nullptr;
#pragma unroll
                        for (int bj = 0; bj < 2; ++bj)
#pragma unroll
                            for (int n = 0; n < 2; ++n) { const f32x4 v = acc[ai][bj][m][n] * rs; const int d1 = 32 * bj + 16 * n + 4 * fq;
                                if (br > 0) {
#pragma unroll
                                    for (int e = 0; e < 4; ++e) vt[(size_t)(d1 + e) * 64] = (bf16)f2bf(v[e]); }
                                if (br < 2) *(GAS f32x4*)(out + (br == 0 ? O_PCMP : O_PSLC) + (size_t)row * 256 + 128 + g * 64 + d1) = v;
                                else if (t >= T - 512) *(GAS f32x4*)(out + O_PWIN + ((size_t)b * 512 + (t - (T - 512))) * 256 + 128 + g * 64 + d1) = v; } }
            }
        } else if (pn < 15) {
            bf16* dst = (bf16*)(ws + WS_ZA);
#pragma unroll
            for (int ai = 0; ai < 2; ++ai)
#pragma unroll
                for (int m = 0; m < 4; ++m) { const int row = rbase + ai * 128 + m * 16; const float rs = rstd[row];
#pragma unroll
                    for (int bj = 0; bj < 2; ++bj)
#pragma unroll
                        for (int n = 0; n < 2; ++n) { const f32x4 z = acc[ai][bj][m][n] * rs; v2u w; w.x = pk2(z.x * sigmoidf(z.x), z.y * sigmoidf(z.y)); w.y = pk2(z.z * sigmoidf(z.z), z.w * sigmoidf(z.w));
                            *(GAS v2u*)(dst + (size_t)row * 512 + 256 * (pn - 13) + 128 * bj + 32 * wc + 16 * n + 4 * fq) = w; } }
        } else {
            if (wc == 0) { float* dst = (float*)(ws + WS_GATE);
#pragma unroll
                for (int ai = 0; ai < 2; ++ai)
#pragma unroll
                    for (int m = 0; m < 4; ++m) { const int row = rbase + ai * 128 + m * 16; const float rs = rstd[row];
#pragma unroll
                        for (int n = 0; n < 2; ++n) { const int c0 = 16 * n + 4 * fq; if (c0 < 24) { const f32x4 z = acc[ai][0][m][n] * rs;
                            *(GAS f32x4*)(dst + (size_t)row * 24 + c0) = (f32x4){sigmoidf(z.x), sigmoidf(z.y), sigmoidf(z.z), sigmoidf(z.w)}; } } } }
        }
    }
};
struct EpiOut {
    static constexpr bool PERM = false, AFTER_DRAIN = false;
    const float* x; float* y;
    __device__ __forceinline__ void operator()(const f32x4 (&acc)[2][2][4][2], const pg8::Unit& u, int wr, int wc, int fr, int fq) const {
        asm volatile("" : "+v"(fr), "+v"(fq));
#pragma unroll
        for (int ai = 0; ai < 2; ++ai)
#pragma unroll
            for (int m = 0; m < 4; ++m) { const size_t row = (size_t)u.pm * 256 + ai * 128 + wr * 64 + m * 16 + fr;
#pragma unroll
                for (int bj = 0; bj < 2; ++bj)
#pragma unroll
                    for (int n = 0; n < 2; ++n) { const size_t off = row * D + u.pn * 256 + 128 * bj + 32 * wc + 16 * n + 4 * fq;
                        *(GAS f32x4*)(y + off) = *(const GAS f32x4*)(x + off) + acc[ai][bj][m][n]; } }
    }
};
template <int MODE>
__device__ __forceinline__ void small_gemm_tile(const Ptrs& P, const bf16* A, const bf16* Bt, int ct, int lane) {
    const int rho = lane & 15, kq = lane >> 4;
    f32x4 acc[2] = {(f32x4){0.f, 0.f, 0.f, 0.f}, (f32x4){0.f, 0.f, 0.f, 0.f}};
    const GAS v4u* a0 = (const GAS v4u*)(A + (size_t)rho * D + 8 * kq); const GAS v4u* a1 = (const GAS v4u*)(A + (size_t)(16 + rho) * D + 8 * kq);
    const GAS v4u* bp = (const GAS v4u*)(Bt + (size_t)(16 * ct + rho) * D + 8 * kq);
#pragma unroll 8
    for (int ks = 0; ks < 32; ++ks) { const bf16x8 bb = __builtin_bit_cast(bf16x8, bp[ks * 4]);
        acc[0] = __builtin_amdgcn_mfma_f32_16x16x32_bf16(bb, __builtin_bit_cast(bf16x8, a0[ks * 4]), acc[0], 0, 0, 0);
        acc[1] = __builtin_amdgcn_mfma_f32_16x16x32_bf16(bb, __builtin_bit_cast(bf16x8, a1[ks * 4]), acc[1], 0, 0, 0); }
#pragma unroll
    for (int rt = 0; rt < 2; ++rt) { const int b = 16 * rt + rho; const int col = 16 * ct + 4 * kq;
        if (MODE == 0) { const float rs = ((const float*)(P.ws + WS_RSTDS))[b]; *(GAS f32x4*)((float*)(P.ws + WS_PROJS) + (size_t)b * NP + col) = acc[rt] * rs; }
        else *(GAS f32x4*)(P.out + O_YS + (size_t)b * D + col) = *(const GAS f32x4*)(P.xs + (size_t)b * D + col) + acc[rt]; }
}
__device__ __forceinline__ int projs_col(int pn, int wc, int d) { return 256 * pn + 128 * (d >> 5) + 32 * wc + (d & 31); }
__device__ __forceinline__ void p2_sample_item(const Ptrs& P, int it, int lane) {
    const int b = it / 37, ty = it - b * 37;
    const float* pr = (const float*)(P.ws + WS_PROJS) + (size_t)b * NP;
    const float* ropes = (const float*)(P.ws + WS_ROPE) + (size_t)8192 * 64;
    float* kvn = (float*)(P.ws + WS_KVN) + (size_t)b * 768;
    if (ty < 14) {
        const bool isq = ty < 8; const int br = isq ? 0 : (ty - 8) >> 1, g = (ty - 8) & 1;
        const int pn = isq ? 8 + (ty >> 2) : 10 + br, wc = isq ? (ty & 3) : g;
        const float v = pr[projs_col(pn, wc, lane)];
        const float ss = wave_sum(v * v); const float inv = 1.0f / sqrtf(ss * (1.0f / 64.0f) + NORM_EPS);
        const float gn = isq ? P.q_gain[lane] : P.k_gain[br * 64 + lane];
        const float xn = v * inv * gn; const float xo = __shfl_xor(xn, 32);
        const int i = lane & 31; const float cs = ropes[i], sn = ropes[32 + i];
        const float o = (lane < 32) ? xn * cs - xo * sn : xn * cs + xo * sn;
        if (isq) ((float*)(P.ws + WS_QS))[(size_t)b * 512 + ty * 64 + lane] = o * QSCALE;
        else { kvn[(br * 2 + 0) * 128 + g * 64 + lane] = o;
            if (br == 0) P.out[O_SCMP + (size_t)b * 256 + g * 64 + lane] = o; else if (br == 1) P.out[O_SSLC + (size_t)b * 256 + g * 64 + lane] = o;
            else P.out[O_SWIN + ((size_t)b * 512 + 511) * 256 + g * 64 + lane] = o; }
    } else if (ty < 20) {
        const int br = (ty - 14) >> 1, g = (ty - 14) & 1; const float v = pr[projs_col(10 + br, 2 + g, lane)];
        kvn[(br * 2 + 1) * 128 + g * 64 + lane] = v;
        if (br == 0) P.out[O_SCMP + (size_t)b * 256 + 128 + g * 64 + lane] = v; else if (br == 1) P.out[O_SSLC + (size_t)b * 256 + 128 + g * 64 + lane] = v;
        else P.out[O_SWIN + ((size_t)b * 512 + 511) * 256 + 128 + g * 64 + lane] = v;
    } else if (ty == 20) {
        if (lane < 24) ((float*)(P.ws + WS_GS))[b * 24 + lane] = sigmoidf(pr[256 * 15 + lane]);
    } else if (ty < 29) {
        const int ch = (ty - 21) * 64 + lane; const int pnb = ch >> 7, tc = ch & 127;
        const float bg = pr[256 * pnb + tc], zc = pr[256 * pnb + 128 + tc], cg = pr[256 * (4 + pnb) + tc], ci = pr[256 * (4 + pnb) + 128 + tc];
        const float u = cg * ci; const float s0 = P.st_conv[(size_t)b * 1024 + ch], s1 = P.st_conv[(size_t)b * 1024 + 512 + ch];
        const float cy = P.conv_w[ch] * s0 + P.conv_w[512 + ch] * s1 + P.conv_w[1024 + ch] * u + P.conv_b[ch];
        ((bf16*)(P.ws + WS_MIXS))[(size_t)b * 1024 + ch] = (bf16)f2bf(bg * cy * zc * sigmoidf(zc));
        P.out[O_SCONV + (size_t)b * 1024 + 512 + ch] = u;
    } else {
        const int col = (ty - 29) * 64 + lane; const float z = pr[256 * (13 + (col >> 8)) + (col & 255)];
        ((float*)(P.ws + WS_ZAS))[(size_t)b * 512 + col] = z * sigmoidf(z);
    }
}
__device__ __forceinline__ void p2_phase(const Ptrs& P, Frame& F) {
    compress_units<false>(P, F, (LAS float*)(F.lds + RING_OFF));
    for (int it = F.gw; it < DECB * 37; it += F.NGW) p2_sample_item(P, it, F.lane);
}
#define MFMA32(a, b, c) __builtin_amdgcn_mfma_f32_32x32x16_bf16(a, b, c, 0, 0, 0)
constexpr int P3_IMP = 0, P3_QL = 32768;
constexpr int P3_NEXT = LDSCTL_OFF + 512, P3_CNT = LDSCTL_OFF + 1024, P3_LISTS = LDSCTL_OFF + 2048, P3_LACC = LDSCTL_OFF + 10240;
constexpr int P3_RING = 65536;
constexpr int P3_MISC = MISC_OFF + 64;
constexpr int SM_Q = 36864, SM_P = 40960, SM_RED = 57344, SM_IMP = 66048, SM_L = 67200, SM_SEL = 67328, SM_O = 67584, SM_VP = 71680  , SM_RED2 = 79872  ;

template <bool MASK>
__device__ __forceinline__ void attend_lds(const LAS unsigned char* blk, const bf16x8 (&qf)[4], f32x16 (&O)[2], float& lsum,
                                           int kbase, int lo, int hi, int lane, bool want_pv, f32x16 (*Sout)[2] = nullptr) {
    const int r = lane & 31, hh = lane >> 5, swz = (r >> 1) & 7;
    const LAS unsigned char* kb = blk + r * 128; const LAS unsigned char* vb = blk + 8192 + r * 128;
#pragma unroll
    for (int kt = 0; kt < 2; ++kt) {
        f32x16 S;
        { bf16x8 kf[4];
#pragma unroll
          for (int s = 0; s < 4; ++s) kf[s] = *(const LAS bf16x8*)(kb + kt * 4096 + (((2 * s + hh) ^ swz) << 4));
#pragma unroll
          for (int i = 0; i < 16; ++i) S[i] = 0.f;
#pragma unroll
          for (int s = 0; s < 4; ++s) S = MFMA32(kf[s], qf[s], S); }
#pragma unroll
        for (int i = 0; i < 16; ++i) { float p = fast_exp2(S[i]);
            if (MASK) { const int kp = kbase + 32 * kt + (i & 3) + 8 * (i >> 2) + 4 * hh; p = (kp >= lo && kp <= hi) ? p : 0.f; }
            S[i] = p; lsum += p; }
        if (Sout) (*Sout)[kt] = S;
        if (want_pv) {
            bf16x8 pf[2];
#pragma unroll
            for (int sp = 0; sp < 2; ++sp) { v4u w; w.x = pk2(S[8 * sp + 0], S[8 * sp + 1]); w.y = pk2(S[8 * sp + 2], S[8 * sp + 3]);
                w.z = pk2(S[8 * sp + 4], S[8 * sp + 5]); w.w = pk2(S[8 * sp + 6], S[8 * sp + 7]); pf[sp] = __builtin_bit_cast(bf16x8, w); }
#pragma unroll
            for (int dt = 0; dt < 2; ++dt)
#pragma unroll
                for (int sp = 0; sp < 2; ++sp) { const bf16x8 vf = *(const LAS bf16x8*)(vb + dt * 4096 + (((2 * (2 * kt + sp) + hh) ^ swz) << 4));
                    O[dt] = MFMA32(vf, pf[sp], O[dt]); }
        }
    }
}
__device__ __forceinline__ void wave_topk(const LAS float* imp, int jmax, int nsel, int lane, int qbase, LAS unsigned* cnt, LAS unsigned char* lists) {
    if (jmax < 1) return;
    const bool c0 = lane >= 1 && lane <= jmax, c1 = 64 + lane <= jmax;
    unsigned k0[8], k1[8], Tv[8];
#pragma unroll
    for (int qi = 0; qi < 8; ++qi) { k0[qi] = c0 ? ((__builtin_bit_cast(unsigned, imp[qi * 128 + lane]) + 0x800u) & ~0x7ffu) : 0u; k1[qi] = c1 ? ((__builtin_bit_cast(unsigned, imp[qi * 128 + 64 + lane]) + 0x800u) & ~0x7ffu) : 0u; Tv[qi] = 0u; }
    if (jmax > nsel) {
        for (int bit = 30; bit >= 11; --bit) {
#pragma unroll
            for (int qi = 0; qi < 8; ++qi) { const unsigned cand = Tv[qi] | (1u << bit);
                const int cn = __popcll(__ballot(k0[qi] >= cand)) + __popcll(__ballot(k1[qi] >= cand)); Tv[qi] = cn >= nsel ? cand : Tv[qi]; } }
    }
    const unsigned long long below = (lane == 0) ? 0ull : (~0ull >> (64 - lane));
#pragma unroll
    for (int qi = 0; qi < 8; ++qi) {
        bool s0, s1;
        if (jmax > nsel) {
            const unsigned long long g0 = __ballot(k0[qi] > Tv[qi]), g1 = __ballot(k1[qi] > Tv[qi]), e0 = __ballot(k0[qi] == Tv[qi]), e1 = __ballot(k1[qi] == Tv[qi]);
            const int need = nsel - __popcll(g0) - __popcll(g1);
            const int rk0 = __popcll(e0 & below), rk1 = __popcll(e0) + __popcll(e1 & below);
            s0 = k0[qi] > Tv[qi] || (k0[qi] == Tv[qi] && rk0 < need); s1 = k1[qi] > Tv[qi] || (k1[qi] == Tv[qi] && rk1 < need);
        } else { s0 = c0; s1 = c1; }
        if (s0) { const unsigned pos = __hip_atomic_fetch_add(cnt + lane, 1u, __ATOMIC_RELAXED, __HIP_MEMORY_SCOPE_WORKGROUP); lists[lane * 64 + pos] = (unsigned char)(qbase + qi); }
        if (s1) { const unsigned pos = __hip_atomic_fetch_add(cnt + 64 + lane, 1u, __ATOMIC_RELAXED, __HIP_MEMORY_SCOPE_WORKGROUP); lists[(64 + lane) * 64 + pos] = (unsigned char)(qbase + qi); }
    }
}
struct BlkSrc { const bf16* k; const bf16* v; int vstride; };
#ifndef PROBE_SEG
#define PROBE_SEG 0
#endif
#define T_BEGIN(id) do { if (PROBE_SEG == (id)) tacc -= __builtin_readcyclecounter(); } while (0)
#define T_END(id) do { if (PROBE_SEG == (id)) tacc += __builtin_readcyclecounter(); } while (0)
__device__ __forceinline__ void p3_prompt_unit(const Ptrs& P, Frame& F, int b, int t, int g, float sh_cmp, float sh_slc, float sh_win, unsigned long long& tacc) {
    int lane = F.lane, w = F.wave, tid = F.tid; asm volatile("" : "+v"(lane), "+s"(w), "+v"(tid));
    const int col = lane & 31, hh = lane >> 5, qi = col >> 2, h = col & 3;
    const int tok = 64 * t + 8 * w + qi; const size_t row = (size_t)b * T + tok; const int qpos = tok;
    const int nck = (2 * t + 2 + 63) >> 6, nf = t >= 2 ? 3 : t + 1, nw = t >= 8 ? 9 : t + 1;
    const int n1 = nck, n2 = 2 * nck, N1 = n2 + nf;
    const bf16* KC = (const bf16*)(P.ws + WS_KC) + (size_t)(b * 2 + g) * 256 * 64; const bf16* VCT = (const bf16*)(P.ws + WS_VCT) + (size_t)(b * 2 + g) * 64 * 256;
    const bf16* KS = (const bf16*)(P.ws + WS_KS) + (size_t)(b * 2 + g) * T * 64; const bf16* VTS = (const bf16*)(P.ws + WS_VTS) + (size_t)(b * 2 + g) * 128 * 4096;
    const bf16* KW = (const bf16*)(P.ws + WS_KW) + (size_t)(b * 2 + g) * T * 64; const bf16* VTW = (const bf16*)(P.ws + WS_VTW) + (size_t)(b * 2 + g) * 128 * 4096;
    auto src1 = [&](int n) -> BlkSrc {
        if (n < n2) { const int ck = n < n1 ? n : n - n1; return BlkSrc{KC + (size_t)ck * 4096, VCT + ck * 64, 256}; }
        const int f = n - n2; const int j = f == 0 ? t : (f == 1 ? 0 : t - 1); return BlkSrc{KS + (size_t)j * 4096, VTS + (size_t)j * 4096, 64}; };
    auto src2 = [&](int n) -> BlkSrc { const int j = (t >= 8 ? t - 8 : 0) + n; return BlkSrc{KW + (size_t)j * 4096, VTW + (size_t)j * 4096, 64}; };
    const int srow = 8 * w + (lane >> 3), sch = (lane & 7) ^ ((srow >> 1) & 7);
    LAS unsigned char* ring = F.lds + P3_RING;
#define ST_DMA(bs_, n) do { LAS unsigned char* d_ = ring + ((n) & 3) * 16384 + w * 1024; \
        __builtin_amdgcn_global_load_lds((const unsigned*)((bs_).k + srow * 64 + sch * 8), (LAS unsigned*)d_, 16, 0, 0); \
        __builtin_amdgcn_global_load_lds((const unsigned*)((bs_).v + (size_t)srow * (bs_).vstride + sch * 8), (LAS unsigned*)(d_ + 8192), 16, 0, 0); } while (0)
#define BLK(n) (ring + ((n) & 3) * 16384)
#define STEP_BEGIN(SRC, n, NN) do { if (((n) & 1) == 0) { if ((n) + 2 < (NN)) { const BlkSrc b_ = SRC((n) + 2); ST_DMA(b_, (n) + 2); } if ((n) + 3 < (NN)) { const BlkSrc b_ = SRC((n) + 3); ST_DMA(b_, (n) + 3); } } } while (0)
#define STEP_END(n, NN) do { if (((n) & 1) == 1 || (n) == (NN) - 1) { asm volatile("s_waitcnt vmcnt(0)" ::: "memory"); __syncthreads(); } } while (0)
    LAS unsigned* cnt = (LAS unsigned*)(F.lds + P3_CNT); LAS unsigned char* lists = F.lds + P3_LISTS; LAS unsigned* nextb = (LAS unsigned*)(F.lds + P3_NEXT);
    LAS int* oacc = (LAS int*)ring; LAS float* lacc = (LAS float*)(F.lds + P3_LACC);
    const float FXS = fast_exp2(18.0f - sh_slc), FXI = 1.0f / FXS;
    LAS unsigned char* ql = F.lds + P3_QL;
    T_BEGIN(1); T_BEGIN(8);
    __syncthreads();
    if (tid < 128) cnt[tid] = 0u; if (tid == 128) nextb[0] = 0u;
    { const BlkSrc b0 = src1(0); ST_DMA(b0, 0); if (N1 > 1) { const BlkSrc b1 = src1(1); ST_DMA(b1, 1); } }
    { const bf16* qg = (const bf16*)(P.ws + WS_Q) + ((size_t)b * T + 64 * t) * 512 + g * 256;
      v4u tq[4];
#pragma unroll
      for (int k = 0; k < 4; ++k) { const int c = tid + 512 * k, rq = c >> 3, ch = c & 7; tq[k] = *(const GAS v4u*)(qg + (size_t)(rq >> 2) * 512 + (rq & 3) * 64 + ch * 8); }
#pragma unroll
      for (int k = 0; k < 4; ++k) { const int c = tid + 512 * k, rq = c >> 3, ch = c & 7; *(LAS v4u*)(ql + rq * 128 + ((ch ^ ((rq >> 1) & 7)) << 4)) = tq[k]; } }
    bf16x8 qf[4];
    { const bf16* q = (const bf16*)(P.ws + WS_Q) + row * 512 + (g * 4 + h) * 64 + 8 * hh;
#pragma unroll
      for (int s = 0; s < 4; ++s) qf[s] = __builtin_bit_cast(bf16x8, *(const GAS v4u*)(q + 16 * s)); }
    const float* gate = (const float*)(P.ws + WS_GATE) + row * 24 + (g * 4 + h) * 3;
    const float g_cmp = gate[0], g_slc = gate[1], g_win = gate[2];
    asm volatile("s_waitcnt vmcnt(0)" ::: "memory"); __syncthreads();
    T_END(1); T_BEGIN(2);
    f32x16 O[2];
    LAS float* wl = (LAS float*)(F.lds + P3_IMP + w * 4096);
    float* totg = (float*)(P.ws + WS_TOT) + ((size_t)blockIdx.x * 8 + w) * 2048 + lane;
    const int nvis = (qpos + 1) >> 5;
    int n = 0;
    float lsum = 0.f;
    for (; n < n1; ++n) { STEP_BEGIN(src1, n, N1); attend_lds<true>(BLK(n), qf, O, lsum, 64 * n, 0, nvis - 1, lane, false); STEP_END(n, N1); }
    lsum += __shfl_xor(lsum, 32);
    const float rl = lsum > 0.f ? 1.0f / lsum : 0.f;
    for (int i = lane; i < 1024; i += 64) wl[i] = 0.f;
#pragma unroll
    for (int i = 0; i < 16; ++i) { O[0][i] = 0.f; O[1][i] = 0.f; }
    { float dummy = 0.f;
      for (; n < n2; ++n) { STEP_BEGIN(src1, n, N1); const int ck = n - n1; f32x16 Sn[2];
        attend_lds<true>(BLK(n), qf, O, dummy, 64 * ck, 0, nvis - 1, lane, true, &Sn);
#pragma unroll
        for (int kt = 0; kt < 2; ++kt)
#pragma unroll
            for (int i2 = 0; i2 < 8; ++i2) { const float v = quad_sum((Sn[kt][2 * i2] + Sn[kt][2 * i2 + 1]) * rl);
                if (h == 0) wl[qi * 128 + 32 * ck + 16 * kt + (i2 & 1) + 4 * (i2 >> 1) + 2 * hh] = v; }
        STEP_END(n, N1); } }
    LDS_WAIT(); asm volatile("" ::: "memory");
    T_END(2); T_BEGIN(3);
    wave_topk(wl, t - 2, 13, lane, 8 * w, cnt, lists);
#pragma unroll
    for (int i = 0; i < 16; ++i) { totg[i * 64] = O[0][i] * (g_cmp * rl); totg[(16 + i) * 64] = O[1][i] * (g_cmp * rl); O[0][i] = 0.f; O[1][i] = 0.f; }
    T_END(3); T_BEGIN(4);
    lsum = 0.f;
    for (; n < N1; ++n) { STEP_BEGIN(src1, n, N1);
        if (n == n2) attend_lds<true>(BLK(n), qf, O, lsum, 64 * t, 0, qpos, lane, true);
        else attend_lds<false>(BLK(n), qf, O, lsum, 0, 0, 0, lane, true);
        STEP_END(n, N1); }
    lsum += __shfl_xor(lsum, 32);
#pragma unroll
    for (int dt = 0; dt < 2; ++dt)
#pragma unroll
        for (int i = 0; i < 16; ++i) oacc[(32 * dt + (i & 3) + 8 * (i >> 2) + 4 * hh) * 256 + 32 * w + col] = __float2int_rn(O[dt][i] * FXS);
    if (hh == 0) lacc[32 * w + col] = lsum;
    __syncthreads();
    T_END(4); T_BEGIN(5);
    if (t > 2) {
        const int r = lane & 31;
#define NEXT_BLOCK(jv_, nq_) do { for (;;) { unsigned t_ = 0u; if (lane == 0) t_ = __hip_atomic_fetch_add(nextb, 1u, __ATOMIC_RELAXED, __HIP_MEMORY_SCOPE_WORKGROUP); \
            jv_ = 1 + (int)__builtin_amdgcn_readfirstlane(t_); if (jv_ > t - 2) { nq_ = 0; break; } nq_ = (int)__builtin_amdgcn_readfirstlane(cnt[jv_]); if (nq_ > 0) break; } } while (0)
#define LOAD_FRAGS(kd_, vd_, jv_) do { const bf16* kp_ = KS + (size_t)(jv_) * 4096 + r * 64 + 8 * hh; const bf16* vp_ = VTS + (size_t)(jv_) * 4096 + r * 64 + 8 * hh; \
            _Pragma("unroll") for (int a_ = 0; a_ < 2; ++a_) _Pragma("unroll") for (int b_ = 0; b_ < 4; ++b_) { kd_[a_][b_] = __builtin_bit_cast(bf16x8, *(const GAS v4u*)(kp_ + a_ * 2048 + 16 * b_)); \
                vd_[a_][b_] = __builtin_bit_cast(bf16x8, *(const GAS v4u*)(vp_ + a_ * 2048 + 16 * b_)); } } while (0)
        bf16x8 kf[2][4], vf[2][4];
        for (;;) {
            int j, nq; NEXT_BLOCK(j, nq);
            if (j > t - 2) break;
            LOAD_FRAGS(kf, vf, j);
#pragma unroll
            for (int a_ = 0; a_ < 2; ++a_)
#pragma unroll
                for (int b_ = 0; b_ < 4; ++b_) asm volatile("" : "+v"(kf[a_][b_]), "+v"(vf[a_][b_]));
            for (int c0 = 0; c0 < nq; c0 += 8) {
                const int sl = c0 + qi; const bool valid = sl < nq;
                const int rowq = (int)lists[j * 64 + (valid ? sl : nq - 1)] * 4 + h;
                const LAS unsigned char* qp = ql + rowq * 128; const int qsw = (rowq >> 1) & 7;
                bf16x8 q2[4];
#pragma unroll
                for (int s = 0; s < 4; ++s) q2[s] = *(const LAS bf16x8*)(qp + (((2 * s + hh) ^ qsw) << 4));
                float l2 = 0.f; bf16x8 pf[4]; f32x16 S0, S1;
#pragma unroll
                for (int i = 0; i < 16; ++i) { S0[i] = 0.f; S1[i] = 0.f; }
#pragma unroll
                for (int s = 0; s < 4; ++s) { S0 = MFMA32(kf[0][s], q2[s], S0); S1 = MFMA32(kf[1][s], q2[s], S1); }
#pragma unroll
                for (int i = 0; i < 16; ++i) { S0[i] = fast_exp2(S0[i]); l2 += S0[i]; }
#pragma unroll
                for (int sp = 0; sp < 2; ++sp) { v4u wv; wv.x = pk2(S0[8 * sp + 0], S0[8 * sp + 1]); wv.y = pk2(S0[8 * sp + 2], S0[8 * sp + 3]);
                    wv.z = pk2(S0[8 * sp + 4], S0[8 * sp + 5]); wv.w = pk2(S0[8 * sp + 6], S0[8 * sp + 7]); pf[sp] = __builtin_bit_cast(bf16x8, wv); }
#pragma unroll
                for (int i = 0; i < 16; ++i) { S1[i] = fast_exp2(S1[i]); l2 += S1[i]; }
#pragma unroll
                for (int sp = 0; sp < 2; ++sp) { v4u wv; wv.x = pk2(S1[8 * sp + 0], S1[8 * sp + 1]); wv.y = pk2(S1[8 * sp + 2], S1[8 * sp + 3]);
                    wv.z = pk2(S1[8 * sp + 4], S1[8 * sp + 5]); wv.w = pk2(S1[8 * sp + 6], S1[8 * sp + 7]); pf[2 + sp] = __builtin_bit_cast(bf16x8, wv); }
                l2 += __shfl_xor(l2, 32);
                T_BEGIN(9);
#pragma unroll
                for (int dt = 0; dt < 2; ++dt) { f32x16 O2;
#pragma unroll
                    for (int i = 0; i < 16; ++i) O2[i] = 0.f;
#pragma unroll
                    for (int ks = 0; ks < 4; ++ks) O2 = MFMA32(vf[dt][ks], pf[ks], O2);
                    if (valid) {
#pragma unroll
                        for (int i = 0; i < 16; ++i) (void)__hip_atomic_fetch_add(oacc + (32 * dt + (i & 3) + 8 * (i >> 2) + 4 * hh) * 256 + rowq, __float2int_rn(O2[i] * FXS), __ATOMIC_RELAXED, __HIP_MEMORY_SCOPE_WORKGROUP); } }
                if (valid) {
                    if (hh == 0) (void)__hip_atomic_fetch_add(lacc + rowq, l2, __ATOMIC_RELAXED, __HIP_MEMORY_SCOPE_WORKGROUP); }
                LDS_WAIT(); T_END(9);
            }
        }
#undef NEXT_BLOCK
#undef LOAD_FRAGS
    }
    __syncthreads();
    T_END(5); T_BEGIN(6);
    LAS float* x0 = (LAS float*)(F.lds + P3_IMP + w * 4096) + lane; LAS float* x1 = (LAS float*)(F.lds + P3_QL + w * 4096) + lane;
    { const float sc = g_slc / fmaxf(lacc[32 * w + col], 1e-30f);
#pragma unroll
      for (int i = 0; i < 16; ++i) { const int dr = (i & 3) + 8 * (i >> 2) + 4 * hh;
          x0[i * 64] = totg[i * 64] + (float)oacc[dr * 256 + 32 * w + col] * (FXI * sc); x1[i * 64] = totg[(16 + i) * 64] + (float)oacc[(32 + dr) * 256 + 32 * w + col] * (FXI * sc); O[0][i] = 0.f; O[1][i] = 0.f; } }
    LDS_WAIT(); __syncthreads();
    { const BlkSrc b0 = src2(0); ST_DMA(b0, 0); if (nw > 1) { const BlkSrc b1 = src2(1); ST_DMA(b1, 1); } }
    { asm volatile("" : "+v"(lane));
      const bf16* q = (const bf16*)(P.ws + WS_Q) + row * 512 + (g * 4 + h) * 64 + 8 * hh;
#pragma unroll
      for (int s = 0; s < 4; ++s) qf[s] = __builtin_bit_cast(bf16x8, *(const GAS v4u*)(q + 16 * s)); }
    asm volatile("s_waitcnt vmcnt(0)" ::: "memory"); __syncthreads();
    lsum = 0.f;
    for (n = 0; n < nw; ++n) { STEP_BEGIN(src2, n, nw); const int j = (t >= 8 ? t - 8 : 0) + n;
        if (j == t || j + 8 == t) attend_lds<true>(BLK(n), qf, O, lsum, 64 * j, qpos - 511, qpos, lane, true);
        else attend_lds<false>(BLK(n), qf, O, lsum, 0, 0, 0, lane, true);
        STEP_END(n, nw); }
    lsum += __shfl_xor(lsum, 32);
    { const float sc = g_win / fmaxf(lsum, 1e-30f);
#pragma unroll
      for (int i = 0; i < 16; ++i) { O[0][i] = x0[i * 64] + O[0][i] * sc; O[1][i] = x1[i * 64] + O[1][i] * sc; } }
#undef ST_DMA
#undef BLK
#undef STEP_BEGIN
#undef STEP_END
    T_END(6); T_BEGIN(7);
    asm volatile("" : "+v"(lane));
    const int col_ = lane & 31, hh_ = lane >> 5, h_ = col_ & 3; const size_t row_ = (size_t)b * T + 64 * t + 8 * w + (col_ >> 2);
    const bf16* za = (const bf16*)(P.ws + WS_ZA) + row_ * 512 + (g * 4 + h_) * 64; bf16* mx = (bf16*)(P.ws + WS_MIX) + row_ * 1024 + 512 + (g * 4 + h_) * 64;
#pragma unroll
    for (int dt = 0; dt < 2; ++dt)
#pragma unroll
        for (int i4 = 0; i4 < 4; ++i4) { const int d = 32 * dt + 8 * i4 + 4 * hh_; const v2u z = *(const GAS v2u*)(za + d);
            v2u o; o.x = pk2(O[dt][4 * i4] * bf2f(z.x & 0xffffu), O[dt][4 * i4 + 1] * bf2f(z.x >> 16)); o.y = pk2(O[dt][4 * i4 + 2] * bf2f(z.y & 0xffffu), O[dt][4 * i4 + 3] * bf2f(z.y >> 16));
            *(GAS v2u*)(mx + d) = o; }
    if (g == 0) { const int tq = w, c8 = lane * 8; const size_t r0 = (size_t)b * T + 64 * t + 8 * tq;
        const bf16* U = (const bf16*)(P.ws + WS_U) + c8; const bf16* CGp = (const bf16*)(P.ws + WS_CG) + c8; bf16* mo = (bf16*)(P.ws + WS_MIX) + c8;
        v4u ur[10], cr[8];
        const bool has_prev = (t > 0) || (tq > 0);
#pragma unroll
        for (int i = 0; i < 10; ++i) ur[i] = (i >= 2 || has_prev) ? *(const GAS v4u*)(U + (r0 + i - 2) * 512) : (v4u){0u, 0u, 0u, 0u};
#pragma unroll
        for (int i = 0; i < 8; ++i) cr[i] = *(const GAS v4u*)(CGp + (r0 + i) * 512);
        float w0[8], w1[8], w2[8], cb[8];
#pragma unroll
        for (int e = 0; e < 8; ++e) { w0[e] = P.conv_w[c8 + e]; w1[e] = P.conv_w[512 + c8 + e]; w2[e] = P.conv_w[1024 + c8 + e]; cb[e] = P.conv_b[c8 + e]; }
#pragma unroll
        for (int i = 0; i < 8; ++i) { float o[8];
#pragma unroll
            for (int e = 0; e < 8; ++e) { const int sh_ = (e & 1) * 16; const float a = bf2f((ur[i][e >> 1] >> sh_) & 0xffffu), bb = bf2f((ur[i + 1][e >> 1] >> sh_) & 0xffffu), c = bf2f((ur[i + 2][e >> 1] >> sh_) & 0xffffu);
                o[e] = bf2f((cr[i][e >> 1] >> sh_) & 0xffffu) * (w0[e] * a + w1[e] * bb + w2[e] * c + cb[e]); }
            v4u ov; ov.x = pk2(o[0], o[1]); ov.y = pk2(o[2], o[3]); ov.z = pk2(o[4], o[5]); ov.w = pk2(o[6], o[7]);
            *(GAS v4u*)(mo + (r0 + i) * 1024) = ov; } }
    T_END(7); T_END(8);
}
template <class KeyFn>
__device__ __forceinline__ void sample_branch(Frame& F, int nslots, float shift, const KeyFn& key, LAS float* obr) {
    LAS float* q = (LAS float*)(F.lds + SM_Q); LAS float* Pb = (LAS float*)(F.lds + SM_P); LAS float* red = (LAS float*)(F.lds + SM_RED); LAS float* lsm = (LAS float*)(F.lds + SM_L);
    LAS unsigned long long* vptr = (LAS unsigned long long*)(F.lds + SM_VP);
    float lacc[4] = {0.f, 0.f, 0.f, 0.f};
    for (int s = F.tid; s < nslots; s += 512) { const float* kp; const float* vp; const bool valid = key(s, kp, vp);
        float sc[4] = {0.f, 0.f, 0.f, 0.f};
        if (valid) {
#pragma unroll 8
            for (int d4 = 0; d4 < 16; ++d4) { const f32x4 kv = *(const GAS f32x4*)(kp + 4 * d4);
#pragma unroll
                for (int hq = 0; hq < 4; ++hq) { const f32x4 qv = *(const LAS f32x4*)(q + hq * 64 + 4 * d4); sc[hq] += (kv.x * qv.x + kv.y * qv.y) + (kv.z * qv.z + kv.w * qv.w); } } }
        f32x4 p;
#pragma unroll
        for (int hq = 0; hq < 4; ++hq) { p[hq] = valid ? fast_exp2(sc[hq] - shift) : 0.f; lacc[hq] += p[hq]; }
        *(LAS f32x4*)(Pb + 4 * s) = p; vptr[s] = (unsigned long long)(uintptr_t)vp; }
#pragma unroll
    for (int hq = 0; hq < 4; ++hq) { lacc[hq] = wave_sum(lacc[hq]); if (F.lane == 0) red[F.wave * 4 + hq] = lacc[hq]; }
    __syncthreads();
    if (F.tid < 4) { float s = 0.f; for (int ww = 0; ww < 8; ++ww) s += red[ww * 4 + F.tid]; lsm[F.tid] = s; }
    const int sg = F.tid >> 4, d4 = F.tid & 15;
    f32x4 oa[4];
#pragma unroll
    for (int hq = 0; hq < 4; ++hq) oa[hq] = (f32x4){0.f, 0.f, 0.f, 0.f};
    for (int s0 = sg; s0 < nslots; s0 += 256) {
        f32x4 vv[8], pp[8];
#pragma unroll
        for (int u = 0; u < 8; ++u) { const int s = s0 + 32 * u; const float* vp = (const float*)(uintptr_t)vptr[s]; vv[u] = *(const GAS f32x4*)(vp + 4 * d4); pp[u] = *(const LAS f32x4*)(Pb + 4 * s); }
#pragma unroll
        for (int u = 0; u < 8; ++u) { oa[0] = oa[0] + vv[u] * pp[u].x; oa[1] = oa[1] + vv[u] * pp[u].y; oa[2] = oa[2] + vv[u] * pp[u].z; oa[3] = oa[3] + vv[u] * pp[u].w; } }
    __syncthreads();
    LAS float* red2 = (LAS float*)(F.lds + SM_RED2);
#pragma unroll
    for (int hq = 0; hq < 4; ++hq) *(LAS f32x4*)(red2 + (sg * 4 + hq) * 64 + 4 * d4) = oa[hq];
    __syncthreads();
    if (F.tid < 256) { float s = 0.f;
#pragma unroll 8
        for (int g2 = 0; g2 < 32; ++g2) s += red2[g2 * 256 + F.tid]; obr[F.tid] = s; }
    __syncthreads();
}
__device__ __forceinline__ void p3_sample_unit(const Ptrs& P, Frame& F, int b, int g) {
    asm volatile("" : "+v"(F.tid), "+v"(F.lane), "+s"(F.wave));
    LAS float* q = (LAS float*)(F.lds + SM_Q); LAS float* Pb = (LAS float*)(F.lds + SM_P); LAS float* imp = (LAS float*)(F.lds + SM_IMP); LAS float* lsm = (LAS float*)(F.lds + SM_L);
    LAS int* sel = (LAS int*)(F.lds + SM_SEL); LAS float* osm = (LAS float*)(F.lds + SM_O);
    const float* cst = (const float*)(P.ws + WS_CONST);
    float kcmax = 0.f; for (int e_ = 0; e_ < 4; ++e_) kcmax += __builtin_bit_cast(float, __hip_atomic_load((unsigned*)(P.ws + WS_CTL) + CW_KCMAX + 64 + e_, RLX_AGENT));
    const float sh_cmp = cst[0] * sqrtf(kcmax) * LOG2E * 1.001f, sh_slc = cst[1], sh_win = cst[2];
    if (F.tid < 256) q[F.tid] = ((const float*)(P.ws + WS_QS))[(size_t)b * 512 + g * 256 + F.tid];
    __syncthreads();
    const float* kcs = (const float*)(P.ws + WS_KCS) + (size_t)(b * 2 + g) * 2 * NCS * 64;
    sample_branch(F, NCS, sh_cmp, [&](int s, const float*& kp, const float*& vp) { kp = kcs + (size_t)s * 64; vp = kcs + (size_t)(NCS + s) * 64; return true; }, osm);
    { const f32x4 p = *(const LAS f32x4*)(Pb + 4 * F.tid); float v = p.x / lsm[0] + p.y / lsm[1] + p.z / lsm[2] + p.w / lsm[3]; v += __shfl_xor(v, 1);
      if ((F.tid & 1) == 0) imp[F.tid >> 1] = v; if (F.tid < 4) imp[256 + F.tid] = 0.f; }
    if (F.tid < 256) osm[F.tid] = osm[F.tid] / lsm[F.tid >> 6];
    __syncthreads();
    if (F.wave == 0) { const int lane = F.lane; unsigned k[4];
#pragma unroll
        for (int i = 0; i < 4; ++i) { const int j = lane + 64 * i; k[i] = (j >= 1 && j <= 254) ? __builtin_bit_cast(unsigned, imp[j]) + 1u : 0u; }
        unsigned Tv = 0u;
        for (int bit = 30; bit >= 0; --bit) { const unsigned cand = Tv | (1u << bit); int cnt = 0;
#pragma unroll
            for (int i = 0; i < 4; ++i) cnt += __popcll(__ballot(k[i] >= cand));
            if (cnt >= 13) Tv = cand; }
        int ngt = 0;
#pragma unroll
        for (int i = 0; i < 4; ++i) ngt += __popcll(__ballot(k[i] > Tv));
        const int need = 13 - ngt; const unsigned long long below = (lane == 0) ? 0ull : (~0ull >> (64 - lane));
        int base = 3, eqbase = 0;
        if (lane == 0) { int z_ = 0; asm volatile("" : "+v"(z_)); sel[0] = z_; sel[1] = z_ + 255; sel[2] = z_ + 256; }
#pragma unroll
        for (int i = 0; i < 4; ++i) { const unsigned long long e = __ballot(k[i] == Tv); const int rk = eqbase + __popcll(e & below); const bool on = k[i] > Tv || (k[i] == Tv && rk < need);
            const unsigned long long m = __ballot(on); if (on) sel[base + __popcll(m & below)] = lane + 64 * i; base += __popcll(m); eqbase += __popcll(e); } }
    __syncthreads();
    const float* kvn = (const float*)(P.ws + WS_KVN) + (size_t)b * 768;
    const int* pt = P.page_table + b * NPAGES; const float* cs = P.cache_slc;
    sample_branch(F, 1024, sh_slc, [&](int s, const float*& kp, const float*& vp) { const int j = sel[s >> 6], rr = s & 63;
        if (j == 256) { kp = kvn + (1 * 2 + 0) * 128 + g * 64; vp = kvn + (1 * 2 + 1) * 128 + g * 64; return rr == 0; }
        const float* rowp = cs + ((size_t)pt[j >> 1] * 128 + (j & 1) * 64 + rr) * 256 + g * 64; kp = rowp; vp = rowp + 128; return true; }, osm + 256);
    if (F.tid < 256) osm[256 + F.tid] = osm[256 + F.tid] / lsm[F.tid >> 6];
    __syncthreads();
    const float* stw = P.st_win + (size_t)b * 512 * 256;
    sample_branch(F, 512, sh_win, [&](int s, const float*& kp, const float*& vp) {
        if (s == 511) { kp = kvn + (2 * 2 + 0) * 128 + g * 64; vp = kvn + (2 * 2 + 1) * 128 + g * 64; return true; }
        const float* rowp = stw + (size_t)(s + 1) * 256 + g * 64; kp = rowp; vp = rowp + 128; return true; }, osm + 512);
    if (F.tid < 256) { const int hq = F.tid >> 6, d = F.tid & 63; const float* gs = (const float*)(P.ws + WS_GS) + b * 24 + (g * 4 + hq) * 3;
        const float o = gs[0] * osm[F.tid] + gs[1] * osm[256 + F.tid] + gs[2] * osm[512 + F.tid] / lsm[hq];
        ((bf16*)(P.ws + WS_MIXS))[(size_t)b * 1024 + 512 + (g * 4 + hq) * 64 + d] = (bf16)f2bf(o * ((const float*)(P.ws + WS_ZAS))[(size_t)b * 512 + (g * 4 + hq) * 64 + d]); }
    __syncthreads();
}
__device__ __forceinline__ void p3_phase(const Ptrs& P, Frame& F, int rep) {
    const float* cst = (const float*)(P.ws + WS_CONST);
    float kcmax = 0.f; for (int e_ = 0; e_ < 4; ++e_) kcmax += __builtin_bit_cast(float, __hip_atomic_load((unsigned*)(P.ws + WS_CTL) + CW_KCMAX + e_, RLX_AGENT));
    const float sh_cmp = cst[0] * sqrtf(kcmax) * LOG2E * 1.001f, sh_slc = cst[1], sh_win = cst[2];
    unsigned long long tacc = 0ull;
    volatile LAS int* qw = (volatile LAS int*)(F.lds + P3_MISC);
#ifndef PROBE_P3
#define PROBE_P3 0
#endif
    constexpr int NS_ = PROBE_P3 == 1 ? 16 : 8, PSH_ = PROBE_P3 == 2 ? 1 : 0;
    constexpr int NQ = NS_ + (128 << PSH_);
    const int x0 = (int)(xb_xcc_id() & 7u);
    for (int xi = 0; xi < 8; ++xi) {
        const int x = (x0 + xi) & 7;
        for (;;) {
            __syncthreads();
            if (F.tid == 0) qw[0] = (int)__hip_atomic_fetch_add((unsigned*)(F.ctl + CW_QUEUE + 64 * (x + 8 * rep)), 1u, RLX_AGENT);
            __syncthreads();
            const int idx = qw[0];
            if (idx >= NQ) break;
            if (idx < NS_) p3_sample_unit(P, F, x * 4 + ((idx & 7) >> 1), idx & 1);
            else p3_prompt_unit(P, F, x >> 1, 127 - ((idx - NS_) >> PSH_), x & 1, sh_cmp, sh_slc, sh_win, tacc);
        }
    }
    if (PROBE_SEG != 0 && blockIdx.x == 0) { const unsigned long long t0_ = __builtin_readcyclecounter(); while (__builtin_readcyclecounter() - t0_ < tacc) __builtin_amdgcn_s_sleep(8); }
}
#ifndef MK_N_LAUNCHES
#define MK_N_LAUNCHES 1
#endif
constexpr int N_PHASES = 5;
constexpr int N_LAUNCHES = MK_N_LAUNCHES;
struct Args { Ptrs p; int ph_lo, ph_hi, rep, mode; };
__global__ void __launch_bounds__(NWAVES * 64, 2) nsa_fwd(Args args) {
    extern __shared__ __attribute__((aligned(16))) unsigned char lds[];
    const Ptrs& P = args.p;
    Frame F;
    F.lds = (LAS unsigned char*)lds;
    F.MISC = (volatile LAS unsigned*)(F.lds + MISC_OFF);
    F.tid = threadIdx.x; F.lane = F.tid & 63; F.wave = __builtin_amdgcn_readfirstlane(F.tid >> 6);
    F.G = gridDim.x; F.gw = blockIdx.x * NWAVES + F.wave; F.NGW = F.G * NWAVES;
    F.ctl = (gu32*)(P.ws + WS_CTL);
    for (int u = F.tid; u < (LDS_BYTES - LDSCTL_OFF) / 4; u += NWAVES * 64) ((LAS unsigned*)(F.lds + LDSCTL_OFF))[u] = 0u;
    __syncthreads();
    XcdBarrier bar; bar.bar = (unsigned*)(F.ctl + CW_BAR); bar.x = 0; bar.st = nullptr;
    if (N_LAUNCHES == 1) bar = xcd_barrier_post((unsigned*)(F.ctl + CW_BAR), F.MISC + 8);
    const int lo = args.ph_lo, hi = args.ph_hi;
    unsigned long long tprobe = 0ull;
#define IN(k) (lo <= (k) && (k) < hi)
#define FENCE() do { asm volatile("" : "+s"(F.wave), "+s"(F.gw)); F.lane = (int)__builtin_amdgcn_mbcnt_hi(~0u, __builtin_amdgcn_mbcnt_lo(~0u, 0u)); F.tid = F.wave * 64 + F.lane; asm volatile("" : "+v"(F.tid), "+v"(F.lane)); } while (0)
#define SEAM(k) do { if (IN(k) && IN((k) + 1)) xcd_barrier(bar, F.wave == 0 && (int)__builtin_amdgcn_mbcnt_hi(~0u, __builtin_amdgcn_mbcnt_lo(~0u, 0u)) == 0); } while (0)

    if (IN(0)) { FENCE(); p0_phase(P, F); } SEAM(0);
    if (IN(1)) { FENCE();
        pg8::Gemm g{(const pg8::bf16_t*)(P.ws + WS_XB), (const pg8::bf16_t*)(P.ws + WS_BT1), M, NP, D}; pg8::StaticOrder S; S.init(M, NP, F.G, (int)blockIdx.x);
        EpiIn E{(const float*)(P.ws + WS_RSTD), (const float*)(P.ws + WS_ROPE), P.q_gain, P.k_gain, P.out, P.ws};
        pg8::gemm_phase<EpiIn, pg8::StaticOrder, true, true>(F.lds + RING_OFF, g, S, E, F.wave, tprobe);
        FENCE();
        for (int ct = F.gw; ct < NP / 16; ct += F.NGW) small_gemm_tile<0>(P, (const bf16*)(P.ws + WS_XSB), (const bf16*)(P.ws + WS_BT1), ct, F.lane);
#if defined(PROBE_EPI)
        if (PROBE_EPI == 1 && blockIdx.x == 0) { const unsigned long long t0_ = __builtin_readcyclecounter(); while (__builtin_readcyclecounter() - t0_ < tprobe) __builtin_amdgcn_s_sleep(8); }
        tprobe = 0ull;
#endif
    } SEAM(1);
    if (IN(2)) { FENCE(); p2_phase(P, F); } SEAM(2);
    if (IN(3)) { FENCE(); p3_phase(P, F, args.rep); } SEAM(3);
    if (IN(4)) { FENCE();
        pg8::Gemm g{(const pg8::bf16_t*)(P.ws + WS_MIX), (const pg8::bf16_t*)(P.ws + WS_BT2), M, D, D}; pg8::StaticOrder S; S.init(M, D, F.G, (int)blockIdx.x);
        EpiOut E{P.xp, P.out + O_Y};
        pg8::gemm_phase<EpiOut, pg8::StaticOrder, true, true>(F.lds + RING_OFF, g, S, E, F.wave, tprobe);
        FENCE();
        for (int ct = F.gw; ct < D / 16; ct += F.NGW) small_gemm_tile<1>(P, (const bf16*)(P.ws + WS_MIXS), (const bf16*)(P.ws + WS_BT2), ct, F.lane);
#if defined(PROBE_EPI)
        if (PROBE_EPI == 2 && blockIdx.x == 0) { const unsigned long long t0_ = __builtin_readcyclecounter(); while (__builtin_readcyclecounter() - t0_ < tprobe) __builtin_amdgcn_s_sleep(8); }
#endif
    }
#undef IN
#undef SEAM
}

extern "C" void kernel_launch(void* const* d_in, const int* in_sizes, int n_in, void* d_out, int out_size, void* d_ws, size_t ws_size, hipStream_t stream) {
    static int grid = 0;
    if (grid == 0) {
        if (n_in != 16 || out_size != (int)O_END || ws_size < WS_END) { fprintf(stderr, "kernel_launch: unexpected shapes (n_in %d, out %d, ws %zu)\n", n_in, out_size, ws_size); grid = -1; return; }
        int dev = 0, cus = 0, per_cu = 0;
        if (hipGetDevice(&dev) != hipSuccess || hipDeviceGetAttribute(&cus, hipDeviceAttributeMultiprocessorCount, dev) != hipSuccess) { grid = -1; return; }
        if (hipFuncSetAttribute((const void*)nsa_fwd, hipFuncAttributeMaxDynamicSharedMemorySize, LDS_BYTES) != hipSuccess) { fprintf(stderr, "kernel_launch: hipFuncSetAttribute failed\n"); grid = -1; return; }
        if (hipOccupancyMaxActiveBlocksPerMultiprocessor(&per_cu, (const void*)nsa_fwd, NWAVES * 64, LDS_BYTES) != hipSuccess || per_cu < 1)
            fprintf(stderr, "kernel_launch: note: occupancy query reports %d workgroups per CU\n", per_cu);
        (void)hipGetLastError();
        grid = cus;
    }
    if (grid < 0) return;
    if (hipMemsetAsync((char*)d_ws + WS_CTL, 0, CTL_ZERO_BYTES, stream) != hipSuccess) return;
    Args a{}; a.mode = 3;
    a.p.xp = (const float*)d_in[0]; a.p.xs = (const float*)d_in[1]; a.p.cache_cmp = (const float*)d_in[2]; a.p.cache_slc = (const float*)d_in[3];
    a.p.st_win = (const float*)d_in[4]; a.p.st_conv = (const float*)d_in[5]; a.p.page_table = (const int*)d_in[6]; a.p.norm_g = (const float*)d_in[7];
    a.p.w_in = (const float*)d_in[8]; a.p.conv_w = (const float*)d_in[9]; a.p.conv_b = (const float*)d_in[10]; a.p.q_gain = (const float*)d_in[11];
    a.p.k_gain = (const float*)d_in[12]; a.p.cmp_pe = (const float*)d_in[13]; a.p.cmp_w = (const float*)d_in[14]; a.p.w_out = (const float*)d_in[15];
    a.p.out = (float*)d_out; a.p.ws = (unsigned char*)d_ws;
#ifndef PROBE_DUP
#define PROBE_DUP -1
#endif
    for (int li = 0; li < N_LAUNCHES; ++li) {
        a.ph_lo = (N_LAUNCHES == 1) ? 0 : li; a.ph_hi = (N_LAUNCHES == 1) ? N_PHASES : li + 1;
        for (int rep = 0; rep < ((N_LAUNCHES > 1 && li == PROBE_DUP) ? 2 : 1); ++rep) {
            a.rep = rep;
            hipLaunchKernelGGL(nsa_fwd, dim3(grid), dim3(NWAVES * 64), LDS_BYTES, stream, a);
            const hipError_t le = hipPeekAtLastError();
            if (le != hipSuccess) { fprintf(stderr, "kernel_launch: launch %d failed: %s\n", li, hipGetErrorName(le)); break; }
        }
    }
}
```

```cpp
#include <hip/hip_runtime.h>
#include <cstdio>
#include <cstdint>
#define GAS __attribute__((address_space(1)))
#define LAS __attribute__((address_space(3)))
typedef unsigned short bf16;
typedef unsigned v4u __attribute__((ext_vector_type(4)));
typedef unsigned v2u __attribute__((ext_vector_type(2)));
typedef float f32x2 __attribute__((ext_vector_type(2)));
typedef float f32x16 __attribute__((ext_vector_type(16)));
typedef GAS unsigned gu32;
typedef GAS unsigned long long gu64;
#define RLX_AGENT __ATOMIC_RELAXED, __HIP_MEMORY_SCOPE_AGENT
#define LDS_WAIT() asm volatile("s_waitcnt lgkmcnt(0)" ::: "memory")
#define VM_WAIT() asm volatile("s_waitcnt vmcnt(0)" ::: "memory")
#define MK_N_LAUNCHES 1
#define PROBE_DUP -1
#define PROBE_P3 0
#define PROBE_SEG 0
namespace pg8 {
#define PG8_LAS __attribute__((address_space(3)))
typedef unsigned short bf16_t;
typedef short bf16x8 __attribute__((ext_vector_type(8)));
typedef float f32x4 __attribute__((ext_vector_type(4)));
typedef unsigned u32x4 __attribute__((ext_vector_type(4)));
constexpr int BM = 256, BK = 64, HALF = 128, HTB = HALF * BK * 2  , STAGE_BYTES = 8 * HTB, NXCD = 8, WGM = 8;

__host__ __device__ __forceinline__ int lds_byte(int r, int c) { const int st = (r >> 4) * 2 + (c >> 5), rr = r & 15, cc = c & 31, ob = rr * 64 + cc * 2; return st * 1024 + (ob ^ (((ob >> 9) & 1) << 5)); }
__host__ __device__ __forceinline__ void stage_rc(int b, int& R, int& C) { const int st = b / 1024, sb = b % 1024, swz = sb ^ (((sb >> 9) & 1) << 5); R = (st >> 1) * 16 + swz / 64; C = (st & 1) * 32 + (swz % 64) / 2; }
__host__ __device__ __forceinline__ int perm32(int rho) { const int n = rho >> 4, i = rho & 15; return 8 * (i >> 2) + 4 * n + (i & 3); }

struct Unit { int pm, pn; };
struct Gemm { const bf16_t* A; const bf16_t* Bt; int M, N, K; };

struct StaticOrder {
    int nM, nN, nwg, G, c;
    __host__ __device__ void init(int M, int N, int G_, int c_) { nM = M / BM; nN = N / BM; nwg = nM * nN; G = G_; c = c_; }
    __host__ __device__ bool next(int i, Unit& u) const {
        const long L = (long)i * G + c; if (L >= nwg) return false;
        int wgid = (int)L; { const int q = nwg / NXCD, r = nwg % NXCD, xcd = wgid % NXCD, off = wgid / NXCD; wgid = (xcd < r ? xcd * (q + 1) : r * (q + 1) + (xcd - r) * q) + off; }
        const int nig = WGM * nN, gid = wgid / nig, fm = gid * WGM, gsz = (nM - fm) < WGM ? (nM - fm) : WGM;
        u.pm = fm + ((wgid % nig) % gsz); u.pn = (wgid % nig) / gsz; return true;
    }
    __device__ __forceinline__ void a_ready(const Unit&) const {}
    __device__ __forceinline__ void done(const Unit&) const {}
};


template <class Epi, class Sched, bool ALIGN_EPI = false, bool SP2 = false>
__device__ __forceinline__ void gemm_phase(PG8_LAS unsigned char* lds, const Gemm g, const Sched& S, const Epi& E, int wave_id  , unsigned long long& tacc_  ) {
    const int lane = (int)__builtin_amdgcn_mbcnt_hi(~0u, __builtin_amdgcn_mbcnt_lo(~0u, 0u)), wid = wave_id, tid = wid * 64 + lane, wr = wid >> 2, wc = wid & 3, fr = lane & 15, fq = lane >> 4;
    const int K = g.K, nt = K / BK;
    unsigned voffA[2], voffB[2];
#pragma unroll
    for (int i = 0; i < 2; ++i) { int R, C; stage_rc(tid * 16 + i * 8192, R, C); const int Rb = Epi::PERM ? ((R & ~31) + perm32(R & 31)) : R;
        voffA[i] = (unsigned)(R * K + C) * 2u; voffB[i] = (unsigned)(Rb * K + C) * 2u; }
    const size_t kstep = (size_t)(BK * 2);
    const size_t hstep = (size_t)HALF * K * 2;
    const size_t tstep = 2 * hstep;
    const unsigned ldsw = (unsigned)wid * 1024u;
    const int aoff = lds_byte(wr * 64 + fr, fq * 8), boff = lds_byte(wc * 32 + fr, fq * 8);
#define PG8_SA(b, h) (((b) * 2 + (h)) * HTB)
#define PG8_SB(b, h) ((4 + (b) * 2 + (h)) * HTB)
#define PG8_STAGE(bufoff, gbase, voff) do { _Pragma("unroll") for (int _i = 0; _i < 2; ++_i) \
        __builtin_amdgcn_global_load_lds((const unsigned*)((const char*)(gbase) + (voff)[_i]), (PG8_LAS unsigned*)(lds + (bufoff) + ldsw + _i * 8192), 16, 0, 0); } while (0)
#define PG8_LDA(dst, b, h) do { _Pragma("unroll") for (int m = 0; m < 4; ++m) _Pragma("unroll") for (int k = 0; k < 2; ++k) dst[m][k] = *(const PG8_LAS bf16x8*)(lds + PG8_SA(b, h) + aoff + m * 2048 + k * 1024); } while (0)
#define PG8_LDB(dst, b, h) do { _Pragma("unroll") for (int n = 0; n < 2; ++n) _Pragma("unroll") for (int k = 0; k < 2; ++k) dst[n][k] = *(const PG8_LAS bf16x8*)(lds + PG8_SB(b, h) + boff + n * 2048 + k * 1024); } while (0)
#define PG8_MMA(ai, bj, At, Bt) do { __builtin_amdgcn_s_setprio(1); _Pragma("unroll") for (int m = 0; m < 4; ++m) _Pragma("unroll") for (int n = 0; n < 2; ++n) _Pragma("unroll") for (int k = 0; k < 2; ++k) \
        acc[ai][bj][m][n] = __builtin_amdgcn_mfma_f32_16x16x32_bf16(Bt[n][k], At[m][k], acc[ai][bj][m][n], 0, 0, 0); __builtin_amdgcn_s_setprio(0); } while (0)
#define PG8_WAIT_V(n) asm volatile("s_waitcnt vmcnt(" #n ")" ::: "memory")
#define PG8_WAIT_L(n) asm volatile("s_waitcnt lgkmcnt(" #n ")" ::: "memory")
#define PG8_BAR __builtin_amdgcn_s_barrier()
#define PG8_SCHED __builtin_amdgcn_sched_barrier(0)
    Unit cur, nxt; int ui = 0;
    if (!S.next(0, cur)) return;
    f32x4 acc[2][2][4][2];
#pragma unroll
    for (int a = 0; a < 2; ++a)
#pragma unroll
        for (int b = 0; b < 2; ++b)
#pragma unroll
            for (int m = 0; m < 4; ++m)
#pragma unroll
                for (int n = 0; n < 2; ++n) acc[a][b][m][n] = (f32x4){0.f, 0.f, 0.f, 0.f};
    bf16x8 At[4][2], B0[2][2], B1[2][2];
    const char* cA = (const char*)g.A + (size_t)cur.pm * tstep; const char* cB = (const char*)g.Bt + (size_t)cur.pn * tstep;
    S.a_ready(cur);
    if constexpr (SP2) {
        PG8_STAGE(PG8_SB(0, 0), cB, voffB); PG8_STAGE(PG8_SB(0, 1), cB + hstep, voffB); PG8_STAGE(PG8_SA(0, 0), cA, voffA); PG8_STAGE(PG8_SA(0, 1), cA + hstep, voffA);
        if (wr == 1) PG8_BAR;
        PG8_WAIT_V(2); PG8_BAR;
        PG8_STAGE(PG8_SB(1, 0), cB + kstep, voffB); PG8_STAGE(PG8_SA(1, 0), cA + kstep, voffA); PG8_STAGE(PG8_SB(1, 1), cB + hstep + kstep, voffB);
        PG8_WAIT_V(6); PG8_BAR;
    } else {
        PG8_STAGE(PG8_SB(0, 0), cB, voffB); PG8_STAGE(PG8_SA(0, 0), cA, voffA); PG8_STAGE(PG8_SB(0, 1), cB + hstep, voffB); PG8_STAGE(PG8_SA(0, 1), cA + hstep, voffA);
        if (wr == 1) PG8_BAR;
        PG8_WAIT_V(4); PG8_BAR;
        PG8_STAGE(PG8_SB(1, 0), cB + kstep, voffB); PG8_STAGE(PG8_SA(1, 0), cA + kstep, voffA); PG8_STAGE(PG8_SB(1, 1), cB + hstep + kstep, voffB);
        PG8_WAIT_V(6); PG8_BAR;
    }
    for (;;) {
        const bool has_next = S.next(ui + 1, nxt);
        const char* nA = has_next ? (const char*)g.A + (size_t)nxt.pm * tstep : cA; const char* nB = has_next ? (const char*)g.Bt + (size_t)nxt.pn * tstep : cB;
        for (int t = 0; t < nt; t += 2) {
            const bool last = (t == nt - 2);
            const char* a1 = cA + (size_t)(t + 1) * kstep;
            const char* a2 = last ? nA : cA + (size_t)(t + 2) * kstep; const char* b2 = last ? nB : cB + (size_t)(t + 2) * kstep;
            const char* a3 = a2 + kstep; const char* b3 = b2 + kstep;
            if (last && has_next) S.a_ready(nxt);
            if constexpr (SP2) {
            PG8_LDB(B0, 0, 0); PG8_LDB(B1, 0, 1); PG8_SCHED; PG8_LDA(At, 0, 0); PG8_STAGE(PG8_SA(1, 1), a1 + hstep, voffA);
            PG8_WAIT_V(8); PG8_WAIT_L(0); PG8_BAR; PG8_MMA(0, 0, At, B0); PG8_MMA(0, 1, At, B1); PG8_BAR; PG8_SCHED;
            PG8_LDA(At, 0, 1); PG8_STAGE(PG8_SB(0, 0), b2, voffB); PG8_STAGE(PG8_SB(0, 1), b2 + hstep, voffB); PG8_STAGE(PG8_SA(0, 0), a2, voffA);
            PG8_WAIT_V(8); PG8_WAIT_L(0); PG8_BAR; PG8_MMA(1, 0, At, B0); PG8_MMA(1, 1, At, B1); PG8_BAR; PG8_SCHED;
            PG8_LDB(B0, 1, 0); PG8_LDB(B1, 1, 1); PG8_SCHED; PG8_LDA(At, 1, 0); PG8_STAGE(PG8_SA(0, 1), a2 + hstep, voffA);
            PG8_WAIT_V(8); PG8_WAIT_L(0); PG8_BAR; PG8_MMA(0, 0, At, B0); PG8_MMA(0, 1, At, B1); PG8_BAR; PG8_SCHED;
            PG8_LDA(At, 1, 1); PG8_STAGE(PG8_SB(1, 0), b3, voffB); PG8_STAGE(PG8_SB(1, 1), b3 + hstep, voffB); PG8_STAGE(PG8_SA(1, 0), a3, voffA);
            PG8_WAIT_V(8); PG8_WAIT_L(0); PG8_BAR; PG8_MMA(1, 0, At, B0); PG8_MMA(1, 1, At, B1); PG8_BAR; PG8_SCHED;
            } else {
            PG8_LDB(B0, 0, 0); PG8_SCHED; PG8_LDA(At, 0, 0); PG8_STAGE(PG8_SA(1, 1), a1 + hstep, voffA);
            PG8_WAIT_L(8); PG8_BAR; PG8_WAIT_L(0); PG8_MMA(0, 0, At, B0); PG8_BAR; PG8_SCHED;
            PG8_LDB(B1, 0, 1); PG8_STAGE(PG8_SB(0, 0), b2, voffB);
            PG8_BAR; PG8_WAIT_L(0); PG8_MMA(0, 1, At, B1); PG8_BAR;
            PG8_LDA(At, 0, 1); PG8_STAGE(PG8_SA(0, 0), a2, voffA);
            PG8_BAR; PG8_WAIT_L(0); PG8_MMA(1, 0, At, B0); PG8_BAR; PG8_SCHED;
            PG8_STAGE(PG8_SB(0, 1), b2 + hstep, voffB);
            PG8_WAIT_V(6); PG8_BAR; PG8_MMA(1, 1, At, B1); PG8_BAR;
            PG8_LDB(B0, 1, 0); PG8_SCHED; PG8_LDA(At, 1, 0); PG8_STAGE(PG8_SA(0, 1), a2 + hstep, voffA);
            PG8_WAIT_L(8); PG8_BAR; PG8_WAIT_L(0); PG8_MMA(0, 0, At, B0); PG8_BAR; PG8_SCHED;
            PG8_LDB(B1, 1, 1); PG8_STAGE(PG8_SB(1, 0), b3, voffB);
            PG8_BAR; PG8_WAIT_L(0); PG8_MMA(0, 1, At, B1); PG8_BAR;
            PG8_LDA(At, 1, 1); PG8_STAGE(PG8_SA(1, 0), a3, voffA);
            PG8_BAR; PG8_WAIT_L(0); PG8_MMA(1, 0, At, B0); PG8_BAR; PG8_SCHED;
            PG8_STAGE(PG8_SB(1, 1), b3 + hstep, voffB);
            PG8_WAIT_V(6); PG8_BAR; PG8_MMA(1, 1, At, B1); PG8_BAR;
            }
        }
        if constexpr (ALIGN_EPI) { if (wr == 0) PG8_BAR; }
#ifdef PROBE_EPI
        { const unsigned long long t0_ = __builtin_readcyclecounter(); E(acc, cur, wr, wc, fr, fq); asm volatile("s_waitcnt vmcnt(0)" ::: "memory"); tacc_ += __builtin_readcyclecounter() - t0_; S.done(cur); }
#else
        if constexpr (!Epi::AFTER_DRAIN) { E(acc, cur, wr, wc, fr, fq); S.done(cur); }
#endif
        if (!has_next) break;
#pragma unroll
        for (int a = 0; a < 2; ++a)
#pragma unroll
            for (int b = 0; b < 2; ++b)
#pragma unroll
                for (int m = 0; m < 4; ++m)
#pragma unroll
                    for (int n = 0; n < 2; ++n) acc[a][b][m][n] = (f32x4){0.f, 0.f, 0.f, 0.f};
        cur = nxt; cA = nA; cB = nB; ++ui;
        if constexpr (ALIGN_EPI) { if (wr == 1) PG8_BAR; }
    }
    PG8_WAIT_V(0);
    if constexpr (!ALIGN_EPI) { if (wr == 0) PG8_BAR; }
    PG8_BAR;
    if constexpr (Epi::AFTER_DRAIN) { E.fused(acc, cur, wr, wc, fr, fq, lds, wid, lane); S.done(cur); }
#undef PG8_SA
#undef PG8_SB
#undef PG8_STAGE
#undef PG8_LDA
#undef PG8_LDB
#undef PG8_MMA
#undef PG8_WAIT_V
#undef PG8_WAIT_L
#undef PG8_BAR
#undef PG8_SCHED
}
}
#define XB_TMO      128
#define XB_XCNT(j)  (256  + 64 * (j))
#define XB_XSUB(j)  (1280 + 64 * (j))
#define XB_XGEN(j)  (2304 + 64 * (j))
#define XB_TOP      3328
#define XB_TOPGEN   3392
#define XCD_BAR_WORDS 3456
#define XB_SPIN_CAP (1u << 18)

__device__ __forceinline__ unsigned xb_ld(unsigned* p)              { return __hip_atomic_load(p, __ATOMIC_RELAXED, __HIP_MEMORY_SCOPE_AGENT); }
__device__ __forceinline__ unsigned xb_add(unsigned* p, unsigned v) { return __hip_atomic_fetch_add(p, v, __ATOMIC_RELAXED, __HIP_MEMORY_SCOPE_AGENT); }
__device__ __forceinline__ unsigned xb_xcc_id() { return (unsigned)__builtin_amdgcn_s_getreg((3 << 11) | 20) & 0xFu; }
#define XB_SPIN(cond, bar) do { unsigned _sp = 0; while (cond) { __builtin_amdgcn_s_sleep(1); \
    if ((++_sp & 255u) == 0u) { if (xb_ld(&(bar)[XB_TMO])) break; if (_sp > XB_SPIN_CAP) { atomicAdd(&(bar)[XB_TMO], 1u); break; } } } } while (0)

struct XcdBarrier {
    unsigned* bar; unsigned x;
    volatile LAS unsigned* st;
};

__device__ __forceinline__ XcdBarrier xcd_barrier_post(unsigned* bar, volatile LAS unsigned* st) {
    XcdBarrier b; b.bar = bar; b.x = xb_xcc_id(); b.st = st;
    if (threadIdx.x == 0) (void)xb_add(&bar[XB_XCNT(b.x)], 1u);
    return b;
}
__device__ __forceinline__ void xcd_barrier_complete(unsigned* bar, unsigned x, unsigned& nloc, unsigned& nx) {
    const unsigned G = gridDim.x * gridDim.y * gridDim.z;
    unsigned sum, cnt, mine, sp = 0u;
    for (;;) {
        sum = 0u; cnt = 0u; mine = 0u;
#pragma unroll
        for (unsigned j = 0; j < 16; ++j) { const unsigned c = xb_ld(&bar[XB_XCNT(j)]); sum += c; cnt += (c > 0u) ? 1u : 0u; mine = (j == x) ? c : mine; }
        if (sum == G) break;
        __builtin_amdgcn_s_sleep(1);
        if ((++sp & 255u) == 0u) { if (xb_ld(&bar[XB_TMO])) break; if (sp > XB_SPIN_CAP) { atomicAdd(&bar[XB_TMO], 1u); break; } }
    }
    nloc = mine > 0u ? mine : 1u; nx = cnt > 0u ? cnt : 1u;
}

__device__ __forceinline__ void xcd_barrier(const XcdBarrier& b, bool leader  ) {
    asm volatile("s_waitcnt vmcnt(0)" ::: "memory");
    __syncthreads();
    if (leader) {
        unsigned* bar = b.bar;
        __builtin_amdgcn_s_waitcnt(0);
        unsigned nloc = b.st[0], nx = b.st[1];
        if (nloc == 0u) { xcd_barrier_complete(bar, b.x, nloc, nx); b.st[0] = nloc; b.st[1] = nx; }
        const unsigned old = xb_add(&bar[XB_XSUB(b.x)], 1u);
        const unsigned gen = old / nloc;
        if (old + 1u == (gen + 1u) * nloc) {
            __builtin_amdgcn_fence(__ATOMIC_RELEASE, "agent");
            asm volatile("s_waitcnt vmcnt(0)" ::: "memory");
            const unsigned og = xb_add(&bar[XB_TOP], 1u);
            const unsigned tg = og / nx;
            if (og + 1u == (tg + 1u) * nx) xb_add(&bar[XB_TOPGEN], 1u);
            else XB_SPIN(xb_ld(&bar[XB_TOPGEN]) == tg, bar);
            __builtin_amdgcn_fence(__ATOMIC_ACQUIRE, "agent");
            xb_add(&bar[XB_XGEN(b.x)], 1u);
            asm volatile("s_waitcnt vmcnt(0)" ::: "memory");
        } else {
            XB_SPIN(xb_ld(&bar[XB_XGEN(b.x)]) == gen, bar);
            __builtin_amdgcn_fence(__ATOMIC_ACQUIRE, "agent");
            asm volatile("s_waitcnt vmcnt(0)" ::: "memory");
        }
    }
    __syncthreads();
}
using pg8::f32x4; using pg8::bf16x8;
constexpr int NWAVES = 8;
constexpr int BATCH = 4, T = 8192, D = 1024, M = BATCH * T, NP = 4096, INW = 3864;
constexpr int DECB = 32, PAST = 16384, NPAGES = 128, NCS = 512  ;
constexpr float NORM_EPS = 1e-6f;
constexpr float LOG2E = 1.4426950408889634f;
constexpr float QSCALE = 0.125f * LOG2E;
constexpr size_t O_Y = 0, O_YS = 33554432, O_PCMP = 33587200, O_PSLC = 41975808, O_PWIN = 50364416, O_PCONV = 50888704,
                 O_SCMP = 50892800, O_SSLC = 50900992, O_SWIN = 50909184, O_SCONV = 55103488, O_END = 55136256;
constexpr int C_BG = 0, C_CG = 512, C_CI = 1024, C_ZC = 1536, C_Q = 2048, C_KV = 2560, C_GL = 3328, C_ZA = 3352;

constexpr size_t MiB = 1u << 20, KiB = 1u << 10;
constexpr size_t WS_CTL = 0, CTL_ZERO_BYTES = 1 * MiB;
constexpr size_t WS_BT1 = 2 * MiB;
constexpr size_t WS_BT2 = 10 * MiB;
constexpr size_t WS_BTC = 12 * MiB;
constexpr size_t WS_CBIAS = 12 * MiB + 512 * KiB;
constexpr size_t WS_CONST = WS_CBIAS + 4 * KiB;
constexpr size_t WS_ROPE = 13 * MiB;
constexpr size_t WS_RSTD = 16 * MiB;
constexpr size_t WS_XSB = 16 * MiB + 256 * KiB;
constexpr size_t WS_RSTDS = WS_XSB + 64 * KiB;
constexpr size_t WS_GATE = 17 * MiB;
constexpr size_t WS_KC = 20 * MiB;
constexpr size_t WS_VCT = WS_KC + 256 * KiB;
constexpr size_t WS_PROJS = 21 * MiB;
constexpr size_t WS_QS = 22 * MiB;
constexpr size_t WS_KVN = WS_QS + 64 * KiB;
constexpr size_t WS_GS = WS_KVN + 96 * KiB;
constexpr size_t WS_ZAS = WS_GS + 4 * KiB;
constexpr size_t WS_MIXS = WS_ZAS + 64 * KiB;
constexpr size_t WS_KCS = 24 * MiB;
constexpr size_t WS_KS = 40 * MiB, WS_VTS = 48 * MiB, WS_KW = 56 * MiB, WS_VTW = 64 * MiB;
constexpr size_t WS_XB = 72 * MiB;
constexpr size_t WS_CG = 136 * MiB, WS_U = 168 * MiB, WS_ZA = 200 * MiB, WS_Q = 232 * MiB;
constexpr size_t WS_MIX = 264 * MiB;
constexpr size_t WS_TOT = 328 * MiB;
constexpr size_t WS_END = 344 * MiB;
constexpr int CW_TMO = 0, CW_CODE = 1;
constexpr int CW_BAR = 4096;
constexpr int CW_QUEUE = 16384;
constexpr int CW_P0CNT = 18432;
constexpr int CW_KCMAX = 20480;

constexpr int RING_OFF = 0, RING_BYTES = 131072;
constexpr int LDSCTL_OFF = RING_BYTES, MISC_OFF = LDSCTL_OFF + 320;
constexpr int LDS_BYTES = 147456;

__device__ __forceinline__ unsigned f2bf(float f) { unsigned u = __builtin_bit_cast(unsigned, f); return (u + 0x7fffu + ((u >> 16) & 1u)) >> 16; }
typedef __bf16 bf16x2_t __attribute__((ext_vector_type(2)));
__device__ __forceinline__ unsigned pk2(float lo, float hi) { return __builtin_bit_cast(unsigned, __builtin_convertvector((f32x2){lo, hi}, bf16x2_t)); }
__device__ __forceinline__ float bf2f(unsigned h) { return __builtin_bit_cast(float, h << 16); }
__device__ __forceinline__ float wave_sum(float v) {
#pragma unroll
    for (int o = 1; o < 64; o <<= 1) v += __shfl_xor(v, o);
    return v;
}
__device__ __forceinline__ float quad_sum(float v) {
    v += __builtin_bit_cast(float, __builtin_amdgcn_update_dpp(0, __builtin_bit_cast(int, v), 0xB1, 0xF, 0xF, true));
    v += __builtin_bit_cast(float, __builtin_amdgcn_update_dpp(0, __builtin_bit_cast(int, v), 0x4E, 0xF, 0xF, true));
    return v;
}
__device__ __forceinline__ float fast_exp2(float x) { return __builtin_amdgcn_exp2f(x); }
__device__ __forceinline__ float sigmoidf(float x) { return __builtin_amdgcn_rcpf(1.0f + fast_exp2(-x * LOG2E)); }
__device__ __forceinline__ int perm16(int kk) { return 8 * ((kk >> 2) & 1) + 4 * (kk >> 3) + (kk & 3); }

struct Ptrs {
    const float *xp, *xs, *cache_cmp, *cache_slc, *st_win, *st_conv; const int* page_table;
    const float *norm_g, *w_in, *conv_w, *conv_b, *q_gain, *k_gain, *cmp_pe, *cmp_w, *w_out;
    float* out; unsigned char* ws;
};
struct Frame {
    LAS unsigned char* lds;
    volatile LAS unsigned* MISC;
    gu32* ctl;
    int tid, lane, wave, G, gw, NGW;
};
__device__ __forceinline__ int bt1_src(int dg, int& nvalid) {
    const int pn = dg >> 3, gi = dg & 7, bj = gi >> 2, wc = gi & 3; nvalid = 32;
    if (pn < 4) return (bj ? C_ZC : C_BG) + 128 * pn + 32 * wc;
    if (pn < 8) return (bj ? C_CI : C_CG) + 128 * (pn - 4) + 32 * wc;
    if (pn < 10) return C_Q + (4 * (pn - 8) + wc) * 64 + 32 * bj;
    if (pn < 13) return C_KV + (pn - 10) * 256 + wc * 64 + 32 * bj;
    if (pn < 15) return C_ZA + 256 * (pn - 13) + 32 * gi;
    nvalid = (gi == 0) ? 24 : 0; return C_GL;
}
__device__ __forceinline__ void p0_transpose_item(const float* W, int ldw, int k0, int src0, int nvalid, const float* ksc, bf16* WT, int ldt, int drow0, LAS float* scr, int lane) {
    const int nn = lane & 31;
#pragma unroll 8
    for (int i = 0; i < 32; ++i) { const int kk = 2 * i + (lane >> 5); float v = 0.f;
        if (nn < nvalid) { v = W[(size_t)(k0 + kk) * ldw + src0 + nn]; if (ksc) v *= ksc[k0 + kk]; }
        scr[kk * 33 + nn] = v; }
    LDS_WAIT(); asm volatile("" ::: "memory");
    const int c = lane & 7;
#pragma unroll
    for (int j = 0; j < 4; ++j) { const int n = (lane >> 3) + 8 * j; const LAS float* s = scr + (8 * c) * 33 + n;
        v4u o; o.x = pk2(s[0 * 33], s[1 * 33]); o.y = pk2(s[2 * 33], s[3 * 33]); o.z = pk2(s[4 * 33], s[5 * 33]); o.w = pk2(s[6 * 33], s[7 * 33]);
        *(GAS v4u*)(WT + (size_t)(drow0 + n) * ldt + k0 + 8 * c) = o; }
    LDS_WAIT(); asm volatile("" ::: "memory");
}
template <int NR>
__device__ __forceinline__ void x_rows_to_bf16(const float* xrow, bf16* orow, float* rstd_out, int lane) {
    f32x4 v[NR][4]; float s[NR];
#pragma unroll
    for (int r = 0; r < NR; ++r)
#pragma unroll
        for (int j = 0; j < 4; ++j) v[r][j] = ((const GAS f32x4*)(xrow + (size_t)r * D) + lane)[64 * j];
#pragma unroll
    for (int r = 0; r < NR; ++r) { s[r] = 0.f;
#pragma unroll
        for (int j = 0; j < 4; ++j) s[r] += (v[r][j].x * v[r][j].x + v[r][j].y * v[r][j].y) + (v[r][j].z * v[r][j].z + v[r][j].w * v[r][j].w); }
#pragma unroll
    for (int o = 1; o < 64; o <<= 1)
#pragma unroll
        for (int r = 0; r < NR; ++r) s[r] += __shfl_xor(s[r], o);
#pragma unroll
    for (int r = 0; r < NR; ++r) { GAS unsigned long long* o8 = (GAS unsigned long long*)(orow + (size_t)r * D) + lane;
#pragma unroll
        for (int j = 0; j < 4; ++j) o8[64 * j] = (unsigned long long)pk2(v[r][j].x, v[r][j].y) | ((unsigned long long)pk2(v[r][j].z, v[r][j].w) << 32);
        if (lane == 0) rstd_out[r] = 1.0f / sqrtf(s[r] * (1.0f / D) + NORM_EPS); }
}
template <bool SAMPLE>
__device__ __forceinline__ const float* cmp_rowbase(const Ptrs& P, int unit, int rho) {
    const int b = SAMPLE ? unit >> 6 : unit >> 5, c = (SAMPLE ? (unit & 63) : (unit & 31)) * 8 + (rho >> 1), g = rho & 1;
    if (SAMPLE) { const int page = P.page_table[b * NPAGES + (c >> 2)]; return P.cache_cmp + ((size_t)page * 128 + (c & 3) * 32) * 256 + g * 64; }
    return P.out + O_PCMP + ((size_t)b * T + c * 32) * 256 + g * 64;
}
template <bool SAMPLE>
__device__ __forceinline__ void compress_units(const Ptrs& P, Frame& F, LAS float* part  ) {
    constexpr int NUNITS = SAMPLE ? DECB * (NCS / 8) : BATCH * 32;
    const int lane = F.lane, w = F.wave, rho = lane & 15, kq = lane >> 4;
    const GAS v4u* bfr = (const GAS v4u*)(P.ws + WS_BTC) + lane;
    const float* cbias = (const float*)(P.ws + WS_CBIAS);
    int unit = blockIdx.x;
    if (unit >= NUNITS) return;
    f32x4 a_cur[8], a_n1[8], a_n2[8];
    const float* rb = cmp_rowbase<SAMPLE>(P, unit, rho) + 4 * kq;
#define CMP_LOAD(dst, base, r) do { _Pragma("unroll") for (int q_ = 0; q_ < 4; ++q_) { dst[2 * q_] = *(const GAS f32x4*)((base) + (r) * 256 + (q_ >> 1) * 128 + (q_ & 1) * 32); dst[2 * q_ + 1] = *(const GAS f32x4*)((base) + (r) * 256 + (q_ >> 1) * 128 + (q_ & 1) * 32 + 16); } } while (0)
    CMP_LOAD(a_cur, rb, 4 * w); CMP_LOAD(a_n1, rb, 4 * w + 1);
    for (;;) {
        f32x4 acc[2][4];
#pragma unroll
        for (int j = 0; j < 2; ++j)
#pragma unroll
            for (int e = 0; e < 4; ++e) acc[j][e] = (f32x4){0.f, 0.f, 0.f, 0.f};
        const int nunit = unit + F.G; const bool has_next = nunit < NUNITS;
        const float* rbn = has_next ? cmp_rowbase<SAMPLE>(P, nunit, rho) + 4 * kq : rb;
#pragma unroll 1
        for (int rr = 0; rr < 4; ++rr) {
            const int r = 4 * w + rr;
            bf16x8 bb[16];
#pragma unroll
            for (int q_ = 0; q_ < 4; ++q_)
#pragma unroll
                for (int et = 0; et < 4; ++et) bb[q_ * 4 + et] = __builtin_bit_cast(bf16x8, bfr[(size_t)(((((q_ >> 1) * 32 + r) * 2 + (q_ & 1)) * 4 + et) * 64)]);
            __builtin_amdgcn_sched_barrier(0);
            { const float* nb_ = rr < 2 ? rb : rbn; const int nr_ = rr < 2 ? r + 2 : 4 * w + (rr - 2); CMP_LOAD(a_n2, nb_, nr_); }
            __builtin_amdgcn_sched_barrier(0);
#pragma unroll
            for (int q_ = 0; q_ < 4; ++q_) { const int j = q_ >> 1;
                v4u wv; wv.x = pk2(a_cur[2 * q_].x, a_cur[2 * q_].y); wv.y = pk2(a_cur[2 * q_].z, a_cur[2 * q_].w); wv.z = pk2(a_cur[2 * q_ + 1].x, a_cur[2 * q_ + 1].y); wv.w = pk2(a_cur[2 * q_ + 1].z, a_cur[2 * q_ + 1].w);
                const bf16x8 af = __builtin_bit_cast(bf16x8, wv);
#pragma unroll
                for (int et = 0; et < 4; ++et) acc[j][et] = __builtin_amdgcn_mfma_f32_16x16x32_bf16(af, bb[q_ * 4 + et], acc[j][et], 0, 0, 0); }
#pragma unroll
            for (int q_ = 0; q_ < 8; ++q_) { a_cur[q_] = a_n1[q_]; a_n1[q_] = a_n2[q_]; }
        }
#pragma unroll
        for (int j = 0; j < 2; ++j)
#pragma unroll
            for (int et = 0; et < 4; ++et) *(LAS f32x4*)(part + ((w * 8 + j * 4 + et) * 64 + lane) * 4) = acc[j][et];
        __syncthreads();
        { const int j = w >> 2, et = w & 3, e = 16 * et + rho; f32x4 sum = *(const LAS f32x4*)(part + ((0 * 8 + w) * 64 + lane) * 4);
#pragma unroll
          for (int ww = 1; ww < 8; ++ww) sum = sum + *(const LAS f32x4*)(part + ((ww * 8 + w) * 64 + lane) * 4);
          const float bs = cbias[j * 64 + e]; const int b = SAMPLE ? unit >> 6 : unit >> 5, c0 = (SAMPLE ? (unit & 63) : (unit & 31)) * 8;
          float nmax = 0.f;
#pragma unroll
          for (int i = 0; i < 4; ++i) { const int row = 4 * kq + i, c = c0 + (row >> 1), g = row & 1; const float val = sum[i] + bs;
              float q2 = val * val; q2 += __shfl_xor(q2, 1); q2 += __shfl_xor(q2, 2); q2 += __shfl_xor(q2, 4); q2 += __shfl_xor(q2, 8); nmax = fmaxf(nmax, q2);
              if (SAMPLE) ((float*)(P.ws + WS_KCS))[((size_t)((b * 2 + g) * 2 + j) * NCS + c) * 64 + e] = val;
              else if (j == 0) ((bf16*)(P.ws + WS_KC))[((size_t)(b * 2 + g) * 256 + c) * 64 + e] = (bf16)f2bf(val);
              else ((bf16*)(P.ws + WS_VCT))[((size_t)(b * 2 + g) * 64 + e) * 256 + (c & ~15) + perm16(c & 15)] = (bf16)f2bf(val); }
          if (j == 0) { nmax = fmaxf(nmax, __shfl_xor(nmax, 16)); nmax = fmaxf(nmax, __shfl_xor(nmax, 32));
              if (lane == 0) atomicMax((unsigned*)(P.ws + WS_CTL) + CW_KCMAX + (SAMPLE ? 64 : 0) + et, __builtin_bit_cast(unsigned, nmax)); } }
        __syncthreads();
        if (!has_next) break;
        unit = nunit; rb = rbn;
    }
#undef CMP_LOAD
}
__device__ __forceinline__ void compress_sample_pass(const Ptrs& P, Frame& F, LAS unsigned char* bl  ) {
    const int lane = F.lane, w = F.wave, tid = F.tid, rho = lane & 15, kq = lane >> 4;
    for (int pass = blockIdx.x; pass < DECB * 8; pass += F.G) {
    __syncthreads();
    const int b = pass >> 3, c0 = (pass & 7) * 64 + w * 8;
    const float* rb; { const int c = c0 + (rho >> 1), g = rho & 1; const int page = P.page_table[b * NPAGES + (c >> 2)]; rb = P.cache_cmp + ((size_t)page * 128 + (c & 3) * 32) * 256 + g * 64 + 4 * kq; }
    const GAS v4u* bsrc = (const GAS v4u*)(P.ws + WS_BTC);
    const int sf = tid >> 5, sj = sf >> 3, sdh = (sf >> 2) & 1, set_ = sf & 3, sl = (tid & 31) * 2;
#define B_SRC(r) (bsrc + (size_t)((((sj * 32 + (r)) * 2 + sdh) * 4 + set_) * 64 + sl))
    LAS v4u* bdst = (LAS v4u*)bl + sf * 64 + sl;
    f32x4 a_cur[8], a_n1[8], a_n2[8];
#define CMP_LOAD(dst, base, r) do { _Pragma("unroll") for (int q_ = 0; q_ < 4; ++q_) { dst[2 * q_] = *(const GAS f32x4*)((base) + (r) * 256 + (q_ >> 1) * 128 + (q_ & 1) * 32); dst[2 * q_ + 1] = *(const GAS f32x4*)((base) + (r) * 256 + (q_ >> 1) * 128 + (q_ & 1) * 32 + 16); } } while (0)
    { const v4u b0 = B_SRC(0)[0], b1 = B_SRC(0)[1]; bdst[0] = b0; bdst[1] = b1; }
    CMP_LOAD(a_cur, rb, 0); CMP_LOAD(a_n1, rb, 1);
    f32x4 acc[2][4];
#pragma unroll
    for (int j = 0; j < 2; ++j)
#pragma unroll
        for (int e = 0; e < 4; ++e) acc[j][e] = (f32x4){0.f, 0.f, 0.f, 0.f};
    __syncthreads();
#pragma unroll 1
    for (int r = 0; r < 32; ++r) {
        const int rn = r + 1 < 32 ? r + 1 : 31, r2 = r + 2 < 32 ? r + 2 : 31;
        const v4u b0 = B_SRC(rn)[0], b1 = B_SRC(rn)[1];
        __builtin_amdgcn_sched_barrier(0);
        CMP_LOAD(a_n2, rb, r2);
        __builtin_amdgcn_sched_barrier(0);
        const LAS v4u* bf = (const LAS v4u*)bl + (r & 1) * 1024 + lane;
#pragma unroll
        for (int q_ = 0; q_ < 4; ++q_) { const int j = q_ >> 1;
            v4u wv; wv.x = pk2(a_cur[2 * q_].x, a_cur[2 * q_].y); wv.y = pk2(a_cur[2 * q_].z, a_cur[2 * q_].w); wv.z = pk2(a_cur[2 * q_ + 1].x, a_cur[2 * q_ + 1].y); wv.w = pk2(a_cur[2 * q_ + 1].z, a_cur[2 * q_ + 1].w);
            const bf16x8 af = __builtin_bit_cast(bf16x8, wv);
#pragma unroll
            for (int et = 0; et < 4; ++et) acc[j][et] = __builtin_amdgcn_mfma_f32_16x16x32_bf16(af, __builtin_bit_cast(bf16x8, bf[(q_ * 4 + et) * 64]), acc[j][et], 0, 0, 0); }
        { LAS v4u* d_ = bdst + ((r + 1) & 1) * 1024; d_[0] = b0; d_[1] = b1; }
#pragma unroll
        for (int q_ = 0; q_ < 8; ++q_) { a_cur[q_] = a_n1[q_]; a_n1[q_] = a_n2[q_]; }
        __syncthreads();
    }
#undef CMP_LOAD
#undef B_SRC
    const float* cbias = (const float*)(P.ws + WS_CBIAS);
    float nmax = 0.f;
#pragma unroll
    for (int i = 0; i < 4; ++i) { const int row = 4 * kq + i, c = c0 + (row >> 1), g = row & 1; float q2 = 0.f;
#pragma unroll
        for (int j = 0; j < 2; ++j)
#pragma unroll
            for (int et = 0; et < 4; ++et) { const int e = 16 * et + rho; const float val = acc[j][et][i] + cbias[j * 64 + e]; if (j == 0) q2 += val * val;
                ((float*)(P.ws + WS_KCS))[((size_t)((b * 2 + g) * 2 + j) * NCS + c) * 64 + e] = val; }
        q2 += __shfl_xor(q2, 1); q2 += __shfl_xor(q2, 2); q2 += __shfl_xor(q2, 4); q2 += __shfl_xor(q2, 8); nmax = fmaxf(nmax, q2); }
    nmax = fmaxf(nmax, __shfl_xor(nmax, 16)); nmax = fmaxf(nmax, __shfl_xor(nmax, 32));
    if (lane == 0) atomicMax((unsigned*)(P.ws + WS_CTL) + CW_KCMAX + 64, __builtin_bit_cast(unsigned, nmax));
    }
}
constexpr int P0_PRODUCERS = 641;
__device__ __forceinline__ void p0_small_items(const Ptrs& P, Frame& F) {
    const int lane = F.lane, gw = F.gw;
    if (gw >= P0_PRODUCERS && F.NGW >= P0_PRODUCERS) return;
    for (int item = gw; item < P0_PRODUCERS; item += F.NGW) {
        if (item < 512) { const int it = item * 64 + lane; const int l = it & 63, et = (it >> 6) & 3, dh = (it >> 8) & 1, r = (it >> 9) & 31, j = it >> 14;
            const float* w = P.cmp_w + ((size_t)(r * 2 + j) * 64 + 32 * dh + 4 * (l >> 4)) * 64 + 16 * et + (l & 15);
            v4u o; o.x = pk2(w[0], w[64]); o.y = pk2(w[128], w[192]); o.z = pk2(w[16 * 64], w[17 * 64]); o.w = pk2(w[18 * 64], w[19 * 64]);
            __builtin_amdgcn_raw_buffer_store_b128(o, __builtin_amdgcn_make_buffer_rsrc((void*)(P.ws + WS_BTC), 0, 512 * 1024, 0x00020000), it * 16, 0, 16);
        } else if (item < 640) { const int it = item - 512, j = it >> 6, e = it & 63; float s = 0.f;
            for (int k = lane; k < 2048; k += 64) { const int r = k >> 6, d = k & 63; s += P.cmp_pe[(r * 2 + j) * 64 + d] * P.cmp_w[((size_t)(r * 2 + j) * 64 + d) * 64 + e]; }
            s = wave_sum(s); if (lane == 0) __hip_atomic_store((float*)(P.ws + WS_CBIAS) + it, s, RLX_AGENT);
        } else { float qm = fabsf(P.q_gain[lane]), k1 = fabsf(P.k_gain[64 + lane]), k2 = fabsf(P.k_gain[128 + lane]);
#pragma unroll
            for (int o = 1; o < 64; o <<= 1) { qm = fmaxf(qm, __shfl_xor(qm, o)); k1 = fmaxf(k1, __shfl_xor(k1, o)); k2 = fmaxf(k2, __shfl_xor(k2, o)); }
            if (lane == 0) { float* cst = (float*)(P.ws + WS_CONST); __hip_atomic_store(cst + 0, qm, RLX_AGENT); __hip_atomic_store(cst + 1, 8.0f * qm * k1 * LOG2E * 1.001f, RLX_AGENT); __hip_atomic_store(cst + 2, 8.0f * qm * k2 * LOG2E * 1.001f, RLX_AGENT); } }
        asm volatile("s_waitcnt vmcnt(0)" ::: "memory");
        if (lane == 0) __hip_atomic_fetch_add((unsigned*)(F.ctl + CW_P0CNT), 1u, RLX_AGENT);
    }
}
__device__ __forceinline__ void p0_rope(const Ptrs& P, Frame& F) {
    const int lane = F.lane, gw = F.gw, NGW = F.NGW; const int i = lane & 31;
    const float inv = (float)pow(10000.0, -(double)i / 32.0);
    for (int it = gw * 64 + lane; it < 8193 * 32; it += NGW * 64) { const int p = it >> 5; const int pos = (p == 8192) ? PAST : p;
        const float ang = (float)pos * inv; const double rev = (double)ang * 0.15915494309189535; const float fr = (float)(rev - __builtin_rint(rev));
        float* rt = (float*)(P.ws + WS_ROPE) + (size_t)p * 64; rt[i] = __builtin_amdgcn_cosf(fr); rt[32 + i] = __builtin_amdgcn_sinf(fr); }
}
__device__ __forceinline__ void p0_phase(const Ptrs& P, Frame& F) {
    LAS float* scr = (LAS float*)(F.lds + RING_OFF + F.wave * 16384);
    const int lane = F.lane;
    p0_small_items(P, F);
    p0_rope(P, F);
    const int gw = F.gw, NGW = F.NGW;
    for (int it = gw; it < 16 * 128; it += NGW) { const int kb = it >> 7, dg = it & 127; int nv; const int src0 = bt1_src(dg, nv);
        p0_transpose_item(P.w_in, INW, 64 * kb, src0, nv, P.norm_g, (bf16*)(P.ws + WS_BT1), D, 32 * dg, scr, lane); }
    for (int it = gw; it < 16 * 32; it += NGW) { const int kb = it >> 5, nb = it & 31;
        p0_transpose_item(P.w_out, D, 64 * kb, 32 * nb, 32, nullptr, (bf16*)(P.ws + WS_BT2), D, 32 * nb, scr, lane); }
    for (int m = gw * 4; m < M; m += NGW * 4) x_rows_to_bf16<4>(P.xp + (size_t)m * D, (bf16*)(P.ws + WS_XB) + (size_t)m * D, (float*)(P.ws + WS_RSTD) + m, lane);
    for (int m = gw; m < DECB; m += NGW) x_rows_to_bf16<1>(P.xs + (size_t)m * D, (bf16*)(P.ws + WS_XSB) + (size_t)m * D, (float*)(P.ws + WS_RSTDS) + m, lane);
    { constexpr int PERB = 511 * 64, TOTAL = DECB * PERB; const GAS f32x4* src = (const GAS f32x4*)P.st_win; GAS f32x4* dst = (GAS f32x4*)(P.out + O_SWIN);
      for (int i0 = gw * 64 + lane; i0 < TOTAL; i0 += NGW * 64 * 8) { f32x4 t[8];
#pragma unroll
        for (int u = 0; u < 8; ++u) { const int i = i0 + u * NGW * 64; if (i < TOTAL) { const int b = i / PERB; t[u] = src[i + 64 * b + 64]; } }
#pragma unroll
        for (int u = 0; u < 8; ++u) { const int i = i0 + u * NGW * 64; if (i < TOTAL) { const int b = i / PERB; dst[i + 64 * b] = t[u]; } } } }
    for (int it = gw * 64 + lane; it < DECB * 512; it += NGW * 64) { const int b = it >> 9, ch = it & 511; P.out[O_SCONV + (size_t)b * 1024 + ch] = P.st_conv[(size_t)b * 1024 + 512 + ch]; }
    if (F.wave == 0) { if (lane == 0) { unsigned sp = 0u; while (__hip_atomic_load((unsigned*)(F.ctl + CW_P0CNT), RLX_AGENT) < (unsigned)P0_PRODUCERS) { __builtin_amdgcn_s_sleep(2); if (++sp > (1u << 22)) break; } }
        __builtin_amdgcn_fence(__ATOMIC_ACQUIRE, "agent"); asm volatile("s_waitcnt vmcnt(0)" ::: "memory"); }
    __syncthreads();
    compress_sample_pass(P, F, F.lds + RING_OFF);
}
struct EpiIn {
    static constexpr bool PERM = false, AFTER_DRAIN = false;
    const float *rstd, *rope, *qg, *kg; float* out; unsigned char* ws;
    __device__ __forceinline__ void operator()(const f32x4 (&acc)[2][2][4][2], const pg8::Unit& u, int wr, int wc, int fr, int fq) const {
        asm volatile("" : "+v"(fr), "+v"(fq));
        const int pn = u.pn; const int rbase = u.pm * 256 + wr * 64 + fr;
        if (pn < 8) {
            const bool bz = pn < 4; bf16* dst = (bf16*)(ws + (bz ? WS_CG : WS_U)); const int col0 = 128 * (pn & 3) + 32 * wc + 4 * fq;
#pragma unroll
            for (int ai = 0; ai < 2; ++ai)
#pragma unroll
                for (int m = 0; m < 4; ++m) { const int row = rbase + ai * 128 + m * 16; const float rs = rstd[row];
#pragma unroll
                    for (int n = 0; n < 2; ++n) { const f32x4 a = acc[ai][0][m][n] * rs, z = acc[ai][1][m][n] * rs; f32x4 o;
                        if (bz) { o.x = a.x * z.x * sigmoidf(z.x); o.y = a.y * z.y * sigmoidf(z.y); o.z = a.z * z.z * sigmoidf(z.z); o.w = a.w * z.w * sigmoidf(z.w); }
                        else o = a * z;
                        v2u w; w.x = pk2(o.x, o.y); w.y = pk2(o.z, o.w);
                        *(GAS v2u*)(dst + (size_t)row * 512 + col0 + 16 * n) = w;
                        if (!bz) { const int t = row & (T - 1); if (t >= T - 2) *(GAS f32x4*)(out + O_PCONV + ((size_t)(row >> 13) * 2 + (t - (T - 2))) * 512 + col0 + 16 * n) = o; } } }
        } else if (pn < 13) {
            const bool isq = pn < 10; const int br = pn - 10; const bool isk = !isq && wc < 2;
            if (isq || isk) {
                const float* gain = isq ? qg : kg + br * 64; float g1[2][4], g2[2][4];
#pragma unroll
                for (int n = 0; n < 2; ++n)
#pragma unroll
                    for (int e = 0; e < 4; ++e) { g1[n][e] = gain[16 * n + 4 * fq + e]; g2[n][e] = gain[32 + 16 * n + 4 * fq + e]; }
#pragma unroll
                for (int ai = 0; ai < 2; ++ai)
#pragma unroll
                    for (int m = 0; m < 4; ++m) { const int row = rbase + ai * 128 + m * 16; const float rs = rstd[row]; const int t = row & (T - 1), b = row >> 13;
                        f32x4 x1[2], x2[2]; float ss = 0.f;
#pragma unroll
                        for (int n = 0; n < 2; ++n) { x1[n] = acc[ai][0][m][n] * rs; x2[n] = acc[ai][1][m][n] * rs;
                            ss += (x1[n].x * x1[n].x + x1[n].y * x1[n].y) + (x1[n].z * x1[n].z + x1[n].w * x1[n].w) + (x2[n].x * x2[n].x + x2[n].y * x2[n].y) + (x2[n].z * x2[n].z + x2[n].w * x2[n].w); }
                        ss += __shfl_xor(ss, 16); ss += __shfl_xor(ss, 32);
                        const float inv = 1.0f / sqrtf(ss * (1.0f / 64.0f) + NORM_EPS);
                        const float* rp = rope + (size_t)t * 64 + 4 * fq;
#pragma unroll
                        for (int n = 0; n < 2; ++n) { const f32x4 cs = *(const GAS f32x4*)(rp + 16 * n), sn = *(const GAS f32x4*)(rp + 32 + 16 * n); f32x4 o1, o2;
#pragma unroll
                            for (int e = 0; e < 4; ++e) { const float a = x1[n][e] * inv * g1[n][e], c = x2[n][e] * inv * g2[n][e]; o1[e] = a * cs[e] - c * sn[e]; o2[e] = c * cs[e] + a * sn[e]; }
                            const int d1 = 16 * n + 4 * fq;
                            if (isq) { o1 = o1 * QSCALE; o2 = o2 * QSCALE; bf16* q = (bf16*)(ws + WS_Q) + (size_t)row * 512 + (4 * (pn - 8) + wc) * 64 + d1;
                                v2u w; w.x = pk2(o1.x, o1.y); w.y = pk2(o1.z, o1.w); *(GAS v2u*)q = w; w.x = pk2(o2.x, o2.y); w.y = pk2(o2.z, o2.w); *(GAS v2u*)(q + 32) = w; }
                            else { const int g = wc;
                                if (br > 0) { bf16* k = (bf16*)(ws + (br == 1 ? WS_KS : WS_KW)) + ((size_t)(b * 2 + g) * T + t) * 64 + d1;
                                    v2u w; w.x = pk2(o1.x, o1.y); w.y = pk2(o1.z, o1.w); *(GAS v2u*)k = w; w.x = pk2(o2.x, o2.y); w.y = pk2(o2.z, o2.w); *(GAS v2u*)(k + 32) = w; }
                                if (br < 2) { float* o = out + (br == 0 ? O_PCMP : O_PSLC) + (size_t)row * 256 + g * 64 + d1; *(GAS f32x4*)o = o1; *(GAS f32x4*)(o + 32) = o2; }
                                else if (t >= T - 512) { float* o = out + O_PWIN + ((size_t)b * 512 + (t - (T - 512))) * 256 + g * 64 + d1; *(GAS f32x4*)o = o1; *(GAS f32x4*)(o + 32) = o2; } } } }
            } else {
                const int g = wc - 2;
#pragma unroll
                for (int ai = 0; ai < 2; ++ai)
#pragma unroll
                    for (int m = 0; m < 4; ++m) { const int row = rbase + ai * 128 + m * 16; const float rs = rstd[row]; const int t = row & (T - 1), b = row >> 13;
                        const int tk = t & 63, vpos = (tk & ~15) + perm16(tk & 15);
                        bf16* vt = (br > 0) ? (bf16*)(ws + (br == 1 ? WS_VTS : WS_VTW)) + ((size_t)((b * 2 + g) * 128 + (t >> 6)) * 64) * 64 + vpos : nullptr;
#pragma unroll
                        for (int bj = 0; bj < 2; ++bj)
#pragma unroll
                            for (int n = 0; n < 2; ++n) { const f32x4 v = acc[ai][bj][m][n] * rs; const int d1 = 32 * bj + 16 * n + 4 * fq;
                                if (br > 0) {
#pragma unroll
                                    for (int e = 0; e < 4; ++e) vt[(size_t)(d1 + e) * 64] = (bf16)f2bf(v[e]); }
                                if (br < 2) *(GAS f32x4*)(out + (br == 0 ? O_PCMP : O_PSLC) + (size_t)row * 256 + 128 + g * 64 + d1) = v;
                                else if (t >= T - 512) *(GAS f32x4*)(out + O_PWIN + ((size_t)b * 512 + (t - (T - 512))) * 256 + 128 + g * 64 + d1) = v; } }
            }
        } else if (pn < 15) {
            bf16* dst = (bf16*)(ws + WS_ZA);
#pragma unroll
            for (int ai = 0; ai < 2; ++ai)
#pragma unroll
                for (int m = 0; m < 4; ++m) { const int row = rbase + ai * 128 + m * 16; const float rs = rstd[row];
#pragma unroll
                    for (int bj = 0; bj < 2; ++bj)
#pragma unroll
                        for (int n = 0; n < 2; ++n) { const f32x4 z = acc[ai][bj][m][n] * rs; v2u w; w.x = pk2(z.x * sigmoidf(z.x), z.y * sigmoidf(z.y)); w.y = pk2(z.z * sigmoidf(z.z), z.w * sigmoidf(z.w));
                            *(GAS v2u*)(dst + (size_t)row * 512 + 256 * (pn - 13) + 128 * bj + 32 * wc + 16 * n + 4 * fq) = w; } }
        } else {
            if (wc == 0) { float* dst = (float*)(ws + WS_GATE);
#pragma unroll
                for (int ai = 0; ai < 2; ++ai)
#pragma unroll
                    for (int m = 0; m < 4; ++m) { const int row = rbase + ai * 128 + m * 16; const float rs = rstd[row];
#pragma unroll
                        for (int n = 0; n < 2; ++n) { const int c0 = 16 * n + 4 * fq; if (c0 < 24) { const f32x4 z = acc[ai][0][m][n] * rs;
                            *(GAS f32x4*)(dst + (size_t)row * 24 + c0) = (f32x4){sigmoidf(z.x), sigmoidf(z.y), sigmoidf(z.z), sigmoidf(z.w)}; } } } }
        }
    }
};
struct EpiOut {
    static constexpr bool PERM = false, AFTER_DRAIN = false;
    const float* x; float* y;
    __device__ __forceinline__ void operator()(const f32x4 (&acc)[2][2][4][2], const pg8::Unit& u, int wr, int wc, int fr, int fq) const {
        asm volatile("" : "+v"(fr), "+v"(fq));
#pragma unroll
        for (int ai = 0; ai < 2; ++ai)
#pragma unroll
            for (int m = 0; m < 4; ++m) { const size_t row = (size_t)u.pm * 256 + ai * 128 + wr * 64 + m * 16 + fr;
#pragma unroll
                for (int bj = 0; bj < 2; ++bj)
#pragma unroll
                    for (int n = 0; n < 2; ++n) { const size_t off = row * D + u.pn * 256 + 128 * bj + 32 * wc + 16 * n + 4 * fq;
                        *(GAS f32x4*)(y + off) = *(const GAS f32x4*)(x + off) + acc[ai][bj][m][n]; } }
    }
};
template <int MODE>
__device__ __forceinline__ void small_gemm_tile(const Ptrs& P, const bf16* A, const bf16* Bt, int ct, int lane) {
    const int rho = lane & 15, kq = lane >> 4;
    f32x4 acc[2] = {(f32x4){0.f, 0.f, 0.f, 0.f}, (f32x4){0.f, 0.f, 0.f, 0.f}};
    const GAS v4u* a0 = (const GAS v4u*)(A + (size_t)rho * D + 8 * kq); const GAS v4u* a1 = (const GAS v4u*)(A + (size_t)(16 + rho) * D + 8 * kq);
    const GAS v4u* bp = (const GAS v4u*)(Bt + (size_t)(16 * ct + rho) * D + 8 * kq);
#pragma unroll 8
    for (int ks = 0; ks < 32; ++ks) { const bf16x8 bb = __builtin_bit_cast(bf16x8, bp[ks * 4]);
        acc[0] = __builtin_amdgcn_mfma_f32_16x16x32_bf16(bb, __builtin_bit_cast(bf16x8, a0[ks * 4]), acc[0], 0, 0, 0);
        acc[1] = __builtin_amdgcn_mfma_f32_16x16x32_bf16(bb, __builtin_bit_cast(bf16x8, a1[ks * 4]), acc[1], 0, 0, 0); }
#pragma unroll
    for (int rt = 0; rt < 2; ++rt) { const int b = 16 * rt + rho; const int col = 16 * ct + 4 * kq;
        if (MODE == 0) { const float rs = ((const float*)(P.ws + WS_RSTDS))[b]; *(GAS f32x4*)((float*)(P.ws + WS_PROJS) + (size_t)b * NP + col) = acc[rt] * rs; }
        else *(GAS f32x4*)(P.out + O_YS + (size_t)b * D + col) = *(const GAS f32x4*)(P.xs + (size_t)b * D + col) + acc[rt]; }
}
__device__ __forceinline__ int projs_col(int pn, int wc, int d) { return 256 * pn + 128 * (d >> 5) + 32 * wc + (d & 31); }
__device__ __forceinline__ void p2_sample_item(const Ptrs& P, int it, int lane) {
    const int b = it / 37, ty = it - b * 37;
    const float* pr = (const float*)(P.ws + WS_PROJS) + (size_t)b * NP;
    const float* ropes = (const float*)(P.ws + WS_ROPE) + (size_t)8192 * 64;
    float* kvn = (float*)(P.ws + WS_KVN) + (size_t)b * 768;
    if (ty < 14) {
        const bool isq = ty < 8; const int br = isq ? 0 : (ty - 8) >> 1, g = (ty - 8) & 1;
        const int pn = isq ? 8 + (ty >> 2) : 10 + br, wc = isq ? (ty & 3) : g;
        const float v = pr[projs_col(pn, wc, lane)];
        const float ss = wave_sum(v * v); const float inv = 1.0f / sqrtf(ss * (1.0f / 64.0f) + NORM_EPS);
        const float gn = isq ? P.q_gain[lane] : P.k_gain[br * 64 + lane];
        const float xn = v * inv * gn; const float xo = __shfl_xor(xn, 32);
        const int i = lane & 31; const float cs = ropes[i], sn = ropes[32 + i];
        const float o = (lane < 32) ? xn * cs - xo * sn : xn * cs + xo * sn;
        if (isq) ((float*)(P.ws + WS_QS))[(size_t)b * 512 + ty * 64 + lane] = o * QSCALE;
        else { kvn[(br * 2 + 0) * 128 + g * 64 + lane] = o;
            if (br == 0) P.out[O_SCMP + (size_t)b * 256 + g * 64 + lane] = o; else if (br == 1) P.out[O_SSLC + (size_t)b * 256 + g * 64 + lane] = o;
            else P.out[O_SWIN + ((size_t)b * 512 + 511) * 256 + g * 64 + lane] = o; }
    } else if (ty < 20) {
        const int br = (ty - 14) >> 1, g = (ty - 14) & 1; const float v = pr[projs_col(10 + br, 2 + g, lane)];
        kvn[(br * 2 + 1) * 128 + g * 64 + lane] = v;
        if (br == 0) P.out[O_SCMP + (size_t)b * 256 + 128 + g * 64 + lane] = v; else if (br == 1) P.out[O_SSLC + (size_t)b * 256 + 128 + g * 64 + lane] = v;
        else P.out[O_SWIN + ((size_t)b * 512 + 511) * 256 + 128 + g * 64 + lane] = v;
    } else if (ty == 20) {
        if (lane < 24) ((float*)(P.ws + WS_GS))[b * 24 + lane] = sigmoidf(pr[256 * 15 + lane]);
    } else if (ty < 29) {
        const int ch = (ty - 21) * 64 + lane; const int pnb = ch >> 7, tc = ch & 127;
        const float bg = pr[256 * pnb + tc], zc = pr[256 * pnb + 128 + tc], cg = pr[256 * (4 + pnb) + tc], ci = pr[256 * (4 + pnb) + 128 + tc];
        const float u = cg * ci; const float s0 = P.st_conv[(size_t)b * 1024 + ch], s1 = P.st_conv[(size_t)b * 1024 + 512 + ch];
        const float cy = P.conv_w[ch] * s0 + P.conv_w[512 + ch] * s1 + P.conv_w[1024 + ch] * u + P.conv_b[ch];
        ((bf16*)(P.ws + WS_MIXS))[(size_t)b * 1024 + ch] = (bf16)f2bf(bg * cy * zc * sigmoidf(zc));
        P.out[O_SCONV + (size_t)b * 1024 + 512 + ch] = u;
    } else {
        const int col = (ty - 29) * 64 + lane; const float z = pr[256 * (13 + (col >> 8)) + (col & 255)];
        ((float*)(P.ws + WS_ZAS))[(size_t)b * 512 + col] = z * sigmoidf(z);
    }
}
__device__ __forceinline__ void p2_phase(const Ptrs& P, Frame& F) {
    compress_units<false>(P, F, (LAS float*)(F.lds + RING_OFF));
    for (int it = F.gw; it < DECB * 37; it += F.NGW) p2_sample_item(P, it, F.lane);
}
#define MFMA32(a, b, c) __builtin_amdgcn_mfma_f32_32x32x16_bf16(a, b, c, 0, 0, 0)
constexpr int P3_IMP = 0, P3_QL = 32768;
constexpr int P3_NEXT = LDSCTL_OFF + 512, P3_CNT = LDSCTL_OFF + 1024, P3_LISTS = LDSCTL_OFF + 2048, P3_LACC = LDSCTL_OFF + 10240;
constexpr int P3_RING = 65536;
constexpr int P3_MISC = MISC_OFF + 64;
constexpr int SM_Q = 36864, SM_P = 40960, SM_RED = 57344, SM_IMP = 66048, SM_L = 67200, SM_SEL = 67328, SM_O = 67584, SM_VP = 71680  , SM_RED2 = 79872  ;

template <bool MASK>
__device__ __forceinline__ void attend_lds(const LAS unsigned char* blk, const bf16x8 (&qf)[4], f32x16 (&O)[2], float& lsum,
                                           int kbase, int lo, int hi, int lane, bool want_pv, f32x16 (*Sout)[2] = nullptr) {
    const int r = lane & 31, hh = lane >> 5, swz = (r >> 1) & 7;
    const LAS unsigned char* kb = blk + r * 128; const LAS unsigned char* vb = blk + 8192 + r * 128;
#pragma unroll
    for (int kt = 0; kt < 2; ++kt) {
        f32x16 S;
        { bf16x8 kf[4];
#pragma unroll
          for (int s = 0; s < 4; ++s) kf[s] = *(const LAS bf16x8*)(kb + kt * 4096 + (((2 * s + hh) ^ swz) << 4));
#pragma unroll
          for (int i = 0; i < 16; ++i) S[i] = 0.f;
#pragma unroll
          for (int s = 0; s < 4; ++s) S = MFMA32(kf[s], qf[s], S); }
#pragma unroll
        for (int i = 0; i < 16; ++i) { float p = fast_exp2(S[i]);
            if (MASK) { const int kp = kbase + 32 * kt + (i & 3) + 8 * (i >> 2) + 4 * hh; p = (kp >= lo && kp <= hi) ? p : 0.f; }
            S[i] = p; lsum += p; }
        if (Sout) (*Sout)[kt] = S;
        if (want_pv) {
            bf16x8 pf[2];
#pragma unroll
            for (int sp = 0; sp < 2; ++sp) { v4u w; w.x = pk2(S[8 * sp + 0], S[8 * sp + 1]); w.y = pk2(S[8 * sp + 2], S[8 * sp + 3]);
                w.z = pk2(S[8 * sp + 4], S[8 * sp + 5]); w.w = pk2(S[8 * sp + 6], S[8 * sp + 7]); pf[sp] = __builtin_bit_cast(bf16x8, w); }
#pragma unroll
            for (int dt = 0; dt < 2; ++dt)
#pragma unroll
                for (int sp = 0; sp < 2; ++sp) { const bf16x8 vf = *(const LAS bf16x8*)(vb + dt * 4096 + (((2 * (2 * kt + sp) + hh) ^ swz) << 4));
                    O[dt] = MFMA32(vf, pf[sp], O[dt]); }
        }
    }
}
__device__ __forceinline__ void wave_topk(const LAS float* imp, int jmax, int nsel, int lane, int qbase, LAS unsigned* cnt, LAS unsigned char* lists) {
    if (jmax < 1) return;
    const bool c0 = lane >= 1 && lane <= jmax, c1 = 64 + lane <= jmax;
    unsigned k0[8], k1[8], Tv[8];
#pragma unroll
    for (int qi = 0; qi < 8; ++qi) { k0[qi] = c0 ? ((__builtin_bit_cast(unsigned, imp[qi * 128 + lane]) + 0x800u) & ~0x7ffu) : 0u; k1[qi] = c1 ? ((__builtin_bit_cast(unsigned, imp[qi * 128 + 64 + lane]) + 0x800u) & ~0x7ffu) : 0u; Tv[qi] = 0u; }
    if (jmax > nsel) {
        for (int bit = 30; bit >= 11; --bit) {
#pragma unroll
            for (int qi = 0; qi < 8; ++qi) { const unsigned cand = Tv[qi] | (1u << bit);
                const int cn = __popcll(__ballot(k0[qi] >= cand)) + __popcll(__ballot(k1[qi] >= cand)); Tv[qi] = cn >= nsel ? cand : Tv[qi]; } }
    }
    const unsigned long long below = (lane == 0) ? 0ull : (~0ull >> (64 - lane));
#pragma unroll
    for (int qi = 0; qi < 8; ++qi) {
        bool s0, s1;
        if (jmax > nsel) {
            const unsigned long long g0 = __ballot(k0[qi] > Tv[qi]), g1 = __ballot(k1[qi] > Tv[qi]), e0 = __ballot(k0[qi] == Tv[qi]), e1 = __ballot(k1[qi] == Tv[qi]);
            const int need = nsel - __popcll(g0) - __popcll(g1);
            const int rk0 = __popcll(e0 & below), rk1 = __popcll(e0) + __popcll(e1 & below);
            s0 = k0[qi] > Tv[qi] || (k0[qi] == Tv[qi] && rk0 < need); s1 = k1[qi] > Tv[qi] || (k1[qi] == Tv[qi] && rk1 < need);
        } else { s0 = c0; s1 = c1; }
        if (s0) { const unsigned pos = __hip_atomic_fetch_add(cnt + lane, 1u, __ATOMIC_RELAXED, __HIP_MEMORY_SCOPE_WORKGROUP); lists[lane * 64 + pos] = (unsigned char)(qbase + qi); }
        if (s1) { const unsigned pos = __hip_atomic_fetch_add(cnt + 64 + lane, 1u, __ATOMIC_RELAXED, __HIP_MEMORY_SCOPE_WORKGROUP); lists[(64 + lane) * 64 + pos] = (unsigned char)(qbase + qi); }
    }
}
struct BlkSrc { const bf16* k; const bf16* v; int vstride; };
#ifndef PROBE_SEG
#define PROBE_SEG 0
#endif
#define T_BEGIN(id) do { if (PROBE_SEG == (id)) tacc -= __builtin_readcyclecounter(); } while (0)
#define T_END(id) do { if (PROBE_SEG == (id)) tacc += __builtin_readcyclecounter(); } while (0)
__device__ __forceinline__ void p3_prompt_unit(const Ptrs& P, Frame& F, int b, int t, int g, float sh_cmp, float sh_slc, float sh_win, unsigned long long& tacc) {
    int lane = F.lane, w = F.wave, tid = F.tid; asm volatile("" : "+v"(lane), "+s"(w), "+v"(tid));
    const int col = lane & 31, hh = lane >> 5, qi = col >> 2, h = col & 3;
    const int tok = 64 * t + 8 * w + qi; const size_t row = (size_t)b * T + tok; const int qpos = tok;
    const int nck = (2 * t + 2 + 63) >> 6, nf = t >= 2 ? 3 : t + 1, nw = t >= 8 ? 9 : t + 1;
    const int n1 = nck, n2 = 2 * nck, N1 = n2 + nf;
    const bf16* KC = (const bf16*)(P.ws + WS_KC) + (size_t)(b * 2 + g) * 256 * 64; const bf16* VCT = (const bf16*)(P.ws + WS_VCT) + (size_t)(b * 2 + g) * 64 * 256;
    const bf16* KS = (const bf16*)(P.ws + WS_KS) + (size_t)(b * 2 + g) * T * 64; const bf16* VTS = (const bf16*)(P.ws + WS_VTS) + (size_t)(b * 2 + g) * 128 * 4096;
    const bf16* KW = (const bf16*)(P.ws + WS_KW) + (size_t)(b * 2 + g) * T * 64; const bf16* VTW = (const bf16*)(P.ws + WS_VTW) + (size_t)(b * 2 + g) * 128 * 4096;
    auto src1 = [&](int n) -> BlkSrc {
        if (n < n2) { const int ck = n < n1 ? n : n - n1; return BlkSrc{KC + (size_t)ck * 4096, VCT + ck * 64, 256}; }
        const int f = n - n2; const int j = f == 0 ? t : (f == 1 ? 0 : t - 1); return BlkSrc{KS + (size_t)j * 4096, VTS + (size_t)j * 4096, 64}; };
    auto src2 = [&](int n) -> BlkSrc { const int j = (t >= 8 ? t - 8 : 0) + n; return BlkSrc{KW + (size_t)j * 4096, VTW + (size_t)j * 4096, 64}; };
    const int srow = 8 * w + (lane >> 3), sch = (lane & 7) ^ ((srow >> 1) & 7);
    LAS unsigned char* ring = F.lds + P3_RING;
#define ST_DMA(bs_, n) do { LAS unsigned char* d_ = ring + ((n) & 3) * 16384 + w * 1024; \
        __builtin_amdgcn_global_load_lds((const unsigned*)((bs_).k + srow * 64 + sch * 8), (LAS unsigned*)d_, 16, 0, 0); \
        __builtin_amdgcn_global_load_lds((const unsigned*)((bs_).v + (size_t)srow * (bs_).vstride + sch * 8), (LAS unsigned*)(d_ + 8192), 16, 0, 0); } while (0)
#define BLK(n) (ring + ((n) & 3) * 16384)
#define STEP_BEGIN(SRC, n, NN) do { if (((n) & 1) == 0) { if ((n) + 2 < (NN)) { const BlkSrc b_ = SRC((n) + 2); ST_DMA(b_, (n) + 2); } if ((n) + 3 < (NN)) { const BlkSrc b_ = SRC((n) + 3); ST_DMA(b_, (n) + 3); } } } while (0)
#define STEP_END(n, NN) do { if (((n) & 1) == 1 || (n) == (NN) - 1) { asm volatile("s_waitcnt vmcnt(0)" ::: "memory"); __syncthreads(); } } while (0)
    LAS unsigned* cnt = (LAS unsigned*)(F.lds + P3_CNT); LAS unsigned char* lists = F.lds + P3_LISTS; LAS unsigned* nextb = (LAS unsigned*)(F.lds + P3_NEXT);
    LAS int* oacc = (LAS int*)ring; LAS float* lacc = (LAS float*)(F.lds + P3_LACC);
    const float FXS = fast_exp2(18.0f - sh_slc), FXI = 1.0f / FXS;
    LAS unsigned char* ql = F.lds + P3_QL;
    T_BEGIN(1); T_BEGIN(8);
    __syncthreads();
    if (tid < 128) cnt[tid] = 0u; if (tid == 128) nextb[0] = 0u;
    { const BlkSrc b0 = src1(0); ST_DMA(b0, 0); if (N1 > 1) { const BlkSrc b1 = src1(1); ST_DMA(b1, 1); } }
    { const bf16* qg = (const bf16*)(P.ws + WS_Q) + ((size_t)b * T + 64 * t) * 512 + g * 256;
      v4u tq[4];
#pragma unroll
      for (int k = 0; k < 4; ++k) { const int c = tid + 512 * k, rq = c >> 3, ch = c & 7; tq[k] = *(const GAS v4u*)(qg + (size_t)(rq >> 2) * 512 + (rq & 3) * 64 + ch * 8); }
#pragma unroll
      for (int k = 0; k < 4; ++k) { const int c = tid + 512 * k, rq = c >> 3, ch = c & 7; *(LAS v4u*)(ql + rq * 128 + ((ch ^ ((rq >> 1) & 7)) << 4)) = tq[k]; } }
    bf16x8 qf[4];
    { const bf16* q = (const bf16*)(P.ws + WS_Q) + row * 512 + (g * 4 + h) * 64 + 8 * hh;
#pragma unroll
      for (int s = 0; s < 4; ++s) qf[s] = __builtin_bit_cast(bf16x8, *(const GAS v4u*)(q + 16 * s)); }
    const float* gate = (const float*)(P.ws + WS_GATE) + row * 24 + (g * 4 + h) * 3;
    const float g_cmp = gate[0], g_slc = gate[1], g_win = gate[2];
    asm volatile("s_waitcnt vmcnt(0)" ::: "memory"); __syncthreads();
    T_END(1); T_BEGIN(2);
    f32x16 O[2];
    LAS float* wl = (LAS float*)(F.lds + P3_IMP + w * 4096);
    LAS float* xw0 = (LAS float*)(F.lds + P3_IMP + w * 4096) + lane;
    f32x16 totr;
    const int nvis = (qpos + 1) >> 5;
    int n = 0;
    float lsum = 0.f;
    for (; n < n1; ++n) { STEP_BEGIN(src1, n, N1); attend_lds<true>(BLK(n), qf, O, lsum, 64 * n, 0, nvis - 1, lane, false); STEP_END(n, N1); }
    lsum += __shfl_xor(lsum, 32);
    const float rl = lsum > 0.f ? 1.0f / lsum : 0.f;
    for (int i = lane; i < 1024; i += 64) wl[i] = 0.f;
#pragma unroll
    for (int i = 0; i < 16; ++i) { O[0][i] = 0.f; O[1][i] = 0.f; }
    { float dummy = 0.f;
      for (; n < n2; ++n) { STEP_BEGIN(src1, n, N1); const int ck = n - n1; f32x16 Sn[2];
        attend_lds<true>(BLK(n), qf, O, dummy, 64 * ck, 0, nvis - 1, lane, true, &Sn);
#pragma unroll
        for (int kt = 0; kt < 2; ++kt)
#pragma unroll
            for (int i2 = 0; i2 < 8; ++i2) { const float v = quad_sum((Sn[kt][2 * i2] + Sn[kt][2 * i2 + 1]) * rl);
                if (h == 0) wl[qi * 128 + 32 * ck + 16 * kt + (i2 & 1) + 4 * (i2 >> 1) + 2 * hh] = v; }
        STEP_END(n, N1); } }
    LDS_WAIT(); asm volatile("" ::: "memory");
    T_END(2); T_BEGIN(3);
    wave_topk(wl, t - 2, 13, lane, 8 * w, cnt, lists);
    LDS_WAIT(); asm volatile("" ::: "memory");
#pragma unroll
    for (int i = 0; i < 16; ++i) { xw0[i * 64] = O[0][i] * (g_cmp * rl); totr[i] = O[1][i] * (g_cmp * rl); O[0][i] = 0.f; O[1][i] = 0.f; }
    T_END(3); T_BEGIN(4);
    lsum = 0.f;
    for (; n < N1; ++n) { STEP_BEGIN(src1, n, N1);
        if (n == n2) attend_lds<true>(BLK(n), qf, O, lsum, 64 * t, 0, qpos, lane, true);
        else attend_lds<false>(BLK(n), qf, O, lsum, 0, 0, 0, lane, true);
        STEP_END(n, N1); }
    lsum += __shfl_xor(lsum, 32);
#pragma unroll
    for (int dt = 0; dt < 2; ++dt)
#pragma unroll
        for (int i = 0; i < 16; ++i) oacc[(32 * dt + (i & 3) + 8 * (i >> 2) + 4 * hh) * 256 + 32 * w + col] = __float2int_rn(O[dt][i] * FXS);
    if (hh == 0) lacc[32 * w + col] = lsum;
    __syncthreads();
    T_END(4); T_BEGIN(5);
    if (t > 2) {
        const int r = lane & 31;
#define NEXT_BLOCK(jv_, nq_) do { for (;;) { unsigned t_ = 0u; if (lane == 0) t_ = __hip_atomic_fetch_add(nextb, 1u, __ATOMIC_RELAXED, __HIP_MEMORY_SCOPE_WORKGROUP); \
            jv_ = 1 + (int)__builtin_amdgcn_readfirstlane(t_); if (jv_ > t - 2) { nq_ = 0; break; } nq_ = (int)__builtin_amdgcn_readfirstlane(cnt[jv_]); if (nq_ > 0) break; } } while (0)
#define LOAD_FRAGS(kd_, vd_, jv_) do { const bf16* kp_ = KS + (size_t)(jv_) * 4096 + r * 64 + 8 * hh; const bf16* vp_ = VTS + (size_t)(jv_) * 4096 + r * 64 + 8 * hh; \
            _Pragma("unroll") for (int a_ = 0; a_ < 2; ++a_) _Pragma("unroll") for (int b_ = 0; b_ < 4; ++b_) { kd_[a_][b_] = __builtin_bit_cast(bf16x8, *(const GAS v4u*)(kp_ + a_ * 2048 + 16 * b_)); \
                vd_[a_][b_] = __builtin_bit_cast(bf16x8, *(const GAS v4u*)(vp_ + a_ * 2048 + 16 * b_)); } } while (0)
        bf16x8 kf[2][4], vf[2][4];
        for (;;) {
            int j, nq; NEXT_BLOCK(j, nq);
            if (j > t - 2) break;
            LOAD_FRAGS(kf, vf, j);
#pragma unroll
            for (int a_ = 0; a_ < 2; ++a_)
#pragma unroll
                for (int b_ = 0; b_ < 4; ++b_) asm volatile("" : "+v"(kf[a_][b_]), "+v"(vf[a_][b_]));
            for (int c0 = 0; c0 < nq; c0 += 8) {
                const int sl = c0 + qi; const bool valid = sl < nq;
                const int rowq = (int)lists[j * 64 + (valid ? sl : nq - 1)] * 4 + h;
                const LAS unsigned char* qp = ql + rowq * 128; const int qsw = (rowq >> 1) & 7;
                bf16x8 q2[4];
#pragma unroll
                for (int s = 0; s < 4; ++s) q2[s] = *(const LAS bf16x8*)(qp + (((2 * s + hh) ^ qsw) << 4));
                float l2 = 0.f; bf16x8 pf[4]; f32x16 S0, S1;
#pragma unroll
                for (int i = 0; i < 16; ++i) { S0[i] = 0.f; S1[i] = 0.f; }
#pragma unroll
                for (int s = 0; s < 4; ++s) { S0 = MFMA32(kf[0][s], q2[s], S0); S1 = MFMA32(kf[1][s], q2[s], S1); }
#pragma unroll
                for (int i = 0; i < 16; ++i) { S0[i] = fast_exp2(S0[i]); l2 += S0[i]; }
#pragma unroll
                for (int sp = 0; sp < 2; ++sp) { v4u wv; wv.x = pk2(S0[8 * sp + 0], S0[8 * sp + 1]); wv.y = pk2(S0[8 * sp + 2], S0[8 * sp + 3]);
                    wv.z = pk2(S0[8 * sp + 4], S0[8 * sp + 5]); wv.w = pk2(S0[8 * sp + 6], S0[8 * sp + 7]); pf[sp] = __builtin_bit_cast(bf16x8, wv); }
#pragma unroll
                for (int i = 0; i < 16; ++i) { S1[i] = fast_exp2(S1[i]); l2 += S1[i]; }
#pragma unroll
                for (int sp = 0; sp < 2; ++sp) { v4u wv; wv.x = pk2(S1[8 * sp + 0], S1[8 * sp + 1]); wv.y = pk2(S1[8 * sp + 2], S1[8 * sp + 3]);
                    wv.z = pk2(S1[8 * sp + 4], S1[8 * sp + 5]); wv.w = pk2(S1[8 * sp + 6], S1[8 * sp + 7]); pf[2 + sp] = __builtin_bit_cast(bf16x8, wv); }
                l2 += __shfl_xor(l2, 32);
                T_BEGIN(9);
#pragma unroll
                for (int dt = 0; dt < 2; ++dt) { f32x16 O2;
#pragma unroll
                    for (int i = 0; i < 16; ++i) O2[i] = 0.f;
#pragma unroll
                    for (int ks = 0; ks < 4; ++ks) O2 = MFMA32(vf[dt][ks], pf[ks], O2);
                    if (valid) {
#pragma unroll
                        for (int i = 0; i < 16; ++i) (void)__hip_atomic_fetch_add(oacc + (32 * dt + (i & 3) + 8 * (i >> 2) + 4 * hh) * 256 + rowq, __float2int_rn(O2[i] * FXS), __ATOMIC_RELAXED, __HIP_MEMORY_SCOPE_WORKGROUP); } }
                if (valid) {
                    if (hh == 0) (void)__hip_atomic_fetch_add(lacc + rowq, l2, __ATOMIC_RELAXED, __HIP_MEMORY_SCOPE_WORKGROUP); }
                LDS_WAIT(); T_END(9);
            }
        }
#undef NEXT_BLOCK
#undef LOAD_FRAGS
    }
    __syncthreads();
    T_END(5); T_BEGIN(6);
    LAS float* x0 = (LAS float*)(F.lds + P3_IMP + w * 4096) + lane; LAS float* x1 = (LAS float*)(F.lds + P3_QL + w * 4096) + lane;
    { const float sc = g_slc / fmaxf(lacc[32 * w + col], 1e-30f);
#pragma unroll
      for (int i = 0; i < 16; ++i) { const int dr = (i & 3) + 8 * (i >> 2) + 4 * hh;
          x0[i * 64] = x0[i * 64] + (float)oacc[dr * 256 + 32 * w + col] * (FXI * sc); x1[i * 64] = totr[i] + (float)oacc[(32 + dr) * 256 + 32 * w + col] * (FXI * sc); O[0][i] = 0.f; O[1][i] = 0.f; } }
    LDS_WAIT(); __syncthreads();
    { const BlkSrc b0 = src2(0); ST_DMA(b0, 0); if (nw > 1) { const BlkSrc b1 = src2(1); ST_DMA(b1, 1); } }
    { asm volatile("" : "+v"(lane));
      const bf16* q = (const bf16*)(P.ws + WS_Q) + row * 512 + (g * 4 + h) * 64 + 8 * hh;
#pragma unroll
      for (int s = 0; s < 4; ++s) qf[s] = __builtin_bit_cast(bf16x8, *(const GAS v4u*)(q + 16 * s)); }
    asm volatile("s_waitcnt vmcnt(0)" ::: "memory"); __syncthreads();
    lsum = 0.f;
    for (n = 0; n < nw; ++n) { STEP_BEGIN(src2, n, nw); const int j = (t >= 8 ? t - 8 : 0) + n;
        if (j == t || j + 8 == t) attend_lds<true>(BLK(n), qf, O, lsum, 64 * j, qpos - 511, qpos, lane, true);
        else attend_lds<false>(BLK(n), qf, O, lsum, 0, 0, 0, lane, true);
        STEP_END(n, nw); }
    lsum += __shfl_xor(lsum, 32);
    { const float sc = g_win / fmaxf(lsum, 1e-30f);
#pragma unroll
      for (int i = 0; i < 16; ++i) { O[0][i] = x0[i * 64] + O[0][i] * sc; O[1][i] = x1[i * 64] + O[1][i] * sc; } }
#undef ST_DMA
#undef BLK
#undef STEP_BEGIN
#undef STEP_END
    T_END(6); T_BEGIN(7);
    asm volatile("" : "+v"(lane));
    const int col_ = lane & 31, hh_ = lane >> 5, h_ = col_ & 3; const size_t row_ = (size_t)b * T + 64 * t + 8 * w + (col_ >> 2);
    const bf16* za = (const bf16*)(P.ws + WS_ZA) + row_ * 512 + (g * 4 + h_) * 64; bf16* mx = (bf16*)(P.ws + WS_MIX) + row_ * 1024 + 512 + (g * 4 + h_) * 64;
#pragma unroll
    for (int dt = 0; dt < 2; ++dt)
#pragma unroll
        for (int i4 = 0; i4 < 4; ++i4) { const int d = 32 * dt + 8 * i4 + 4 * hh_; const v2u z = *(const GAS v2u*)(za + d);
            v2u o; o.x = pk2(O[dt][4 * i4] * bf2f(z.x & 0xffffu), O[dt][4 * i4 + 1] * bf2f(z.x >> 16)); o.y = pk2(O[dt][4 * i4 + 2] * bf2f(z.y & 0xffffu), O[dt][4 * i4 + 3] * bf2f(z.y >> 16));
            *(GAS v2u*)(mx + d) = o; }
    if (g == 0) { const int tq = w, c8 = lane * 8; const size_t r0 = (size_t)b * T + 64 * t + 8 * tq;
        const bf16* U = (const bf16*)(P.ws + WS_U) + c8; const bf16* CGp = (const bf16*)(P.ws + WS_CG) + c8; bf16* mo = (bf16*)(P.ws + WS_MIX) + c8;
        v4u ur[10], cr[8];
        const bool has_prev = (t > 0) || (tq > 0);
#pragma unroll
        for (int i = 0; i < 10; ++i) ur[i] = (i >= 2 || has_prev) ? *(const GAS v4u*)(U + (r0 + i - 2) * 512) : (v4u){0u, 0u, 0u, 0u};
#pragma unroll
        for (int i = 0; i < 8; ++i) cr[i] = *(const GAS v4u*)(CGp + (r0 + i) * 512);
        float w0[8], w1[8], w2[8], cb[8];
#pragma unroll
        for (int e = 0; e < 8; ++e) { w0[e] = P.conv_w[c8 + e]; w1[e] = P.conv_w[512 + c8 + e]; w2[e] = P.conv_w[1024 + c8 + e]; cb[e] = P.conv_b[c8 + e]; }
#pragma unroll
        for (int i = 0; i < 8; ++i) { float o[8];
#pragma unroll
            for (int e = 0; e < 8; ++e) { const int sh_ = (e & 1) * 16; const float a = bf2f((ur[i][e >> 1] >> sh_) & 0xffffu), bb = bf2f((ur[i + 1][e >> 1] >> sh_) & 0xffffu), c = bf2f((ur[i + 2][e >> 1] >> sh_) & 0xffffu);
                o[e] = bf2f((cr[i][e >> 1] >> sh_) & 0xffffu) * (w0[e] * a + w1[e] * bb + w2[e] * c + cb[e]); }
            v4u ov; ov.x = pk2(o[0], o[1]); ov.y = pk2(o[2], o[3]); ov.z = pk2(o[4], o[5]); ov.w = pk2(o[6], o[7]);
            *(GAS v4u*)(mo + (r0 + i) * 1024) = ov; } }
    T_END(7); T_END(8);
}
template <class KeyFn>
__device__ __forceinline__ void sample_branch(Frame& F, int nslots, float shift, const KeyFn& key, LAS float* obr) {
    LAS float* q = (LAS float*)(F.lds + SM_Q); LAS float* Pb = (LAS float*)(F.lds + SM_P); LAS float* red = (LAS float*)(F.lds + SM_RED); LAS float* lsm = (LAS float*)(F.lds + SM_L);
    LAS unsigned long long* vptr = (LAS unsigned long long*)(F.lds + SM_VP);
    float lacc[4] = {0.f, 0.f, 0.f, 0.f};
    for (int s = F.tid; s < nslots; s += 512) { const float* kp; const float* vp; const bool valid = key(s, kp, vp);
        float sc[4] = {0.f, 0.f, 0.f, 0.f};
        if (valid) {
#pragma unroll 8
            for (int d4 = 0; d4 < 16; ++d4) { const f32x4 kv = *(const GAS f32x4*)(kp + 4 * d4);
#pragma unroll
                for (int hq = 0; hq < 4; ++hq) { const f32x4 qv = *(const LAS f32x4*)(q + hq * 64 + 4 * d4); sc[hq] += (kv.x * qv.x + kv.y * qv.y) + (kv.z * qv.z + kv.w * qv.w); } } }
        f32x4 p;
#pragma unroll
        for (int hq = 0; hq < 4; ++hq) { p[hq] = valid ? fast_exp2(sc[hq] - shift) : 0.f; lacc[hq] += p[hq]; }
        *(LAS f32x4*)(Pb + 4 * s) = p; vptr[s] = (unsigned long long)(uintptr_t)vp; }
#pragma unroll
    for (int hq = 0; hq < 4; ++hq) { lacc[hq] = wave_sum(lacc[hq]); if (F.lane == 0) red[F.wave * 4 + hq] = lacc[hq]; }
    __syncthreads();
    if (F.tid < 4) { float s = 0.f; for (int ww = 0; ww < 8; ++ww) s += red[ww * 4 + F.tid]; lsm[F.tid] = s; }
    const int sg = F.tid >> 4, d4 = F.tid & 15;
    f32x4 oa[4];
#pragma unroll
    for (int hq = 0; hq < 4; ++hq) oa[hq] = (f32x4){0.f, 0.f, 0.f, 0.f};
    for (int s0 = sg; s0 < nslots; s0 += 256) {
        f32x4 vv[8], pp[8];
#pragma unroll
        for (int u = 0; u < 8; ++u) { const int s = s0 + 32 * u; const float* vp = (const float*)(uintptr_t)vptr[s]; vv[u] = *(const GAS f32x4*)(vp + 4 * d4); pp[u] = *(const LAS f32x4*)(Pb + 4 * s); }
#pragma unroll
        for (int u = 0; u < 8; ++u) { oa[0] = oa[0] + vv[u] * pp[u].x; oa[1] = oa[1] + vv[u] * pp[u].y; oa[2] = oa[2] + vv[u] * pp[u].z; oa[3] = oa[3] + vv[u] * pp[u].w; } }
    __syncthreads();
    LAS float* red2 = (LAS float*)(F.lds + SM_RED2);
#pragma unroll
    for (int hq = 0; hq < 4; ++hq) *(LAS f32x4*)(red2 + (sg * 4 + hq) * 64 + 4 * d4) = oa[hq];
    __syncthreads();
    if (F.tid < 256) { float s = 0.f;
#pragma unroll 8
        for (int g2 = 0; g2 < 32; ++g2) s += red2[g2 * 256 + F.tid]; obr[F.tid] = s; }
    __syncthreads();
}
__device__ __forceinline__ void p3_sample_unit(const Ptrs& P, Frame& F, int b, int g) {
    asm volatile("" : "+v"(F.tid), "+v"(F.lane), "+s"(F.wave));
    LAS float* q = (LAS float*)(F.lds + SM_Q); LAS float* Pb = (LAS float*)(F.lds + SM_P); LAS float* imp = (LAS float*)(F.lds + SM_IMP); LAS float* lsm = (LAS float*)(F.lds + SM_L);
    LAS int* sel = (LAS int*)(F.lds + SM_SEL); LAS float* osm = (LAS float*)(F.lds + SM_O);
    const float* cst = (const float*)(P.ws + WS_CONST);
    float kcmax = 0.f; for (int e_ = 0; e_ < 4; ++e_) kcmax += __builtin_bit_cast(float, __hip_atomic_load((unsigned*)(P.ws + WS_CTL) + CW_KCMAX + 64 + e_, RLX_AGENT));
    const float sh_cmp = cst[0] * sqrtf(kcmax) * LOG2E * 1.001f, sh_slc = cst[1], sh_win = cst[2];
    if (F.tid < 256) q[F.tid] = ((const float*)(P.ws + WS_QS))[(size_t)b * 512 + g * 256 + F.tid];
    __syncthreads();
    const float* kcs = (const float*)(P.ws + WS_KCS) + (size_t)(b * 2 + g) * 2 * NCS * 64;
    sample_branch(F, NCS, sh_cmp, [&](int s, const float*& kp, const float*& vp) { kp = kcs + (size_t)s * 64; vp = kcs + (size_t)(NCS + s) * 64; return true; }, osm);
    { const f32x4 p = *(const LAS f32x4*)(Pb + 4 * F.tid); float v = p.x / lsm[0] + p.y / lsm[1] + p.z / lsm[2] + p.w / lsm[3]; v += __shfl_xor(v, 1);
      if ((F.tid & 1) == 0) imp[F.tid >> 1] = v; if (F.tid < 4) imp[256 + F.tid] = 0.f; }
    if (F.tid < 256) osm[F.tid] = osm[F.tid] / lsm[F.tid >> 6];
    __syncthreads();
    if (F.wave == 0) { const int lane = F.lane; unsigned k[4];
#pragma unroll
        for (int i = 0; i < 4; ++i) { const int j = lane + 64 * i; k[i] = (j >= 1 && j <= 254) ? __builtin_bit_cast(unsigned, imp[j]) + 1u : 0u; }
        unsigned Tv = 0u;
        for (int bit = 30; bit >= 0; --bit) { const unsigned cand = Tv | (1u << bit); int cnt = 0;
#pragma unroll
            for (int i = 0; i < 4; ++i) cnt += __popcll(__ballot(k[i] >= cand));
            if (cnt >= 13) Tv = cand; }
        int ngt = 0;
#pragma unroll
        for (int i = 0; i < 4; ++i) ngt += __popcll(__ballot(k[i] > Tv));
        const int need = 13 - ngt; const unsigned long long below = (lane == 0) ? 0ull : (~0ull >> (64 - lane));
        int base = 3, eqbase = 0;
        if (lane == 0) { int z_ = 0; asm volatile("" : "+v"(z_)); sel[0] = z_; sel[1] = z_ + 255; sel[2] = z_ + 256; }
#pragma unroll
        for (int i = 0; i < 4; ++i) { const unsigned long long e = __ballot(k[i] == Tv); const int rk = eqbase + __popcll(e & below); const bool on = k[i] > Tv || (k[i] == Tv && rk < need);
            const unsigned long long m = __ballot(on); if (on) sel[base + __popcll(m & below)] = lane + 64 * i; base += __popcll(m); eqbase += __popcll(e); } }
    __syncthreads();
    const float* kvn = (const float*)(P.ws + WS_KVN) + (size_t)b * 768;
    const int* pt = P.page_table + b * NPAGES; const float* cs = P.cache_slc;
    sample_branch(F, 1024, sh_slc, [&](int s, const float*& kp, const float*& vp) { const int j = sel[s >> 6], rr = s & 63;
        if (j == 256) { kp = kvn + (1 * 2 + 0) * 128 + g * 64; vp = kvn + (1 * 2 + 1) * 128 + g * 64; return rr == 0; }
        const float* rowp = cs + ((size_t)pt[j >> 1] * 128 + (j & 1) * 64 + rr) * 256 + g * 64; kp = rowp; vp = rowp + 128; return true; }, osm + 256);
    if (F.tid < 256) osm[256 + F.tid] = osm[256 + F.tid] / lsm[F.tid >> 6];
    __syncthreads();
    const float* stw = P.st_win + (size_t)b * 512 * 256;
    sample_branch(F, 512, sh_win, [&](int s, const float*& kp, const float*& vp) {
        if (s == 511) { kp = kvn + (2 * 2 + 0) * 128 + g * 64; vp = kvn + (2 * 2 + 1) * 128 + g * 64; return true; }
        const float* rowp = stw + (size_t)(s + 1) * 256 + g * 64; kp = rowp; vp = rowp + 128; return true; }, osm + 512);
    if (F.tid < 256) { const int hq = F.tid >> 6, d = F.tid & 63; const float* gs = (const float*)(P.ws + WS_GS) + b * 24 + (g * 4 + hq) * 3;
        const float o = gs[0] * osm[F.tid] + gs[1] * osm[256 + F.tid] + gs[2] * osm[512 + F.tid] / lsm[hq];
        ((bf16*)(P.ws + WS_MIXS))[(size_t)b * 1024 + 512 + (g * 4 + hq) * 64 + d] = (bf16)f2bf(o * ((const float*)(P.ws + WS_ZAS))[(size_t)b * 512 + (g * 4 + hq) * 64 + d]); }
    __syncthreads();
}
__device__ __forceinline__ void p3_phase(const Ptrs& P, Frame& F, int rep) {
    const float* cst = (const float*)(P.ws + WS_CONST);
    float kcmax = 0.f; for (int e_ = 0; e_ < 4; ++e_) kcmax += __builtin_bit_cast(float, __hip_atomic_load((unsigned*)(P.ws + WS_CTL) + CW_KCMAX + e_, RLX_AGENT));
    const float sh_cmp = cst[0] * sqrtf(kcmax) * LOG2E * 1.001f, sh_slc = cst[1], sh_win = cst[2];
    unsigned long long tacc = 0ull;
    volatile LAS int* qw = (volatile LAS int*)(F.lds + P3_MISC);
#ifndef PROBE_P3
#define PROBE_P3 0
#endif
    constexpr int NS_ = PROBE_P3 == 1 ? 16 : 8, PSH_ = PROBE_P3 == 2 ? 1 : 0;
    constexpr int NQ = NS_ + (128 << PSH_);
    const int x0 = (int)(xb_xcc_id() & 7u);
    for (int xi = 0; xi < 8; ++xi) {
        const int x = (x0 + xi) & 7;
        for (;;) {
            __syncthreads();
            if (F.tid == 0) qw[0] = (int)__hip_atomic_fetch_add((unsigned*)(F.ctl + CW_QUEUE + 64 * (x + 8 * rep)), 1u, RLX_AGENT);
            __syncthreads();
            const int idx = qw[0];
            if (idx >= NQ) break;
            if (idx < NS_) p3_sample_unit(P, F, x * 4 + ((idx & 7) >> 1), idx & 1);
            else p3_prompt_unit(P, F, x >> 1, 127 - ((idx - NS_) >> PSH_), x & 1, sh_cmp, sh_slc, sh_win, tacc);
        }
    }
    if (PROBE_SEG != 0 && blockIdx.x == 0) { const unsigned long long t0_ = __builtin_readcyclecounter(); while (__builtin_readcyclecounter() - t0_ < tacc) __builtin_amdgcn_s_sleep(8); }
}
#ifndef MK_N_LAUNCHES
#define MK_N_LAUNCHES 1
#endif
constexpr int N_PHASES = 5;
constexpr int N_LAUNCHES = MK_N_LAUNCHES;
struct Args { Ptrs p; int ph_lo, ph_hi, rep, mode; };
__global__ void __launch_bounds__(NWAVES * 64, 2) nsa_fwd(Args args) {
    extern __shared__ __attribute__((aligned(16))) unsigned char lds[];
    const Ptrs& P = args.p;
    Frame F;
    F.lds = (LAS unsigned char*)lds;
    F.MISC = (volatile LAS unsigned*)(F.lds + MISC_OFF);
    F.tid = threadIdx.x; F.lane = F.tid & 63; F.wave = __builtin_amdgcn_readfirstlane(F.tid >> 6);
    F.G = gridDim.x; F.gw = blockIdx.x * NWAVES + F.wave; F.NGW = F.G * NWAVES;
    F.ctl = (gu32*)(P.ws + WS_CTL);
    for (int u = F.tid; u < (LDS_BYTES - LDSCTL_OFF) / 4; u += NWAVES * 64) ((LAS unsigned*)(F.lds + LDSCTL_OFF))[u] = 0u;
    __syncthreads();
    XcdBarrier bar; bar.bar = (unsigned*)(F.ctl + CW_BAR); bar.x = 0; bar.st = nullptr;
    if (N_LAUNCHES == 1) bar = xcd_barrier_post((unsigned*)(F.ctl + CW_BAR), F.MISC + 8);
    const int lo = args.ph_lo, hi = args.ph_hi;
    unsigned long long tprobe = 0ull;
#define IN(k) (lo <= (k) && (k) < hi)
#define FENCE() do { asm volatile("" : "+s"(F.wave), "+s"(F.gw)); F.lane = (int)__builtin_amdgcn_mbcnt_hi(~0u, __builtin_amdgcn_mbcnt_lo(~0u, 0u)); F.tid = F.wave * 64 + F.lane; asm volatile("" : "+v"(F.tid), "+v"(F.lane)); } while (0)
#define SEAM(k) do { if (IN(k) && IN((k) + 1)) xcd_barrier(bar, F.wave == 0 && (int)__builtin_amdgcn_mbcnt_hi(~0u, __builtin_amdgcn_mbcnt_lo(~0u, 0u)) == 0); } while (0)

    if (IN(0)) { FENCE(); p0_phase(P, F); } SEAM(0);
    if (IN(1)) { FENCE();
        pg8::Gemm g{(const pg8::bf16_t*)(P.ws + WS_XB), (const pg8::bf16_t*)(P.ws + WS_BT1), M, NP, D}; pg8::StaticOrder S; S.init(M, NP, F.G, (int)blockIdx.x);
        EpiIn E{(const float*)(P.ws + WS_RSTD), (const float*)(P.ws + WS_ROPE), P.q_gain, P.k_gain, P.out, P.ws};
        pg8::gemm_phase<EpiIn, pg8::StaticOrder, true, true>(F.lds + RING_OFF, g, S, E, F.wave, tprobe);
        FENCE();
        for (int ct = F.gw; ct < NP / 16; ct += F.NGW) small_gemm_tile<0>(P, (const bf16*)(P.ws + WS_XSB), (const bf16*)(P.ws + WS_BT1), ct, F.lane);
#if defined(PROBE_EPI)
        if (PROBE_EPI == 1 && blockIdx.x == 0) { const unsigned long long t0_ = __builtin_readcyclecounter(); while (__builtin_readcyclecounter() - t0_ < tprobe) __builtin_amdgcn_s_sleep(8); }
        tprobe = 0ull;
#endif
    } SEAM(1);
    if (IN(2)) { FENCE(); p2_phase(P, F); } SEAM(2);
    if (IN(3)) { FENCE(); p3_phase(P, F, args.rep); } SEAM(3);
    if (IN(4)) { FENCE();
        pg8::Gemm g{(const pg8::bf16_t*)(P.ws + WS_MIX), (const pg8::bf16_t*)(P.ws + WS_BT2), M, D, D}; pg8::StaticOrder S; S.init(M, D, F.G, (int)blockIdx.x);
        EpiOut E{P.xp, P.out + O_Y};
        pg8::gemm_phase<EpiOut, pg8::StaticOrder, true, true>(F.lds + RING_OFF, g, S, E, F.wave, tprobe);
        FENCE();
        for (int ct = F.gw; ct < D / 16; ct += F.NGW) small_gemm_tile<1>(P, (const bf16*)(P.ws + WS_MIXS), (const bf16*)(P.ws + WS_BT2), ct, F.lane);
#if defined(PROBE_EPI)
        if (PROBE_EPI == 2 && blockIdx.x == 0) { const unsigned long long t0_ = __builtin_readcyclecounter(); while (__builtin_readcyclecounter() - t0_ < tprobe) __builtin_amdgcn_s_sleep(8); }
#endif
    }
#undef IN
#undef SEAM
}

extern "C" void kernel_launch(void* const* d_in, const int* in_sizes, int n_in, void* d_out, int out_size, void* d_ws, size_t ws_size, hipStream_t stream) {
    static int grid = 0;
    if (grid == 0) {
        if (n_in != 16 || out_size != (int)O_END || ws_size < WS_END) { fprintf(stderr, "kernel_launch: unexpected shapes (n_in %d, out %d, ws %zu)\n", n_in, out_size, ws_size); grid = -1; return; }
        int dev = 0, cus = 0, per_cu = 0;
        if (hipGetDevice(&dev) != hipSuccess || hipDeviceGetAttribute(&cus, hipDeviceAttributeMultiprocessorCount, dev) != hipSuccess) { grid = -1; return; }
        if (hipFuncSetAttribute((const void*)nsa_fwd, hipFuncAttributeMaxDynamicSharedMemorySize, LDS_BYTES) != hipSuccess) { fprintf(stderr, "kernel_launch: hipFuncSetAttribute failed\n"); grid = -1; return; }
        if (hipOccupancyMaxActiveBlocksPerMultiprocessor(&per_cu, (const void*)nsa_fwd, NWAVES * 64, LDS_BYTES) != hipSuccess || per_cu < 1)
            fprintf(stderr, "kernel_launch: note: occupancy query reports %d workgroups per CU\n", per_cu);
        (void)hipGetLastError();
        grid = cus;
    }
    if (grid < 0) return;
    if (hipMemsetAsync((char*)d_ws + WS_CTL, 0, CTL_ZERO_BYTES, stream) != hipSuccess) return;
    Args a{}; a.mode = 3;
    a.p.xp = (const float*)d_in[0]; a.p.xs = (const float*)d_in[1]; a.p.cache_cmp = (const float*)d_in[2]; a.p.cache_slc = (const float*)d_in[3];
    a.p.st_win = (const float*)d_in[4]; a.p.st_conv = (const float*)d_in[5]; a.p.page_table = (const int*)d_in[6]; a.p.norm_g = (const float*)d_in[7];
    a.p.w_in = (const float*)d_in[8]; a.p.conv_w = (const float*)d_in[9]; a.p.conv_b = (const float*)d_in[10]; a.p.q_gain = (const float*)d_in[11];
    a.p.k_gain = (const float*)d_in[12]; a.p.cmp_pe = (const float*)d_in[13]; a.p.cmp_w = (const float*)d_in[14]; a.p.w_out = (const float*)d_in[15];
    a.p.out = (float*)d_out; a.p.ws = (unsigned char*)d_ws;
#ifndef PROBE_DUP
#define PROBE_DUP -1
#endif
    for (int li = 0; li < N_LAUNCHES; ++li) {
        a.ph_lo = (N_LAUNCHES == 1) ? 0 : li; a.ph_hi = (N_LAUNCHES == 1) ? N_PHASES : li + 1;
        for (int rep = 0; rep < ((N_LAUNCHES > 1 && li == PROBE_DUP) ? 2 : 1); ++rep) {
            a.rep = rep;
            hipLaunchKernelGGL(nsa_fwd, dim3(grid), dim3(NWAVES * 64), LDS_BYTES, stream, a);
            const hipError_t le = hipPeekAtLastError();
            if (le != hipSuccess) { fprintf(stderr, "kernel_launch: launch %d failed: %s\n", li, hipGetErrorName(le)); break; }
        }
    }
}
```

```cpp
#include <hip/hip_runtime.h>
#include <cstdio>
#include <cstdint>
#define GAS __attribute__((address_space(1)))
#define LAS __attribute__((address_space(3)))
typedef unsigned short bf16;
typedef unsigned v4u __attribute__((ext_vector_type(4)));
typedef unsigned v2u __attribute__((ext_vector_type(2)));
typedef float f32x2 __attribute__((ext_vector_type(2)));
typedef float f32x16 __attribute__((ext_vector_type(16)));
typedef GAS unsigned gu32;
typedef GAS unsigned long long gu64;
#define RLX_AGENT __ATOMIC_RELAXED, __HIP_MEMORY_SCOPE_AGENT
#define LDS_WAIT() asm volatile("s_waitcnt lgkmcnt(0)" ::: "memory")
#define VM_WAIT() asm volatile("s_waitcnt vmcnt(0)" ::: "memory")
#define MK_N_LAUNCHES 1
#define PROBE_DUP -1
#define PROBE_P3 0
#define PROBE_SEG 0
namespace pg8 {
#define PG8_LAS __attribute__((address_space(3)))
typedef unsigned short bf16_t;
typedef short bf16x8 __attribute__((ext_vector_type(8)));
typedef float f32x4 __attribute__((ext_vector_type(4)));
typedef unsigned u32x4 __attribute__((ext_vector_type(4)));
constexpr int BM = 256, BK = 64, HALF = 128, HTB = HALF * BK * 2  , STAGE_BYTES = 8 * HTB, NXCD = 8, WGM = 8;

__host__ __device__ __forceinline__ int lds_byte(int r, int c) { const int st = (r >> 4) * 2 + (c >> 5), rr = r & 15, cc = c & 31, ob = rr * 64 + cc * 2; return st * 1024 + (ob ^ (((ob >> 9) & 1) << 5)); }
__host__ __device__ __forceinline__ void stage_rc(int b, int& R, int& C) { const int st = b / 1024, sb = b % 1024, swz = sb ^ (((sb >> 9) & 1) << 5); R = (st >> 1) * 16 + swz / 64; C = (st & 1) * 32 + (swz % 64) / 2; }
__host__ __device__ __forceinline__ int perm32(int rho) { const int n = rho >> 4, i = rho & 15; return 8 * (i >> 2) + 4 * n + (i & 3); }

struct Unit { int pm, pn; };
struct Gemm { const bf16_t* A; const bf16_t* Bt; int M, N, K; };

struct StaticOrder {
    int nM, nN, nwg, G, c;
    __host__ __device__ void init(int M, int N, int G_, int c_) { nM = M / BM; nN = N / BM; nwg = nM * nN; G = G_; c = c_; }
    __host__ __device__ bool next(int i, Unit& u) const {
        const long L = (long)i * G + c; if (L >= nwg) return false;
        int wgid = (int)L; { const int q = nwg / NXCD, r = nwg % NXCD, xcd = wgid % NXCD, off = wgid / NXCD; wgid = (xcd < r ? xcd * (q + 1) : r * (q + 1) + (xcd - r) * q) + off; }
        const int nig = WGM * nN, gid = wgid / nig, fm = gid * WGM, gsz = (nM - fm) < WGM ? (nM - fm) : WGM;
        u.pm = fm + ((wgid % nig) % gsz); u.pn = (wgid % nig) / gsz; return true;
    }
    __device__ __forceinline__ void a_ready(const Unit&) const {}
    __device__ __forceinline__ void done(const Unit&) const {}
};


template <class Epi, class Sched, bool ALIGN_EPI = false, bool SP2 = false>
__device__ __forceinline__ void gemm_phase(PG8_LAS unsigned char* lds, const Gemm g, const Sched& S, const Epi& E, int wave_id  , unsigned long long& tacc_  ) {
    const int lane = (int)__builtin_amdgcn_mbcnt_hi(~0u, __builtin_amdgcn_mbcnt_lo(~0u, 0u)), wid = wave_id, tid = wid * 64 + lane, wr = wid >> 2, wc = wid & 3, fr = lane & 15, fq = lane >> 4;
    const int K = g.K, nt = K / BK;
    unsigned voffA[2], voffB[2];
#pragma unroll
    for (int i = 0; i < 2; ++i) { int R, C; stage_rc(tid * 16 + i * 8192, R, C); const int Rb = Epi::PERM ? ((R & ~31) + perm32(R & 31)) : R;
        voffA[i] = (unsigned)(R * K + C) * 2u; voffB[i] = (unsigned)(Rb * K + C) * 2u; }
    const size_t kstep = (size_t)(BK * 2);
    const size_t hstep = (size_t)HALF * K * 2;
    const size_t tstep = 2 * hstep;
    const unsigned ldsw = (unsigned)wid * 1024u;
    const int aoff = lds_byte(wr * 64 + fr, fq * 8), boff = lds_byte(wc * 32 + fr, fq * 8);
#define PG8_SA(b, h) (((b) * 2 + (h)) * HTB)
#define PG8_SB(b, h) ((4 + (b) * 2 + (h)) * HTB)
#define PG8_STAGE(bufoff, gbase, voff) do { _Pragma("unroll") for (int _i = 0; _i < 2; ++_i) \
        __builtin_amdgcn_global_load_lds((const unsigned*)((const char*)(gbase) + (voff)[_i]), (PG8_LAS unsigned*)(lds + (bufoff) + ldsw + _i * 8192), 16, 0, 0); } while (0)
#define PG8_LDA(dst, b, h) do { _Pragma("unroll") for (int m = 0; m < 4; ++m) _Pragma("unroll") for (int k = 0; k < 2; ++k) dst[m][k] = *(const PG8_LAS bf16x8*)(lds + PG8_SA(b, h) + aoff + m * 2048 + k * 1024); } while (0)
#define PG8_LDB(dst, b, h) do { _Pragma("unroll") for (int n = 0; n < 2; ++n) _Pragma("unroll") for (int k = 0; k < 2; ++k) dst[n][k] = *(const PG8_LAS bf16x8*)(lds + PG8_SB(b, h) + boff + n * 2048 + k * 1024); } while (0)
#define PG8_MMA(ai, bj, At, Bt) do { __builtin_amdgcn_s_setprio(1); _Pragma("unroll") for (int m = 0; m < 4; ++m) _Pragma("unroll") for (int n = 0; n < 2; ++n) _Pragma("unroll") for (int k = 0; k < 2; ++k) \
        acc[ai][bj][m][n] = __builtin_amdgcn_mfma_f32_16x16x32_bf16(Bt[n][k], At[m][k], acc[ai][bj][m][n], 0, 0, 0); __builtin_amdgcn_s_setprio(0); } while (0)
#define PG8_WAIT_V(n) asm volatile("s_waitcnt vmcnt(" #n ")" ::: "memory")
#define PG8_WAIT_L(n) asm volatile("s_waitcnt lgkmcnt(" #n ")" ::: "memory")
#define PG8_BAR __builtin_amdgcn_s_barrier()
#define PG8_SCHED __builtin_amdgcn_sched_barrier(0)
    Unit cur, nxt; int ui = 0;
    if (!S.next(0, cur)) return;
    f32x4 acc[2][2][4][2];
#pragma unroll
    for (int a = 0; a < 2; ++a)
#pragma unroll
        for (int b = 0; b < 2; ++b)
#pragma unroll
            for (int m = 0; m < 4; ++m)
#pragma unroll
                for (int n = 0; n < 2; ++n) acc[a][b][m][n] = (f32x4){0.f, 0.f, 0.f, 0.f};
    bf16x8 At[4][2], B0[2][2], B1[2][2];
    const char* cA = (const char*)g.A + (size_t)cur.pm * tstep; const char* cB = (const char*)g.Bt + (size_t)cur.pn * tstep;
    S.a_ready(cur);
    if constexpr (SP2) {
        PG8_STAGE(PG8_SB(0, 0), cB, voffB); PG8_STAGE(PG8_SB(0, 1), cB + hstep, voffB); PG8_STAGE(PG8_SA(0, 0), cA, voffA); PG8_STAGE(PG8_SA(0, 1), cA + hstep, voffA);
        if (wr == 1) PG8_BAR;
        PG8_WAIT_V(2); PG8_BAR;
        PG8_STAGE(PG8_SB(1, 0), cB + kstep, voffB); PG8_STAGE(PG8_SA(1, 0), cA + kstep, voffA); PG8_STAGE(PG8_SB(1, 1), cB + hstep + kstep, voffB);
        PG8_WAIT_V(6); PG8_BAR;
    } else {
        PG8_STAGE(PG8_SB(0, 0), cB, voffB); PG8_STAGE(PG8_SA(0, 0), cA, voffA); PG8_STAGE(PG8_SB(0, 1), cB + hstep, voffB); PG8_STAGE(PG8_SA(0, 1), cA + hstep, voffA);
        if (wr == 1) PG8_BAR;
        PG8_WAIT_V(4); PG8_BAR;
        PG8_STAGE(PG8_SB(1, 0), cB + kstep, voffB); PG8_STAGE(PG8_SA(1, 0), cA + kstep, voffA); PG8_STAGE(PG8_SB(1, 1), cB + hstep + kstep, voffB);
        PG8_WAIT_V(6); PG8_BAR;
    }
    for (;;) {
        const bool has_next = S.next(ui + 1, nxt);
        const char* nA = has_next ? (const char*)g.A + (size_t)nxt.pm * tstep : cA; const char* nB = has_next ? (const char*)g.Bt + (size_t)nxt.pn * tstep : cB;
        for (int t = 0; t < nt; t += 2) {
            const bool last = (t == nt - 2);
            const char* a1 = cA + (size_t)(t + 1) * kstep;
            const char* a2 = last ? nA : cA + (size_t)(t + 2) * kstep; const char* b2 = last ? nB : cB + (size_t)(t + 2) * kstep;
            const char* a3 = a2 + kstep; const char* b3 = b2 + kstep;
            if (last && has_next) S.a_ready(nxt);
            if constexpr (SP2) {
            PG8_LDB(B0, 0, 0); PG8_LDB(B1, 0, 1); PG8_SCHED; PG8_LDA(At, 0, 0); PG8_STAGE(PG8_SA(1, 1), a1 + hstep, voffA);
            PG8_WAIT_V(8); PG8_WAIT_L(0); PG8_BAR; PG8_MMA(0, 0, At, B0); PG8_MMA(0, 1, At, B1); PG8_BAR; PG8_SCHED;
            PG8_LDA(At, 0, 1); PG8_STAGE(PG8_SB(0, 0), b2, voffB); PG8_STAGE(PG8_SB(0, 1), b2 + hstep, voffB); PG8_STAGE(PG8_SA(0, 0), a2, voffA);
            PG8_WAIT_V(8); PG8_WAIT_L(0); PG8_BAR; PG8_MMA(1, 0, At, B0); PG8_MMA(1, 1, At, B1); PG8_BAR; PG8_SCHED;
            PG8_LDB(B0, 1, 0); PG8_LDB(B1, 1, 1); PG8_SCHED; PG8_LDA(At, 1, 0); PG8_STAGE(PG8_SA(0, 1), a2 + hstep, voffA);
            PG8_WAIT_V(8); PG8_WAIT_L(0); PG8_BAR; PG8_MMA(0, 0, At, B0); PG8_MMA(0, 1, At, B1); PG8_BAR; PG8_SCHED;
            PG8_LDA(At, 1, 1); PG8_STAGE(PG8_SB(1, 0), b3, voffB); PG8_STAGE(PG8_SB(1, 1), b3 + hstep, voffB); PG8_STAGE(PG8_SA(1, 0), a3, voffA);
            PG8_WAIT_V(8); PG8_WAIT_L(0); PG8_BAR; PG8_MMA(1, 0, At, B0); PG8_MMA(1, 1, At, B1); PG8_BAR; PG8_SCHED;
            } else {
            PG8_LDB(B0, 0, 0); PG8_SCHED; PG8_LDA(At, 0, 0); PG8_STAGE(PG8_SA(1, 1), a1 + hstep, voffA);
            PG8_WAIT_L(8); PG8_BAR; PG8_WAIT_L(0); PG8_MMA(0, 0, At, B0); PG8_BAR; PG8_SCHED;
            PG8_LDB(B1, 0, 1); PG8_STAGE(PG8_SB(0, 0), b2, voffB);
            PG8_BAR; PG8_WAIT_L(0); PG8_MMA(0, 1, At, B1); PG8_BAR;
            PG8_LDA(At, 0, 1); PG8_STAGE(PG8_SA(0, 0), a2, voffA);
            PG8_BAR; PG8_WAIT_L(0); PG8_MMA(1, 0, At, B0); PG8_BAR; PG8_SCHED;
            PG8_STAGE(PG8_SB(0, 1), b2 + hstep, voffB);
            PG8_WAIT_V(6); PG8_BAR; PG8_MMA(1, 1, At, B1); PG8_BAR;
            PG8_LDB(B0, 1, 0); PG8_SCHED; PG8_LDA(At, 1, 0); PG8_STAGE(PG8_SA(0, 1), a2 + hstep, voffA);
            PG8_WAIT_L(8); PG8_BAR; PG8_WAIT_L(0); PG8_MMA(0, 0, At, B0); PG8_BAR; PG8_SCHED;
            PG8_LDB(B1, 1, 1); PG8_STAGE(PG8_SB(1, 0), b3, voffB);
            PG8_BAR; PG8_WAIT_L(0); PG8_MMA(0, 1, At, B1); PG8_BAR;
            PG8_LDA(At, 1, 1); PG8_STAGE(PG8_SA(1, 0), a3, voffA);
            PG8_BAR; PG8_WAIT_L(0); PG8_MMA(1, 0, At, B0); PG8_BAR; PG8_SCHED;
            PG8_STAGE(PG8_SB(1, 1), b3 + hstep, voffB);
            PG8_WAIT_V(6); PG8_BAR; PG8_MMA(1, 1, At, B1); PG8_BAR;
            }
        }
        if constexpr (ALIGN_EPI) { if (wr == 0) PG8_BAR; }
#ifdef PROBE_EPI
        { const unsigned long long t0_ = __builtin_readcyclecounter(); E(acc, cur, wr, wc, fr, fq); asm volatile("s_waitcnt vmcnt(0)" ::: "memory"); tacc_ += __builtin_readcyclecounter() - t0_; S.done(cur); }
#else
        if constexpr (!Epi::AFTER_DRAIN) { E(acc, cur, wr, wc, fr, fq); S.done(cur); }
#endif
        if (!has_next) break;
#pragma unroll
        for (int a = 0; a < 2; ++a)
#pragma unroll
            for (int b = 0; b < 2; ++b)
#pragma unroll
                for (int m = 0; m < 4; ++m)
#pragma unroll
                    for (int n = 0; n < 2; ++n) acc[a][b][m][n] = (f32x4){0.f, 0.f, 0.f, 0.f};
        cur = nxt; cA = nA; cB = nB; ++ui;
        if constexpr (ALIGN_EPI) { if (wr == 1) PG8_BAR; }
    }
    PG8_WAIT_V(0);
    if constexpr (!ALIGN_EPI) { if (wr == 0) PG8_BAR; }
    PG8_BAR;
    if constexpr (Epi::AFTER_DRAIN) { E.fused(acc, cur, wr, wc, fr, fq, lds, wid, lane); S.done(cur); }
#undef PG8_SA
#undef PG8_SB
#undef PG8_STAGE
#undef PG8_LDA
#undef PG8_LDB
#undef PG8_MMA
#undef PG8_WAIT_V
#undef PG8_WAIT_L
#undef PG8_BAR
#undef PG8_SCHED
}
}
#define XB_TMO      128
#define XB_XCNT(j)  (256  + 64 * (j))
#define XB_XSUB(j)  (1280 + 64 * (j))
#define XB_XGEN(j)  (2304 + 64 * (j))
#define XB_TOP      3328
#define XB_TOPGEN   3392
#define XCD_BAR_WORDS 3456
#define XB_SPIN_CAP (1u << 18)

__device__ __forceinline__ unsigned xb_ld(unsigned* p)              { return __hip_atomic_load(p, __ATOMIC_RELAXED, __HIP_MEMORY_SCOPE_AGENT); }
__device__ __forceinline__ unsigned xb_add(unsigned* p, unsigned v) { return __hip_atomic_fetch_add(p, v, __ATOMIC_RELAXED, __HIP_MEMORY_SCOPE_AGENT); }
__device__ __forceinline__ unsigned xb_xcc_id() { return (unsigned)__builtin_amdgcn_s_getreg((3 << 11) | 20) & 0xFu; }
#define XB_SPIN(cond, bar) do { unsigned _sp = 0; while (cond) { __builtin_amdgcn_s_sleep(1); \
    if ((++_sp & 255u) == 0u) { if (xb_ld(&(bar)[XB_TMO])) break; if (_sp > XB_SPIN_CAP) { atomicAdd(&(bar)[XB_TMO], 1u); break; } } } } while (0)

struct XcdBarrier {
    unsigned* bar; unsigned x;
    volatile LAS unsigned* st;
};

__device__ __forceinline__ XcdBarrier xcd_barrier_post(unsigned* bar, volatile LAS unsigned* st) {
    XcdBarrier b; b.bar = bar; b.x = xb_xcc_id(); b.st = st;
    if (threadIdx.x == 0) (void)xb_add(&bar[XB_XCNT(b.x)], 1u);
    return b;
}
__device__ __forceinline__ void xcd_barrier_complete(unsigned* bar, unsigned x, unsigned& nloc, unsigned& nx) {
    const unsigned G = gridDim.x * gridDim.y * gridDim.z;
    unsigned sum, cnt, mine, sp = 0u;
    for (;;) {
        sum = 0u; cnt = 0u; mine = 0u;
#pragma unroll
        for (unsigned j = 0; j < 16; ++j) { const unsigned c = xb_ld(&bar[XB_XCNT(j)]); sum += c; cnt += (c > 0u) ? 1u : 0u; mine = (j == x) ? c : mine; }
        if (sum == G) break;
        __builtin_amdgcn_s_sleep(1);
        if ((++sp & 255u) == 0u) { if (xb_ld(&bar[XB_TMO])) break; if (sp > XB_SPIN_CAP) { atomicAdd(&bar[XB_TMO], 1u); break; } }
    }
    nloc = mine > 0u ? mine : 1u; nx = cnt > 0u ? cnt : 1u;
}

__device__ __forceinline__ void xcd_barrier(const XcdBarrier& b, bool leader  ) {
    asm volatile("s_waitcnt vmcnt(0)" ::: "memory");
    __syncthreads();
    if (leader) {
        unsigned* bar = b.bar;
        __builtin_amdgcn_s_waitcnt(0);
        unsigned nloc = b.st[0], nx = b.st[1];
        if (nloc == 0u) { xcd_barrier_complete(bar, b.x, nloc, nx); b.st[0] = nloc; b.st[1] = nx; }
        const unsigned old = xb_add(&bar[XB_XSUB(b.x)], 1u);
        const unsigned gen = old / nloc;
        if (old + 1u == (gen + 1u) * nloc) {
            __builtin_amdgcn_fence(__ATOMIC_RELEASE, "agent");
            asm volatile("s_waitcnt vmcnt(0)" ::: "memory");
            const unsigned og = xb_add(&bar[XB_TOP], 1u);
            const unsigned tg = og / nx;
            if (og + 1u == (tg + 1u) * nx) xb_add(&bar[XB_TOPGEN], 1u);
            else XB_SPIN(xb_ld(&bar[XB_TOPGEN]) == tg, bar);
            __builtin_amdgcn_fence(__ATOMIC_ACQUIRE, "agent");
            xb_add(&bar[XB_XGEN(b.x)], 1u);
            asm volatile("s_waitcnt vmcnt(0)" ::: "memory");
        } else {
            XB_SPIN(xb_ld(&bar[XB_XGEN(b.x)]) == gen, bar);
            __builtin_amdgcn_fence(__ATOMIC_ACQUIRE, "agent");
            asm volatile("s_waitcnt vmcnt(0)" ::: "memory");
        }
    }
    __syncthreads();
}
using pg8::f32x4; using pg8::bf16x8;
constexpr int NWAVES = 8;
constexpr int BATCH = 4, T = 8192, D = 1024, M = BATCH * T, NP = 4096, INW = 3864;
constexpr int DECB = 32, PAST = 16384, NPAGES = 128, NCS = 512  ;
constexpr float NORM_EPS = 1e-6f;
constexpr float LOG2E = 1.4426950408889634f;
constexpr float QSCALE = 0.125f * LOG2E;
constexpr size_t O_Y = 0, O_YS = 33554432, O_PCMP = 33587200, O_PSLC = 41975808, O_PWIN = 50364416, O_PCONV = 50888704,
                 O_SCMP = 50892800, O_SSLC = 50900992, O_SWIN = 50909184, O_SCONV = 55103488, O_END = 55136256;
constexpr int C_BG = 0, C_CG = 512, C_CI = 1024, C_ZC = 1536, C_Q = 2048, C_KV = 2560, C_GL = 3328, C_ZA = 3352;

constexpr size_t MiB = 1u << 20, KiB = 1u << 10;
constexpr size_t WS_CTL = 0, CTL_ZERO_BYTES = 1 * MiB;
constexpr size_t WS_BT1 = 2 * MiB;
constexpr size_t WS_BT2 = 10 * MiB;
constexpr size_t WS_BTC = 12 * MiB;
constexpr size_t WS_CBIAS = 12 * MiB + 512 * KiB;
constexpr size_t WS_CONST = WS_CBIAS + 4 * KiB;
constexpr size_t WS_ROPE = 13 * MiB;
constexpr size_t WS_RSTD = 16 * MiB;
constexpr size_t WS_XSB = 16 * MiB + 256 * KiB;
constexpr size_t WS_RSTDS = WS_XSB + 64 * KiB;
constexpr size_t WS_GATE = 17 * MiB;
constexpr size_t WS_KC = 20 * MiB;
constexpr size_t WS_VCT = WS_KC + 256 * KiB;
constexpr size_t WS_PROJS = 21 * MiB;
constexpr size_t WS_QS = 22 * MiB;
constexpr size_t WS_KVN = WS_QS + 64 * KiB;
constexpr size_t WS_GS = WS_KVN + 96 * KiB;
constexpr size_t WS_ZAS = WS_GS + 4 * KiB;
constexpr size_t WS_MIXS = WS_ZAS + 64 * KiB;
constexpr size_t WS_KCS = 24 * MiB;
constexpr size_t WS_KS = 40 * MiB, WS_VTS = 48 * MiB, WS_KW = 56 * MiB, WS_VTW = 64 * MiB;
constexpr size_t WS_XB = 72 * MiB;
constexpr size_t WS_CG = 136 * MiB, WS_U = 168 * MiB, WS_ZA = 200 * MiB, WS_Q = 232 * MiB;
constexpr size_t WS_MIX = 264 * MiB;
constexpr size_t WS_TOT = 328 * MiB;
constexpr size_t WS_END = 344 * MiB;
constexpr int CW_TMO = 0, CW_CODE = 1;
constexpr int CW_BAR = 4096;
constexpr int CW_QUEUE = 16384;
constexpr int CW_P0CNT = 18432;
constexpr int CW_KCMAX = 20480;

constexpr int RING_OFF = 0, RING_BYTES = 131072;
constexpr int LDSCTL_OFF = RING_BYTES, MISC_OFF = LDSCTL_OFF + 320;
constexpr int LDS_BYTES = 147456;

__device__ __forceinline__ unsigned f2bf(float f) { unsigned u = __builtin_bit_cast(unsigned, f); return (u + 0x7fffu + ((u >> 16) & 1u)) >> 16; }
typedef __bf16 bf16x2_t __attribute__((ext_vector_type(2)));
__device__ __forceinline__ unsigned pk2(float lo, float hi) { return __builtin_bit_cast(unsigned, __builtin_convertvector((f32x2){lo, hi}, bf16x2_t)); }
__device__ __forceinline__ float bf2f(unsigned h) { return __builtin_bit_cast(float, h << 16); }
__device__ __forceinline__ float wave_sum(float v) {
#pragma unroll
    for (int o = 1; o < 64; o <<= 1) v += __shfl_xor(v, o);
    return v;
}
__device__ __forceinline__ float quad_sum(float v) {
    v += __builtin_bit_cast(float, __builtin_amdgcn_update_dpp(0, __builtin_bit_cast(int, v), 0xB1, 0xF, 0xF, true));
    v += __builtin_bit_cast(float, __builtin_amdgcn_update_dpp(0, __builtin_bit_cast(int, v), 0x4E, 0xF, 0xF, true));
    return v;
}
__device__ __forceinline__ float fast_exp2(float x) { return __builtin_amdgcn_exp2f(x); }
__device__ __forceinline__ float sigmoidf(float x) { return __builtin_amdgcn_rcpf(1.0f + fast_exp2(-x * LOG2E)); }
__device__ __forceinline__ int perm16(int kk) { return 8 * ((kk >> 2) & 1) + 4 * (kk >> 3) + (kk & 3); }

struct Ptrs {
    const float *xp, *xs, *cache_cmp, *cache_slc, *st_win, *st_conv; const int* page_table;
    const float *norm_g, *w_in, *conv_w, *conv_b, *q_gain, *k_gain, *cmp_pe, *cmp_w, *w_out;
    float* out; unsigned char* ws;
};
struct Frame {
    LAS unsigned char* lds;
    volatile LAS unsigned* MISC;
    gu32* ctl;
    int tid, lane, wave, G, gw, NGW;
};
__device__ __forceinline__ int bt1_src(int dg, int& nvalid) {
    const int pn = dg >> 3, gi = dg & 7, bj = gi >> 2, wc = gi & 3; nvalid = 32;
    if (pn < 4) return (bj ? C_ZC : C_BG) + 128 * pn + 32 * wc;
    if (pn < 8) return (bj ? C_CI : C_CG) + 128 * (pn - 4) + 32 * wc;
    if (pn < 10) return C_Q + (4 * (pn - 8) + wc) * 64 + 32 * bj;
    if (pn < 13) return C_KV + (pn - 10) * 256 + wc * 64 + 32 * bj;
    if (pn < 15) return C_ZA + 256 * (pn - 13) + 32 * gi;
    nvalid = (gi == 0) ? 24 : 0; return C_GL;
}
__device__ __forceinline__ void p0_transpose_item(const float* W, int ldw, int k0, int src0, int nvalid, const float* ksc, bf16* WT, int ldt, int drow0, LAS float* scr, int lane) {
    const int nn = lane & 31;
#pragma unroll 8
    for (int i = 0; i < 32; ++i) { const int kk = 2 * i + (lane >> 5); float v = 0.f;
        if (nn < nvalid) { v = W[(size_t)(k0 + kk) * ldw + src0 + nn]; if (ksc) v *= ksc[k0 + kk]; }
        scr[kk * 33 + nn] = v; }
    LDS_WAIT(); asm volatile("" ::: "memory");
    const int c = lane & 7;
#pragma unroll
    for (int j = 0; j < 4; ++j) { const int n = (lane >> 3) + 8 * j; const LAS float* s = scr + (8 * c) * 33 + n;
        v4u o; o.x = pk2(s[0 * 33], s[1 * 33]); o.y = pk2(s[2 * 33], s[3 * 33]); o.z = pk2(s[4 * 33], s[5 * 33]); o.w = pk2(s[6 * 33], s[7 * 33]);
        *(GAS v4u*)(WT + (size_t)(drow0 + n) * ldt + k0 + 8 * c) = o; }
    LDS_WAIT(); asm volatile("" ::: "memory");
}
template <int NR>
__device__ __forceinline__ void x_rows_to_bf16(const float* xrow, bf16* orow, float* rstd_out, int lane) {
    f32x4 v[NR][4]; float s[NR];
#pragma unroll
    for (int r = 0; r < NR; ++r)
#pragma unroll
        for (int j = 0; j < 4; ++j) v[r][j] = ((const GAS f32x4*)(xrow + (size_t)r * D) + lane)[64 * j];
#pragma unroll
    for (int r = 0; r < NR; ++r) { s[r] = 0.f;
#pragma unroll
        for (int j = 0; j < 4; ++j) s[r] += (v[r][j].x * v[r][j].x + v[r][j].y * v[r][j].y) + (v[r][j].z * v[r][j].z + v[r][j].w * v[r][j].w); }
#pragma unroll
    for (int o = 1; o < 64; o <<= 1)
#pragma unroll
        for (int r = 0; r < NR; ++r) s[r] += __shfl_xor(s[r], o);
#pragma unroll
    for (int r = 0; r < NR; ++r) { GAS unsigned long long* o8 = (GAS unsigned long long*)(orow + (size_t)r * D) + lane;
#pragma unroll
        for (int j = 0; j < 4; ++j) o8[64 * j] = (unsigned long long)pk2(v[r][j].x, v[r][j].y) | ((unsigned long long)pk2(v[r][j].z, v[r][j].w) << 32);
        if (lane == 0) rstd_out[r] = 1.0f / sqrtf(s[r] * (1.0f / D) + NORM_EPS); }
}
template <bool SAMPLE>
__device__ __forceinline__ const float* cmp_rowbase(const Ptrs& P, int unit, int rho) {
    const int b = SAMPLE ? unit >> 6 : unit >> 5, c = (SAMPLE ? (unit & 63) : (unit & 31)) * 8 + (rho >> 1), g = rho & 1;
    if (SAMPLE) { const int page = P.page_table[b * NPAGES + (c >> 2)]; return P.cache_cmp + ((size_t)page * 128 + (c & 3) * 32) * 256 + g * 64; }
    return P.out + O_PCMP + ((size_t)b * T + c * 32) * 256 + g * 64;
}
template <bool SAMPLE>
__device__ __forceinline__ void compress_units(const Ptrs& P, Frame& F, LAS float* part  ) {
    constexpr int NUNITS = SAMPLE ? DECB * (NCS / 8) : BATCH * 32;
    const int lane = F.lane, w = F.wave, rho = lane & 15, kq = lane >> 4;
    const GAS v4u* bfr = (const GAS v4u*)(P.ws + WS_BTC) + lane;
    const float* cbias = (const float*)(P.ws + WS_CBIAS);
    int unit = blockIdx.x;
    if (unit >= NUNITS) return;
    f32x4 a_cur[8], a_n1[8], a_n2[8];
    const float* rb = cmp_rowbase<SAMPLE>(P, unit, rho) + 4 * kq;
#define CMP_LOAD(dst, base, r) do { _Pragma("unroll") for (int q_ = 0; q_ < 4; ++q_) { dst[2 * q_] = *(const GAS f32x4*)((base) + (r) * 256 + (q_ >> 1) * 128 + (q_ & 1) * 32); dst[2 * q_ + 1] = *(const GAS f32x4*)((base) + (r) * 256 + (q_ >> 1) * 128 + (q_ & 1) * 32 + 16); } } while (0)
    CMP_LOAD(a_cur, rb, 4 * w); CMP_LOAD(a_n1, rb, 4 * w + 1);
    for (;;) {
        f32x4 acc[2][4];
#pragma unroll
        for (int j = 0; j < 2; ++j)
#pragma unroll
            for (int e = 0; e < 4; ++e) acc[j][e] = (f32x4){0.f, 0.f, 0.f, 0.f};
        const int nunit = unit + F.G; const bool has_next = nunit < NUNITS;
        const float* rbn = has_next ? cmp_rowbase<SAMPLE>(P, nunit, rho) + 4 * kq : rb;
#pragma unroll 1
        for (int rr = 0; rr < 4; ++rr) {
            const int r = 4 * w + rr;
            bf16x8 bb[16];
#pragma unroll
            for (int q_ = 0; q_ < 4; ++q_)
#pragma unroll
                for (int et = 0; et < 4; ++et) bb[q_ * 4 + et] = __builtin_bit_cast(bf16x8, bfr[(size_t)(((((q_ >> 1) * 32 + r) * 2 + (q_ & 1)) * 4 + et) * 64)]);
            __builtin_amdgcn_sched_barrier(0);
            { const float* nb_ = rr < 2 ? rb : rbn; const int nr_ = rr < 2 ? r + 2 : 4 * w + (rr - 2); CMP_LOAD(a_n2, nb_, nr_); }
            __builtin_amdgcn_sched_barrier(0);
#pragma unroll
            for (int q_ = 0; q_ < 4; ++q_) { const int j = q_ >> 1;
                v4u wv; wv.x = pk2(a_cur[2 * q_].x, a_cur[2 * q_].y); wv.y = pk2(a_cur[2 * q_].z, a_cur[2 * q_].w); wv.z = pk2(a_cur[2 * q_ + 1].x, a_cur[2 * q_ + 1].y); wv.w = pk2(a_cur[2 * q_ + 1].z, a_cur[2 * q_ + 1].w);
                const bf16x8 af = __builtin_bit_cast(bf16x8, wv);
#pragma unroll
                for (int et = 0; et < 4; ++et) acc[j][et] = __builtin_amdgcn_mfma_f32_16x16x32_bf16(af, bb[q_ * 4 + et], acc[j][et], 0, 0, 0); }
#pragma unroll
            for (int q_ = 0; q_ < 8; ++q_) { a_cur[q_] = a_n1[q_]; a_n1[q_] = a_n2[q_]; }
        }
#pragma unroll
        for (int j = 0; j < 2; ++j)
#pragma unroll
            for (int et = 0; et < 4; ++et) *(LAS f32x4*)(part + ((w * 8 + j * 4 + et) * 64 + lane) * 4) = acc[j][et];
        __syncthreads();
        { const int j = w >> 2, et = w & 3, e = 16 * et + rho; f32x4 sum = *(const LAS f32x4*)(part + ((0 * 8 + w) * 64 + lane) * 4);
#pragma unroll
          for (int ww = 1; ww < 8; ++ww) sum = sum + *(const LAS f32x4*)(part + ((ww * 8 + w) * 64 + lane) * 4);
          const float bs = cbias[j * 64 + e]; const int b = SAMPLE ? unit >> 6 : unit >> 5, c0 = (SAMPLE ? (unit & 63) : (unit & 31)) * 8;
          float nmax = 0.f;
#pragma unroll
          for (int i = 0; i < 4; ++i) { const int row = 4 * kq + i, c = c0 + (row >> 1), g = row & 1; const float val = sum[i] + bs;
              float q2 = val * val; q2 += __shfl_xor(q2, 1); q2 += __shfl_xor(q2, 2); q2 += __shfl_xor(q2, 4); q2 += __shfl_xor(q2, 8); nmax = fmaxf(nmax, q2);
              if (SAMPLE) ((float*)(P.ws + WS_KCS))[((size_t)((b * 2 + g) * 2 + j) * NCS + c) * 64 + e] = val;
              else if (j == 0) ((bf16*)(P.ws + WS_KC))[((size_t)(b * 2 + g) * 256 + c) * 64 + e] = (bf16)f2bf(val);
              else ((bf16*)(P.ws + WS_VCT))[((size_t)(b * 2 + g) * 64 + e) * 256 + (c & ~15) + perm16(c & 15)] = (bf16)f2bf(val); }
          if (j == 0) { nmax = fmaxf(nmax, __shfl_xor(nmax, 16)); nmax = fmaxf(nmax, __shfl_xor(nmax, 32));
              if (lane == 0) atomicMax((unsigned*)(P.ws + WS_CTL) + CW_KCMAX + (SAMPLE ? 64 : 0) + et, __builtin_bit_cast(unsigned, nmax)); } }
        __syncthreads();
        if (!has_next) break;
        unit = nunit; rb = rbn;
    }
#undef CMP_LOAD
}
__device__ __forceinline__ void compress_sample_pass(const Ptrs& P, Frame& F, LAS unsigned char* bl  ) {
    const int lane = F.lane, w = F.wave, tid = F.tid, rho = lane & 15, kq = lane >> 4;
    for (int pass = blockIdx.x; pass < DECB * 8; pass += F.G) {
    __syncthreads();
    const int b = pass >> 3, c0 = (pass & 7) * 64 + w * 8;
    const float* rb; { const int c = c0 + (rho >> 1), g = rho & 1; const int page = P.page_table[b * NPAGES + (c >> 2)]; rb = P.cache_cmp + ((size_t)page * 128 + (c & 3) * 32) * 256 + g * 64 + 4 * kq; }
    const GAS v4u* bsrc = (const GAS v4u*)(P.ws + WS_BTC);
    const int sf = tid >> 5, sj = sf >> 3, sdh = (sf >> 2) & 1, set_ = sf & 3, sl = (tid & 31) * 2;
#define B_SRC(r) (bsrc + (size_t)((((sj * 32 + (r)) * 2 + sdh) * 4 + set_) * 64 + sl))
    LAS v4u* bdst = (LAS v4u*)bl + sf * 64 + sl;
    f32x4 a_cur[8], a_n1[8], a_n2[8];
#define CMP_LOAD(dst, base, r) do { _Pragma("unroll") for (int q_ = 0; q_ < 4; ++q_) { dst[2 * q_] = *(const GAS f32x4*)((base) + (r) * 256 + (q_ >> 1) * 128 + (q_ & 1) * 32); dst[2 * q_ + 1] = *(const GAS f32x4*)((base) + (r) * 256 + (q_ >> 1) * 128 + (q_ & 1) * 32 + 16); } } while (0)
    { const v4u b0 = B_SRC(0)[0], b1 = B_SRC(0)[1]; bdst[0] = b0; bdst[1] = b1; }
    CMP_LOAD(a_cur, rb, 0); CMP_LOAD(a_n1, rb, 1);
    f32x4 acc[2][4];
#pragma unroll
    for (int j = 0; j < 2; ++j)
#pragma unroll
        for (int e = 0; e < 4; ++e) acc[j][e] = (f32x4){0.f, 0.f, 0.f, 0.f};
    __syncthreads();
#pragma unroll 1
    for (int r = 0; r < 32; ++r) {
        const int rn = r + 1 < 32 ? r + 1 : 31, r2 = r + 2 < 32 ? r + 2 : 31;
        const v4u b0 = B_SRC(rn)[0], b1 = B_SRC(rn)[1];
        __builtin_amdgcn_sched_barrier(0);
        CMP_LOAD(a_n2, rb, r2);
        __builtin_amdgcn_sched_barrier(0);
        const LAS v4u* bf = (const LAS v4u*)bl + (r & 1) * 1024 + lane;
#pragma unroll
        for (int q_ = 0; q_ < 4; ++q_) { const int j = q_ >> 1;
            v4u wv; wv.x = pk2(a_cur[2 * q_].x, a_cur[2 * q_].y); wv.y = pk2(a_cur[2 * q_].z, a_cur[2 * q_].w); wv.z = pk2(a_cur[2 * q_ + 1].x, a_cur[2 * q_ + 1].y); wv.w = pk2(a_cur[2 * q_ + 1].z, a_cur[2 * q_ + 1].w);
            const bf16x8 af = __builtin_bit_cast(bf16x8, wv);
#pragma unroll
            for (int et = 0; et < 4; ++et) acc[j][et] = __builtin_amdgcn_mfma_f32_16x16x32_bf16(af, __builtin_bit_cast(bf16x8, bf[(q_ * 4 + et) * 64]), acc[j][et], 0, 0, 0); }
        { LAS v4u* d_ = bdst + ((r + 1) & 1) * 1024; d_[0] = b0; d_[1] = b1; }
#pragma unroll
        for (int q_ = 0; q_ < 8; ++q_) { a_cur[q_] = a_n1[q_]; a_n1[q_] = a_n2[q_]; }
        __syncthreads();
    }
#undef CMP_LOAD
#undef B_SRC
    const float* cbias = (const float*)(P.ws + WS_CBIAS);
    float nmax = 0.f;
#pragma unroll
    for (int i = 0; i < 4; ++i) { const int row = 4 * kq + i, c = c0 + (row >> 1), g = row & 1; float q2 = 0.f;
#pragma unroll
        for (int j = 0; j < 2; ++j)
#pragma unroll
            for (int et = 0; et < 4; ++et) { const int e = 16 * et + rho; const float val = acc[j][et][i] + cbias[j * 64 + e]; if (j == 0) q2 += val * val;
                ((float*)(P.ws + WS_KCS))[((size_t)((b * 2 + g) * 2 + j) * NCS + c) * 64 + e] = val; }
        q2 += __shfl_xor(q2, 1); q2 += __shfl_xor(q2, 2); q2 += __shfl_xor(q2, 4); q2 += __shfl_xor(q2, 8); nmax = fmaxf(nmax, q2); }
    nmax = fmaxf(nmax, __shfl_xor(nmax, 16)); nmax = fmaxf(nmax, __shfl_xor(nmax, 32));
    if (lane == 0) atomicMax((unsigned*)(P.ws + WS_CTL) + CW_KCMAX + 64, __builtin_bit_cast(unsigned, nmax));
    }
}
constexpr int P0_PRODUCERS = 641;
__device__ __forceinline__ void p0_small_items(const Ptrs& P, Frame& F) {
    const int lane = F.lane, gw = F.gw;
    if (gw >= P0_PRODUCERS && F.NGW >= P0_PRODUCERS) return;
    for (int item = gw; item < P0_PRODUCERS; item += F.NGW) {
        if (item < 512) { const int it = item * 64 + lane; const int l = it & 63, et = (it >> 6) & 3, dh = (it >> 8) & 1, r = (it >> 9) & 31, j = it >> 14;
            const float* w = P.cmp_w + ((size_t)(r * 2 + j) * 64 + 32 * dh + 4 * (l >> 4)) * 64 + 16 * et + (l & 15);
            v4u o; o.x = pk2(w[0], w[64]); o.y = pk2(w[128], w[192]); o.z = pk2(w[16 * 64], w[17 * 64]); o.w = pk2(w[18 * 64], w[19 * 64]);
            __builtin_amdgcn_raw_buffer_store_b128(o, __builtin_amdgcn_make_buffer_rsrc((void*)(P.ws + WS_BTC), 0, 512 * 1024, 0x00020000), it * 16, 0, 16);
        } else if (item < 640) { const int it = item - 512, j = it >> 6, e = it & 63; float s = 0.f;
            for (int k = lane; k < 2048; k += 64) { const int r = k >> 6, d = k & 63; s += P.cmp_pe[(r * 2 + j) * 64 + d] * P.cmp_w[((size_t)(r * 2 + j) * 64 + d) * 64 + e]; }
            s = wave_sum(s); if (lane == 0) __hip_atomic_store((float*)(P.ws + WS_CBIAS) + it, s, RLX_AGENT);
        } else { float qm = fabsf(P.q_gain[lane]), k1 = fabsf(P.k_gain[64 + lane]), k2 = fabsf(P.k_gain[128 + lane]);
#pragma unroll
            for (int o = 1; o < 64; o <<= 1) { qm = fmaxf(qm, __shfl_xor(qm, o)); k1 = fmaxf(k1, __shfl_xor(k1, o)); k2 = fmaxf(k2, __shfl_xor(k2, o)); }
            if (lane == 0) { float* cst = (float*)(P.ws + WS_CONST); __hip_atomic_store(cst + 0, qm, RLX_AGENT); __hip_atomic_store(cst + 1, 8.0f * qm * k1 * LOG2E * 1.001f, RLX_AGENT); __hip_atomic_store(cst + 2, 8.0f * qm * k2 * LOG2E * 1.001f, RLX_AGENT); } }
        asm volatile("s_waitcnt vmcnt(0)" ::: "memory");
        if (lane == 0) __hip_atomic_fetch_add((unsigned*)(F.ctl + CW_P0CNT), 1u, RLX_AGENT);
    }
}
__device__ __forceinline__ void p0_rope(const Ptrs& P, Frame& F) {
    const int lane = F.lane, gw = F.gw, NGW = F.NGW; const int i = lane & 31;
    const float inv = (float)pow(10000.0, -(double)i / 32.0);
    for (int it = gw * 64 + lane; it < 8193 * 32; it += NGW * 64) { const int p = it >> 5; const int pos = (p == 8192) ? PAST : p;
        const float ang = (float)pos * inv; const double rev = (double)ang * 0.15915494309189535; const float fr = (float)(rev - __builtin_rint(rev));
        float* rt = (float*)(P.ws + WS_ROPE) + (size_t)p * 64; rt[i] = __builtin_amdgcn_cosf(fr); rt[32 + i] = __builtin_amdgcn_sinf(fr); }
}
__device__ __forceinline__ void p0_phase(const Ptrs& P, Frame& F) {
    LAS float* scr = (LAS float*)(F.lds + RING_OFF + F.wave * 16384);
    const int lane = F.lane;
    p0_small_items(P, F);
    p0_rope(P, F);
    const int gw = F.gw, NGW = F.NGW;
    for (int it = gw; it < 16 * 128; it += NGW) { const int kb = it >> 7, dg = it & 127; int nv; const int src0 = bt1_src(dg, nv);
        p0_transpose_item(P.w_in, INW, 64 * kb, src0, nv, P.norm_g, (bf16*)(P.ws + WS_BT1), D, 32 * dg, scr, lane); }
    for (int it = gw; it < 16 * 32; it += NGW) { const int kb = it >> 5, nb = it & 31;
        p0_transpose_item(P.w_out, D, 64 * kb, 32 * nb, 32, nullptr, (bf16*)(P.ws + WS_BT2), D, 32 * nb, scr, lane); }
    for (int m = gw * 4; m < M; m += NGW * 4) x_rows_to_bf16<4>(P.xp + (size_t)m * D, (bf16*)(P.ws + WS_XB) + (size_t)m * D, (float*)(P.ws + WS_RSTD) + m, lane);
    for (int m = gw; m < DECB; m += NGW) x_rows_to_bf16<1>(P.xs + (size_t)m * D, (bf16*)(P.ws + WS_XSB) + (size_t)m * D, (float*)(P.ws + WS_RSTDS) + m, lane);
    { constexpr int PERB = 511 * 64, TOTAL = DECB * PERB; const GAS f32x4* src = (const GAS f32x4*)P.st_win; GAS f32x4* dst = (GAS f32x4*)(P.out + O_SWIN);
      for (int i0 = gw * 64 + lane; i0 < TOTAL; i0 += NGW * 64 * 8) { f32x4 t[8];
#pragma unroll
        for (int u = 0; u < 8; ++u) { const int i = i0 + u * NGW * 64; if (i < TOTAL) { const int b = i / PERB; t[u] = src[i + 64 * b + 64]; } }
#pragma unroll
        for (int u = 0; u < 8; ++u) { const int i = i0 + u * NGW * 64; if (i < TOTAL) { const int b = i / PERB; dst[i + 64 * b] = t[u]; } } } }
    for (int it = gw * 64 + lane; it < DECB * 512; it += NGW * 64) { const int b = it >> 9, ch = it & 511; P.out[O_SCONV + (size_t)b * 1024 + ch] = P.st_conv[(size_t)b * 1024 + 512 + ch]; }
    if (F.wave == 0) { if (lane == 0) { unsigned sp = 0u; while (__hip_atomic_load((unsigned*)(F.ctl + CW_P0CNT), RLX_AGENT) < (unsigned)P0_PRODUCERS) { __builtin_amdgcn_s_sleep(2); if (++sp > (1u << 22)) break; } }
        __builtin_amdgcn_fence(__ATOMIC_ACQUIRE, "agent"); asm volatile("s_waitcnt vmcnt(0)" ::: "memory"); }
    __syncthreads();
    compress_sample_pass(P, F, F.lds + RING_OFF);
}
struct EpiIn {
    static constexpr bool PERM = false, AFTER_DRAIN = false;
    const float *rstd, *rope, *qg, *kg; float* out; unsigned char* ws;
    __device__ __forceinline__ void operator()(const f32x4 (&acc)[2][2][4][2], const pg8::Unit& u, int wr, int wc, int fr, int fq) const {
        asm volatile("" : "+v"(fr), "+v"(fq));
        const int pn = u.pn; const int rbase = u.pm * 256 + wr * 64 + fr;
        if (pn < 8) {
            const bool bz = pn < 4; bf16* dst = (bf16*)(ws + (bz ? WS_CG : WS_U)); const int col0 = 128 * (pn & 3) + 32 * wc + 4 * fq;
#pragma unroll
            for (int ai = 0; ai < 2; ++ai)
#pragma unroll
                for (int m = 0; m < 4; ++m) { const int row = rbase + ai * 128 + m * 16; const float rs = rstd[row];
#pragma unroll
                    for (int n = 0; n < 2; ++n) { const f32x4 a = acc[ai][0][m][n] * rs, z = acc[ai][1][m][n] * rs; f32x4 o;
                        if (bz) { o.x = a.x * z.x * sigmoidf(z.x); o.y = a.y * z.y * sigmoidf(z.y); o.z = a.z * z.z * sigmoidf(z.z); o.w = a.w * z.w * sigmoidf(z.w); }
                        else o = a * z;
                        v2u w; w.x = pk2(o.x, o.y); w.y = pk2(o.z, o.w);
                        *(GAS v2u*)(dst + (size_t)row * 512 + col0 + 16 * n) = w;
                        if (!bz) { const int t = row & (T - 1); if (t >= T - 2) *(GAS f32x4*)(out + O_PCONV + ((size_t)(row >> 13) * 2 + (t - (T - 2))) * 512 + col0 + 16 * n) = o; } } }
        } else if (pn < 13) {
            const bool isq = pn < 10; const int br = pn - 10; const bool isk = !isq && wc < 2;
            if (isq || isk) {
                const float* gain = isq ? qg : kg + br * 64; float g1[2][4], g2[2][4];
#pragma unroll
                for (int n = 0; n < 2; ++n)
#pragma unroll
                    for (int e = 0; e < 4; ++e) { g1[n][e] = gain[16 * n + 4 * fq + e]; g2[n][e] = gain[32 + 16 * n + 4 * fq + e]; }
#pragma unroll
                for (int ai = 0; ai < 2; ++ai)
#pragma unroll
                    for (int m = 0; m < 4; ++m) { const int row = rbase + ai * 128 + m * 16; const float rs = rstd[row]; const int t = row & (T - 1), b = row >> 13;
                        f32x4 x1[2], x2[2]; float ss = 0.f;
#pragma unroll
                        for (int n = 0; n < 2; ++n) { x1[n] = acc[ai][0][m][n] * rs; x2[n] = acc[ai][1][m][n] * rs;
                            ss += (x1[n].x * x1[n].x + x1[n].y * x1[n].y) + (x1[n].z * x1[n].z + x1[n].w * x1[n].w) + (x2[n].x * x2[n].x + x2[n].y * x2[n].y) + (x2[n].z * x2[n].z + x2[n].w * x2[n].w); }
                        ss += __shfl_xor(ss, 16); ss += __shfl_xor(ss, 32);
                        const float inv = 1.0f / sqrtf(ss * (1.0f / 64.0f) + NORM_EPS);
                        const float* rp = rope + (size_t)t * 64 + 4 * fq;
#pragma unroll
                        for (int n = 0; n < 2; ++n) { const f32x4 cs = *(const GAS f32x4*)(rp + 16 * n), sn = *(const GAS f32x4*)(rp + 32 + 16 * n); f32x4 o1, o2;
#pragma unroll
                            for (int e = 0; e < 4; ++e) { const float a = x1[n][e] * inv * g1[n][e], c = x2[n][e] * inv * g2[n][e]; o1[e] = a * cs[e] - c * sn[e]; o2[e] = c * cs[e] + a * sn[e]; }
                            const int d1 = 16 * n + 4 * fq;
                            if (isq) { o1 = o1 * QSCALE; o2 = o2 * QSCALE; bf16* q = (bf16*)(ws + WS_Q) + (size_t)row * 512 + (4 * (pn - 8) + wc) * 64 + d1;
                                v2u w; w.x = pk2(o1.x, o1.y); w.y = pk2(o1.z, o1.w); *(GAS v2u*)q = w; w.x = pk2(o2.x, o2.y); w.y = pk2(o2.z, o2.w); *(GAS v2u*)(q + 32) = w; }
                            else { const int g = wc;
                                if (br > 0) { bf16* k = (bf16*)(ws + (br == 1 ? WS_KS : WS_KW)) + ((size_t)(b * 2 + g) * T + t) * 64 + d1;
                                    v2u w; w.x = pk2(o1.x, o1.y); w.y = pk2(o1.z, o1.w); *(GAS v2u*)k = w; w.x = pk2(o2.x, o2.y); w.y = pk2(o2.z, o2.w); *(GAS v2u*)(k + 32) = w; }
                                if (br < 2) { float* o = out + (br == 0 ? O_PCMP : O_PSLC) + (size_t)row * 256 + g * 64 + d1; *(GAS f32x4*)o = o1; *(GAS f32x4*)(o + 32) = o2; }
                                else if (t >= T - 512) { float* o = out + O_PWIN + ((size_t)b * 512 + (t - (T - 512))) * 256 + g * 64 + d1; *(GAS f32x4*)o = o1; *(GAS f32x4*)(o + 32) = o2; } } } }
            } else {
                const int g = wc - 2;
#pragma unroll
                for (int ai = 0; ai < 2; ++ai)
#pragma unroll
                    for (int m = 0; m < 4; ++m) { const int row = rbase + ai * 128 + m * 16; const float rs = rstd[row]; const int t = row & (T - 1), b = row >> 13;
                        const int tk = t & 63, vpos = (tk & ~15) + perm16(tk & 15);
                        bf16* vt = (br > 0) ? (bf16*)(ws + (br == 1 ? WS_VTS : WS_VTW)) + ((size_t)((b * 2 + g) * 128 + (t >> 6)) * 64) * 64 + vpos : nullptr;
#pragma unroll
                        for (int bj = 0; bj < 2; ++bj)
#pragma unroll
                            for (int n = 0; n < 2; ++n) { const f32x4 v = acc[ai][bj][m][n] * rs; const int d1 = 32 * bj + 16 * n + 4 * fq;
                                if (br > 0) {
#pragma unroll
                                    for (int e = 0; e < 4; ++e) vt[(size_t)(d1 + e) * 64] = (bf16)f2bf(v[e]); }
                                if (br < 2) *(GAS f32x4*)(out + (br == 0 ? O_PCMP : O_PSLC) + (size_t)row * 256 + 128 + g * 64 + d1) = v;
                                else if (t >= T - 512) *(GAS f32x4*)(out + O_PWIN + ((size_t)b * 512 + (t - (T - 512))) * 256 + 128 + g * 64 + d1) = v; } }
            }
        } else if (pn < 15) {
            bf16* dst = (bf16*)(ws + WS_ZA);
#pragma unroll
            for (int ai = 0; ai < 2; ++ai)
#pragma unroll
                for (int m = 0; m < 4; ++m) { const int row = rbase + ai * 128 + m * 16; const float rs = rstd[row];
#pragma unroll
                    for (int bj = 0; bj < 2; ++bj)
#pragma unroll
                        for (int n = 0; n < 2; ++n) { const f32x4 z = acc[ai][bj][m][n] * rs; v2u w; w.x = pk2(z.x * sigmoidf(z.x), z.y * sigmoidf(z.y)); w.y = pk2(z.z * sigmoidf(z.z), z.w * sigmoidf(z.w));
                            *(GAS v2u*)(dst + (size_t)row * 512 + 256 * (pn - 13) + 128 * bj + 32 * wc + 16 * n + 4 * fq) = w; } }
        } else {
            if (wc == 0) { float* dst = (float*)(ws + WS_GATE);
#pragma unroll
                for (int ai = 0; ai < 2; ++ai)
#pragma unroll
                    for (int m = 0; m < 4; ++m) { const int row = rbase + ai * 128 + m * 16; const float rs = rstd[row];
#pragma unroll
                        for (int n = 0; n < 2; ++n) { const int c0 = 16 * n + 4 * fq; if (c0 < 24) { const f32x4 z = acc[ai][0][m][n] * rs;
                            *(GAS f32x4*)(dst + (size_t)row * 24 + c0) = (f32x4){sigmoidf(z.x), sigmoidf(z.y), sigmoidf(z.z), sigmoidf(z.w)}; } } } }
        }
    }
};
struct EpiOut {
    static constexpr bool PERM = false, AFTER_DRAIN = false;
    const float* x; float* y;
    __device__ __forceinline__ void operator()(const f32x4 (&acc)[2][2][4][2], const pg8::Unit& u, int wr, int wc, int fr, int fq) const {
        asm volatile("" : "+v"(fr), "+v"(fq));
#pragma unroll
        for (int ai = 0; ai < 2; ++ai)
#pragma unroll
            for (int m = 0; m < 4; ++m) { const size_t row = (size_t)u.pm * 256 + ai * 128 + wr * 64 + m * 16 + fr;
#pragma unroll
                for (int bj = 0; bj < 2; ++bj)
#pragma unroll
                    for (int n = 0; n < 2; ++n) { const size_t off = row * D + u.pn * 256 + 128 * bj + 32 * wc + 16 * n + 4 * fq;
                        *(GAS f32x4*)(y + off) = *(const GAS f32x4*)(x + off) + acc[ai][bj][m][n]; } }
    }
};
template <int MODE>
__device__ __forceinline__ void small_gemm_tile(const Ptrs& P, const bf16* A, const bf16* Bt, int ct, int lane) {
    const int rho = lane & 15, kq = lane >> 4;
    f32x4 acc[2] = {(f32x4){0.f, 0.f, 0.f, 0.f}, (f32x4){0.f, 0.f, 0.f, 0.f}};
    const GAS v4u* a0 = (const GAS v4u*)(A + (size_t)rho * D + 8 * kq); const GAS v4u* a1 = (const GAS v4u*)(A + (size_t)(16 + rho) * D + 8 * kq);
    const GAS v4u* bp = (const GAS v4u*)(Bt + (size_t)(16 * ct + rho) * D + 8 * kq);
#pragma unroll 8
    for (int ks = 0; ks < 32; ++ks) { const bf16x8 bb = __builtin_bit_cast(bf16x8, bp[ks * 4]);
        acc[0] = __builtin_amdgcn_mfma_f32_16x16x32_bf16(bb, __builtin_bit_cast(bf16x8, a0[ks * 4]), acc[0], 0, 0, 0);
        acc[1] = __builtin_amdgcn_mfma_f32_16x16x32_bf16(bb, __builtin_bit_cast(bf16x8, a1[ks * 4]), acc[1], 0, 0, 0); }
#pragma unroll
    for (int rt = 0; rt < 2; ++rt) { const int b = 16 * rt + rho; const int col = 16 * ct + 4 * kq;
        if (MODE == 0) { const float rs = ((const float*)(P.ws + WS_RSTDS))[b]; *(GAS f32x4*)((float*)(P.ws + WS_PROJS) + (size_t)b * NP + col) = acc[rt] * rs; }
        else *(GAS f32x4*)(P.out + O_YS + (size_t)b * D + col) = *(const GAS f32x4*)(P.xs + (size_t)b * D + col) + acc[rt]; }
}
__device__ __forceinline__ int projs_col(int pn, int wc, int d) { return 256 * pn + 128 * (d >> 5) + 32 * wc + (d & 31); }
__device__ __forceinline__ void p2_sample_item(const Ptrs& P, int it, int lane) {
    const int b = it / 37, ty = it - b * 37;
    const float* pr = (const float*)(P.ws + WS_PROJS) + (size_t)b * NP;
    const float* ropes = (const float*)(P.ws + WS_ROPE) + (size_t)8192 * 64;
    float* kvn = (float*)(P.ws + WS_KVN) + (size_t)b * 768;
    if (ty < 14) {
        const bool isq = ty < 8; const int br = isq ? 0 : (ty - 8) >> 1, g = (ty - 8) & 1;
        const int pn = isq ? 8 + (ty >> 2) : 10 + br, wc = isq ? (ty & 3) : g;
        const float v = pr[projs_col(pn, wc, lane)];
        const float ss = wave_sum(v * v); const float inv = 1.0f / sqrtf(ss * (1.0f / 64.0f) + NORM_EPS);
        const float gn = isq ? P.q_gain[lane] : P.k_gain[br * 64 + lane];
        const float xn = v * inv * gn; const float xo = __shfl_xor(xn, 32);
        const int i = lane & 31; const float cs = ropes[i], sn = ropes[32 + i];
        const float o = (lane < 32) ? xn * cs - xo * sn : xn * cs + xo * sn;
        if (isq) ((float*)(P.ws + WS_QS))[(size_t)b * 512 + ty * 64 + lane] = o * QSCALE;
        else { kvn[(br * 2 + 0) * 128 + g * 64 + lane] = o;
            if (br == 0) P.out[O_SCMP + (size_t)b * 256 + g * 64 + lane] = o; else if (br == 1) P.out[O_SSLC + (size_t)b * 256 + g * 64 + lane] = o;
            else P.out[O_SWIN + ((size_t)b * 512 + 511) * 256 + g * 64 + lane] = o; }
    } else if (ty < 20) {
        const int br = (ty - 14) >> 1, g = (ty - 14) & 1; const float v = pr[projs_col(10 + br, 2 + g, lane)];
        kvn[(br * 2 + 1) * 128 + g * 64 + lane] = v;
        if (br == 0) P.out[O_SCMP + (size_t)b * 256 + 128 + g * 64 + lane] = v; else if (br == 1) P.out[O_SSLC + (size_t)b * 256 + 128 + g * 64 + lane] = v;
        else P.out[O_SWIN + ((size_t)b * 512 + 511) * 256 + 128 + g * 64 + lane] = v;
    } else if (ty == 20) {
        if (lane < 24) ((float*)(P.ws + WS_GS))[b * 24 + lane] = sigmoidf(pr[256 * 15 + lane]);
    } else if (ty < 29) {
        const int ch = (ty - 21) * 64 + lane; const int pnb = ch >> 7, tc = ch & 127;
        const float bg = pr[256 * pnb + tc], zc = pr[256 * pnb + 128 + tc], cg = pr[256 * (4 + pnb) + tc], ci = pr[256 * (4 + pnb) + 128 + tc];
        const float u = cg * ci; const float s0 = P.st_conv[(size_t)b * 1024 + ch], s1 = P.st_conv[(size_t)b * 1024 + 512 + ch];
        const float cy = P.conv_w[ch] * s0 + P.conv_w[512 + ch] * s1 + P.conv_w[1024 + ch] * u + P.conv_b[ch];
        ((bf16*)(P.ws + WS_MIXS))[(size_t)b * 1024 + ch] = (bf16)f2bf(bg * cy * zc * sigmoidf(zc));
        P.out[O_SCONV + (size_t)b * 1024 + 512 + ch] = u;
    } else {
        const int col = (ty - 29) * 64 + lane; const float z = pr[256 * (13 + (col >> 8)) + (col & 255)];
        ((float*)(P.ws + WS_ZAS))[(size_t)b * 512 + col] = z * sigmoidf(z);
    }
}
__device__ __forceinline__ void p2_phase(const Ptrs& P, Frame& F) {
    compress_units<false>(P, F, (LAS float*)(F.lds + RING_OFF));
    for (int it = F.gw; it < DECB * 37; it += F.NGW) p2_sample_item(P, it, F.lane);
}
#define MFMA32(a, b, c) __builtin_amdgcn_mfma_f32_32x32x16_bf16(a, b, c, 0, 0, 0)
constexpr int P3_IMP = 0, P3_QL = 32768;
constexpr int P3_NEXT = LDSCTL_OFF + 512, P3_CNT = LDSCTL_OFF + 1024, P3_LISTS = LDSCTL_OFF + 2048, P3_LACC = LDSCTL_OFF + 10240;
constexpr int P3_RING = 65536;
constexpr int P3_MISC = MISC_OFF + 64;
constexpr int SM_Q = 36864, SM_P = 40960, SM_RED = 57344, SM_IMP = 66048, SM_L = 67200, SM_SEL = 67328, SM_O = 67584, SM_VP = 71680  , SM_RED2 = 79872  ;

template <bool MASK>
__device__ __forceinline__ void attend_lds(const LAS unsigned char* blk, const bf16x8 (&qf)[4], f32x16 (&O)[2], float& lsum,
                                           int kbase, int lo, int hi, int lane, bool want_pv, f32x16 (*Sout)[2] = nullptr) {
    const int r = lane & 31, hh = lane >> 5, swz = (r >> 1) & 7;
    const LAS unsigned char* kb = blk + r * 128; const LAS unsigned char* vb = blk + 8192 + r * 128;
#pragma unroll
    for (int kt = 0; kt < 2; ++kt) {
        f32x16 S;
        { bf16x8 kf[4];
#pragma unroll
          for (int s = 0; s < 4; ++s) kf[s] = *(const LAS bf16x8*)(kb + kt * 4096 + (((2 * s + hh) ^ swz) << 4));
#pragma unroll
          for (int i = 0; i < 16; ++i) S[i] = 0.f;
#pragma unroll
          for (int s = 0; s < 4; ++s) S = MFMA32(kf[s], qf[s], S); }
#pragma unroll
        for (int i = 0; i < 16; ++i) { float p = fast_exp2(S[i]);
            if (MASK) { const int kp = kbase + 32 * kt + (i & 3) + 8 * (i >> 2) + 4 * hh; p = (kp >= lo && kp <= hi) ? p : 0.f; }
            S[i] = p; lsum += p; }
        if (Sout) (*Sout)[kt] = S;
        if (want_pv) {
            bf16x8 pf[2];
#pragma unroll
            for (int sp = 0; sp < 2; ++sp) { v4u w; w.x = pk2(S[8 * sp + 0], S[8 * sp + 1]); w.y = pk2(S[8 * sp + 2], S[8 * sp + 3]);
                w.z = pk2(S[8 * sp + 4], S[8 * sp + 5]); w.w = pk2(S[8 * sp + 6], S[8 * sp + 7]); pf[sp] = __builtin_bit_cast(bf16x8, w); }
#pragma unroll
            for (int dt = 0; dt < 2; ++dt)
#pragma unroll
                for (int sp = 0; sp < 2; ++sp) { const bf16x8 vf = *(const LAS bf16x8*)(vb + dt * 4096 + (((2 * (2 * kt + sp) + hh) ^ swz) << 4));
                    O[dt] = MFMA32(vf, pf[sp], O[dt]); }
        }
    }
}
__device__ __forceinline__ void wave_topk(const LAS float* imp, int jmax, int nsel, int lane, int qbase, LAS unsigned* cnt, LAS unsigned char* lists) {
    if (jmax < 1) return;
    const bool c0 = lane >= 1 && lane <= jmax, c1 = 64 + lane <= jmax;
    unsigned k0[8], k1[8], Tv[8];
#pragma unroll
    for (int qi = 0; qi < 8; ++qi) { k0[qi] = c0 ? ((__builtin_bit_cast(unsigned, imp[qi * 128 + lane]) + 0x800u) & ~0x7ffu) : 0u; k1[qi] = c1 ? ((__builtin_bit_cast(unsigned, imp[qi * 128 + 64 + lane]) + 0x800u) & ~0x7ffu) : 0u; Tv[qi] = 0u; }
    if (jmax > nsel) {
        for (int bit = 30; bit >= 11; --bit) {
#pragma unroll
            for (int qi = 0; qi < 8; ++qi) { const unsigned cand = Tv[qi] | (1u << bit);
                const int cn = __popcll(__ballot(k0[qi] >= cand)) + __popcll(__ballot(k1[qi] >= cand)); Tv[qi] = cn >= nsel ? cand : Tv[qi]; } }
    }
    const unsigned long long below = (lane == 0) ? 0ull : (~0ull >> (64 - lane));
#pragma unroll
    for (int qi = 0; qi < 8; ++qi) {
        bool s0, s1;
        if (jmax > nsel) {
            const unsigned long long g0 = __ballot(k0[qi] > Tv[qi]), g1 = __ballot(k1[qi] > Tv[qi]), e0 = __ballot(k0[qi] == Tv[qi]), e1 = __ballot(k1[qi] == Tv[qi]);
            const int need = nsel - __popcll(g0) - __popcll(g1);
            const int rk0 = __popcll(e0 & below), rk1 = __popcll(e0) + __popcll(e1 & below);
            s0 = k0[qi] > Tv[qi] || (k0[qi] == Tv[qi] && rk0 < need); s1 = k1[qi] > Tv[qi] || (k1[qi] == Tv[qi] && rk1 < need);
        } else { s0 = c0; s1 = c1; }
        if (s0) { const unsigned pos = __hip_atomic_fetch_add(cnt + lane, 1u, __ATOMIC_RELAXED, __HIP_MEMORY_SCOPE_WORKGROUP); lists[lane * 64 + pos] = (unsigned char)(qbase + qi); }
        if (s1) { const unsigned pos = __hip_atomic_fetch_add(cnt + 64 + lane, 1u, __ATOMIC_RELAXED, __HIP_MEMORY_SCOPE_WORKGROUP); lists[(64 + lane) * 64 + pos] = (unsigned char)(qbase + qi); }
    }
}
struct BlkSrc { const bf16* k; const bf16* v; int vstride; };
#ifndef PROBE_SEG
#define PROBE_SEG 0
#endif
#define T_BEGIN(id) do { if (PROBE_SEG == (id)) tacc -= __builtin_readcyclecounter(); } while (0)
#define T_END(id) do { if (PROBE_SEG == (id)) tacc += __builtin_readcyclecounter(); } while (0)
__device__ __forceinline__ void p3_prompt_unit(const Ptrs& P, Frame& F, int b, int t, int g, float sh_cmp, float sh_slc, float sh_win, unsigned long long& tacc) {
    int lane = F.lane, w = F.wave, tid = F.tid; asm volatile("" : "+v"(lane), "+s"(w), "+v"(tid));
    const int col = lane & 31, hh = lane >> 5, qi = col >> 2, h = col & 3;
    const int tok = 64 * t + 8 * w + qi; const size_t row = (size_t)b * T + tok; const int qpos = tok;
    const int nck = (2 * t + 2 + 63) >> 6, nf = t >= 2 ? 3 : t + 1, nw = t >= 8 ? 9 : t + 1;
    const int n1 = nck, n2 = 2 * nck, N1 = n2 + nf;
    const bf16* KC = (const bf16*)(P.ws + WS_KC) + (size_t)(b * 2 + g) * 256 * 64; const bf16* VCT = (const bf16*)(P.ws + WS_VCT) + (size_t)(b * 2 + g) * 64 * 256;
    const bf16* KS = (const bf16*)(P.ws + WS_KS) + (size_t)(b * 2 + g) * T * 64; const bf16* VTS = (const bf16*)(P.ws + WS_VTS) + (size_t)(b * 2 + g) * 128 * 4096;
    const bf16* KW = (const bf16*)(P.ws + WS_KW) + (size_t)(b * 2 + g) * T * 64; const bf16* VTW = (const bf16*)(P.ws + WS_VTW) + (size_t)(b * 2 + g) * 128 * 4096;
    auto src1 = [&](int n) -> BlkSrc {
        if (n < n2) { const int ck = n < n1 ? n : n - n1; return BlkSrc{KC + (size_t)ck * 4096, VCT + ck * 64, 256}; }
        const int f = n - n2; const int j = f == 0 ? t : (f == 1 ? 0 : t - 1); return BlkSrc{KS + (size_t)j * 4096, VTS + (size_t)j * 4096, 64}; };
    auto src2 = [&](int n) -> BlkSrc { const int j = (t >= 8 ? t - 8 : 0) + n; return BlkSrc{KW + (size_t)j * 4096, VTW + (size_t)j * 4096, 64}; };
    const int srow = 8 * w + (lane >> 3), sch = (lane & 7) ^ ((srow >> 1) & 7);
    LAS unsigned char* ring = F.lds + P3_RING;
#define ST_DMA(bs_, n) do { LAS unsigned char* d_ = ring + ((n) & 3) * 16384 + w * 1024; \
        __builtin_amdgcn_global_load_lds((const unsigned*)((bs_).k + srow * 64 + sch * 8), (LAS unsigned*)d_, 16, 0, 0); \
        __builtin_amdgcn_global_load_lds((const unsigned*)((bs_).v + (size_t)srow * (bs_).vstride + sch * 8), (LAS unsigned*)(d_ + 8192), 16, 0, 0); } while (0)
#define BLK(n) (ring + ((n) & 3) * 16384)
#define STEP_BEGIN(SRC, n, NN) do { if (((n) & 1) == 0) { if ((n) + 2 < (NN)) { const BlkSrc b_ = SRC((n) + 2); ST_DMA(b_, (n) + 2); } if ((n) + 3 < (NN)) { const BlkSrc b_ = SRC((n) + 3); ST_DMA(b_, (n) + 3); } } } while (0)
#define STEP_END(n, NN) do { if (((n) & 1) == 1 || (n) == (NN) - 1) { asm volatile("s_waitcnt vmcnt(0)" ::: "memory"); __syncthreads(); } } while (0)
    LAS unsigned* cnt = (LAS unsigned*)(F.lds + P3_CNT); LAS unsigned char* lists = F.lds + P3_LISTS; LAS unsigned* nextb = (LAS unsigned*)(F.lds + P3_NEXT);
    LAS int* oacc = (LAS int*)ring; LAS int* lacc = (LAS int*)(F.lds + P3_LACC);
    const float FXS = fast_exp2(18.0f - sh_slc), FXI = 1.0f / FXS;
    LAS unsigned char* ql = F.lds + P3_QL;
    T_BEGIN(1); T_BEGIN(8);
    __syncthreads();
    if (tid < 128) cnt[tid] = 0u; if (tid == 128) nextb[0] = 0u;
    { const BlkSrc b0 = src1(0); ST_DMA(b0, 0); if (N1 > 1) { const BlkSrc b1 = src1(1); ST_DMA(b1, 1); } }
    { const bf16* qg = (const bf16*)(P.ws + WS_Q) + ((size_t)b * T + 64 * t) * 512 + g * 256;
      v4u tq[4];
#pragma unroll
      for (int k = 0; k < 4; ++k) { const int c = tid + 512 * k, rq = c >> 3, ch = c & 7; tq[k] = *(const GAS v4u*)(qg + (size_t)(rq >> 2) * 512 + (rq & 3) * 64 + ch * 8); }
#pragma unroll
      for (int k = 0; k < 4; ++k) { const int c = tid + 512 * k, rq = c >> 3, ch = c & 7; *(LAS v4u*)(ql + rq * 128 + ((ch ^ ((rq >> 1) & 7)) << 4)) = tq[k]; } }
    bf16x8 qf[4];
    { const bf16* q = (const bf16*)(P.ws + WS_Q) + row * 512 + (g * 4 + h) * 64 + 8 * hh;
#pragma unroll
      for (int s = 0; s < 4; ++s) qf[s] = __builtin_bit_cast(bf16x8, *(const GAS v4u*)(q + 16 * s)); }
    const float* gate = (const float*)(P.ws + WS_GATE) + row * 24 + (g * 4 + h) * 3;
    const float g_cmp = gate[0], g_slc = gate[1], g_win = gate[2];
    asm volatile("s_waitcnt vmcnt(0)" ::: "memory"); __syncthreads();
    T_END(1); T_BEGIN(2);
    f32x16 O[2];
    LAS float* wl = (LAS float*)(F.lds + P3_IMP + w * 4096);
    LAS float* xw0 = (LAS float*)(F.lds + P3_IMP + w * 4096) + lane;
    f32x16 totr;
    const int nvis = (qpos + 1) >> 5;
    int n = 0;
    float lsum = 0.f;
    for (; n < n1; ++n) { STEP_BEGIN(src1, n, N1); attend_lds<true>(BLK(n), qf, O, lsum, 64 * n, 0, nvis - 1, lane, false); STEP_END(n, N1); }
    lsum += __shfl_xor(lsum, 32);
    const float rl = lsum > 0.f ? 1.0f / lsum : 0.f;
    for (int i = lane; i < 1024; i += 64) wl[i] = 0.f;
#pragma unroll
    for (int i = 0; i < 16; ++i) { O[0][i] = 0.f; O[1][i] = 0.f; }
    { float dummy = 0.f;
      for (; n < n2; ++n) { STEP_BEGIN(src1, n, N1); const int ck = n - n1; f32x16 Sn[2];
        attend_lds<true>(BLK(n), qf, O, dummy, 64 * ck, 0, nvis - 1, lane, true, &Sn);
#pragma unroll
        for (int kt = 0; kt < 2; ++kt)
#pragma unroll
            for (int i2 = 0; i2 < 8; ++i2) { const float v = quad_sum((Sn[kt][2 * i2] + Sn[kt][2 * i2 + 1]) * rl);
                if (h == 0) wl[qi * 128 + 32 * ck + 16 * kt + (i2 & 1) + 4 * (i2 >> 1) + 2 * hh] = v; }
        STEP_END(n, N1); } }
    LDS_WAIT(); asm volatile("" ::: "memory");
    T_END(2); T_BEGIN(3);
    wave_topk(wl, t - 2, 13, lane, 8 * w, cnt, lists);
    LDS_WAIT(); asm volatile("" ::: "memory");
#pragma unroll
    for (int i = 0; i < 16; ++i) { xw0[i * 64] = O[0][i] * (g_cmp * rl); totr[i] = O[1][i] * (g_cmp * rl); O[0][i] = 0.f; O[1][i] = 0.f; }
    T_END(3); T_BEGIN(4);
    lsum = 0.f;
    for (; n < N1; ++n) { STEP_BEGIN(src1, n, N1);
        if (n == n2) attend_lds<true>(BLK(n), qf, O, lsum, 64 * t, 0, qpos, lane, true);
        else attend_lds<false>(BLK(n), qf, O, lsum, 0, 0, 0, lane, true);
        STEP_END(n, N1); }
    lsum += __shfl_xor(lsum, 32);
#pragma unroll
    for (int dt = 0; dt < 2; ++dt)
#pragma unroll
        for (int i = 0; i < 16; ++i) oacc[(32 * dt + (i & 3) + 8 * (i >> 2) + 4 * hh) * 256 + 32 * w + col] = __float2int_rn(O[dt][i] * FXS);
    if (hh == 0) lacc[32 * w + col] = __float2int_rn(lsum * FXS);
    __syncthreads();
    T_END(4); T_BEGIN(5);
    if (t > 2) {
        const int r = lane & 31;
#define NEXT_BLOCK(jv_, nq_) do { for (;;) { unsigned t_ = 0u; if (lane == 0) t_ = __hip_atomic_fetch_add(nextb, 1u, __ATOMIC_RELAXED, __HIP_MEMORY_SCOPE_WORKGROUP); \
            jv_ = 1 + (int)__builtin_amdgcn_readfirstlane(t_); if (jv_ > t - 2) { nq_ = 0; break; } nq_ = (int)__builtin_amdgcn_readfirstlane(cnt[jv_]); if (nq_ > 0) break; } } while (0)
#define LOAD_FRAGS(kd_, vd_, jv_) do { const bf16* kp_ = KS + (size_t)(jv_) * 4096 + r * 64 + 8 * hh; const bf16* vp_ = VTS + (size_t)(jv_) * 4096 + r * 64 + 8 * hh; \
            _Pragma("unroll") for (int a_ = 0; a_ < 2; ++a_) _Pragma("unroll") for (int b_ = 0; b_ < 4; ++b_) { kd_[a_][b_] = __builtin_bit_cast(bf16x8, *(const GAS v4u*)(kp_ + a_ * 2048 + 16 * b_)); \
                vd_[a_][b_] = __builtin_bit_cast(bf16x8, *(const GAS v4u*)(vp_ + a_ * 2048 + 16 * b_)); } } while (0)
        bf16x8 kf[2][4], vf[2][4];
        for (;;) {
            int j, nq; NEXT_BLOCK(j, nq);
            if (j > t - 2) break;
            LOAD_FRAGS(kf, vf, j);
#pragma unroll
            for (int a_ = 0; a_ < 2; ++a_)
#pragma unroll
                for (int b_ = 0; b_ < 4; ++b_) asm volatile("" : "+v"(kf[a_][b_]), "+v"(vf[a_][b_]));
            for (int c0 = 0; c0 < nq; c0 += 8) {
                const int sl = c0 + qi; const bool valid = sl < nq;
                const int rowq = (int)lists[j * 64 + (valid ? sl : nq - 1)] * 4 + h;
                const LAS unsigned char* qp = ql + rowq * 128; const int qsw = (rowq >> 1) & 7;
                bf16x8 q2[4];
#pragma unroll
                for (int s = 0; s < 4; ++s) q2[s] = *(const LAS bf16x8*)(qp + (((2 * s + hh) ^ qsw) << 4));
                float l2 = 0.f; bf16x8 pf[4]; f32x16 S0, S1;
#pragma unroll
                for (int i = 0; i < 16; ++i) { S0[i] = 0.f; S1[i] = 0.f; }
#pragma unroll
                for (int s = 0; s < 4; ++s) { S0 = MFMA32(kf[0][s], q2[s], S0); S1 = MFMA32(kf[1][s], q2[s], S1); }
#pragma unroll
                for (int i = 0; i < 16; ++i) { S0[i] = fast_exp2(S0[i]); l2 += S0[i]; }
#pragma unroll
                for (int sp = 0; sp < 2; ++sp) { v4u wv; wv.x = pk2(S0[8 * sp + 0], S0[8 * sp + 1]); wv.y = pk2(S0[8 * sp + 2], S0[8 * sp + 3]);
                    wv.z = pk2(S0[8 * sp + 4], S0[8 * sp + 5]); wv.w = pk2(S0[8 * sp + 6], S0[8 * sp + 7]); pf[sp] = __builtin_bit_cast(bf16x8, wv); }
#pragma unroll
                for (int i = 0; i < 16; ++i) { S1[i] = fast_exp2(S1[i]); l2 += S1[i]; }
#pragma unroll
                for (int sp = 0; sp < 2; ++sp) { v4u wv; wv.x = pk2(S1[8 * sp + 0], S1[8 * sp + 1]); wv.y = pk2(S1[8 * sp + 2], S1[8 * sp + 3]);
                    wv.z = pk2(S1[8 * sp + 4], S1[8 * sp + 5]); wv.w = pk2(S1[8 * sp + 6], S1[8 * sp + 7]); pf[2 + sp] = __builtin_bit_cast(bf16x8, wv); }
                T_BEGIN(9);
#pragma unroll
                for (int dt = 0; dt < 2; ++dt) { f32x16 O2;
#pragma unroll
                    for (int i = 0; i < 16; ++i) O2[i] = 0.f;
#pragma unroll
                    for (int ks = 0; ks < 4; ++ks) O2 = MFMA32(vf[dt][ks], pf[ks], O2);
                    if (valid) {
#pragma unroll
                        for (int i = 0; i < 16; ++i) (void)__hip_atomic_fetch_add(oacc + (32 * dt + (i & 3) + 8 * (i >> 2) + 4 * hh) * 256 + rowq, __float2int_rn(O2[i] * FXS), __ATOMIC_RELAXED, __HIP_MEMORY_SCOPE_WORKGROUP); } }
                if (valid) {
                    (void)__hip_atomic_fetch_add(lacc + rowq, __float2int_rn(l2 * FXS), __ATOMIC_RELAXED, __HIP_MEMORY_SCOPE_WORKGROUP); }
                LDS_WAIT(); T_END(9);
            }
        }
#undef NEXT_BLOCK
#undef LOAD_FRAGS
    }
    __syncthreads();
    T_END(5); T_BEGIN(6);
    LAS float* x0 = (LAS float*)(F.lds + P3_IMP + w * 4096) + lane; LAS float* x1 = (LAS float*)(F.lds + P3_QL + w * 4096) + lane;
    { const float sc = g_slc / fmaxf((float)lacc[32 * w + col] * FXI, 1e-30f);
#pragma unroll
      for (int i = 0; i < 16; ++i) { const int dr = (i & 3) + 8 * (i >> 2) + 4 * hh;
          x0[i * 64] = x0[i * 64] + (float)oacc[dr * 256 + 32 * w + col] * (FXI * sc); x1[i * 64] = totr[i] + (float)oacc[(32 + dr) * 256 + 32 * w + col] * (FXI * sc); O[0][i] = 0.f; O[1][i] = 0.f; } }
    LDS_WAIT(); __syncthreads();
    { const BlkSrc b0 = src2(0); ST_DMA(b0, 0); if (nw > 1) { const BlkSrc b1 = src2(1); ST_DMA(b1, 1); } }
    { asm volatile("" : "+v"(lane));
      const bf16* q = (const bf16*)(P.ws + WS_Q) + row * 512 + (g * 4 + h) * 64 + 8 * hh;
#pragma unroll
      for (int s = 0; s < 4; ++s) qf[s] = __builtin_bit_cast(bf16x8, *(const GAS v4u*)(q + 16 * s)); }
    asm volatile("s_waitcnt vmcnt(0)" ::: "memory"); __syncthreads();
    lsum = 0.f;
    for (n = 0; n < nw; ++n) { STEP_BEGIN(src2, n, nw); const int j = (t >= 8 ? t - 8 : 0) + n;
        if (j == t || j + 8 == t) attend_lds<true>(BLK(n), qf, O, lsum, 64 * j, qpos - 511, qpos, lane, true);
        else attend_lds<false>(BLK(n), qf, O, lsum, 0, 0, 0, lane, true);
        STEP_END(n, nw); }
    lsum += __shfl_xor(lsum, 32);
    { const float sc = g_win / fmaxf(lsum, 1e-30f);
#pragma unroll
      for (int i = 0; i < 16; ++i) { O[0][i] = x0[i * 64] + O[0][i] * sc; O[1][i] = x1[i * 64] + O[1][i] * sc; } }
#undef ST_DMA
#undef BLK
#undef STEP_BEGIN
#undef STEP_END
    T_END(6); T_BEGIN(7);
    asm volatile("" : "+v"(lane));
    const int col_ = lane & 31, hh_ = lane >> 5, h_ = col_ & 3; const size_t row_ = (size_t)b * T + 64 * t + 8 * w + (col_ >> 2);
    const bf16* za = (const bf16*)(P.ws + WS_ZA) + row_ * 512 + (g * 4 + h_) * 64; bf16* mx = (bf16*)(P.ws + WS_MIX) + row_ * 1024 + 512 + (g * 4 + h_) * 64;
#pragma unroll
    for (int dt = 0; dt < 2; ++dt)
#pragma unroll
        for (int i4 = 0; i4 < 4; ++i4) { const int d = 32 * dt + 8 * i4 + 4 * hh_; const v2u z = *(const GAS v2u*)(za + d);
            v2u o; o.x = pk2(O[dt][4 * i4] * bf2f(z.x & 0xffffu), O[dt][4 * i4 + 1] * bf2f(z.x >> 16)); o.y = pk2(O[dt][4 * i4 + 2] * bf2f(z.y & 0xffffu), O[dt][4 * i4 + 3] * bf2f(z.y >> 16));
            *(GAS v2u*)(mx + d) = o; }
    if (g == 0) { const int tq = w, c8 = lane * 8; const size_t r0 = (size_t)b * T + 64 * t + 8 * tq;
        const bf16* U = (const bf16*)(P.ws + WS_U) + c8; const bf16* CGp = (const bf16*)(P.ws + WS_CG) + c8; bf16* mo = (bf16*)(P.ws + WS_MIX) + c8;
        v4u ur[10], cr[8];
        const bool has_prev = (t > 0) || (tq > 0);
#pragma unroll
        for (int i = 0; i < 10; ++i) ur[i] = (i >= 2 || has_prev) ? *(const GAS v4u*)(U + (r0 + i - 2) * 512) : (v4u){0u, 0u, 0u, 0u};
#pragma unroll
        for (int i = 0; i < 8; ++i) cr[i] = *(const GAS v4u*)(CGp + (r0 + i) * 512);
        float w0[8], w1[8], w2[8], cb[8];
#pragma unroll
        for (int e = 0; e < 8; ++e) { w0[e] = P.conv_w[c8 + e]; w1[e] = P.conv_w[512 + c8 + e]; w2[e] = P.conv_w[1024 + c8 + e]; cb[e] = P.conv_b[c8 + e]; }
#pragma unroll
        for (int i = 0; i < 8; ++i) { float o[8];
#pragma unroll
            for (int e = 0; e < 8; ++e) { const int sh_ = (e & 1) * 16; const float a = bf2f((ur[i][e >> 1] >> sh_) & 0xffffu), bb = bf2f((ur[i + 1][e >> 1] >> sh_) & 0xffffu), c = bf2f((ur[i + 2][e >> 1] >> sh_) & 0xffffu);
                o[e] = bf2f((cr[i][e >> 1] >> sh_) & 0xffffu) * (w0[e] * a + w1[e] * bb + w2[e] * c + cb[e]); }
            v4u ov; ov.x = pk2(o[0], o[1]); ov.y = pk2(o[2], o[3]); ov.z = pk2(o[4], o[5]); ov.w = pk2(o[6], o[7]);
            *(GAS v4u*)(mo + (r0 + i) * 1024) = ov; } }
    T_END(7); T_END(8);
}
template <class KeyFn>
__device__ __forceinline__ void sample_branch(Frame& F, int nslots, float shift, const KeyFn& key, LAS float* obr) {
    LAS float* q = (LAS float*)(F.lds + SM_Q); LAS float* Pb = (LAS float*)(F.lds + SM_P); LAS float* red = (LAS float*)(F.lds + SM_RED); LAS float* lsm = (LAS float*)(F.lds + SM_L);
    LAS unsigned long long* vptr = (LAS unsigned long long*)(F.lds + SM_VP);
    float lacc[4] = {0.f, 0.f, 0.f, 0.f};
    for (int s = F.tid; s < nslots; s += 512) { const float* kp; const float* vp; const bool valid = key(s, kp, vp);
        float sc[4] = {0.f, 0.f, 0.f, 0.f};
        if (valid) {
#pragma unroll 8
            for (int d4 = 0; d4 < 16; ++d4) { const f32x4 kv = *(const GAS f32x4*)(kp + 4 * d4);
#pragma unroll
                for (int hq = 0; hq < 4; ++hq) { const f32x4 qv = *(const LAS f32x4*)(q + hq * 64 + 4 * d4); sc[hq] += (kv.x * qv.x + kv.y * qv.y) + (kv.z * qv.z + kv.w * qv.w); } } }
        f32x4 p;
#pragma unroll
        for (int hq = 0; hq < 4; ++hq) { p[hq] = valid ? fast_exp2(sc[hq] - shift) : 0.f; lacc[hq] += p[hq]; }
        *(LAS f32x4*)(Pb + 4 * s) = p; vptr[s] = (unsigned long long)(uintptr_t)vp; }
#pragma unroll
    for (int hq = 0; hq < 4; ++hq) { lacc[hq] = wave_sum(lacc[hq]); if (F.lane == 0) red[F.wave * 4 + hq] = lacc[hq]; }
    __syncthreads();
    if (F.tid < 4) { float s = 0.f; for (int ww = 0; ww < 8; ++ww) s += red[ww * 4 + F.tid]; lsm[F.tid] = s; }
    const int sg = F.tid >> 4, d4 = F.tid & 15;
    f32x4 oa[4];
#pragma unroll
    for (int hq = 0; hq < 4; ++hq) oa[hq] = (f32x4){0.f, 0.f, 0.f, 0.f};
    for (int s0 = sg; s0 < nslots; s0 += 256) {
        f32x4 vv[8], pp[8];
#pragma unroll
        for (int u = 0; u < 8; ++u) { const int s = s0 + 32 * u; const float* vp = (const float*)(uintptr_t)vptr[s]; vv[u] = *(const GAS f32x4*)(vp + 4 * d4); pp[u] = *(const LAS f32x4*)(Pb + 4 * s); }
#pragma unroll
        for (int u = 0; u < 8; ++u) { oa[0] = oa[0] + vv[u] * pp[u].x; oa[1] = oa[1] + vv[u] * pp[u].y; oa[2] = oa[2] + vv[u] * pp[u].z; oa[3] = oa[3] + vv[u] * pp[u].w; } }
    __syncthreads();
    LAS float* red2 = (LAS float*)(F.lds + SM_RED2);
#pragma unroll
    for (int hq = 0; hq < 4; ++hq) *(LAS f32x4*)(red2 + (sg * 4 + hq) * 64 + 4 * d4) = oa[hq];
    __syncthreads();
    if (F.tid < 256) { float s = 0.f;
#pragma unroll 8
        for (int g2 = 0; g2 < 32; ++g2) s += red2[g2 * 256 + F.tid]; obr[F.tid] = s; }
    __syncthreads();
}
__device__ __forceinline__ void p3_sample_unit(const Ptrs& P, Frame& F, int b, int g) {
    asm volatile("" : "+v"(F.tid), "+v"(F.lane), "+s"(F.wave));
    LAS float* q = (LAS float*)(F.lds + SM_Q); LAS float* Pb = (LAS float*)(F.lds + SM_P); LAS float* imp = (LAS float*)(F.lds + SM_IMP); LAS float* lsm = (LAS float*)(F.lds + SM_L);
    LAS int* sel = (LAS int*)(F.lds + SM_SEL); LAS float* osm = (LAS float*)(F.lds + SM_O);
    const float* cst = (const float*)(P.ws + WS_CONST);
    float kcmax = 0.f; for (int e_ = 0; e_ < 4; ++e_) kcmax += __builtin_bit_cast(float, __hip_atomic_load((unsigned*)(P.ws + WS_CTL) + CW_KCMAX + 64 + e_, RLX_AGENT));
    const float sh_cmp = cst[0] * sqrtf(kcmax) * LOG2E * 1.001f, sh_slc = cst[1], sh_win = cst[2];
    if (F.tid < 256) q[F.tid] = ((const float*)(P.ws + WS_QS))[(size_t)b * 512 + g * 256 + F.tid];
    __syncthreads();
    const float* kcs = (const float*)(P.ws + WS_KCS) + (size_t)(b * 2 + g) * 2 * NCS * 64;
    sample_branch(F, NCS, sh_cmp, [&](int s, const float*& kp, const float*& vp) { kp = kcs + (size_t)s * 64; vp = kcs + (size_t)(NCS + s) * 64; return true; }, osm);
    { const f32x4 p = *(const LAS f32x4*)(Pb + 4 * F.tid); float v = p.x / lsm[0] + p.y / lsm[1] + p.z / lsm[2] + p.w / lsm[3]; v += __shfl_xor(v, 1);
      if ((F.tid & 1) == 0) imp[F.tid >> 1] = v; if (F.tid < 4) imp[256 + F.tid] = 0.f; }
    if (F.tid < 256) osm[F.tid] = osm[F.tid] / lsm[F.tid >> 6];
    __syncthreads();
    if (F.wave == 0) { const int lane = F.lane; unsigned k[4];
#pragma unroll
        for (int i = 0; i < 4; ++i) { const int j = lane + 64 * i; k[i] = (j >= 1 && j <= 254) ? __builtin_bit_cast(unsigned, imp[j]) + 1u : 0u; }
        unsigned Tv = 0u;
        for (int bit = 30; bit >= 0; --bit) { const unsigned cand = Tv | (1u << bit); int cnt = 0;
#pragma unroll
            for (int i = 0; i < 4; ++i) cnt += __popcll(__ballot(k[i] >= cand));
            if (cnt >= 13) Tv = cand; }
        int ngt = 0;
#pragma unroll
        for (int i = 0; i < 4; ++i) ngt += __popcll(__ballot(k[i] > Tv));
        const int need = 13 - ngt; const unsigned long long below = (lane == 0) ? 0ull : (~0ull >> (64 - lane));
        int base = 3, eqbase = 0;
        if (lane == 0) { int z_ = 0; asm volatile("" : "+v"(z_)); sel[0] = z_; sel[1] = z_ + 255; sel[2] = z_ + 256; }
#pragma unroll
        for (int i = 0; i < 4; ++i) { const unsigned long long e = __ballot(k[i] == Tv); const int rk = eqbase + __popcll(e & below); const bool on = k[i] > Tv || (k[i] == Tv && rk < need);
            const unsigned long long m = __ballot(on); if (on) sel[base + __popcll(m & below)] = lane + 64 * i; base += __popcll(m); eqbase += __popcll(e); } }
    __syncthreads();
    const float* kvn = (const float*)(P.ws + WS_KVN) + (size_t)b * 768;
    const int* pt = P.page_table + b * NPAGES; const float* cs = P.cache_slc;
    sample_branch(F, 1024, sh_slc, [&](int s, const float*& kp, const float*& vp) { const int j = sel[s >> 6], rr = s & 63;
        if (j == 256) { kp = kvn + (1 * 2 + 0) * 128 + g * 64; vp = kvn + (1 * 2 + 1) * 128 + g * 64; return rr == 0; }
        const float* rowp = cs + ((size_t)pt[j >> 1] * 128 + (j & 1) * 64 + rr) * 256 + g * 64; kp = rowp; vp = rowp + 128; return true; }, osm + 256);
    if (F.tid < 256) osm[256 + F.tid] = osm[256 + F.tid] / lsm[F.tid >> 6];
    __syncthreads();
    const float* stw = P.st_win + (size_t)b * 512 * 256;
    sample_branch(F, 512, sh_win, [&](int s, const float*& kp, const float*& vp) {
        if (s == 511) { kp = kvn + (2 * 2 + 0) * 128 + g * 64; vp = kvn + (2 * 2 + 1) * 128 + g * 64; return true; }
        const float* rowp = stw + (size_t)(s + 1) * 256 + g * 64; kp = rowp; vp = rowp + 128; return true; }, osm + 512);
    if (F.tid < 256) { const int hq = F.tid >> 6, d = F.tid & 63; const float* gs = (const float*)(P.ws + WS_GS) + b * 24 + (g * 4 + hq) * 3;
        const float o = gs[0] * osm[F.tid] + gs[1] * osm[256 + F.tid] + gs[2] * osm[512 + F.tid] / lsm[hq];
        ((bf16*)(P.ws + WS_MIXS))[(size_t)b * 1024 + 512 + (g * 4 + hq) * 64 + d] = (bf16)f2bf(o * ((const float*)(P.ws + WS_ZAS))[(size_t)b * 512 + (g * 4 + hq) * 64 + d]); }
    __syncthreads();
}
__device__ __forceinline__ void p3_phase(const Ptrs& P, Frame& F, int rep) {
    const float* cst = (const float*)(P.ws + WS_CONST);
    float kcmax = 0.f; for (int e_ = 0; e_ < 4; ++e_) kcmax += __builtin_bit_cast(float, __hip_atomic_load((unsigned*)(P.ws + WS_CTL) + CW_KCMAX + e_, RLX_AGENT));
    const float sh_cmp = cst[0] * sqrtf(kcmax) * LOG2E * 1.001f, sh_slc = cst[1], sh_win = cst[2];
    unsigned long long tacc = 0ull;
    volatile LAS int* qw = (volatile LAS int*)(F.lds + P3_MISC);
#ifndef PROBE_P3
#define PROBE_P3 0
#endif
    constexpr int NS_ = PROBE_P3 == 1 ? 16 : 8, PSH_ = PROBE_P3 == 2 ? 1 : 0;
    constexpr int NQ = NS_ + (128 << PSH_);
    const int x0 = (int)(xb_xcc_id() & 7u);
    for (int xi = 0; xi < 8; ++xi) {
        const int x = (x0 + xi) & 7;
        for (;;) {
            __syncthreads();
            if (F.tid == 0) qw[0] = (int)__hip_atomic_fetch_add((unsigned*)(F.ctl + CW_QUEUE + 64 * (x + 8 * rep)), 1u, RLX_AGENT);
            __syncthreads();
            const int idx = qw[0];
            if (idx >= NQ) break;
            if (idx < NS_) p3_sample_unit(P, F, x * 4 + ((idx & 7) >> 1), idx & 1);
            else p3_prompt_unit(P, F, x >> 1, 127 - ((idx - NS_) >> PSH_), x & 1, sh_cmp, sh_slc, sh_win, tacc);
        }
    }
    if (PROBE_SEG != 0 && blockIdx.x == 0) { const unsigned long long t0_ = __builtin_readcyclecounter(); while (__builtin_readcyclecounter() - t0_ < tacc) __builtin_amdgcn_s_sleep(8); }
}
#ifndef MK_N_LAUNCHES
#define MK_N_LAUNCHES 1
#endif
constexpr int N_PHASES = 5;
constexpr int N_LAUNCHES = MK_N_LAUNCHES;
struct Args { Ptrs p; int ph_lo, ph_hi, rep, mode; };
__global__ void __launch_bounds__(NWAVES * 64, 2) nsa_fwd(Args args) {
    extern __shared__ __attribute__((aligned(16))) unsigned char lds[];
    const Ptrs& P = args.p;
    Frame F;
    F.lds = (LAS unsigned char*)lds;
    F.MISC = (volatile LAS unsigned*)(F.lds + MISC_OFF);
    F.tid = threadIdx.x; F.lane = F.tid & 63; F.wave = __builtin_amdgcn_readfirstlane(F.tid >> 6);
    F.G = gridDim.x; F.gw = blockIdx.x * NWAVES + F.wave; F.NGW = F.G * NWAVES;
    F.ctl = (gu32*)(P.ws + WS_CTL);
    for (int u = F.tid; u < (LDS_BYTES - LDSCTL_OFF) / 4; u += NWAVES * 64) ((LAS unsigned*)(F.lds + LDSCTL_OFF))[u] = 0u;
    __syncthreads();
    XcdBarrier bar; bar.bar = (unsigned*)(F.ctl + CW_BAR); bar.x = 0; bar.st = nullptr;
    if (N_LAUNCHES == 1) bar = xcd_barrier_post((unsigned*)(F.ctl + CW_BAR), F.MISC + 8);
    const int lo = args.ph_lo, hi = args.ph_hi;
    unsigned long long tprobe = 0ull;
#define IN(k) (lo <= (k) && (k) < hi)
#define FENCE() do { asm volatile("" : "+s"(F.wave), "+s"(F.gw)); F.lane = (int)__builtin_amdgcn_mbcnt_hi(~0u, __builtin_amdgcn_mbcnt_lo(~0u, 0u)); F.tid = F.wave * 64 + F.lane; asm volatile("" : "+v"(F.tid), "+v"(F.lane)); } while (0)
#define SEAM(k) do { if (IN(k) && IN((k) + 1)) xcd_barrier(bar, F.wave == 0 && (int)__builtin_amdgcn_mbcnt_hi(~0u, __builtin_amdgcn_mbcnt_lo(~0u, 0u)) == 0); } while (0)

    if (IN(0)) { FENCE(); p0_phase(P, F); } SEAM(0);
    if (IN(1)) { FENCE();
        pg8::Gemm g{(const pg8::bf16_t*)(P.ws + WS_XB), (const pg8::bf16_t*)(P.ws + WS_BT1), M, NP, D}; pg8::StaticOrder S; S.init(M, NP, F.G, (int)blockIdx.x);
        EpiIn E{(const float*)(P.ws + WS_RSTD), (const float*)(P.ws + WS_ROPE), P.q_gain, P.k_gain, P.out, P.ws};
        pg8::gemm_phase<EpiIn, pg8::StaticOrder, true, true>(F.lds + RING_OFF, g, S, E, F.wave, tprobe);
        FENCE();
        for (int ct = F.gw; ct < NP / 16; ct += F.NGW) small_gemm_tile<0>(P, (const bf16*)(P.ws + WS_XSB), (const bf16*)(P.ws + WS_BT1), ct, F.lane);
#if defined(PROBE_EPI)
        if (PROBE_EPI == 1 && blockIdx.x == 0) { const unsigned long long t0_ = __builtin_readcyclecounter(); while (__builtin_readcyclecounter() - t0_ < tprobe) __builtin_amdgcn_s_sleep(8); }
        tprobe = 0ull;
#endif
    } SEAM(1);
    if (IN(2)) { FENCE(); p2_phase(P, F); } SEAM(2);
    if (IN(3)) { FENCE(); p3_phase(P, F, args.rep); } SEAM(3);
    if (IN(4)) { FENCE();
        pg8::Gemm g{(const pg8::bf16_t*)(P.ws + WS_MIX), (const pg8::bf16_t*)(P.ws + WS_BT2), M, D, D}; pg8::StaticOrder S; S.init(M, D, F.G, (int)blockIdx.x);
        EpiOut E{P.xp, P.out + O_Y};
        pg8::gemm_phase<EpiOut, pg8::StaticOrder, true, true>(F.lds + RING_OFF, g, S, E, F.wave, tprobe);
        FENCE();
        for (int ct = F.gw; ct < D / 16; ct += F.NGW) small_gemm_tile<1>(P, (const bf16*)(P.ws + WS_MIXS), (const bf16*)(P.ws + WS_BT2), ct, F.lane);
#if defined(PROBE_EPI)
        if (PROBE_EPI == 2 && blockIdx.x == 0) { const unsigned long long t0_ = __builtin_readcyclecounter(); while (__builtin_readcyclecounter() - t0_ < tprobe) __builtin_amdgcn_s_sleep(8); }
#endif
    }
#undef IN
#undef SEAM
}

extern "C" void kernel_launch(void* const* d_in, const int* in_sizes, int n_in, void* d_out, int out_size, void* d_ws, size_t ws_size, hipStream_t stream) {
    static int grid = 0;
    if (grid == 0) {
        if (n_in != 16 || out_size != (int)O_END || ws_size < WS_END) { fprintf(stderr, "kernel_launch: unexpected shapes (n_in %d, out %d, ws %zu)\n", n_in, out_size, ws_size); grid = -1; return; }
        int dev = 0, cus = 0, per_cu = 0;
        if (hipGetDevice(&dev) != hipSuccess || hipDeviceGetAttribute(&cus, hipDeviceAttributeMultiprocessorCount, dev) != hipSuccess) { grid = -1; return; }
        if (hipFuncSetAttribute((const void*)nsa_fwd, hipFuncAttributeMaxDynamicSharedMemorySize, LDS_BYTES) != hipSuccess) { fprintf(stderr, "kernel_launch: hipFuncSetAttribute failed\n"); grid = -1; return; }
        if (hipOccupancyMaxActiveBlocksPerMultiprocessor(&per_cu, (const void*)nsa_fwd, NWAVES * 64, LDS_BYTES) != hipSuccess || per_cu < 1)
            fprintf(stderr, "kernel_launch: note: occupancy query reports %d workgroups per CU\n", per_cu);
        (void)hipGetLastError();
        grid = cus;
    }
    if (grid < 0) return;
    if (hipMemsetAsync((char*)d_ws + WS_CTL, 0, CTL_ZERO_BYTES, stream) != hipSuccess) return;
    Args a{}; a.mode = 3;
    a.p.xp = (const float*)d_in[0]; a.p.xs = (const float*)d_in[1]; a.p.cache_cmp = (const float*)d_in[2]; a.p.cache_slc = (const float*)d_in[3];
    a.p.st_win = (const float*)d_in[4]; a.p.st_conv = (const float*)d_in[5]; a.p.page_table = (const int*)d_in[6]; a.p.norm_g = (const float*)d_in[7];
    a.p.w_in = (const float*)d_in[8]; a.p.conv_w = (const float*)d_in[9]; a.p.conv_b = (const float*)d_in[10]; a.p.q_gain = (const float*)d_in[11];
    a.p.k_gain = (const float*)d_in[12]; a.p.cmp_pe = (const float*)d_in[13]; a.p.cmp_w = (const float*)d_in[14]; a.p.w_out = (const float*)d_in[15];
    a.p.out = (float*)d_out; a.p.ws = (unsigned char*)d_ws;
#ifndef PROBE_DUP
#define PROBE_DUP -1
#endif
    for (int li = 0; li < N_LAUNCHES; ++li) {
        a.ph_lo = (N_LAUNCHES == 1) ? 0 : li; a.ph_hi = (N_LAUNCHES == 1) ? N_PHASES : li + 1;
        for (int rep = 0; rep < ((N_LAUNCHES > 1 && li == PROBE_DUP) ? 2 : 1); ++rep) {
            a.rep = rep;
            hipLaunchKernelGGL(nsa_fwd, dim3(grid), dim3(NWAVES * 64), LDS_BYTES, stream, a);
            const hipError_t le = hipPeekAtLastError();
            if (le != hipSuccess) { fprintf(stderr, "kernel_launch: launch %d failed: %s\n", li, hipGetErrorName(le)); break; }
        }
    }
}
```

```cpp
#include <hip/hip_runtime.h>
#include <cstdio>
#include <cstdint>
#define GAS __attribute__((address_space(1)))
#define LAS __attribute__((address_space(3)))
typedef unsigned short bf16;
typedef unsigned v4u __attribute__((ext_vector_type(4)));
typedef unsigned v2u __attribute__((ext_vector_type(2)));
typedef float f32x2 __attribute__((ext_vector_type(2)));
typedef float f32x16 __attribute__((ext_vector_type(16)));
typedef GAS unsigned gu32;
typedef GAS unsigned long long gu64;
#define RLX_AGENT __ATOMIC_RELAXED, __HIP_MEMORY_SCOPE_AGENT
#define LDS_WAIT() asm volatile("s_waitcnt lgkmcnt(0)" ::: "memory")
#define VM_WAIT() asm volatile("s_waitcnt vmcnt(0)" ::: "memory")
#define MK_N_LAUNCHES 1
#define PROBE_DUP -1
#define PROBE_P3 0
#define PROBE_SEG 0
namespace pg8 {
#define PG8_LAS __attribute__((address_space(3)))
typedef unsigned short bf16_t;
typedef short bf16x8 __attribute__((ext_vector_type(8)));
typedef float f32x4 __attribute__((ext_vector_type(4)));
typedef unsigned u32x4 __attribute__((ext_vector_type(4)));
constexpr int BM = 256, BK = 64, HALF = 128, HTB = HALF * BK * 2  , STAGE_BYTES = 8 * HTB, NXCD = 8, WGM = 8;

__host__ __device__ __forceinline__ int lds_byte(int r, int c) { const int st = (r >> 4) * 2 + (c >> 5), rr = r & 15, cc = c & 31, ob = rr * 64 + cc * 2; return st * 1024 + (ob ^ (((ob >> 9) & 1) << 5)); }
__host__ __device__ __forceinline__ void stage_rc(int b, int& R, int& C) { const int st = b / 1024, sb = b % 1024, swz = sb ^ (((sb >> 9) & 1) << 5); R = (st >> 1) * 16 + swz / 64; C = (st & 1) * 32 + (swz % 64) / 2; }
__host__ __device__ __forceinline__ int perm32(int rho) { const int n = rho >> 4, i = rho & 15; return 8 * (i >> 2) + 4 * n + (i & 3); }

struct Unit { int pm, pn; };
struct Gemm { const bf16_t* A; const bf16_t* Bt; int M, N, K; };

struct StaticOrder {
    int nM, nN, nwg, G, c;
    __host__ __device__ void init(int M, int N, int G_, int c_) { nM = M / BM; nN = N / BM; nwg = nM * nN; G = G_; c = c_; }
    __host__ __device__ bool next(int i, Unit& u) const {
        const long L = (long)i * G + c; if (L >= nwg) return false;
        int wgid = (int)L; { const int q = nwg / NXCD, r = nwg % NXCD, xcd = wgid % NXCD, off = wgid / NXCD; wgid = (xcd < r ? xcd * (q + 1) : r * (q + 1) + (xcd - r) * q) + off; }
        const int nig = WGM * nN, gid = wgid / nig, fm = gid * WGM, gsz = (nM - fm) < WGM ? (nM - fm) : WGM;
        u.pm = fm + ((wgid % nig) % gsz); u.pn = (wgid % nig) / gsz; return true;
    }
    __device__ __forceinline__ void a_ready(const Unit&) const {}
    __device__ __forceinline__ void done(const Unit&) const {}
};


template <class Epi, class Sched, bool ALIGN_EPI = false, bool SP2 = false>
__device__ __forceinline__ void gemm_phase(PG8_LAS unsigned char* lds, const Gemm g, const Sched& S, const Epi& E, int wave_id  , unsigned long long& tacc_  ) {
    const int lane = (int)__builtin_amdgcn_mbcnt_hi(~0u, __builtin_amdgcn_mbcnt_lo(~0u, 0u)), wid = wave_id, tid = wid * 64 + lane, wr = wid >> 2, wc = wid & 3, fr = lane & 15, fq = lane >> 4;
    const int K = g.K, nt = K / BK;
    unsigned voffA[2], voffB[2];
#pragma unroll
    for (int i = 0; i < 2; ++i) { int R, C; stage_rc(tid * 16 + i * 8192, R, C); const int Rb = Epi::PERM ? ((R & ~31) + perm32(R & 31)) : R;
        voffA[i] = (unsigned)(R * K + C) * 2u; voffB[i] = (unsigned)(Rb * K + C) * 2u; }
    const size_t kstep = (size_t)(BK * 2);
    const size_t hstep = (size_t)HALF * K * 2;
    const size_t tstep = 2 * hstep;
    const unsigned ldsw = (unsigned)wid * 1024u;
    const int aoff = lds_byte(wr * 64 + fr, fq * 8), boff = lds_byte(wc * 32 + fr, fq * 8);
#define PG8_SA(b, h) (((b) * 2 + (h)) * HTB)
#define PG8_SB(b, h) ((4 + (b) * 2 + (h)) * HTB)
#define PG8_STAGE(bufoff, gbase, voff) do { _Pragma("unroll") for (int _i = 0; _i < 2; ++_i) \
        __builtin_amdgcn_global_load_lds((const unsigned*)((const char*)(gbase) + (voff)[_i]), (PG8_LAS unsigned*)(lds + (bufoff) + ldsw + _i * 8192), 16, 0, 0); } while (0)
#define PG8_LDA(dst, b, h) do { _Pragma("unroll") for (int m = 0; m < 4; ++m) _Pragma("unroll") for (int k = 0; k < 2; ++k) dst[m][k] = *(const PG8_LAS bf16x8*)(lds + PG8_SA(b, h) + aoff + m * 2048 + k * 1024); } while (0)
#define PG8_LDB(dst, b, h) do { _Pragma("unroll") for (int n = 0; n < 2; ++n) _Pragma("unroll") for (int k = 0; k < 2; ++k) dst[n][k] = *(const PG8_LAS bf16x8*)(lds + PG8_SB(b, h) + boff + n * 2048 + k * 1024); } while (0)
#define PG8_MMA(ai, bj, At, Bt) do { __builtin_amdgcn_s_setprio(1); _Pragma("unroll") for (int m = 0; m < 4; ++m) _Pragma("unroll") for (int n = 0; n < 2; ++n) _Pragma("unroll") for (int k = 0; k < 2; ++k) \
        acc[ai][bj][m][n] = __builtin_amdgcn_mfma_f32_16x16x32_bf16(Bt[n][k], At[m][k], acc[ai][bj][m][n], 0, 0, 0); __builtin_amdgcn_s_setprio(0); } while (0)
#define PG8_WAIT_V(n) asm volatile("s_waitcnt vmcnt(" #n ")" ::: "memory")
#define PG8_WAIT_L(n) asm volatile("s_waitcnt lgkmcnt(" #n ")" ::: "memory")
#define PG8_BAR __builtin_amdgcn_s_barrier()
#define PG8_SCHED __builtin_amdgcn_sched_barrier(0)
    Unit cur, nxt; int ui = 0;
    if (!S.next(0, cur)) return;
    f32x4 acc[2][2][4][2];
#pragma unroll
    for (int a = 0; a < 2; ++a)
#pragma unroll
        for (int b = 0; b < 2; ++b)
#pragma unroll
            for (int m = 0; m < 4; ++m)
#pragma unroll
                for (int n = 0; n < 2; ++n) acc[a][b][m][n] = (f32x4){0.f, 0.f, 0.f, 0.f};
    bf16x8 At[4][2], B0[2][2], B1[2][2];
    const char* cA = (const char*)g.A + (size_t)cur.pm * tstep; const char* cB = (const char*)g.Bt + (size_t)cur.pn * tstep;
    S.a_ready(cur);
    if constexpr (SP2) {
        PG8_STAGE(PG8_SB(0, 0), cB, voffB); PG8_STAGE(PG8_SB(0, 1), cB + hstep, voffB); PG8_STAGE(PG8_SA(0, 0), cA, voffA); PG8_STAGE(PG8_SA(0, 1), cA + hstep, voffA);
        if (wr == 1) PG8_BAR;
        PG8_WAIT_V(2); PG8_BAR;
        PG8_STAGE(PG8_SB(1, 0), cB + kstep, voffB); PG8_STAGE(PG8_SA(1, 0), cA + kstep, voffA); PG8_STAGE(PG8_SB(1, 1), cB + hstep + kstep, voffB);
        PG8_WAIT_V(6); PG8_BAR;
    } else {
        PG8_STAGE(PG8_SB(0, 0), cB, voffB); PG8_STAGE(PG8_SA(0, 0), cA, voffA); PG8_STAGE(PG8_SB(0, 1), cB + hstep, voffB); PG8_STAGE(PG8_SA(0, 1), cA + hstep, voffA);
        if (wr == 1) PG8_BAR;
        PG8_WAIT_V(4); PG8_BAR;
        PG8_STAGE(PG8_SB(1, 0), cB + kstep, voffB); PG8_STAGE(PG8_SA(1, 0), cA + kstep, voffA); PG8_STAGE(PG8_SB(1, 1), cB + hstep + kstep, voffB);
        PG8_WAIT_V(6); PG8_BAR;
    }
    for (;;) {
        const bool has_next = S.next(ui + 1, nxt);
        const char* nA = has_next ? (const char*)g.A + (size_t)nxt.pm * tstep : cA; const char* nB = has_next ? (const char*)g.Bt + (size_t)nxt.pn * tstep : cB;
        for (int t = 0; t < nt; t += 2) {
            const bool last = (t == nt - 2);
            const char* a1 = cA + (size_t)(t + 1) * kstep;
            const char* a2 = last ? nA : cA + (size_t)(t + 2) * kstep; const char* b2 = last ? nB : cB + (size_t)(t + 2) * kstep;
            const char* a3 = a2 + kstep; const char* b3 = b2 + kstep;
            if (last && has_next) S.a_ready(nxt);
            if constexpr (SP2) {
            PG8_LDB(B0, 0, 0); PG8_LDB(B1, 0, 1); PG8_SCHED; PG8_LDA(At, 0, 0); PG8_STAGE(PG8_SA(1, 1), a1 + hstep, voffA);
            PG8_WAIT_V(8); PG8_WAIT_L(0); PG8_BAR; PG8_MMA(0, 0, At, B0); PG8_MMA(0, 1, At, B1); PG8_BAR; PG8_SCHED;
            PG8_LDA(At, 0, 1); PG8_STAGE(PG8_SB(0, 0), b2, voffB); PG8_STAGE(PG8_SB(0, 1), b2 + hstep, voffB); PG8_STAGE(PG8_SA(0, 0), a2, voffA);
            PG8_WAIT_V(8); PG8_WAIT_L(0); PG8_BAR; PG8_MMA(1, 0, At, B0); PG8_MMA(1, 1, At, B1); PG8_BAR; PG8_SCHED;
            PG8_LDB(B0, 1, 0); PG8_LDB(B1, 1, 1); PG8_SCHED; PG8_LDA(At, 1, 0); PG8_STAGE(PG8_SA(0, 1), a2 + hstep, voffA);
            PG8_WAIT_V(8); PG8_WAIT_L(0); PG8_BAR; PG8_MMA(0, 0, At, B0); PG8_MMA(0, 1, At, B1); PG8_BAR; PG8_SCHED;
            PG8_LDA(At, 1, 1); PG8_STAGE(PG8_SB(1, 0), b3, voffB); PG8_STAGE(PG8_SB(1, 1), b3 + hstep, voffB); PG8_STAGE(PG8_SA(1, 0), a3, voffA);
            PG8_WAIT_V(8); PG8_WAIT_L(0); PG8_BAR; PG8_MMA(1, 0, At, B0); PG8_MMA(1, 1, At, B1); PG8_BAR; PG8_SCHED;
            } else {
            PG8_LDB(B0, 0, 0); PG8_SCHED; PG8_LDA(At, 0, 0); PG8_STAGE(PG8_SA(1, 1), a1 + hstep, voffA);
            PG8_WAIT_L(8); PG8_BAR; PG8_WAIT_L(0); PG8_MMA(0, 0, At, B0); PG8_BAR; PG8_SCHED;
            PG8_LDB(B1, 0, 1); PG8_STAGE(PG8_SB(0, 0), b2, voffB);
            PG8_BAR; PG8_WAIT_L(0); PG8_MMA(0, 1, At, B1); PG8_BAR;
            PG8_LDA(At, 0, 1); PG8_STAGE(PG8_SA(0, 0), a2, voffA);
            PG8_BAR; PG8_WAIT_L(0); PG8_MMA(1, 0, At, B0); PG8_BAR; PG8_SCHED;
            PG8_STAGE(PG8_SB(0, 1), b2 + hstep, voffB);
            PG8_WAIT_V(6); PG8_BAR; PG8_MMA(1, 1, At, B1); PG8_BAR;
            PG8_LDB(B0, 1, 0); PG8_SCHED; PG8_LDA(At, 1, 0); PG8_STAGE(PG8_SA(0, 1), a2 + hstep, voffA);
            PG8_WAIT_L(8); PG8_BAR; PG8_WAIT_L(0); PG8_MMA(0, 0, At, B0); PG8_BAR; PG8_SCHED;
            PG8_LDB(B1, 1, 1); PG8_STAGE(PG8_SB(1, 0), b3, voffB);
            PG8_BAR; PG8_WAIT_L(0); PG8_MMA(0, 1, At, B1); PG8_BAR;
            PG8_LDA(At, 1, 1); PG8_STAGE(PG8_SA(1, 0), a3, voffA);
            PG8_BAR; PG8_WAIT_L(0); PG8_MMA(1, 0, At, B0); PG8_BAR; PG8_SCHED;
            PG8_STAGE(PG8_SB(1, 1), b3 + hstep, voffB);
            PG8_WAIT_V(6); PG8_BAR; PG8_MMA(1, 1, At, B1); PG8_BAR;
            }
        }
        if constexpr (ALIGN_EPI) { if (wr == 0) PG8_BAR; }
#ifdef PROBE_EPI
        { const unsigned long long t0_ = __builtin_readcyclecounter(); E(acc, cur, wr, wc, fr, fq); asm volatile("s_waitcnt vmcnt(0)" ::: "memory"); tacc_ += __builtin_readcyclecounter() - t0_; S.done(cur); }
#else
        if constexpr (!Epi::AFTER_DRAIN) { E(acc, cur, wr, wc, fr, fq); S.done(cur); }
#endif
        if (!has_next) break;
#pragma unroll
        for (int a = 0; a < 2; ++a)
#pragma unroll
            for (int b = 0; b < 2; ++b)
#pragma unroll
                for (int m = 0; m < 4; ++m)
#pragma unroll
                    for (int n = 0; n < 2; ++n) acc[a][b][m][n] = (f32x4){0.f, 0.f, 0.f, 0.f};
        cur = nxt; cA = nA; cB = nB; ++ui;
        if constexpr (ALIGN_EPI) { if (wr == 1) PG8_BAR; }
    }
    PG8_WAIT_V(0);
    if constexpr (!ALIGN_EPI) { if (wr == 0) PG8_BAR; }
    PG8_BAR;
    if constexpr (Epi::AFTER_DRAIN) { E.fused(acc, cur, wr, wc, fr, fq, lds, wid, lane); S.done(cur); }
#undef PG8_SA
#undef PG8_SB
#undef PG8_STAGE
#undef PG8_LDA
#undef PG8_LDB
#undef PG8_MMA
#undef PG8_WAIT_V
#undef PG8_WAIT_L
#undef PG8_BAR
#undef PG8_SCHED
}
}
#define XB_TMO      128
#define XB_XCNT(j)  (256  + 64 * (j))
#define XB_XSUB(j)  (1280 + 64 * (j))
#define XB_XGEN(j)  (2304 + 64 * (j))
#define XB_TOP      3328
#define XB_TOPGEN   3392
#define XCD_BAR_WORDS 3456
#define XB_SPIN_CAP (1u << 18)

__device__ __forceinline__ unsigned xb_ld(unsigned* p)              { return __hip_atomic_load(p, __ATOMIC_RELAXED, __HIP_MEMORY_SCOPE_AGENT); }
__device__ __forceinline__ unsigned xb_add(unsigned* p, unsigned v) { return __hip_atomic_fetch_add(p, v, __ATOMIC_RELAXED, __HIP_MEMORY_SCOPE_AGENT); }
__device__ __forceinline__ unsigned xb_xcc_id() { return (unsigned)__builtin_amdgcn_s_getreg((3 << 11) | 20) & 0xFu; }
#define XB_SPIN(cond, bar) do { unsigned _sp = 0; while (cond) { __builtin_amdgcn_s_sleep(1); \
    if ((++_sp & 255u) == 0u) { if (xb_ld(&(bar)[XB_TMO])) break; if (_sp > XB_SPIN_CAP) { atomicAdd(&(bar)[XB_TMO], 1u); break; } } } } while (0)

struct XcdBarrier {
    unsigned* bar; unsigned x;
    volatile LAS unsigned* st;
};

__device__ __forceinline__ XcdBarrier xcd_barrier_post(unsigned* bar, volatile LAS unsigned* st) {
    XcdBarrier b; b.bar = bar; b.x = xb_xcc_id(); b.st = st;
    if (threadIdx.x == 0) (void)xb_add(&bar[XB_XCNT(b.x)], 1u);
    return b;
}
__device__ __forceinline__ void xcd_barrier_complete(unsigned* bar, unsigned x, unsigned& nloc, unsigned& nx) {
    const unsigned G = gridDim.x * gridDim.y * gridDim.z;
    unsigned sum, cnt, mine, sp = 0u;
    for (;;) {
        sum = 0u; cnt = 0u; mine = 0u;
#pragma unroll
        for (unsigned j = 0; j < 16; ++j) { const unsigned c = xb_ld(&bar[XB_XCNT(j)]); sum += c; cnt += (c > 0u) ? 1u : 0u; mine = (j == x) ? c : mine; }
        if (sum == G) break;
        __builtin_amdgcn_s_sleep(1);
        if ((++sp & 255u) == 0u) { if (xb_ld(&bar[XB_TMO])) break; if (sp > XB_SPIN_CAP) { atomicAdd(&bar[XB_TMO], 1u); break; } }
    }
    nloc = mine > 0u ? mine : 1u; nx = cnt > 0u ? cnt : 1u;
}

__device__ __forceinline__ void xcd_barrier(const XcdBarrier& b, bool leader  ) {
    asm volatile("s_waitcnt vmcnt(0)" ::: "memory");
    __syncthreads();
    if (leader) {
        unsigned* bar = b.bar;
        __builtin_amdgcn_s_waitcnt(0);
        unsigned nloc = b.st[0], nx = b.st[1];
        if (nloc == 0u) { xcd_barrier_complete(bar, b.x, nloc, nx); b.st[0] = nloc; b.st[1] = nx; }
        const unsigned old = xb_add(&bar[XB_XSUB(b.x)], 1u);
        const unsigned gen = old / nloc;
        if (old + 1u == (gen + 1u) * nloc) {
            __builtin_amdgcn_fence(__ATOMIC_RELEASE, "agent");
            asm volatile("s_waitcnt vmcnt(0)" ::: "memory");
            const unsigned og = xb_add(&bar[XB_TOP], 1u);
            const unsigned tg = og / nx;
            if (og + 1u == (tg + 1u) * nx) xb_add(&bar[XB_TOPGEN], 1u);
            else XB_SPIN(xb_ld(&bar[XB_TOPGEN]) == tg, bar);
            __builtin_amdgcn_fence(__ATOMIC_ACQUIRE, "agent");
            xb_add(&bar[XB_XGEN(b.x)], 1u);
            asm volatile("s_waitcnt vmcnt(0)" ::: "memory");
        } else {
            XB_SPIN(xb_ld(&bar[XB_XGEN(b.x)]) == gen, bar);
            __builtin_amdgcn_fence(__ATOMIC_ACQUIRE, "agent");
            asm volatile("s_waitcnt vmcnt(0)" ::: "memory");
        }
    }
    __syncthreads();
}
using pg8::f32x4; using pg8::bf16x8;
constexpr int NWAVES = 8;
constexpr int BATCH = 4, T = 8192, D = 1024, M = BATCH * T, NP = 4096, INW = 3864;
constexpr int DECB = 32, PAST = 16384, NPAGES = 128, NCS = 512  ;
constexpr float NORM_EPS = 1e-6f;
constexpr float LOG2E = 1.4426950408889634f;
constexpr float QSCALE = 0.125f * LOG2E;
constexpr size_t O_Y = 0, O_YS = 33554432, O_PCMP = 33587200, O_PSLC = 41975808, O_PWIN = 50364416, O_PCONV = 50888704,
                 O_SCMP = 50892800, O_SSLC = 50900992, O_SWIN = 50909184, O_SCONV = 55103488, O_END = 55136256;
constexpr int C_BG = 0, C_CG = 512, C_CI = 1024, C_ZC = 1536, C_Q = 2048, C_KV = 2560, C_GL = 3328, C_ZA = 3352;

constexpr size_t MiB = 1u << 20, KiB = 1u << 10;
constexpr size_t WS_CTL = 0, CTL_ZERO_BYTES = 1 * MiB;
constexpr size_t WS_BT1 = 2 * MiB;
constexpr size_t WS_BT2 = 10 * MiB;
constexpr size_t WS_BTC = 12 * MiB;
constexpr size_t WS_CBIAS = 12 * MiB + 512 * KiB;
constexpr size_t WS_CONST = WS_CBIAS + 4 * KiB;
constexpr size_t WS_ROPE = 13 * MiB;
constexpr size_t WS_RSTD = 16 * MiB;
constexpr size_t WS_XSB = 16 * MiB + 256 * KiB;
constexpr size_t WS_RSTDS = WS_XSB + 64 * KiB;
constexpr size_t WS_GATE = 17 * MiB;
constexpr size_t WS_KC = 20 * MiB;
constexpr size_t WS_VCT = WS_KC + 256 * KiB;
constexpr size_t WS_PROJS = 21 * MiB;
constexpr size_t WS_QS = 22 * MiB;
constexpr size_t WS_KVN = WS_QS + 64 * KiB;
constexpr size_t WS_GS = WS_KVN + 96 * KiB;
constexpr size_t WS_ZAS = WS_GS + 4 * KiB;
constexpr size_t WS_MIXS = WS_ZAS + 64 * KiB;
constexpr size_t WS_KCS = 24 * MiB;
constexpr size_t WS_KS = 40 * MiB, WS_VTS = 48 * MiB, WS_KW = 56 * MiB, WS_VTW = 64 * MiB;
constexpr size_t WS_XB = 72 * MiB;
constexpr size_t WS_CG = 136 * MiB, WS_U = 168 * MiB, WS_ZA = 200 * MiB, WS_Q = 232 * MiB;
constexpr size_t WS_MIX = 264 * MiB;
constexpr size_t WS_TOT = 328 * MiB;
constexpr size_t WS_END = 344 * MiB;
constexpr int CW_TMO = 0, CW_CODE = 1;
constexpr int CW_BAR = 4096;
constexpr int CW_QUEUE = 16384;
constexpr int CW_P0CNT = 18432;
constexpr int CW_KCMAX = 20480;

constexpr int RING_OFF = 0, RING_BYTES = 131072;
constexpr int LDSCTL_OFF = RING_BYTES, MISC_OFF = LDSCTL_OFF + 320;
constexpr int LDS_BYTES = 147456;

__device__ __forceinline__ unsigned f2bf(float f) { unsigned u = __builtin_bit_cast(unsigned, f); return (u + 0x7fffu + ((u >> 16) & 1u)) >> 16; }
typedef __bf16 bf16x2_t __attribute__((ext_vector_type(2)));
__device__ __forceinline__ unsigned pk2(float lo, float hi) { return __builtin_bit_cast(unsigned, __builtin_convertvector((f32x2){lo, hi}, bf16x2_t)); }
__device__ __forceinline__ float bf2f(unsigned h) { return __builtin_bit_cast(float, h << 16); }
__device__ __forceinline__ float wave_sum(float v) {
#pragma unroll
    for (int o = 1; o < 64; o <<= 1) v += __shfl_xor(v, o);
    return v;
}
__device__ __forceinline__ float quad_sum(float v) {
    v += __builtin_bit_cast(float, __builtin_amdgcn_update_dpp(0, __builtin_bit_cast(int, v), 0xB1, 0xF, 0xF, true));
    v += __builtin_bit_cast(float, __builtin_amdgcn_update_dpp(0, __builtin_bit_cast(int, v), 0x4E, 0xF, 0xF, true));
    return v;
}
__device__ __forceinline__ float fast_exp2(float x) { return __builtin_amdgcn_exp2f(x); }
__device__ __forceinline__ float sigmoidf(float x) { return __builtin_amdgcn_rcpf(1.0f + fast_exp2(-x * LOG2E)); }
__device__ __forceinline__ int perm16(int kk) { return 8 * ((kk >> 2) & 1) + 4 * (kk >> 3) + (kk & 3); }

struct Ptrs {
    const float *xp, *xs, *cache_cmp, *cache_slc, *st_win, *st_conv; const int* page_table;
    const float *norm_g, *w_in, *conv_w, *conv_b, *q_gain, *k_gain, *cmp_pe, *cmp_w, *w_out;
    float* out; unsigned char* ws;
};
struct Frame {
    LAS unsigned char* lds;
    volatile LAS unsigned* MISC;
    gu32* ctl;
    int tid, lane, wave, G, gw, NGW;
};
__device__ __forceinline__ int bt1_src(int dg, int& nvalid) {
    const int pn = dg >> 3, gi = dg & 7, bj = gi >> 2, wc = gi & 3; nvalid = 32;
    if (pn < 4) return (bj ? C_ZC : C_BG) + 128 * pn + 32 * wc;
    if (pn < 8) return (bj ? C_CI : C_CG) + 128 * (pn - 4) + 32 * wc;
    if (pn < 10) return C_Q + (4 * (pn - 8) + wc) * 64 + 32 * bj;
    if (pn < 13) return C_KV + (pn - 10) * 256 + wc * 64 + 32 * bj;
    if (pn < 15) return C_ZA + 256 * (pn - 13) + 32 * gi;
    nvalid = (gi == 0) ? 24 : 0; return C_GL;
}
__device__ __forceinline__ void p0_transpose_item(const float* W, int ldw, int k0, int src0, int nvalid, const float* ksc, bf16* WT, int ldt, int drow0, LAS float* scr, int lane) {
    const int nn = lane & 31;
#pragma unroll 8
    for (int i = 0; i < 32; ++i) { const int kk = 2 * i + (lane >> 5); float v = 0.f;
        if (nn < nvalid) { v = W[(size_t)(k0 + kk) * ldw + src0 + nn]; if (ksc) v *= ksc[k0 + kk]; }
        scr[kk * 33 + nn] = v; }
    LDS_WAIT(); asm volatile("" ::: "memory");
    const int c = lane & 7;
#pragma unroll
    for (int j = 0; j < 4; ++j) { const int n = (lane >> 3) + 8 * j; const LAS float* s = scr + (8 * c) * 33 + n;
        v4u o; o.x = pk2(s[0 * 33], s[1 * 33]); o.y = pk2(s[2 * 33], s[3 * 33]); o.z = pk2(s[4 * 33], s[5 * 33]); o.w = pk2(s[6 * 33], s[7 * 33]);
        *(GAS v4u*)(WT + (size_t)(drow0 + n) * ldt + k0 + 8 * c) = o; }
    LDS_WAIT(); asm volatile("" ::: "memory");
}
template <int NR>
__device__ __forceinline__ void x_rows_to_bf16(const float* xrow, bf16* orow, float* rstd_out, int lane) {
    f32x4 v[NR][4]; float s[NR];
#pragma unroll
    for (int r = 0; r < NR; ++r)
#pragma unroll
        for (int j = 0; j < 4; ++j) v[r][j] = ((const GAS f32x4*)(xrow + (size_t)r * D) + lane)[64 * j];
#pragma unroll
    for (int r = 0; r < NR; ++r) { s[r] = 0.f;
#pragma unroll
        for (int j = 0; j < 4; ++j) s[r] += (v[r][j].x * v[r][j].x + v[r][j].y * v[r][j].y) + (v[r][j].z * v[r][j].z + v[r][j].w * v[r][j].w); }
#pragma unroll
    for (int o = 1; o < 64; o <<= 1)
#pragma unroll
        for (int r = 0; r < NR; ++r) s[r] += __shfl_xor(s[r], o);
#pragma unroll
    for (int r = 0; r < NR; ++r) { GAS unsigned long long* o8 = (GAS unsigned long long*)(orow + (size_t)r * D) + lane;
#pragma unroll
        for (int j = 0; j < 4; ++j) o8[64 * j] = (unsigned long long)pk2(v[r][j].x, v[r][j].y) | ((unsigned long long)pk2(v[r][j].z, v[r][j].w) << 32);
        if (lane == 0) rstd_out[r] = 1.0f / sqrtf(s[r] * (1.0f / D) + NORM_EPS); }
}
template <bool SAMPLE>
__device__ __forceinline__ const float* cmp_rowbase(const Ptrs& P, int unit, int rho) {
    const int b = SAMPLE ? unit >> 6 : unit >> 5, c = (SAMPLE ? (unit & 63) : (unit & 31)) * 8 + (rho >> 1), g = rho & 1;
    if (SAMPLE) { const int page = P.page_table[b * NPAGES + (c >> 2)]; return P.cache_cmp + ((size_t)page * 128 + (c & 3) * 32) * 256 + g * 64; }
    return P.out + O_PCMP + ((size_t)b * T + c * 32) * 256 + g * 64;
}
template <bool SAMPLE>
__device__ __forceinline__ void compress_units(const Ptrs& P, Frame& F, LAS float* part  ) {
    constexpr int NUNITS = SAMPLE ? DECB * (NCS / 8) : BATCH * 32;
    const int lane = F.lane, w = F.wave, rho = lane & 15, kq = lane >> 4;
    const GAS v4u* bfr = (const GAS v4u*)(P.ws + WS_BTC) + lane;
    const float* cbias = (const float*)(P.ws + WS_CBIAS);
    int unit = blockIdx.x;
    if (unit >= NUNITS) return;
    f32x4 a_cur[8], a_n1[8], a_n2[8];
    const float* rb = cmp_rowbase<SAMPLE>(P, unit, rho) + 4 * kq;
#define CMP_LOAD(dst, base, r) do { _Pragma("unroll") for (int q_ = 0; q_ < 4; ++q_) { dst[2 * q_] = *(const GAS f32x4*)((base) + (r) * 256 + (q_ >> 1) * 128 + (q_ & 1) * 32); dst[2 * q_ + 1] = *(const GAS f32x4*)((base) + (r) * 256 + (q_ >> 1) * 128 + (q_ & 1) * 32 + 16); } } while (0)
    CMP_LOAD(a_cur, rb, 4 * w); CMP_LOAD(a_n1, rb, 4 * w + 1);
    for (;;) {
        f32x4 acc[2][4];
#pragma unroll
        for (int j = 0; j < 2; ++j)
#pragma unroll
            for (int e = 0; e < 4; ++e) acc[j][e] = (f32x4){0.f, 0.f, 0.f, 0.f};
        const int nunit = unit + F.G; const bool has_next = nunit < NUNITS;
        const float* rbn = has_next ? cmp_rowbase<SAMPLE>(P, nunit, rho) + 4 * kq : rb;
#pragma unroll 1
        for (int rr = 0; rr < 4; ++rr) {
            const int r = 4 * w + rr;
            bf16x8 bb[16];
#pragma unroll
            for (int q_ = 0; q_ < 4; ++q_)
#pragma unroll
                for (int et = 0; et < 4; ++et) bb[q_ * 4 + et] = __builtin_bit_cast(bf16x8, bfr[(size_t)(((((q_ >> 1) * 32 + r) * 2 + (q_ & 1)) * 4 + et) * 64)]);
            __builtin_amdgcn_sched_barrier(0);
            { const float* nb_ = rr < 2 ? rb : rbn; const int nr_ = rr < 2 ? r + 2 : 4 * w + (rr - 2); CMP_LOAD(a_n2, nb_, nr_); }
            __builtin_amdgcn_sched_barrier(0);
#pragma unroll
            for (int q_ = 0; q_ < 4; ++q_) { const int j = q_ >> 1;
                v4u wv; wv.x = pk2(a_cur[2 * q_].x, a_cur[2 * q_].y); wv.y = pk2(a_cur[2 * q_].z, a_cur[2 * q_].w); wv.z = pk2(a_cur[2 * q_ + 1].x, a_cur[2 * q_ + 1].y); wv.w = pk2(a_cur[2 * q_ + 1].z, a_cur[2 * q_ + 1].w);
                const bf16x8 af = __builtin_bit_cast(bf16x8, wv);
#pragma unroll
                for (int et = 0; et < 4; ++et) acc[j][et] = __builtin_amdgcn_mfma_f32_16x16x32_bf16(af, bb[q_ * 4 + et], acc[j][et], 0, 0, 0); }
#pragma unroll
            for (int q_ = 0; q_ < 8; ++q_) { a_cur[q_] = a_n1[q_]; a_n1[q_] = a_n2[q_]; }
        }
#pragma unroll
        for (int j = 0; j < 2; ++j)
#pragma unroll
            for (int et = 0; et < 4; ++et) *(LAS f32x4*)(part + ((w * 8 + j * 4 + et) * 64 + lane) * 4) = acc[j][et];
        __syncthreads();
        { const int j = w >> 2, et = w & 3, e = 16 * et + rho; f32x4 sum = *(const LAS f32x4*)(part + ((0 * 8 + w) * 64 + lane) * 4);
#pragma unroll
          for (int ww = 1; ww < 8; ++ww) sum = sum + *(const LAS f32x4*)(part + ((ww * 8 + w) * 64 + lane) * 4);
          const float bs = cbias[j * 64 + e]; const int b = SAMPLE ? unit >> 6 : unit >> 5, c0 = (SAMPLE ? (unit & 63) : (unit & 31)) * 8;
          float nmax = 0.f;
#pragma unroll
          for (int i = 0; i < 4; ++i) { const int row = 4 * kq + i, c = c0 + (row >> 1), g = row & 1; const float val = sum[i] + bs;
              float q2 = val * val; q2 += __shfl_xor(q2, 1); q2 += __shfl_xor(q2, 2); q2 += __shfl_xor(q2, 4); q2 += __shfl_xor(q2, 8); nmax = fmaxf(nmax, q2);
              if (SAMPLE) ((float*)(P.ws + WS_KCS))[((size_t)((b * 2 + g) * 2 + j) * NCS + c) * 64 + e] = val;
              else if (j == 0) ((bf16*)(P.ws + WS_KC))[((size_t)(b * 2 + g) * 256 + c) * 64 + e] = (bf16)f2bf(val);
              else ((bf16*)(P.ws + WS_VCT))[((size_t)(b * 2 + g) * 64 + e) * 256 + (c & ~15) + perm16(c & 15)] = (bf16)f2bf(val); }
          if (j == 0) { nmax = fmaxf(nmax, __shfl_xor(nmax, 16)); nmax = fmaxf(nmax, __shfl_xor(nmax, 32));
              if (lane == 0) atomicMax((unsigned*)(P.ws + WS_CTL) + CW_KCMAX + (SAMPLE ? 64 : 0) + et, __builtin_bit_cast(unsigned, nmax)); } }
        __syncthreads();
        if (!has_next) break;
        unit = nunit; rb = rbn;
    }
#undef CMP_LOAD
}
constexpr int CMP_NPASS = DECB * 16;
__device__ __forceinline__ void lds_wait_ge(volatile LAS unsigned* c, unsigned want) { unsigned sp = 0u; while (*c < want) { __builtin_amdgcn_s_sleep(1); if (++sp > (1u << 24)) break; } }
__device__ __forceinline__ void compress_team(const Ptrs& P, Frame& F, LAS unsigned char* bl  , volatile LAS unsigned* cw  , volatile LAS unsigned* cr  , int npass) {
    const int lane = F.lane, w = F.wave, tid = w * 64 + lane, rho = lane & 15, kq = lane >> 4;
    unsigned nw_ = 0u, nr_ = 0u;
    for (int pi = 0; pi < npass; ++pi) { const int pass = blockIdx.x + pi * F.G;
    const int b = pass >> 4, c0 = (pass & 15) * 32 + w * 8;
    const float* rb; { const int c = c0 + (rho >> 1), g = rho & 1; const int page = P.page_table[b * NPAGES + (c >> 2)]; rb = P.cache_cmp + ((size_t)page * 128 + (c & 3) * 32) * 256 + g * 64 + 4 * kq; }
    const GAS v4u* bsrc = (const GAS v4u*)(P.ws + WS_BTC);
    const int sf = tid >> 4, sj = sf >> 3, sdh = (sf >> 2) & 1, set_ = sf & 3, sl = (tid & 15) * 4;
#define B_SRC(r) (bsrc + (size_t)((((sj * 32 + (r)) * 2 + sdh) * 4 + set_) * 64 + sl))
    LAS v4u* bdst = (LAS v4u*)bl + sf * 64 + sl;
    f32x4 a_cur[8], a_n1[8], a_n2[8], a_n3[8];
#define CMP_LOAD(dst, base, r) do { _Pragma("unroll") for (int q_ = 0; q_ < 4; ++q_) { dst[2 * q_] = *(const GAS f32x4*)((base) + (r) * 256 + (q_ >> 1) * 128 + (q_ & 1) * 32); dst[2 * q_ + 1] = *(const GAS f32x4*)((base) + (r) * 256 + (q_ >> 1) * 128 + (q_ & 1) * 32 + 16); } } while (0)
    { const v4u b0 = B_SRC(0)[0], b1 = B_SRC(0)[1], b2 = B_SRC(0)[2], b3 = B_SRC(0)[3];
      lds_wait_ge(cr, 4u * nr_);
      bdst[0] = b0; bdst[1] = b1; bdst[2] = b2; bdst[3] = b3; LDS_WAIT(); ++nw_; if (lane == 0) __hip_atomic_fetch_add((LAS unsigned*)cw, 1u, __ATOMIC_RELAXED, __HIP_MEMORY_SCOPE_WORKGROUP); }
    CMP_LOAD(a_cur, rb, 0); CMP_LOAD(a_n1, rb, 1); CMP_LOAD(a_n2, rb, 2);
    f32x4 acc[2][4];
#pragma unroll
    for (int j = 0; j < 2; ++j)
#pragma unroll
        for (int e = 0; e < 4; ++e) acc[j][e] = (f32x4){0.f, 0.f, 0.f, 0.f};
#pragma unroll 1
    for (int r = 0; r < 32; ++r) {
        const int rn = r + 1 < 32 ? r + 1 : 31, r3 = r + 3 < 32 ? r + 3 : 31;
        const v4u b0 = B_SRC(rn)[0], b1 = B_SRC(rn)[1], b2 = B_SRC(rn)[2], b3 = B_SRC(rn)[3];
        __builtin_amdgcn_sched_barrier(0);
        CMP_LOAD(a_n3, rb, r3);
        __builtin_amdgcn_sched_barrier(0);
        lds_wait_ge(cw, 4u * nw_);
        const LAS v4u* bf = (const LAS v4u*)bl + (r & 1) * 1024 + lane;
#pragma unroll
        for (int q_ = 0; q_ < 4; ++q_) { const int j = q_ >> 1;
            v4u wv; wv.x = pk2(a_cur[2 * q_].x, a_cur[2 * q_].y); wv.y = pk2(a_cur[2 * q_].z, a_cur[2 * q_].w); wv.z = pk2(a_cur[2 * q_ + 1].x, a_cur[2 * q_ + 1].y); wv.w = pk2(a_cur[2 * q_ + 1].z, a_cur[2 * q_ + 1].w);
            const bf16x8 af = __builtin_bit_cast(bf16x8, wv);
#pragma unroll
            for (int et = 0; et < 4; ++et) acc[j][et] = __builtin_amdgcn_mfma_f32_16x16x32_bf16(af, __builtin_bit_cast(bf16x8, bf[(q_ * 4 + et) * 64]), acc[j][et], 0, 0, 0); }
        LDS_WAIT(); ++nr_; if (lane == 0) __hip_atomic_fetch_add((LAS unsigned*)cr, 1u, __ATOMIC_RELAXED, __HIP_MEMORY_SCOPE_WORKGROUP);
        if (r + 1 < 32) { lds_wait_ge(cr, 4u * (nr_ - 1u));
            LAS v4u* d_ = bdst + ((r + 1) & 1) * 1024; d_[0] = b0; d_[1] = b1; d_[2] = b2; d_[3] = b3; LDS_WAIT(); ++nw_; if (lane == 0) __hip_atomic_fetch_add((LAS unsigned*)cw, 1u, __ATOMIC_RELAXED, __HIP_MEMORY_SCOPE_WORKGROUP); }
#pragma unroll
        for (int q_ = 0; q_ < 8; ++q_) { a_cur[q_] = a_n1[q_]; a_n1[q_] = a_n2[q_]; a_n2[q_] = a_n3[q_]; }
    }
#undef CMP_LOAD
#undef B_SRC
    const float* cbias = (const float*)(P.ws + WS_CBIAS);
    float nmax = 0.f;
#pragma unroll
    for (int i = 0; i < 4; ++i) { const int row = 4 * kq + i, c = c0 + (row >> 1), g = row & 1; float q2 = 0.f;
#pragma unroll
        for (int j = 0; j < 2; ++j)
#pragma unroll
            for (int et = 0; et < 4; ++et) { const int e = 16 * et + rho; const float val = acc[j][et][i] + cbias[j * 64 + e]; if (j == 0) q2 += val * val;
                ((float*)(P.ws + WS_KCS))[((size_t)((b * 2 + g) * 2 + j) * NCS + c) * 64 + e] = val; }
        q2 += __shfl_xor(q2, 1); q2 += __shfl_xor(q2, 2); q2 += __shfl_xor(q2, 4); q2 += __shfl_xor(q2, 8); nmax = fmaxf(nmax, q2); }
    nmax = fmaxf(nmax, __shfl_xor(nmax, 16)); nmax = fmaxf(nmax, __shfl_xor(nmax, 32));
    if (lane == 0) atomicMax((unsigned*)(P.ws + WS_CTL) + CW_KCMAX + 64, __builtin_bit_cast(unsigned, nmax));
    }
}
constexpr int P0_PRODUCERS = 641;
__device__ __forceinline__ void p0_small_items(const Ptrs& P, Frame& F) {
    const int lane = F.lane, gw = F.gw;
    if (gw >= P0_PRODUCERS && F.NGW >= P0_PRODUCERS) return;
    for (int item = gw; item < P0_PRODUCERS; item += F.NGW) {
        if (item < 512) { const int it = item * 64 + lane; const int l = it & 63, et = (it >> 6) & 3, dh = (it >> 8) & 1, r = (it >> 9) & 31, j = it >> 14;
            const float* w = P.cmp_w + ((size_t)(r * 2 + j) * 64 + 32 * dh + 4 * (l >> 4)) * 64 + 16 * et + (l & 15);
            v4u o; o.x = pk2(w[0], w[64]); o.y = pk2(w[128], w[192]); o.z = pk2(w[16 * 64], w[17 * 64]); o.w = pk2(w[18 * 64], w[19 * 64]);
            __builtin_amdgcn_raw_buffer_store_b128(o, __builtin_amdgcn_make_buffer_rsrc((void*)(P.ws + WS_BTC), 0, 512 * 1024, 0x00020000), it * 16, 0, 16);
        } else if (item < 640) { const int it = item - 512, j = it >> 6, e = it & 63; float s = 0.f;
            for (int k = lane; k < 2048; k += 64) { const int r = k >> 6, d = k & 63; s += P.cmp_pe[(r * 2 + j) * 64 + d] * P.cmp_w[((size_t)(r * 2 + j) * 64 + d) * 64 + e]; }
            s = wave_sum(s); if (lane == 0) __hip_atomic_store((float*)(P.ws + WS_CBIAS) + it, s, RLX_AGENT);
        } else { float qm = fabsf(P.q_gain[lane]), k1 = fabsf(P.k_gain[64 + lane]), k2 = fabsf(P.k_gain[128 + lane]);
#pragma unroll
            for (int o = 1; o < 64; o <<= 1) { qm = fmaxf(qm, __shfl_xor(qm, o)); k1 = fmaxf(k1, __shfl_xor(k1, o)); k2 = fmaxf(k2, __shfl_xor(k2, o)); }
            if (lane == 0) { float* cst = (float*)(P.ws + WS_CONST); __hip_atomic_store(cst + 0, qm, RLX_AGENT); __hip_atomic_store(cst + 1, 8.0f * qm * k1 * LOG2E * 1.001f, RLX_AGENT); __hip_atomic_store(cst + 2, 8.0f * qm * k2 * LOG2E * 1.001f, RLX_AGENT); } }
        asm volatile("s_waitcnt vmcnt(0)" ::: "memory");
        if (lane == 0) __hip_atomic_fetch_add((unsigned*)(F.ctl + CW_P0CNT), 1u, RLX_AGENT);
    }
}
__device__ __forceinline__ void p0_rope(const Ptrs& P, Frame& F, int gw, int NGW) {
    const int lane = F.lane; const int i = lane & 31;
    const float inv = (float)pow(10000.0, -(double)i / 32.0);
    for (int it = gw * 64 + lane; it < 8193 * 32; it += NGW * 64) { const int p = it >> 5; const int pos = (p == 8192) ? PAST : p;
        const float ang = (float)pos * inv; const double rev = (double)ang * 0.15915494309189535; const float fr = (float)(rev - __builtin_rint(rev));
        float* rt = (float*)(P.ws + WS_ROPE) + (size_t)p * 64; rt[i] = __builtin_amdgcn_cosf(fr); rt[32 + i] = __builtin_amdgcn_sinf(fr); }
}
__device__ __forceinline__ void p0_other_slice(const Ptrs& P, Frame& F, int k, int gw, int NGW, LAS float* scr) {
    const int lane = F.lane;
    if (k < 2) { const int it = gw + k * NGW; if (it < 16 * 128) { const int kb = it >> 7, dg = it & 127; int nv; const int src0 = bt1_src(dg, nv);
        p0_transpose_item(P.w_in, INW, 64 * kb, src0, nv, P.norm_g, (bf16*)(P.ws + WS_BT1), D, 32 * dg, scr, lane); }
    } else if (k == 2) { for (int it = gw; it < 16 * 32; it += NGW) { const int kb = it >> 5, nb = it & 31;
        p0_transpose_item(P.w_out, D, 64 * kb, 32 * nb, 32, nullptr, (bf16*)(P.ws + WS_BT2), D, 32 * nb, scr, lane); }
    } else if (k < 11) { for (int m = (gw + (k - 3) * NGW) * 4; m < M; m += NGW * 4 * 8) x_rows_to_bf16<4>(P.xp + (size_t)m * D, (bf16*)(P.ws + WS_XB) + (size_t)m * D, (float*)(P.ws + WS_RSTD) + m, lane);
    } else if (k == 11) { for (int m = gw; m < DECB; m += NGW) x_rows_to_bf16<1>(P.xs + (size_t)m * D, (bf16*)(P.ws + WS_XSB) + (size_t)m * D, (float*)(P.ws + WS_RSTDS) + m, lane);
        for (int it = gw * 64 + lane; it < DECB * 512; it += NGW * 64) { const int b = it >> 9, ch = it & 511; P.out[O_SCONV + (size_t)b * 1024 + ch] = P.st_conv[(size_t)b * 1024 + 512 + ch]; }
    } else if (k == 12) {
        constexpr int PERB = 511 * 64, TOTAL = DECB * PERB; const GAS f32x4* src = (const GAS f32x4*)P.st_win; GAS f32x4* dst = (GAS f32x4*)(P.out + O_SWIN);
        for (int i0 = gw * 64 + lane; i0 < TOTAL; i0 += NGW * 64 * 8) { f32x4 t[8];
#pragma unroll
            for (int u = 0; u < 8; ++u) { const int i = i0 + u * NGW * 64; if (i < TOTAL) { const int b = i / PERB; t[u] = src[i + 64 * b + 64]; } }
#pragma unroll
            for (int u = 0; u < 8; ++u) { const int i = i0 + u * NGW * 64; if (i < TOTAL) { const int b = i / PERB; dst[i + 64 * b] = t[u]; } } }
    } else if (k == 13) p0_rope(P, F, gw, NGW);
}
constexpr int P0_OTHER_SLICES = 14;
__device__ __forceinline__ void p0_phase(const Ptrs& P, Frame& F) {
    p0_small_items(P, F);
    if (F.wave == 0) { if (F.lane == 0) { unsigned sp = 0u; while (__hip_atomic_load((unsigned*)(F.ctl + CW_P0CNT), RLX_AGENT) < (unsigned)P0_PRODUCERS) { __builtin_amdgcn_s_sleep(2); if (++sp > (1u << 22)) break; } }
        __builtin_amdgcn_fence(__ATOMIC_ACQUIRE, "agent"); asm volatile("s_waitcnt vmcnt(0)" ::: "memory"); }
    __syncthreads();
    const int npass = (int)blockIdx.x < CMP_NPASS ? (CMP_NPASS - 1 - (int)blockIdx.x) / F.G + 1 : 0;
    if (F.wave < 4) compress_team(P, F, F.lds + RING_OFF, F.MISC + 16, F.MISC + 17, npass);
    else { const int gw = blockIdx.x * 4 + (F.wave - 4), NGW = F.G * 4; LAS float* scr = (LAS float*)(F.lds + RING_OFF + 32768 + (F.wave - 4) * 16384);
        for (int k = 0; k < P0_OTHER_SLICES; ++k) p0_other_slice(P, F, k, gw, NGW, scr); }
}
struct EpiIn {
    static constexpr bool PERM = false, AFTER_DRAIN = false;
    const float *rstd, *rope, *qg, *kg; float* out; unsigned char* ws;
    __device__ __forceinline__ void operator()(const f32x4 (&acc)[2][2][4][2], const pg8::Unit& u, int wr, int wc, int fr, int fq) const {
        asm volatile("" : "+v"(fr), "+v"(fq));
        const int pn = u.pn; const int rbase = u.pm * 256 + wr * 64 + fr;
        if (pn < 8) {
            const bool bz = pn < 4; bf16* dst = (bf16*)(ws + (bz ? WS_CG : WS_U)); const int col0 = 128 * (pn & 3) + 32 * wc + 4 * fq;
#pragma unroll
            for (int ai = 0; ai < 2; ++ai)
#pragma unroll
                for (int m = 0; m < 4; ++m) { const int row = rbase + ai * 128 + m * 16; const float rs = rstd[row];
#pragma unroll
                    for (int n = 0; n < 2; ++n) { const f32x4 a = acc[ai][0][m][n] * rs, z = acc[ai][1][m][n] * rs; f32x4 o;
                        if (bz) { o.x = a.x * z.x * sigmoidf(z.x); o.y = a.y * z.y * sigmoidf(z.y); o.z = a.z * z.z * sigmoidf(z.z); o.w = a.w * z.w * sigmoidf(z.w); }
                        else o = a * z;
                        v2u w; w.x = pk2(o.x, o.y); w.y = pk2(o.z, o.w);
                        *(GAS v2u*)(dst + (size_t)row * 512 + col0 + 16 * n) = w;
                        if (!bz) { const int t = row & (T - 1); if (t >= T - 2) *(GAS f32x4*)(out + O_PCONV + ((size_t)(row >> 13) * 2 + (t - (T - 2))) * 512 + col0 + 16 * n) = o; } } }
        } else if (pn < 13) {
            const bool isq = pn < 10; const int br = pn - 10; const bool isk = !isq && wc < 2;
            if (isq || isk) {
                const float* gain = isq ? qg : kg + br * 64; float g1[2][4], g2[2][4];
#pragma unroll
                for (int n = 0; n < 2; ++n)
#pragma unroll
                    for (int e = 0; e < 4; ++e) { g1[n][e] = gain[16 * n + 4 * fq + e]; g2[n][e] = gain[32 + 16 * n + 4 * fq + e]; }
#pragma unroll
                for (int ai = 0; ai < 2; ++ai)
#pragma unroll
                    for (int m = 0; m < 4; ++m) { const int row = rbase + ai * 128 + m * 16; const float rs = rstd[row]; const int t = row & (T - 1), b = row >> 13;
                        f32x4 x1[2], x2[2]; float ss = 0.f;
#pragma unroll
                        for (int n = 0; n < 2; ++n) { x1[n] = acc[ai][0][m][n] * rs; x2[n] = acc[ai][1][m][n] * rs;
                            ss += (x1[n].x * x1[n].x + x1[n].y * x1[n].y) + (x1[n].z * x1[n].z + x1[n].w * x1[n].w) + (x2[n].x * x2[n].x + x2[n].y * x2[n].y) + (x2[n].z * x2[n].z + x2[n].w * x2[n].w); }
                        ss += __shfl_xor(ss, 16); ss += __shfl_xor(ss, 32);
                        const float inv = 1.0f / sqrtf(ss * (1.0f / 64.0f) + NORM_EPS);
                        const float* rp = rope + (size_t)t * 64 + 4 * fq;
#pragma unroll
                        for (int n = 0; n < 2; ++n) { const f32x4 cs = *(const GAS f32x4*)(rp + 16 * n), sn = *(const GAS f32x4*)(rp + 32 + 16 * n); f32x4 o1, o2;
#pragma unroll
                            for (int e = 0; e < 4; ++e) { const float a = x1[n][e] * inv * g1[n][e], c = x2[n][e] * inv * g2[n][e]; o1[e] = a * cs[e] - c * sn[e]; o2[e] = c * cs[e] + a * sn[e]; }
                            const int d1 = 16 * n + 4 * fq;
                            if (isq) { o1 = o1 * QSCALE; o2 = o2 * QSCALE; bf16* q = (bf16*)(ws + WS_Q) + (size_t)row * 512 + (4 * (pn - 8) + wc) * 64 + d1;
                                v2u w; w.x = pk2(o1.x, o1.y); w.y = pk2(o1.z, o1.w); *(GAS v2u*)q = w; w.x = pk2(o2.x, o2.y); w.y = pk2(o2.z, o2.w); *(GAS v2u*)(q + 32) = w; }
                            else { const int g = wc;
                                if (br > 0) { bf16* k = (bf16*)(ws + (br == 1 ? WS_KS : WS_KW)) + ((size_t)(b * 2 + g) * T + t) * 64 + d1;
                                    v2u w; w.x = pk2(o1.x, o1.y); w.y = pk2(o1.z, o1.w); *(GAS v2u*)k = w; w.x = pk2(o2.x, o2.y); w.y = pk2(o2.z, o2.w); *(GAS v2u*)(k + 32) = w; }
                                if (br < 2) { float* o = out + (br == 0 ? O_PCMP : O_PSLC) + (size_t)row * 256 + g * 64 + d1; *(GAS f32x4*)o = o1; *(GAS f32x4*)(o + 32) = o2; }
                                else if (t >= T - 512) { float* o = out + O_PWIN + ((size_t)b * 512 + (t - (T - 512))) * 256 + g * 64 + d1; *(GAS f32x4*)o = o1; *(GAS f32x4*)(o + 32) = o2; } } } }
            } else {
                const int g = wc - 2;
#pragma unroll
                for (int ai = 0; ai < 2; ++ai)
#pragma unroll
                    for (int m = 0; m < 4; ++m) { const int row = rbase + ai * 128 + m * 16; const float rs = rstd[row]; const int t = row & (T - 1), b = row >> 13;
                        const int tk = t & 63, vpos = (tk & ~15) + perm16(tk & 15);
                        bf16* vt = (br > 0) ? (bf16*)(ws + (br == 1 ? WS_VTS : WS_VTW)) + ((size_t)((b * 2 + g) * 128 + (t >> 6)) * 64) * 64 + vpos : nullptr;
#pragma unroll
                        for (int bj = 0; bj < 2; ++bj)
#pragma unroll
                            for (int n = 0; n < 2; ++n) { const f32x4 v = acc[ai][bj][m][n] * rs; const int d1 = 32 * bj + 16 * n + 4 * fq;
                                if (br > 0) {
#pragma unroll
                                    for (int e = 0; e < 4; ++e) vt[(size_t)(d1 + e) * 64] = (bf16)f2bf(v[e]); }
                                if (br < 2) *(GAS f32x4*)(out + (br == 0 ? O_PCMP : O_PSLC) + (size_t)row * 256 + 128 + g * 64 + d1) = v;
                                else if (t >= T - 512) *(GAS f32x4*)(out + O_PWIN + ((size_t)b * 512 + (t - (T - 512))) * 256 + 128 + g * 64 + d1) = v; } }
            }
        } else if (pn < 15) {
            bf16* dst = (bf16*)(ws + WS_ZA);
#pragma unroll
            for (int ai = 0; ai < 2; ++ai)
#pragma unroll
                for (int m = 0; m < 4; ++m) { const int row = rbase + ai * 128 + m * 16; const float rs = rstd[row];
#pragma unroll
                    for (int bj = 0; bj < 2; ++bj)
#pragma unroll
                        for (int n = 0; n < 2; ++n) { const f32x4 z = acc[ai][bj][m][n] * rs; v2u w; w.x = pk2(z.x * sigmoidf(z.x), z.y * sigmoidf(z.y)); w.y = pk2(z.z * sigmoidf(z.z), z.w * sigmoidf(z.w));
                            *(GAS v2u*)(dst + (size_t)row * 512 + 256 * (pn - 13) + 128 * bj + 32 * wc + 16 * n + 4 * fq) = w; } }
        } else {
            if (wc == 0) { float* dst = (float*)(ws + WS_GATE);
#pragma unroll
                for (int ai = 0; ai < 2; ++ai)
#pragma unroll
                    for (int m = 0; m < 4; ++m) { const int row = rbase + ai * 128 + m * 16; const float rs = rstd[row];
#pragma unroll
                        for (int n = 0; n < 2; ++n) { const int c0 = 16 * n + 4 * fq; if (c0 < 24) { const f32x4 z = acc[ai][0][m][n] * rs;
                            *(GAS f32x4*)(dst + (size_t)row * 24 + c0) = (f32x4){sigmoidf(z.x), sigmoidf(z.y), sigmoidf(z.z), sigmoidf(z.w)}; } } } }
        }
    }
};
struct EpiOut {
    static constexpr bool PERM = false, AFTER_DRAIN = false;
    const float* x; float* y;
    __device__ __forceinline__ void operator()(const f32x4 (&acc)[2][2][4][2], const pg8::Unit& u, int wr, int wc, int fr, int fq) const {
        asm volatile("" : "+v"(fr), "+v"(fq));
#pragma unroll
        for (int ai = 0; ai < 2; ++ai)
#pragma unroll
            for (int m = 0; m < 4; ++m) { const size_t row = (size_t)u.pm * 256 + ai * 128 + wr * 64 + m * 16 + fr;
#pragma unroll
                for (int bj = 0; bj < 2; ++bj)
#pragma unroll
                    for (int n = 0; n < 2; ++n) { const size_t off = row * D + u.pn * 256 + 128 * bj + 32 * wc + 16 * n + 4 * fq;
                        *(GAS f32x4*)(y + off) = *(const GAS f32x4*)(x + off) + acc[ai][bj][m][n]; } }
    }
};
template <int MODE>
__device__ __forceinline__ void small_gemm_tile(const Ptrs& P, const bf16* A, const bf16* Bt, int ct, int lane) {
    const int rho = lane & 15, kq = lane >> 4;
    f32x4 acc[2] = {(f32x4){0.f, 0.f, 0.f, 0.f}, (f32x4){0.f, 0.f, 0.f, 0.f}};
    const GAS v4u* a0 = (const GAS v4u*)(A + (size_t)rho * D + 8 * kq); const GAS v4u* a1 = (const GAS v4u*)(A + (size_t)(16 + rho) * D + 8 * kq);
    const GAS v4u* bp = (const GAS v4u*)(Bt + (size_t)(16 * ct + rho) * D + 8 * kq);
#pragma unroll 8
    for (int ks = 0; ks < 32; ++ks) { const bf16x8 bb = __builtin_bit_cast(bf16x8, bp[ks * 4]);
        acc[0] = __builtin_amdgcn_mfma_f32_16x16x32_bf16(bb, __builtin_bit_cast(bf16x8, a0[ks * 4]), acc[0], 0, 0, 0);
        acc[1] = __builtin_amdgcn_mfma_f32_16x16x32_bf16(bb, __builtin_bit_cast(bf16x8, a1[ks * 4]), acc[1], 0, 0, 0); }
#pragma unroll
    for (int rt = 0; rt < 2; ++rt) { const int b = 16 * rt + rho; const int col = 16 * ct + 4 * kq;
        if (MODE == 0) { const float rs = ((const float*)(P.ws + WS_RSTDS))[b]; *(GAS f32x4*)((float*)(P.ws + WS_PROJS) + (size_t)b * NP + col) = acc[rt] * rs; }
        else *(GAS f32x4*)(P.out + O_YS + (size_t)b * D + col) = *(const GAS f32x4*)(P.xs + (size_t)b * D + col) + acc[rt]; }
}
__device__ __forceinline__ int projs_col(int pn, int wc, int d) { return 256 * pn + 128 * (d >> 5) + 32 * wc + (d & 31); }
__device__ __forceinline__ void p2_sample_item(const Ptrs& P, int it, int lane) {
    const int b = it / 37, ty = it - b * 37;
    const float* pr = (const float*)(P.ws + WS_PROJS) + (size_t)b * NP;
    const float* ropes = (const float*)(P.ws + WS_ROPE) + (size_t)8192 * 64;
    float* kvn = (float*)(P.ws + WS_KVN) + (size_t)b * 768;
    if (ty < 14) {
        const bool isq = ty < 8; const int br = isq ? 0 : (ty - 8) >> 1, g = (ty - 8) & 1;
        const int pn = isq ? 8 + (ty >> 2) : 10 + br, wc = isq ? (ty & 3) : g;
        const float v = pr[projs_col(pn, wc, lane)];
        const float ss = wave_sum(v * v); const float inv = 1.0f / sqrtf(ss * (1.0f / 64.0f) + NORM_EPS);
        const float gn = isq ? P.q_gain[lane] : P.k_gain[br * 64 + lane];
        const float xn = v * inv * gn; const float xo = __shfl_xor(xn, 32);
        const int i = lane & 31; const float cs = ropes[i], sn = ropes[32 + i];
        const float o = (lane < 32) ? xn * cs - xo * sn : xn * cs + xo * sn;
        if (isq) ((float*)(P.ws + WS_QS))[(size_t)b * 512 + ty * 64 + lane] = o * QSCALE;
        else { kvn[(br * 2 + 0) * 128 + g * 64 + lane] = o;
            if (br == 0) P.out[O_SCMP + (size_t)b * 256 + g * 64 + lane] = o; else if (br == 1) P.out[O_SSLC + (size_t)b * 256 + g * 64 + lane] = o;
            else P.out[O_SWIN + ((size_t)b * 512 + 511) * 256 + g * 64 + lane] = o; }
    } else if (ty < 20) {
        const int br = (ty - 14) >> 1, g = (ty - 14) & 1; const float v = pr[projs_col(10 + br, 2 + g, lane)];
        kvn[(br * 2 + 1) * 128 + g * 64 + lane] = v;
        if (br == 0) P.out[O_SCMP + (size_t)b * 256 + 128 + g * 64 + lane] = v; else if (br == 1) P.out[O_SSLC + (size_t)b * 256 + 128 + g * 64 + lane] = v;
        else P.out[O_SWIN + ((size_t)b * 512 + 511) * 256 + 128 + g * 64 + lane] = v;
    } else if (ty == 20) {
        if (lane < 24) ((float*)(P.ws + WS_GS))[b * 24 + lane] = sigmoidf(pr[256 * 15 + lane]);
    } else if (ty < 29) {
        const int ch = (ty - 21) * 64 + lane; const int pnb = ch >> 7, tc = ch & 127;
        const float bg = pr[256 * pnb + tc], zc = pr[256 * pnb + 128 + tc], cg = pr[256 * (4 + pnb) + tc], ci = pr[256 * (4 + pnb) + 128 + tc];
        const float u = cg * ci; const float s0 = P.st_conv[(size_t)b * 1024 + ch], s1 = P.st_conv[(size_t)b * 1024 + 512 + ch];
        const float cy = P.conv_w[ch] * s0 + P.conv_w[512 + ch] * s1 + P.conv_w[1024 + ch] * u + P.conv_b[ch];
        ((bf16*)(P.ws + WS_MIXS))[(size_t)b * 1024 + ch] = (bf16)f2bf(bg * cy * zc * sigmoidf(zc));
        P.out[O_SCONV + (size_t)b * 1024 + 512 + ch] = u;
    } else {
        const int col = (ty - 29) * 64 + lane; const float z = pr[256 * (13 + (col >> 8)) + (col & 255)];
        ((float*)(P.ws + WS_ZAS))[(size_t)b * 512 + col] = z * sigmoidf(z);
    }
}
__device__ __forceinline__ void p2_phase(const Ptrs& P, Frame& F) {
    compress_units<false>(P, F, (LAS float*)(F.lds + RING_OFF));
    for (int it = F.gw; it < DECB * 37; it += F.NGW) p2_sample_item(P, it, F.lane);
}
#define MFMA32(a, b, c) __builtin_amdgcn_mfma_f32_32x32x16_bf16(a, b, c, 0, 0, 0)
constexpr int P3_IMP = 0, P3_QL = 32768;
constexpr int P3_NEXT = LDSCTL_OFF + 512, P3_CNT = LDSCTL_OFF + 1024, P3_LISTS = LDSCTL_OFF + 2048, P3_LACC = LDSCTL_OFF + 10240;
constexpr int P3_RING = 65536;
constexpr int P3_MISC = MISC_OFF + 64;
constexpr int SM_Q = 36864, SM_P = 40960, SM_RED = 57344, SM_IMP = 66048, SM_L = 67200, SM_SEL = 67328, SM_O = 67584, SM_VP = 71680  , SM_RED2 = 79872  ;

template <bool MASK>
__device__ __forceinline__ void attend_lds(const LAS unsigned char* blk, const bf16x8 (&qf)[4], f32x16 (&O)[2], float& lsum,
                                           int kbase, int lo, int hi, int lane, bool want_pv, f32x16 (*Sout)[2] = nullptr) {
    const int r = lane & 31, hh = lane >> 5, swz = (r >> 1) & 7;
    const LAS unsigned char* kb = blk + r * 128; const LAS unsigned char* vb = blk + 8192 + r * 128;
#pragma unroll
    for (int kt = 0; kt < 2; ++kt) {
        f32x16 S;
        { bf16x8 kf[4];
#pragma unroll
          for (int s = 0; s < 4; ++s) kf[s] = *(const LAS bf16x8*)(kb + kt * 4096 + (((2 * s + hh) ^ swz) << 4));
#pragma unroll
          for (int i = 0; i < 16; ++i) S[i] = 0.f;
#pragma unroll
          for (int s = 0; s < 4; ++s) S = MFMA32(kf[s], qf[s], S); }
#pragma unroll
        for (int i = 0; i < 16; ++i) { float p = fast_exp2(S[i]);
            if (MASK) { const int kp = kbase + 32 * kt + (i & 3) + 8 * (i >> 2) + 4 * hh; p = (kp >= lo && kp <= hi) ? p : 0.f; }
            S[i] = p; lsum += p; }
        if (Sout) (*Sout)[kt] = S;
        if (want_pv) {
            bf16x8 pf[2];
#pragma unroll
            for (int sp = 0; sp < 2; ++sp) { v4u w; w.x = pk2(S[8 * sp + 0], S[8 * sp + 1]); w.y = pk2(S[8 * sp + 2], S[8 * sp + 3]);
                w.z = pk2(S[8 * sp + 4], S[8 * sp + 5]); w.w = pk2(S[8 * sp + 6], S[8 * sp + 7]); pf[sp] = __builtin_bit_cast(bf16x8, w); }
#pragma unroll
            for (int dt = 0; dt < 2; ++dt)
#pragma unroll
                for (int sp = 0; sp < 2; ++sp) { const bf16x8 vf = *(const LAS bf16x8*)(vb + dt * 4096 + (((2 * (2 * kt + sp) + hh) ^ swz) << 4));
                    O[dt] = MFMA32(vf, pf[sp], O[dt]); }
        }
    }
}
__device__ __forceinline__ void wave_topk(const LAS float* imp, int jmax, int nsel, int lane, int qbase, LAS unsigned* cnt, LAS unsigned char* lists) {
    if (jmax < 1) return;
    const bool c0 = lane >= 1 && lane <= jmax, c1 = 64 + lane <= jmax;
    unsigned k0[8], k1[8], Tv[8];
#pragma unroll
    for (int qi = 0; qi < 8; ++qi) { k0[qi] = c0 ? ((__builtin_bit_cast(unsigned, imp[qi * 128 + lane]) + 0x800u) & ~0x7ffu) : 0u; k1[qi] = c1 ? ((__builtin_bit_cast(unsigned, imp[qi * 128 + 64 + lane]) + 0x800u) & ~0x7ffu) : 0u; Tv[qi] = 0u; }
    if (jmax > nsel) {
        for (int bit = 30; bit >= 11; --bit) {
#pragma unroll
            for (int qi = 0; qi < 8; ++qi) { const unsigned cand = Tv[qi] | (1u << bit);
                const int cn = __popcll(__ballot(k0[qi] >= cand)) + __popcll(__ballot(k1[qi] >= cand)); Tv[qi] = cn >= nsel ? cand : Tv[qi]; } }
    }
    const unsigned long long below = (lane == 0) ? 0ull : (~0ull >> (64 - lane));
#pragma unroll
    for (int qi = 0; qi < 8; ++qi) {
        bool s0, s1;
        if (jmax > nsel) {
            const unsigned long long g0 = __ballot(k0[qi] > Tv[qi]), g1 = __ballot(k1[qi] > Tv[qi]), e0 = __ballot(k0[qi] == Tv[qi]), e1 = __ballot(k1[qi] == Tv[qi]);
            const int need = nsel - __popcll(g0) - __popcll(g1);
            const int rk0 = __popcll(e0 & below), rk1 = __popcll(e0) + __popcll(e1 & below);
            s0 = k0[qi] > Tv[qi] || (k0[qi] == Tv[qi] && rk0 < need); s1 = k1[qi] > Tv[qi] || (k1[qi] == Tv[qi] && rk1 < need);
        } else { s0 = c0; s1 = c1; }
        if (s0) { const unsigned pos = __hip_atomic_fetch_add(cnt + lane, 1u, __ATOMIC_RELAXED, __HIP_MEMORY_SCOPE_WORKGROUP); lists[lane * 64 + pos] = (unsigned char)(qbase + qi); }
        if (s1) { const unsigned pos = __hip_atomic_fetch_add(cnt + 64 + lane, 1u, __ATOMIC_RELAXED, __HIP_MEMORY_SCOPE_WORKGROUP); lists[(64 + lane) * 64 + pos] = (unsigned char)(qbase + qi); }
    }
}
struct BlkSrc { const bf16* k; const bf16* v; int vstride; };
#ifndef PROBE_SEG
#define PROBE_SEG 0
#endif
#define T_BEGIN(id) do { if (PROBE_SEG == (id)) tacc -= __builtin_readcyclecounter(); } while (0)
#define T_END(id) do { if (PROBE_SEG == (id)) tacc += __builtin_readcyclecounter(); } while (0)
__device__ __forceinline__ void p3_prompt_unit(const Ptrs& P, Frame& F, int b, int t, int g, float sh_cmp, float sh_slc, float sh_win, unsigned long long& tacc) {
    int lane = F.lane, w = F.wave, tid = F.tid; asm volatile("" : "+v"(lane), "+s"(w), "+v"(tid));
    const int col = lane & 31, hh = lane >> 5, qi = col >> 2, h = col & 3;
    const int tok = 64 * t + 8 * w + qi; const size_t row = (size_t)b * T + tok; const int qpos = tok;
    const int nck = (2 * t + 2 + 63) >> 6, nf = t >= 2 ? 3 : t + 1, nw = t >= 8 ? 9 : t + 1;
    const int n1 = nck, n2 = 2 * nck, N1 = n2 + nf;
    const bf16* KC = (const bf16*)(P.ws + WS_KC) + (size_t)(b * 2 + g) * 256 * 64; const bf16* VCT = (const bf16*)(P.ws + WS_VCT) + (size_t)(b * 2 + g) * 64 * 256;
    const bf16* KS = (const bf16*)(P.ws + WS_KS) + (size_t)(b * 2 + g) * T * 64; const bf16* VTS = (const bf16*)(P.ws + WS_VTS) + (size_t)(b * 2 + g) * 128 * 4096;
    const bf16* KW = (const bf16*)(P.ws + WS_KW) + (size_t)(b * 2 + g) * T * 64; const bf16* VTW = (const bf16*)(P.ws + WS_VTW) + (size_t)(b * 2 + g) * 128 * 4096;
    auto src1 = [&](int n) -> BlkSrc {
        if (n < n2) { const int ck = n < n1 ? n : n - n1; return BlkSrc{KC + (size_t)ck * 4096, VCT + ck * 64, 256}; }
        const int f = n - n2; const int j = f == 0 ? t : (f == 1 ? 0 : t - 1); return BlkSrc{KS + (size_t)j * 4096, VTS + (size_t)j * 4096, 64}; };
    auto src2 = [&](int n) -> BlkSrc { const int j = (t >= 8 ? t - 8 : 0) + n; return BlkSrc{KW + (size_t)j * 4096, VTW + (size_t)j * 4096, 64}; };
    const int srow = 8 * w + (lane >> 3), sch = (lane & 7) ^ ((srow >> 1) & 7);
    LAS unsigned char* ring = F.lds + P3_RING;
#define ST_DMA(bs_, n) do { LAS unsigned char* d_ = ring + ((n) & 3) * 16384 + w * 1024; \
        __builtin_amdgcn_global_load_lds((const unsigned*)((bs_).k + srow * 64 + sch * 8), (LAS unsigned*)d_, 16, 0, 0); \
        __builtin_amdgcn_global_load_lds((const unsigned*)((bs_).v + (size_t)srow * (bs_).vstride + sch * 8), (LAS unsigned*)(d_ + 8192), 16, 0, 0); } while (0)
#define BLK(n) (ring + ((n) & 3) * 16384)
#define STEP_BEGIN(SRC, n, NN) do { if (((n) & 1) == 0) { if ((n) + 2 < (NN)) { const BlkSrc b_ = SRC((n) + 2); ST_DMA(b_, (n) + 2); } if ((n) + 3 < (NN)) { const BlkSrc b_ = SRC((n) + 3); ST_DMA(b_, (n) + 3); } } } while (0)
#define STEP_END(n, NN) do { if (((n) & 1) == 1 || (n) == (NN) - 1) { asm volatile("s_waitcnt vmcnt(0)" ::: "memory"); __syncthreads(); } } while (0)
    LAS unsigned* cnt = (LAS unsigned*)(F.lds + P3_CNT); LAS unsigned char* lists = F.lds + P3_LISTS; LAS unsigned* nextb = (LAS unsigned*)(F.lds + P3_NEXT);
    LAS int* oacc = (LAS int*)ring; LAS int* lacc = (LAS int*)(F.lds + P3_LACC);
    const float FXS = fast_exp2(18.0f - sh_slc), FXI = 1.0f / FXS;
    LAS unsigned char* ql = F.lds + P3_QL;
    T_BEGIN(1); T_BEGIN(8);
    __syncthreads();
    if (tid < 128) cnt[tid] = 0u; if (tid == 128) nextb[0] = 0u;
    { const BlkSrc b0 = src1(0); ST_DMA(b0, 0); if (N1 > 1) { const BlkSrc b1 = src1(1); ST_DMA(b1, 1); } }
    { const bf16* qg = (const bf16*)(P.ws + WS_Q) + ((size_t)b * T + 64 * t) * 512 + g * 256;
      v4u tq[4];
#pragma unroll
      for (int k = 0; k < 4; ++k) { const int c = tid + 512 * k, rq = c >> 3, ch = c & 7; tq[k] = *(const GAS v4u*)(qg + (size_t)(rq >> 2) * 512 + (rq & 3) * 64 + ch * 8); }
#pragma unroll
      for (int k = 0; k < 4; ++k) { const int c = tid + 512 * k, rq = c >> 3, ch = c & 7; *(LAS v4u*)(ql + rq * 128 + ((ch ^ ((rq >> 1) & 7)) << 4)) = tq[k]; } }
    bf16x8 qf[4];
    { const bf16* q = (const bf16*)(P.ws + WS_Q) + row * 512 + (g * 4 + h) * 64 + 8 * hh;
#pragma unroll
      for (int s = 0; s < 4; ++s) qf[s] = __builtin_bit_cast(bf16x8, *(const GAS v4u*)(q + 16 * s)); }
    const float* gate = (const float*)(P.ws + WS_GATE) + row * 24 + (g * 4 + h) * 3;
    const float g_cmp = gate[0], g_slc = gate[1], g_win = gate[2];
    asm volatile("s_waitcnt vmcnt(0)" ::: "memory"); __syncthreads();
    T_END(1); T_BEGIN(2);
    f32x16 O[2];
    LAS float* wl = (LAS float*)(F.lds + P3_IMP + w * 4096);
    LAS float* xw0 = (LAS float*)(F.lds + P3_IMP + w * 4096) + lane;
    f32x16 totr;
    const int nvis = (qpos + 1) >> 5;
    int n = 0;
    float lsum = 0.f;
    for (; n < n1; ++n) { STEP_BEGIN(src1, n, N1); attend_lds<true>(BLK(n), qf, O, lsum, 64 * n, 0, nvis - 1, lane, false); STEP_END(n, N1); }
    lsum += __shfl_xor(lsum, 32);
    const float rl = lsum > 0.f ? 1.0f / lsum : 0.f;
    for (int i = lane; i < 1024; i += 64) wl[i] = 0.f;
#pragma unroll
    for (int i = 0; i < 16; ++i) { O[0][i] = 0.f; O[1][i] = 0.f; }
    { float dummy = 0.f;
      for (; n < n2; ++n) { STEP_BEGIN(src1, n, N1); const int ck = n - n1; f32x16 Sn[2];
        attend_lds<true>(BLK(n), qf, O, dummy, 64 * ck, 0, nvis - 1, lane, true, &Sn);
#pragma unroll
        for (int kt = 0; kt < 2; ++kt)
#pragma unroll
            for (int i2 = 0; i2 < 8; ++i2) { const float v = quad_sum((Sn[kt][2 * i2] + Sn[kt][2 * i2 + 1]) * rl);
                if (h == 0) wl[qi * 128 + 32 * ck + 16 * kt + (i2 & 1) + 4 * (i2 >> 1) + 2 * hh] = v; }
        STEP_END(n, N1); } }
    LDS_WAIT(); asm volatile("" ::: "memory");
    T_END(2); T_BEGIN(3);
    wave_topk(wl, t - 2, 13, lane, 8 * w, cnt, lists);
    LDS_WAIT(); asm volatile("" ::: "memory");
#pragma unroll
    for (int i = 0; i < 16; ++i) { xw0[i * 64] = O[0][i] * (g_cmp * rl); totr[i] = O[1][i] * (g_cmp * rl); O[0][i] = 0.f; O[1][i] = 0.f; }
    T_END(3); T_BEGIN(4);
    lsum = 0.f;
    for (; n < N1; ++n) { STEP_BEGIN(src1, n, N1);
        if (n == n2) attend_lds<true>(BLK(n), qf, O, lsum, 64 * t, 0, qpos, lane, true);
        else attend_lds<false>(BLK(n), qf, O, lsum, 0, 0, 0, lane, true);
        STEP_END(n, N1); }
    lsum += __shfl_xor(lsum, 32);
#pragma unroll
    for (int dt = 0; dt < 2; ++dt)
#pragma unroll
        for (int i = 0; i < 16; ++i) oacc[(32 * dt + (i & 3) + 8 * (i >> 2) + 4 * hh) * 256 + 32 * w + col] = __float2int_rn(O[dt][i] * FXS);
    if (hh == 0) lacc[32 * w + col] = __float2int_rn(lsum * FXS);
    __syncthreads();
    T_END(4); T_BEGIN(5);
    if (t > 2) {
        const int r = lane & 31;
#define NEXT_BLOCK(jv_, nq_) do { for (;;) { unsigned t_ = 0u; if (lane == 0) t_ = __hip_atomic_fetch_add(nextb, 1u, __ATOMIC_RELAXED, __HIP_MEMORY_SCOPE_WORKGROUP); \
            jv_ = 1 + (int)__builtin_amdgcn_readfirstlane(t_); if (jv_ > t - 2) { nq_ = 0; break; } nq_ = (int)__builtin_amdgcn_readfirstlane(cnt[jv_]); if (nq_ > 0) break; } } while (0)
#define LOAD_FRAGS(kd_, vd_, jv_) do { const bf16* kp_ = KS + (size_t)(jv_) * 4096 + r * 64 + 8 * hh; const bf16* vp_ = VTS + (size_t)(jv_) * 4096 + r * 64 + 8 * hh; \
            _Pragma("unroll") for (int a_ = 0; a_ < 2; ++a_) _Pragma("unroll") for (int b_ = 0; b_ < 4; ++b_) { kd_[a_][b_] = __builtin_bit_cast(bf16x8, *(const GAS v4u*)(kp_ + a_ * 2048 + 16 * b_)); \
                vd_[a_][b_] = __builtin_bit_cast(bf16x8, *(const GAS v4u*)(vp_ + a_ * 2048 + 16 * b_)); } } while (0)
        bf16x8 kf[2][4], vf[2][4];
        for (;;) {
            int j, nq; NEXT_BLOCK(j, nq);
            if (j > t - 2) break;
            LOAD_FRAGS(kf, vf, j);
#pragma unroll
            for (int a_ = 0; a_ < 2; ++a_)
#pragma unroll
                for (int b_ = 0; b_ < 4; ++b_) asm volatile("" : "+v"(kf[a_][b_]), "+v"(vf[a_][b_]));
            for (int c0 = 0; c0 < nq; c0 += 8) {
                const int sl = c0 + qi; const bool valid = sl < nq;
                const int rowq = (int)lists[j * 64 + (valid ? sl : nq - 1)] * 4 + h;
                const LAS unsigned char* qp = ql + rowq * 128; const int qsw = (rowq >> 1) & 7;
                bf16x8 q2[4];
#pragma unroll
                for (int s = 0; s < 4; ++s) q2[s] = *(const LAS bf16x8*)(qp + (((2 * s + hh) ^ qsw) << 4));
                float l2 = 0.f; bf16x8 pf[4]; f32x16 S0, S1;
#pragma unroll
                for (int i = 0; i < 16; ++i) { S0[i] = 0.f; S1[i] = 0.f; }
#pragma unroll
                for (int s = 0; s < 4; ++s) { S0 = MFMA32(kf[0][s], q2[s], S0); S1 = MFMA32(kf[1][s], q2[s], S1); }
#pragma unroll
                for (int i = 0; i < 16; ++i) { S0[i] = fast_exp2(S0[i]); l2 += S0[i]; }
#pragma unroll
                for (int sp = 0; sp < 2; ++sp) { v4u wv; wv.x = pk2(S0[8 * sp + 0], S0[8 * sp + 1]); wv.y = pk2(S0[8 * sp + 2], S0[8 * sp + 3]);
                    wv.z = pk2(S0[8 * sp + 4], S0[8 * sp + 5]); wv.w = pk2(S0[8 * sp + 6], S0[8 * sp + 7]); pf[sp] = __builtin_bit_cast(bf16x8, wv); }
#pragma unroll
                for (int i = 0; i < 16; ++i) { S1[i] = fast_exp2(S1[i]); l2 += S1[i]; }
#pragma unroll
                for (int sp = 0; sp < 2; ++sp) { v4u wv; wv.x = pk2(S1[8 * sp + 0], S1[8 * sp + 1]); wv.y = pk2(S1[8 * sp + 2], S1[8 * sp + 3]);
                    wv.z = pk2(S1[8 * sp + 4], S1[8 * sp + 5]); wv.w = pk2(S1[8 * sp + 6], S1[8 * sp + 7]); pf[2 + sp] = __builtin_bit_cast(bf16x8, wv); }
                T_BEGIN(9);
#pragma unroll
                for (int dt = 0; dt < 2; ++dt) { f32x16 O2;
#pragma unroll
                    for (int i = 0; i < 16; ++i) O2[i] = 0.f;
#pragma unroll
                    for (int ks = 0; ks < 4; ++ks) O2 = MFMA32(vf[dt][ks], pf[ks], O2);
                    if (valid) {
#pragma unroll
                        for (int i = 0; i < 16; ++i) (void)__hip_atomic_fetch_add(oacc + (32 * dt + (i & 3) + 8 * (i >> 2) + 4 * hh) * 256 + rowq, __float2int_rn(O2[i] * FXS), __ATOMIC_RELAXED, __HIP_MEMORY_SCOPE_WORKGROUP); } }
                if (valid) {
                    (void)__hip_atomic_fetch_add(lacc + rowq, __float2int_rn(l2 * FXS), __ATOMIC_RELAXED, __HIP_MEMORY_SCOPE_WORKGROUP); }
                LDS_WAIT(); T_END(9);
            }
        }
#undef NEXT_BLOCK
#undef LOAD_FRAGS
    }
    __syncthreads();
    T_END(5); T_BEGIN(6);
    LAS float* x0 = (LAS float*)(F.lds + P3_IMP + w * 4096) + lane; LAS float* x1 = (LAS float*)(F.lds + P3_QL + w * 4096) + lane;
    { const float sc = g_slc / fmaxf((float)lacc[32 * w + col] * FXI, 1e-30f);
#pragma unroll
      for (int i = 0; i < 16; ++i) { const int dr = (i & 3) + 8 * (i >> 2) + 4 * hh;
          x0[i * 64] = x0[i * 64] + (float)oacc[dr * 256 + 32 * w + col] * (FXI * sc); x1[i * 64] = totr[i] + (float)oacc[(32 + dr) * 256 + 32 * w + col] * (FXI * sc); O[0][i] = 0.f; O[1][i] = 0.f; } }
    LDS_WAIT(); __syncthreads();
    { const BlkSrc b0 = src2(0); ST_DMA(b0, 0); if (nw > 1) { const BlkSrc b1 = src2(1); ST_DMA(b1, 1); } }
    { asm volatile("" : "+v"(lane));
      const bf16* q = (const bf16*)(P.ws + WS_Q) + row * 512 + (g * 4 + h) * 64 + 8 * hh;
#pragma unroll
      for (int s = 0; s < 4; ++s) qf[s] = __builtin_bit_cast(bf16x8, *(const GAS v4u*)(q + 16 * s)); }
    asm volatile("s_waitcnt vmcnt(0)" ::: "memory"); __syncthreads();
    lsum = 0.f;
    for (n = 0; n < nw; ++n) { STEP_BEGIN(src2, n, nw); const int j = (t >= 8 ? t - 8 : 0) + n;
        if (j == t || j + 8 == t) attend_lds<true>(BLK(n), qf, O, lsum, 64 * j, qpos - 511, qpos, lane, true);
        else attend_lds<false>(BLK(n), qf, O, lsum, 0, 0, 0, lane, true);
        STEP_END(n, nw); }
    lsum += __shfl_xor(lsum, 32);
    { const float sc = g_win / fmaxf(lsum, 1e-30f);
#pragma unroll
      for (int i = 0; i < 16; ++i) { O[0][i] = x0[i * 64] + O[0][i] * sc; O[1][i] = x1[i * 64] + O[1][i] * sc; } }
#undef ST_DMA
#undef BLK
#undef STEP_BEGIN
#undef STEP_END
    T_END(6); T_BEGIN(7);
    asm volatile("" : "+v"(lane));
    const int col_ = lane & 31, hh_ = lane >> 5, h_ = col_ & 3; const size_t row_ = (size_t)b * T + 64 * t + 8 * w + (col_ >> 2);
    const bf16* za = (const bf16*)(P.ws + WS_ZA) + row_ * 512 + (g * 4 + h_) * 64; bf16* mx = (bf16*)(P.ws + WS_MIX) + row_ * 1024 + 512 + (g * 4 + h_) * 64;
#pragma unroll
    for (int dt = 0; dt < 2; ++dt)
#pragma unroll
        for (int i4 = 0; i4 < 4; ++i4) { const int d = 32 * dt + 8 * i4 + 4 * hh_; const v2u z = *(const GAS v2u*)(za + d);
            v2u o; o.x = pk2(O[dt][4 * i4] * bf2f(z.x & 0xffffu), O[dt][4 * i4 + 1] * bf2f(z.x >> 16)); o.y = pk2(O[dt][4 * i4 + 2] * bf2f(z.y & 0xffffu), O[dt][4 * i4 + 3] * bf2f(z.y >> 16));
            *(GAS v2u*)(mx + d) = o; }
    if (g == 0) { const int tq = w, c8 = lane * 8; const size_t r0 = (size_t)b * T + 64 * t + 8 * tq;
        const bf16* U = (const bf16*)(P.ws + WS_U) + c8; const bf16* CGp = (const bf16*)(P.ws + WS_CG) + c8; bf16* mo = (bf16*)(P.ws + WS_MIX) + c8;
        v4u ur[10], cr[8];
        const bool has_prev = (t > 0) || (tq > 0);
#pragma unroll
        for (int i = 0; i < 10; ++i) ur[i] = (i >= 2 || has_prev) ? *(const GAS v4u*)(U + (r0 + i - 2) * 512) : (v4u){0u, 0u, 0u, 0u};
#pragma unroll
        for (int i = 0; i < 8; ++i) cr[i] = *(const GAS v4u*)(CGp + (r0 + i) * 512);
        float w0[8], w1[8], w2[8], cb[8];
#pragma unroll
        for (int e = 0; e < 8; ++e) { w0[e] = P.conv_w[c8 + e]; w1[e] = P.conv_w[512 + c8 + e]; w2[e] = P.conv_w[1024 + c8 + e]; cb[e] = P.conv_b[c8 + e]; }
#pragma unroll
        for (int i = 0; i < 8; ++i) { float o[8];
#pragma unroll
            for (int e = 0; e < 8; ++e) { const int sh_ = (e & 1) * 16; const float a = bf2f((ur[i][e >> 1] >> sh_) & 0xffffu), bb = bf2f((ur[i + 1][e >> 1] >> sh_) & 0xffffu), c = bf2f((ur[i + 2][e >> 1] >> sh_) & 0xffffu);
                o[e] = bf2f((cr[i][e >> 1] >> sh_) & 0xffffu) * (w0[e] * a + w1[e] * bb + w2[e] * c + cb[e]); }
            v4u ov; ov.x = pk2(o[0], o[1]); ov.y = pk2(o[2], o[3]); ov.z = pk2(o[4], o[5]); ov.w = pk2(o[6], o[7]);
            *(GAS v4u*)(mo + (r0 + i) * 1024) = ov; } }
    T_END(7); T_END(8);
}
template <class KeyFn>
__device__ __forceinline__ void sample_branch(Frame& F, int nslots, float shift, const KeyFn& key, LAS float* obr) {
    LAS float* q = (LAS float*)(F.lds + SM_Q); LAS float* Pb = (LAS float*)(F.lds + SM_P); LAS float* red = (LAS float*)(F.lds + SM_RED); LAS float* lsm = (LAS float*)(F.lds + SM_L);
    LAS unsigned long long* vptr = (LAS unsigned long long*)(F.lds + SM_VP);
    float lacc[4] = {0.f, 0.f, 0.f, 0.f};
    for (int s = F.tid; s < nslots; s += 512) { const float* kp; const float* vp; const bool valid = key(s, kp, vp);
        float sc[4] = {0.f, 0.f, 0.f, 0.f};
        if (valid) {
#pragma unroll 8
            for (int d4 = 0; d4 < 16; ++d4) { const f32x4 kv = *(const GAS f32x4*)(kp + 4 * d4);
#pragma unroll
                for (int hq = 0; hq < 4; ++hq) { const f32x4 qv = *(const LAS f32x4*)(q + hq * 64 + 4 * d4); sc[hq] += (kv.x * qv.x + kv.y * qv.y) + (kv.z * qv.z + kv.w * qv.w); } } }
        f32x4 p;
#pragma unroll
        for (int hq = 0; hq < 4; ++hq) { p[hq] = valid ? fast_exp2(sc[hq] - shift) : 0.f; lacc[hq] += p[hq]; }
        *(LAS f32x4*)(Pb + 4 * s) = p; vptr[s] = (unsigned long long)(uintptr_t)vp; }
#pragma unroll
    for (int hq = 0; hq < 4; ++hq) { lacc[hq] = wave_sum(lacc[hq]); if (F.lane == 0) red[F.wave * 4 + hq] = lacc[hq]; }
    __syncthreads();
    if (F.tid < 4) { float s = 0.f; for (int ww = 0; ww < 8; ++ww) s += red[ww * 4 + F.tid]; lsm[F.tid] = s; }
    const int sg = F.tid >> 4, d4 = F.tid & 15;
    f32x4 oa[4];
#pragma unroll
    for (int hq = 0; hq < 4; ++hq) oa[hq] = (f32x4){0.f, 0.f, 0.f, 0.f};
    for (int s0 = sg; s0 < nslots; s0 += 256) {
        f32x4 vv[8], pp[8];
#pragma unroll
        for (int u = 0; u < 8; ++u) { const int s = s0 + 32 * u; const float* vp = (const float*)(uintptr_t)vptr[s]; vv[u] = *(const GAS f32x4*)(vp + 4 * d4); pp[u] = *(const LAS f32x4*)(Pb + 4 * s); }
#pragma unroll
        for (int u = 0; u < 8; ++u) { oa[0] = oa[0] + vv[u] * pp[u].x; oa[1] = oa[1] + vv[u] * pp[u].y; oa[2] = oa[2] + vv[u] * pp[u].z; oa[3] = oa[3] + vv[u] * pp[u].w; } }
    __syncthreads();
    LAS float* red2 = (LAS float*)(F.lds + SM_RED2);
#pragma unroll
    for (int hq = 0; hq < 4; ++hq) *(LAS f32x4*)(red2 + (sg * 4 + hq) * 64 + 4 * d4) = oa[hq];
    __syncthreads();
    if (F.tid < 256) { float s = 0.f;
#pragma unroll 8
        for (int g2 = 0; g2 < 32; ++g2) s += red2[g2 * 256 + F.tid]; obr[F.tid] = s; }
    __syncthreads();
}
__device__ __forceinline__ void p3_sample_unit(const Ptrs& P, Frame& F, int b, int g) {
    asm volatile("" : "+v"(F.tid), "+v"(F.lane), "+s"(F.wave));
    LAS float* q = (LAS float*)(F.lds + SM_Q); LAS float* Pb = (LAS float*)(F.lds + SM_P); LAS float* imp = (LAS float*)(F.lds + SM_IMP); LAS float* lsm = (LAS float*)(F.lds + SM_L);
    LAS int* sel = (LAS int*)(F.lds + SM_SEL); LAS float* osm = (LAS float*)(F.lds + SM_O);
    const float* cst = (const float*)(P.ws + WS_CONST);
    float kcmax = 0.f; for (int e_ = 0; e_ < 4; ++e_) kcmax += __builtin_bit_cast(float, __hip_atomic_load((unsigned*)(P.ws + WS_CTL) + CW_KCMAX + 64 + e_, RLX_AGENT));
    const float sh_cmp = cst[0] * sqrtf(kcmax) * LOG2E * 1.001f, sh_slc = cst[1], sh_win = cst[2];
    if (F.tid < 256) q[F.tid] = ((const float*)(P.ws + WS_QS))[(size_t)b * 512 + g * 256 + F.tid];
    __syncthreads();
    const float* kcs = (const float*)(P.ws + WS_KCS) + (size_t)(b * 2 + g) * 2 * NCS * 64;
    sample_branch(F, NCS, sh_cmp, [&](int s, const float*& kp, const float*& vp) { kp = kcs + (size_t)s * 64; vp = kcs + (size_t)(NCS + s) * 64; return true; }, osm);
    { const f32x4 p = *(const LAS f32x4*)(Pb + 4 * F.tid); float v = p.x / lsm[0] + p.y / lsm[1] + p.z / lsm[2] + p.w / lsm[3]; v += __shfl_xor(v, 1);
      if ((F.tid & 1) == 0) imp[F.tid >> 1] = v; if (F.tid < 4) imp[256 + F.tid] = 0.f; }
    if (F.tid < 256) osm[F.tid] = osm[F.tid] / lsm[F.tid >> 6];
    __syncthreads();
    if (F.wave == 0) { const int lane = F.lane; unsigned k[4];
#pragma unroll
        for (int i = 0; i < 4; ++i) { const int j = lane + 64 * i; k[i] = (j >= 1 && j <= 254) ? __builtin_bit_cast(unsigned, imp[j]) + 1u : 0u; }
        unsigned Tv = 0u;
        for (int bit = 30; bit >= 0; --bit) { const unsigned cand = Tv | (1u << bit); int cnt = 0;
#pragma unroll
            for (int i = 0; i < 4; ++i) cnt += __popcll(__ballot(k[i] >= cand));
            if (cnt >= 13) Tv = cand; }
        int ngt = 0;
#pragma unroll
        for (int i = 0; i < 4; ++i) ngt += __popcll(__ballot(k[i] > Tv));
        const int need = 13 - ngt; const unsigned long long below = (lane == 0) ? 0ull : (~0ull >> (64 - lane));
        int base = 3, eqbase = 0;
        if (lane == 0) { int z_ = 0; asm volatile("" : "+v"(z_)); sel[0] = z_; sel[1] = z_ + 255; sel[2] = z_ + 256; }
#pragma unroll
        for (int i = 0; i < 4; ++i) { const unsigned long long e = __ballot(k[i] == Tv); const int rk = eqbase + __popcll(e & below); const bool on = k[i] > Tv || (k[i] == Tv && rk < need);
            const unsigned long long m = __ballot(on); if (on) sel[base + __popcll(m & below)] = lane + 64 * i; base += __popcll(m); eqbase += __popcll(e); } }
    __syncthreads();
    const float* kvn = (const float*)(P.ws + WS_KVN) + (size_t)b * 768;
    const int* pt = P.page_table + b * NPAGES; const float* cs = P.cache_slc;
    sample_branch(F, 1024, sh_slc, [&](int s, const float*& kp, const float*& vp) { const int j = sel[s >> 6], rr = s & 63;
        if (j == 256) { kp = kvn + (1 * 2 + 0) * 128 + g * 64; vp = kvn + (1 * 2 + 1) * 128 + g * 64; return rr == 0; }
        const float* rowp = cs + ((size_t)pt[j >> 1] * 128 + (j & 1) * 64 + rr) * 256 + g * 64; kp = rowp; vp = rowp + 128; return true; }, osm + 256);
    if (F.tid < 256) osm[256 + F.tid] = osm[256 + F.tid] / lsm[F.tid >> 6];
    __syncthreads();
    const float* stw = P.st_win + (size_t)b * 512 * 256;
    sample_branch(F, 512, sh_win, [&](int s, const float*& kp, const float*& vp) {
        if (s == 511) { kp = kvn + (2 * 2 + 0) * 128 + g * 64; vp = kvn + (2 * 2 + 1) * 128 + g * 64; return true; }
        const float* rowp = stw + (size_t)(s + 1) * 256 + g * 64; kp = rowp; vp = rowp + 128; return true; }, osm + 512);
    if (F.tid < 256) { const int hq = F.tid >> 6, d = F.tid & 63; const float* gs = (const float*)(P.ws + WS_GS) + b * 24 + (g * 4 + hq) * 3;
        const float o = gs[0] * osm[F.tid] + gs[1] * osm[256 + F.tid] + gs[2] * osm[512 + F.tid] / lsm[hq];
        ((bf16*)(P.ws + WS_MIXS))[(size_t)b * 1024 + 512 + (g * 4 + hq) * 64 + d] = (bf16)f2bf(o * ((const float*)(P.ws + WS_ZAS))[(size_t)b * 512 + (g * 4 + hq) * 64 + d]); }
    __syncthreads();
}
__device__ __forceinline__ void p3_phase(const Ptrs& P, Frame& F, int rep) {
    const float* cst = (const float*)(P.ws + WS_CONST);
    float kcmax = 0.f; for (int e_ = 0; e_ < 4; ++e_) kcmax += __builtin_bit_cast(float, __hip_atomic_load((unsigned*)(P.ws + WS_CTL) + CW_KCMAX + e_, RLX_AGENT));
    const float sh_cmp = cst[0] * sqrtf(kcmax) * LOG2E * 1.001f, sh_slc = cst[1], sh_win = cst[2];
    unsigned long long tacc = 0ull;
    volatile LAS int* qw = (volatile LAS int*)(F.lds + P3_MISC);
#ifndef PROBE_P3
#define PROBE_P3 0
#endif
    constexpr int NS_ = PROBE_P3 == 1 ? 16 : 8, PSH_ = PROBE_P3 == 2 ? 1 : 0;
    constexpr int NQ = NS_ + (128 << PSH_);
    const int x0 = (int)(xb_xcc_id() & 7u);
    for (int xi = 0; xi < 8; ++xi) {
        const int x = (x0 + xi) & 7;
        for (;;) {
            __syncthreads();
            if (F.tid == 0) qw[0] = (int)__hip_atomic_fetch_add((unsigned*)(F.ctl + CW_QUEUE + 64 * (x + 8 * rep)), 1u, RLX_AGENT);
            __syncthreads();
            const int idx = qw[0];
            if (idx >= NQ) break;
            if (idx < NS_) p3_sample_unit(P, F, x * 4 + ((idx & 7) >> 1), idx & 1);
            else p3_prompt_unit(P, F, x >> 1, 127 - ((idx - NS_) >> PSH_), x & 1, sh_cmp, sh_slc, sh_win, tacc);
        }
    }
    if (PROBE_SEG != 0 && blockIdx.x == 0) { const unsigned long long t0_ = __builtin_readcyclecounter(); while (__builtin_readcyclecounter() - t0_ < tacc) __builtin_amdgcn_s_sleep(8); }
}
#ifndef MK_N_LAUNCHES
#define MK_N_LAUNCHES 1
#endif
constexpr int N_PHASES = 5;
constexpr int N_LAUNCHES = MK_N_LAUNCHES;
struct Args { Ptrs p; int ph_lo, ph_hi, rep, mode; };
__global__ void __launch_bounds__(NWAVES * 64, 2) nsa_fwd(Args args) {
    extern __shared__ __attribute__((aligned(16))) unsigned char lds[];
    const Ptrs& P = args.p;
    Frame F;
    F.lds = (LAS unsigned char*)lds;
    F.MISC = (volatile LAS unsigned*)(F.lds + MISC_OFF);
    F.tid = threadIdx.x; F.lane = F.tid & 63; F.wave = __builtin_amdgcn_readfirstlane(F.tid >> 6);
    F.G = gridDim.x; F.gw = blockIdx.x * NWAVES + F.wave; F.NGW = F.G * NWAVES;
    F.ctl = (gu32*)(P.ws + WS_CTL);
    for (int u = F.tid; u < (LDS_BYTES - LDSCTL_OFF) / 4; u += NWAVES * 64) ((LAS unsigned*)(F.lds + LDSCTL_OFF))[u] = 0u;
    __syncthreads();
    XcdBarrier bar; bar.bar = (unsigned*)(F.ctl + CW_BAR); bar.x = 0; bar.st = nullptr;
    if (N_LAUNCHES == 1) bar = xcd_barrier_post((unsigned*)(F.ctl + CW_BAR), F.MISC + 8);
    const int lo = args.ph_lo, hi = args.ph_hi;
    unsigned long long tprobe = 0ull;
#define IN(k) (lo <= (k) && (k) < hi)
#define FENCE() do { asm volatile("" : "+s"(F.wave), "+s"(F.gw)); F.lane = (int)__builtin_amdgcn_mbcnt_hi(~0u, __builtin_amdgcn_mbcnt_lo(~0u, 0u)); F.tid = F.wave * 64 + F.lane; asm volatile("" : "+v"(F.tid), "+v"(F.lane)); } while (0)
#define SEAM(k) do { if (IN(k) && IN((k) + 1)) xcd_barrier(bar, F.wave == 0 && (int)__builtin_amdgcn_mbcnt_hi(~0u, __builtin_amdgcn_mbcnt_lo(~0u, 0u)) == 0); } while (0)

    if (IN(0)) { FENCE(); p0_phase(P, F); } SEAM(0);
    if (IN(1)) { FENCE();
        pg8::Gemm g{(const pg8::bf16_t*)(P.ws + WS_XB), (const pg8::bf16_t*)(P.ws + WS_BT1), M, NP, D}; pg8::StaticOrder S; S.init(M, NP, F.G, (int)blockIdx.x);
        EpiIn E{(const float*)(P.ws + WS_RSTD), (const float*)(P.ws + WS_ROPE), P.q_gain, P.k_gain, P.out, P.ws};
        pg8::gemm_phase<EpiIn, pg8::StaticOrder, true, true>(F.lds + RING_OFF, g, S, E, F.wave, tprobe);
        FENCE();
        for (int ct = F.gw; ct < NP / 16; ct += F.NGW) small_gemm_tile<0>(P, (const bf16*)(P.ws + WS_XSB), (const bf16*)(P.ws + WS_BT1), ct, F.lane);
#if defined(PROBE_EPI)
        if (PROBE_EPI == 1 && blockIdx.x == 0) { const unsigned long long t0_ = __builtin_readcyclecounter(); while (__builtin_readcyclecounter() - t0_ < tprobe) __builtin_amdgcn_s_sleep(8); }
        tprobe = 0ull;
#endif
    } SEAM(1);
    if (IN(2)) { FENCE(); p2_phase(P, F); } SEAM(2);
    if (IN(3)) { FENCE(); p3_phase(P, F, args.rep); } SEAM(3);
    if (IN(4)) { FENCE();
        pg8::Gemm g{(const pg8::bf16_t*)(P.ws + WS_MIX), (const pg8::bf16_t*)(P.ws + WS_BT2), M, D, D}; pg8::StaticOrder S; S.init(M, D, F.G, (int)blockIdx.x);
        EpiOut E{P.xp, P.out + O_Y};
        pg8::gemm_phase<EpiOut, pg8::StaticOrder, true, true>(F.lds + RING_OFF, g, S, E, F.wave, tprobe);
        FENCE();
        for (int ct = F.gw; ct < D / 16; ct += F.NGW) small_gemm_tile<1>(P, (const bf16*)(P.ws + WS_MIXS), (const bf16*)(P.ws + WS_BT2), ct, F.lane);
#if defined(PROBE_EPI)
        if (PROBE_EPI == 2 && blockIdx.x == 0) { const unsigned long long t0_ = __builtin_readcyclecounter(); while (__builtin_readcyclecounter() - t0_ < tprobe) __builtin_amdgcn_s_sleep(8); }
#endif
    }
#undef IN
#undef SEAM
}

extern "C" void kernel_launch(void* const* d_in, const int* in_sizes, int n_in, void* d_out, int out_size, void* d_ws, size_t ws_size, hipStream_t stream) {
    static int grid = 0;
    if (grid == 0) {
        if (n_in != 16 || out_size != (int)O_END || ws_size < WS_END) { fprintf(stderr, "kernel_launch: unexpected shapes (n_in %d, out %d, ws %zu)\n", n_in, out_size, ws_size); grid = -1; return; }
        int dev = 0, cus = 0, per_cu = 0;
        if (hipGetDevice(&dev) != hipSuccess || hipDeviceGetAttribute(&cus, hipDeviceAttributeMultiprocessorCount, dev) != hipSuccess) { grid = -1; return; }
        if (hipFuncSetAttribute((const void*)nsa_fwd, hipFuncAttributeMaxDynamicSharedMemorySize, LDS_BYTES) != hipSuccess) { fprintf(stderr, "kernel_launch: hipFuncSetAttribute failed\n"); grid = -1; return; }
        if (hipOccupancyMaxActiveBlocksPerMultiprocessor(&per_cu, (const void*)nsa_fwd, NWAVES * 64, LDS_BYTES) != hipSuccess || per_cu < 1)
            fprintf(stderr, "kernel_launch: note: occupancy query reports %d workgroups per CU\n", per_cu);
        (void)hipGetLastError();
        grid = cus;
    }
    if (grid < 0) return;
    if (hipMemsetAsync((char*)d_ws + WS_CTL, 0, CTL_ZERO_BYTES, stream) != hipSuccess) return;
    Args a{}; a.mode = 3;
    a.p.xp = (const float*)d_in[0]; a.p.xs = (const float*)d_in[1]; a.p.cache_cmp = (const float*)d_in[2]; a.p.cache_slc = (const float*)d_in[3];
    a.p.st_win = (const float*)d_in[4]; a.p.st_conv = (const float*)d_in[5]; a.p.page_table = (const int*)d_in[6]; a.p.norm_g = (const float*)d_in[7];
    a.p.w_in = (const float*)d_in[8]; a.p.conv_w = (const float*)d_in[9]; a.p.conv_b = (const float*)d_in[10]; a.p.q_gain = (const float*)d_in[11];
    a.p.k_gain = (const float*)d_in[12]; a.p.cmp_pe = (const float*)d_in[13]; a.p.cmp_w = (const float*)d_in[14]; a.p.w_out = (const float*)d_in[15];
    a.p.out = (float*)d_out; a.p.ws = (unsigned char*)d_ws;
#ifndef PROBE_DUP
#define PROBE_DUP -1
#endif
    for (int li = 0; li < N_LAUNCHES; ++li) {
        a.ph_lo = (N_LAUNCHES == 1) ? 0 : li; a.ph_hi = (N_LAUNCHES == 1) ? N_PHASES : li + 1;
        for (int rep = 0; rep < ((N_LAUNCHES > 1 && li == PROBE_DUP) ? 2 : 1); ++rep) {
            a.rep = rep;
            hipLaunchKernelGGL(nsa_fwd, dim3(grid), dim3(NWAVES * 64), LDS_BYTES, stream, a);
            const hipError_t le = hipPeekAtLastError();
            if (le != hipSuccess) { fprintf(stderr, "kernel_launch: launch %d failed: %s\n", li, hipGetErrorName(le)); break; }
        }
    }
}
```

```cpp
#include <hip/hip_runtime.h>
#include <cstdio>
#include <cstdint>
#define GAS __attribute__((address_space(1)))
#define LAS __attribute__((address_space(3)))
typedef unsigned short bf16;
typedef unsigned v4u __attribute__((ext_vector_type(4)));
typedef unsigned v2u __attribute__((ext_vector_type(2)));
typedef float f32x2 __attribute__((ext_vector_type(2)));
typedef float f32x16 __attribute__((ext_vector_type(16)));
typedef GAS unsigned gu32;
typedef GAS unsigned long long gu64;
#define RLX_AGENT __ATOMIC_RELAXED, __HIP_MEMORY_SCOPE_AGENT
#define LDS_WAIT() asm volatile("s_waitcnt lgkmcnt(0)" ::: "memory")
#define VM_WAIT() asm volatile("s_waitcnt vmcnt(0)" ::: "memory")
#define MK_N_LAUNCHES 1
#define PROBE_DUP -1
#define PROBE_P3 0
#define PROBE_SEG 0
namespace pg8 {
#define PG8_LAS __attribute__((address_space(3)))
typedef unsigned short bf16_t;
typedef short bf16x8 __attribute__((ext_vector_type(8)));
typedef float f32x4 __attribute__((ext_vector_type(4)));
typedef unsigned u32x4 __attribute__((ext_vector_type(4)));
constexpr int BM = 256, BK = 64, HALF = 128, HTB = HALF * BK * 2  , STAGE_BYTES = 8 * HTB, NXCD = 8, WGM = 8;

__host__ __device__ __forceinline__ int lds_byte(int r, int c) { const int st = (r >> 4) * 2 + (c >> 5), rr = r & 15, cc = c & 31, ob = rr * 64 + cc * 2; return st * 1024 + (ob ^ (((ob >> 9) & 1) << 5)); }
__host__ __device__ __forceinline__ void stage_rc(int b, int& R, int& C) { const int st = b / 1024, sb = b % 1024, swz = sb ^ (((sb >> 9) & 1) << 5); R = (st >> 1) * 16 + swz / 64; C = (st & 1) * 32 + (swz % 64) / 2; }
__host__ __device__ __forceinline__ int perm32(int rho) { const int n = rho >> 4, i = rho & 15; return 8 * (i >> 2) + 4 * n + (i & 3); }

struct Unit { int pm, pn; };
struct Gemm { const bf16_t* A; const bf16_t* Bt; int M, N, K; };

struct StaticOrder {
    int nM, nN, nwg, G, c;
    __host__ __device__ void init(int M, int N, int G_, int c_) { nM = M / BM; nN = N / BM; nwg = nM * nN; G = G_; c = c_; }
    __host__ __device__ bool next(int i, Unit& u) const {
        const long L = (long)i * G + c; if (L >= nwg) return false;
        int wgid = (int)L; { const int q = nwg / NXCD, r = nwg % NXCD, xcd = wgid % NXCD, off = wgid / NXCD; wgid = (xcd < r ? xcd * (q + 1) : r * (q + 1) + (xcd - r) * q) + off; }
        const int nig = WGM * nN, gid = wgid / nig, fm = gid * WGM, gsz = (nM - fm) < WGM ? (nM - fm) : WGM;
        u.pm = fm + ((wgid % nig) % gsz); u.pn = (wgid % nig) / gsz; return true;
    }
    __device__ __forceinline__ void a_ready(const Unit&) const {}
    __device__ __forceinline__ void done(const Unit&) const {}
};


template <class Epi, class Sched, bool ALIGN_EPI = false, bool SP2 = false>
__device__ __forceinline__ void gemm_phase(PG8_LAS unsigned char* lds, const Gemm g, const Sched& S, const Epi& E, int wave_id  , unsigned long long& tacc_  ) {
    const int lane = (int)__builtin_amdgcn_mbcnt_hi(~0u, __builtin_amdgcn_mbcnt_lo(~0u, 0u)), wid = wave_id, tid = wid * 64 + lane, wr = wid >> 2, wc = wid & 3, fr = lane & 15, fq = lane >> 4;
    const int K = g.K, nt = K / BK;
    unsigned voffA[2], voffB[2];
#pragma unroll
    for (int i = 0; i < 2; ++i) { int R, C; stage_rc(tid * 16 + i * 8192, R, C); const int Rb = Epi::PERM ? ((R & ~31) + perm32(R & 31)) : R;
        voffA[i] = (unsigned)(R * K + C) * 2u; voffB[i] = (unsigned)(Rb * K + C) * 2u; }
    const size_t kstep = (size_t)(BK * 2);
    const size_t hstep = (size_t)HALF * K * 2;
    const size_t tstep = 2 * hstep;
    const unsigned ldsw = (unsigned)wid * 1024u;
    const int aoff = lds_byte(wr * 64 + fr, fq * 8), boff = lds_byte(wc * 32 + fr, fq * 8);
#define PG8_SA(b, h) (((b) * 2 + (h)) * HTB)
#define PG8_SB(b, h) ((4 + (b) * 2 + (h)) * HTB)
#define PG8_STAGE(bufoff, gbase, voff) do { _Pragma("unroll") for (int _i = 0; _i < 2; ++_i) \
        __builtin_amdgcn_global_load_lds((const unsigned*)((const char*)(gbase) + (voff)[_i]), (PG8_LAS unsigned*)(lds + (bufoff) + ldsw + _i * 8192), 16, 0, 0); } while (0)
#define PG8_LDA(dst, b, h) do { _Pragma("unroll") for (int m = 0; m < 4; ++m) _Pragma("unroll") for (int k = 0; k < 2; ++k) dst[m][k] = *(const PG8_LAS bf16x8*)(lds + PG8_SA(b, h) + aoff + m * 2048 + k * 1024); } while (0)
#define PG8_LDB(dst, b, h) do { _Pragma("unroll") for (int n = 0; n < 2; ++n) _Pragma("unroll") for (int k = 0; k < 2; ++k) dst[n][k] = *(const PG8_LAS bf16x8*)(lds + PG8_SB(b, h) + boff + n * 2048 + k * 1024); } while (0)
#define PG8_MMA(ai, bj, At, Bt) do { __builtin_amdgcn_s_setprio(1); _Pragma("unroll") for (int m = 0; m < 4; ++m) _Pragma("unroll") for (int n = 0; n < 2; ++n) _Pragma("unroll") for (int k = 0; k < 2; ++k) \
        acc[ai][bj][m][n] = __builtin_amdgcn_mfma_f32_16x16x32_bf16(Bt[n][k], At[m][k], acc[ai][bj][m][n], 0, 0, 0); __builtin_amdgcn_s_setprio(0); } while (0)
#define PG8_WAIT_V(n) asm volatile("s_waitcnt vmcnt(" #n ")" ::: "memory")
#define PG8_WAIT_L(n) asm volatile("s_waitcnt lgkmcnt(" #n ")" ::: "memory")
#define PG8_BAR __builtin_amdgcn_s_barrier()
#define PG8_SCHED __builtin_amdgcn_sched_barrier(0)
    Unit cur, nxt; int ui = 0;
    if (!S.next(0, cur)) return;
    f32x4 acc[2][2][4][2];
#pragma unroll
    for (int a = 0; a < 2; ++a)
#pragma unroll
        for (int b = 0; b < 2; ++b)
#pragma unroll
            for (int m = 0; m < 4; ++m)
#pragma unroll
                for (int n = 0; n < 2; ++n) acc[a][b][m][n] = (f32x4){0.f, 0.f, 0.f, 0.f};
    bf16x8 At[4][2], B0[2][2], B1[2][2];
    const char* cA = (const char*)g.A + (size_t)cur.pm * tstep; const char* cB = (const char*)g.Bt + (size_t)cur.pn * tstep;
    S.a_ready(cur);
    if constexpr (SP2) {
        PG8_STAGE(PG8_SB(0, 0), cB, voffB); PG8_STAGE(PG8_SB(0, 1), cB + hstep, voffB); PG8_STAGE(PG8_SA(0, 0), cA, voffA); PG8_STAGE(PG8_SA(0, 1), cA + hstep, voffA);
        if (wr == 1) PG8_BAR;
        PG8_WAIT_V(2); PG8_BAR;
        PG8_STAGE(PG8_SB(1, 0), cB + kstep, voffB); PG8_STAGE(PG8_SA(1, 0), cA + kstep, voffA); PG8_STAGE(PG8_SB(1, 1), cB + hstep + kstep, voffB);
        PG8_WAIT_V(6); PG8_BAR;
    } else {
        PG8_STAGE(PG8_SB(0, 0), cB, voffB); PG8_STAGE(PG8_SA(0, 0), cA, voffA); PG8_STAGE(PG8_SB(0, 1), cB + hstep, voffB); PG8_STAGE(PG8_SA(0, 1), cA + hstep, voffA);
        if (wr == 1) PG8_BAR;
        PG8_WAIT_V(4); PG8_BAR;
        PG8_STAGE(PG8_SB(1, 0), cB + kstep, voffB); PG8_STAGE(PG8_SA(1, 0), cA + kstep, voffA); PG8_STAGE(PG8_SB(1, 1), cB + hstep + kstep, voffB);
        PG8_WAIT_V(6); PG8_BAR;
    }
    for (;;) {
        const bool has_next = S.next(ui + 1, nxt);
        const char* nA = has_next ? (const char*)g.A + (size_t)nxt.pm * tstep : cA; const char* nB = has_next ? (const char*)g.Bt + (size_t)nxt.pn * tstep : cB;
        for (int t = 0; t < nt; t += 2) {
            const bool last = (t == nt - 2);
            const char* a1 = cA + (size_t)(t + 1) * kstep;
            const char* a2 = last ? nA : cA + (size_t)(t + 2) * kstep; const char* b2 = last ? nB : cB + (size_t)(t + 2) * kstep;
            const char* a3 = a2 + kstep; const char* b3 = b2 + kstep;
            if (last && has_next) S.a_ready(nxt);
            if constexpr (SP2) {
            PG8_LDB(B0, 0, 0); PG8_LDB(B1, 0, 1); PG8_SCHED; PG8_LDA(At, 0, 0); PG8_STAGE(PG8_SA(1, 1), a1 + hstep, voffA);
            PG8_WAIT_V(8); PG8_WAIT_L(0); PG8_BAR; PG8_MMA(0, 0, At, B0); PG8_MMA(0, 1, At, B1); PG8_BAR; PG8_SCHED;
            PG8_LDA(At, 0, 1); PG8_STAGE(PG8_SB(0, 0), b2, voffB); PG8_STAGE(PG8_SB(0, 1), b2 + hstep, voffB); PG8_STAGE(PG8_SA(0, 0), a2, voffA);
            PG8_WAIT_V(8); PG8_WAIT_L(0); PG8_BAR; PG8_MMA(1, 0, At, B0); PG8_MMA(1, 1, At, B1); PG8_BAR; PG8_SCHED;
            PG8_LDB(B0, 1, 0); PG8_LDB(B1, 1, 1); PG8_SCHED; PG8_LDA(At, 1, 0); PG8_STAGE(PG8_SA(0, 1), a2 + hstep, voffA);
            PG8_WAIT_V(8); PG8_WAIT_L(0); PG8_BAR; PG8_MMA(0, 0, At, B0); PG8_MMA(0, 1, At, B1); PG8_BAR; PG8_SCHED;
            PG8_LDA(At, 1, 1); PG8_STAGE(PG8_SB(1, 0), b3, voffB); PG8_STAGE(PG8_SB(1, 1), b3 + hstep, voffB); PG8_STAGE(PG8_SA(1, 0), a3, voffA);
            PG8_WAIT_V(8); PG8_WAIT_L(0); PG8_BAR; PG8_MMA(1, 0, At, B0); PG8_MMA(1, 1, At, B1); PG8_BAR; PG8_SCHED;
            } else {
            PG8_LDB(B0, 0, 0); PG8_SCHED; PG8_LDA(At, 0, 0); PG8_STAGE(PG8_SA(1, 1), a1 + hstep, voffA);
            PG8_WAIT_L(8); PG8_BAR; PG8_WAIT_L(0); PG8_MMA(0, 0, At, B0); PG8_BAR; PG8_SCHED;
            PG8_LDB(B1, 0, 1); PG8_STAGE(PG8_SB(0, 0), b2, voffB);
            PG8_BAR; PG8_WAIT_L(0); PG8_MMA(0, 1, At, B1); PG8_BAR;
            PG8_LDA(At, 0, 1); PG8_STAGE(PG8_SA(0, 0), a2, voffA);
            PG8_BAR; PG8_WAIT_L(0); PG8_MMA(1, 0, At, B0); PG8_BAR; PG8_SCHED;
            PG8_STAGE(PG8_SB(0, 1), b2 + hstep, voffB);
            PG8_WAIT_V(6); PG8_BAR; PG8_MMA(1, 1, At, B1); PG8_BAR;
            PG8_LDB(B0, 1, 0); PG8_SCHED; PG8_LDA(At, 1, 0); PG8_STAGE(PG8_SA(0, 1), a2 + hstep, voffA);
            PG8_WAIT_L(8); PG8_BAR; PG8_WAIT_L(0); PG8_MMA(0, 0, At, B0); PG8_BAR; PG8_SCHED;
            PG8_LDB(B1, 1, 1); PG8_STAGE(PG8_SB(1, 0), b3, voffB);
            PG8_BAR; PG8_WAIT_L(0); PG8_MMA(0, 1, At, B1); PG8_BAR;
            PG8_LDA(At, 1, 1); PG8_STAGE(PG8_SA(1, 0), a3, voffA);
            PG8_BAR; PG8_WAIT_L(0); PG8_MMA(1, 0, At, B0); PG8_BAR; PG8_SCHED;
            PG8_STAGE(PG8_SB(1, 1), b3 + hstep, voffB);
            PG8_WAIT_V(6); PG8_BAR; PG8_MMA(1, 1, At, B1); PG8_BAR;
            }
        }
        if constexpr (ALIGN_EPI) { if (wr == 0) PG8_BAR; }
#ifdef PROBE_EPI
        { const unsigned long long t0_ = __builtin_readcyclecounter(); E(acc, cur, wr, wc, fr, fq); asm volatile("s_waitcnt vmcnt(0)" ::: "memory"); tacc_ += __builtin_readcyclecounter() - t0_; S.done(cur); }
#else
        if constexpr (!Epi::AFTER_DRAIN) { E(acc, cur, wr, wc, fr, fq); S.done(cur); }
#endif
        if (!has_next) break;
#pragma unroll
        for (int a = 0; a < 2; ++a)
#pragma unroll
            for (int b = 0; b < 2; ++b)
#pragma unroll
                for (int m = 0; m < 4; ++m)
#pragma unroll
                    for (int n = 0; n < 2; ++n) acc[a][b][m][n] = (f32x4){0.f, 0.f, 0.f, 0.f};
        cur = nxt; cA = nA; cB = nB; ++ui;
        if constexpr (ALIGN_EPI) { if (wr == 1) PG8_BAR; }
    }
    PG8_WAIT_V(0);
    if constexpr (!ALIGN_EPI) { if (wr == 0) PG8_BAR; }
    PG8_BAR;
    if constexpr (Epi::AFTER_DRAIN) { E.fused(acc, cur, wr, wc, fr, fq, lds, wid, lane); S.done(cur); }
#undef PG8_SA
#undef PG8_SB
#undef PG8_STAGE
#undef PG8_LDA
#undef PG8_LDB
#undef PG8_MMA
#undef PG8_WAIT_V
#undef PG8_WAIT_L
#undef PG8_BAR
#undef PG8_SCHED
}
}
#define XB_TMO      128
#define XB_XCNT(j)  (256  + 64 * (j))
#define XB_XSUB(j)  (1280 + 64 * (j))
#define XB_XGEN(j)  (2304 + 64 * (j))
#define XB_TOP      3328
#define XB_TOPGEN   3392
#define XCD_BAR_WORDS 3456
#define XB_SPIN_CAP (1u << 18)

__device__ __forceinline__ unsigned xb_ld(unsigned* p)              { return __hip_atomic_load(p, __ATOMIC_RELAXED, __HIP_MEMORY_SCOPE_AGENT); }
__device__ __forceinline__ unsigned xb_add(unsigned* p, unsigned v) { return __hip_atomic_fetch_add(p, v, __ATOMIC_RELAXED, __HIP_MEMORY_SCOPE_AGENT); }
__device__ __forceinline__ unsigned xb_xcc_id() { return (unsigned)__builtin_amdgcn_s_getreg((3 << 11) | 20) & 0xFu; }
#define XB_SPIN(cond, bar) do { unsigned _sp = 0; while (cond) { __builtin_amdgcn_s_sleep(1); \
    if ((++_sp & 255u) == 0u) { if (xb_ld(&(bar)[XB_TMO])) break; if (_sp > XB_SPIN_CAP) { atomicAdd(&(bar)[XB_TMO], 1u); break; } } } } while (0)

struct XcdBarrier {
    unsigned* bar; unsigned x;
    volatile LAS unsigned* st;
};

__device__ __forceinline__ XcdBarrier xcd_barrier_post(unsigned* bar, volatile LAS unsigned* st) {
    XcdBarrier b; b.bar = bar; b.x = xb_xcc_id(); b.st = st;
    if (threadIdx.x == 0) (void)xb_add(&bar[XB_XCNT(b.x)], 1u);
    return b;
}
__device__ __forceinline__ void xcd_barrier_complete(unsigned* bar, unsigned x, unsigned& nloc, unsigned& nx) {
    const unsigned G = gridDim.x * gridDim.y * gridDim.z;
    unsigned sum, cnt, mine, sp = 0u;
    for (;;) {
        sum = 0u; cnt = 0u; mine = 0u;
#pragma unroll
        for (unsigned j = 0; j < 16; ++j) { const unsigned c = xb_ld(&bar[XB_XCNT(j)]); sum += c; cnt += (c > 0u) ? 1u : 0u; mine = (j == x) ? c : mine; }
        if (sum == G) break;
        __builtin_amdgcn_s_sleep(1);
        if ((++sp & 255u) == 0u) { if (xb_ld(&bar[XB_TMO])) break; if (sp > XB_SPIN_CAP) { atomicAdd(&bar[XB_TMO], 1u); break; } }
    }
    nloc = mine > 0u ? mine : 1u; nx = cnt > 0u ? cnt : 1u;
}

__device__ __forceinline__ void xcd_barrier(const XcdBarrier& b, bool leader  ) {
    asm volatile("s_waitcnt vmcnt(0)" ::: "memory");
    __syncthreads();
    if (leader) {
        unsigned* bar = b.bar;
        __builtin_amdgcn_s_waitcnt(0);
        unsigned nloc = b.st[0], nx = b.st[1];
        if (nloc == 0u) { xcd_barrier_complete(bar, b.x, nloc, nx); b.st[0] = nloc; b.st[1] = nx; }
        const unsigned old = xb_add(&bar[XB_XSUB(b.x)], 1u);
        const unsigned gen = old / nloc;
        if (old + 1u == (gen + 1u) * nloc) {
            __builtin_amdgcn_fence(__ATOMIC_RELEASE, "agent");
            asm volatile("s_waitcnt vmcnt(0)" ::: "memory");
            const unsigned og = xb_add(&bar[XB_TOP], 1u);
            const unsigned tg = og / nx;
            if (og + 1u == (tg + 1u) * nx) xb_add(&bar[XB_TOPGEN], 1u);
            else XB_SPIN(xb_ld(&bar[XB_TOPGEN]) == tg, bar);
            __builtin_amdgcn_fence(__ATOMIC_ACQUIRE, "agent");
            xb_add(&bar[XB_XGEN(b.x)], 1u);
            asm volatile("s_waitcnt vmcnt(0)" ::: "memory");
        } else {
            XB_SPIN(xb_ld(&bar[XB_XGEN(b.x)]) == gen, bar);
            __builtin_amdgcn_fence(__ATOMIC_ACQUIRE, "agent");
            asm volatile("s_waitcnt vmcnt(0)" ::: "memory");
        }
    }
    __syncthreads();
}
using pg8::f32x4; using pg8::bf16x8;
constexpr int NWAVES = 8;
constexpr int BATCH = 4, T = 8192, D = 1024, M = BATCH * T, NP = 4096, INW = 3864;
constexpr int DECB = 32, PAST = 16384, NPAGES = 128, NCS = 512  ;
constexpr float NORM_EPS = 1e-6f;
constexpr float LOG2E = 1.4426950408889634f;
constexpr float QSCALE = 0.125f * LOG2E;
constexpr size_t O_Y = 0, O_YS = 33554432, O_PCMP = 33587200, O_PSLC = 41975808, O_PWIN = 50364416, O_PCONV = 50888704,
                 O_SCMP = 50892800, O_SSLC = 50900992, O_SWIN = 50909184, O_SCONV = 55103488, O_END = 55136256;
constexpr int C_BG = 0, C_CG = 512, C_CI = 1024, C_ZC = 1536, C_Q = 2048, C_KV = 2560, C_GL = 3328, C_ZA = 3352;

constexpr size_t MiB = 1u << 20, KiB = 1u << 10;
constexpr size_t WS_CTL = 0, CTL_ZERO_BYTES = 1 * MiB;
constexpr size_t WS_BT1 = 2 * MiB;
constexpr size_t WS_BT2 = 10 * MiB;
constexpr size_t WS_BTC = 12 * MiB;
constexpr size_t WS_CBIAS = 12 * MiB + 512 * KiB;
constexpr size_t WS_CONST = WS_CBIAS + 4 * KiB;
constexpr size_t WS_ROPE = 13 * MiB;
constexpr size_t WS_RSTD = 16 * MiB;
constexpr size_t WS_XSB = 16 * MiB + 256 * KiB;
constexpr size_t WS_RSTDS = WS_XSB + 64 * KiB;
constexpr size_t WS_GATE = 17 * MiB;
constexpr size_t WS_KC = 20 * MiB;
constexpr size_t WS_PROJS = 21 * MiB;
constexpr size_t WS_QS = 22 * MiB;
constexpr size_t WS_KVN = WS_QS + 64 * KiB;
constexpr size_t WS_GS = WS_KVN + 96 * KiB;
constexpr size_t WS_ZAS = WS_GS + 4 * KiB;
constexpr size_t WS_MIXS = WS_ZAS + 64 * KiB;
constexpr size_t WS_KCS = 24 * MiB;
constexpr size_t WS_KS = 40 * MiB, WS_KW = 56 * MiB;
constexpr size_t WS_XB = 72 * MiB;
constexpr size_t WS_CG = 136 * MiB, WS_U = 168 * MiB, WS_ZA = 200 * MiB, WS_Q = 232 * MiB;
constexpr size_t WS_MIX = 264 * MiB;
constexpr size_t WS_TOT = 328 * MiB;
constexpr size_t WS_END = 344 * MiB;
constexpr int CW_TMO = 0, CW_CODE = 1;
constexpr int CW_BAR = 4096;
constexpr int CW_QUEUE = 16384;
constexpr int CW_P0CNT = 18432;
constexpr int CW_KCMAX = 20480;

constexpr int RING_OFF = 0, RING_BYTES = 131072;
constexpr int LDSCTL_OFF = RING_BYTES, MISC_OFF = LDSCTL_OFF + 320;
constexpr int LDS_BYTES = 147456;

__device__ __forceinline__ unsigned f2bf(float f) { unsigned u = __builtin_bit_cast(unsigned, f); return (u + 0x7fffu + ((u >> 16) & 1u)) >> 16; }
typedef __bf16 bf16x2_t __attribute__((ext_vector_type(2)));
__device__ __forceinline__ unsigned pk2(float lo, float hi) { return __builtin_bit_cast(unsigned, __builtin_convertvector((f32x2){lo, hi}, bf16x2_t)); }
__device__ __forceinline__ float bf2f(unsigned h) { return __builtin_bit_cast(float, h << 16); }
__device__ __forceinline__ float wave_sum(float v) {
#pragma unroll
    for (int o = 1; o < 64; o <<= 1) v += __shfl_xor(v, o);
    return v;
}
__device__ __forceinline__ float quad_sum(float v) {
    v += __builtin_bit_cast(float, __builtin_amdgcn_update_dpp(0, __builtin_bit_cast(int, v), 0xB1, 0xF, 0xF, true));
    v += __builtin_bit_cast(float, __builtin_amdgcn_update_dpp(0, __builtin_bit_cast(int, v), 0x4E, 0xF, 0xF, true));
    return v;
}
__device__ __forceinline__ float fast_exp2(float x) { return __builtin_amdgcn_exp2f(x); }
__device__ __forceinline__ float sigmoidf(float x) { return __builtin_amdgcn_rcpf(1.0f + fast_exp2(-x * LOG2E)); }
__device__ __forceinline__ float slc_vscale(float sh_slc) { return fast_exp2(floorf(18.0f - sh_slc)); }
__device__ __forceinline__ int kimg_off(int key, int d) { return ((((key >> 5) * 4 + (d >> 4)) * 64 + ((d >> 3) & 1) * 32 + (key & 31)) << 3) + (d & 7); }
__device__ __forceinline__ int vimg_off(int d, int pos) { return 4096 + ((((d >> 5) * 4 + (pos >> 4)) * 64 + ((pos >> 3) & 1) * 32 + (d & 31)) << 3) + (pos & 7); }
__device__ __forceinline__ int perm16(int kk) { return 8 * ((kk >> 2) & 1) + 4 * (kk >> 3) + (kk & 3); }

struct Ptrs {
    const float *xp, *xs, *cache_cmp, *cache_slc, *st_win, *st_conv; const int* page_table;
    const float *norm_g, *w_in, *conv_w, *conv_b, *q_gain, *k_gain, *cmp_pe, *cmp_w, *w_out;
    float* out; unsigned char* ws;
};
struct Frame {
    LAS unsigned char* lds;
    volatile LAS unsigned* MISC;
    gu32* ctl;
    int tid, lane, wave, G, gw, NGW;
};
__device__ __forceinline__ int bt1_src(int dg, int& nvalid) {
    const int pn = dg >> 3, gi = dg & 7, bj = gi >> 2, wc = gi & 3; nvalid = 32;
    if (pn < 4) return (bj ? C_ZC : C_BG) + 128 * pn + 32 * wc;
    if (pn < 8) return (bj ? C_CI : C_CG) + 128 * (pn - 4) + 32 * wc;
    if (pn < 10) return C_Q + (4 * (pn - 8) + wc) * 64 + 32 * bj;
    if (pn < 13) return C_KV + (pn - 10) * 256 + wc * 64 + 32 * bj;
    if (pn < 15) return C_ZA + 256 * (pn - 13) + 32 * gi;
    nvalid = (gi == 0) ? 24 : 0; return C_GL;
}
__device__ __forceinline__ void p0_transpose_item(const float* W, int ldw, int k0, int src0, int nvalid, const float* ksc, bf16* WT, int ldt, int drow0, LAS float* scr, int lane) {
    const int nn = lane & 31;
#pragma unroll 8
    for (int i = 0; i < 32; ++i) { const int kk = 2 * i + (lane >> 5); float v = 0.f;
        if (nn < nvalid) { v = W[(size_t)(k0 + kk) * ldw + src0 + nn]; if (ksc) v *= ksc[k0 + kk]; }
        scr[kk * 33 + nn] = v; }
    LDS_WAIT(); asm volatile("" ::: "memory");
    const int c = lane & 7;
#pragma unroll
    for (int j = 0; j < 4; ++j) { const int n = (lane >> 3) + 8 * j; const LAS float* s = scr + (8 * c) * 33 + n;
        v4u o; o.x = pk2(s[0 * 33], s[1 * 33]); o.y = pk2(s[2 * 33], s[3 * 33]); o.z = pk2(s[4 * 33], s[5 * 33]); o.w = pk2(s[6 * 33], s[7 * 33]);
        *(GAS v4u*)(WT + (size_t)(drow0 + n) * ldt + k0 + 8 * c) = o; }
    LDS_WAIT(); asm volatile("" ::: "memory");
}
template <int NR>
__device__ __forceinline__ void x_rows_to_bf16(const float* xrow, bf16* orow, float* rstd_out, int lane) {
    f32x4 v[NR][4]; float s[NR];
#pragma unroll
    for (int r = 0; r < NR; ++r)
#pragma unroll
        for (int j = 0; j < 4; ++j) v[r][j] = ((const GAS f32x4*)(xrow + (size_t)r * D) + lane)[64 * j];
#pragma unroll
    for (int r = 0; r < NR; ++r) { s[r] = 0.f;
#pragma unroll
        for (int j = 0; j < 4; ++j) s[r] += (v[r][j].x * v[r][j].x + v[r][j].y * v[r][j].y) + (v[r][j].z * v[r][j].z + v[r][j].w * v[r][j].w); }
#pragma unroll
    for (int o = 1; o < 64; o <<= 1)
#pragma unroll
        for (int r = 0; r < NR; ++r) s[r] += __shfl_xor(s[r], o);
#pragma unroll
    for (int r = 0; r < NR; ++r) { GAS unsigned long long* o8 = (GAS unsigned long long*)(orow + (size_t)r * D) + lane;
#pragma unroll
        for (int j = 0; j < 4; ++j) o8[64 * j] = (unsigned long long)pk2(v[r][j].x, v[r][j].y) | ((unsigned long long)pk2(v[r][j].z, v[r][j].w) << 32);
        if (lane == 0) rstd_out[r] = 1.0f / sqrtf(s[r] * (1.0f / D) + NORM_EPS); }
}
template <bool SAMPLE>
__device__ __forceinline__ const float* cmp_rowbase(const Ptrs& P, int unit, int rho) {
    const int b = SAMPLE ? unit >> 6 : unit >> 5, c = (SAMPLE ? (unit & 63) : (unit & 31)) * 8 + (rho >> 1), g = rho & 1;
    if (SAMPLE) { const int page = P.page_table[b * NPAGES + (c >> 2)]; return P.cache_cmp + ((size_t)page * 128 + (c & 3) * 32) * 256 + g * 64; }
    return P.out + O_PCMP + ((size_t)b * T + c * 32) * 256 + g * 64;
}
template <bool SAMPLE>
__device__ __forceinline__ void compress_units(const Ptrs& P, Frame& F, LAS float* part  ) {
    constexpr int NUNITS = SAMPLE ? DECB * (NCS / 8) : BATCH * 32;
    const int lane = F.lane, w = F.wave, rho = lane & 15, kq = lane >> 4;
    const GAS v4u* bfr = (const GAS v4u*)(P.ws + WS_BTC) + lane;
    const float* cbias = (const float*)(P.ws + WS_CBIAS);
    int unit = blockIdx.x;
    if (unit >= NUNITS) return;
    f32x4 a_cur[8], a_n1[8], a_n2[8];
    const float* rb = cmp_rowbase<SAMPLE>(P, unit, rho) + 4 * kq;
#define CMP_LOAD(dst, base, r) do { _Pragma("unroll") for (int q_ = 0; q_ < 4; ++q_) { dst[2 * q_] = *(const GAS f32x4*)((base) + (r) * 256 + (q_ >> 1) * 128 + (q_ & 1) * 32); dst[2 * q_ + 1] = *(const GAS f32x4*)((base) + (r) * 256 + (q_ >> 1) * 128 + (q_ & 1) * 32 + 16); } } while (0)
    CMP_LOAD(a_cur, rb, 4 * w); CMP_LOAD(a_n1, rb, 4 * w + 1);
    for (;;) {
        f32x4 acc[2][4];
#pragma unroll
        for (int j = 0; j < 2; ++j)
#pragma unroll
            for (int e = 0; e < 4; ++e) acc[j][e] = (f32x4){0.f, 0.f, 0.f, 0.f};
        const int nunit = unit + F.G; const bool has_next = nunit < NUNITS;
        const float* rbn = has_next ? cmp_rowbase<SAMPLE>(P, nunit, rho) + 4 * kq : rb;
#pragma unroll 1
        for (int rr = 0; rr < 4; ++rr) {
            const int r = 4 * w + rr;
            bf16x8 bb[16];
#pragma unroll
            for (int q_ = 0; q_ < 4; ++q_)
#pragma unroll
                for (int et = 0; et < 4; ++et) bb[q_ * 4 + et] = __builtin_bit_cast(bf16x8, bfr[(size_t)(((((q_ >> 1) * 32 + r) * 2 + (q_ & 1)) * 4 + et) * 64)]);
            __builtin_amdgcn_sched_barrier(0);
            { const float* nb_ = rr < 2 ? rb : rbn; const int nr_ = rr < 2 ? r + 2 : 4 * w + (rr - 2); CMP_LOAD(a_n2, nb_, nr_); }
            __builtin_amdgcn_sched_barrier(0);
#pragma unroll
            for (int q_ = 0; q_ < 4; ++q_) { const int j = q_ >> 1;
                v4u wv; wv.x = pk2(a_cur[2 * q_].x, a_cur[2 * q_].y); wv.y = pk2(a_cur[2 * q_].z, a_cur[2 * q_].w); wv.z = pk2(a_cur[2 * q_ + 1].x, a_cur[2 * q_ + 1].y); wv.w = pk2(a_cur[2 * q_ + 1].z, a_cur[2 * q_ + 1].w);
                const bf16x8 af = __builtin_bit_cast(bf16x8, wv);
#pragma unroll
                for (int et = 0; et < 4; ++et) acc[j][et] = __builtin_amdgcn_mfma_f32_16x16x32_bf16(af, bb[q_ * 4 + et], acc[j][et], 0, 0, 0); }
#pragma unroll
            for (int q_ = 0; q_ < 8; ++q_) { a_cur[q_] = a_n1[q_]; a_n1[q_] = a_n2[q_]; }
        }
#pragma unroll
        for (int j = 0; j < 2; ++j)
#pragma unroll
            for (int et = 0; et < 4; ++et) *(LAS f32x4*)(part + ((w * 8 + j * 4 + et) * 64 + lane) * 4) = acc[j][et];
        __syncthreads();
        { const int j = w >> 2, et = w & 3, e = 16 * et + rho; f32x4 sum = *(const LAS f32x4*)(part + ((0 * 8 + w) * 64 + lane) * 4);
#pragma unroll
          for (int ww = 1; ww < 8; ++ww) sum = sum + *(const LAS f32x4*)(part + ((ww * 8 + w) * 64 + lane) * 4);
          const float bs = cbias[j * 64 + e]; const int b = SAMPLE ? unit >> 6 : unit >> 5, c0 = (SAMPLE ? (unit & 63) : (unit & 31)) * 8;
          float nmax = 0.f;
#pragma unroll
          for (int i = 0; i < 4; ++i) { const int row = 4 * kq + i, c = c0 + (row >> 1), g = row & 1; const float val = sum[i] + bs;
              float q2 = val * val; q2 += __shfl_xor(q2, 1); q2 += __shfl_xor(q2, 2); q2 += __shfl_xor(q2, 4); q2 += __shfl_xor(q2, 8); nmax = fmaxf(nmax, q2);
              if (SAMPLE) ((float*)(P.ws + WS_KCS))[((size_t)((b * 2 + g) * 2 + j) * NCS + c) * 64 + e] = val;
              else { bf16* img = (bf16*)(P.ws + WS_KC) + ((size_t)(b * 2 + g) * 4 + (c >> 6)) * 8192;
                  if (j == 0) img[kimg_off(c & 63, e)] = (bf16)f2bf(val); else img[vimg_off(e, (c & 48) + perm16(c & 15))] = (bf16)f2bf(val); } }
          if (j == 0) { nmax = fmaxf(nmax, __shfl_xor(nmax, 16)); nmax = fmaxf(nmax, __shfl_xor(nmax, 32));
              if (lane == 0) atomicMax((unsigned*)(P.ws + WS_CTL) + CW_KCMAX + (SAMPLE ? 64 : 0) + et, __builtin_bit_cast(unsigned, nmax)); } }
        __syncthreads();
        if (!has_next) break;
        unit = nunit; rb = rbn;
    }
#undef CMP_LOAD
}
constexpr int CMP_NPASS = DECB * 16;
__device__ __forceinline__ void lds_wait_ge(volatile LAS unsigned* c, unsigned want) { unsigned sp = 0u; while (*c < want) { __builtin_amdgcn_s_sleep(1); if (++sp > (1u << 24)) break; } }
__device__ __forceinline__ void compress_team(const Ptrs& P, Frame& F, LAS unsigned char* bl  , volatile LAS unsigned* cw  , volatile LAS unsigned* cr  , int npass) {
    const int lane = F.lane, w = F.wave, tid = w * 64 + lane, rho = lane & 15, kq = lane >> 4;
    unsigned nw_ = 0u, nr_ = 0u;
    for (int pi = 0; pi < npass; ++pi) { const int pass = blockIdx.x + pi * F.G;
    const int b = pass >> 4, c0 = (pass & 15) * 32 + w * 8;
    const float* rb; { const int c = c0 + (rho >> 1), g = rho & 1; const int page = P.page_table[b * NPAGES + (c >> 2)]; rb = P.cache_cmp + ((size_t)page * 128 + (c & 3) * 32) * 256 + g * 64 + 4 * kq; }
    const GAS v4u* bsrc = (const GAS v4u*)(P.ws + WS_BTC);
    const int sf = tid >> 4, sj = sf >> 3, sdh = (sf >> 2) & 1, set_ = sf & 3, sl = (tid & 15) * 4;
#define B_SRC(r) (bsrc + (size_t)((((sj * 32 + (r)) * 2 + sdh) * 4 + set_) * 64 + sl))
    LAS v4u* bdst = (LAS v4u*)bl + sf * 64 + sl;
    f32x4 a_cur[8], a_n1[8], a_n2[8], a_n3[8];
#define CMP_LOAD(dst, base, r) do { _Pragma("unroll") for (int q_ = 0; q_ < 4; ++q_) { dst[2 * q_] = *(const GAS f32x4*)((base) + (r) * 256 + (q_ >> 1) * 128 + (q_ & 1) * 32); dst[2 * q_ + 1] = *(const GAS f32x4*)((base) + (r) * 256 + (q_ >> 1) * 128 + (q_ & 1) * 32 + 16); } } while (0)
    { const v4u b0 = B_SRC(0)[0], b1 = B_SRC(0)[1], b2 = B_SRC(0)[2], b3 = B_SRC(0)[3];
      lds_wait_ge(cr, 4u * nr_);
      bdst[0] = b0; bdst[1] = b1; bdst[2] = b2; bdst[3] = b3; LDS_WAIT(); ++nw_; if (lane == 0) __hip_atomic_fetch_add((LAS unsigned*)cw, 1u, __ATOMIC_RELAXED, __HIP_MEMORY_SCOPE_WORKGROUP); }
    CMP_LOAD(a_cur, rb, 0); CMP_LOAD(a_n1, rb, 1); CMP_LOAD(a_n2, rb, 2);
    f32x4 acc[2][4];
#pragma unroll
    for (int j = 0; j < 2; ++j)
#pragma unroll
        for (int e = 0; e < 4; ++e) acc[j][e] = (f32x4){0.f, 0.f, 0.f, 0.f};
#pragma unroll 1
    for (int r = 0; r < 32; ++r) {
        const int rn = r + 1 < 32 ? r + 1 : 31, r3 = r + 3 < 32 ? r + 3 : 31;
        const v4u b0 = B_SRC(rn)[0], b1 = B_SRC(rn)[1], b2 = B_SRC(rn)[2], b3 = B_SRC(rn)[3];
        __builtin_amdgcn_sched_barrier(0);
        CMP_LOAD(a_n3, rb, r3);
        __builtin_amdgcn_sched_barrier(0);
        lds_wait_ge(cw, 4u * nw_);
        const LAS v4u* bf = (const LAS v4u*)bl + (r & 1) * 1024 + lane;
#pragma unroll
        for (int q_ = 0; q_ < 4; ++q_) { const int j = q_ >> 1;
            v4u wv; wv.x = pk2(a_cur[2 * q_].x, a_cur[2 * q_].y); wv.y = pk2(a_cur[2 * q_].z, a_cur[2 * q_].w); wv.z = pk2(a_cur[2 * q_ + 1].x, a_cur[2 * q_ + 1].y); wv.w = pk2(a_cur[2 * q_ + 1].z, a_cur[2 * q_ + 1].w);
            const bf16x8 af = __builtin_bit_cast(bf16x8, wv);
#pragma unroll
            for (int et = 0; et < 4; ++et) acc[j][et] = __builtin_amdgcn_mfma_f32_16x16x32_bf16(af, __builtin_bit_cast(bf16x8, bf[(q_ * 4 + et) * 64]), acc[j][et], 0, 0, 0); }
        LDS_WAIT(); ++nr_; if (lane == 0) __hip_atomic_fetch_add((LAS unsigned*)cr, 1u, __ATOMIC_RELAXED, __HIP_MEMORY_SCOPE_WORKGROUP);
        if (r + 1 < 32) { lds_wait_ge(cr, 4u * (nr_ - 1u));
            LAS v4u* d_ = bdst + ((r + 1) & 1) * 1024; d_[0] = b0; d_[1] = b1; d_[2] = b2; d_[3] = b3; LDS_WAIT(); ++nw_; if (lane == 0) __hip_atomic_fetch_add((LAS unsigned*)cw, 1u, __ATOMIC_RELAXED, __HIP_MEMORY_SCOPE_WORKGROUP); }
#pragma unroll
        for (int q_ = 0; q_ < 8; ++q_) { a_cur[q_] = a_n1[q_]; a_n1[q_] = a_n2[q_]; a_n2[q_] = a_n3[q_]; }
    }
#undef CMP_LOAD
#undef B_SRC
    const float* cbias = (const float*)(P.ws + WS_CBIAS);
    float nmax = 0.f;
#pragma unroll
    for (int i = 0; i < 4; ++i) { const int row = 4 * kq + i, c = c0 + (row >> 1), g = row & 1; float q2 = 0.f;
#pragma unroll
        for (int j = 0; j < 2; ++j)
#pragma unroll
            for (int et = 0; et < 4; ++et) { const int e = 16 * et + rho; const float val = acc[j][et][i] + cbias[j * 64 + e]; if (j == 0) q2 += val * val;
                ((float*)(P.ws + WS_KCS))[((size_t)((b * 2 + g) * 2 + j) * NCS + c) * 64 + e] = val; }
        q2 += __shfl_xor(q2, 1); q2 += __shfl_xor(q2, 2); q2 += __shfl_xor(q2, 4); q2 += __shfl_xor(q2, 8); nmax = fmaxf(nmax, q2); }
    nmax = fmaxf(nmax, __shfl_xor(nmax, 16)); nmax = fmaxf(nmax, __shfl_xor(nmax, 32));
    if (lane == 0) atomicMax((unsigned*)(P.ws + WS_CTL) + CW_KCMAX + 64, __builtin_bit_cast(unsigned, nmax));
    }
}
constexpr int P0_PRODUCERS = 641;
__device__ __forceinline__ void p0_small_items(const Ptrs& P, Frame& F) {
    const int lane = F.lane, gw = F.gw;
    if (gw >= P0_PRODUCERS && F.NGW >= P0_PRODUCERS) return;
    for (int item = gw; item < P0_PRODUCERS; item += F.NGW) {
        if (item < 512) { const int it = item * 64 + lane; const int l = it & 63, et = (it >> 6) & 3, dh = (it >> 8) & 1, r = (it >> 9) & 31, j = it >> 14;
            const float* w = P.cmp_w + ((size_t)(r * 2 + j) * 64 + 32 * dh + 4 * (l >> 4)) * 64 + 16 * et + (l & 15);
            v4u o; o.x = pk2(w[0], w[64]); o.y = pk2(w[128], w[192]); o.z = pk2(w[16 * 64], w[17 * 64]); o.w = pk2(w[18 * 64], w[19 * 64]);
            __builtin_amdgcn_raw_buffer_store_b128(o, __builtin_amdgcn_make_buffer_rsrc((void*)(P.ws + WS_BTC), 0, 512 * 1024, 0x00020000), it * 16, 0, 16);
        } else if (item < 640) { const int it = item - 512, j = it >> 6, e = it & 63; float s = 0.f;
            for (int k = lane; k < 2048; k += 64) { const int r = k >> 6, d = k & 63; s += P.cmp_pe[(r * 2 + j) * 64 + d] * P.cmp_w[((size_t)(r * 2 + j) * 64 + d) * 64 + e]; }
            s = wave_sum(s); if (lane == 0) __hip_atomic_store((float*)(P.ws + WS_CBIAS) + it, s, RLX_AGENT);
        } else { float qm = fabsf(P.q_gain[lane]), k1 = fabsf(P.k_gain[64 + lane]), k2 = fabsf(P.k_gain[128 + lane]);
#pragma unroll
            for (int o = 1; o < 64; o <<= 1) { qm = fmaxf(qm, __shfl_xor(qm, o)); k1 = fmaxf(k1, __shfl_xor(k1, o)); k2 = fmaxf(k2, __shfl_xor(k2, o)); }
            if (lane == 0) { float* cst = (float*)(P.ws + WS_CONST); __hip_atomic_store(cst + 0, qm, RLX_AGENT); __hip_atomic_store(cst + 1, 8.0f * qm * k1 * LOG2E * 1.001f, RLX_AGENT); __hip_atomic_store(cst + 2, 8.0f * qm * k2 * LOG2E * 1.001f, RLX_AGENT); } }
        asm volatile("s_waitcnt vmcnt(0)" ::: "memory");
        if (lane == 0) __hip_atomic_fetch_add((unsigned*)(F.ctl + CW_P0CNT), 1u, RLX_AGENT);
    }
}
__device__ __forceinline__ void p0_rope(const Ptrs& P, Frame& F, int gw, int NGW) {
    const int lane = F.lane; const int i = lane & 31;
    const float inv = (float)pow(10000.0, -(double)i / 32.0);
    for (int it = gw * 64 + lane; it < 8193 * 32; it += NGW * 64) { const int p = it >> 5; const int pos = (p == 8192) ? PAST : p;
        const float ang = (float)pos * inv; const double rev = (double)ang * 0.15915494309189535; const float fr = (float)(rev - __builtin_rint(rev));
        float* rt = (float*)(P.ws + WS_ROPE) + (size_t)p * 64; rt[i] = __builtin_amdgcn_cosf(fr); rt[32 + i] = __builtin_amdgcn_sinf(fr); }
}
__device__ __forceinline__ void p0_other_slice(const Ptrs& P, Frame& F, int k, int gw, int NGW, LAS float* scr) {
    const int lane = F.lane;
    if (k < 2) { const int it = gw + k * NGW; if (it < 16 * 128) { const int kb = it >> 7, dg = it & 127; int nv; const int src0 = bt1_src(dg, nv);
        p0_transpose_item(P.w_in, INW, 64 * kb, src0, nv, P.norm_g, (bf16*)(P.ws + WS_BT1), D, 32 * dg, scr, lane); }
    } else if (k == 2) { for (int it = gw; it < 16 * 32; it += NGW) { const int kb = it >> 5, nb = it & 31;
        p0_transpose_item(P.w_out, D, 64 * kb, 32 * nb, 32, nullptr, (bf16*)(P.ws + WS_BT2), D, 32 * nb, scr, lane); }
    } else if (k < 11) { for (int m = (gw + (k - 3) * NGW) * 4; m < M; m += NGW * 4 * 8) x_rows_to_bf16<4>(P.xp + (size_t)m * D, (bf16*)(P.ws + WS_XB) + (size_t)m * D, (float*)(P.ws + WS_RSTD) + m, lane);
    } else if (k == 11) { for (int m = gw; m < DECB; m += NGW) x_rows_to_bf16<1>(P.xs + (size_t)m * D, (bf16*)(P.ws + WS_XSB) + (size_t)m * D, (float*)(P.ws + WS_RSTDS) + m, lane);
        for (int it = gw * 64 + lane; it < DECB * 512; it += NGW * 64) { const int b = it >> 9, ch = it & 511; P.out[O_SCONV + (size_t)b * 1024 + ch] = P.st_conv[(size_t)b * 1024 + 512 + ch]; }
    } else if (k == 12) {
        constexpr int PERB = 511 * 64, TOTAL = DECB * PERB; const GAS f32x4* src = (const GAS f32x4*)P.st_win; GAS f32x4* dst = (GAS f32x4*)(P.out + O_SWIN);
        for (int i0 = gw * 64 + lane; i0 < TOTAL; i0 += NGW * 64 * 8) { f32x4 t[8];
#pragma unroll
            for (int u = 0; u < 8; ++u) { const int i = i0 + u * NGW * 64; if (i < TOTAL) { const int b = i / PERB; t[u] = src[i + 64 * b + 64]; } }
#pragma unroll
            for (int u = 0; u < 8; ++u) { const int i = i0 + u * NGW * 64; if (i < TOTAL) { const int b = i / PERB; dst[i + 64 * b] = t[u]; } } }
    } else if (k == 13) p0_rope(P, F, gw, NGW);
}
constexpr int P0_OTHER_SLICES = 14;
__device__ __forceinline__ void p0_phase(const Ptrs& P, Frame& F) {
    p0_small_items(P, F);
    if (F.wave == 0) { if (F.lane == 0) { unsigned sp = 0u; while (__hip_atomic_load((unsigned*)(F.ctl + CW_P0CNT), RLX_AGENT) < (unsigned)P0_PRODUCERS) { __builtin_amdgcn_s_sleep(2); if (++sp > (1u << 22)) break; } }
        __builtin_amdgcn_fence(__ATOMIC_ACQUIRE, "agent"); asm volatile("s_waitcnt vmcnt(0)" ::: "memory"); }
    __syncthreads();
    const int npass = (int)blockIdx.x < CMP_NPASS ? (CMP_NPASS - 1 - (int)blockIdx.x) / F.G + 1 : 0;
    if (F.wave < 4) compress_team(P, F, F.lds + RING_OFF, F.MISC + 16, F.MISC + 17, npass);
    else { const int gw = blockIdx.x * 4 + (F.wave - 4), NGW = F.G * 4; LAS float* scr = (LAS float*)(F.lds + RING_OFF + 32768 + (F.wave - 4) * 16384);
        for (int k = 0; k < P0_OTHER_SLICES; ++k) p0_other_slice(P, F, k, gw, NGW, scr); }
}
struct EpiIn {
    static constexpr bool PERM = false, AFTER_DRAIN = false;
    const float *rstd, *rope, *qg, *kg; float* out; unsigned char* ws;
    __device__ __forceinline__ void operator()(const f32x4 (&acc)[2][2][4][2], const pg8::Unit& u, int wr, int wc, int fr, int fq) const {
        asm volatile("" : "+v"(fr), "+v"(fq));
        const int pn = u.pn; const int rbase = u.pm * 256 + wr * 64 + fr;
        if (pn < 8) {
            const bool bz = pn < 4; bf16* dst = (bf16*)(ws + (bz ? WS_CG : WS_U)); const int col0 = 128 * (pn & 3) + 32 * wc + 4 * fq;
#pragma unroll
            for (int ai = 0; ai < 2; ++ai)
#pragma unroll
                for (int m = 0; m < 4; ++m) { const int row = rbase + ai * 128 + m * 16; const float rs = rstd[row];
#pragma unroll
                    for (int n = 0; n < 2; ++n) { const f32x4 a = acc[ai][0][m][n] * rs, z = acc[ai][1][m][n] * rs; f32x4 o;
                        if (bz) { o.x = a.x * z.x * sigmoidf(z.x); o.y = a.y * z.y * sigmoidf(z.y); o.z = a.z * z.z * sigmoidf(z.z); o.w = a.w * z.w * sigmoidf(z.w); }
                        else o = a * z;
                        v2u w; w.x = pk2(o.x, o.y); w.y = pk2(o.z, o.w);
                        *(GAS v2u*)(dst + (size_t)row * 512 + col0 + 16 * n) = w;
                        if (!bz) { const int t = row & (T - 1); if (t >= T - 2) *(GAS f32x4*)(out + O_PCONV + ((size_t)(row >> 13) * 2 + (t - (T - 2))) * 512 + col0 + 16 * n) = o; } } }
        } else if (pn < 13) {
            const bool isq = pn < 10; const int br = pn - 10; const bool isk = !isq && wc < 2;
            if (isq || isk) {
                const float* gain = isq ? qg : kg + br * 64; float g1[2][4], g2[2][4];
#pragma unroll
                for (int n = 0; n < 2; ++n)
#pragma unroll
                    for (int e = 0; e < 4; ++e) { g1[n][e] = gain[16 * n + 4 * fq + e]; g2[n][e] = gain[32 + 16 * n + 4 * fq + e]; }
#pragma unroll
                for (int ai = 0; ai < 2; ++ai)
#pragma unroll
                    for (int m = 0; m < 4; ++m) { const int row = rbase + ai * 128 + m * 16; const float rs = rstd[row]; const int t = row & (T - 1), b = row >> 13;
                        f32x4 x1[2], x2[2]; float ss = 0.f;
#pragma unroll
                        for (int n = 0; n < 2; ++n) { x1[n] = acc[ai][0][m][n] * rs; x2[n] = acc[ai][1][m][n] * rs;
                            ss += (x1[n].x * x1[n].x + x1[n].y * x1[n].y) + (x1[n].z * x1[n].z + x1[n].w * x1[n].w) + (x2[n].x * x2[n].x + x2[n].y * x2[n].y) + (x2[n].z * x2[n].z + x2[n].w * x2[n].w); }
                        ss += __shfl_xor(ss, 16); ss += __shfl_xor(ss, 32);
                        const float inv = 1.0f / sqrtf(ss * (1.0f / 64.0f) + NORM_EPS);
                        const float* rp = rope + (size_t)t * 64 + 4 * fq;
#pragma unroll
                        for (int n = 0; n < 2; ++n) { const f32x4 cs = *(const GAS f32x4*)(rp + 16 * n), sn = *(const GAS f32x4*)(rp + 32 + 16 * n); f32x4 o1, o2;
#pragma unroll
                            for (int e = 0; e < 4; ++e) { const float a = x1[n][e] * inv * g1[n][e], c = x2[n][e] * inv * g2[n][e]; o1[e] = a * cs[e] - c * sn[e]; o2[e] = c * cs[e] + a * sn[e]; }
                            const int d1 = 16 * n + 4 * fq;
                            if (isq) { o1 = o1 * QSCALE; o2 = o2 * QSCALE; bf16* q = (bf16*)(ws + WS_Q) + (size_t)row * 512 + (4 * (pn - 8) + wc) * 64 + d1;
                                v2u w; w.x = pk2(o1.x, o1.y); w.y = pk2(o1.z, o1.w); *(GAS v2u*)q = w; w.x = pk2(o2.x, o2.y); w.y = pk2(o2.z, o2.w); *(GAS v2u*)(q + 32) = w; }
                            else { const int g = wc;
                                if (br > 0) { bf16* img = (bf16*)(ws + (br == 1 ? WS_KS : WS_KW)) + ((size_t)(b * 2 + g) * 128 + (t >> 6)) * 8192;
                                    v2u w; w.x = pk2(o1.x, o1.y); w.y = pk2(o1.z, o1.w); *(GAS v2u*)(img + kimg_off(t & 63, d1)) = w; w.x = pk2(o2.x, o2.y); w.y = pk2(o2.z, o2.w); *(GAS v2u*)(img + kimg_off(t & 63, d1 + 32)) = w; }
                                if (br < 2) { float* o = out + (br == 0 ? O_PCMP : O_PSLC) + (size_t)row * 256 + g * 64 + d1; *(GAS f32x4*)o = o1; *(GAS f32x4*)(o + 32) = o2; }
                                else if (t >= T - 512) { float* o = out + O_PWIN + ((size_t)b * 512 + (t - (T - 512))) * 256 + g * 64 + d1; *(GAS f32x4*)o = o1; *(GAS f32x4*)(o + 32) = o2; } } } }
            } else {
                const int g = wc - 2;
#pragma unroll
                for (int ai = 0; ai < 2; ++ai)
#pragma unroll
                    for (int m = 0; m < 4; ++m) { const int row = rbase + ai * 128 + m * 16; const float rs = rstd[row]; const int t = row & (T - 1), b = row >> 13;
                        const int tk = t & 63, vpos = (tk & ~15) + perm16(tk & 15);
                        bf16* vt = (br > 0) ? (bf16*)(ws + (br == 1 ? WS_KS : WS_KW)) + ((size_t)(b * 2 + g) * 128 + (t >> 6)) * 8192 : nullptr;
                        const float vsc = (br == 1) ? slc_vscale(((const float*)(ws + WS_CONST))[1]) : 1.0f;
#pragma unroll
                        for (int bj = 0; bj < 2; ++bj)
#pragma unroll
                            for (int n = 0; n < 2; ++n) { const f32x4 v = acc[ai][bj][m][n] * rs; const int d1 = 32 * bj + 16 * n + 4 * fq;
                                if (br > 0) {
#pragma unroll
                                    for (int e = 0; e < 4; ++e) vt[vimg_off(d1 + e, vpos)] = (bf16)f2bf(v[e] * vsc); }
                                if (br < 2) *(GAS f32x4*)(out + (br == 0 ? O_PCMP : O_PSLC) + (size_t)row * 256 + 128 + g * 64 + d1) = v;
                                else if (t >= T - 512) *(GAS f32x4*)(out + O_PWIN + ((size_t)b * 512 + (t - (T - 512))) * 256 + 128 + g * 64 + d1) = v; } }
            }
        } else if (pn < 15) {
            bf16* dst = (bf16*)(ws + WS_ZA);
#pragma unroll
            for (int ai = 0; ai < 2; ++ai)
#pragma unroll
                for (int m = 0; m < 4; ++m) { const int row = rbase + ai * 128 + m * 16; const float rs = rstd[row];
#pragma unroll
                    for (int bj = 0; bj < 2; ++bj)
#pragma unroll
                        for (int n = 0; n < 2; ++n) { const f32x4 z = acc[ai][bj][m][n] * rs; v2u w; w.x = pk2(z.x * sigmoidf(z.x), z.y * sigmoidf(z.y)); w.y = pk2(z.z * sigmoidf(z.z), z.w * sigmoidf(z.w));
                            *(GAS v2u*)(dst + (size_t)row * 512 + 256 * (pn - 13) + 128 * bj + 32 * wc + 16 * n + 4 * fq) = w; } }
        } else {
            if (wc == 0) { float* dst = (float*)(ws + WS_GATE);
#pragma unroll
                for (int ai = 0; ai < 2; ++ai)
#pragma unroll
                    for (int m = 0; m < 4; ++m) { const int row = rbase + ai * 128 + m * 16; const float rs = rstd[row];
#pragma unroll
                        for (int n = 0; n < 2; ++n) { const int c0 = 16 * n + 4 * fq; if (c0 < 24) { const f32x4 z = acc[ai][0][m][n] * rs;
                            *(GAS f32x4*)(dst + (size_t)row * 24 + c0) = (f32x4){sigmoidf(z.x), sigmoidf(z.y), sigmoidf(z.z), sigmoidf(z.w)}; } } } }
        }
    }
};
struct EpiOut {
    static constexpr bool PERM = false, AFTER_DRAIN = false;
    const float* x; float* y;
    __device__ __forceinline__ void operator()(const f32x4 (&acc)[2][2][4][2], const pg8::Unit& u, int wr, int wc, int fr, int fq) const {
        asm volatile("" : "+v"(fr), "+v"(fq));
#pragma unroll
        for (int ai = 0; ai < 2; ++ai)
#pragma unroll
            for (int m = 0; m < 4; ++m) { const size_t row = (size_t)u.pm * 256 + ai * 128 + wr * 64 + m * 16 + fr;
#pragma unroll
                for (int bj = 0; bj < 2; ++bj)
#pragma unroll
                    for (int n = 0; n < 2; ++n) { const size_t off = row * D + u.pn * 256 + 128 * bj + 32 * wc + 16 * n + 4 * fq;
                        *(GAS f32x4*)(y + off) = *(const GAS f32x4*)(x + off) + acc[ai][bj][m][n]; } }
    }
};
template <int MODE>
__device__ __forceinline__ void small_gemm_tile(const Ptrs& P, const bf16* A, const bf16* Bt, int ct, int lane) {
    const int rho = lane & 15, kq = lane >> 4;
    f32x4 acc[2] = {(f32x4){0.f, 0.f, 0.f, 0.f}, (f32x4){0.f, 0.f, 0.f, 0.f}};
    const GAS v4u* a0 = (const GAS v4u*)(A + (size_t)rho * D + 8 * kq); const GAS v4u* a1 = (const GAS v4u*)(A + (size_t)(16 + rho) * D + 8 * kq);
    const GAS v4u* bp = (const GAS v4u*)(Bt + (size_t)(16 * ct + rho) * D + 8 * kq);
#pragma unroll 8
    for (int ks = 0; ks < 32; ++ks) { const bf16x8 bb = __builtin_bit_cast(bf16x8, bp[ks * 4]);
        acc[0] = __builtin_amdgcn_mfma_f32_16x16x32_bf16(bb, __builtin_bit_cast(bf16x8, a0[ks * 4]), acc[0], 0, 0, 0);
        acc[1] = __builtin_amdgcn_mfma_f32_16x16x32_bf16(bb, __builtin_bit_cast(bf16x8, a1[ks * 4]), acc[1], 0, 0, 0); }
#pragma unroll
    for (int rt = 0; rt < 2; ++rt) { const int b = 16 * rt + rho; const int col = 16 * ct + 4 * kq;
        if (MODE == 0) { const float rs = ((const float*)(P.ws + WS_RSTDS))[b]; *(GAS f32x4*)((float*)(P.ws + WS_PROJS) + (size_t)b * NP + col) = acc[rt] * rs; }
        else *(GAS f32x4*)(P.out + O_YS + (size_t)b * D + col) = *(const GAS f32x4*)(P.xs + (size_t)b * D + col) + acc[rt]; }
}
__device__ __forceinline__ int projs_col(int pn, int wc, int d) { return 256 * pn + 128 * (d >> 5) + 32 * wc + (d & 31); }
__device__ __forceinline__ void p2_sample_item(const Ptrs& P, int it, int lane) {
    const int b = it / 37, ty = it - b * 37;
    const float* pr = (const float*)(P.ws + WS_PROJS) + (size_t)b * NP;
    const float* ropes = (const float*)(P.ws + WS_ROPE) + (size_t)8192 * 64;
    float* kvn = (float*)(P.ws + WS_KVN) + (size_t)b * 768;
    if (ty < 14) {
        const bool isq = ty < 8; const int br = isq ? 0 : (ty - 8) >> 1, g = (ty - 8) & 1;
        const int pn = isq ? 8 + (ty >> 2) : 10 + br, wc = isq ? (ty & 3) : g;
        const float v = pr[projs_col(pn, wc, lane)];
        const float ss = wave_sum(v * v); const float inv = 1.0f / sqrtf(ss * (1.0f / 64.0f) + NORM_EPS);
        const float gn = isq ? P.q_gain[lane] : P.k_gain[br * 64 + lane];
        const float xn = v * inv * gn; const float xo = __shfl_xor(xn, 32);
        const int i = lane & 31; const float cs = ropes[i], sn = ropes[32 + i];
        const float o = (lane < 32) ? xn * cs - xo * sn : xn * cs + xo * sn;
        if (isq) ((float*)(P.ws + WS_QS))[(size_t)b * 512 + ty * 64 + lane] = o * QSCALE;
        else { kvn[(br * 2 + 0) * 128 + g * 64 + lane] = o;
            if (br == 0) P.out[O_SCMP + (size_t)b * 256 + g * 64 + lane] = o; else if (br == 1) P.out[O_SSLC + (size_t)b * 256 + g * 64 + lane] = o;
            else P.out[O_SWIN + ((size_t)b * 512 + 511) * 256 + g * 64 + lane] = o; }
    } else if (ty < 20) {
        const int br = (ty - 14) >> 1, g = (ty - 14) & 1; const float v = pr[projs_col(10 + br, 2 + g, lane)];
        kvn[(br * 2 + 1) * 128 + g * 64 + lane] = v;
        if (br == 0) P.out[O_SCMP + (size_t)b * 256 + 128 + g * 64 + lane] = v; else if (br == 1) P.out[O_SSLC + (size_t)b * 256 + 128 + g * 64 + lane] = v;
        else P.out[O_SWIN + ((size_t)b * 512 + 511) * 256 + 128 + g * 64 + lane] = v;
    } else if (ty == 20) {
        if (lane < 24) ((float*)(P.ws + WS_GS))[b * 24 + lane] = sigmoidf(pr[256 * 15 + lane]);
    } else if (ty < 29) {
        const int ch = (ty - 21) * 64 + lane; const int pnb = ch >> 7, tc = ch & 127;
        const float bg = pr[256 * pnb + tc], zc = pr[256 * pnb + 128 + tc], cg = pr[256 * (4 + pnb) + tc], ci = pr[256 * (4 + pnb) + 128 + tc];
        const float u = cg * ci; const float s0 = P.st_conv[(size_t)b * 1024 + ch], s1 = P.st_conv[(size_t)b * 1024 + 512 + ch];
        const float cy = P.conv_w[ch] * s0 + P.conv_w[512 + ch] * s1 + P.conv_w[1024 + ch] * u + P.conv_b[ch];
        ((bf16*)(P.ws + WS_MIXS))[(size_t)b * 1024 + ch] = (bf16)f2bf(bg * cy * zc * sigmoidf(zc));
        P.out[O_SCONV + (size_t)b * 1024 + 512 + ch] = u;
    } else {
        const int col = (ty - 29) * 64 + lane; const float z = pr[256 * (13 + (col >> 8)) + (col & 255)];
        ((float*)(P.ws + WS_ZAS))[(size_t)b * 512 + col] = z * sigmoidf(z);
    }
}
__device__ __forceinline__ void p2_phase(const Ptrs& P, Frame& F) {
    compress_units<false>(P, F, (LAS float*)(F.lds + RING_OFF));
    for (int it = F.gw; it < DECB * 37; it += F.NGW) p2_sample_item(P, it, F.lane);
}
#define MFMA32(a, b, c) __builtin_amdgcn_mfma_f32_32x32x16_bf16(a, b, c, 0, 0, 0)
constexpr int P3_IMP = 0, P3_QL = 32768;
constexpr int P3_NEXT = LDSCTL_OFF + 512, P3_CNT = LDSCTL_OFF + 1024, P3_LISTS = LDSCTL_OFF + 2048, P3_LACC = LDSCTL_OFF + 10240;
constexpr int P3_RING = 65536;
constexpr int P3_MISC = MISC_OFF + 64;
constexpr int SM_Q = 36864, SM_P = 40960, SM_RED = 57344, SM_IMP = 66048, SM_L = 67200, SM_SEL = 67328, SM_O = 67584, SM_VP = 71680  , SM_RED2 = 79872  ;

template <bool MASK>
__device__ __forceinline__ void attend_lds(const LAS unsigned char* blk, const bf16x8 (&qf)[4], f32x16 (&O)[2], float& lsum,
                                           int kbase, int lo, int hi, int lane, bool want_pv, f32x16 (*Sout)[2] = nullptr) {
    const int hh = lane >> 5;
    const LAS unsigned char* kb = blk + lane * 16; const LAS unsigned char* vb = blk + 8192 + lane * 16;
#pragma unroll
    for (int kt = 0; kt < 2; ++kt) {
        f32x16 S;
        { bf16x8 kf[4];
#pragma unroll
          for (int s = 0; s < 4; ++s) kf[s] = *(const LAS bf16x8*)(kb + (kt * 4 + s) * 1024);
#pragma unroll
          for (int i = 0; i < 16; ++i) S[i] = 0.f;
#pragma unroll
          for (int s = 0; s < 4; ++s) S = MFMA32(kf[s], qf[s], S); }
#pragma unroll
        for (int i = 0; i < 16; ++i) { float p = fast_exp2(S[i]);
            if (MASK) { const int kp = kbase + 32 * kt + (i & 3) + 8 * (i >> 2) + 4 * hh; p = (kp >= lo && kp <= hi) ? p : 0.f; }
            S[i] = p; lsum += p; }
        if (Sout) (*Sout)[kt] = S;
        if (want_pv) {
            bf16x8 pf[2];
#pragma unroll
            for (int sp = 0; sp < 2; ++sp) { v4u w; w.x = pk2(S[8 * sp + 0], S[8 * sp + 1]); w.y = pk2(S[8 * sp + 2], S[8 * sp + 3]);
                w.z = pk2(S[8 * sp + 4], S[8 * sp + 5]); w.w = pk2(S[8 * sp + 6], S[8 * sp + 7]); pf[sp] = __builtin_bit_cast(bf16x8, w); }
#pragma unroll
            for (int dt = 0; dt < 2; ++dt)
#pragma unroll
                for (int sp = 0; sp < 2; ++sp) { const bf16x8 vf = *(const LAS bf16x8*)(vb + (dt * 4 + 2 * kt + sp) * 1024);
                    O[dt] = MFMA32(vf, pf[sp], O[dt]); }
        }
    }
}
__device__ __forceinline__ void wave_topk(const LAS float* imp, int jmax, int nsel, int lane, int qbase, LAS unsigned* cnt, LAS unsigned char* lists) {
    if (jmax < 1) return;
    const bool c0 = lane >= 1 && lane <= jmax, c1 = 64 + lane <= jmax;
    unsigned k0[8], k1[8], Tv[8];
#pragma unroll
    for (int qi = 0; qi < 8; ++qi) { k0[qi] = c0 ? ((__builtin_bit_cast(unsigned, imp[qi * 128 + lane]) + 0x800u) & ~0x7ffu) : 0u; k1[qi] = c1 ? ((__builtin_bit_cast(unsigned, imp[qi * 128 + 64 + lane]) + 0x800u) & ~0x7ffu) : 0u; Tv[qi] = 0u; }
    if (jmax > nsel) {
        for (int bit = 30; bit >= 11; --bit) {
#pragma unroll
            for (int qi = 0; qi < 8; ++qi) { const unsigned cand = Tv[qi] | (1u << bit);
                const int cn = __popcll(__ballot(k0[qi] >= cand)) + __popcll(__ballot(k1[qi] >= cand)); Tv[qi] = cn >= nsel ? cand : Tv[qi]; } }
    }
    const unsigned long long below = (lane == 0) ? 0ull : (~0ull >> (64 - lane));
#pragma unroll
    for (int qi = 0; qi < 8; ++qi) {
        bool s0, s1;
        if (jmax > nsel) {
            const unsigned long long g0 = __ballot(k0[qi] > Tv[qi]), g1 = __ballot(k1[qi] > Tv[qi]), e0 = __ballot(k0[qi] == Tv[qi]), e1 = __ballot(k1[qi] == Tv[qi]);
            const int need = nsel - __popcll(g0) - __popcll(g1);
            const int rk0 = __popcll(e0 & below), rk1 = __popcll(e0) + __popcll(e1 & below);
            s0 = k0[qi] > Tv[qi] || (k0[qi] == Tv[qi] && rk0 < need); s1 = k1[qi] > Tv[qi] || (k1[qi] == Tv[qi] && rk1 < need);
        } else { s0 = c0; s1 = c1; }
        if (s0) { const unsigned pos = __hip_atomic_fetch_add(cnt + lane, 1u, __ATOMIC_RELAXED, __HIP_MEMORY_SCOPE_WORKGROUP); lists[lane * 64 + pos] = (unsigned char)(qbase + qi); }
        if (s1) { const unsigned pos = __hip_atomic_fetch_add(cnt + 64 + lane, 1u, __ATOMIC_RELAXED, __HIP_MEMORY_SCOPE_WORKGROUP); lists[(64 + lane) * 64 + pos] = (unsigned char)(qbase + qi); }
    }
}
struct BlkSrc { const bf16* img; };
#ifndef PROBE_SEG
#define PROBE_SEG 0
#endif
#define T_BEGIN(id) do { if (PROBE_SEG == (id)) tacc -= __builtin_readcyclecounter(); } while (0)
#define T_END(id) do { if (PROBE_SEG == (id)) tacc += __builtin_readcyclecounter(); } while (0)
__device__ __forceinline__ void p3_prompt_unit(const Ptrs& P, Frame& F, int b, int t, int g, float sh_cmp, float sh_slc, float sh_win, unsigned long long& tacc) {
    int lane = F.lane, w = F.wave, tid = F.tid; asm volatile("" : "+v"(lane), "+s"(w), "+v"(tid));
    const int col = lane & 31, hh = lane >> 5, qi = col >> 2, h = col & 3;
    const int tok = 64 * t + 8 * w + qi; const size_t row = (size_t)b * T + tok; const int qpos = tok;
    const int nck = (2 * t + 2 + 63) >> 6, nf = t >= 2 ? 3 : t + 1, nw = t >= 8 ? 9 : t + 1;
    const int n1 = nck, n2 = 2 * nck, N1 = n2 + nf;
    const bf16* KC = (const bf16*)(P.ws + WS_KC) + (size_t)(b * 2 + g) * 4 * 8192;
    const bf16* KS = (const bf16*)(P.ws + WS_KS) + (size_t)(b * 2 + g) * 128 * 8192;
    const bf16* KW = (const bf16*)(P.ws + WS_KW) + (size_t)(b * 2 + g) * 128 * 8192;
    auto src1 = [&](int n) -> BlkSrc {
        if (n < n2) { const int ck = n < n1 ? n : n - n1; return BlkSrc{KC + (size_t)ck * 8192}; }
        const int f = n - n2; const int j = f == 0 ? t : (f == 1 ? 0 : t - 1); return BlkSrc{KS + (size_t)j * 8192}; };
    auto src2 = [&](int n) -> BlkSrc { const int j = (t >= 8 ? t - 8 : 0) + n; return BlkSrc{KW + (size_t)j * 8192}; };
    LAS unsigned char* ring = F.lds + P3_RING;
#define ST_DMA(bs_, n) do { LAS unsigned char* d_ = ring + ((n) & 3) * 16384 + w * 2048; \
        __builtin_amdgcn_global_load_lds((const unsigned*)((bs_).img + (2 * w) * 512 + lane * 8), (LAS unsigned*)d_, 16, 0, 0); \
        __builtin_amdgcn_global_load_lds((const unsigned*)((bs_).img + (2 * w + 1) * 512 + lane * 8), (LAS unsigned*)(d_ + 1024), 16, 0, 0); } while (0)
#define BLK(n) (ring + ((n) & 3) * 16384)
#define STEP_BEGIN(SRC, n, NN) do { if (((n) & 1) == 0) { if ((n) + 2 < (NN)) { const BlkSrc b_ = SRC((n) + 2); ST_DMA(b_, (n) + 2); } if ((n) + 3 < (NN)) { const BlkSrc b_ = SRC((n) + 3); ST_DMA(b_, (n) + 3); } } } while (0)
#define STEP_END(n, NN) do { if (((n) & 1) == 1 || (n) == (NN) - 1) { asm volatile("s_waitcnt vmcnt(0)" ::: "memory"); __syncthreads(); } } while (0)
    LAS unsigned* cnt = (LAS unsigned*)(F.lds + P3_CNT); LAS unsigned char* lists = F.lds + P3_LISTS; LAS unsigned* nextb = (LAS unsigned*)(F.lds + P3_NEXT);
    LAS int* oacc = (LAS int*)ring; LAS int* lacc = (LAS int*)(F.lds + P3_LACC);
    const float FXS = slc_vscale(sh_slc), FXI = 1.0f / FXS;
    LAS unsigned char* ql = F.lds + P3_QL;
    T_BEGIN(1); T_BEGIN(8);
    __syncthreads();
    if (tid < 128) cnt[tid] = 0u; if (tid == 128) nextb[0] = 0u;
    { const BlkSrc b0 = src1(0); ST_DMA(b0, 0); if (N1 > 1) { const BlkSrc b1 = src1(1); ST_DMA(b1, 1); } }
    { const bf16* qg = (const bf16*)(P.ws + WS_Q) + ((size_t)b * T + 64 * t) * 512 + g * 256;
      v4u tq[4];
#pragma unroll
      for (int k = 0; k < 4; ++k) { const int c = tid + 512 * k, rq = c >> 3, ch = c & 7; tq[k] = *(const GAS v4u*)(qg + (size_t)(rq >> 2) * 512 + (rq & 3) * 64 + ch * 8); }
#pragma unroll
      for (int k = 0; k < 4; ++k) { const int c = tid + 512 * k, rq = c >> 3, ch = c & 7; *(LAS v4u*)(ql + rq * 128 + ((ch ^ ((rq >> 1) & 7)) << 4)) = tq[k]; } }
    bf16x8 qf[4];
    { const bf16* q = (const bf16*)(P.ws + WS_Q) + row * 512 + (g * 4 + h) * 64 + 8 * hh;
#pragma unroll
      for (int s = 0; s < 4; ++s) qf[s] = __builtin_bit_cast(bf16x8, *(const GAS v4u*)(q + 16 * s)); }
    const float* gate = (const float*)(P.ws + WS_GATE) + row * 24 + (g * 4 + h) * 3;
    const float g_cmp = gate[0], g_slc = gate[1], g_win = gate[2];
    asm volatile("s_waitcnt vmcnt(0)" ::: "memory"); __syncthreads();
    T_END(1); T_BEGIN(2);
    f32x16 O[2];
    LAS float* wl = (LAS float*)(F.lds + P3_IMP + w * 4096);
    LAS float* xw0 = (LAS float*)(F.lds + P3_IMP + w * 4096) + lane;
    f32x16 totr;
    const int nvis = (qpos + 1) >> 5;
    int n = 0;
    float lsum = 0.f;
    for (; n < n1; ++n) { STEP_BEGIN(src1, n, N1); attend_lds<true>(BLK(n), qf, O, lsum, 64 * n, 0, nvis - 1, lane, false); STEP_END(n, N1); }
    lsum += __shfl_xor(lsum, 32);
    const float rl = lsum > 0.f ? 1.0f / lsum : 0.f;
    for (int i = lane; i < 1024; i += 64) wl[i] = 0.f;
#pragma unroll
    for (int i = 0; i < 16; ++i) { O[0][i] = 0.f; O[1][i] = 0.f; }
    { float dummy = 0.f;
      for (; n < n2; ++n) { STEP_BEGIN(src1, n, N1); const int ck = n - n1; f32x16 Sn[2];
        attend_lds<true>(BLK(n), qf, O, dummy, 64 * ck, 0, nvis - 1, lane, true, &Sn);
#pragma unroll
        for (int kt = 0; kt < 2; ++kt)
#pragma unroll
            for (int i2 = 0; i2 < 8; ++i2) { const float v = quad_sum((Sn[kt][2 * i2] + Sn[kt][2 * i2 + 1]) * rl);
                if (h == 0) wl[qi * 128 + 32 * ck + 16 * kt + (i2 & 1) + 4 * (i2 >> 1) + 2 * hh] = v; }
        STEP_END(n, N1); } }
    LDS_WAIT(); asm volatile("" ::: "memory");
    T_END(2); T_BEGIN(3);
    wave_topk(wl, t - 2, 13, lane, 8 * w, cnt, lists);
    LDS_WAIT(); asm volatile("" ::: "memory");
#pragma unroll
    for (int i = 0; i < 16; ++i) { xw0[i * 64] = O[0][i] * (g_cmp * rl); totr[i] = O[1][i] * (g_cmp * rl); O[0][i] = 0.f; O[1][i] = 0.f; }
    T_END(3); T_BEGIN(4);
    lsum = 0.f;
    for (; n < N1; ++n) { STEP_BEGIN(src1, n, N1);
        if (n == n2) attend_lds<true>(BLK(n), qf, O, lsum, 64 * t, 0, qpos, lane, true);
        else attend_lds<false>(BLK(n), qf, O, lsum, 0, 0, 0, lane, true);
        STEP_END(n, N1); }
    lsum += __shfl_xor(lsum, 32);
#pragma unroll
    for (int dt = 0; dt < 2; ++dt)
#pragma unroll
        for (int i = 0; i < 16; ++i) oacc[(32 * dt + (i & 3) + 8 * (i >> 2) + 4 * hh) * 256 + 32 * w + col] = (int)O[dt][i];
    if (hh == 0) lacc[32 * w + col] = __float2int_rn(lsum * FXS);
    __syncthreads();
    T_END(4); T_BEGIN(5);
    if (t > 2) {
        const int r = lane & 31;
#define NEXT_BLOCK(jv_, nq_) do { for (;;) { unsigned t_ = 0u; if (lane == 0) t_ = __hip_atomic_fetch_add(nextb, 1u, __ATOMIC_RELAXED, __HIP_MEMORY_SCOPE_WORKGROUP); \
            jv_ = 1 + (int)__builtin_amdgcn_readfirstlane(t_); if (jv_ > t - 2) { nq_ = 0; break; } nq_ = (int)__builtin_amdgcn_readfirstlane(cnt[jv_]); if (nq_ > 0) break; } } while (0)
#define LOAD_FRAGS(kd_, vd_, jv_) do { const bf16* im_ = KS + (size_t)(jv_) * 8192 + lane * 8;     \
            _Pragma("unroll") for (int a_ = 0; a_ < 2; ++a_) _Pragma("unroll") for (int b_ = 0; b_ < 4; ++b_) { kd_[a_][b_] = __builtin_bit_cast(bf16x8, *(const GAS v4u*)(im_ + (a_ * 4 + b_) * 512)); \
                vd_[a_][b_] = __builtin_bit_cast(bf16x8, *(const GAS v4u*)(im_ + 4096 + (a_ * 4 + b_) * 512)); } } while (0)
        bf16x8 kf[2][4], vf[2][4];
        for (;;) {
            T_BEGIN(10); int j, nq; NEXT_BLOCK(j, nq);
            if (j > t - 2) { T_END(10); break; }
            LOAD_FRAGS(kf, vf, j);
#pragma unroll
            for (int a_ = 0; a_ < 2; ++a_)
#pragma unroll
                for (int b_ = 0; b_ < 4; ++b_) asm volatile("" : "+v"(kf[a_][b_]), "+v"(vf[a_][b_])); T_END(10);
            for (int c0 = 0; c0 < nq; c0 += 8) { T_BEGIN(11);
                const int sl = c0 + qi; const bool valid = sl < nq;
                const int rowq = (int)lists[j * 64 + (valid ? sl : nq - 1)] * 4 + h;
                const LAS unsigned char* qp = ql + rowq * 128; const int qsw = (rowq >> 1) & 7;
                bf16x8 q2[4];
#pragma unroll
                for (int s = 0; s < 4; ++s) q2[s] = *(const LAS bf16x8*)(qp + (((2 * s + hh) ^ qsw) << 4));
                float l2 = 0.f; bf16x8 pf[4]; f32x16 S0, S1;
#pragma unroll
                for (int i = 0; i < 16; ++i) { S0[i] = 0.f; S1[i] = 0.f; }
#pragma unroll
                for (int s = 0; s < 4; ++s) { S0 = MFMA32(kf[0][s], q2[s], S0); S1 = MFMA32(kf[1][s], q2[s], S1); }
#pragma unroll
                for (int i = 0; i < 16; ++i) { S0[i] = fast_exp2(S0[i]); l2 += S0[i]; }
#pragma unroll
                for (int sp = 0; sp < 2; ++sp) { v4u wv; wv.x = pk2(S0[8 * sp + 0], S0[8 * sp + 1]); wv.y = pk2(S0[8 * sp + 2], S0[8 * sp + 3]);
                    wv.z = pk2(S0[8 * sp + 4], S0[8 * sp + 5]); wv.w = pk2(S0[8 * sp + 6], S0[8 * sp + 7]); pf[sp] = __builtin_bit_cast(bf16x8, wv); }
#pragma unroll
                for (int i = 0; i < 16; ++i) { S1[i] = fast_exp2(S1[i]); l2 += S1[i]; }
#pragma unroll
                for (int sp = 0; sp < 2; ++sp) { v4u wv; wv.x = pk2(S1[8 * sp + 0], S1[8 * sp + 1]); wv.y = pk2(S1[8 * sp + 2], S1[8 * sp + 3]);
                    wv.z = pk2(S1[8 * sp + 4], S1[8 * sp + 5]); wv.w = pk2(S1[8 * sp + 6], S1[8 * sp + 7]); pf[2 + sp] = __builtin_bit_cast(bf16x8, wv); }
                T_END(11); T_BEGIN(9);
#pragma unroll
                for (int dt = 0; dt < 2; ++dt) { f32x16 O2;
#pragma unroll
                    for (int i = 0; i < 16; ++i) O2[i] = 0.f;
#pragma unroll
                    for (int ks = 0; ks < 4; ++ks) O2 = MFMA32(vf[dt][ks], pf[ks], O2);
                    if (valid) {
#pragma unroll
                        for (int i = 0; i < 16; ++i) (void)__hip_atomic_fetch_add(oacc + (32 * dt + (i & 3) + 8 * (i >> 2) + 4 * hh) * 256 + rowq, (int)O2[i], __ATOMIC_RELAXED, __HIP_MEMORY_SCOPE_WORKGROUP); } }
                if (valid) {
                    (void)__hip_atomic_fetch_add(lacc + rowq, __float2int_rn(l2 * FXS), __ATOMIC_RELAXED, __HIP_MEMORY_SCOPE_WORKGROUP); }
                if (PROBE_SEG == 9) LDS_WAIT(); T_END(9);
            }
        }
#undef NEXT_BLOCK
#undef LOAD_FRAGS
    }
    __syncthreads();
    T_END(5); T_BEGIN(6);
    LAS float* x0 = (LAS float*)(F.lds + P3_IMP + w * 4096) + lane; LAS float* x1 = (LAS float*)(F.lds + P3_QL + w * 4096) + lane;
    { const float sc = g_slc / fmaxf((float)lacc[32 * w + col] * FXI, 1e-30f);
#pragma unroll
      for (int i = 0; i < 16; ++i) { const int dr = (i & 3) + 8 * (i >> 2) + 4 * hh;
          x0[i * 64] = x0[i * 64] + (float)oacc[dr * 256 + 32 * w + col] * (FXI * sc); x1[i * 64] = totr[i] + (float)oacc[(32 + dr) * 256 + 32 * w + col] * (FXI * sc); O[0][i] = 0.f; O[1][i] = 0.f; } }
    LDS_WAIT(); __syncthreads();
    { const BlkSrc b0 = src2(0); ST_DMA(b0, 0); if (nw > 1) { const BlkSrc b1 = src2(1); ST_DMA(b1, 1); } }
    { asm volatile("" : "+v"(lane));
      const bf16* q = (const bf16*)(P.ws + WS_Q) + row * 512 + (g * 4 + h) * 64 + 8 * hh;
#pragma unroll
      for (int s = 0; s < 4; ++s) qf[s] = __builtin_bit_cast(bf16x8, *(const GAS v4u*)(q + 16 * s)); }
    asm volatile("s_waitcnt vmcnt(0)" ::: "memory"); __syncthreads();
    lsum = 0.f;
    for (n = 0; n < nw; ++n) { STEP_BEGIN(src2, n, nw); const int j = (t >= 8 ? t - 8 : 0) + n;
        if (j == t || j + 8 == t) attend_lds<true>(BLK(n), qf, O, lsum, 64 * j, qpos - 511, qpos, lane, true);
        else attend_lds<false>(BLK(n), qf, O, lsum, 0, 0, 0, lane, true);
        STEP_END(n, nw); }
    lsum += __shfl_xor(lsum, 32);
    { const float sc = g_win / fmaxf(lsum, 1e-30f);
#pragma unroll
      for (int i = 0; i < 16; ++i) { O[0][i] = x0[i * 64] + O[0][i] * sc; O[1][i] = x1[i * 64] + O[1][i] * sc; } }
#undef ST_DMA
#undef BLK
#undef STEP_BEGIN
#undef STEP_END
    T_END(6); T_BEGIN(7);
    asm volatile("" : "+v"(lane));
    const int col_ = lane & 31, hh_ = lane >> 5, h_ = col_ & 3; const size_t row_ = (size_t)b * T + 64 * t + 8 * w + (col_ >> 2);
    const bf16* za = (const bf16*)(P.ws + WS_ZA) + row_ * 512 + (g * 4 + h_) * 64; bf16* mx = (bf16*)(P.ws + WS_MIX) + row_ * 1024 + 512 + (g * 4 + h_) * 64;
#pragma unroll
    for (int dt = 0; dt < 2; ++dt)
#pragma unroll
        for (int i4 = 0; i4 < 4; ++i4) { const int d = 32 * dt + 8 * i4 + 4 * hh_; const v2u z = *(const GAS v2u*)(za + d);
            v2u o; o.x = pk2(O[dt][4 * i4] * bf2f(z.x & 0xffffu), O[dt][4 * i4 + 1] * bf2f(z.x >> 16)); o.y = pk2(O[dt][4 * i4 + 2] * bf2f(z.y & 0xffffu), O[dt][4 * i4 + 3] * bf2f(z.y >> 16));
            *(GAS v2u*)(mx + d) = o; }
    if (g == 0) { const int tq = w, c8 = lane * 8; const size_t r0 = (size_t)b * T + 64 * t + 8 * tq;
        const bf16* U = (const bf16*)(P.ws + WS_U) + c8; const bf16* CGp = (const bf16*)(P.ws + WS_CG) + c8; bf16* mo = (bf16*)(P.ws + WS_MIX) + c8;
        v4u ur[10], cr[8];
        const bool has_prev = (t > 0) || (tq > 0);
#pragma unroll
        for (int i = 0; i < 10; ++i) ur[i] = (i >= 2 || has_prev) ? *(const GAS v4u*)(U + (r0 + i - 2) * 512) : (v4u){0u, 0u, 0u, 0u};
#pragma unroll
        for (int i = 0; i < 8; ++i) cr[i] = *(const GAS v4u*)(CGp + (r0 + i) * 512);
        float w0[8], w1[8], w2[8], cb[8];
#pragma unroll
        for (int e = 0; e < 8; ++e) { w0[e] = P.conv_w[c8 + e]; w1[e] = P.conv_w[512 + c8 + e]; w2[e] = P.conv_w[1024 + c8 + e]; cb[e] = P.conv_b[c8 + e]; }
#pragma unroll
        for (int i = 0; i < 8; ++i) { float o[8];
#pragma unroll
            for (int e = 0; e < 8; ++e) { const int sh_ = (e & 1) * 16; const float a = bf2f((ur[i][e >> 1] >> sh_) & 0xffffu), bb = bf2f((ur[i + 1][e >> 1] >> sh_) & 0xffffu), c = bf2f((ur[i + 2][e >> 1] >> sh_) & 0xffffu);
                o[e] = bf2f((cr[i][e >> 1] >> sh_) & 0xffffu) * (w0[e] * a + w1[e] * bb + w2[e] * c + cb[e]); }
            v4u ov; ov.x = pk2(o[0], o[1]); ov.y = pk2(o[2], o[3]); ov.z = pk2(o[4], o[5]); ov.w = pk2(o[6], o[7]);
            *(GAS v4u*)(mo + (r0 + i) * 1024) = ov; } }
    T_END(7); T_END(8);
}
template <class KeyFn>
__device__ __forceinline__ void sample_branch(Frame& F, int nslots, float shift, const KeyFn& key, LAS float* obr) {
    LAS float* q = (LAS float*)(F.lds + SM_Q); LAS float* Pb = (LAS float*)(F.lds + SM_P); LAS float* red = (LAS float*)(F.lds + SM_RED); LAS float* lsm = (LAS float*)(F.lds + SM_L);
    LAS unsigned long long* vptr = (LAS unsigned long long*)(F.lds + SM_VP);
    float lacc[4] = {0.f, 0.f, 0.f, 0.f};
    for (int s = F.tid; s < nslots; s += 512) { const float* kp; const float* vp; const bool valid = key(s, kp, vp);
        float sc[4] = {0.f, 0.f, 0.f, 0.f};
        if (valid) {
#pragma unroll 8
            for (int d4 = 0; d4 < 16; ++d4) { const f32x4 kv = *(const GAS f32x4*)(kp + 4 * d4);
#pragma unroll
                for (int hq = 0; hq < 4; ++hq) { const f32x4 qv = *(const LAS f32x4*)(q + hq * 64 + 4 * d4); sc[hq] += (kv.x * qv.x + kv.y * qv.y) + (kv.z * qv.z + kv.w * qv.w); } } }
        f32x4 p;
#pragma unroll
        for (int hq = 0; hq < 4; ++hq) { p[hq] = valid ? fast_exp2(sc[hq] - shift) : 0.f; lacc[hq] += p[hq]; }
        *(LAS f32x4*)(Pb + 4 * s) = p; vptr[s] = (unsigned long long)(uintptr_t)vp; }
#pragma unroll
    for (int hq = 0; hq < 4; ++hq) { lacc[hq] = wave_sum(lacc[hq]); if (F.lane == 0) red[F.wave * 4 + hq] = lacc[hq]; }
    __syncthreads();
    if (F.tid < 4) { float s = 0.f; for (int ww = 0; ww < 8; ++ww) s += red[ww * 4 + F.tid]; lsm[F.tid] = s; }
    const int sg = F.tid >> 4, d4 = F.tid & 15;
    f32x4 oa[4];
#pragma unroll
    for (int hq = 0; hq < 4; ++hq) oa[hq] = (f32x4){0.f, 0.f, 0.f, 0.f};
    for (int s0 = sg; s0 < nslots; s0 += 256) {
        f32x4 vv[8], pp[8];
#pragma unroll
        for (int u = 0; u < 8; ++u) { const int s = s0 + 32 * u; const float* vp = (const float*)(uintptr_t)vptr[s]; vv[u] = *(const GAS f32x4*)(vp + 4 * d4); pp[u] = *(const LAS f32x4*)(Pb + 4 * s); }
#pragma unroll
        for (int u = 0; u < 8; ++u) { oa[0] = oa[0] + vv[u] * pp[u].x; oa[1] = oa[1] + vv[u] * pp[u].y; oa[2] = oa[2] + vv[u] * pp[u].z; oa[3] = oa[3] + vv[u] * pp[u].w; } }
    __syncthreads();
    LAS float* red2 = (LAS float*)(F.lds + SM_RED2);
#pragma unroll
    for (int hq = 0; hq < 4; ++hq) *(LAS f32x4*)(red2 + (sg * 4 + hq) * 64 + 4 * d4) = oa[hq];
    __syncthreads();
    if (F.tid < 256) { float s = 0.f;
#pragma unroll 8
        for (int g2 = 0; g2 < 32; ++g2) s += red2[g2 * 256 + F.tid]; obr[F.tid] = s; }
    __syncthreads();
}
__device__ __forceinline__ void p3_sample_unit(const Ptrs& P, Frame& F, int b, int g) {
    asm volatile("" : "+v"(F.tid), "+v"(F.lane), "+s"(F.wave));
    LAS float* q = (LAS float*)(F.lds + SM_Q); LAS float* Pb = (LAS float*)(F.lds + SM_P); LAS float* imp = (LAS float*)(F.lds + SM_IMP); LAS float* lsm = (LAS float*)(F.lds + SM_L);
    LAS int* sel = (LAS int*)(F.lds + SM_SEL); LAS float* osm = (LAS float*)(F.lds + SM_O);
    const float* cst = (const float*)(P.ws + WS_CONST);
    float kcmax = 0.f; for (int e_ = 0; e_ < 4; ++e_) kcmax += __builtin_bit_cast(float, __hip_atomic_load((unsigned*)(P.ws + WS_CTL) + CW_KCMAX + 64 + e_, RLX_AGENT));
    const float sh_cmp = cst[0] * sqrtf(kcmax) * LOG2E * 1.001f, sh_slc = cst[1], sh_win = cst[2];
    if (F.tid < 256) q[F.tid] = ((const float*)(P.ws + WS_QS))[(size_t)b * 512 + g * 256 + F.tid];
    __syncthreads();
    const float* kcs = (const float*)(P.ws + WS_KCS) + (size_t)(b * 2 + g) * 2 * NCS * 64;
    sample_branch(F, NCS, sh_cmp, [&](int s, const float*& kp, const float*& vp) { kp = kcs + (size_t)s * 64; vp = kcs + (size_t)(NCS + s) * 64; return true; }, osm);
    { const f32x4 p = *(const LAS f32x4*)(Pb + 4 * F.tid); float v = p.x / lsm[0] + p.y / lsm[1] + p.z / lsm[2] + p.w / lsm[3]; v += __shfl_xor(v, 1);
      if ((F.tid & 1) == 0) imp[F.tid >> 1] = v; if (F.tid < 4) imp[256 + F.tid] = 0.f; }
    if (F.tid < 256) osm[F.tid] = osm[F.tid] / lsm[F.tid >> 6];
    __syncthreads();
    if (F.wave == 0) { const int lane = F.lane; unsigned k[4];
#pragma unroll
        for (int i = 0; i < 4; ++i) { const int j = lane + 64 * i; k[i] = (j >= 1 && j <= 254) ? __builtin_bit_cast(unsigned, imp[j]) + 1u : 0u; }
        unsigned Tv = 0u;
        for (int bit = 30; bit >= 0; --bit) { const unsigned cand = Tv | (1u << bit); int cnt = 0;
#pragma unroll
            for (int i = 0; i < 4; ++i) cnt += __popcll(__ballot(k[i] >= cand));
            if (cnt >= 13) Tv = cand; }
        int ngt = 0;
#pragma unroll
        for (int i = 0; i < 4; ++i) ngt += __popcll(__ballot(k[i] > Tv));
        const int need = 13 - ngt; const unsigned long long below = (lane == 0) ? 0ull : (~0ull >> (64 - lane));
        int base = 3, eqbase = 0;
        if (lane == 0) { int z_ = 0; asm volatile("" : "+v"(z_)); sel[0] = z_; sel[1] = z_ + 255; sel[2] = z_ + 256; }
#pragma unroll
        for (int i = 0; i < 4; ++i) { const unsigned long long e = __ballot(k[i] == Tv); const int rk = eqbase + __popcll(e & below); const bool on = k[i] > Tv || (k[i] == Tv && rk < need);
            const unsigned long long m = __ballot(on); if (on) sel[base + __popcll(m & below)] = lane + 64 * i; base += __popcll(m); eqbase += __popcll(e); } }
    __syncthreads();
    const float* kvn = (const float*)(P.ws + WS_KVN) + (size_t)b * 768;
    const int* pt = P.page_table + b * NPAGES; const float* cs = P.cache_slc;
    sample_branch(F, 1024, sh_slc, [&](int s, const float*& kp, const float*& vp) { const int j = sel[s >> 6], rr = s & 63;
        if (j == 256) { kp = kvn + (1 * 2 + 0) * 128 + g * 64; vp = kvn + (1 * 2 + 1) * 128 + g * 64; return rr == 0; }
        const float* rowp = cs + ((size_t)pt[j >> 1] * 128 + (j & 1) * 64 + rr) * 256 + g * 64; kp = rowp; vp = rowp + 128; return true; }, osm + 256);
    if (F.tid < 256) osm[256 + F.tid] = osm[256 + F.tid] / lsm[F.tid >> 6];
    __syncthreads();
    const float* stw = P.st_win + (size_t)b * 512 * 256;
    sample_branch(F, 512, sh_win, [&](int s, const float*& kp, const float*& vp) {
        if (s == 511) { kp = kvn + (2 * 2 + 0) * 128 + g * 64; vp = kvn + (2 * 2 + 1) * 128 + g * 64; return true; }
        const float* rowp = stw + (size_t)(s + 1) * 256 + g * 64; kp = rowp; vp = rowp + 128; return true; }, osm + 512);
    if (F.tid < 256) { const int hq = F.tid >> 6, d = F.tid & 63; const float* gs = (const float*)(P.ws + WS_GS) + b * 24 + (g * 4 + hq) * 3;
        const float o = gs[0] * osm[F.tid] + gs[1] * osm[256 + F.tid] + gs[2] * osm[512 + F.tid] / lsm[hq];
        ((bf16*)(P.ws + WS_MIXS))[(size_t)b * 1024 + 512 + (g * 4 + hq) * 64 + d] = (bf16)f2bf(o * ((const float*)(P.ws + WS_ZAS))[(size_t)b * 512 + (g * 4 + hq) * 64 + d]); }
    __syncthreads();
}
__device__ __forceinline__ void p3_phase(const Ptrs& P, Frame& F, int rep) {
    const float* cst = (const float*)(P.ws + WS_CONST);
    float kcmax = 0.f; for (int e_ = 0; e_ < 4; ++e_) kcmax += __builtin_bit_cast(float, __hip_atomic_load((unsigned*)(P.ws + WS_CTL) + CW_KCMAX + e_, RLX_AGENT));
    const float sh_cmp = cst[0] * sqrtf(kcmax) * LOG2E * 1.001f, sh_slc = cst[1], sh_win = cst[2];
    unsigned long long tacc = 0ull;
    volatile LAS int* qw = (volatile LAS int*)(F.lds + P3_MISC);
#ifndef PROBE_P3
#define PROBE_P3 0
#endif
    constexpr int NS_ = PROBE_P3 == 1 ? 16 : 8, PSH_ = PROBE_P3 == 2 ? 1 : 0;
    constexpr int NQ = NS_ + (128 << PSH_);
    const int x0 = (int)(xb_xcc_id() & 7u);
    for (int xi = 0; xi < 8; ++xi) {
        const int x = (x0 + xi) & 7;
        for (;;) {
            __syncthreads();
            if (F.tid == 0) qw[0] = (int)__hip_atomic_fetch_add((unsigned*)(F.ctl + CW_QUEUE + 64 * (x + 8 * rep)), 1u, RLX_AGENT);
            __syncthreads();
            const int idx = qw[0];
            if (idx >= NQ) break;
            if (idx < NS_) p3_sample_unit(P, F, x * 4 + ((idx & 7) >> 1), idx & 1);
            else p3_prompt_unit(P, F, x >> 1, 127 - ((idx - NS_) >> PSH_), x & 1, sh_cmp, sh_slc, sh_win, tacc);
        }
    }
    if (PROBE_SEG != 0 && blockIdx.x == 0) { const unsigned long long t0_ = __builtin_readcyclecounter(); while (__builtin_readcyclecounter() - t0_ < tacc) __builtin_amdgcn_s_sleep(8); }
}
#ifndef MK_N_LAUNCHES
#define MK_N_LAUNCHES 1
#endif
constexpr int N_PHASES = 5;
constexpr int N_LAUNCHES = MK_N_LAUNCHES;
struct Args { Ptrs p; int ph_lo, ph_hi, rep, mode; };
__global__ void __launch_bounds__(NWAVES * 64, 2) nsa_fwd(Args args) {
    extern __shared__ __attribute__((aligned(16))) unsigned char lds[];
    const Ptrs& P = args.p;
    Frame F;
    F.lds = (LAS unsigned char*)lds;
    F.MISC = (volatile LAS unsigned*)(F.lds + MISC_OFF);
    F.tid = threadIdx.x; F.lane = F.tid & 63; F.wave = __builtin_amdgcn_readfirstlane(F.tid >> 6);
    F.G = gridDim.x; F.gw = blockIdx.x * NWAVES + F.wave; F.NGW = F.G * NWAVES;
    F.ctl = (gu32*)(P.ws + WS_CTL);
    for (int u = F.tid; u < (LDS_BYTES - LDSCTL_OFF) / 4; u += NWAVES * 64) ((LAS unsigned*)(F.lds + LDSCTL_OFF))[u] = 0u;
    __syncthreads();
    XcdBarrier bar; bar.bar = (unsigned*)(F.ctl + CW_BAR); bar.x = 0; bar.st = nullptr;
    if (N_LAUNCHES == 1) bar = xcd_barrier_post((unsigned*)(F.ctl + CW_BAR), F.MISC + 8);
    const int lo = args.ph_lo, hi = args.ph_hi;
    unsigned long long tprobe = 0ull;
#define IN(k) (lo <= (k) && (k) < hi)
#define FENCE() do { asm volatile("" : "+s"(F.wave), "+s"(F.gw)); F.lane = (int)__builtin_amdgcn_mbcnt_hi(~0u, __builtin_amdgcn_mbcnt_lo(~0u, 0u)); F.tid = F.wave * 64 + F.lane; asm volatile("" : "+v"(F.tid), "+v"(F.lane)); } while (0)
#define SEAM(k) do { if (IN(k) && IN((k) + 1)) xcd_barrier(bar, F.wave == 0 && (int)__builtin_amdgcn_mbcnt_hi(~0u, __builtin_amdgcn_mbcnt_lo(~0u, 0u)) == 0); } while (0)

    if (IN(0)) { FENCE(); p0_phase(P, F); } SEAM(0);
    if (IN(1)) { FENCE();
        pg8::Gemm g{(const pg8::bf16_t*)(P.ws + WS_XB), (const pg8::bf16_t*)(P.ws + WS_BT1), M, NP, D}; pg8::StaticOrder S; S.init(M, NP, F.G, (int)blockIdx.x);
        EpiIn E{(const float*)(P.ws + WS_RSTD), (const float*)(P.ws + WS_ROPE), P.q_gain, P.k_gain, P.out, P.ws};
        pg8::gemm_phase<EpiIn, pg8::StaticOrder, true, true>(F.lds + RING_OFF, g, S, E, F.wave, tprobe);
        FENCE();
        for (int ct = F.gw; ct < NP / 16; ct += F.NGW) small_gemm_tile<0>(P, (const bf16*)(P.ws + WS_XSB), (const bf16*)(P.ws + WS_BT1), ct, F.lane);
#if defined(PROBE_EPI)
        if (PROBE_EPI == 1 && blockIdx.x == 0) { const unsigned long long t0_ = __builtin_readcyclecounter(); while (__builtin_readcyclecounter() - t0_ < tprobe) __builtin_amdgcn_s_sleep(8); }
        tprobe = 0ull;
#endif
    } SEAM(1);
    if (IN(2)) { FENCE(); p2_phase(P, F); } SEAM(2);
    if (IN(3)) { FENCE(); p3_phase(P, F, args.rep); } SEAM(3);
    if (IN(4)) { FENCE();
        pg8::Gemm g{(const pg8::bf16_t*)(P.ws + WS_MIX), (const pg8::bf16_t*)(P.ws + WS_BT2), M, D, D}; pg8::StaticOrder S; S.init(M, D, F.G, (int)blockIdx.x);
        EpiOut E{P.xp, P.out + O_Y};
        pg8::gemm_phase<EpiOut, pg8::StaticOrder, true, true>(F.lds + RING_OFF, g, S, E, F.wave, tprobe);
        FENCE();
        for (int ct = F.gw; ct < D / 16; ct += F.NGW) small_gemm_tile<1>(P, (const bf16*)(P.ws + WS_MIXS), (const bf16*)(P.ws + WS_BT2), ct, F.lane);
#if defined(PROBE_EPI)
        if (PROBE_EPI == 2 && blockIdx.x == 0) { const unsigned long long t0_ = __builtin_readcyclecounter(); while (__builtin_readcyclecounter() - t0_ < tprobe) __builtin_amdgcn_s_sleep(8); }
#endif
    }
#undef IN
#undef SEAM
}

extern "C" void kernel_launch(void* const* d_in, const int* in_sizes, int n_in, void* d_out, int out_size, void* d_ws, size_t ws_size, hipStream_t stream) {
    static int grid = 0;
    if (grid == 0) {
        if (n_in != 16 || out_size != (int)O_END || ws_size < WS_END) { fprintf(stderr, "kernel_launch: unexpected shapes (n_in %d, out %d, ws %zu)\n", n_in, out_size, ws_size); grid = -1; return; }
        int dev = 0, cus = 0, per_cu = 0;
        if (hipGetDevice(&dev) != hipSuccess || hipDeviceGetAttribute(&cus, hipDeviceAttributeMultiprocessorCount, dev) != hipSuccess) { grid = -1; return; }
        if (hipFuncSetAttribute((const void*)nsa_fwd, hipFuncAttributeMaxDynamicSharedMemorySize, LDS_BYTES) != hipSuccess) { fprintf(stderr, "kernel_launch: hipFuncSetAttribute failed\n"); grid = -1; return; }
        if (hipOccupancyMaxActiveBlocksPerMultiprocessor(&per_cu, (const void*)nsa_fwd, NWAVES * 64, LDS_BYTES) != hipSuccess || per_cu < 1)
            fprintf(stderr, "kernel_launch: note: occupancy query reports %d workgroups per CU\n", per_cu);
        (void)hipGetLastError();
        grid = cus;
    }
    if (grid < 0) return;
    if (hipMemsetAsync((char*)d_ws + WS_CTL, 0, CTL_ZERO_BYTES, stream) != hipSuccess) return;
    Args a{}; a.mode = 3;
    a.p.xp = (const float*)d_in[0]; a.p.xs = (const float*)d_in[1]; a.p.cache_cmp = (const float*)d_in[2]; a.p.cache_slc = (const float*)d_in[3];
    a.p.st_win = (const float*)d_in[4]; a.p.st_conv = (const float*)d_in[5]; a.p.page_table = (const int*)d_in[6]; a.p.norm_g = (const float*)d_in[7];
    a.p.w_in = (const float*)d_in[8]; a.p.conv_w = (const float*)d_in[9]; a.p.conv_b = (const float*)d_in[10]; a.p.q_gain = (const float*)d_in[11];
    a.p.k_gain = (const float*)d_in[12]; a.p.cmp_pe = (const float*)d_in[13]; a.p.cmp_w = (const float*)d_in[14]; a.p.w_out = (const float*)d_in[15];
    a.p.out = (float*)d_out; a.p.ws = (unsigned char*)d_ws;
#ifndef PROBE_DUP
#define PROBE_DUP -1
#endif
    for (int li = 0; li < N_LAUNCHES; ++li) {
        a.ph_lo = (N_LAUNCHES == 1) ? 0 : li; a.ph_hi = (N_LAUNCHES == 1) ? N_PHASES : li + 1;
        for (int rep = 0; rep < ((N_LAUNCHES > 1 && li == PROBE_DUP) ? 2 : 1); ++rep) {
            a.rep = rep;
            hipLaunchKernelGGL(nsa_fwd, dim3(grid), dim3(NWAVES * 64), LDS_BYTES, stream, a);
            const hipError_t le = hipPeekAtLastError();
            if (le != hipSuccess) { fprintf(stderr, "kernel_launch: launch %d failed: %s\n", li, hipGetErrorName(le)); break; }
        }
    }
}
```

```cpp
#include <hip/hip_runtime.h>
#include <cstdio>
#include <cstdint>
#define GAS __attribute__((address_space(1)))
#define LAS __attribute__((address_space(3)))
typedef unsigned short bf16;
typedef unsigned v4u __attribute__((ext_vector_type(4)));
typedef unsigned v2u __attribute__((ext_vector_type(2)));
typedef float f32x2 __attribute__((ext_vector_type(2)));
typedef float f32x16 __attribute__((ext_vector_type(16)));
typedef GAS unsigned gu32;
typedef GAS unsigned long long gu64;
#define RLX_AGENT __ATOMIC_RELAXED, __HIP_MEMORY_SCOPE_AGENT
#define LDS_WAIT() asm volatile("s_waitcnt lgkmcnt(0)" ::: "memory")
#define VM_WAIT() asm volatile("s_waitcnt vmcnt(0)" ::: "memory")
#define MK_N_LAUNCHES 1
#define PROBE_DUP -1
#define PROBE_P3 0
#define PROBE_SEG 0
namespace pg8 {
#define PG8_LAS __attribute__((address_space(3)))
typedef unsigned short bf16_t;
typedef short bf16x8 __attribute__((ext_vector_type(8)));
typedef float f32x4 __attribute__((ext_vector_type(4)));
typedef unsigned u32x4 __attribute__((ext_vector_type(4)));
constexpr int BM = 256, BK = 64, HALF = 128, HTB = HALF * BK * 2  , STAGE_BYTES = 8 * HTB, NXCD = 8, WGM = 8;

__host__ __device__ __forceinline__ int lds_byte(int r, int c) { const int st = (r >> 4) * 2 + (c >> 5), rr = r & 15, cc = c & 31, ob = rr * 64 + cc * 2; return st * 1024 + (ob ^ (((ob >> 9) & 1) << 5)); }
__host__ __device__ __forceinline__ void stage_rc(int b, int& R, int& C) { const int st = b / 1024, sb = b % 1024, swz = sb ^ (((sb >> 9) & 1) << 5); R = (st >> 1) * 16 + swz / 64; C = (st & 1) * 32 + (swz % 64) / 2; }
__host__ __device__ __forceinline__ int perm32(int rho) { const int n = rho >> 4, i = rho & 15; return 8 * (i >> 2) + 4 * n + (i & 3); }

struct Unit { int pm, pn; };
struct Gemm { const bf16_t* A; const bf16_t* Bt; int M, N, K; };

struct StaticOrder {
    int nM, nN, nwg, G, c, i0, n;
    __host__ __device__ void init(int M, int N, int G_, int c_, int i0_ = 0, int n_ = 1 << 30) { nM = M / BM; nN = N / BM; nwg = nM * nN; G = G_; c = c_; i0 = i0_; n = n_; }
    __host__ __device__ bool next(int i, Unit& u) const {
        if (i >= n) return false;
        const long L = (long)(i + i0) * G + c; if (L >= nwg) return false;
        int wgid = (int)L; { const int q = nwg / NXCD, r = nwg % NXCD, xcd = wgid % NXCD, off = wgid / NXCD; wgid = (xcd < r ? xcd * (q + 1) : r * (q + 1) + (xcd - r) * q) + off; }
        const int nig = WGM * nN, gid = wgid / nig, fm = gid * WGM, gsz = (nM - fm) < WGM ? (nM - fm) : WGM;
        u.pm = fm + ((wgid % nig) % gsz); u.pn = (wgid % nig) / gsz; return true;
    }
    __device__ __forceinline__ void a_ready(const Unit&) const {}
    __device__ __forceinline__ void done(const Unit&) const {}
};


template <class Epi, class Sched, bool ALIGN_EPI = false, bool SP2 = false>
__device__ __forceinline__ void gemm_phase(PG8_LAS unsigned char* lds, const Gemm g, const Sched& S, const Epi& E, int wave_id  , unsigned long long& tacc_  ) {
    const int lane = (int)__builtin_amdgcn_mbcnt_hi(~0u, __builtin_amdgcn_mbcnt_lo(~0u, 0u)), wid = wave_id, tid = wid * 64 + lane, wr = wid >> 2, wc = wid & 3, fr = lane & 15, fq = lane >> 4;
    const int K = g.K, nt = K / BK;
    unsigned voffA[2], voffB[2];
#pragma unroll
    for (int i = 0; i < 2; ++i) { int R, C; stage_rc(tid * 16 + i * 8192, R, C); const int Rb = Epi::PERM ? ((R & ~31) + perm32(R & 31)) : R;
        voffA[i] = (unsigned)(R * K + C) * 2u; voffB[i] = (unsigned)(Rb * K + C) * 2u; }
    const size_t kstep = (size_t)(BK * 2);
    const size_t hstep = (size_t)HALF * K * 2;
    const size_t tstep = 2 * hstep;
    const unsigned ldsw = (unsigned)wid * 1024u;
    const int aoff = lds_byte(wr * 64 + fr, fq * 8), boff = lds_byte(wc * 32 + fr, fq * 8);
#define PG8_SA(b, h) (((b) * 2 + (h)) * HTB)
#define PG8_SB(b, h) ((4 + (b) * 2 + (h)) * HTB)
#define PG8_STAGE(bufoff, gbase, voff) do { _Pragma("unroll") for (int _i = 0; _i < 2; ++_i) \
        __builtin_amdgcn_global_load_lds((const unsigned*)((const char*)(gbase) + (voff)[_i]), (PG8_LAS unsigned*)(lds + (bufoff) + ldsw + _i * 8192), 16, 0, 0); } while (0)
#define PG8_LDA(dst, b, h) do { _Pragma("unroll") for (int m = 0; m < 4; ++m) _Pragma("unroll") for (int k = 0; k < 2; ++k) dst[m][k] = *(const PG8_LAS bf16x8*)(lds + PG8_SA(b, h) + aoff + m * 2048 + k * 1024); } while (0)
#define PG8_LDB(dst, b, h) do { _Pragma("unroll") for (int n = 0; n < 2; ++n) _Pragma("unroll") for (int k = 0; k < 2; ++k) dst[n][k] = *(const PG8_LAS bf16x8*)(lds + PG8_SB(b, h) + boff + n * 2048 + k * 1024); } while (0)
#define PG8_MMA(ai, bj, At, Bt) do { __builtin_amdgcn_s_setprio(1); _Pragma("unroll") for (int m = 0; m < 4; ++m) _Pragma("unroll") for (int n = 0; n < 2; ++n) _Pragma("unroll") for (int k = 0; k < 2; ++k) \
        acc[ai][bj][m][n] = __builtin_amdgcn_mfma_f32_16x16x32_bf16(Bt[n][k], At[m][k], acc[ai][bj][m][n], 0, 0, 0); __builtin_amdgcn_s_setprio(0); } while (0)
#define PG8_WAIT_V(n) asm volatile("s_waitcnt vmcnt(" #n ")" ::: "memory")
#define PG8_WAIT_L(n) asm volatile("s_waitcnt lgkmcnt(" #n ")" ::: "memory")
#define PG8_BAR __builtin_amdgcn_s_barrier()
#define PG8_SCHED __builtin_amdgcn_sched_barrier(0)
    Unit cur, nxt; int ui = 0;
    if (!S.next(0, cur)) return;
    f32x4 acc[2][2][4][2];
#pragma unroll
    for (int a = 0; a < 2; ++a)
#pragma unroll
        for (int b = 0; b < 2; ++b)
#pragma unroll
            for (int m = 0; m < 4; ++m)
#pragma unroll
                for (int n = 0; n < 2; ++n) acc[a][b][m][n] = (f32x4){0.f, 0.f, 0.f, 0.f};
    bf16x8 At[4][2], B0[2][2], B1[2][2];
    const char* cA = (const char*)g.A + (size_t)cur.pm * tstep; const char* cB = (const char*)g.Bt + (size_t)cur.pn * tstep;
    S.a_ready(cur);
    if constexpr (SP2) {
        PG8_STAGE(PG8_SB(0, 0), cB, voffB); PG8_STAGE(PG8_SB(0, 1), cB + hstep, voffB); PG8_STAGE(PG8_SA(0, 0), cA, voffA); PG8_STAGE(PG8_SA(0, 1), cA + hstep, voffA);
        if (wr == 1) PG8_BAR;
        PG8_WAIT_V(2); PG8_BAR;
        PG8_STAGE(PG8_SB(1, 0), cB + kstep, voffB); PG8_STAGE(PG8_SA(1, 0), cA + kstep, voffA); PG8_STAGE(PG8_SB(1, 1), cB + hstep + kstep, voffB);
        PG8_WAIT_V(6); PG8_BAR;
    } else {
        PG8_STAGE(PG8_SB(0, 0), cB, voffB); PG8_STAGE(PG8_SA(0, 0), cA, voffA); PG8_STAGE(PG8_SB(0, 1), cB + hstep, voffB); PG8_STAGE(PG8_SA(0, 1), cA + hstep, voffA);
        if (wr == 1) PG8_BAR;
        PG8_WAIT_V(4); PG8_BAR;
        PG8_STAGE(PG8_SB(1, 0), cB + kstep, voffB); PG8_STAGE(PG8_SA(1, 0), cA + kstep, voffA); PG8_STAGE(PG8_SB(1, 1), cB + hstep + kstep, voffB);
        PG8_WAIT_V(6); PG8_BAR;
    }
    for (;;) {
        const bool has_next = S.next(ui + 1, nxt);
        const char* nA = has_next ? (const char*)g.A + (size_t)nxt.pm * tstep : cA; const char* nB = has_next ? (const char*)g.Bt + (size_t)nxt.pn * tstep : cB;
        for (int t = 0; t < nt; t += 2) {
            const bool last = (t == nt - 2);
            const char* a1 = cA + (size_t)(t + 1) * kstep;
            const char* a2 = last ? nA : cA + (size_t)(t + 2) * kstep; const char* b2 = last ? nB : cB + (size_t)(t + 2) * kstep;
            const char* a3 = a2 + kstep; const char* b3 = b2 + kstep;
            if (last && has_next) S.a_ready(nxt);
            if constexpr (SP2) {
            PG8_LDB(B0, 0, 0); PG8_LDB(B1, 0, 1); PG8_SCHED; PG8_LDA(At, 0, 0); PG8_STAGE(PG8_SA(1, 1), a1 + hstep, voffA);
            PG8_WAIT_V(8); PG8_WAIT_L(0); PG8_BAR; PG8_MMA(0, 0, At, B0); PG8_MMA(0, 1, At, B1); PG8_BAR; PG8_SCHED;
            PG8_LDA(At, 0, 1); PG8_STAGE(PG8_SB(0, 0), b2, voffB); PG8_STAGE(PG8_SB(0, 1), b2 + hstep, voffB); PG8_STAGE(PG8_SA(0, 0), a2, voffA);
            PG8_WAIT_V(8); PG8_WAIT_L(0); PG8_BAR; PG8_MMA(1, 0, At, B0); PG8_MMA(1, 1, At, B1); PG8_BAR; PG8_SCHED;
            PG8_LDB(B0, 1, 0); PG8_LDB(B1, 1, 1); PG8_SCHED; PG8_LDA(At, 1, 0); PG8_STAGE(PG8_SA(0, 1), a2 + hstep, voffA);
            PG8_WAIT_V(8); PG8_WAIT_L(0); PG8_BAR; PG8_MMA(0, 0, At, B0); PG8_MMA(0, 1, At, B1); PG8_BAR; PG8_SCHED;
            PG8_LDA(At, 1, 1); PG8_STAGE(PG8_SB(1, 0), b3, voffB); PG8_STAGE(PG8_SB(1, 1), b3 + hstep, voffB); PG8_STAGE(PG8_SA(1, 0), a3, voffA);
            PG8_WAIT_V(8); PG8_WAIT_L(0); PG8_BAR; PG8_MMA(1, 0, At, B0); PG8_MMA(1, 1, At, B1); PG8_BAR; PG8_SCHED;
            } else {
            PG8_LDB(B0, 0, 0); PG8_SCHED; PG8_LDA(At, 0, 0); PG8_STAGE(PG8_SA(1, 1), a1 + hstep, voffA);
            PG8_WAIT_L(8); PG8_BAR; PG8_WAIT_L(0); PG8_MMA(0, 0, At, B0); PG8_BAR; PG8_SCHED;
            PG8_LDB(B1, 0, 1); PG8_STAGE(PG8_SB(0, 0), b2, voffB);
            PG8_BAR; PG8_WAIT_L(0); PG8_MMA(0, 1, At, B1); PG8_BAR;
            PG8_LDA(At, 0, 1); PG8_STAGE(PG8_SA(0, 0), a2, voffA);
            PG8_BAR; PG8_WAIT_L(0); PG8_MMA(1, 0, At, B0); PG8_BAR; PG8_SCHED;
            PG8_STAGE(PG8_SB(0, 1), b2 + hstep, voffB);
            PG8_WAIT_V(6); PG8_BAR; PG8_MMA(1, 1, At, B1); PG8_BAR;
            PG8_LDB(B0, 1, 0); PG8_SCHED; PG8_LDA(At, 1, 0); PG8_STAGE(PG8_SA(0, 1), a2 + hstep, voffA);
            PG8_WAIT_L(8); PG8_BAR; PG8_WAIT_L(0); PG8_MMA(0, 0, At, B0); PG8_BAR; PG8_SCHED;
            PG8_LDB(B1, 1, 1); PG8_STAGE(PG8_SB(1, 0), b3, voffB);
            PG8_BAR; PG8_WAIT_L(0); PG8_MMA(0, 1, At, B1); PG8_BAR;
            PG8_LDA(At, 1, 1); PG8_STAGE(PG8_SA(1, 0), a3, voffA);
            PG8_BAR; PG8_WAIT_L(0); PG8_MMA(1, 0, At, B0); PG8_BAR; PG8_SCHED;
            PG8_STAGE(PG8_SB(1, 1), b3 + hstep, voffB);
            PG8_WAIT_V(6); PG8_BAR; PG8_MMA(1, 1, At, B1); PG8_BAR;
            }
        }
        if constexpr (ALIGN_EPI) { if (wr == 0) PG8_BAR; }
#ifdef PROBE_EPI
        { const unsigned long long t0_ = __builtin_readcyclecounter(); E(acc, cur, wr, wc, fr, fq); asm volatile("s_waitcnt vmcnt(0)" ::: "memory"); tacc_ += __builtin_readcyclecounter() - t0_; S.done(cur); }
#else
        if constexpr (!Epi::AFTER_DRAIN) { E(acc, cur, wr, wc, fr, fq); S.done(cur); }
#endif
        if (!has_next) break;
#pragma unroll
        for (int a = 0; a < 2; ++a)
#pragma unroll
            for (int b = 0; b < 2; ++b)
#pragma unroll
                for (int m = 0; m < 4; ++m)
#pragma unroll
                    for (int n = 0; n < 2; ++n) acc[a][b][m][n] = (f32x4){0.f, 0.f, 0.f, 0.f};
        cur = nxt; cA = nA; cB = nB; ++ui;
        if constexpr (ALIGN_EPI) { if (wr == 1) PG8_BAR; }
    }
    PG8_WAIT_V(0);
    if constexpr (!ALIGN_EPI) { if (wr == 0) PG8_BAR; }
    PG8_BAR;
    if constexpr (Epi::AFTER_DRAIN) { E.fused(acc, cur, wr, wc, fr, fq, lds, wid, lane); S.done(cur); }
#undef PG8_SA
#undef PG8_SB
#undef PG8_STAGE
#undef PG8_LDA
#undef PG8_LDB
#undef PG8_MMA
#undef PG8_WAIT_V
#undef PG8_WAIT_L
#undef PG8_BAR
#undef PG8_SCHED
}
}
#define XB_TMO      128
#define XB_XCNT(j)  (256  + 64 * (j))
#define XB_XSUB(j)  (1280 + 64 * (j))
#define XB_XGEN(j)  (2304 + 64 * (j))
#define XB_TOP      3328
#define XB_TOPGEN   3392
#define XCD_BAR_WORDS 3456
#define XB_SPIN_CAP (1u << 18)

__device__ __forceinline__ unsigned xb_ld(unsigned* p)              { return __hip_atomic_load(p, __ATOMIC_RELAXED, __HIP_MEMORY_SCOPE_AGENT); }
__device__ __forceinline__ unsigned xb_add(unsigned* p, unsigned v) { return __hip_atomic_fetch_add(p, v, __ATOMIC_RELAXED, __HIP_MEMORY_SCOPE_AGENT); }
__device__ __forceinline__ unsigned xb_xcc_id() { return (unsigned)__builtin_amdgcn_s_getreg((3 << 11) | 20) & 0xFu; }
#define XB_SPIN(cond, bar) do { unsigned _sp = 0; while (cond) { __builtin_amdgcn_s_sleep(1); \
    if ((++_sp & 255u) == 0u) { if (xb_ld(&(bar)[XB_TMO])) break; if (_sp > XB_SPIN_CAP) { atomicAdd(&(bar)[XB_TMO], 1u); break; } } } } while (0)

struct XcdBarrier {
    unsigned* bar; unsigned x;
    volatile LAS unsigned* st;
};

__device__ __forceinline__ XcdBarrier xcd_barrier_post(unsigned* bar, volatile LAS unsigned* st) {
    XcdBarrier b; b.bar = bar; b.x = xb_xcc_id(); b.st = st;
    if (threadIdx.x == 0) (void)xb_add(&bar[XB_XCNT(b.x)], 1u);
    return b;
}
__device__ __forceinline__ void xcd_barrier_complete(unsigned* bar, unsigned x, unsigned& nloc, unsigned& nx) {
    const unsigned G = gridDim.x * gridDim.y * gridDim.z;
    unsigned sum, cnt, mine, sp = 0u;
    for (;;) {
        sum = 0u; cnt = 0u; mine = 0u;
#pragma unroll
        for (unsigned j = 0; j < 16; ++j) { const unsigned c = xb_ld(&bar[XB_XCNT(j)]); sum += c; cnt += (c > 0u) ? 1u : 0u; mine = (j == x) ? c : mine; }
        if (sum == G) break;
        __builtin_amdgcn_s_sleep(1);
        if ((++sp & 255u) == 0u) { if (xb_ld(&bar[XB_TMO])) break; if (sp > XB_SPIN_CAP) { atomicAdd(&bar[XB_TMO], 1u); break; } }
    }
    nloc = mine > 0u ? mine : 1u; nx = cnt > 0u ? cnt : 1u;
}

__device__ __forceinline__ void xcd_barrier(const XcdBarrier& b, bool leader  ) {
    asm volatile("s_waitcnt vmcnt(0)" ::: "memory");
    __syncthreads();
    if (leader) {
        unsigned* bar = b.bar;
        __builtin_amdgcn_s_waitcnt(0);
        unsigned nloc = b.st[0], nx = b.st[1];
        if (nloc == 0u) { xcd_barrier_complete(bar, b.x, nloc, nx); b.st[0] = nloc; b.st[1] = nx; }
        const unsigned old = xb_add(&bar[XB_XSUB(b.x)], 1u);
        const unsigned gen = old / nloc;
        if (old + 1u == (gen + 1u) * nloc) {
            __builtin_amdgcn_fence(__ATOMIC_RELEASE, "agent");
            asm volatile("s_waitcnt vmcnt(0)" ::: "memory");
            const unsigned og = xb_add(&bar[XB_TOP], 1u);
            const unsigned tg = og / nx;
            if (og + 1u == (tg + 1u) * nx) xb_add(&bar[XB_TOPGEN], 1u);
            else XB_SPIN(xb_ld(&bar[XB_TOPGEN]) == tg, bar);
            __builtin_amdgcn_fence(__ATOMIC_ACQUIRE, "agent");
            xb_add(&bar[XB_XGEN(b.x)], 1u);
            asm volatile("s_waitcnt vmcnt(0)" ::: "memory");
        } else {
            XB_SPIN(xb_ld(&bar[XB_XGEN(b.x)]) == gen, bar);
            __builtin_amdgcn_fence(__ATOMIC_ACQUIRE, "agent");
            asm volatile("s_waitcnt vmcnt(0)" ::: "memory");
        }
    }
    __syncthreads();
}
using pg8::f32x4; using pg8::bf16x8;
constexpr int NWAVES = 8;
constexpr int BATCH = 4, T = 8192, D = 1024, M = BATCH * T, NP = 4096, INW = 3864;
constexpr int DECB = 32, PAST = 16384, NPAGES = 128, NCS = 512  ;
constexpr float NORM_EPS = 1e-6f;
constexpr float LOG2E = 1.4426950408889634f;
constexpr float QSCALE = 0.125f * LOG2E;
constexpr size_t O_Y = 0, O_YS = 33554432, O_PCMP = 33587200, O_PSLC = 41975808, O_PWIN = 50364416, O_PCONV = 50888704,
                 O_SCMP = 50892800, O_SSLC = 50900992, O_SWIN = 50909184, O_SCONV = 55103488, O_END = 55136256;
constexpr int C_BG = 0, C_CG = 512, C_CI = 1024, C_ZC = 1536, C_Q = 2048, C_KV = 2560, C_GL = 3328, C_ZA = 3352;

constexpr size_t MiB = 1u << 20, KiB = 1u << 10;
constexpr size_t WS_CTL = 0, CTL_ZERO_BYTES = 1 * MiB;
constexpr size_t WS_BT1 = 2 * MiB;
constexpr size_t WS_BT2 = 10 * MiB;
constexpr size_t WS_BTC = 12 * MiB;
constexpr size_t WS_CBIAS = 12 * MiB + 512 * KiB;
constexpr size_t WS_CONST = WS_CBIAS + 4 * KiB;
constexpr size_t WS_ROPE = 13 * MiB;
constexpr size_t WS_RSTD = 16 * MiB;
constexpr size_t WS_XSB = 16 * MiB + 256 * KiB;
constexpr size_t WS_RSTDS = WS_XSB + 64 * KiB;
constexpr size_t WS_GATE = 17 * MiB;
constexpr size_t WS_KC = 20 * MiB;
constexpr size_t WS_PROJS = 21 * MiB;
constexpr size_t WS_QS = 22 * MiB;
constexpr size_t WS_KVN = WS_QS + 64 * KiB;
constexpr size_t WS_GS = WS_KVN + 96 * KiB;
constexpr size_t WS_ZAS = WS_GS + 4 * KiB;
constexpr size_t WS_MIXS = WS_ZAS + 64 * KiB;
constexpr size_t WS_KCS = 24 * MiB;
constexpr size_t WS_KS = 40 * MiB, WS_KW = 56 * MiB;
constexpr size_t WS_XB = 72 * MiB;
constexpr size_t WS_CG = 136 * MiB, WS_U = 168 * MiB, WS_ZA = 200 * MiB, WS_Q = 232 * MiB;
constexpr size_t WS_MIX = 264 * MiB;
constexpr size_t WS_TOT = 328 * MiB;
constexpr size_t WS_END = 344 * MiB;
constexpr int CW_TMO = 0, CW_CODE = 1;
constexpr int CW_BAR = 4096;
constexpr int CW_QUEUE = 16384;
constexpr int CW_P0CNT = 18432;
constexpr int CW_KCMAX = 20480;

constexpr int RING_OFF = 0, RING_BYTES = 131072;
constexpr int LDSCTL_OFF = RING_BYTES, MISC_OFF = LDSCTL_OFF + 320;
constexpr int LDS_BYTES = 147456;

__device__ __forceinline__ unsigned f2bf(float f) { unsigned u = __builtin_bit_cast(unsigned, f); return (u + 0x7fffu + ((u >> 16) & 1u)) >> 16; }
typedef __bf16 bf16x2_t __attribute__((ext_vector_type(2)));
__device__ __forceinline__ unsigned pk2(float lo, float hi) { return __builtin_bit_cast(unsigned, __builtin_convertvector((f32x2){lo, hi}, bf16x2_t)); }
__device__ __forceinline__ float bf2f(unsigned h) { return __builtin_bit_cast(float, h << 16); }
__device__ __forceinline__ float wave_sum(float v) {
#pragma unroll
    for (int o = 1; o < 64; o <<= 1) v += __shfl_xor(v, o);
    return v;
}
__device__ __forceinline__ float quad_sum(float v) {
    v += __builtin_bit_cast(float, __builtin_amdgcn_update_dpp(0, __builtin_bit_cast(int, v), 0xB1, 0xF, 0xF, true));
    v += __builtin_bit_cast(float, __builtin_amdgcn_update_dpp(0, __builtin_bit_cast(int, v), 0x4E, 0xF, 0xF, true));
    return v;
}
__device__ __forceinline__ float fast_exp2(float x) { return __builtin_amdgcn_exp2f(x); }
__device__ __forceinline__ float sigmoidf(float x) { return __builtin_amdgcn_rcpf(1.0f + fast_exp2(-x * LOG2E)); }
__device__ __forceinline__ float slc_vscale(float sh_slc) { return fast_exp2(floorf(18.0f - sh_slc)); }
__device__ __forceinline__ int kimg_off(int key, int d) { return ((((key >> 5) * 4 + (d >> 4)) * 64 + ((d >> 3) & 1) * 32 + (key & 31)) << 3) + (d & 7); }
__device__ __forceinline__ int vimg_off(int d, int pos) { return 4096 + ((((d >> 5) * 4 + (pos >> 4)) * 64 + ((pos >> 3) & 1) * 32 + (d & 31)) << 3) + (pos & 7); }
__device__ __forceinline__ int perm16(int kk) { return 8 * ((kk >> 2) & 1) + 4 * (kk >> 3) + (kk & 3); }

struct Ptrs {
    const float *xp, *xs, *cache_cmp, *cache_slc, *st_win, *st_conv; const int* page_table;
    const float *norm_g, *w_in, *conv_w, *conv_b, *q_gain, *k_gain, *cmp_pe, *cmp_w, *w_out;
    float* out; unsigned char* ws;
};
struct Frame {
    LAS unsigned char* lds;
    volatile LAS unsigned* MISC;
    gu32* ctl;
    int tid, lane, wave, G, gw, NGW;
};
__device__ __forceinline__ int bt1_src(int dg, int& nvalid) {
    const int pn = dg >> 3, gi = dg & 7, bj = gi >> 2, wc = gi & 3; nvalid = 32;
    if (pn < 4) return (bj ? C_ZC : C_BG) + 128 * pn + 32 * wc;
    if (pn < 8) return (bj ? C_CI : C_CG) + 128 * (pn - 4) + 32 * wc;
    if (pn < 10) return C_Q + (4 * (pn - 8) + wc) * 64 + 32 * bj;
    if (pn < 13) return C_KV + (pn - 10) * 256 + wc * 64 + 32 * bj;
    if (pn < 15) return C_ZA + 256 * (pn - 13) + 32 * gi;
    nvalid = (gi == 0) ? 24 : 0; return C_GL;
}
__device__ __forceinline__ void p0_transpose_item(const float* W, int ldw, int k0, int src0, int nvalid, const float* ksc, bf16* WT, int ldt, int drow0, LAS float* scr, int lane) {
    const int nn = lane & 31;
#pragma unroll 8
    for (int i = 0; i < 32; ++i) { const int kk = 2 * i + (lane >> 5); float v = 0.f;
        if (nn < nvalid) { v = W[(size_t)(k0 + kk) * ldw + src0 + nn]; if (ksc) v *= ksc[k0 + kk]; }
        scr[kk * 33 + nn] = v; }
    LDS_WAIT(); asm volatile("" ::: "memory");
    const int c = lane & 7;
#pragma unroll
    for (int j = 0; j < 4; ++j) { const int n = (lane >> 3) + 8 * j; const LAS float* s = scr + (8 * c) * 33 + n;
        v4u o; o.x = pk2(s[0 * 33], s[1 * 33]); o.y = pk2(s[2 * 33], s[3 * 33]); o.z = pk2(s[4 * 33], s[5 * 33]); o.w = pk2(s[6 * 33], s[7 * 33]);
        *(GAS v4u*)(WT + (size_t)(drow0 + n) * ldt + k0 + 8 * c) = o; }
    LDS_WAIT(); asm volatile("" ::: "memory");
}
template <int NR>
__device__ __forceinline__ void x_rows_to_bf16(const float* xrow, bf16* orow, float* rstd_out, int lane) {
    f32x4 v[NR][4]; float s[NR];
#pragma unroll
    for (int r = 0; r < NR; ++r)
#pragma unroll
        for (int j = 0; j < 4; ++j) v[r][j] = ((const GAS f32x4*)(xrow + (size_t)r * D) + lane)[64 * j];
#pragma unroll
    for (int r = 0; r < NR; ++r) { s[r] = 0.f;
#pragma unroll
        for (int j = 0; j < 4; ++j) s[r] += (v[r][j].x * v[r][j].x + v[r][j].y * v[r][j].y) + (v[r][j].z * v[r][j].z + v[r][j].w * v[r][j].w); }
#pragma unroll
    for (int o = 1; o < 64; o <<= 1)
#pragma unroll
        for (int r = 0; r < NR; ++r) s[r] += __shfl_xor(s[r], o);
#pragma unroll
    for (int r = 0; r < NR; ++r) { GAS unsigned long long* o8 = (GAS unsigned long long*)(orow + (size_t)r * D) + lane;
#pragma unroll
        for (int j = 0; j < 4; ++j) o8[64 * j] = (unsigned long long)pk2(v[r][j].x, v[r][j].y) | ((unsigned long long)pk2(v[r][j].z, v[r][j].w) << 32);
        if (lane == 0) rstd_out[r] = 1.0f / sqrtf(s[r] * (1.0f / D) + NORM_EPS); }
}
template <bool SAMPLE>
__device__ __forceinline__ const float* cmp_rowbase(const Ptrs& P, int unit, int rho) {
    const int b = SAMPLE ? unit >> 6 : unit >> 5, c = (SAMPLE ? (unit & 63) : (unit & 31)) * 8 + (rho >> 1), g = rho & 1;
    if (SAMPLE) { const int page = P.page_table[b * NPAGES + (c >> 2)]; return P.cache_cmp + ((size_t)page * 128 + (c & 3) * 32) * 256 + g * 64; }
    return P.out + O_PCMP + ((size_t)b * T + c * 32) * 256 + g * 64;
}
template <bool SAMPLE>
__device__ __forceinline__ void compress_units(const Ptrs& P, Frame& F, LAS float* part  ) {
    constexpr int NUNITS = SAMPLE ? DECB * (NCS / 8) : BATCH * 32;
    const int lane = F.lane, w = F.wave, rho = lane & 15, kq = lane >> 4;
    const GAS v4u* bfr = (const GAS v4u*)(P.ws + WS_BTC) + lane;
    const float* cbias = (const float*)(P.ws + WS_CBIAS);
    int unit = blockIdx.x;
    if (unit >= NUNITS) return;
    f32x4 a_cur[8], a_n1[8], a_n2[8];
    const float* rb = cmp_rowbase<SAMPLE>(P, unit, rho) + 4 * kq;
#define CMP_LOAD(dst, base, r) do { _Pragma("unroll") for (int q_ = 0; q_ < 4; ++q_) { dst[2 * q_] = *(const GAS f32x4*)((base) + (r) * 256 + (q_ >> 1) * 128 + (q_ & 1) * 32); dst[2 * q_ + 1] = *(const GAS f32x4*)((base) + (r) * 256 + (q_ >> 1) * 128 + (q_ & 1) * 32 + 16); } } while (0)
    CMP_LOAD(a_cur, rb, 4 * w); CMP_LOAD(a_n1, rb, 4 * w + 1);
    for (;;) {
        f32x4 acc[2][4];
#pragma unroll
        for (int j = 0; j < 2; ++j)
#pragma unroll
            for (int e = 0; e < 4; ++e) acc[j][e] = (f32x4){0.f, 0.f, 0.f, 0.f};
        const int nunit = unit + F.G; const bool has_next = nunit < NUNITS;
        const float* rbn = has_next ? cmp_rowbase<SAMPLE>(P, nunit, rho) + 4 * kq : rb;
#pragma unroll 1
        for (int rr = 0; rr < 4; ++rr) {
            const int r = 4 * w + rr;
            bf16x8 bb[16];
#pragma unroll
            for (int q_ = 0; q_ < 4; ++q_)
#pragma unroll
                for (int et = 0; et < 4; ++et) bb[q_ * 4 + et] = __builtin_bit_cast(bf16x8, bfr[(size_t)(((((q_ >> 1) * 32 + r) * 2 + (q_ & 1)) * 4 + et) * 64)]);
            __builtin_amdgcn_sched_barrier(0);
            { const float* nb_ = rr < 2 ? rb : rbn; const int nr_ = rr < 2 ? r + 2 : 4 * w + (rr - 2); CMP_LOAD(a_n2, nb_, nr_); }
            __builtin_amdgcn_sched_barrier(0);
#pragma unroll
            for (int q_ = 0; q_ < 4; ++q_) { const int j = q_ >> 1;
                v4u wv; wv.x = pk2(a_cur[2 * q_].x, a_cur[2 * q_].y); wv.y = pk2(a_cur[2 * q_].z, a_cur[2 * q_].w); wv.z = pk2(a_cur[2 * q_ + 1].x, a_cur[2 * q_ + 1].y); wv.w = pk2(a_cur[2 * q_ + 1].z, a_cur[2 * q_ + 1].w);
                const bf16x8 af = __builtin_bit_cast(bf16x8, wv);
#pragma unroll
                for (int et = 0; et < 4; ++et) acc[j][et] = __builtin_amdgcn_mfma_f32_16x16x32_bf16(af, bb[q_ * 4 + et], acc[j][et], 0, 0, 0); }
#pragma unroll
            for (int q_ = 0; q_ < 8; ++q_) { a_cur[q_] = a_n1[q_]; a_n1[q_] = a_n2[q_]; }
        }
#pragma unroll
        for (int j = 0; j < 2; ++j)
#pragma unroll
            for (int et = 0; et < 4; ++et) *(LAS f32x4*)(part + ((w * 8 + j * 4 + et) * 64 + lane) * 4) = acc[j][et];
        __syncthreads();
        { const int j = w >> 2, et = w & 3, e = 16 * et + rho; f32x4 sum = *(const LAS f32x4*)(part + ((0 * 8 + w) * 64 + lane) * 4);
#pragma unroll
          for (int ww = 1; ww < 8; ++ww) sum = sum + *(const LAS f32x4*)(part + ((ww * 8 + w) * 64 + lane) * 4);
          const float bs = cbias[j * 64 + e]; const int b = SAMPLE ? unit >> 6 : unit >> 5, c0 = (SAMPLE ? (unit & 63) : (unit & 31)) * 8;
          float nmax = 0.f;
#pragma unroll
          for (int i = 0; i < 4; ++i) { const int row = 4 * kq + i, c = c0 + (row >> 1), g = row & 1; const float val = sum[i] + bs;
              float q2 = val * val; q2 += __shfl_xor(q2, 1); q2 += __shfl_xor(q2, 2); q2 += __shfl_xor(q2, 4); q2 += __shfl_xor(q2, 8); nmax = fmaxf(nmax, q2);
              if (SAMPLE) ((float*)(P.ws + WS_KCS))[((size_t)((b * 2 + g) * 2 + j) * NCS + c) * 64 + e] = val;
              else { bf16* img = (bf16*)(P.ws + WS_KC) + ((size_t)(b * 2 + g) * 4 + (c >> 6)) * 8192;
                  if (j == 0) img[kimg_off(c & 63, e)] = (bf16)f2bf(val); else img[vimg_off(e, (c & 48) + perm16(c & 15))] = (bf16)f2bf(val); } }
          if (j == 0) { nmax = fmaxf(nmax, __shfl_xor(nmax, 16)); nmax = fmaxf(nmax, __shfl_xor(nmax, 32));
              if (lane == 0) atomicMax((unsigned*)(P.ws + WS_CTL) + CW_KCMAX + (SAMPLE ? 64 : 0) + et, __builtin_bit_cast(unsigned, nmax)); } }
        __syncthreads();
        if (!has_next) break;
        unit = nunit; rb = rbn;
    }
#undef CMP_LOAD
}
constexpr int CMP_NPASS = DECB * 16;
__device__ __forceinline__ void lds_wait_ge(volatile LAS unsigned* c, unsigned want) { unsigned sp = 0u; while (*c < want) { __builtin_amdgcn_s_sleep(1); if (++sp > (1u << 24)) break; } }
__device__ __forceinline__ void compress_team(const Ptrs& P, Frame& F, LAS unsigned char* bl  , volatile LAS unsigned* cw  , volatile LAS unsigned* cr  , int pass0, int pstride, int npass) {
    const int lane = F.lane, w = F.wave & 3, tid = w * 64 + lane, rho = lane & 15, kq = lane >> 4;
    unsigned nw_ = 0u, nr_ = 0u;
    for (int pi = 0; pi < npass; ++pi) { const int pass = pass0 + pi * pstride;
    const int b = pass >> 4, c0 = (pass & 15) * 32 + w * 8;
    const float* rb; { const int c = c0 + (rho >> 1), g = rho & 1; const int page = P.page_table[b * NPAGES + (c >> 2)]; rb = P.cache_cmp + ((size_t)page * 128 + (c & 3) * 32) * 256 + g * 64 + 4 * kq; }
    const GAS v4u* bsrc = (const GAS v4u*)(P.ws + WS_BTC);
    const int sf = tid >> 4, sj = sf >> 3, sdh = (sf >> 2) & 1, set_ = sf & 3, sl = (tid & 15) * 4;
#define B_SRC(r) (bsrc + (size_t)((((sj * 32 + (r)) * 2 + sdh) * 4 + set_) * 64 + sl))
    LAS v4u* bdst = (LAS v4u*)bl + sf * 64 + sl;
    f32x4 a_cur[8], a_n1[8], a_n2[8], a_n3[8];
#define CMP_LOAD(dst, base, r) do { _Pragma("unroll") for (int q_ = 0; q_ < 4; ++q_) { dst[2 * q_] = *(const GAS f32x4*)((base) + (r) * 256 + (q_ >> 1) * 128 + (q_ & 1) * 32); dst[2 * q_ + 1] = *(const GAS f32x4*)((base) + (r) * 256 + (q_ >> 1) * 128 + (q_ & 1) * 32 + 16); } } while (0)
    { const v4u b0 = B_SRC(0)[0], b1 = B_SRC(0)[1], b2 = B_SRC(0)[2], b3 = B_SRC(0)[3];
      lds_wait_ge(cr, 4u * nr_);
      bdst[0] = b0; bdst[1] = b1; bdst[2] = b2; bdst[3] = b3; LDS_WAIT(); ++nw_; if (lane == 0) __hip_atomic_fetch_add((LAS unsigned*)cw, 1u, __ATOMIC_RELAXED, __HIP_MEMORY_SCOPE_WORKGROUP); }
    CMP_LOAD(a_cur, rb, 0); CMP_LOAD(a_n1, rb, 1); CMP_LOAD(a_n2, rb, 2);
    f32x4 acc[2][4];
#pragma unroll
    for (int j = 0; j < 2; ++j)
#pragma unroll
        for (int e = 0; e < 4; ++e) acc[j][e] = (f32x4){0.f, 0.f, 0.f, 0.f};
#pragma unroll 1
    for (int r = 0; r < 32; ++r) {
        const int rn = r + 1 < 32 ? r + 1 : 31, r3 = r + 3 < 32 ? r + 3 : 31;
        const v4u b0 = B_SRC(rn)[0], b1 = B_SRC(rn)[1], b2 = B_SRC(rn)[2], b3 = B_SRC(rn)[3];
        __builtin_amdgcn_sched_barrier(0);
        CMP_LOAD(a_n3, rb, r3);
        __builtin_amdgcn_sched_barrier(0);
        lds_wait_ge(cw, 4u * nw_);
        const LAS v4u* bf = (const LAS v4u*)bl + (r & 1) * 1024 + lane;
#pragma unroll
        for (int q_ = 0; q_ < 4; ++q_) { const int j = q_ >> 1;
            v4u wv; wv.x = pk2(a_cur[2 * q_].x, a_cur[2 * q_].y); wv.y = pk2(a_cur[2 * q_].z, a_cur[2 * q_].w); wv.z = pk2(a_cur[2 * q_ + 1].x, a_cur[2 * q_ + 1].y); wv.w = pk2(a_cur[2 * q_ + 1].z, a_cur[2 * q_ + 1].w);
            const bf16x8 af = __builtin_bit_cast(bf16x8, wv);
#pragma unroll
            for (int et = 0; et < 4; ++et) acc[j][et] = __builtin_amdgcn_mfma_f32_16x16x32_bf16(af, __builtin_bit_cast(bf16x8, bf[(q_ * 4 + et) * 64]), acc[j][et], 0, 0, 0); }
        LDS_WAIT(); ++nr_; if (lane == 0) __hip_atomic_fetch_add((LAS unsigned*)cr, 1u, __ATOMIC_RELAXED, __HIP_MEMORY_SCOPE_WORKGROUP);
        if (r + 1 < 32) { lds_wait_ge(cr, 4u * (nr_ - 1u));
            LAS v4u* d_ = bdst + ((r + 1) & 1) * 1024; d_[0] = b0; d_[1] = b1; d_[2] = b2; d_[3] = b3; LDS_WAIT(); ++nw_; if (lane == 0) __hip_atomic_fetch_add((LAS unsigned*)cw, 1u, __ATOMIC_RELAXED, __HIP_MEMORY_SCOPE_WORKGROUP); }
#pragma unroll
        for (int q_ = 0; q_ < 8; ++q_) { a_cur[q_] = a_n1[q_]; a_n1[q_] = a_n2[q_]; a_n2[q_] = a_n3[q_]; }
    }
#undef CMP_LOAD
#undef B_SRC
    const float* cbias = (const float*)(P.ws + WS_CBIAS);
    float nmax = 0.f;
#pragma unroll
    for (int i = 0; i < 4; ++i) { const int row = 4 * kq + i, c = c0 + (row >> 1), g = row & 1; float q2 = 0.f;
#pragma unroll
        for (int j = 0; j < 2; ++j)
#pragma unroll
            for (int et = 0; et < 4; ++et) { const int e = 16 * et + rho; const float val = acc[j][et][i] + cbias[j * 64 + e]; if (j == 0) q2 += val * val;
                ((float*)(P.ws + WS_KCS))[((size_t)((b * 2 + g) * 2 + j) * NCS + c) * 64 + e] = val; }
        q2 += __shfl_xor(q2, 1); q2 += __shfl_xor(q2, 2); q2 += __shfl_xor(q2, 4); q2 += __shfl_xor(q2, 8); nmax = fmaxf(nmax, q2); }
    nmax = fmaxf(nmax, __shfl_xor(nmax, 16)); nmax = fmaxf(nmax, __shfl_xor(nmax, 32));
    if (lane == 0) atomicMax((unsigned*)(P.ws + WS_CTL) + CW_KCMAX + 64, __builtin_bit_cast(unsigned, nmax));
    }
}
constexpr int P0_PRODUCERS = 641;
__device__ __forceinline__ void p0_small_items(const Ptrs& P, Frame& F) {
    const int lane = F.lane, gw = F.gw;
    if (gw >= P0_PRODUCERS && F.NGW >= P0_PRODUCERS) return;
    for (int item = gw; item < P0_PRODUCERS; item += F.NGW) {
        if (item < 512) { const int it = item * 64 + lane; const int l = it & 63, et = (it >> 6) & 3, dh = (it >> 8) & 1, r = (it >> 9) & 31, j = it >> 14;
            const float* w = P.cmp_w + ((size_t)(r * 2 + j) * 64 + 32 * dh + 4 * (l >> 4)) * 64 + 16 * et + (l & 15);
            v4u o; o.x = pk2(w[0], w[64]); o.y = pk2(w[128], w[192]); o.z = pk2(w[16 * 64], w[17 * 64]); o.w = pk2(w[18 * 64], w[19 * 64]);
            __builtin_amdgcn_raw_buffer_store_b128(o, __builtin_amdgcn_make_buffer_rsrc((void*)(P.ws + WS_BTC), 0, 512 * 1024, 0x00020000), it * 16, 0, 16);
        } else if (item < 640) { const int it = item - 512, j = it >> 6, e = it & 63; float s = 0.f;
            for (int k = lane; k < 2048; k += 64) { const int r = k >> 6, d = k & 63; s += P.cmp_pe[(r * 2 + j) * 64 + d] * P.cmp_w[((size_t)(r * 2 + j) * 64 + d) * 64 + e]; }
            s = wave_sum(s); if (lane == 0) __hip_atomic_store((float*)(P.ws + WS_CBIAS) + it, s, RLX_AGENT);
        } else { float qm = fabsf(P.q_gain[lane]), k1 = fabsf(P.k_gain[64 + lane]), k2 = fabsf(P.k_gain[128 + lane]);
#pragma unroll
            for (int o = 1; o < 64; o <<= 1) { qm = fmaxf(qm, __shfl_xor(qm, o)); k1 = fmaxf(k1, __shfl_xor(k1, o)); k2 = fmaxf(k2, __shfl_xor(k2, o)); }
            if (lane == 0) { float* cst = (float*)(P.ws + WS_CONST); __hip_atomic_store(cst + 0, qm, RLX_AGENT); __hip_atomic_store(cst + 1, 8.0f * qm * k1 * LOG2E * 1.001f, RLX_AGENT); __hip_atomic_store(cst + 2, 8.0f * qm * k2 * LOG2E * 1.001f, RLX_AGENT); } }
        asm volatile("s_waitcnt vmcnt(0)" ::: "memory");
        if (lane == 0) __hip_atomic_fetch_add((unsigned*)(F.ctl + CW_P0CNT), 1u, RLX_AGENT);
    }
}
__device__ __forceinline__ void p0_rope(const Ptrs& P, Frame& F, int gw, int NGW) {
    const int lane = F.lane; const int i = lane & 31;
    const float inv = (float)pow(10000.0, -(double)i / 32.0);
    for (int it = gw * 64 + lane; it < 8193 * 32; it += NGW * 64) { const int p = it >> 5; const int pos = (p == 8192) ? PAST : p;
        const float ang = (float)pos * inv; const double rev = (double)ang * 0.15915494309189535; const float fr = (float)(rev - __builtin_rint(rev));
        float* rt = (float*)(P.ws + WS_ROPE) + (size_t)p * 64; rt[i] = __builtin_amdgcn_cosf(fr); rt[32 + i] = __builtin_amdgcn_sinf(fr); }
}
__device__ __forceinline__ void p0_other_slice(const Ptrs& P, Frame& F, int k, int gw, int NGW, LAS float* scr) {
    const int lane = F.lane;
    if (k < 2) { const int it = gw + k * NGW; if (it < 16 * 128) { const int kb = it >> 7, dg = it & 127; int nv; const int src0 = bt1_src(dg, nv);
        p0_transpose_item(P.w_in, INW, 64 * kb, src0, nv, P.norm_g, (bf16*)(P.ws + WS_BT1), D, 32 * dg, scr, lane); }
    } else if (k == 2) { for (int it = gw; it < 16 * 32; it += NGW) { const int kb = it >> 5, nb = it & 31;
        p0_transpose_item(P.w_out, D, 64 * kb, 32 * nb, 32, nullptr, (bf16*)(P.ws + WS_BT2), D, 32 * nb, scr, lane); }
    } else if (k < 11) { for (int m = (gw + (k - 3) * NGW) * 4; m < M; m += NGW * 4 * 8) x_rows_to_bf16<4>(P.xp + (size_t)m * D, (bf16*)(P.ws + WS_XB) + (size_t)m * D, (float*)(P.ws + WS_RSTD) + m, lane);
    } else if (k == 11) { for (int m = gw; m < DECB; m += NGW) x_rows_to_bf16<1>(P.xs + (size_t)m * D, (bf16*)(P.ws + WS_XSB) + (size_t)m * D, (float*)(P.ws + WS_RSTDS) + m, lane);
        for (int it = gw * 64 + lane; it < DECB * 512; it += NGW * 64) { const int b = it >> 9, ch = it & 511; P.out[O_SCONV + (size_t)b * 1024 + ch] = P.st_conv[(size_t)b * 1024 + 512 + ch]; }
    } else if (k == 12) {
        constexpr int PERB = 511 * 64, TOTAL = DECB * PERB; const GAS f32x4* src = (const GAS f32x4*)P.st_win; GAS f32x4* dst = (GAS f32x4*)(P.out + O_SWIN);
        for (int i0 = gw * 64 + lane; i0 < TOTAL; i0 += NGW * 64 * 8) { f32x4 t[8];
#pragma unroll
            for (int u = 0; u < 8; ++u) { const int i = i0 + u * NGW * 64; if (i < TOTAL) { const int b = i / PERB; t[u] = src[i + 64 * b + 64]; } }
#pragma unroll
            for (int u = 0; u < 8; ++u) { const int i = i0 + u * NGW * 64; if (i < TOTAL) { const int b = i / PERB; dst[i + 64 * b] = t[u]; } } }
    } else if (k == 13) p0_rope(P, F, gw, NGW);
}
constexpr int P0_OTHER_SLICES = 14;
__device__ __forceinline__ void p0_phase(const Ptrs& P, Frame& F) {
    p0_small_items(P, F);
    LAS float* scr = (LAS float*)(F.lds + RING_OFF + F.wave * 16384);
    for (int k = 0; k < P0_OTHER_SLICES; ++k) p0_other_slice(P, F, k, F.gw, F.NGW, scr);
}
__device__ __forceinline__ void p1_compress(const Ptrs& P, Frame& F) {
    const int team = F.wave >> 2, slot = (int)blockIdx.x * 2 + team, stride = F.G * 2;
    const int npass = slot < CMP_NPASS ? (CMP_NPASS - 1 - slot) / stride + 1 : 0;
    compress_team(P, F, F.lds + RING_OFF + team * 32768, F.MISC + 16 + 2 * team, F.MISC + 17 + 2 * team, slot, stride, npass);
}
struct EpiIn {
    static constexpr bool PERM = false, AFTER_DRAIN = false;
    const float *rstd, *rope, *qg, *kg; float* out; unsigned char* ws;
    __device__ __forceinline__ void operator()(const f32x4 (&acc)[2][2][4][2], const pg8::Unit& u, int wr, int wc, int fr, int fq) const {
        asm volatile("" : "+v"(fr), "+v"(fq));
        const int pn = u.pn; const int rbase = u.pm * 256 + wr * 64 + fr;
        if (pn < 8) {
            const bool bz = pn < 4; bf16* dst = (bf16*)(ws + (bz ? WS_CG : WS_U)); const int col0 = 128 * (pn & 3) + 32 * wc + 4 * fq;
#pragma unroll
            for (int ai = 0; ai < 2; ++ai)
#pragma unroll
                for (int m = 0; m < 4; ++m) { const int row = rbase + ai * 128 + m * 16; const float rs = rstd[row];
#pragma unroll
                    for (int n = 0; n < 2; ++n) { const f32x4 a = acc[ai][0][m][n] * rs, z = acc[ai][1][m][n] * rs; f32x4 o;
                        if (bz) { o.x = a.x * z.x * sigmoidf(z.x); o.y = a.y * z.y * sigmoidf(z.y); o.z = a.z * z.z * sigmoidf(z.z); o.w = a.w * z.w * sigmoidf(z.w); }
                        else o = a * z;
                        v2u w; w.x = pk2(o.x, o.y); w.y = pk2(o.z, o.w);
                        *(GAS v2u*)(dst + (size_t)row * 512 + col0 + 16 * n) = w;
                        if (!bz) { const int t = row & (T - 1); if (t >= T - 2) *(GAS f32x4*)(out + O_PCONV + ((size_t)(row >> 13) * 2 + (t - (T - 2))) * 512 + col0 + 16 * n) = o; } } }
        } else if (pn < 13) {
            const bool isq = pn < 10; const int br = pn - 10; const bool isk = !isq && wc < 2;
            if (isq || isk) {
                const float* gain = isq ? qg : kg + br * 64; float g1[2][4], g2[2][4];
#pragma unroll
                for (int n = 0; n < 2; ++n)
#pragma unroll
                    for (int e = 0; e < 4; ++e) { g1[n][e] = gain[16 * n + 4 * fq + e]; g2[n][e] = gain[32 + 16 * n + 4 * fq + e]; }
#pragma unroll
                for (int ai = 0; ai < 2; ++ai)
#pragma unroll
                    for (int m = 0; m < 4; ++m) { const int row = rbase + ai * 128 + m * 16; const float rs = rstd[row]; const int t = row & (T - 1), b = row >> 13;
                        f32x4 x1[2], x2[2]; float ss = 0.f;
#pragma unroll
                        for (int n = 0; n < 2; ++n) { x1[n] = acc[ai][0][m][n] * rs; x2[n] = acc[ai][1][m][n] * rs;
                            ss += (x1[n].x * x1[n].x + x1[n].y * x1[n].y) + (x1[n].z * x1[n].z + x1[n].w * x1[n].w) + (x2[n].x * x2[n].x + x2[n].y * x2[n].y) + (x2[n].z * x2[n].z + x2[n].w * x2[n].w); }
                        ss += __shfl_xor(ss, 16); ss += __shfl_xor(ss, 32);
                        const float inv = 1.0f / sqrtf(ss * (1.0f / 64.0f) + NORM_EPS);
                        const float* rp = rope + (size_t)t * 64 + 4 * fq;
#pragma unroll
                        for (int n = 0; n < 2; ++n) { const f32x4 cs = *(const GAS f32x4*)(rp + 16 * n), sn = *(const GAS f32x4*)(rp + 32 + 16 * n); f32x4 o1, o2;
#pragma unroll
                            for (int e = 0; e < 4; ++e) { const float a = x1[n][e] * inv * g1[n][e], c = x2[n][e] * inv * g2[n][e]; o1[e] = a * cs[e] - c * sn[e]; o2[e] = c * cs[e] + a * sn[e]; }
                            const int d1 = 16 * n + 4 * fq;
                            if (isq) { o1 = o1 * QSCALE; o2 = o2 * QSCALE; bf16* q = (bf16*)(ws + WS_Q) + (size_t)row * 512 + (4 * (pn - 8) + wc) * 64 + d1;
                                v2u w; w.x = pk2(o1.x, o1.y); w.y = pk2(o1.z, o1.w); *(GAS v2u*)q = w; w.x = pk2(o2.x, o2.y); w.y = pk2(o2.z, o2.w); *(GAS v2u*)(q + 32) = w; }
                            else { const int g = wc;
                                if (br > 0) { bf16* img = (bf16*)(ws + (br == 1 ? WS_KS : WS_KW)) + ((size_t)(b * 2 + g) * 128 + (t >> 6)) * 8192;
                                    v2u w; w.x = pk2(o1.x, o1.y); w.y = pk2(o1.z, o1.w); *(GAS v2u*)(img + kimg_off(t & 63, d1)) = w; w.x = pk2(o2.x, o2.y); w.y = pk2(o2.z, o2.w); *(GAS v2u*)(img + kimg_off(t & 63, d1 + 32)) = w; }
                                if (br < 2) { float* o = out + (br == 0 ? O_PCMP : O_PSLC) + (size_t)row * 256 + g * 64 + d1; *(GAS f32x4*)o = o1; *(GAS f32x4*)(o + 32) = o2; }
                                else if (t >= T - 512) { float* o = out + O_PWIN + ((size_t)b * 512 + (t - (T - 512))) * 256 + g * 64 + d1; *(GAS f32x4*)o = o1; *(GAS f32x4*)(o + 32) = o2; } } } }
            } else {
                const int g = wc - 2;
#pragma unroll
                for (int ai = 0; ai < 2; ++ai)
#pragma unroll
                    for (int m = 0; m < 4; ++m) { const int row = rbase + ai * 128 + m * 16; const float rs = rstd[row]; const int t = row & (T - 1), b = row >> 13;
                        const int tk = t & 63, vpos = (tk & ~15) + perm16(tk & 15);
                        bf16* vt = (br > 0) ? (bf16*)(ws + (br == 1 ? WS_KS : WS_KW)) + ((size_t)(b * 2 + g) * 128 + (t >> 6)) * 8192 : nullptr;
                        const float vsc = (br == 1) ? slc_vscale(((const float*)(ws + WS_CONST))[1]) : 1.0f;
#pragma unroll
                        for (int bj = 0; bj < 2; ++bj)
#pragma unroll
                            for (int n = 0; n < 2; ++n) { const f32x4 v = acc[ai][bj][m][n] * rs; const int d1 = 32 * bj + 16 * n + 4 * fq;
                                if (br > 0) {
#pragma unroll
                                    for (int e = 0; e < 4; ++e) vt[vimg_off(d1 + e, vpos)] = (bf16)f2bf(v[e] * vsc); }
                                if (br < 2) *(GAS f32x4*)(out + (br == 0 ? O_PCMP : O_PSLC) + (size_t)row * 256 + 128 + g * 64 + d1) = v;
                                else if (t >= T - 512) *(GAS f32x4*)(out + O_PWIN + ((size_t)b * 512 + (t - (T - 512))) * 256 + 128 + g * 64 + d1) = v; } }
            }
        } else if (pn < 15) {
            bf16* dst = (bf16*)(ws + WS_ZA);
#pragma unroll
            for (int ai = 0; ai < 2; ++ai)
#pragma unroll
                for (int m = 0; m < 4; ++m) { const int row = rbase + ai * 128 + m * 16; const float rs = rstd[row];
#pragma unroll
                    for (int bj = 0; bj < 2; ++bj)
#pragma unroll
                        for (int n = 0; n < 2; ++n) { const f32x4 z = acc[ai][bj][m][n] * rs; v2u w; w.x = pk2(z.x * sigmoidf(z.x), z.y * sigmoidf(z.y)); w.y = pk2(z.z * sigmoidf(z.z), z.w * sigmoidf(z.w));
                            *(GAS v2u*)(dst + (size_t)row * 512 + 256 * (pn - 13) + 128 * bj + 32 * wc + 16 * n + 4 * fq) = w; } }
        } else {
            if (wc == 0) { float* dst = (float*)(ws + WS_GATE);
#pragma unroll
                for (int ai = 0; ai < 2; ++ai)
#pragma unroll
                    for (int m = 0; m < 4; ++m) { const int row = rbase + ai * 128 + m * 16; const float rs = rstd[row];
#pragma unroll
                        for (int n = 0; n < 2; ++n) { const int c0 = 16 * n + 4 * fq; if (c0 < 24) { const f32x4 z = acc[ai][0][m][n] * rs;
                            *(GAS f32x4*)(dst + (size_t)row * 24 + c0) = (f32x4){sigmoidf(z.x), sigmoidf(z.y), sigmoidf(z.z), sigmoidf(z.w)}; } } } }
        }
    }
};
struct EpiOut {
    static constexpr bool PERM = false, AFTER_DRAIN = false;
    const float* x; float* y;
    __device__ __forceinline__ void operator()(const f32x4 (&acc)[2][2][4][2], const pg8::Unit& u, int wr, int wc, int fr, int fq) const {
        asm volatile("" : "+v"(fr), "+v"(fq));
#pragma unroll
        for (int ai = 0; ai < 2; ++ai)
#pragma unroll
            for (int m = 0; m < 4; ++m) { const size_t row = (size_t)u.pm * 256 + ai * 128 + wr * 64 + m * 16 + fr;
#pragma unroll
                for (int bj = 0; bj < 2; ++bj)
#pragma unroll
                    for (int n = 0; n < 2; ++n) { const size_t off = row * D + u.pn * 256 + 128 * bj + 32 * wc + 16 * n + 4 * fq;
                        *(GAS f32x4*)(y + off) = *(const GAS f32x4*)(x + off) + acc[ai][bj][m][n]; } }
    }
};
template <int MODE>
__device__ __forceinline__ void small_gemm_tile(const Ptrs& P, const bf16* A, const bf16* Bt, int ct, int lane) {
    const int rho = lane & 15, kq = lane >> 4;
    f32x4 acc[2] = {(f32x4){0.f, 0.f, 0.f, 0.f}, (f32x4){0.f, 0.f, 0.f, 0.f}};
    const GAS v4u* a0 = (const GAS v4u*)(A + (size_t)rho * D + 8 * kq); const GAS v4u* a1 = (const GAS v4u*)(A + (size_t)(16 + rho) * D + 8 * kq);
    const GAS v4u* bp = (const GAS v4u*)(Bt + (size_t)(16 * ct + rho) * D + 8 * kq);
#pragma unroll 8
    for (int ks = 0; ks < 32; ++ks) { const bf16x8 bb = __builtin_bit_cast(bf16x8, bp[ks * 4]);
        acc[0] = __builtin_amdgcn_mfma_f32_16x16x32_bf16(bb, __builtin_bit_cast(bf16x8, a0[ks * 4]), acc[0], 0, 0, 0);
        acc[1] = __builtin_amdgcn_mfma_f32_16x16x32_bf16(bb, __builtin_bit_cast(bf16x8, a1[ks * 4]), acc[1], 0, 0, 0); }
#pragma unroll
    for (int rt = 0; rt < 2; ++rt) { const int b = 16 * rt + rho; const int col = 16 * ct + 4 * kq;
        if (MODE == 0) { const float rs = ((const float*)(P.ws + WS_RSTDS))[b]; *(GAS f32x4*)((float*)(P.ws + WS_PROJS) + (size_t)b * NP + col) = acc[rt] * rs; }
        else *(GAS f32x4*)(P.out + O_YS + (size_t)b * D + col) = *(const GAS f32x4*)(P.xs + (size_t)b * D + col) + acc[rt]; }
}
__device__ __forceinline__ int projs_col(int pn, int wc, int d) { return 256 * pn + 128 * (d >> 5) + 32 * wc + (d & 31); }
__device__ __forceinline__ void p2_sample_item(const Ptrs& P, int it, int lane) {
    const int b = it / 37, ty = it - b * 37;
    const float* pr = (const float*)(P.ws + WS_PROJS) + (size_t)b * NP;
    const float* ropes = (const float*)(P.ws + WS_ROPE) + (size_t)8192 * 64;
    float* kvn = (float*)(P.ws + WS_KVN) + (size_t)b * 768;
    if (ty < 14) {
        const bool isq = ty < 8; const int br = isq ? 0 : (ty - 8) >> 1, g = (ty - 8) & 1;
        const int pn = isq ? 8 + (ty >> 2) : 10 + br, wc = isq ? (ty & 3) : g;
        const float v = pr[projs_col(pn, wc, lane)];
        const float ss = wave_sum(v * v); const float inv = 1.0f / sqrtf(ss * (1.0f / 64.0f) + NORM_EPS);
        const float gn = isq ? P.q_gain[lane] : P.k_gain[br * 64 + lane];
        const float xn = v * inv * gn; const float xo = __shfl_xor(xn, 32);
        const int i = lane & 31; const float cs = ropes[i], sn = ropes[32 + i];
        const float o = (lane < 32) ? xn * cs - xo * sn : xn * cs + xo * sn;
        if (isq) ((float*)(P.ws + WS_QS))[(size_t)b * 512 + ty * 64 + lane] = o * QSCALE;
        else { kvn[(br * 2 + 0) * 128 + g * 64 + lane] = o;
            if (br == 0) P.out[O_SCMP + (size_t)b * 256 + g * 64 + lane] = o; else if (br == 1) P.out[O_SSLC + (size_t)b * 256 + g * 64 + lane] = o;
            else P.out[O_SWIN + ((size_t)b * 512 + 511) * 256 + g * 64 + lane] = o; }
    } else if (ty < 20) {
        const int br = (ty - 14) >> 1, g = (ty - 14) & 1; const float v = pr[projs_col(10 + br, 2 + g, lane)];
        kvn[(br * 2 + 1) * 128 + g * 64 + lane] = v;
        if (br == 0) P.out[O_SCMP + (size_t)b * 256 + 128 + g * 64 + lane] = v; else if (br == 1) P.out[O_SSLC + (size_t)b * 256 + 128 + g * 64 + lane] = v;
        else P.out[O_SWIN + ((size_t)b * 512 + 511) * 256 + 128 + g * 64 + lane] = v;
    } else if (ty == 20) {
        if (lane < 24) ((float*)(P.ws + WS_GS))[b * 24 + lane] = sigmoidf(pr[256 * 15 + lane]);
    } else if (ty < 29) {
        const int ch = (ty - 21) * 64 + lane; const int pnb = ch >> 7, tc = ch & 127;
        const float bg = pr[256 * pnb + tc], zc = pr[256 * pnb + 128 + tc], cg = pr[256 * (4 + pnb) + tc], ci = pr[256 * (4 + pnb) + 128 + tc];
        const float u = cg * ci; const float s0 = P.st_conv[(size_t)b * 1024 + ch], s1 = P.st_conv[(size_t)b * 1024 + 512 + ch];
        const float cy = P.conv_w[ch] * s0 + P.conv_w[512 + ch] * s1 + P.conv_w[1024 + ch] * u + P.conv_b[ch];
        ((bf16*)(P.ws + WS_MIXS))[(size_t)b * 1024 + ch] = (bf16)f2bf(bg * cy * zc * sigmoidf(zc));
        P.out[O_SCONV + (size_t)b * 1024 + 512 + ch] = u;
    } else {
        const int col = (ty - 29) * 64 + lane; const float z = pr[256 * (13 + (col >> 8)) + (col & 255)];
        ((float*)(P.ws + WS_ZAS))[(size_t)b * 512 + col] = z * sigmoidf(z);
    }
}
__device__ __forceinline__ void p2_phase(const Ptrs& P, Frame& F) {
    compress_units<false>(P, F, (LAS float*)(F.lds + RING_OFF));
    for (int it = F.gw; it < DECB * 37; it += F.NGW) p2_sample_item(P, it, F.lane);
}
#define MFMA32(a, b, c) __builtin_amdgcn_mfma_f32_32x32x16_bf16(a, b, c, 0, 0, 0)
constexpr int P3_IMP = 0, P3_QL = 32768;
constexpr int P3_NEXT = LDSCTL_OFF + 512, P3_CNT = LDSCTL_OFF + 1024, P3_LISTS = LDSCTL_OFF + 2048, P3_LACC = LDSCTL_OFF + 10240;
constexpr int P3_RING = 65536;
constexpr int P3_MISC = MISC_OFF + 64;
constexpr int SM_Q = 36864, SM_P = 40960, SM_RED = 57344, SM_IMP = 66048, SM_L = 67200, SM_SEL = 67328, SM_O = 67584, SM_VP = 71680  , SM_RED2 = 79872  ;

template <bool MASK>
__device__ __forceinline__ void attend_lds(const LAS unsigned char* blk, const bf16x8 (&qf)[4], f32x16 (&O)[2], float& lsum,
                                           int kbase, int lo, int hi, int lane, bool want_pv, f32x16 (*Sout)[2] = nullptr) {
    const int hh = lane >> 5;
    const LAS unsigned char* kb = blk + lane * 16; const LAS unsigned char* vb = blk + 8192 + lane * 16;
#pragma unroll
    for (int kt = 0; kt < 2; ++kt) {
        f32x16 S;
        { bf16x8 kf[4];
#pragma unroll
          for (int s = 0; s < 4; ++s) kf[s] = *(const LAS bf16x8*)(kb + (kt * 4 + s) * 1024);
#pragma unroll
          for (int i = 0; i < 16; ++i) S[i] = 0.f;
#pragma unroll
          for (int s = 0; s < 4; ++s) S = MFMA32(kf[s], qf[s], S); }
#pragma unroll
        for (int i = 0; i < 16; ++i) { float p = fast_exp2(S[i]);
            if (MASK) { const int kp = kbase + 32 * kt + (i & 3) + 8 * (i >> 2) + 4 * hh; p = (kp >= lo && kp <= hi) ? p : 0.f; }
            S[i] = p; lsum += p; }
        if (Sout) (*Sout)[kt] = S;
        if (want_pv) {
            bf16x8 pf[2];
#pragma unroll
            for (int sp = 0; sp < 2; ++sp) { v4u w; w.x = pk2(S[8 * sp + 0], S[8 * sp + 1]); w.y = pk2(S[8 * sp + 2], S[8 * sp + 3]);
                w.z = pk2(S[8 * sp + 4], S[8 * sp + 5]); w.w = pk2(S[8 * sp + 6], S[8 * sp + 7]); pf[sp] = __builtin_bit_cast(bf16x8, w); }
#pragma unroll
            for (int dt = 0; dt < 2; ++dt)
#pragma unroll
                for (int sp = 0; sp < 2; ++sp) { const bf16x8 vf = *(const LAS bf16x8*)(vb + (dt * 4 + 2 * kt + sp) * 1024);
                    O[dt] = MFMA32(vf, pf[sp], O[dt]); }
        }
    }
}
__device__ __forceinline__ void wave_topk(const LAS float* imp, int jmax, int nsel, int lane, int qbase, LAS unsigned* cnt, LAS unsigned char* lists) {
    if (jmax < 1) return;
    const bool c0 = lane >= 1 && lane <= jmax, c1 = 64 + lane <= jmax;
    unsigned k0[8], k1[8], Tv[8];
#pragma unroll
    for (int qi = 0; qi < 8; ++qi) { k0[qi] = c0 ? ((__builtin_bit_cast(unsigned, imp[qi * 128 + lane]) + 0x800u) & ~0x7ffu) : 0u; k1[qi] = c1 ? ((__builtin_bit_cast(unsigned, imp[qi * 128 + 64 + lane]) + 0x800u) & ~0x7ffu) : 0u; Tv[qi] = 0u; }
    if (jmax > nsel) {
        for (int bit = 30; bit >= 11; --bit) {
#pragma unroll
            for (int qi = 0; qi < 8; ++qi) { const unsigned cand = Tv[qi] | (1u << bit);
                const int cn = __popcll(__ballot(k0[qi] >= cand)) + __popcll(__ballot(k1[qi] >= cand)); Tv[qi] = cn >= nsel ? cand : Tv[qi]; } }
    }
    const unsigned long long below = (lane == 0) ? 0ull : (~0ull >> (64 - lane));
#pragma unroll
    for (int qi = 0; qi < 8; ++qi) {
        bool s0, s1;
        if (jmax > nsel) {
            const unsigned long long g0 = __ballot(k0[qi] > Tv[qi]), g1 = __ballot(k1[qi] > Tv[qi]), e0 = __ballot(k0[qi] == Tv[qi]), e1 = __ballot(k1[qi] == Tv[qi]);
            const int need = nsel - __popcll(g0) - __popcll(g1);
            const int rk0 = __popcll(e0 & below), rk1 = __popcll(e0) + __popcll(e1 & below);
            s0 = k0[qi] > Tv[qi] || (k0[qi] == Tv[qi] && rk0 < need); s1 = k1[qi] > Tv[qi] || (k1[qi] == Tv[qi] && rk1 < need);
        } else { s0 = c0; s1 = c1; }
        if (s0) { const unsigned pos = __hip_atomic_fetch_add(cnt + lane, 1u, __ATOMIC_RELAXED, __HIP_MEMORY_SCOPE_WORKGROUP); lists[lane * 64 + pos] = (unsigned char)(qbase + qi); }
        if (s1) { const unsigned pos = __hip_atomic_fetch_add(cnt + 64 + lane, 1u, __ATOMIC_RELAXED, __HIP_MEMORY_SCOPE_WORKGROUP); lists[(64 + lane) * 64 + pos] = (unsigned char)(qbase + qi); }
    }
}
struct BlkSrc { const bf16* img; };
#ifndef PROBE_SEG
#define PROBE_SEG 0
#endif
#define T_BEGIN(id) do { if (PROBE_SEG == (id)) tacc -= __builtin_readcyclecounter(); } while (0)
#define T_END(id) do { if (PROBE_SEG == (id)) tacc += __builtin_readcyclecounter(); } while (0)
__device__ __forceinline__ void p3_prompt_unit(const Ptrs& P, Frame& F, int b, int t, int g, float sh_cmp, float sh_slc, float sh_win, unsigned long long& tacc) {
    int lane = F.lane, w = F.wave, tid = F.tid; asm volatile("" : "+v"(lane), "+s"(w), "+v"(tid));
    const int col = lane & 31, hh = lane >> 5, qi = col >> 2, h = col & 3;
    const int tok = 64 * t + 8 * w + qi; const size_t row = (size_t)b * T + tok; const int qpos = tok;
    const int nck = (2 * t + 2 + 63) >> 6, nf = t >= 2 ? 3 : t + 1, nw = t >= 8 ? 9 : t + 1;
    const int n1 = nck, n2 = 2 * nck, N1 = n2 + nf;
    const bf16* KC = (const bf16*)(P.ws + WS_KC) + (size_t)(b * 2 + g) * 4 * 8192;
    const bf16* KS = (const bf16*)(P.ws + WS_KS) + (size_t)(b * 2 + g) * 128 * 8192;
    const bf16* KW = (const bf16*)(P.ws + WS_KW) + (size_t)(b * 2 + g) * 128 * 8192;
    auto src1 = [&](int n) -> BlkSrc {
        if (n < n2) { const int ck = n < n1 ? n : n - n1; return BlkSrc{KC + (size_t)ck * 8192}; }
        const int f = n - n2; const int j = f == 0 ? t : (f == 1 ? 0 : t - 1); return BlkSrc{KS + (size_t)j * 8192}; };
    auto src2 = [&](int n) -> BlkSrc { const int j = (t >= 8 ? t - 8 : 0) + n; return BlkSrc{KW + (size_t)j * 8192}; };
    LAS unsigned char* ring = F.lds + P3_RING;
#define ST_DMA(bs_, n) do { LAS unsigned char* d_ = ring + ((n) & 3) * 16384 + w * 2048; \
        __builtin_amdgcn_global_load_lds((const unsigned*)((bs_).img + (2 * w) * 512 + lane * 8), (LAS unsigned*)d_, 16, 0, 0); \
        __builtin_amdgcn_global_load_lds((const unsigned*)((bs_).img + (2 * w + 1) * 512 + lane * 8), (LAS unsigned*)(d_ + 1024), 16, 0, 0); } while (0)
#define BLK(n) (ring + ((n) & 3) * 16384)
#define STEP_BEGIN(SRC, n, NN) do { if (((n) & 1) == 0) { if ((n) + 2 < (NN)) { const BlkSrc b_ = SRC((n) + 2); ST_DMA(b_, (n) + 2); } if ((n) + 3 < (NN)) { const BlkSrc b_ = SRC((n) + 3); ST_DMA(b_, (n) + 3); } } } while (0)
#define STEP_END(n, NN) do { if (((n) & 1) == 1 || (n) == (NN) - 1) { asm volatile("s_waitcnt vmcnt(0)" ::: "memory"); __syncthreads(); } } while (0)
    LAS unsigned* cnt = (LAS unsigned*)(F.lds + P3_CNT); LAS unsigned char* lists = F.lds + P3_LISTS; LAS unsigned* nextb = (LAS unsigned*)(F.lds + P3_NEXT);
    LAS int* oacc = (LAS int*)ring; LAS int* lacc = (LAS int*)(F.lds + P3_LACC);
    const float FXS = slc_vscale(sh_slc), FXI = 1.0f / FXS;
    LAS unsigned char* ql = F.lds + P3_QL;
    T_BEGIN(1); T_BEGIN(8);
    __syncthreads();
    if (tid < 128) cnt[tid] = 0u; if (tid == 128) nextb[0] = 0u;
    { const BlkSrc b0 = src1(0); ST_DMA(b0, 0); if (N1 > 1) { const BlkSrc b1 = src1(1); ST_DMA(b1, 1); } }
    { const bf16* qg = (const bf16*)(P.ws + WS_Q) + ((size_t)b * T + 64 * t) * 512 + g * 256;
      v4u tq[4];
#pragma unroll
      for (int k = 0; k < 4; ++k) { const int c = tid + 512 * k, rq = c >> 3, ch = c & 7; tq[k] = *(const GAS v4u*)(qg + (size_t)(rq >> 2) * 512 + (rq & 3) * 64 + ch * 8); }
#pragma unroll
      for (int k = 0; k < 4; ++k) { const int c = tid + 512 * k, rq = c >> 3, ch = c & 7; *(LAS v4u*)(ql + rq * 128 + ((ch ^ ((rq >> 1) & 7)) << 4)) = tq[k]; } }
    bf16x8 qf[4];
    { const bf16* q = (const bf16*)(P.ws + WS_Q) + row * 512 + (g * 4 + h) * 64 + 8 * hh;
#pragma unroll
      for (int s = 0; s < 4; ++s) qf[s] = __builtin_bit_cast(bf16x8, *(const GAS v4u*)(q + 16 * s)); }
    const float* gate = (const float*)(P.ws + WS_GATE) + row * 24 + (g * 4 + h) * 3;
    const float g_cmp = gate[0], g_slc = gate[1], g_win = gate[2];
    asm volatile("s_waitcnt vmcnt(0)" ::: "memory"); __syncthreads();
    T_END(1); T_BEGIN(2);
    f32x16 O[2];
    LAS float* wl = (LAS float*)(F.lds + P3_IMP + w * 4096);
    LAS float* xw0 = (LAS float*)(F.lds + P3_IMP + w * 4096) + lane;
    f32x16 totr;
    const int nvis = (qpos + 1) >> 5;
    int n = 0;
    float lsum = 0.f;
    for (; n < n1; ++n) { STEP_BEGIN(src1, n, N1); attend_lds<true>(BLK(n), qf, O, lsum, 64 * n, 0, nvis - 1, lane, false); STEP_END(n, N1); }
    lsum += __shfl_xor(lsum, 32);
    const float rl = lsum > 0.f ? 1.0f / lsum : 0.f;
    for (int i = lane; i < 1024; i += 64) wl[i] = 0.f;
#pragma unroll
    for (int i = 0; i < 16; ++i) { O[0][i] = 0.f; O[1][i] = 0.f; }
    { float dummy = 0.f;
      for (; n < n2; ++n) { STEP_BEGIN(src1, n, N1); const int ck = n - n1; f32x16 Sn[2];
        attend_lds<true>(BLK(n), qf, O, dummy, 64 * ck, 0, nvis - 1, lane, true, &Sn);
#pragma unroll
        for (int kt = 0; kt < 2; ++kt)
#pragma unroll
            for (int i2 = 0; i2 < 8; ++i2) { const float v = quad_sum((Sn[kt][2 * i2] + Sn[kt][2 * i2 + 1]) * rl);
                if (h == 0) wl[qi * 128 + 32 * ck + 16 * kt + (i2 & 1) + 4 * (i2 >> 1) + 2 * hh] = v; }
        STEP_END(n, N1); } }
    LDS_WAIT(); asm volatile("" ::: "memory");
    T_END(2); T_BEGIN(3);
    wave_topk(wl, t - 2, 13, lane, 8 * w, cnt, lists);
    LDS_WAIT(); asm volatile("" ::: "memory");
#pragma unroll
    for (int i = 0; i < 16; ++i) { xw0[i * 64] = O[0][i] * (g_cmp * rl); totr[i] = O[1][i] * (g_cmp * rl); O[0][i] = 0.f; O[1][i] = 0.f; }
    T_END(3); T_BEGIN(4);
    lsum = 0.f;
    for (; n < N1; ++n) { STEP_BEGIN(src1, n, N1);
        if (n == n2) attend_lds<true>(BLK(n), qf, O, lsum, 64 * t, 0, qpos, lane, true);
        else attend_lds<false>(BLK(n), qf, O, lsum, 0, 0, 0, lane, true);
        STEP_END(n, N1); }
    lsum += __shfl_xor(lsum, 32);
#pragma unroll
    for (int dt = 0; dt < 2; ++dt)
#pragma unroll
        for (int i = 0; i < 16; ++i) oacc[(32 * dt + (i & 3) + 8 * (i >> 2) + 4 * hh) * 256 + 32 * w + col] = (int)O[dt][i];
    if (hh == 0) lacc[32 * w + col] = __float2int_rn(lsum * FXS);
    __syncthreads();
    T_END(4); T_BEGIN(5);
    if (t > 2) {
        const int r = lane & 31;
#define NEXT_BLOCK(jv_, nq_) do { for (;;) { unsigned t_ = 0u; if (lane == 0) t_ = __hip_atomic_fetch_add(nextb, 1u, __ATOMIC_RELAXED, __HIP_MEMORY_SCOPE_WORKGROUP); \
            jv_ = 1 + (int)__builtin_amdgcn_readfirstlane(t_); if (jv_ > t - 2) { nq_ = 0; break; } nq_ = (int)__builtin_amdgcn_readfirstlane(cnt[jv_]); if (nq_ > 0) break; } } while (0)
#define LOAD_FRAGS(kd_, vd_, jv_) do { const bf16* im_ = KS + (size_t)(jv_) * 8192 + lane * 8;     \
            _Pragma("unroll") for (int a_ = 0; a_ < 2; ++a_) _Pragma("unroll") for (int b_ = 0; b_ < 4; ++b_) { kd_[a_][b_] = __builtin_bit_cast(bf16x8, *(const GAS v4u*)(im_ + (a_ * 4 + b_) * 512)); \
                vd_[a_][b_] = __builtin_bit_cast(bf16x8, *(const GAS v4u*)(im_ + 4096 + (a_ * 4 + b_) * 512)); } } while (0)
        bf16x8 kf[2][4], vf[2][4];
        for (;;) {
            T_BEGIN(10); int j, nq; NEXT_BLOCK(j, nq);
            if (j > t - 2) { T_END(10); break; }
            LOAD_FRAGS(kf, vf, j);
#pragma unroll
            for (int a_ = 0; a_ < 2; ++a_)
#pragma unroll
                for (int b_ = 0; b_ < 4; ++b_) asm volatile("" : "+v"(kf[a_][b_]), "+v"(vf[a_][b_])); T_END(10);
            for (int c0 = 0; c0 < nq; c0 += 8) { T_BEGIN(11);
                const int sl = c0 + qi; const bool valid = sl < nq;
                const int rowq = (int)lists[j * 64 + (valid ? sl : nq - 1)] * 4 + h;
                const LAS unsigned char* qp = ql + rowq * 128; const int qsw = (rowq >> 1) & 7;
                bf16x8 q2[4];
#pragma unroll
                for (int s = 0; s < 4; ++s) q2[s] = *(const LAS bf16x8*)(qp + (((2 * s + hh) ^ qsw) << 4));
                float l2 = 0.f; bf16x8 pf[4]; f32x16 S0, S1;
#pragma unroll
                for (int i = 0; i < 16; ++i) { S0[i] = 0.f; S1[i] = 0.f; }
#pragma unroll
                for (int s = 0; s < 4; ++s) { S0 = MFMA32(kf[0][s], q2[s], S0); S1 = MFMA32(kf[1][s], q2[s], S1); }
#pragma unroll
                for (int i = 0; i < 16; ++i) { S0[i] = fast_exp2(S0[i]); l2 += S0[i]; }
#pragma unroll
                for (int sp = 0; sp < 2; ++sp) { v4u wv; wv.x = pk2(S0[8 * sp + 0], S0[8 * sp + 1]); wv.y = pk2(S0[8 * sp + 2], S0[8 * sp + 3]);
                    wv.z = pk2(S0[8 * sp + 4], S0[8 * sp + 5]); wv.w = pk2(S0[8 * sp + 6], S0[8 * sp + 7]); pf[sp] = __builtin_bit_cast(bf16x8, wv); }
#pragma unroll
                for (int i = 0; i < 16; ++i) { S1[i] = fast_exp2(S1[i]); l2 += S1[i]; }
#pragma unroll
                for (int sp = 0; sp < 2; ++sp) { v4u wv; wv.x = pk2(S1[8 * sp + 0], S1[8 * sp + 1]); wv.y = pk2(S1[8 * sp + 2], S1[8 * sp + 3]);
                    wv.z = pk2(S1[8 * sp + 4], S1[8 * sp + 5]); wv.w = pk2(S1[8 * sp + 6], S1[8 * sp + 7]); pf[2 + sp] = __builtin_bit_cast(bf16x8, wv); }
                T_END(11); T_BEGIN(9);
#pragma unroll
                for (int dt = 0; dt < 2; ++dt) { f32x16 O2;
#pragma unroll
                    for (int i = 0; i < 16; ++i) O2[i] = 0.f;
#pragma unroll
                    for (int ks = 0; ks < 4; ++ks) O2 = MFMA32(vf[dt][ks], pf[ks], O2);
                    if (valid) {
#pragma unroll
                        for (int i = 0; i < 16; ++i) (void)__hip_atomic_fetch_add(oacc + (32 * dt + (i & 3) + 8 * (i >> 2) + 4 * hh) * 256 + rowq, (int)O2[i], __ATOMIC_RELAXED, __HIP_MEMORY_SCOPE_WORKGROUP); } }
                if (valid) {
                    (void)__hip_atomic_fetch_add(lacc + rowq, __float2int_rn(l2 * FXS), __ATOMIC_RELAXED, __HIP_MEMORY_SCOPE_WORKGROUP); }
                if (PROBE_SEG == 9) LDS_WAIT(); T_END(9);
            }
        }
#undef NEXT_BLOCK
#undef LOAD_FRAGS
    }
    __syncthreads();
    T_END(5); T_BEGIN(6);
    LAS float* x0 = (LAS float*)(F.lds + P3_IMP + w * 4096) + lane; LAS float* x1 = (LAS float*)(F.lds + P3_QL + w * 4096) + lane;
    { const float sc = g_slc / fmaxf((float)lacc[32 * w + col] * FXI, 1e-30f);
#pragma unroll
      for (int i = 0; i < 16; ++i) { const int dr = (i & 3) + 8 * (i >> 2) + 4 * hh;
          x0[i * 64] = x0[i * 64] + (float)oacc[dr * 256 + 32 * w + col] * (FXI * sc); x1[i * 64] = totr[i] + (float)oacc[(32 + dr) * 256 + 32 * w + col] * (FXI * sc); O[0][i] = 0.f; O[1][i] = 0.f; } }
    LDS_WAIT(); __syncthreads();
    { const BlkSrc b0 = src2(0); ST_DMA(b0, 0); if (nw > 1) { const BlkSrc b1 = src2(1); ST_DMA(b1, 1); } }
    { asm volatile("" : "+v"(lane));
      const bf16* q = (const bf16*)(P.ws + WS_Q) + row * 512 + (g * 4 + h) * 64 + 8 * hh;
#pragma unroll
      for (int s = 0; s < 4; ++s) qf[s] = __builtin_bit_cast(bf16x8, *(const GAS v4u*)(q + 16 * s)); }
    asm volatile("s_waitcnt vmcnt(0)" ::: "memory"); __syncthreads();
    lsum = 0.f;
    for (n = 0; n < nw; ++n) { STEP_BEGIN(src2, n, nw); const int j = (t >= 8 ? t - 8 : 0) + n;
        if (j == t || j + 8 == t) attend_lds<true>(BLK(n), qf, O, lsum, 64 * j, qpos - 511, qpos, lane, true);
        else attend_lds<false>(BLK(n), qf, O, lsum, 0, 0, 0, lane, true);
        STEP_END(n, nw); }
    lsum += __shfl_xor(lsum, 32);
    { const float sc = g_win / fmaxf(lsum, 1e-30f);
#pragma unroll
      for (int i = 0; i < 16; ++i) { O[0][i] = x0[i * 64] + O[0][i] * sc; O[1][i] = x1[i * 64] + O[1][i] * sc; } }
#undef ST_DMA
#undef BLK
#undef STEP_BEGIN
#undef STEP_END
    T_END(6); T_BEGIN(7);
    asm volatile("" : "+v"(lane));
    const int col_ = lane & 31, hh_ = lane >> 5, h_ = col_ & 3; const size_t row_ = (size_t)b * T + 64 * t + 8 * w + (col_ >> 2);
    const bf16* za = (const bf16*)(P.ws + WS_ZA) + row_ * 512 + (g * 4 + h_) * 64; bf16* mx = (bf16*)(P.ws + WS_MIX) + row_ * 1024 + 512 + (g * 4 + h_) * 64;
#pragma unroll
    for (int dt = 0; dt < 2; ++dt)
#pragma unroll
        for (int i4 = 0; i4 < 4; ++i4) { const int d = 32 * dt + 8 * i4 + 4 * hh_; const v2u z = *(const GAS v2u*)(za + d);
            v2u o; o.x = pk2(O[dt][4 * i4] * bf2f(z.x & 0xffffu), O[dt][4 * i4 + 1] * bf2f(z.x >> 16)); o.y = pk2(O[dt][4 * i4 + 2] * bf2f(z.y & 0xffffu), O[dt][4 * i4 + 3] * bf2f(z.y >> 16));
            *(GAS v2u*)(mx + d) = o; }
    if (g == 0) { const int tq = w, c8 = lane * 8; const size_t r0 = (size_t)b * T + 64 * t + 8 * tq;
        const bf16* U = (const bf16*)(P.ws + WS_U) + c8; const bf16* CGp = (const bf16*)(P.ws + WS_CG) + c8; bf16* mo = (bf16*)(P.ws + WS_MIX) + c8;
        v4u ur[10], cr[8];
        const bool has_prev = (t > 0) || (tq > 0);
#pragma unroll
        for (int i = 0; i < 10; ++i) ur[i] = (i >= 2 || has_prev) ? *(const GAS v4u*)(U + (r0 + i - 2) * 512) : (v4u){0u, 0u, 0u, 0u};
#pragma unroll
        for (int i = 0; i < 8; ++i) cr[i] = *(const GAS v4u*)(CGp + (r0 + i) * 512);
        float w0[8], w1[8], w2[8], cb[8];
#pragma unroll
        for (int e = 0; e < 8; ++e) { w0[e] = P.conv_w[c8 + e]; w1[e] = P.conv_w[512 + c8 + e]; w2[e] = P.conv_w[1024 + c8 + e]; cb[e] = P.conv_b[c8 + e]; }
#pragma unroll
        for (int i = 0; i < 8; ++i) { float o[8];
#pragma unroll
            for (int e = 0; e < 8; ++e) { const int sh_ = (e & 1) * 16; const float a = bf2f((ur[i][e >> 1] >> sh_) & 0xffffu), bb = bf2f((ur[i + 1][e >> 1] >> sh_) & 0xffffu), c = bf2f((ur[i + 2][e >> 1] >> sh_) & 0xffffu);
                o[e] = bf2f((cr[i][e >> 1] >> sh_) & 0xffffu) * (w0[e] * a + w1[e] * bb + w2[e] * c + cb[e]); }
            v4u ov; ov.x = pk2(o[0], o[1]); ov.y = pk2(o[2], o[3]); ov.z = pk2(o[4], o[5]); ov.w = pk2(o[6], o[7]);
            *(GAS v4u*)(mo + (r0 + i) * 1024) = ov; } }
    T_END(7); T_END(8);
}
template <class KeyFn>
__device__ __forceinline__ void sample_branch(Frame& F, int nslots, float shift, const KeyFn& key, LAS float* obr) {
    LAS float* q = (LAS float*)(F.lds + SM_Q); LAS float* Pb = (LAS float*)(F.lds + SM_P); LAS float* red = (LAS float*)(F.lds + SM_RED); LAS float* lsm = (LAS float*)(F.lds + SM_L);
    LAS unsigned long long* vptr = (LAS unsigned long long*)(F.lds + SM_VP);
    float lacc[4] = {0.f, 0.f, 0.f, 0.f};
    for (int s = F.tid; s < nslots; s += 512) { const float* kp; const float* vp; const bool valid = key(s, kp, vp);
        float sc[4] = {0.f, 0.f, 0.f, 0.f};
        if (valid) {
#pragma unroll 8
            for (int d4 = 0; d4 < 16; ++d4) { const f32x4 kv = *(const GAS f32x4*)(kp + 4 * d4);
#pragma unroll
                for (int hq = 0; hq < 4; ++hq) { const f32x4 qv = *(const LAS f32x4*)(q + hq * 64 + 4 * d4); sc[hq] += (kv.x * qv.x + kv.y * qv.y) + (kv.z * qv.z + kv.w * qv.w); } } }
        f32x4 p;
#pragma unroll
        for (int hq = 0; hq < 4; ++hq) { p[hq] = valid ? fast_exp2(sc[hq] - shift) : 0.f; lacc[hq] += p[hq]; }
        *(LAS f32x4*)(Pb + 4 * s) = p; vptr[s] = (unsigned long long)(uintptr_t)vp; }
#pragma unroll
    for (int hq = 0; hq < 4; ++hq) { lacc[hq] = wave_sum(lacc[hq]); if (F.lane == 0) red[F.wave * 4 + hq] = lacc[hq]; }
    __syncthreads();
    if (F.tid < 4) { float s = 0.f; for (int ww = 0; ww < 8; ++ww) s += red[ww * 4 + F.tid]; lsm[F.tid] = s; }
    const int sg = F.tid >> 4, d4 = F.tid & 15;
    f32x4 oa[4];
#pragma unroll
    for (int hq = 0; hq < 4; ++hq) oa[hq] = (f32x4){0.f, 0.f, 0.f, 0.f};
    for (int s0 = sg; s0 < nslots; s0 += 256) {
        f32x4 vv[8], pp[8];
#pragma unroll
        for (int u = 0; u < 8; ++u) { const int s = s0 + 32 * u; const float* vp = (const float*)(uintptr_t)vptr[s]; vv[u] = *(const GAS f32x4*)(vp + 4 * d4); pp[u] = *(const LAS f32x4*)(Pb + 4 * s); }
#pragma unroll
        for (int u = 0; u < 8; ++u) { oa[0] = oa[0] + vv[u] * pp[u].x; oa[1] = oa[1] + vv[u] * pp[u].y; oa[2] = oa[2] + vv[u] * pp[u].z; oa[3] = oa[3] + vv[u] * pp[u].w; } }
    __syncthreads();
    LAS float* red2 = (LAS float*)(F.lds + SM_RED2);
#pragma unroll
    for (int hq = 0; hq < 4; ++hq) *(LAS f32x4*)(red2 + (sg * 4 + hq) * 64 + 4 * d4) = oa[hq];
    __syncthreads();
    if (F.tid < 256) { float s = 0.f;
#pragma unroll 8
        for (int g2 = 0; g2 < 32; ++g2) s += red2[g2 * 256 + F.tid]; obr[F.tid] = s; }
    __syncthreads();
}
__device__ __forceinline__ void p3_sample_unit(const Ptrs& P, Frame& F, int b, int g) {
    asm volatile("" : "+v"(F.tid), "+v"(F.lane), "+s"(F.wave));
    LAS float* q = (LAS float*)(F.lds + SM_Q); LAS float* Pb = (LAS float*)(F.lds + SM_P); LAS float* imp = (LAS float*)(F.lds + SM_IMP); LAS float* lsm = (LAS float*)(F.lds + SM_L);
    LAS int* sel = (LAS int*)(F.lds + SM_SEL); LAS float* osm = (LAS float*)(F.lds + SM_O);
    const float* cst = (const float*)(P.ws + WS_CONST);
    float kcmax = 0.f; for (int e_ = 0; e_ < 4; ++e_) kcmax += __builtin_bit_cast(float, __hip_atomic_load((unsigned*)(P.ws + WS_CTL) + CW_KCMAX + 64 + e_, RLX_AGENT));
    const float sh_cmp = cst[0] * sqrtf(kcmax) * LOG2E * 1.001f, sh_slc = cst[1], sh_win = cst[2];
    if (F.tid < 256) q[F.tid] = ((const float*)(P.ws + WS_QS))[(size_t)b * 512 + g * 256 + F.tid];
    __syncthreads();
    const float* kcs = (const float*)(P.ws + WS_KCS) + (size_t)(b * 2 + g) * 2 * NCS * 64;
    sample_branch(F, NCS, sh_cmp, [&](int s, const float*& kp, const float*& vp) { kp = kcs + (size_t)s * 64; vp = kcs + (size_t)(NCS + s) * 64; return true; }, osm);
    { const f32x4 p = *(const LAS f32x4*)(Pb + 4 * F.tid); float v = p.x / lsm[0] + p.y / lsm[1] + p.z / lsm[2] + p.w / lsm[3]; v += __shfl_xor(v, 1);
      if ((F.tid & 1) == 0) imp[F.tid >> 1] = v; if (F.tid < 4) imp[256 + F.tid] = 0.f; }
    if (F.tid < 256) osm[F.tid] = osm[F.tid] / lsm[F.tid >> 6];
    __syncthreads();
    if (F.wave == 0) { const int lane = F.lane; unsigned k[4];
#pragma unroll
        for (int i = 0; i < 4; ++i) { const int j = lane + 64 * i; k[i] = (j >= 1 && j <= 254) ? __builtin_bit_cast(unsigned, imp[j]) + 1u : 0u; }
        unsigned Tv = 0u;
        for (int bit = 30; bit >= 0; --bit) { const unsigned cand = Tv | (1u << bit); int cnt = 0;
#pragma unroll
            for (int i = 0; i < 4; ++i) cnt += __popcll(__ballot(k[i] >= cand));
            if (cnt >= 13) Tv = cand; }
        int ngt = 0;
#pragma unroll
        for (int i = 0; i < 4; ++i) ngt += __popcll(__ballot(k[i] > Tv));
        const int need = 13 - ngt; const unsigned long long below = (lane == 0) ? 0ull : (~0ull >> (64 - lane));
        int base = 3, eqbase = 0;
        if (lane == 0) { int z_ = 0; asm volatile("" : "+v"(z_)); sel[0] = z_; sel[1] = z_ + 255; sel[2] = z_ + 256; }
#pragma unroll
        for (int i = 0; i < 4; ++i) { const unsigned long long e = __ballot(k[i] == Tv); const int rk = eqbase + __popcll(e & below); const bool on = k[i] > Tv || (k[i] == Tv && rk < need);
            const unsigned long long m = __ballot(on); if (on) sel[base + __popcll(m & below)] = lane + 64 * i; base += __popcll(m); eqbase += __popcll(e); } }
    __syncthreads();
    const float* kvn = (const float*)(P.ws + WS_KVN) + (size_t)b * 768;
    const int* pt = P.page_table + b * NPAGES; const float* cs = P.cache_slc;
    sample_branch(F, 1024, sh_slc, [&](int s, const float*& kp, const float*& vp) { const int j = sel[s >> 6], rr = s & 63;
        if (j == 256) { kp = kvn + (1 * 2 + 0) * 128 + g * 64; vp = kvn + (1 * 2 + 1) * 128 + g * 64; return rr == 0; }
        const float* rowp = cs + ((size_t)pt[j >> 1] * 128 + (j & 1) * 64 + rr) * 256 + g * 64; kp = rowp; vp = rowp + 128; return true; }, osm + 256);
    if (F.tid < 256) osm[256 + F.tid] = osm[256 + F.tid] / lsm[F.tid >> 6];
    __syncthreads();
    const float* stw = P.st_win + (size_t)b * 512 * 256;
    sample_branch(F, 512, sh_win, [&](int s, const float*& kp, const float*& vp) {
        if (s == 511) { kp = kvn + (2 * 2 + 0) * 128 + g * 64; vp = kvn + (2 * 2 + 1) * 128 + g * 64; return true; }
        const float* rowp = stw + (size_t)(s + 1) * 256 + g * 64; kp = rowp; vp = rowp + 128; return true; }, osm + 512);
    if (F.tid < 256) { const int hq = F.tid >> 6, d = F.tid & 63; const float* gs = (const float*)(P.ws + WS_GS) + b * 24 + (g * 4 + hq) * 3;
        const float o = gs[0] * osm[F.tid] + gs[1] * osm[256 + F.tid] + gs[2] * osm[512 + F.tid] / lsm[hq];
        ((bf16*)(P.ws + WS_MIXS))[(size_t)b * 1024 + 512 + (g * 4 + hq) * 64 + d] = (bf16)f2bf(o * ((const float*)(P.ws + WS_ZAS))[(size_t)b * 512 + (g * 4 + hq) * 64 + d]); }
    __syncthreads();
}
__device__ __forceinline__ void p3_phase(const Ptrs& P, Frame& F, int rep) {
    const float* cst = (const float*)(P.ws + WS_CONST);
    float kcmax = 0.f; for (int e_ = 0; e_ < 4; ++e_) kcmax += __builtin_bit_cast(float, __hip_atomic_load((unsigned*)(P.ws + WS_CTL) + CW_KCMAX + e_, RLX_AGENT));
    const float sh_cmp = cst[0] * sqrtf(kcmax) * LOG2E * 1.001f, sh_slc = cst[1], sh_win = cst[2];
    unsigned long long tacc = 0ull;
    volatile LAS int* qw = (volatile LAS int*)(F.lds + P3_MISC);
#ifndef PROBE_P3
#define PROBE_P3 0
#endif
    constexpr int NS_ = PROBE_P3 == 1 ? 16 : 8, PSH_ = PROBE_P3 == 2 ? 1 : 0;
    constexpr int NQ = NS_ + (128 << PSH_);
    const int x0 = (int)(xb_xcc_id() & 7u);
    for (int xi = 0; xi < 8; ++xi) {
        const int x = (x0 + xi) & 7;
        for (;;) {
            __syncthreads();
            if (F.tid == 0) qw[0] = (int)__hip_atomic_fetch_add((unsigned*)(F.ctl + CW_QUEUE + 64 * (x + 8 * rep)), 1u, RLX_AGENT);
            __syncthreads();
            const int idx = qw[0];
            if (idx >= NQ) break;
            if (idx < NS_) p3_sample_unit(P, F, x * 4 + ((idx & 7) >> 1), idx & 1);
            else p3_prompt_unit(P, F, x >> 1, 127 - ((idx - NS_) >> PSH_), x & 1, sh_cmp, sh_slc, sh_win, tacc);
        }
    }
    if (PROBE_SEG != 0 && blockIdx.x == 0) { const unsigned long long t0_ = __builtin_readcyclecounter(); while (__builtin_readcyclecounter() - t0_ < tacc) __builtin_amdgcn_s_sleep(8); }
}
#ifndef MK_N_LAUNCHES
#define MK_N_LAUNCHES 1
#endif
constexpr int N_PHASES = 5;
constexpr int N_LAUNCHES = MK_N_LAUNCHES;
struct Args { Ptrs p; int ph_lo, ph_hi, rep, mode; };
__global__ void __launch_bounds__(NWAVES * 64, 2) nsa_fwd(Args args) {
    extern __shared__ __attribute__((aligned(16))) unsigned char lds[];
    const Ptrs& P = args.p;
    Frame F;
    F.lds = (LAS unsigned char*)lds;
    F.MISC = (volatile LAS unsigned*)(F.lds + MISC_OFF);
    F.tid = threadIdx.x; F.lane = F.tid & 63; F.wave = __builtin_amdgcn_readfirstlane(F.tid >> 6);
    F.G = gridDim.x; F.gw = blockIdx.x * NWAVES + F.wave; F.NGW = F.G * NWAVES;
    F.ctl = (gu32*)(P.ws + WS_CTL);
    for (int u = F.tid; u < (LDS_BYTES - LDSCTL_OFF) / 4; u += NWAVES * 64) ((LAS unsigned*)(F.lds + LDSCTL_OFF))[u] = 0u;
    __syncthreads();
    XcdBarrier bar; bar.bar = (unsigned*)(F.ctl + CW_BAR); bar.x = 0; bar.st = nullptr;
    if (N_LAUNCHES == 1) bar = xcd_barrier_post((unsigned*)(F.ctl + CW_BAR), F.MISC + 8);
    const int lo = args.ph_lo, hi = args.ph_hi;
    unsigned long long tprobe = 0ull;
#define IN(k) (lo <= (k) && (k) < hi)
#define FENCE() do { asm volatile("" : "+s"(F.wave), "+s"(F.gw)); F.lane = (int)__builtin_amdgcn_mbcnt_hi(~0u, __builtin_amdgcn_mbcnt_lo(~0u, 0u)); F.tid = F.wave * 64 + F.lane; asm volatile("" : "+v"(F.tid), "+v"(F.lane)); } while (0)
#define SEAM(k) do { if (IN(k) && IN((k) + 1)) xcd_barrier(bar, F.wave == 0 && (int)__builtin_amdgcn_mbcnt_hi(~0u, __builtin_amdgcn_mbcnt_lo(~0u, 0u)) == 0); } while (0)

    if (IN(0)) { FENCE(); p0_phase(P, F); } SEAM(0);
    if (IN(1)) { FENCE();
        pg8::Gemm g{(const pg8::bf16_t*)(P.ws + WS_XB), (const pg8::bf16_t*)(P.ws + WS_BT1), M, NP, D};
        EpiIn E{(const float*)(P.ws + WS_RSTD), (const float*)(P.ws + WS_ROPE), P.q_gain, P.k_gain, P.out, P.ws};
        const int nround = ((M / 256) * (NP / 256) + F.G - 1) / F.G, kst = ((((int)blockIdx.x >> 3) & 7) * nround) >> 3;
        { pg8::StaticOrder S; S.init(M, NP, F.G, (int)blockIdx.x, 0, kst); pg8::gemm_phase<EpiIn, pg8::StaticOrder, true, true>(F.lds + RING_OFF, g, S, E, F.wave, tprobe); }
        FENCE(); __syncthreads();
        p1_compress(P, F);
        __syncthreads(); FENCE();
        { pg8::StaticOrder S; S.init(M, NP, F.G, (int)blockIdx.x, kst, nround - kst); pg8::gemm_phase<EpiIn, pg8::StaticOrder, true, true>(F.lds + RING_OFF, g, S, E, F.wave, tprobe); }
        FENCE();
        for (int ct = F.gw; ct < NP / 16; ct += F.NGW) small_gemm_tile<0>(P, (const bf16*)(P.ws + WS_XSB), (const bf16*)(P.ws + WS_BT1), ct, F.lane);
#if defined(PROBE_EPI)
        if (PROBE_EPI == 1 && blockIdx.x == 0) { const unsigned long long t0_ = __builtin_readcyclecounter(); while (__builtin_readcyclecounter() - t0_ < tprobe) __builtin_amdgcn_s_sleep(8); }
        tprobe = 0ull;
#endif
    } SEAM(1);
    if (IN(2)) { FENCE(); p2_phase(P, F); } SEAM(2);
    if (IN(3)) { FENCE(); p3_phase(P, F, args.rep); } SEAM(3);
    if (IN(4)) { FENCE();
        pg8::Gemm g{(const pg8::bf16_t*)(P.ws + WS_MIX), (const pg8::bf16_t*)(P.ws + WS_BT2), M, D, D}; pg8::StaticOrder S; S.init(M, D, F.G, (int)blockIdx.x);
        EpiOut E{P.xp, P.out + O_Y};
        pg8::gemm_phase<EpiOut, pg8::StaticOrder, true, true>(F.lds + RING_OFF, g, S, E, F.wave, tprobe);
        FENCE();
        for (int ct = F.gw; ct < D / 16; ct += F.NGW) small_gemm_tile<1>(P, (const bf16*)(P.ws + WS_MIXS), (const bf16*)(P.ws + WS_BT2), ct, F.lane);
#if defined(PROBE_EPI)
        if (PROBE_EPI == 2 && blockIdx.x == 0) { const unsigned long long t0_ = __builtin_readcyclecounter(); while (__builtin_readcyclecounter() - t0_ < tprobe) __builtin_amdgcn_s_sleep(8); }
#endif
    }
#undef IN
#undef SEAM
}

extern "C" void kernel_launch(void* const* d_in, const int* in_sizes, int n_in, void* d_out, int out_size, void* d_ws, size_t ws_size, hipStream_t stream) {
    static int grid = 0;
    if (grid == 0) {
        if (n_in != 16 || out_size != (int)O_END || ws_size < WS_END) { fprintf(stderr, "kernel_launch: unexpected shapes (n_in %d, out %d, ws %zu)\n", n_in, out_size, ws_size); grid = -1; return; }
        int dev = 0, cus = 0, per_cu = 0;
        if (hipGetDevice(&dev) != hipSuccess || hipDeviceGetAttribute(&cus, hipDeviceAttributeMultiprocessorCount, dev) != hipSuccess) { grid = -1; return; }
        if (hipFuncSetAttribute((const void*)nsa_fwd, hipFuncAttributeMaxDynamicSharedMemorySize, LDS_BYTES) != hipSuccess) { fprintf(stderr, "kernel_launch: hipFuncSetAttribute failed\n"); grid = -1; return; }
        if (hipOccupancyMaxActiveBlocksPerMultiprocessor(&per_cu, (const void*)nsa_fwd, NWAVES * 64, LDS_BYTES) != hipSuccess || per_cu < 1)
            fprintf(stderr, "kernel_launch: note: occupancy query reports %d workgroups per CU\n", per_cu);
        (void)hipGetLastError();
        grid = cus;
    }
    if (grid < 0) return;
    if (hipMemsetAsync((char*)d_ws + WS_CTL, 0, CTL_ZERO_BYTES, stream) != hipSuccess) return;
    Args a{}; a.mode = 3;
    a.p.xp = (const float*)d_in[0]; a.p.xs = (const float*)d_in[1]; a.p.cache_cmp = (const float*)d_in[2]; a.p.cache_slc = (const float*)d_in[3];
    a.p.st_win = (const float*)d_in[4]; a.p.st_conv = (const float*)d_in[5]; a.p.page_table = (const int*)d_in[6]; a.p.norm_g = (const float*)d_in[7];
    a.p.w_in = (const float*)d_in[8]; a.p.conv_w = (const float*)d_in[9]; a.p.conv_b = (const float*)d_in[10]; a.p.q_gain = (const float*)d_in[11];
    a.p.k_gain = (const float*)d_in[12]; a.p.cmp_pe = (const float*)d_in[13]; a.p.cmp_w = (const float*)d_in[14]; a.p.w_out = (const float*)d_in[15];
    a.p.out = (float*)d_out; a.p.ws = (unsigned char*)d_ws;
#ifndef PROBE_DUP
#define PROBE_DUP -1
#endif
    for (int li = 0; li < N_LAUNCHES; ++li) {
        a.ph_lo = (N_LAUNCHES == 1) ? 0 : li; a.ph_hi = (N_LAUNCHES == 1) ? N_PHASES : li + 1;
        for (int rep = 0; rep < ((N_LAUNCHES > 1 && li == PROBE_DUP) ? 2 : 1); ++rep) {
            a.rep = rep;
            hipLaunchKernelGGL(nsa_fwd, dim3(grid), dim3(NWAVES * 64), LDS_BYTES, stream, a);
            const hipError_t le = hipPeekAtLastError();
            if (le != hipSuccess) { fprintf(stderr, "kernel_launch: launch %d failed: %s\n", li, hipGetErrorName(le)); break; }
        }
    }
}
```

```cpp
#include <hip/hip_runtime.h>
#include <cstdio>
#include <cstdint>
#define GAS __attribute__((address_space(1)))
#define LAS __attribute__((address_space(3)))
typedef unsigned short bf16;
typedef unsigned v4u __attribute__((ext_vector_type(4)));
typedef unsigned v2u __attribute__((ext_vector_type(2)));
typedef float f32x2 __attribute__((ext_vector_type(2)));
typedef float f32x16 __attribute__((ext_vector_type(16)));
typedef GAS unsigned gu32;
typedef GAS unsigned long long gu64;
#define RLX_AGENT __ATOMIC_RELAXED, __HIP_MEMORY_SCOPE_AGENT
#define LDS_WAIT() asm volatile("s_waitcnt lgkmcnt(0)" ::: "memory")
#define VM_WAIT() asm volatile("s_waitcnt vmcnt(0)" ::: "memory")
#define MK_N_LAUNCHES 1
#define PROBE_DUP -1
#define PROBE_P3 0
#define PROBE_SEG 0
namespace pg8 {
#define PG8_LAS __attribute__((address_space(3)))
typedef unsigned short bf16_t;
typedef short bf16x8 __attribute__((ext_vector_type(8)));
typedef float f32x4 __attribute__((ext_vector_type(4)));
typedef unsigned u32x4 __attribute__((ext_vector_type(4)));
constexpr int BM = 256, BK = 64, HALF = 128, HTB = HALF * BK * 2  , STAGE_BYTES = 8 * HTB, NXCD = 8, WGM = 8;

__host__ __device__ __forceinline__ int lds_byte(int r, int c) { const int st = (r >> 4) * 2 + (c >> 5), rr = r & 15, cc = c & 31, ob = rr * 64 + cc * 2; return st * 1024 + (ob ^ (((ob >> 9) & 1) << 5)); }
__host__ __device__ __forceinline__ void stage_rc(int b, int& R, int& C) { const int st = b / 1024, sb = b % 1024, swz = sb ^ (((sb >> 9) & 1) << 5); R = (st >> 1) * 16 + swz / 64; C = (st & 1) * 32 + (swz % 64) / 2; }
__host__ __device__ __forceinline__ int perm32(int rho) { const int n = rho >> 4, i = rho & 15; return 8 * (i >> 2) + 4 * n + (i & 3); }

struct Unit { int pm, pn; };
struct Gemm { const bf16_t* A; const bf16_t* Bt; int M, N, K; };

struct StaticOrder {
    int nM, nN, nwg, G, c, i0, n;
    __host__ __device__ void init(int M, int N, int G_, int c_, int i0_ = 0, int n_ = 1 << 30) { nM = M / BM; nN = N / BM; nwg = nM * nN; G = G_; c = c_; i0 = i0_; n = n_; }
    __host__ __device__ bool next(int i, Unit& u) const {
        if (i >= n) return false;
        const long L = (long)(i + i0) * G + c; if (L >= nwg) return false;
        int wgid = (int)L; { const int q = nwg / NXCD, r = nwg % NXCD, xcd = wgid % NXCD, off = wgid / NXCD; wgid = (xcd < r ? xcd * (q + 1) : r * (q + 1) + (xcd - r) * q) + off; }
        const int nig = WGM * nN, gid = wgid / nig, fm = gid * WGM, gsz = (nM - fm) < WGM ? (nM - fm) : WGM;
        u.pm = fm + ((wgid % nig) % gsz); u.pn = (wgid % nig) / gsz; return true;
    }
    __device__ __forceinline__ void a_ready(const Unit&) const {}
    __device__ __forceinline__ void done(const Unit&) const {}
};


template <class Epi, class Sched, bool ALIGN_EPI = false, bool SP2 = false>
__device__ __forceinline__ void gemm_phase(PG8_LAS unsigned char* lds, const Gemm g, const Sched& S, const Epi& E, int wave_id  , unsigned long long& tacc_  ) {
    const int lane = (int)__builtin_amdgcn_mbcnt_hi(~0u, __builtin_amdgcn_mbcnt_lo(~0u, 0u)), wid = wave_id, tid = wid * 64 + lane, wr = wid >> 2, wc = wid & 3, fr = lane & 15, fq = lane >> 4;
    const int K = g.K, nt = K / BK;
    unsigned voffA[2], voffB[2];
#pragma unroll
    for (int i = 0; i < 2; ++i) { int R, C; stage_rc(tid * 16 + i * 8192, R, C); const int Rb = Epi::PERM ? ((R & ~31) + perm32(R & 31)) : R;
        voffA[i] = (unsigned)(R * K + C) * 2u; voffB[i] = (unsigned)(Rb * K + C) * 2u; }
    const size_t kstep = (size_t)(BK * 2);
    const size_t hstep = (size_t)HALF * K * 2;
    const size_t tstep = 2 * hstep;
    const unsigned ldsw = (unsigned)wid * 1024u;
    const int aoff = lds_byte(wr * 64 + fr, fq * 8), boff = lds_byte(wc * 32 + fr, fq * 8);
#define PG8_SA(b, h) (((b) * 2 + (h)) * HTB)
#define PG8_SB(b, h) ((4 + (b) * 2 + (h)) * HTB)
#define PG8_STAGE(bufoff, gbase, voff) do { _Pragma("unroll") for (int _i = 0; _i < 2; ++_i) \
        __builtin_amdgcn_global_load_lds((const unsigned*)((const char*)(gbase) + (voff)[_i]), (PG8_LAS unsigned*)(lds + (bufoff) + ldsw + _i * 8192), 16, 0, 0); } while (0)
#define PG8_LDA(dst, b, h) do { _Pragma("unroll") for (int m = 0; m < 4; ++m) _Pragma("unroll") for (int k = 0; k < 2; ++k) dst[m][k] = *(const PG8_LAS bf16x8*)(lds + PG8_SA(b, h) + aoff + m * 2048 + k * 1024); } while (0)
#define PG8_LDB(dst, b, h) do { _Pragma("unroll") for (int n = 0; n < 2; ++n) _Pragma("unroll") for (int k = 0; k < 2; ++k) dst[n][k] = *(const PG8_LAS bf16x8*)(lds + PG8_SB(b, h) + boff + n * 2048 + k * 1024); } while (0)
#define PG8_MMA(ai, bj, At, Bt) do { __builtin_amdgcn_s_setprio(1); _Pragma("unroll") for (int m = 0; m < 4; ++m) _Pragma("unroll") for (int n = 0; n < 2; ++n) _Pragma("unroll") for (int k = 0; k < 2; ++k) \
        acc[ai][bj][m][n] = __builtin_amdgcn_mfma_f32_16x16x32_bf16(Bt[n][k], At[m][k], acc[ai][bj][m][n], 0, 0, 0); __builtin_amdgcn_s_setprio(0); } while (0)
#define PG8_WAIT_V(n) asm volatile("s_waitcnt vmcnt(" #n ")" ::: "memory")
#define PG8_WAIT_L(n) asm volatile("s_waitcnt lgkmcnt(" #n ")" ::: "memory")
#define PG8_BAR __builtin_amdgcn_s_barrier()
#define PG8_SCHED __builtin_amdgcn_sched_barrier(0)
    Unit cur, nxt; int ui = 0;
    if (!S.next(0, cur)) return;
    f32x4 acc[2][2][4][2];
#pragma unroll
    for (int a = 0; a < 2; ++a)
#pragma unroll
        for (int b = 0; b < 2; ++b)
#pragma unroll
            for (int m = 0; m < 4; ++m)
#pragma unroll
                for (int n = 0; n < 2; ++n) acc[a][b][m][n] = (f32x4){0.f, 0.f, 0.f, 0.f};
    bf16x8 At[4][2], B0[2][2], B1[2][2];
    const char* cA = (const char*)g.A + (size_t)cur.pm * tstep; const char* cB = (const char*)g.Bt + (size_t)cur.pn * tstep;
    S.a_ready(cur);
    if constexpr (SP2) {
        PG8_STAGE(PG8_SB(0, 0), cB, voffB); PG8_STAGE(PG8_SB(0, 1), cB + hstep, voffB); PG8_STAGE(PG8_SA(0, 0), cA, voffA); PG8_STAGE(PG8_SA(0, 1), cA + hstep, voffA);
        if (wr == 1) PG8_BAR;
        PG8_WAIT_V(2); PG8_BAR;
        PG8_STAGE(PG8_SB(1, 0), cB + kstep, voffB); PG8_STAGE(PG8_SA(1, 0), cA + kstep, voffA); PG8_STAGE(PG8_SB(1, 1), cB + hstep + kstep, voffB);
        PG8_WAIT_V(6); PG8_BAR;
    } else {
        PG8_STAGE(PG8_SB(0, 0), cB, voffB); PG8_STAGE(PG8_SA(0, 0), cA, voffA); PG8_STAGE(PG8_SB(0, 1), cB + hstep, voffB); PG8_STAGE(PG8_SA(0, 1), cA + hstep, voffA);
        if (wr == 1) PG8_BAR;
        PG8_WAIT_V(4); PG8_BAR;
        PG8_STAGE(PG8_SB(1, 0), cB + kstep, voffB); PG8_STAGE(PG8_SA(1, 0), cA + kstep, voffA); PG8_STAGE(PG8_SB(1, 1), cB + hstep + kstep, voffB);
        PG8_WAIT_V(6); PG8_BAR;
    }
    for (;;) {
        const bool has_next = S.next(ui + 1, nxt);
        const char* nA = has_next ? (const char*)g.A + (size_t)nxt.pm * tstep : cA; const char* nB = has_next ? (const char*)g.Bt + (size_t)nxt.pn * tstep : cB;
        for (int t = 0; t < nt; t += 2) {
            const bool last = (t == nt - 2);
            const char* a1 = cA + (size_t)(t + 1) * kstep;
            const char* a2 = last ? nA : cA + (size_t)(t + 2) * kstep; const char* b2 = last ? nB : cB + (size_t)(t + 2) * kstep;
            const char* a3 = a2 + kstep; const char* b3 = b2 + kstep;
            if (last && has_next) S.a_ready(nxt);
            if constexpr (SP2) {
            PG8_LDB(B0, 0, 0); PG8_LDB(B1, 0, 1); PG8_SCHED; PG8_LDA(At, 0, 0); PG8_STAGE(PG8_SA(1, 1), a1 + hstep, voffA);
            PG8_WAIT_V(8); PG8_WAIT_L(0); PG8_BAR; PG8_MMA(0, 0, At, B0); PG8_MMA(0, 1, At, B1); PG8_BAR; PG8_SCHED;
            PG8_LDA(At, 0, 1); PG8_STAGE(PG8_SB(0, 0), b2, voffB); PG8_STAGE(PG8_SB(0, 1), b2 + hstep, voffB); PG8_STAGE(PG8_SA(0, 0), a2, voffA);
            PG8_WAIT_V(8); PG8_WAIT_L(0); PG8_BAR; PG8_MMA(1, 0, At, B0); PG8_MMA(1, 1, At, B1); PG8_BAR; PG8_SCHED;
            PG8_LDB(B0, 1, 0); PG8_LDB(B1, 1, 1); PG8_SCHED; PG8_LDA(At, 1, 0); PG8_STAGE(PG8_SA(0, 1), a2 + hstep, voffA);
            PG8_WAIT_V(8); PG8_WAIT_L(0); PG8_BAR; PG8_MMA(0, 0, At, B0); PG8_MMA(0, 1, At, B1); PG8_BAR; PG8_SCHED;
            PG8_LDA(At, 1, 1); PG8_STAGE(PG8_SB(1, 0), b3, voffB); PG8_STAGE(PG8_SB(1, 1), b3 + hstep, voffB); PG8_STAGE(PG8_SA(1, 0), a3, voffA);
            PG8_WAIT_V(8); PG8_WAIT_L(0); PG8_BAR; PG8_MMA(1, 0, At, B0); PG8_MMA(1, 1, At, B1); PG8_BAR; PG8_SCHED;
            } else {
            PG8_LDB(B0, 0, 0); PG8_SCHED; PG8_LDA(At, 0, 0); PG8_STAGE(PG8_SA(1, 1), a1 + hstep, voffA);
            PG8_WAIT_L(8); PG8_BAR; PG8_WAIT_L(0); PG8_MMA(0, 0, At, B0); PG8_BAR; PG8_SCHED;
            PG8_LDB(B1, 0, 1); PG8_STAGE(PG8_SB(0, 0), b2, voffB);
            PG8_BAR; PG8_WAIT_L(0); PG8_MMA(0, 1, At, B1); PG8_BAR;
            PG8_LDA(At, 0, 1); PG8_STAGE(PG8_SA(0, 0), a2, voffA);
            PG8_BAR; PG8_WAIT_L(0); PG8_MMA(1, 0, At, B0); PG8_BAR; PG8_SCHED;
            PG8_STAGE(PG8_SB(0, 1), b2 + hstep, voffB);
            PG8_WAIT_V(6); PG8_BAR; PG8_MMA(1, 1, At, B1); PG8_BAR;
            PG8_LDB(B0, 1, 0); PG8_SCHED; PG8_LDA(At, 1, 0); PG8_STAGE(PG8_SA(0, 1), a2 + hstep, voffA);
            PG8_WAIT_L(8); PG8_BAR; PG8_WAIT_L(0); PG8_MMA(0, 0, At, B0); PG8_BAR; PG8_SCHED;
            PG8_LDB(B1, 1, 1); PG8_STAGE(PG8_SB(1, 0), b3, voffB);
            PG8_BAR; PG8_WAIT_L(0); PG8_MMA(0, 1, At, B1); PG8_BAR;
            PG8_LDA(At, 1, 1); PG8_STAGE(PG8_SA(1, 0), a3, voffA);
            PG8_BAR; PG8_WAIT_L(0); PG8_MMA(1, 0, At, B0); PG8_BAR; PG8_SCHED;
            PG8_STAGE(PG8_SB(1, 1), b3 + hstep, voffB);
            PG8_WAIT_V(6); PG8_BAR; PG8_MMA(1, 1, At, B1); PG8_BAR;
            }
        }
        if constexpr (ALIGN_EPI) { if (wr == 0) PG8_BAR; }
#ifdef PROBE_EPI
        { const unsigned long long t0_ = __builtin_readcyclecounter(); E(acc, cur, wr, wc, fr, fq); asm volatile("s_waitcnt vmcnt(0)" ::: "memory"); tacc_ += __builtin_readcyclecounter() - t0_; S.done(cur); }
#else
        if constexpr (!Epi::AFTER_DRAIN) { E(acc, cur, wr, wc, fr, fq); S.done(cur); }
#endif
        if (!has_next) break;
#pragma unroll
        for (int a = 0; a < 2; ++a)
#pragma unroll
            for (int b = 0; b < 2; ++b)
#pragma unroll
                for (int m = 0; m < 4; ++m)
#pragma unroll
                    for (int n = 0; n < 2; ++n) acc[a][b][m][n] = (f32x4){0.f, 0.f, 0.f, 0.f};
        cur = nxt; cA = nA; cB = nB; ++ui;
        if constexpr (ALIGN_EPI) { if (wr == 1) PG8_BAR; }
    }
    PG8_WAIT_V(0);
    if constexpr (!ALIGN_EPI) { if (wr == 0) PG8_BAR; }
    PG8_BAR;
    if constexpr (Epi::AFTER_DRAIN) { E.fused(acc, cur, wr, wc, fr, fq, lds, wid, lane); S.done(cur); }
#undef PG8_SA
#undef PG8_SB
#undef PG8_STAGE
#undef PG8_LDA
#undef PG8_LDB
#undef PG8_MMA
#undef PG8_WAIT_V
#undef PG8_WAIT_L
#undef PG8_BAR
#undef PG8_SCHED
}
}
#define XB_TMO      128
#define XB_XCNT(j)  (256  + 64 * (j))
#define XB_XSUB(j)  (1280 + 64 * (j))
#define XB_XGEN(j)  (2304 + 64 * (j))
#define XB_TOP      3328
#define XB_TOPGEN   3392
#define XCD_BAR_WORDS 3456
#define XB_SPIN_CAP (1u << 18)

__device__ __forceinline__ unsigned xb_ld(unsigned* p)              { return __hip_atomic_load(p, __ATOMIC_RELAXED, __HIP_MEMORY_SCOPE_AGENT); }
__device__ __forceinline__ unsigned xb_add(unsigned* p, unsigned v) { return __hip_atomic_fetch_add(p, v, __ATOMIC_RELAXED, __HIP_MEMORY_SCOPE_AGENT); }
__device__ __forceinline__ unsigned xb_xcc_id() { return (unsigned)__builtin_amdgcn_s_getreg((3 << 11) | 20) & 0xFu; }
#define XB_SPIN(cond, bar) do { unsigned _sp = 0; while (cond) { __builtin_amdgcn_s_sleep(1); \
    if ((++_sp & 255u) == 0u) { if (xb_ld(&(bar)[XB_TMO])) break; if (_sp > XB_SPIN_CAP) { atomicAdd(&(bar)[XB_TMO], 1u); break; } } } } while (0)

struct XcdBarrier {
    unsigned* bar; unsigned x;
    volatile LAS unsigned* st;
};

__device__ __forceinline__ XcdBarrier xcd_barrier_post(unsigned* bar, volatile LAS unsigned* st) {
    XcdBarrier b; b.bar = bar; b.x = xb_xcc_id(); b.st = st;
    if (threadIdx.x == 0) (void)xb_add(&bar[XB_XCNT(b.x)], 1u);
    return b;
}
__device__ __forceinline__ void xcd_barrier_complete(unsigned* bar, unsigned x, unsigned& nloc, unsigned& nx) {
    const unsigned G = gridDim.x * gridDim.y * gridDim.z;
    unsigned sum, cnt, mine, sp = 0u;
    for (;;) {
        sum = 0u; cnt = 0u; mine = 0u;
#pragma unroll
        for (unsigned j = 0; j < 16; ++j) { const unsigned c = xb_ld(&bar[XB_XCNT(j)]); sum += c; cnt += (c > 0u) ? 1u : 0u; mine = (j == x) ? c : mine; }
        if (sum == G) break;
        __builtin_amdgcn_s_sleep(1);
        if ((++sp & 255u) == 0u) { if (xb_ld(&bar[XB_TMO])) break; if (sp > XB_SPIN_CAP) { atomicAdd(&bar[XB_TMO], 1u); break; } }
    }
    nloc = mine > 0u ? mine : 1u; nx = cnt > 0u ? cnt : 1u;
}

__device__ __forceinline__ void xcd_barrier(const XcdBarrier& b, bool leader  ) {
    asm volatile("s_waitcnt vmcnt(0)" ::: "memory");
    __syncthreads();
    if (leader) {
        unsigned* bar = b.bar;
        __builtin_amdgcn_s_waitcnt(0);
        unsigned nloc = b.st[0], nx = b.st[1];
        if (nloc == 0u) { xcd_barrier_complete(bar, b.x, nloc, nx); b.st[0] = nloc; b.st[1] = nx; }
        const unsigned old = xb_add(&bar[XB_XSUB(b.x)], 1u);
        const unsigned gen = old / nloc;
        if (old + 1u == (gen + 1u) * nloc) {
            __builtin_amdgcn_fence(__ATOMIC_RELEASE, "agent");
            asm volatile("s_waitcnt vmcnt(0)" ::: "memory");
            const unsigned og = xb_add(&bar[XB_TOP], 1u);
            const unsigned tg = og / nx;
            if (og + 1u == (tg + 1u) * nx) xb_add(&bar[XB_TOPGEN], 1u);
            else XB_SPIN(xb_ld(&bar[XB_TOPGEN]) == tg, bar);
            __builtin_amdgcn_fence(__ATOMIC_ACQUIRE, "agent");
            xb_add(&bar[XB_XGEN(b.x)], 1u);
            asm volatile("s_waitcnt vmcnt(0)" ::: "memory");
        } else {
            XB_SPIN(xb_ld(&bar[XB_XGEN(b.x)]) == gen, bar);
            __builtin_amdgcn_fence(__ATOMIC_ACQUIRE, "agent");
            asm volatile("s_waitcnt vmcnt(0)" ::: "memory");
        }
    }
    __syncthreads();
}
using pg8::f32x4; using pg8::bf16x8;
constexpr int NWAVES = 8;
constexpr int BATCH = 4, T = 8192, D = 1024, M = BATCH * T, NP = 4096, INW = 3864;
constexpr int DECB = 32, PAST = 16384, NPAGES = 128, NCS = 512  ;
constexpr float NORM_EPS = 1e-6f;
constexpr float LOG2E = 1.4426950408889634f;
constexpr float QSCALE = 0.125f * LOG2E;
constexpr size_t O_Y = 0, O_YS = 33554432, O_PCMP = 33587200, O_PSLC = 41975808, O_PWIN = 50364416, O_PCONV = 50888704,
                 O_SCMP = 50892800, O_SSLC = 50900992, O_SWIN = 50909184, O_SCONV = 55103488, O_END = 55136256;
constexpr int C_BG = 0, C_CG = 512, C_CI = 1024, C_ZC = 1536, C_Q = 2048, C_KV = 2560, C_GL = 3328, C_ZA = 3352;

constexpr size_t MiB = 1u << 20, KiB = 1u << 10;
constexpr size_t WS_CTL = 0, CTL_ZERO_BYTES = 1 * MiB;
constexpr size_t WS_BT1 = 2 * MiB;
constexpr size_t WS_BT2 = 10 * MiB;
constexpr size_t WS_BTC = 12 * MiB;
constexpr size_t WS_CBIAS = 12 * MiB + 512 * KiB;
constexpr size_t WS_CONST = WS_CBIAS + 4 * KiB;
constexpr size_t WS_ROPE = 13 * MiB;
constexpr size_t WS_RSTD = 16 * MiB;
constexpr size_t WS_XSB = 16 * MiB + 256 * KiB;
constexpr size_t WS_RSTDS = WS_XSB + 64 * KiB;
constexpr size_t WS_GATE = 17 * MiB;
constexpr size_t WS_KC = 20 * MiB;
constexpr size_t WS_PROJS = 21 * MiB;
constexpr size_t WS_QS = 22 * MiB;
constexpr size_t WS_KVN = WS_QS + 64 * KiB;
constexpr size_t WS_GS = WS_KVN + 96 * KiB;
constexpr size_t WS_ZAS = WS_GS + 4 * KiB;
constexpr size_t WS_MIXS = WS_ZAS + 64 * KiB;
constexpr size_t WS_KCS = 24 * MiB;
constexpr size_t WS_KS = 40 * MiB, WS_KW = 56 * MiB;
constexpr size_t WS_XB = 72 * MiB;
constexpr size_t WS_CG = 136 * MiB, WS_U = 168 * MiB, WS_ZA = 200 * MiB, WS_Q = 232 * MiB;
constexpr size_t WS_MIX = 264 * MiB;
constexpr size_t WS_TOT = 328 * MiB;
constexpr size_t WS_END = 344 * MiB;
constexpr int CW_TMO = 0, CW_CODE = 1;
constexpr int CW_BAR = 4096;
constexpr int CW_QUEUE = 16384;
constexpr int CW_P0CNT = 18432;
constexpr int CW_KCMAX = 20480;

constexpr int RING_OFF = 0, RING_BYTES = 131072;
constexpr int LDSCTL_OFF = RING_BYTES, MISC_OFF = LDSCTL_OFF + 320;
constexpr int LDS_BYTES = 147456;

__device__ __forceinline__ unsigned f2bf(float f) { unsigned u = __builtin_bit_cast(unsigned, f); return (u + 0x7fffu + ((u >> 16) & 1u)) >> 16; }
typedef __bf16 bf16x2_t __attribute__((ext_vector_type(2)));
__device__ __forceinline__ unsigned pk2(float lo, float hi) { return __builtin_bit_cast(unsigned, __builtin_convertvector((f32x2){lo, hi}, bf16x2_t)); }
__device__ __forceinline__ float bf2f(unsigned h) { return __builtin_bit_cast(float, h << 16); }
__device__ __forceinline__ float wave_sum(float v) {
#pragma unroll
    for (int o = 1; o < 64; o <<= 1) v += __shfl_xor(v, o);
    return v;
}
__device__ __forceinline__ float quad_sum(float v) {
    v += __builtin_bit_cast(float, __builtin_amdgcn_update_dpp(0, __builtin_bit_cast(int, v), 0xB1, 0xF, 0xF, true));
    v += __builtin_bit_cast(float, __builtin_amdgcn_update_dpp(0, __builtin_bit_cast(int, v), 0x4E, 0xF, 0xF, true));
    return v;
}
__device__ __forceinline__ float fast_exp2(float x) { return __builtin_amdgcn_exp2f(x); }
__device__ __forceinline__ float sigmoidf(float x) { return __builtin_amdgcn_rcpf(1.0f + fast_exp2(-x * LOG2E)); }
__device__ __forceinline__ float slc_vscale(float sh_slc) { return fast_exp2(floorf(18.0f - sh_slc)); }
__device__ __forceinline__ int kimg_off(int key, int d) { return ((((key >> 5) * 4 + (d >> 4)) * 64 + ((d >> 3) & 1) * 32 + (key & 31)) << 3) + (d & 7); }
__device__ __forceinline__ int vimg_off(int d, int pos) { return 4096 + ((((d >> 5) * 4 + (pos >> 4)) * 64 + ((pos >> 3) & 1) * 32 + (d & 31)) << 3) + (pos & 7); }
__device__ __forceinline__ int perm16(int kk) { return 8 * ((kk >> 2) & 1) + 4 * (kk >> 3) + (kk & 3); }

struct Ptrs {
    const float *xp, *xs, *cache_cmp, *cache_slc, *st_win, *st_conv; const int* page_table;
    const float *norm_g, *w_in, *conv_w, *conv_b, *q_gain, *k_gain, *cmp_pe, *cmp_w, *w_out;
    float* out; unsigned char* ws;
};
struct Frame {
    LAS unsigned char* lds;
    volatile LAS unsigned* MISC;
    gu32* ctl;
    int tid, lane, wave, G, gw, NGW;
};
__device__ __forceinline__ int bt1_src(int dg, int& nvalid) {
    const int pn = dg >> 3, gi = dg & 7, bj = gi >> 2, wc = gi & 3; nvalid = 32;
    if (pn < 4) return (bj ? C_ZC : C_BG) + 128 * pn + 32 * wc;
    if (pn < 8) return (bj ? C_CI : C_CG) + 128 * (pn - 4) + 32 * wc;
    if (pn < 10) return C_Q + (4 * (pn - 8) + wc) * 64 + 32 * bj;
    if (pn < 13) return C_KV + (pn - 10) * 256 + wc * 64 + 32 * bj;
    if (pn < 15) return C_ZA + 256 * (pn - 13) + 32 * gi;
    nvalid = (gi == 0) ? 24 : 0; return C_GL;
}
__device__ __forceinline__ void p0_transpose_item(const float* W, int ldw, int k0, int src0, int nvalid, const float* ksc, bf16* WT, int ldt, int drow0, LAS float* scr, int lane) {
    const int nn = lane & 31;
#pragma unroll 8
    for (int i = 0; i < 32; ++i) { const int kk = 2 * i + (lane >> 5); float v = 0.f;
        if (nn < nvalid) { v = W[(size_t)(k0 + kk) * ldw + src0 + nn]; if (ksc) v *= ksc[k0 + kk]; }
        scr[kk * 33 + nn] = v; }
    LDS_WAIT(); asm volatile("" ::: "memory");
    const int c = lane & 7;
#pragma unroll
    for (int j = 0; j < 4; ++j) { const int n = (lane >> 3) + 8 * j; const LAS float* s = scr + (8 * c) * 33 + n;
        v4u o; o.x = pk2(s[0 * 33], s[1 * 33]); o.y = pk2(s[2 * 33], s[3 * 33]); o.z = pk2(s[4 * 33], s[5 * 33]); o.w = pk2(s[6 * 33], s[7 * 33]);
        *(GAS v4u*)(WT + (size_t)(drow0 + n) * ldt + k0 + 8 * c) = o; }
    LDS_WAIT(); asm volatile("" ::: "memory");
}
template <int NR>
__device__ __forceinline__ void x_rows_to_bf16(const float* xrow, bf16* orow, float* rstd_out, int lane) {
    f32x4 v[NR][4]; float s[NR];
#pragma unroll
    for (int r = 0; r < NR; ++r)
#pragma unroll
        for (int j = 0; j < 4; ++j) v[r][j] = ((const GAS f32x4*)(xrow + (size_t)r * D) + lane)[64 * j];
#pragma unroll
    for (int r = 0; r < NR; ++r) { s[r] = 0.f;
#pragma unroll
        for (int j = 0; j < 4; ++j) s[r] += (v[r][j].x * v[r][j].x + v[r][j].y * v[r][j].y) + (v[r][j].z * v[r][j].z + v[r][j].w * v[r][j].w); }
#pragma unroll
    for (int o = 1; o < 64; o <<= 1)
#pragma unroll
        for (int r = 0; r < NR; ++r) s[r] += __shfl_xor(s[r], o);
#pragma unroll
    for (int r = 0; r < NR; ++r) { GAS unsigned long long* o8 = (GAS unsigned long long*)(orow + (size_t)r * D) + lane;
#pragma unroll
        for (int j = 0; j < 4; ++j) o8[64 * j] = (unsigned long long)pk2(v[r][j].x, v[r][j].y) | ((unsigned long long)pk2(v[r][j].z, v[r][j].w) << 32);
        if (lane == 0) rstd_out[r] = 1.0f / sqrtf(s[r] * (1.0f / D) + NORM_EPS); }
}
template <class Side>
__device__ __forceinline__ void compress_prompt_units(const Ptrs& P, Frame& F, LAS float* part  , const Side& side  ) {
    constexpr int NUNITS = BATCH * 32 * 2;
    const int lane = F.lane, w = F.wave, rho = lane & 15, kq = lane >> 4;
    const GAS v4u* bfr = (const GAS v4u*)(P.ws + WS_BTC) + lane;
    const float* cbias = (const float*)(P.ws + WS_CBIAS);
    for (int unit = blockIdx.x; unit < NUNITS; unit += F.G) {
        const int j = unit & 1, b = unit >> 6, c0 = ((unit >> 1) & 31) * 8;
        const float* rb = P.out + O_PCMP + ((size_t)b * T + (c0 + (rho >> 1)) * 32) * 256 + j * 128 + (rho & 1) * 64 + 4 * kq;
        f32x4 a[4][4]; bf16x8 bb[4][8];
#pragma unroll
        for (int rr = 0; rr < 4; ++rr) { const int r = 4 * w + rr;
#pragma unroll
            for (int dh = 0; dh < 2; ++dh) { a[rr][2 * dh] = *(const GAS f32x4*)(rb + r * 256 + dh * 32); a[rr][2 * dh + 1] = *(const GAS f32x4*)(rb + r * 256 + dh * 32 + 16); } }
        f32x4 acc[4];
#pragma unroll
        for (int e = 0; e < 4; ++e) acc[e] = (f32x4){0.f, 0.f, 0.f, 0.f};
        if (unit == (int)blockIdx.x) side();
#pragma unroll
        for (int rr = 0; rr < 4; ++rr) { const int r = 4 * w + rr;
#pragma unroll
            for (int dh = 0; dh < 2; ++dh)
#pragma unroll
                for (int et = 0; et < 4; ++et) bb[rr & 1][dh * 4 + et] = __builtin_bit_cast(bf16x8, bfr[(size_t)((((j * 32 + r) * 2 + dh) * 4 + et) * 64)]);
#pragma unroll
            for (int dh = 0; dh < 2; ++dh) { const f32x4 x0 = a[rr][2 * dh], x1 = a[rr][2 * dh + 1];
                v4u wv; wv.x = pk2(x0.x, x0.y); wv.y = pk2(x0.z, x0.w); wv.z = pk2(x1.x, x1.y); wv.w = pk2(x1.z, x1.w);
                const bf16x8 af = __builtin_bit_cast(bf16x8, wv);
#pragma unroll
                for (int et = 0; et < 4; ++et) acc[et] = __builtin_amdgcn_mfma_f32_16x16x32_bf16(af, bb[rr & 1][dh * 4 + et], acc[et], 0, 0, 0); } }
        __syncthreads();
#pragma unroll
        for (int et = 0; et < 4; ++et) *(LAS f32x4*)(part + ((w * 4 + et) * 64 + lane) * 4) = acc[et];
        __syncthreads();
        if (w < 4) { const int et = w, e = 16 * et + rho; f32x4 sum = *(const LAS f32x4*)(part + ((0 * 4 + et) * 64 + lane) * 4);
#pragma unroll
          for (int ww = 1; ww < 8; ++ww) sum = sum + *(const LAS f32x4*)(part + ((ww * 4 + et) * 64 + lane) * 4);
          const float bs = cbias[j * 64 + e];
          float nmax = 0.f;
#pragma unroll
          for (int i = 0; i < 4; ++i) { const int row = 4 * kq + i, c = c0 + (row >> 1), g = row & 1; const float val = sum[i] + bs;
              float q2 = val * val; q2 += __shfl_xor(q2, 1); q2 += __shfl_xor(q2, 2); q2 += __shfl_xor(q2, 4); q2 += __shfl_xor(q2, 8); nmax = fmaxf(nmax, q2);
              bf16* img = (bf16*)(P.ws + WS_KC) + ((size_t)(b * 2 + g) * 4 + (c >> 6)) * 8192;
              if (j == 0) img[kimg_off(c & 63, e)] = (bf16)f2bf(val); else img[vimg_off(e, (c & 48) + perm16(c & 15))] = (bf16)f2bf(val); }
          if (j == 0) { nmax = fmaxf(nmax, __shfl_xor(nmax, 16)); nmax = fmaxf(nmax, __shfl_xor(nmax, 32));
              if (lane == 0) atomicMax((unsigned*)(P.ws + WS_CTL) + CW_KCMAX + et, __builtin_bit_cast(unsigned, nmax)); } }
    }
}
constexpr int P0_PRODUCERS = 641;
__device__ __forceinline__ void p0_small_items(const Ptrs& P, Frame& F) {
    const int lane = F.lane, gw = F.gw;
    if (gw >= P0_PRODUCERS && F.NGW >= P0_PRODUCERS) return;
    for (int item = gw; item < P0_PRODUCERS; item += F.NGW) {
        if (item < 512) { const int it = item * 64 + lane; const int l = it & 63, et = (it >> 6) & 3, dh = (it >> 8) & 1, r = (it >> 9) & 31, j = it >> 14;
            const float* w = P.cmp_w + ((size_t)(r * 2 + j) * 64 + 32 * dh + 4 * (l >> 4)) * 64 + 16 * et + (l & 15);
            v4u o; o.x = pk2(w[0], w[64]); o.y = pk2(w[128], w[192]); o.z = pk2(w[16 * 64], w[17 * 64]); o.w = pk2(w[18 * 64], w[19 * 64]);
            __builtin_amdgcn_raw_buffer_store_b128(o, __builtin_amdgcn_make_buffer_rsrc((void*)(P.ws + WS_BTC), 0, 512 * 1024, 0x00020000), it * 16, 0, 16);
        } else if (item < 640) { const int it = item - 512, j = it >> 6, e = it & 63; float s = 0.f;
            for (int k = lane; k < 2048; k += 64) { const int r = k >> 6, d = k & 63; s += P.cmp_pe[(r * 2 + j) * 64 + d] * P.cmp_w[((size_t)(r * 2 + j) * 64 + d) * 64 + e]; }
            s = wave_sum(s); if (lane == 0) __hip_atomic_store((float*)(P.ws + WS_CBIAS) + it, s, RLX_AGENT);
        } else { float qm = fabsf(P.q_gain[lane]), k1 = fabsf(P.k_gain[64 + lane]), k2 = fabsf(P.k_gain[128 + lane]);
#pragma unroll
            for (int o = 1; o < 64; o <<= 1) { qm = fmaxf(qm, __shfl_xor(qm, o)); k1 = fmaxf(k1, __shfl_xor(k1, o)); k2 = fmaxf(k2, __shfl_xor(k2, o)); }
            if (lane == 0) { float* cst = (float*)(P.ws + WS_CONST); __hip_atomic_store(cst + 0, qm, RLX_AGENT); __hip_atomic_store(cst + 1, 8.0f * qm * k1 * LOG2E * 1.001f, RLX_AGENT); __hip_atomic_store(cst + 2, 8.0f * qm * k2 * LOG2E * 1.001f, RLX_AGENT); } }
        asm volatile("s_waitcnt vmcnt(0)" ::: "memory");
        if (lane == 0) __hip_atomic_fetch_add((unsigned*)(F.ctl + CW_P0CNT), 1u, RLX_AGENT);
    }
}
__device__ __forceinline__ void p0_rope(const Ptrs& P, Frame& F, int gw, int NGW) {
    const int lane = F.lane; const int i = lane & 31;
    const float inv = (float)pow(10000.0, -(double)i / 32.0);
    for (int it = gw * 64 + lane; it < 8193 * 32; it += NGW * 64) { const int p = it >> 5; const int pos = (p == 8192) ? PAST : p;
        const float ang = (float)pos * inv; const double rev = (double)ang * 0.15915494309189535; const float fr = (float)(rev - __builtin_rint(rev));
        float* rt = (float*)(P.ws + WS_ROPE) + (size_t)p * 64; rt[i] = __builtin_amdgcn_cosf(fr); rt[32 + i] = __builtin_amdgcn_sinf(fr); }
}
__device__ __forceinline__ void p0_other_slice(const Ptrs& P, Frame& F, int k, int gw, int NGW, LAS float* scr) {
    const int lane = F.lane;
    if (k < 2) { const int it = gw + k * NGW; if (it < 16 * 128) { const int kb = it >> 7, dg = it & 127; int nv; const int src0 = bt1_src(dg, nv);
        p0_transpose_item(P.w_in, INW, 64 * kb, src0, nv, P.norm_g, (bf16*)(P.ws + WS_BT1), D, 32 * dg, scr, lane); }
    } else if (k == 2) { for (int it = gw; it < 16 * 32; it += NGW) { const int kb = it >> 5, nb = it & 31;
        p0_transpose_item(P.w_out, D, 64 * kb, 32 * nb, 32, nullptr, (bf16*)(P.ws + WS_BT2), D, 32 * nb, scr, lane); }
    } else if (k < 11) { for (int m = (gw + (k - 3) * NGW) * 4; m < M; m += NGW * 4 * 8) x_rows_to_bf16<4>(P.xp + (size_t)m * D, (bf16*)(P.ws + WS_XB) + (size_t)m * D, (float*)(P.ws + WS_RSTD) + m, lane);
    } else if (k == 11) { for (int m = gw; m < DECB; m += NGW) x_rows_to_bf16<1>(P.xs + (size_t)m * D, (bf16*)(P.ws + WS_XSB) + (size_t)m * D, (float*)(P.ws + WS_RSTDS) + m, lane);
        for (int it = gw * 64 + lane; it < DECB * 512; it += NGW * 64) { const int b = it >> 9, ch = it & 511; P.out[O_SCONV + (size_t)b * 1024 + ch] = P.st_conv[(size_t)b * 1024 + 512 + ch]; }
    } else if (k == 12) {
        constexpr int PERB = 511 * 64, TOTAL = DECB * PERB; const GAS f32x4* src = (const GAS f32x4*)P.st_win; GAS f32x4* dst = (GAS f32x4*)(P.out + O_SWIN);
        for (int i0 = gw * 64 + lane; i0 < TOTAL; i0 += NGW * 64 * 8) { f32x4 t[8];
#pragma unroll
            for (int u = 0; u < 8; ++u) { const int i = i0 + u * NGW * 64; if (i < TOTAL) { const int b = i / PERB; t[u] = src[i + 64 * b + 64]; } }
#pragma unroll
            for (int u = 0; u < 8; ++u) { const int i = i0 + u * NGW * 64; if (i < TOTAL) { const int b = i / PERB; dst[i + 64 * b] = t[u]; } } }
    } else if (k == 13) p0_rope(P, F, gw, NGW);
}
constexpr int P0_OTHER_SLICES = 14;
__device__ __forceinline__ void p0_phase(const Ptrs& P, Frame& F) {
    p0_small_items(P, F);
    LAS float* scr = (LAS float*)(F.lds + RING_OFF + F.wave * 16384);
    for (int k = 0; k < P0_OTHER_SLICES; ++k) p0_other_slice(P, F, k, F.gw, F.NGW, scr);
}
constexpr int CW_NS = 4, CW_NPASS = DECB * 8;
#define CW_LOAD(dst, base, r) do { _Pragma("unroll") for (int q_ = 0; q_ < 4; ++q_) { dst[2 * q_] = *(const GAS f32x4*)((base) + (r) * 256 + (q_ >> 1) * 128 + (q_ & 1) * 32); dst[2 * q_ + 1] = *(const GAS f32x4*)((base) + (r) * 256 + (q_ >> 1) * 128 + (q_ & 1) * 32 + 16); } } while (0)
template <int S>
__device__ __forceinline__ void cw_step(f32x4 (&a)[CW_NS][8], v4u (&vb)[4], f32x4 (&acc)[2][4], const float*& rp, int& nr, const GAS v4u*& bp, int& nb, LAS v4u* bdst, const LAS v4u* bl_lane) {
    if constexpr ((S & 1) == 0) {
#pragma unroll
        for (int i = 0; i < 4; ++i) vb[i] = bp[i];
        if (nb < 15) { ++nb; bp += 1024; } asm volatile("" : "+v"(bp));
        __builtin_amdgcn_sched_barrier(0); }
    CW_LOAD(a[(S + CW_NS - 1) % CW_NS], rp, 0); if (nr < 31) { ++nr; rp += 256; } asm volatile("" : "+v"(rp)); __builtin_amdgcn_sched_barrier(0);
    { const LAS v4u* bf = bl_lane + (S >> 1) * 2048 + (S & 1) * 1024;
#pragma unroll
      for (int q_ = 0; q_ < 4; ++q_) { const int j = q_ >> 1; const f32x4 x0 = a[S][2 * q_], x1 = a[S][2 * q_ + 1];
          v4u wv; wv.x = pk2(x0.x, x0.y); wv.y = pk2(x0.z, x0.w); wv.z = pk2(x1.x, x1.y); wv.w = pk2(x1.z, x1.w);
          const bf16x8 af = __builtin_bit_cast(bf16x8, wv);
#pragma unroll
          for (int et = 0; et < 4; ++et) acc[j][et] = __builtin_amdgcn_mfma_f32_16x16x32_bf16(af, __builtin_bit_cast(bf16x8, bf[(q_ * 4 + et) * 64]), acc[j][et], 0, 0, 0); } }
    if constexpr ((S & 1) == 1) {
        LDS_WAIT(); LAS v4u* d_ = bdst + (((S >> 1) + 1) & 1) * 2048;
#pragma unroll
        for (int i = 0; i < 4; ++i) d_[i] = vb[i];
        LDS_WAIT(); asm volatile("" ::: "memory"); __builtin_amdgcn_s_barrier(); asm volatile("" ::: "memory"); }
}
__device__ __forceinline__ void compress_wg(const Ptrs& P, Frame& F, LAS unsigned char* bl  ) {
    const int lane = F.lane, w = F.wave, tid = w * 64 + lane, rho = lane & 15, kq = lane >> 4;
    const int sf = tid >> 4, ssr = sf >> 4, sj = (sf >> 3) & 1, sdh = (sf >> 2) & 1, set_ = sf & 3, sl = (tid & 15) * 4;
    const GAS v4u* bs0 = (const GAS v4u*)(P.ws + WS_BTC) + (size_t)((((sj * 32 + ssr) * 2 + sdh) * 4 + set_) * 64 + sl);
    LAS v4u* bdst = (LAS v4u*)bl + sf * 64 + sl; const LAS v4u* bl_lane = (const LAS v4u*)bl + lane;
    const float* cbias = (const float*)(P.ws + WS_CBIAS);
    for (int pass = blockIdx.x; pass < CW_NPASS; pass += F.G) {
        const int b = pass >> 3, c0 = (pass & 7) * 64 + w * 8;
        const float* rb; { const int c = c0 + (rho >> 1), g = rho & 1; const int page = P.page_table[b * NPAGES + (c >> 2)]; rb = P.cache_cmp + ((size_t)page * 128 + (c & 3) * 32) * 256 + g * 64 + 4 * kq; }
        f32x4 a[CW_NS][8]; v4u vb[4]; f32x4 acc[2][4];
#pragma unroll
        for (int i = 0; i < 4; ++i) vb[i] = bs0[i];
#pragma unroll
        for (int r = 0; r < CW_NS - 1; ++r) CW_LOAD(a[r], rb, r);
        const float* rp = rb + (CW_NS - 1) * 256; const GAS v4u* bp = bs0 + 1024; int nr = CW_NS - 1, nb = 1; asm volatile("" : "+v"(rp), "+v"(bp));
#pragma unroll
        for (int j = 0; j < 2; ++j)
#pragma unroll
            for (int e = 0; e < 4; ++e) acc[j][e] = (f32x4){0.f, 0.f, 0.f, 0.f};
        asm volatile("" ::: "memory"); __builtin_amdgcn_s_barrier(); asm volatile("" ::: "memory");
#pragma unroll
        for (int i = 0; i < 4; ++i) bdst[i] = vb[i];
        LDS_WAIT(); asm volatile("" ::: "memory"); __builtin_amdgcn_s_barrier(); asm volatile("" ::: "memory");
#pragma unroll 1
        for (int it = 0; it < 8; ++it) { cw_step<0>(a, vb, acc, rp, nr, bp, nb, bdst, bl_lane); cw_step<1>(a, vb, acc, rp, nr, bp, nb, bdst, bl_lane);
            cw_step<2>(a, vb, acc, rp, nr, bp, nb, bdst, bl_lane); cw_step<3>(a, vb, acc, rp, nr, bp, nb, bdst, bl_lane); }
        float nmax = 0.f;
#pragma unroll
        for (int i = 0; i < 4; ++i) { const int row = 4 * kq + i, c = c0 + (row >> 1), g = row & 1; float q2 = 0.f;
#pragma unroll
            for (int j = 0; j < 2; ++j)
#pragma unroll
                for (int et = 0; et < 4; ++et) { const int e = 16 * et + rho; const float val = acc[j][et][i] + cbias[j * 64 + e]; if (j == 0) q2 += val * val;
                    ((float*)(P.ws + WS_KCS))[((size_t)((b * 2 + g) * 2 + j) * NCS + c) * 64 + e] = val; }
            q2 += __shfl_xor(q2, 1); q2 += __shfl_xor(q2, 2); q2 += __shfl_xor(q2, 4); q2 += __shfl_xor(q2, 8); nmax = fmaxf(nmax, q2); }
        nmax = fmaxf(nmax, __shfl_xor(nmax, 16)); nmax = fmaxf(nmax, __shfl_xor(nmax, 32));
        if (lane == 0) atomicMax((unsigned*)(P.ws + WS_CTL) + CW_KCMAX + 64, __builtin_bit_cast(unsigned, nmax));
    }
}
struct EpiIn {
    static constexpr bool PERM = false, AFTER_DRAIN = false;
    const float *rstd, *rope, *qg, *kg; float* out; unsigned char* ws;
    __device__ __forceinline__ void operator()(const f32x4 (&acc)[2][2][4][2], const pg8::Unit& u, int wr, int wc, int fr, int fq) const {
        asm volatile("" : "+v"(fr), "+v"(fq));
        const int pn = u.pn; const int rbase = u.pm * 256 + wr * 64 + fr;
        if (pn < 8) {
            const bool bz = pn < 4; bf16* dst = (bf16*)(ws + (bz ? WS_CG : WS_U)); const int col0 = 128 * (pn & 3) + 32 * wc + 4 * fq;
#pragma unroll
            for (int ai = 0; ai < 2; ++ai)
#pragma unroll
                for (int m = 0; m < 4; ++m) { const int row = rbase + ai * 128 + m * 16; const float rs = rstd[row];
#pragma unroll
                    for (int n = 0; n < 2; ++n) { const f32x4 a = acc[ai][0][m][n] * rs, z = acc[ai][1][m][n] * rs; f32x4 o;
                        if (bz) { o.x = a.x * z.x * sigmoidf(z.x); o.y = a.y * z.y * sigmoidf(z.y); o.z = a.z * z.z * sigmoidf(z.z); o.w = a.w * z.w * sigmoidf(z.w); }
                        else o = a * z;
                        v2u w; w.x = pk2(o.x, o.y); w.y = pk2(o.z, o.w);
                        *(GAS v2u*)(dst + (size_t)row * 512 + col0 + 16 * n) = w;
                        if (!bz) { const int t = row & (T - 1); if (t >= T - 2) *(GAS f32x4*)(out + O_PCONV + ((size_t)(row >> 13) * 2 + (t - (T - 2))) * 512 + col0 + 16 * n) = o; } } }
        } else if (pn < 13) {
            const bool isq = pn < 10; const int br = pn - 10; const bool isk = !isq && wc < 2;
            if (isq || isk) {
                const float* gain = isq ? qg : kg + br * 64; float g1[2][4], g2[2][4];
#pragma unroll
                for (int n = 0; n < 2; ++n)
#pragma unroll
                    for (int e = 0; e < 4; ++e) { g1[n][e] = gain[16 * n + 4 * fq + e]; g2[n][e] = gain[32 + 16 * n + 4 * fq + e]; }
#pragma unroll
                for (int ai = 0; ai < 2; ++ai)
#pragma unroll
                    for (int m = 0; m < 4; ++m) { const int row = rbase + ai * 128 + m * 16; const float rs = rstd[row]; const int t = row & (T - 1), b = row >> 13;
                        f32x4 x1[2], x2[2]; float ss = 0.f;
#pragma unroll
                        for (int n = 0; n < 2; ++n) { x1[n] = acc[ai][0][m][n] * rs; x2[n] = acc[ai][1][m][n] * rs;
                            ss += (x1[n].x * x1[n].x + x1[n].y * x1[n].y) + (x1[n].z * x1[n].z + x1[n].w * x1[n].w) + (x2[n].x * x2[n].x + x2[n].y * x2[n].y) + (x2[n].z * x2[n].z + x2[n].w * x2[n].w); }
                        ss += __shfl_xor(ss, 16); ss += __shfl_xor(ss, 32);
                        const float inv = 1.0f / sqrtf(ss * (1.0f / 64.0f) + NORM_EPS);
                        const float* rp = rope + (size_t)t * 64 + 4 * fq;
#pragma unroll
                        for (int n = 0; n < 2; ++n) { const f32x4 cs = *(const GAS f32x4*)(rp + 16 * n), sn = *(const GAS f32x4*)(rp + 32 + 16 * n); f32x4 o1, o2;
#pragma unroll
                            for (int e = 0; e < 4; ++e) { const float a = x1[n][e] * inv * g1[n][e], c = x2[n][e] * inv * g2[n][e]; o1[e] = a * cs[e] - c * sn[e]; o2[e] = c * cs[e] + a * sn[e]; }
                            const int d1 = 16 * n + 4 * fq;
                            if (isq) { o1 = o1 * QSCALE; o2 = o2 * QSCALE; bf16* q = (bf16*)(ws + WS_Q) + (size_t)row * 512 + (4 * (pn - 8) + wc) * 64 + d1;
                                v2u w; w.x = pk2(o1.x, o1.y); w.y = pk2(o1.z, o1.w); *(GAS v2u*)q = w; w.x = pk2(o2.x, o2.y); w.y = pk2(o2.z, o2.w); *(GAS v2u*)(q + 32) = w; }
                            else { const int g = wc;
                                if (br > 0) { bf16* img = (bf16*)(ws + (br == 1 ? WS_KS : WS_KW)) + ((size_t)(b * 2 + g) * 128 + (t >> 6)) * 8192;
                                    v2u w; w.x = pk2(o1.x, o1.y); w.y = pk2(o1.z, o1.w); *(GAS v2u*)(img + kimg_off(t & 63, d1)) = w; w.x = pk2(o2.x, o2.y); w.y = pk2(o2.z, o2.w); *(GAS v2u*)(img + kimg_off(t & 63, d1 + 32)) = w; }
                                if (br < 2) { float* o = out + (br == 0 ? O_PCMP : O_PSLC) + (size_t)row * 256 + g * 64 + d1; *(GAS f32x4*)o = o1; *(GAS f32x4*)(o + 32) = o2; }
                                else if (t >= T - 512) { float* o = out + O_PWIN + ((size_t)b * 512 + (t - (T - 512))) * 256 + g * 64 + d1; *(GAS f32x4*)o = o1; *(GAS f32x4*)(o + 32) = o2; } } } }
            } else {
                const int g = wc - 2;
#pragma unroll
                for (int ai = 0; ai < 2; ++ai)
#pragma unroll
                    for (int m = 0; m < 4; ++m) { const int row = rbase + ai * 128 + m * 16; const float rs = rstd[row]; const int t = row & (T - 1), b = row >> 13;
                        const int tk = t & 63, vpos = (tk & ~15) + perm16(tk & 15);
                        bf16* vt = (br > 0) ? (bf16*)(ws + (br == 1 ? WS_KS : WS_KW)) + ((size_t)(b * 2 + g) * 128 + (t >> 6)) * 8192 : nullptr;
                        const float vsc = (br == 1) ? slc_vscale(((const float*)(ws + WS_CONST))[1]) : 1.0f;
#pragma unroll
                        for (int bj = 0; bj < 2; ++bj)
#pragma unroll
                            for (int n = 0; n < 2; ++n) { const f32x4 v = acc[ai][bj][m][n] * rs; const int d1 = 32 * bj + 16 * n + 4 * fq;
                                if (br > 0) {
#pragma unroll
                                    for (int e = 0; e < 4; ++e) vt[vimg_off(d1 + e, vpos)] = (bf16)f2bf(v[e] * vsc); }
                                if (br < 2) *(GAS f32x4*)(out + (br == 0 ? O_PCMP : O_PSLC) + (size_t)row * 256 + 128 + g * 64 + d1) = v;
                                else if (t >= T - 512) *(GAS f32x4*)(out + O_PWIN + ((size_t)b * 512 + (t - (T - 512))) * 256 + 128 + g * 64 + d1) = v; } }
            }
        } else if (pn < 15) {
            bf16* dst = (bf16*)(ws + WS_ZA);
#pragma unroll
            for (int ai = 0; ai < 2; ++ai)
#pragma unroll
                for (int m = 0; m < 4; ++m) { const int row = rbase + ai * 128 + m * 16; const float rs = rstd[row];
#pragma unroll
                    for (int bj = 0; bj < 2; ++bj)
#pragma unroll
                        for (int n = 0; n < 2; ++n) { const f32x4 z = acc[ai][bj][m][n] * rs; v2u w; w.x = pk2(z.x * sigmoidf(z.x), z.y * sigmoidf(z.y)); w.y = pk2(z.z * sigmoidf(z.z), z.w * sigmoidf(z.w));
                            *(GAS v2u*)(dst + (size_t)row * 512 + 256 * (pn - 13) + 128 * bj + 32 * wc + 16 * n + 4 * fq) = w; } }
        } else {
            if (wc == 0) { float* dst = (float*)(ws + WS_GATE);
#pragma unroll
                for (int ai = 0; ai < 2; ++ai)
#pragma unroll
                    for (int m = 0; m < 4; ++m) { const int row = rbase + ai * 128 + m * 16; const float rs = rstd[row];
#pragma unroll
                        for (int n = 0; n < 2; ++n) { const int c0 = 16 * n + 4 * fq; if (c0 < 24) { const f32x4 z = acc[ai][0][m][n] * rs;
                            *(GAS f32x4*)(dst + (size_t)row * 24 + c0) = (f32x4){sigmoidf(z.x), sigmoidf(z.y), sigmoidf(z.z), sigmoidf(z.w)}; } } } }
        }
    }
};
struct EpiOut {
    static constexpr bool PERM = false, AFTER_DRAIN = false;
    const float* x; float* y;
    __device__ __forceinline__ void operator()(const f32x4 (&acc)[2][2][4][2], const pg8::Unit& u, int wr, int wc, int fr, int fq) const {
        asm volatile("" : "+v"(fr), "+v"(fq));
#pragma unroll
        for (int ai = 0; ai < 2; ++ai)
#pragma unroll
            for (int m = 0; m < 4; ++m) { const size_t row = (size_t)u.pm * 256 + ai * 128 + wr * 64 + m * 16 + fr;
#pragma unroll
                for (int bj = 0; bj < 2; ++bj)
#pragma unroll
                    for (int n = 0; n < 2; ++n) { const size_t off = row * D + u.pn * 256 + 128 * bj + 32 * wc + 16 * n + 4 * fq;
                        *(GAS f32x4*)(y + off) = *(const GAS f32x4*)(x + off) + acc[ai][bj][m][n]; } }
    }
};
template <int MODE>
__device__ __forceinline__ void small_gemm_tile(const Ptrs& P, const bf16* A, const bf16* Bt, int ct, int lane) {
    const int rho = lane & 15, kq = lane >> 4;
    f32x4 acc[2] = {(f32x4){0.f, 0.f, 0.f, 0.f}, (f32x4){0.f, 0.f, 0.f, 0.f}};
    const GAS v4u* a0 = (const GAS v4u*)(A + (size_t)rho * D + 8 * kq); const GAS v4u* a1 = (const GAS v4u*)(A + (size_t)(16 + rho) * D + 8 * kq);
    const GAS v4u* bp = (const GAS v4u*)(Bt + (size_t)(16 * ct + rho) * D + 8 * kq);
#pragma unroll 8
    for (int ks = 0; ks < 32; ++ks) { const bf16x8 bb = __builtin_bit_cast(bf16x8, bp[ks * 4]);
        acc[0] = __builtin_amdgcn_mfma_f32_16x16x32_bf16(bb, __builtin_bit_cast(bf16x8, a0[ks * 4]), acc[0], 0, 0, 0);
        acc[1] = __builtin_amdgcn_mfma_f32_16x16x32_bf16(bb, __builtin_bit_cast(bf16x8, a1[ks * 4]), acc[1], 0, 0, 0); }
#pragma unroll
    for (int rt = 0; rt < 2; ++rt) { const int b = 16 * rt + rho; const int col = 16 * ct + 4 * kq;
        if (MODE == 0) { const float rs = ((const float*)(P.ws + WS_RSTDS))[b]; *(GAS f32x4*)((float*)(P.ws + WS_PROJS) + (size_t)b * NP + col) = acc[rt] * rs; }
        else *(GAS f32x4*)(P.out + O_YS + (size_t)b * D + col) = *(const GAS f32x4*)(P.xs + (size_t)b * D + col) + acc[rt]; }
}
__device__ __forceinline__ int projs_col(int pn, int wc, int d) { return 256 * pn + 128 * (d >> 5) + 32 * wc + (d & 31); }
__device__ __forceinline__ void p2_sample_item(const Ptrs& P, int it, int lane) {
    const int b = it / 37, ty = it - b * 37;
    const float* pr = (const float*)(P.ws + WS_PROJS) + (size_t)b * NP;
    const float* ropes = (const float*)(P.ws + WS_ROPE) + (size_t)8192 * 64;
    float* kvn = (float*)(P.ws + WS_KVN) + (size_t)b * 768;
    if (ty < 14) {
        const bool isq = ty < 8; const int br = isq ? 0 : (ty - 8) >> 1, g = (ty - 8) & 1;
        const int pn = isq ? 8 + (ty >> 2) : 10 + br, wc = isq ? (ty & 3) : g;
        const float v = pr[projs_col(pn, wc, lane)];
        const float ss = wave_sum(v * v); const float inv = 1.0f / sqrtf(ss * (1.0f / 64.0f) + NORM_EPS);
        const float gn = isq ? P.q_gain[lane] : P.k_gain[br * 64 + lane];
        const float xn = v * inv * gn; const float xo = __shfl_xor(xn, 32);
        const int i = lane & 31; const float cs = ropes[i], sn = ropes[32 + i];
        const float o = (lane < 32) ? xn * cs - xo * sn : xn * cs + xo * sn;
        if (isq) ((float*)(P.ws + WS_QS))[(size_t)b * 512 + ty * 64 + lane] = o * QSCALE;
        else { kvn[(br * 2 + 0) * 128 + g * 64 + lane] = o;
            if (br == 0) P.out[O_SCMP + (size_t)b * 256 + g * 64 + lane] = o; else if (br == 1) P.out[O_SSLC + (size_t)b * 256 + g * 64 + lane] = o;
            else P.out[O_SWIN + ((size_t)b * 512 + 511) * 256 + g * 64 + lane] = o; }
    } else if (ty < 20) {
        const int br = (ty - 14) >> 1, g = (ty - 14) & 1; const float v = pr[projs_col(10 + br, 2 + g, lane)];
        kvn[(br * 2 + 1) * 128 + g * 64 + lane] = v;
        if (br == 0) P.out[O_SCMP + (size_t)b * 256 + 128 + g * 64 + lane] = v; else if (br == 1) P.out[O_SSLC + (size_t)b * 256 + 128 + g * 64 + lane] = v;
        else P.out[O_SWIN + ((size_t)b * 512 + 511) * 256 + 128 + g * 64 + lane] = v;
    } else if (ty == 20) {
        if (lane < 24) ((float*)(P.ws + WS_GS))[b * 24 + lane] = sigmoidf(pr[256 * 15 + lane]);
    } else if (ty < 29) {
        const int ch = (ty - 21) * 64 + lane; const int pnb = ch >> 7, tc = ch & 127;
        const float bg = pr[256 * pnb + tc], zc = pr[256 * pnb + 128 + tc], cg = pr[256 * (4 + pnb) + tc], ci = pr[256 * (4 + pnb) + 128 + tc];
        const float u = cg * ci; const float s0 = P.st_conv[(size_t)b * 1024 + ch], s1 = P.st_conv[(size_t)b * 1024 + 512 + ch];
        const float cy = P.conv_w[ch] * s0 + P.conv_w[512 + ch] * s1 + P.conv_w[1024 + ch] * u + P.conv_b[ch];
        ((bf16*)(P.ws + WS_MIXS))[(size_t)b * 1024 + ch] = (bf16)f2bf(bg * cy * zc * sigmoidf(zc));
        P.out[O_SCONV + (size_t)b * 1024 + 512 + ch] = u;
    } else {
        const int col = (ty - 29) * 64 + lane; const float z = pr[256 * (13 + (col >> 8)) + (col & 255)];
        ((float*)(P.ws + WS_ZAS))[(size_t)b * 512 + col] = z * sigmoidf(z);
    }
}
__device__ __forceinline__ void p2_phase(const Ptrs& P, Frame& F) {
    compress_prompt_units(P, F, (LAS float*)(F.lds + RING_OFF), [&]() { for (int it = F.gw; it < DECB * 37; it += F.NGW) p2_sample_item(P, it, F.lane); });
    if ((int)blockIdx.x >= BATCH * 64) for (int it = F.gw; it < DECB * 37; it += F.NGW) p2_sample_item(P, it, F.lane);
}
#define MFMA32(a, b, c) __builtin_amdgcn_mfma_f32_32x32x16_bf16(a, b, c, 0, 0, 0)
constexpr int P3_IMP = 0, P3_QL = 32768;
constexpr int P3_NEXT = LDSCTL_OFF + 512, P3_CNT = LDSCTL_OFF + 1024, P3_LISTS = LDSCTL_OFF + 2048, P3_LACC = LDSCTL_OFF + 10240;
constexpr int P3_RING = 65536;
constexpr int P3_MISC = MISC_OFF + 64;
constexpr int SM_Q = 36864, SM_P = 40960, SM_RED = 57344, SM_IMP = 66048, SM_L = 67200, SM_SEL = 67328, SM_O = 67584, SM_VP = 71680  , SM_RED2 = 79872  ;

template <bool MASK>
__device__ __forceinline__ void attend_lds(const LAS unsigned char* blk, const bf16x8 (&qf)[4], f32x16 (&O)[2], float& lsum,
                                           int kbase, int lo, int hi, int lane, bool want_pv, f32x16 (*Sout)[2] = nullptr) {
    const int hh = lane >> 5;
    const LAS unsigned char* kb = blk + lane * 16; const LAS unsigned char* vb = blk + 8192 + lane * 16;
#pragma unroll
    for (int kt = 0; kt < 2; ++kt) {
        f32x16 S;
        { bf16x8 kf[4];
#pragma unroll
          for (int s = 0; s < 4; ++s) kf[s] = *(const LAS bf16x8*)(kb + (kt * 4 + s) * 1024);
#pragma unroll
          for (int i = 0; i < 16; ++i) S[i] = 0.f;
#pragma unroll
          for (int s = 0; s < 4; ++s) S = MFMA32(kf[s], qf[s], S); }
#pragma unroll
        for (int i = 0; i < 16; ++i) { float p = fast_exp2(S[i]);
            if (MASK) { const int kp = kbase + 32 * kt + (i & 3) + 8 * (i >> 2) + 4 * hh; p = (kp >= lo && kp <= hi) ? p : 0.f; }
            S[i] = p; lsum += p; }
        if (Sout) (*Sout)[kt] = S;
        if (want_pv) {
            bf16x8 pf[2];
#pragma unroll
            for (int sp = 0; sp < 2; ++sp) { v4u w; w.x = pk2(S[8 * sp + 0], S[8 * sp + 1]); w.y = pk2(S[8 * sp + 2], S[8 * sp + 3]);
                w.z = pk2(S[8 * sp + 4], S[8 * sp + 5]); w.w = pk2(S[8 * sp + 6], S[8 * sp + 7]); pf[sp] = __builtin_bit_cast(bf16x8, w); }
#pragma unroll
            for (int dt = 0; dt < 2; ++dt)
#pragma unroll
                for (int sp = 0; sp < 2; ++sp) { const bf16x8 vf = *(const LAS bf16x8*)(vb + (dt * 4 + 2 * kt + sp) * 1024);
                    O[dt] = MFMA32(vf, pf[sp], O[dt]); }
        }
    }
}
__device__ __forceinline__ void wave_topk(const LAS float* imp, int jmax, int nsel, int lane, int qbase, LAS unsigned* cnt, LAS unsigned char* lists) {
    if (jmax < 1) return;
    const bool c0 = lane >= 1 && lane <= jmax, c1 = 64 + lane <= jmax;
    unsigned k0[8], k1[8], Tv[8];
#pragma unroll
    for (int qi = 0; qi < 8; ++qi) { k0[qi] = c0 ? ((__builtin_bit_cast(unsigned, imp[qi * 128 + lane]) + 0x800u) & ~0x7ffu) : 0u; k1[qi] = c1 ? ((__builtin_bit_cast(unsigned, imp[qi * 128 + 64 + lane]) + 0x800u) & ~0x7ffu) : 0u; Tv[qi] = 0u; }
    if (jmax > nsel) {
        for (int bit = 30; bit >= 11; --bit) {
#pragma unroll
            for (int qi = 0; qi < 8; ++qi) { const unsigned cand = Tv[qi] | (1u << bit);
                const int cn = __popcll(__ballot(k0[qi] >= cand)) + __popcll(__ballot(k1[qi] >= cand)); Tv[qi] = cn >= nsel ? cand : Tv[qi]; } }
    }
    const unsigned long long below = (lane == 0) ? 0ull : (~0ull >> (64 - lane));
#pragma unroll
    for (int qi = 0; qi < 8; ++qi) {
        bool s0, s1;
        if (jmax > nsel) {
            const unsigned long long g0 = __ballot(k0[qi] > Tv[qi]), g1 = __ballot(k1[qi] > Tv[qi]), e0 = __ballot(k0[qi] == Tv[qi]), e1 = __ballot(k1[qi] == Tv[qi]);
            const int need = nsel - __popcll(g0) - __popcll(g1);
            const int rk0 = __popcll(e0 & below), rk1 = __popcll(e0) + __popcll(e1 & below);
            s0 = k0[qi] > Tv[qi] || (k0[qi] == Tv[qi] && rk0 < need); s1 = k1[qi] > Tv[qi] || (k1[qi] == Tv[qi] && rk1 < need);
        } else { s0 = c0; s1 = c1; }
        if (s0) { const unsigned pos = __hip_atomic_fetch_add(cnt + lane, 1u, __ATOMIC_RELAXED, __HIP_MEMORY_SCOPE_WORKGROUP); lists[lane * 64 + pos] = (unsigned char)(qbase + qi); }
        if (s1) { const unsigned pos = __hip_atomic_fetch_add(cnt + 64 + lane, 1u, __ATOMIC_RELAXED, __HIP_MEMORY_SCOPE_WORKGROUP); lists[(64 + lane) * 64 + pos] = (unsigned char)(qbase + qi); }
    }
}
struct BlkSrc { const bf16* img; };
#ifndef PROBE_SEG
#define PROBE_SEG 0
#endif
#define T_BEGIN(id) do { if (PROBE_SEG == (id)) tacc -= __builtin_readcyclecounter(); } while (0)
#define T_END(id) do { if (PROBE_SEG == (id)) tacc += __builtin_readcyclecounter(); } while (0)
__device__ __forceinline__ void p3_prompt_unit(const Ptrs& P, Frame& F, int b, int t, int g, float sh_cmp, float sh_slc, float sh_win, unsigned long long& tacc) {
    int lane = F.lane, w = F.wave, tid = F.tid; asm volatile("" : "+v"(lane), "+s"(w), "+v"(tid));
    const int col = lane & 31, hh = lane >> 5, qi = col >> 2, h = col & 3;
    const int tok = 64 * t + 8 * w + qi; const size_t row = (size_t)b * T + tok; const int qpos = tok;
    const int nck = (2 * t + 2 + 63) >> 6, nf = t >= 2 ? 3 : t + 1, nw = t >= 8 ? 9 : t + 1;
    const int n1 = nck, n2 = 2 * nck, N1 = n2 + nf;
    const bf16* KC = (const bf16*)(P.ws + WS_KC) + (size_t)(b * 2 + g) * 4 * 8192;
    const bf16* KS = (const bf16*)(P.ws + WS_KS) + (size_t)(b * 2 + g) * 128 * 8192;
    const bf16* KW = (const bf16*)(P.ws + WS_KW) + (size_t)(b * 2 + g) * 128 * 8192;
    auto src1 = [&](int n) -> BlkSrc {
        if (n < n2) { const int ck = n < n1 ? n : n - n1; return BlkSrc{KC + (size_t)ck * 8192}; }
        const int f = n - n2; const int j = f == 0 ? t : (f == 1 ? 0 : t - 1); return BlkSrc{KS + (size_t)j * 8192}; };
    auto src2 = [&](int n) -> BlkSrc { const int j = (t >= 8 ? t - 8 : 0) + n; return BlkSrc{KW + (size_t)j * 8192}; };
    LAS unsigned char* ring = F.lds + P3_RING;
#define ST_DMA(bs_, n) do { LAS unsigned char* d_ = ring + ((n) & 3) * 16384 + w * 2048; \
        __builtin_amdgcn_global_load_lds((const unsigned*)((bs_).img + (2 * w) * 512 + lane * 8), (LAS unsigned*)d_, 16, 0, 0); \
        __builtin_amdgcn_global_load_lds((const unsigned*)((bs_).img + (2 * w + 1) * 512 + lane * 8), (LAS unsigned*)(d_ + 1024), 16, 0, 0); } while (0)
#define BLK(n) (ring + ((n) & 3) * 16384)
#define STEP_BEGIN(SRC, n, NN) do { if (((n) & 1) == 0) { if ((n) + 2 < (NN)) { const BlkSrc b_ = SRC((n) + 2); ST_DMA(b_, (n) + 2); } if ((n) + 3 < (NN)) { const BlkSrc b_ = SRC((n) + 3); ST_DMA(b_, (n) + 3); } } } while (0)
#define STEP_END(n, NN) do { if (((n) & 1) == 1 || (n) == (NN) - 1) { asm volatile("s_waitcnt vmcnt(0)" ::: "memory"); __syncthreads(); } } while (0)
    LAS unsigned* cnt = (LAS unsigned*)(F.lds + P3_CNT); LAS unsigned char* lists = F.lds + P3_LISTS; LAS unsigned* nextb = (LAS unsigned*)(F.lds + P3_NEXT);
    LAS int* oacc = (LAS int*)ring; LAS int* lacc = (LAS int*)(F.lds + P3_LACC);
    const float FXS = slc_vscale(sh_slc), FXI = 1.0f / FXS;
    LAS unsigned char* ql = F.lds + P3_QL;
    T_BEGIN(1); T_BEGIN(8);
    __syncthreads();
    if (tid < 128) cnt[tid] = 0u; if (tid == 128) nextb[0] = 0u;
    { const BlkSrc b0 = src1(0); ST_DMA(b0, 0); if (N1 > 1) { const BlkSrc b1 = src1(1); ST_DMA(b1, 1); } }
    { const bf16* qg = (const bf16*)(P.ws + WS_Q) + ((size_t)b * T + 64 * t) * 512 + g * 256;
      v4u tq[4];
#pragma unroll
      for (int k = 0; k < 4; ++k) { const int c = tid + 512 * k, rq = c >> 3, ch = c & 7; tq[k] = *(const GAS v4u*)(qg + (size_t)(rq >> 2) * 512 + (rq & 3) * 64 + ch * 8); }
#pragma unroll
      for (int k = 0; k < 4; ++k) { const int c = tid + 512 * k, rq = c >> 3, ch = c & 7; *(LAS v4u*)(ql + rq * 128 + ((ch ^ ((rq >> 1) & 7)) << 4)) = tq[k]; } }
    bf16x8 qf[4];
    { const bf16* q = (const bf16*)(P.ws + WS_Q) + row * 512 + (g * 4 + h) * 64 + 8 * hh;
#pragma unroll
      for (int s = 0; s < 4; ++s) qf[s] = __builtin_bit_cast(bf16x8, *(const GAS v4u*)(q + 16 * s)); }
    const float* gate = (const float*)(P.ws + WS_GATE) + row * 24 + (g * 4 + h) * 3;
    const float g_cmp = gate[0], g_slc = gate[1], g_win = gate[2];
    asm volatile("s_waitcnt vmcnt(0)" ::: "memory"); __syncthreads();
    T_END(1); T_BEGIN(2);
    f32x16 O[2];
    LAS float* wl = (LAS float*)(F.lds + P3_IMP + w * 4096);
    LAS float* xw0 = (LAS float*)(F.lds + P3_IMP + w * 4096) + lane;
    f32x16 totr;
    const int nvis = (qpos + 1) >> 5;
    int n = 0;
    float lsum = 0.f;
    for (; n < n1; ++n) { STEP_BEGIN(src1, n, N1); attend_lds<true>(BLK(n), qf, O, lsum, 64 * n, 0, nvis - 1, lane, false); STEP_END(n, N1); }
    lsum += __shfl_xor(lsum, 32);
    const float rl = lsum > 0.f ? 1.0f / lsum : 0.f;
    for (int i = lane; i < 1024; i += 64) wl[i] = 0.f;
#pragma unroll
    for (int i = 0; i < 16; ++i) { O[0][i] = 0.f; O[1][i] = 0.f; }
    { float dummy = 0.f;
      for (; n < n2; ++n) { STEP_BEGIN(src1, n, N1); const int ck = n - n1; f32x16 Sn[2];
        attend_lds<true>(BLK(n), qf, O, dummy, 64 * ck, 0, nvis - 1, lane, true, &Sn);
#pragma unroll
        for (int kt = 0; kt < 2; ++kt)
#pragma unroll
            for (int i2 = 0; i2 < 8; ++i2) { const float v = quad_sum((Sn[kt][2 * i2] + Sn[kt][2 * i2 + 1]) * rl);
                if (h == 0) wl[qi * 128 + 32 * ck + 16 * kt + (i2 & 1) + 4 * (i2 >> 1) + 2 * hh] = v; }
        STEP_END(n, N1); } }
    LDS_WAIT(); asm volatile("" ::: "memory");
    T_END(2); T_BEGIN(3);
    wave_topk(wl, t - 2, 13, lane, 8 * w, cnt, lists);
    LDS_WAIT(); asm volatile("" ::: "memory");
#pragma unroll
    for (int i = 0; i < 16; ++i) { xw0[i * 64] = O[0][i] * (g_cmp * rl); totr[i] = O[1][i] * (g_cmp * rl); O[0][i] = 0.f; O[1][i] = 0.f; }
    T_END(3); T_BEGIN(4);
    lsum = 0.f;
    for (; n < N1; ++n) { STEP_BEGIN(src1, n, N1);
        if (n == n2) attend_lds<true>(BLK(n), qf, O, lsum, 64 * t, 0, qpos, lane, true);
        else attend_lds<false>(BLK(n), qf, O, lsum, 0, 0, 0, lane, true);
        STEP_END(n, N1); }
    lsum += __shfl_xor(lsum, 32);
#pragma unroll
    for (int dt = 0; dt < 2; ++dt)
#pragma unroll
        for (int i = 0; i < 16; ++i) oacc[(32 * dt + (i & 3) + 8 * (i >> 2) + 4 * hh) * 256 + 32 * w + col] = (int)O[dt][i];
    if (hh == 0) lacc[32 * w + col] = __float2int_rn(lsum * FXS);
    __syncthreads();
    T_END(4); T_BEGIN(5);
    if (t > 2) {
        const int r = lane & 31;
#define NEXT_BLOCK(jv_, nq_) do { for (;;) { unsigned t_ = 0u; if (lane == 0) t_ = __hip_atomic_fetch_add(nextb, 1u, __ATOMIC_RELAXED, __HIP_MEMORY_SCOPE_WORKGROUP); \
            jv_ = 1 + (int)__builtin_amdgcn_readfirstlane(t_); if (jv_ > t - 2) { nq_ = 0; break; } nq_ = (int)__builtin_amdgcn_readfirstlane(cnt[jv_]); if (nq_ > 0) break; } } while (0)
#define LOAD_K(kd_, jv_) do { const bf16* im_ = KS + (size_t)(jv_) * 8192 + lane * 8;     \
            _Pragma("unroll") for (int a_ = 0; a_ < 2; ++a_) _Pragma("unroll") for (int b_ = 0; b_ < 4; ++b_) kd_[a_][b_] = __builtin_bit_cast(bf16x8, *(const GAS v4u*)(im_ + (a_ * 4 + b_) * 512)); } while (0)
#define LOAD_V(vd_, jv_) do { const bf16* im_ = KS + (size_t)(jv_) * 8192 + 4096 + lane * 8; \
            _Pragma("unroll") for (int a_ = 0; a_ < 2; ++a_) _Pragma("unroll") for (int b_ = 0; b_ < 4; ++b_) vd_[a_][b_] = __builtin_bit_cast(bf16x8, *(const GAS v4u*)(im_ + (a_ * 4 + b_) * 512)); } while (0)
        bf16x8 kf[2][4], vf[2][4], kn[2][4];
        int j, nq; T_BEGIN(10); NEXT_BLOCK(j, nq); if (j <= t - 2) LOAD_K(kf, j); T_END(10);
        while (j <= t - 2) {
            T_BEGIN(10); LOAD_V(vf, j);
            int jn, nqn; NEXT_BLOCK(jn, nqn); LOAD_K(kn, (jn <= t - 2 ? jn : t - 2));
#pragma unroll
            for (int a_ = 0; a_ < 2; ++a_)
#pragma unroll
                for (int b_ = 0; b_ < 4; ++b_) asm volatile("" : "+v"(kf[a_][b_])); T_END(10);
            for (int c0 = 0; c0 < nq; c0 += 8) { T_BEGIN(11);
                const int sl = c0 + qi; const bool valid = sl < nq;
                const int rowq = (int)lists[j * 64 + (valid ? sl : nq - 1)] * 4 + h;
                const LAS unsigned char* qp = ql + rowq * 128; const int qsw = (rowq >> 1) & 7;
                bf16x8 q2[4];
#pragma unroll
                for (int s = 0; s < 4; ++s) q2[s] = *(const LAS bf16x8*)(qp + (((2 * s + hh) ^ qsw) << 4));
                float l2 = 0.f; bf16x8 pf[4]; f32x16 S0, S1;
#pragma unroll
                for (int i = 0; i < 16; ++i) { S0[i] = 0.f; S1[i] = 0.f; }
#pragma unroll
                for (int s = 0; s < 4; ++s) { S0 = MFMA32(kf[0][s], q2[s], S0); S1 = MFMA32(kf[1][s], q2[s], S1); }
#pragma unroll
                for (int i = 0; i < 16; ++i) { S0[i] = fast_exp2(S0[i]); l2 += S0[i]; }
#pragma unroll
                for (int sp = 0; sp < 2; ++sp) { v4u wv; wv.x = pk2(S0[8 * sp + 0], S0[8 * sp + 1]); wv.y = pk2(S0[8 * sp + 2], S0[8 * sp + 3]);
                    wv.z = pk2(S0[8 * sp + 4], S0[8 * sp + 5]); wv.w = pk2(S0[8 * sp + 6], S0[8 * sp + 7]); pf[sp] = __builtin_bit_cast(bf16x8, wv); }
#pragma unroll
                for (int i = 0; i < 16; ++i) { S1[i] = fast_exp2(S1[i]); l2 += S1[i]; }
#pragma unroll
                for (int sp = 0; sp < 2; ++sp) { v4u wv; wv.x = pk2(S1[8 * sp + 0], S1[8 * sp + 1]); wv.y = pk2(S1[8 * sp + 2], S1[8 * sp + 3]);
                    wv.z = pk2(S1[8 * sp + 4], S1[8 * sp + 5]); wv.w = pk2(S1[8 * sp + 6], S1[8 * sp + 7]); pf[2 + sp] = __builtin_bit_cast(bf16x8, wv); }
                T_END(11); T_BEGIN(9);
                __builtin_amdgcn_sched_barrier(0);
#pragma unroll
                for (int a_ = 0; a_ < 2; ++a_)
#pragma unroll
                    for (int b_ = 0; b_ < 4; ++b_) asm volatile("" : "+v"(vf[a_][b_]));
#pragma unroll
                for (int dt = 0; dt < 2; ++dt) { f32x16 O2;
#pragma unroll
                    for (int i = 0; i < 16; ++i) O2[i] = 0.f;
#pragma unroll
                    for (int ks = 0; ks < 4; ++ks) O2 = MFMA32(vf[dt][ks], pf[ks], O2);
                    if (valid) {
#pragma unroll
                        for (int i = 0; i < 16; ++i) (void)__hip_atomic_fetch_add(oacc + (32 * dt + (i & 3) + 8 * (i >> 2) + 4 * hh) * 256 + rowq, (int)O2[i], __ATOMIC_RELAXED, __HIP_MEMORY_SCOPE_WORKGROUP); } }
                if (valid) {
                    (void)__hip_atomic_fetch_add(lacc + rowq, __float2int_rn(l2 * FXS), __ATOMIC_RELAXED, __HIP_MEMORY_SCOPE_WORKGROUP); }
                if (PROBE_SEG == 9) LDS_WAIT(); T_END(9);
            }
#pragma unroll
            for (int a_ = 0; a_ < 2; ++a_)
#pragma unroll
                for (int b_ = 0; b_ < 4; ++b_) kf[a_][b_] = kn[a_][b_];
            j = jn; nq = nqn;
        }
#undef NEXT_BLOCK
#undef LOAD_K
#undef LOAD_V
    }
    __syncthreads();
    T_END(5); T_BEGIN(6);
    LAS float* x0 = (LAS float*)(F.lds + P3_IMP + w * 4096) + lane; LAS float* x1 = (LAS float*)(F.lds + P3_QL + w * 4096) + lane;
    { const float sc = g_slc / fmaxf((float)lacc[32 * w + col] * FXI, 1e-30f);
#pragma unroll
      for (int i = 0; i < 16; ++i) { const int dr = (i & 3) + 8 * (i >> 2) + 4 * hh;
          x0[i * 64] = x0[i * 64] + (float)oacc[dr * 256 + 32 * w + col] * (FXI * sc); x1[i * 64] = totr[i] + (float)oacc[(32 + dr) * 256 + 32 * w + col] * (FXI * sc); O[0][i] = 0.f; O[1][i] = 0.f; } }
    LDS_WAIT(); __syncthreads();
    { const BlkSrc b0 = src2(0); ST_DMA(b0, 0); if (nw > 1) { const BlkSrc b1 = src2(1); ST_DMA(b1, 1); } }
    { asm volatile("" : "+v"(lane));
      const bf16* q = (const bf16*)(P.ws + WS_Q) + row * 512 + (g * 4 + h) * 64 + 8 * hh;
#pragma unroll
      for (int s = 0; s < 4; ++s) qf[s] = __builtin_bit_cast(bf16x8, *(const GAS v4u*)(q + 16 * s)); }
    asm volatile("s_waitcnt vmcnt(0)" ::: "memory"); __syncthreads();
    lsum = 0.f;
    for (n = 0; n < nw; ++n) { STEP_BEGIN(src2, n, nw); const int j = (t >= 8 ? t - 8 : 0) + n;
        if (j == t || j + 8 == t) attend_lds<true>(BLK(n), qf, O, lsum, 64 * j, qpos - 511, qpos, lane, true);
        else attend_lds<false>(BLK(n), qf, O, lsum, 0, 0, 0, lane, true);
        STEP_END(n, nw); }
    lsum += __shfl_xor(lsum, 32);
    { const float sc = g_win / fmaxf(lsum, 1e-30f);
#pragma unroll
      for (int i = 0; i < 16; ++i) { O[0][i] = x0[i * 64] + O[0][i] * sc; O[1][i] = x1[i * 64] + O[1][i] * sc; } }
#undef ST_DMA
#undef BLK
#undef STEP_BEGIN
#undef STEP_END
    T_END(6); T_BEGIN(7);
    asm volatile("" : "+v"(lane));
    const int col_ = lane & 31, hh_ = lane >> 5, h_ = col_ & 3; const size_t row_ = (size_t)b * T + 64 * t + 8 * w + (col_ >> 2);
    const bf16* za = (const bf16*)(P.ws + WS_ZA) + row_ * 512 + (g * 4 + h_) * 64; bf16* mx = (bf16*)(P.ws + WS_MIX) + row_ * 1024 + 512 + (g * 4 + h_) * 64;
#pragma unroll
    for (int dt = 0; dt < 2; ++dt)
#pragma unroll
        for (int i4 = 0; i4 < 4; ++i4) { const int d = 32 * dt + 8 * i4 + 4 * hh_; const v2u z = *(const GAS v2u*)(za + d);
            v2u o; o.x = pk2(O[dt][4 * i4] * bf2f(z.x & 0xffffu), O[dt][4 * i4 + 1] * bf2f(z.x >> 16)); o.y = pk2(O[dt][4 * i4 + 2] * bf2f(z.y & 0xffffu), O[dt][4 * i4 + 3] * bf2f(z.y >> 16));
            *(GAS v2u*)(mx + d) = o; }
    if (g == 0) { const int tq = w, c8 = lane * 8; const size_t r0 = (size_t)b * T + 64 * t + 8 * tq;
        const bf16* U = (const bf16*)(P.ws + WS_U) + c8; const bf16* CGp = (const bf16*)(P.ws + WS_CG) + c8; bf16* mo = (bf16*)(P.ws + WS_MIX) + c8;
        v4u ur[10], cr[8];
        const bool has_prev = (t > 0) || (tq > 0);
#pragma unroll
        for (int i = 0; i < 10; ++i) ur[i] = (i >= 2 || has_prev) ? *(const GAS v4u*)(U + (r0 + i - 2) * 512) : (v4u){0u, 0u, 0u, 0u};
#pragma unroll
        for (int i = 0; i < 8; ++i) cr[i] = *(const GAS v4u*)(CGp + (r0 + i) * 512);
        float w0[8], w1[8], w2[8], cb[8];
#pragma unroll
        for (int e = 0; e < 8; ++e) { w0[e] = P.conv_w[c8 + e]; w1[e] = P.conv_w[512 + c8 + e]; w2[e] = P.conv_w[1024 + c8 + e]; cb[e] = P.conv_b[c8 + e]; }
#pragma unroll
        for (int i = 0; i < 8; ++i) { float o[8];
#pragma unroll
            for (int e = 0; e < 8; ++e) { const int sh_ = (e & 1) * 16; const float a = bf2f((ur[i][e >> 1] >> sh_) & 0xffffu), bb = bf2f((ur[i + 1][e >> 1] >> sh_) & 0xffffu), c = bf2f((ur[i + 2][e >> 1] >> sh_) & 0xffffu);
                o[e] = bf2f((cr[i][e >> 1] >> sh_) & 0xffffu) * (w0[e] * a + w1[e] * bb + w2[e] * c + cb[e]); }
            v4u ov; ov.x = pk2(o[0], o[1]); ov.y = pk2(o[2], o[3]); ov.z = pk2(o[4], o[5]); ov.w = pk2(o[6], o[7]);
            *(GAS v4u*)(mo + (r0 + i) * 1024) = ov; } }
    T_END(7); T_END(8);
}
template <class KeyFn>
__device__ __forceinline__ void sample_branch(Frame& F, int nslots, float shift, const KeyFn& key, LAS float* obr) {
    LAS float* q = (LAS float*)(F.lds + SM_Q); LAS float* Pb = (LAS float*)(F.lds + SM_P); LAS float* red = (LAS float*)(F.lds + SM_RED); LAS float* lsm = (LAS float*)(F.lds + SM_L);
    LAS unsigned long long* vptr = (LAS unsigned long long*)(F.lds + SM_VP);
    float lacc[4] = {0.f, 0.f, 0.f, 0.f};
    for (int s = F.tid; s < nslots; s += 512) { const float* kp; const float* vp; const bool valid = key(s, kp, vp);
        float sc[4] = {0.f, 0.f, 0.f, 0.f};
        if (valid) {
#pragma unroll 8
            for (int d4 = 0; d4 < 16; ++d4) { const f32x4 kv = *(const GAS f32x4*)(kp + 4 * d4);
#pragma unroll
                for (int hq = 0; hq < 4; ++hq) { const f32x4 qv = *(const LAS f32x4*)(q + hq * 64 + 4 * d4); sc[hq] += (kv.x * qv.x + kv.y * qv.y) + (kv.z * qv.z + kv.w * qv.w); } } }
        f32x4 p;
#pragma unroll
        for (int hq = 0; hq < 4; ++hq) { p[hq] = valid ? fast_exp2(sc[hq] - shift) : 0.f; lacc[hq] += p[hq]; }
        *(LAS f32x4*)(Pb + 4 * s) = p; vptr[s] = (unsigned long long)(uintptr_t)vp; }
#pragma unroll
    for (int hq = 0; hq < 4; ++hq) { lacc[hq] = wave_sum(lacc[hq]); if (F.lane == 0) red[F.wave * 4 + hq] = lacc[hq]; }
    __syncthreads();
    if (F.tid < 4) { float s = 0.f; for (int ww = 0; ww < 8; ++ww) s += red[ww * 4 + F.tid]; lsm[F.tid] = s; }
    const int sg = F.tid >> 4, d4 = F.tid & 15;
    f32x4 oa[4];
#pragma unroll
    for (int hq = 0; hq < 4; ++hq) oa[hq] = (f32x4){0.f, 0.f, 0.f, 0.f};
    for (int s0 = sg; s0 < nslots; s0 += 256) {
        f32x4 vv[8], pp[8];
#pragma unroll
        for (int u = 0; u < 8; ++u) { const int s = s0 + 32 * u; const float* vp = (const float*)(uintptr_t)vptr[s]; vv[u] = *(const GAS f32x4*)(vp + 4 * d4); pp[u] = *(const LAS f32x4*)(Pb + 4 * s); }
#pragma unroll
        for (int u = 0; u < 8; ++u) { oa[0] = oa[0] + vv[u] * pp[u].x; oa[1] = oa[1] + vv[u] * pp[u].y; oa[2] = oa[2] + vv[u] * pp[u].z; oa[3] = oa[3] + vv[u] * pp[u].w; } }
    __syncthreads();
    LAS float* red2 = (LAS float*)(F.lds + SM_RED2);
#pragma unroll
    for (int hq = 0; hq < 4; ++hq) *(LAS f32x4*)(red2 + (sg * 4 + hq) * 64 + 4 * d4) = oa[hq];
    __syncthreads();
    if (F.tid < 256) { float s = 0.f;
#pragma unroll 8
        for (int g2 = 0; g2 < 32; ++g2) s += red2[g2 * 256 + F.tid]; obr[F.tid] = s; }
    __syncthreads();
}
__device__ __forceinline__ void p3_sample_unit(const Ptrs& P, Frame& F, int b, int g) {
    asm volatile("" : "+v"(F.tid), "+v"(F.lane), "+s"(F.wave));
    LAS float* q = (LAS float*)(F.lds + SM_Q); LAS float* Pb = (LAS float*)(F.lds + SM_P); LAS float* imp = (LAS float*)(F.lds + SM_IMP); LAS float* lsm = (LAS float*)(F.lds + SM_L);
    LAS int* sel = (LAS int*)(F.lds + SM_SEL); LAS float* osm = (LAS float*)(F.lds + SM_O);
    const float* cst = (const float*)(P.ws + WS_CONST);
    float kcmax = 0.f; for (int e_ = 0; e_ < 4; ++e_) kcmax += __builtin_bit_cast(float, __hip_atomic_load((unsigned*)(P.ws + WS_CTL) + CW_KCMAX + 64 + e_, RLX_AGENT));
    const float sh_cmp = cst[0] * sqrtf(kcmax) * LOG2E * 1.001f, sh_slc = cst[1], sh_win = cst[2];
    if (F.tid < 256) q[F.tid] = ((const float*)(P.ws + WS_QS))[(size_t)b * 512 + g * 256 + F.tid];
    __syncthreads();
    const float* kcs = (const float*)(P.ws + WS_KCS) + (size_t)(b * 2 + g) * 2 * NCS * 64;
    sample_branch(F, NCS, sh_cmp, [&](int s, const float*& kp, const float*& vp) { kp = kcs + (size_t)s * 64; vp = kcs + (size_t)(NCS + s) * 64; return true; }, osm);
    { const f32x4 p = *(const LAS f32x4*)(Pb + 4 * F.tid); float v = p.x / lsm[0] + p.y / lsm[1] + p.z / lsm[2] + p.w / lsm[3]; v += __shfl_xor(v, 1);
      if ((F.tid & 1) == 0) imp[F.tid >> 1] = v; if (F.tid < 4) imp[256 + F.tid] = 0.f; }
    if (F.tid < 256) osm[F.tid] = osm[F.tid] / lsm[F.tid >> 6];
    __syncthreads();
    if (F.wave == 0) { const int lane = F.lane; unsigned k[4];
#pragma unroll
        for (int i = 0; i < 4; ++i) { const int j = lane + 64 * i; k[i] = (j >= 1 && j <= 254) ? __builtin_bit_cast(unsigned, imp[j]) + 1u : 0u; }
        unsigned Tv = 0u;
        for (int bit = 30; bit >= 0; --bit) { const unsigned cand = Tv | (1u << bit); int cnt = 0;
#pragma unroll
            for (int i = 0; i < 4; ++i) cnt += __popcll(__ballot(k[i] >= cand));
            if (cnt >= 13) Tv = cand; }
        int ngt = 0;
#pragma unroll
        for (int i = 0; i < 4; ++i) ngt += __popcll(__ballot(k[i] > Tv));
        const int need = 13 - ngt; const unsigned long long below = (lane == 0) ? 0ull : (~0ull >> (64 - lane));
        int base = 3, eqbase = 0;
        if (lane == 0) { int z_ = 0; asm volatile("" : "+v"(z_)); sel[0] = z_; sel[1] = z_ + 255; sel[2] = z_ + 256; }
#pragma unroll
        for (int i = 0; i < 4; ++i) { const unsigned long long e = __ballot(k[i] == Tv); const int rk = eqbase + __popcll(e & below); const bool on = k[i] > Tv || (k[i] == Tv && rk < need);
            const unsigned long long m = __ballot(on); if (on) sel[base + __popcll(m & below)] = lane + 64 * i; base += __popcll(m); eqbase += __popcll(e); } }
    __syncthreads();
    const float* kvn = (const float*)(P.ws + WS_KVN) + (size_t)b * 768;
    const int* pt = P.page_table + b * NPAGES; const float* cs = P.cache_slc;
    sample_branch(F, 1024, sh_slc, [&](int s, const float*& kp, const float*& vp) { const int j = sel[s >> 6], rr = s & 63;
        if (j == 256) { kp = kvn + (1 * 2 + 0) * 128 + g * 64; vp = kvn + (1 * 2 + 1) * 128 + g * 64; return rr == 0; }
        const float* rowp = cs + ((size_t)pt[j >> 1] * 128 + (j & 1) * 64 + rr) * 256 + g * 64; kp = rowp; vp = rowp + 128; return true; }, osm + 256);
    if (F.tid < 256) osm[256 + F.tid] = osm[256 + F.tid] / lsm[F.tid >> 6];
    __syncthreads();
    const float* stw = P.st_win + (size_t)b * 512 * 256;
    sample_branch(F, 512, sh_win, [&](int s, const float*& kp, const float*& vp) {
        if (s == 511) { kp = kvn + (2 * 2 + 0) * 128 + g * 64; vp = kvn + (2 * 2 + 1) * 128 + g * 64; return true; }
        const float* rowp = stw + (size_t)(s + 1) * 256 + g * 64; kp = rowp; vp = rowp + 128; return true; }, osm + 512);
    if (F.tid < 256) { const int hq = F.tid >> 6, d = F.tid & 63; const float* gs = (const float*)(P.ws + WS_GS) + b * 24 + (g * 4 + hq) * 3;
        const float o = gs[0] * osm[F.tid] + gs[1] * osm[256 + F.tid] + gs[2] * osm[512 + F.tid] / lsm[hq];
        ((bf16*)(P.ws + WS_MIXS))[(size_t)b * 1024 + 512 + (g * 4 + hq) * 64 + d] = (bf16)f2bf(o * ((const float*)(P.ws + WS_ZAS))[(size_t)b * 512 + (g * 4 + hq) * 64 + d]); }
    __syncthreads();
}
__device__ __forceinline__ void p3_phase(const Ptrs& P, Frame& F, int rep) {
    const float* cst = (const float*)(P.ws + WS_CONST);
    float kcmax = 0.f; for (int e_ = 0; e_ < 4; ++e_) kcmax += __builtin_bit_cast(float, __hip_atomic_load((unsigned*)(P.ws + WS_CTL) + CW_KCMAX + e_, RLX_AGENT));
    const float sh_cmp = cst[0] * sqrtf(kcmax) * LOG2E * 1.001f, sh_slc = cst[1], sh_win = cst[2];
    unsigned long long tacc = 0ull;
    volatile LAS int* qw = (volatile LAS int*)(F.lds + P3_MISC);
#ifndef PROBE_P3
#define PROBE_P3 0
#endif
    constexpr int NS_ = PROBE_P3 == 1 ? 16 : 8, PSH_ = PROBE_P3 == 2 ? 1 : 0;
    constexpr int NQ = NS_ + (128 << PSH_);
    const int x0 = (int)(xb_xcc_id() & 7u);
    for (int xi = 0; xi < 8; ++xi) {
        const int x = (x0 + xi) & 7;
        for (;;) {
            __syncthreads();
            if (F.tid == 0) qw[0] = (int)__hip_atomic_fetch_add((unsigned*)(F.ctl + CW_QUEUE + 64 * (x + 8 * rep)), 1u, RLX_AGENT);
            __syncthreads();
            const int idx = qw[0];
            if (idx >= NQ) break;
            if (idx < NS_) p3_sample_unit(P, F, x * 4 + ((idx & 7) >> 1), idx & 1);
            else p3_prompt_unit(P, F, x >> 1, 127 - ((idx - NS_) >> PSH_), x & 1, sh_cmp, sh_slc, sh_win, tacc);
        }
    }
    if (PROBE_SEG != 0 && blockIdx.x == 0) { const unsigned long long t0_ = __builtin_readcyclecounter(); while (__builtin_readcyclecounter() - t0_ < tacc) __builtin_amdgcn_s_sleep(8); }
}
#ifndef MK_N_LAUNCHES
#define MK_N_LAUNCHES 1
#endif
constexpr int N_PHASES = 5;
constexpr int N_LAUNCHES = MK_N_LAUNCHES;
struct Args { Ptrs p; int ph_lo, ph_hi, rep, mode; };
__global__ void __launch_bounds__(NWAVES * 64, 2) nsa_fwd(Args args) {
    extern __shared__ __attribute__((aligned(16))) unsigned char lds[];
    const Ptrs& P = args.p;
    Frame F;
    F.lds = (LAS unsigned char*)lds;
    F.MISC = (volatile LAS unsigned*)(F.lds + MISC_OFF);
    F.tid = threadIdx.x; F.lane = F.tid & 63; F.wave = __builtin_amdgcn_readfirstlane(F.tid >> 6);
    F.G = gridDim.x; F.gw = blockIdx.x * NWAVES + F.wave; F.NGW = F.G * NWAVES;
    F.ctl = (gu32*)(P.ws + WS_CTL);
    for (int u = F.tid; u < (LDS_BYTES - LDSCTL_OFF) / 4; u += NWAVES * 64) ((LAS unsigned*)(F.lds + LDSCTL_OFF))[u] = 0u;
    __syncthreads();
    XcdBarrier bar; bar.bar = (unsigned*)(F.ctl + CW_BAR); bar.x = 0; bar.st = nullptr;
    if (N_LAUNCHES == 1) bar = xcd_barrier_post((unsigned*)(F.ctl + CW_BAR), F.MISC + 8);
    const int lo = args.ph_lo, hi = args.ph_hi;
    unsigned long long tprobe = 0ull;
#define IN(k) (lo <= (k) && (k) < hi)
#define FENCE() do { asm volatile("" : "+s"(F.wave), "+s"(F.gw)); F.lane = (int)__builtin_amdgcn_mbcnt_hi(~0u, __builtin_amdgcn_mbcnt_lo(~0u, 0u)); F.tid = F.wave * 64 + F.lane; asm volatile("" : "+v"(F.tid), "+v"(F.lane)); } while (0)
#define SEAM(k) do { if (IN(k) && IN((k) + 1)) xcd_barrier(bar, F.wave == 0 && (int)__builtin_amdgcn_mbcnt_hi(~0u, __builtin_amdgcn_mbcnt_lo(~0u, 0u)) == 0); } while (0)

    if (IN(0)) { FENCE(); p0_phase(P, F); } SEAM(0);
    if (IN(1)) { FENCE();
        pg8::Gemm g{(const pg8::bf16_t*)(P.ws + WS_XB), (const pg8::bf16_t*)(P.ws + WS_BT1), M, NP, D};
        EpiIn E{(const float*)(P.ws + WS_RSTD), (const float*)(P.ws + WS_ROPE), P.q_gain, P.k_gain, P.out, P.ws};
        const int nround = ((M / 256) * (NP / 256) + F.G - 1) / F.G, jx = (int)blockIdx.x >> 3,
                  kst = (((((int)blockIdx.x & 7) + 2 * (((jx >> 2) & 1) | ((jx >> 4) << 1))) & 7) * nround) >> 3;
        { pg8::StaticOrder S; S.init(M, NP, F.G, (int)blockIdx.x, 0, kst); pg8::gemm_phase<EpiIn, pg8::StaticOrder, true, true>(F.lds + RING_OFF, g, S, E, F.wave, tprobe); }
        FENCE(); __syncthreads();
#ifdef PROBE_CW
        const unsigned long long tc0_ = __builtin_readcyclecounter();
#endif
        compress_wg(P, F, F.lds + RING_OFF);
        __syncthreads(); FENCE();
#ifdef PROBE_CW
        asm volatile("s_waitcnt vmcnt(0)" ::: "memory"); tprobe = __builtin_readcyclecounter() - tc0_;
#endif
        { pg8::StaticOrder S; S.init(M, NP, F.G, (int)blockIdx.x, kst, nround - kst); pg8::gemm_phase<EpiIn, pg8::StaticOrder, true, true>(F.lds + RING_OFF, g, S, E, F.wave, tprobe); }
        FENCE();
        for (int ct = F.gw; ct < NP / 16; ct += F.NGW) small_gemm_tile<0>(P, (const bf16*)(P.ws + WS_XSB), (const bf16*)(P.ws + WS_BT1), ct, F.lane);
#ifdef PROBE_CW
        if (blockIdx.x == PROBE_CW) { const unsigned long long t0_ = __builtin_readcyclecounter(); while (__builtin_readcyclecounter() - t0_ < tprobe) __builtin_amdgcn_s_sleep(8); }
        tprobe = 0ull;
#endif
#if defined(PROBE_EPI)
        if (PROBE_EPI == 1 && blockIdx.x == 0) { const unsigned long long t0_ = __builtin_readcyclecounter(); while (__builtin_readcyclecounter() - t0_ < tprobe) __builtin_amdgcn_s_sleep(8); }
        tprobe = 0ull;
#endif
    } SEAM(1);
    if (IN(2)) { FENCE(); p2_phase(P, F); } SEAM(2);
    if (IN(3)) { FENCE(); p3_phase(P, F, args.rep); } SEAM(3);
    if (IN(4)) { FENCE();
        pg8::Gemm g{(const pg8::bf16_t*)(P.ws + WS_MIX), (const pg8::bf16_t*)(P.ws + WS_BT2), M, D, D}; pg8::StaticOrder S; S.init(M, D, F.G, (int)blockIdx.x);
        EpiOut E{P.xp, P.out + O_Y};
        pg8::gemm_phase<EpiOut, pg8::StaticOrder, true, true>(F.lds + RING_OFF, g, S, E, F.wave, tprobe);
        FENCE();
        for (int ct = F.gw; ct < D / 16; ct += F.NGW) small_gemm_tile<1>(P, (const bf16*)(P.ws + WS_MIXS), (const bf16*)(P.ws + WS_BT2), ct, F.lane);
#if defined(PROBE_EPI)
        if (PROBE_EPI == 2 && blockIdx.x == 0) { const unsigned long long t0_ = __builtin_readcyclecounter(); while (__builtin_readcyclecounter() - t0_ < tprobe) __builtin_amdgcn_s_sleep(8); }
#endif
    }
#undef IN
#undef SEAM
}

extern "C" void kernel_launch(void* const* d_in, const int* in_sizes, int n_in, void* d_out, int out_size, void* d_ws, size_t ws_size, hipStream_t stream) {
    static int grid = 0;
    if (grid == 0) {
        if (n_in != 16 || out_size != (int)O_END || ws_size < WS_END) { fprintf(stderr, "kernel_launch: unexpected shapes (n_in %d, out %d, ws %zu)\n", n_in, out_size, ws_size); grid = -1; return; }
        int dev = 0, cus = 0, per_cu = 0;
        if (hipGetDevice(&dev) != hipSuccess || hipDeviceGetAttribute(&cus, hipDeviceAttributeMultiprocessorCount, dev) != hipSuccess) { grid = -1; return; }
        if (hipFuncSetAttribute((const void*)nsa_fwd, hipFuncAttributeMaxDynamicSharedMemorySize, LDS_BYTES) != hipSuccess) { fprintf(stderr, "kernel_launch: hipFuncSetAttribute failed\n"); grid = -1; return; }
        if (hipOccupancyMaxActiveBlocksPerMultiprocessor(&per_cu, (const void*)nsa_fwd, NWAVES * 64, LDS_BYTES) != hipSuccess || per_cu < 1)
            fprintf(stderr, "kernel_launch: note: occupancy query reports %d workgroups per CU\n", per_cu);
        (void)hipGetLastError();
        grid = cus;
    }
    if (grid < 0) return;
    if (hipMemsetAsync((char*)d_ws + WS_CTL, 0, CTL_ZERO_BYTES, stream) != hipSuccess) return;
    Args a{}; a.mode = 3;
    a.p.xp = (const float*)d_in[0]; a.p.xs = (const float*)d_in[1]; a.p.cache_cmp = (const float*)d_in[2]; a.p.cache_slc = (const float*)d_in[3];
    a.p.st_win = (const float*)d_in[4]; a.p.st_conv = (const float*)d_in[5]; a.p.page_table = (const int*)d_in[6]; a.p.norm_g = (const float*)d_in[7];
    a.p.w_in = (const float*)d_in[8]; a.p.conv_w = (const float*)d_in[9]; a.p.conv_b = (const float*)d_in[10]; a.p.q_gain = (const float*)d_in[11];
    a.p.k_gain = (const float*)d_in[12]; a.p.cmp_pe = (const float*)d_in[13]; a.p.cmp_w = (const float*)d_in[14]; a.p.w_out = (const float*)d_in[15];
    a.p.out = (float*)d_out; a.p.ws = (unsigned char*)d_ws;
#ifndef PROBE_DUP
#define PROBE_DUP -1
#endif
    for (int li = 0; li < N_LAUNCHES; ++li) {
        a.ph_lo = (N_LAUNCHES == 1) ? 0 : li; a.ph_hi = (N_LAUNCHES == 1) ? N_PHASES : li + 1;
        for (int rep = 0; rep < ((N_LAUNCHES > 1 && li == PROBE_DUP) ? 2 : 1); ++rep) {
            a.rep = rep;
            hipLaunchKernelGGL(nsa_fwd, dim3(grid), dim3(NWAVES * 64), LDS_BYTES, stream, a);
            const hipError_t le = hipPeekAtLastError();
            if (le != hipSuccess) { fprintf(stderr, "kernel_launch: launch %d failed: %s\n", li, hipGetErrorName(le)); break; }
        }
    }
}
```

```cpp
#include <hip/hip_runtime.h>
#include <cstdio>
#include <cstdint>
#define GAS __attribute__((address_space(1)))
#define LAS __attribute__((address_space(3)))
typedef unsigned short bf16;
typedef unsigned v4u __attribute__((ext_vector_type(4)));
typedef unsigned v2u __attribute__((ext_vector_type(2)));
typedef float f32x2 __attribute__((ext_vector_type(2)));
typedef float f32x16 __attribute__((ext_vector_type(16)));
typedef GAS unsigned gu32;
typedef GAS unsigned long long gu64;
#define RLX_AGENT __ATOMIC_RELAXED, __HIP_MEMORY_SCOPE_AGENT
#define LDS_WAIT() asm volatile("s_waitcnt lgkmcnt(0)" ::: "memory")
#define VM_WAIT() asm volatile("s_waitcnt vmcnt(0)" ::: "memory")
#define MK_N_LAUNCHES 1
#define PROBE_DUP -1
#define PROBE_P3 0
#define PROBE_SEG 0
namespace pg8 {
#define PG8_LAS __attribute__((address_space(3)))
typedef unsigned short bf16_t;
typedef short bf16x8 __attribute__((ext_vector_type(8)));
typedef float f32x4 __attribute__((ext_vector_type(4)));
typedef unsigned u32x4 __attribute__((ext_vector_type(4)));
constexpr int BM = 256, BK = 64, HALF = 128, HTB = HALF * BK * 2  , STAGE_BYTES = 8 * HTB, NXCD = 8, WGM = 8;

__host__ __device__ __forceinline__ int lds_byte(int r, int c) { const int st = (r >> 4) * 2 + (c >> 5), rr = r & 15, cc = c & 31, ob = rr * 64 + cc * 2; return st * 1024 + (ob ^ (((ob >> 9) & 1) << 5)); }
__host__ __device__ __forceinline__ void stage_rc(int b, int& R, int& C) { const int st = b / 1024, sb = b % 1024, swz = sb ^ (((sb >> 9) & 1) << 5); R = (st >> 1) * 16 + swz / 64; C = (st & 1) * 32 + (swz % 64) / 2; }
__host__ __device__ __forceinline__ int perm32(int rho) { const int n = rho >> 4, i = rho & 15; return 8 * (i >> 2) + 4 * n + (i & 3); }

struct Unit { int pm, pn; };
struct Gemm { const bf16_t* A; const bf16_t* Bt; int M, N, K; };

struct StaticOrder {
    int nM, nN, nwg, G, c, i0, n;
    __host__ __device__ void init(int M, int N, int G_, int c_, int i0_ = 0, int n_ = 1 << 30) { nM = M / BM; nN = N / BM; nwg = nM * nN; G = G_; c = c_; i0 = i0_; n = n_; }
    __host__ __device__ bool next(int i, Unit& u) const {
        if (i >= n) return false;
        const long L = (long)(i + i0) * G + c; if (L >= nwg) return false;
        int wgid = (int)L; { const int q = nwg / NXCD, r = nwg % NXCD, xcd = wgid % NXCD, off = wgid / NXCD; wgid = (xcd < r ? xcd * (q + 1) : r * (q + 1) + (xcd - r) * q) + off; }
        const int nig = WGM * nN, gid = wgid / nig, fm = gid * WGM, gsz = (nM - fm) < WGM ? (nM - fm) : WGM;
        u.pm = fm + ((wgid % nig) % gsz); u.pn = (wgid % nig) / gsz; return true;
    }
    __device__ __forceinline__ void a_ready(const Unit&) const {}
    __device__ __forceinline__ void done(const Unit&) const {}
};


template <class Epi, class Sched, bool ALIGN_EPI = false, bool SP2 = false>
__device__ __forceinline__ void gemm_phase(PG8_LAS unsigned char* lds, const Gemm g, const Sched& S, const Epi& E, int wave_id  , unsigned long long& tacc_  ) {
    const int lane = (int)__builtin_amdgcn_mbcnt_hi(~0u, __builtin_amdgcn_mbcnt_lo(~0u, 0u)), wid = wave_id, tid = wid * 64 + lane, wr = wid >> 2, wc = wid & 3, fr = lane & 15, fq = lane >> 4;
    const int K = g.K, nt = K / BK;
    unsigned voffA[2], voffB[2];
#pragma unroll
    for (int i = 0; i < 2; ++i) { int R, C; stage_rc(tid * 16 + i * 8192, R, C); const int Rb = Epi::PERM ? ((R & ~31) + perm32(R & 31)) : R;
        voffA[i] = (unsigned)(R * K + C) * 2u; voffB[i] = (unsigned)(Rb * K + C) * 2u; }
    const size_t kstep = (size_t)(BK * 2);
    const size_t hstep = (size_t)HALF * K * 2;
    const size_t tstep = 2 * hstep;
    const unsigned ldsw = (unsigned)wid * 1024u;
    const int aoff = lds_byte(wr * 64 + fr, fq * 8), boff = lds_byte(wc * 32 + fr, fq * 8);
#define PG8_SA(b, h) (((b) * 2 + (h)) * HTB)
#define PG8_SB(b, h) ((4 + (b) * 2 + (h)) * HTB)
#define PG8_STAGE(bufoff, gbase, voff) do { _Pragma("unroll") for (int _i = 0; _i < 2; ++_i) \
        __builtin_amdgcn_global_load_lds((const unsigned*)((const char*)(gbase) + (voff)[_i]), (PG8_LAS unsigned*)(lds + (bufoff) + ldsw + _i * 8192), 16, 0, 0); } while (0)
#define PG8_LDA(dst, b, h) do { _Pragma("unroll") for (int m = 0; m < 4; ++m) _Pragma("unroll") for (int k = 0; k < 2; ++k) dst[m][k] = *(const PG8_LAS bf16x8*)(lds + PG8_SA(b, h) + aoff + m * 2048 + k * 1024); } while (0)
#define PG8_LDB(dst, b, h) do { _Pragma("unroll") for (int n = 0; n < 2; ++n) _Pragma("unroll") for (int k = 0; k < 2; ++k) dst[n][k] = *(const PG8_LAS bf16x8*)(lds + PG8_SB(b, h) + boff + n * 2048 + k * 1024); } while (0)
#define PG8_MMA(ai, bj, At, Bt) do { __builtin_amdgcn_s_setprio(1); _Pragma("unroll") for (int m = 0; m < 4; ++m) _Pragma("unroll") for (int n = 0; n < 2; ++n) _Pragma("unroll") for (int k = 0; k < 2; ++k) \
        acc[ai][bj][m][n] = __builtin_amdgcn_mfma_f32_16x16x32_bf16(Bt[n][k], At[m][k], acc[ai][bj][m][n], 0, 0, 0); __builtin_amdgcn_s_setprio(0); } while (0)
#define PG8_WAIT_V(n) asm volatile("s_waitcnt vmcnt(" #n ")" ::: "memory")
#define PG8_WAIT_L(n) asm volatile("s_waitcnt lgkmcnt(" #n ")" ::: "memory")
#define PG8_BAR __builtin_amdgcn_s_barrier()
#define PG8_SCHED __builtin_amdgcn_sched_barrier(0)
    Unit cur, nxt; int ui = 0;
    if (!S.next(0, cur)) return;
    f32x4 acc[2][2][4][2];
#pragma unroll
    for (int a = 0; a < 2; ++a)
#pragma unroll
        for (int b = 0; b < 2; ++b)
#pragma unroll
            for (int m = 0; m < 4; ++m)
#pragma unroll
                for (int n = 0; n < 2; ++n) acc[a][b][m][n] = (f32x4){0.f, 0.f, 0.f, 0.f};
    bf16x8 At[4][2], B0[2][2], B1[2][2];
    const char* cA = (const char*)g.A + (size_t)cur.pm * tstep; const char* cB = (const char*)g.Bt + (size_t)cur.pn * tstep;
    S.a_ready(cur);
    if constexpr (SP2) {
        PG8_STAGE(PG8_SB(0, 0), cB, voffB); PG8_STAGE(PG8_SB(0, 1), cB + hstep, voffB); PG8_STAGE(PG8_SA(0, 0), cA, voffA); PG8_STAGE(PG8_SA(0, 1), cA + hstep, voffA);
        if (wr == 1) PG8_BAR;
        PG8_WAIT_V(2); PG8_BAR;
        PG8_STAGE(PG8_SB(1, 0), cB + kstep, voffB); PG8_STAGE(PG8_SA(1, 0), cA + kstep, voffA); PG8_STAGE(PG8_SB(1, 1), cB + hstep + kstep, voffB);
        PG8_WAIT_V(6); PG8_BAR;
    } else {
        PG8_STAGE(PG8_SB(0, 0), cB, voffB); PG8_STAGE(PG8_SA(0, 0), cA, voffA); PG8_STAGE(PG8_SB(0, 1), cB + hstep, voffB); PG8_STAGE(PG8_SA(0, 1), cA + hstep, voffA);
        if (wr == 1) PG8_BAR;
        PG8_WAIT_V(4); PG8_BAR;
        PG8_STAGE(PG8_SB(1, 0), cB + kstep, voffB); PG8_STAGE(PG8_SA(1, 0), cA + kstep, voffA); PG8_STAGE(PG8_SB(1, 1), cB + hstep + kstep, voffB);
        PG8_WAIT_V(6); PG8_BAR;
    }
    for (;;) {
        const bool has_next = S.next(ui + 1, nxt);
        const char* nA = has_next ? (const char*)g.A + (size_t)nxt.pm * tstep : cA; const char* nB = has_next ? (const char*)g.Bt + (size_t)nxt.pn * tstep : cB;
        for (int t = 0; t < nt; t += 2) {
            const bool last = (t == nt - 2);
            const char* a1 = cA + (size_t)(t + 1) * kstep;
            const char* a2 = last ? nA : cA + (size_t)(t + 2) * kstep; const char* b2 = last ? nB : cB + (size_t)(t + 2) * kstep;
            const char* a3 = a2 + kstep; const char* b3 = b2 + kstep;
            if (last && has_next) S.a_ready(nxt);
            if constexpr (SP2) {
            PG8_LDB(B0, 0, 0); PG8_LDB(B1, 0, 1); PG8_SCHED; PG8_LDA(At, 0, 0); PG8_STAGE(PG8_SA(1, 1), a1 + hstep, voffA);
            PG8_WAIT_V(8); PG8_WAIT_L(0); PG8_BAR; PG8_MMA(0, 0, At, B0); PG8_MMA(0, 1, At, B1); PG8_BAR; PG8_SCHED;
            PG8_LDA(At, 0, 1); PG8_STAGE(PG8_SB(0, 0), b2, voffB); PG8_STAGE(PG8_SB(0, 1), b2 + hstep, voffB); PG8_STAGE(PG8_SA(0, 0), a2, voffA);
            PG8_WAIT_V(8); PG8_WAIT_L(0); PG8_BAR; PG8_MMA(1, 0, At, B0); PG8_MMA(1, 1, At, B1); PG8_BAR; PG8_SCHED;
            PG8_LDB(B0, 1, 0); PG8_LDB(B1, 1, 1); PG8_SCHED; PG8_LDA(At, 1, 0); PG8_STAGE(PG8_SA(0, 1), a2 + hstep, voffA);
            PG8_WAIT_V(8); PG8_WAIT_L(0); PG8_BAR; PG8_MMA(0, 0, At, B0); PG8_MMA(0, 1, At, B1); PG8_BAR; PG8_SCHED;
            PG8_LDA(At, 1, 1); PG8_STAGE(PG8_SB(1, 0), b3, voffB); PG8_STAGE(PG8_SB(1, 1), b3 + hstep, voffB); PG8_STAGE(PG8_SA(1, 0), a3, voffA);
            PG8_WAIT_V(8); PG8_WAIT_L(0); PG8_BAR; PG8_MMA(1, 0, At, B0); PG8_MMA(1, 1, At, B1); PG8_BAR; PG8_SCHED;
            } else {
            PG8_LDB(B0, 0, 0); PG8_SCHED; PG8_LDA(At, 0, 0); PG8_STAGE(PG8_SA(1, 1), a1 + hstep, voffA);
            PG8_WAIT_L(8); PG8_BAR; PG8_WAIT_L(0); PG8_MMA(0, 0, At, B0); PG8_BAR; PG8_SCHED;
            PG8_LDB(B1, 0, 1); PG8_STAGE(PG8_SB(0, 0), b2, voffB);
            PG8_BAR; PG8_WAIT_L(0); PG8_MMA(0, 1, At, B1); PG8_BAR;
            PG8_LDA(At, 0, 1); PG8_STAGE(PG8_SA(0, 0), a2, voffA);
            PG8_BAR; PG8_WAIT_L(0); PG8_MMA(1, 0, At, B0); PG8_BAR; PG8_SCHED;
            PG8_STAGE(PG8_SB(0, 1), b2 + hstep, voffB);
            PG8_WAIT_V(6); PG8_BAR; PG8_MMA(1, 1, At, B1); PG8_BAR;
            PG8_LDB(B0, 1, 0); PG8_SCHED; PG8_LDA(At, 1, 0); PG8_STAGE(PG8_SA(0, 1), a2 + hstep, voffA);
            PG8_WAIT_L(8); PG8_BAR; PG8_WAIT_L(0); PG8_MMA(0, 0, At, B0); PG8_BAR; PG8_SCHED;
            PG8_LDB(B1, 1, 1); PG8_STAGE(PG8_SB(1, 0), b3, voffB);
            PG8_BAR; PG8_WAIT_L(0); PG8_MMA(0, 1, At, B1); PG8_BAR;
            PG8_LDA(At, 1, 1); PG8_STAGE(PG8_SA(1, 0), a3, voffA);
            PG8_BAR; PG8_WAIT_L(0); PG8_MMA(1, 0, At, B0); PG8_BAR; PG8_SCHED;
            PG8_STAGE(PG8_SB(1, 1), b3 + hstep, voffB);
            PG8_WAIT_V(6); PG8_BAR; PG8_MMA(1, 1, At, B1); PG8_BAR;
            }
        }
        if constexpr (ALIGN_EPI) { if (wr == 0) PG8_BAR; }
#ifdef PROBE_EPI
        { const unsigned long long t0_ = __builtin_readcyclecounter(); E(acc, cur, wr, wc, fr, fq); asm volatile("s_waitcnt vmcnt(0)" ::: "memory"); tacc_ += __builtin_readcyclecounter() - t0_; S.done(cur); }
#else
        if constexpr (!Epi::AFTER_DRAIN) { E(acc, cur, wr, wc, fr, fq); S.done(cur); }
#endif
        if (!has_next) break;
#pragma unroll
        for (int a = 0; a < 2; ++a)
#pragma unroll
            for (int b = 0; b < 2; ++b)
#pragma unroll
                for (int m = 0; m < 4; ++m)
#pragma unroll
                    for (int n = 0; n < 2; ++n) acc[a][b][m][n] = (f32x4){0.f, 0.f, 0.f, 0.f};
        cur = nxt; cA = nA; cB = nB; ++ui;
        if constexpr (ALIGN_EPI) { if (wr == 1) PG8_BAR; }
    }
    PG8_WAIT_V(0);
    if constexpr (!ALIGN_EPI) { if (wr == 0) PG8_BAR; }
    PG8_BAR;
    if constexpr (Epi::AFTER_DRAIN) { E.fused(acc, cur, wr, wc, fr, fq, lds, wid, lane); S.done(cur); }
#undef PG8_SA
#undef PG8_SB
#undef PG8_STAGE
#undef PG8_LDA
#undef PG8_LDB
#undef PG8_MMA
#undef PG8_WAIT_V
#undef PG8_WAIT_L
#undef PG8_BAR
#undef PG8_SCHED
}
}
#define XB_TMO      128
#define XB_XCNT(j)  (256  + 64 * (j))
#define XB_XSUB(j)  (1280 + 64 * (j))
#define XB_XGEN(j)  (2304 + 64 * (j))
#define XB_TOP      3328
#define XB_TOPGEN   3392
#define XCD_BAR_WORDS 3456
#define XB_SPIN_CAP (1u << 18)

__device__ __forceinline__ unsigned xb_ld(unsigned* p)              { return __hip_atomic_load(p, __ATOMIC_RELAXED, __HIP_MEMORY_SCOPE_AGENT); }
__device__ __forceinline__ unsigned xb_add(unsigned* p, unsigned v) { return __hip_atomic_fetch_add(p, v, __ATOMIC_RELAXED, __HIP_MEMORY_SCOPE_AGENT); }
__device__ __forceinline__ unsigned xb_xcc_id() { return (unsigned)__builtin_amdgcn_s_getreg((3 << 11) | 20) & 0xFu; }
#define XB_SPIN(cond, bar) do { unsigned _sp = 0; while (cond) { __builtin_amdgcn_s_sleep(1); \
    if ((++_sp & 255u) == 0u) { if (xb_ld(&(bar)[XB_TMO])) break; if (_sp > XB_SPIN_CAP) { atomicAdd(&(bar)[XB_TMO], 1u); break; } } } } while (0)

struct XcdBarrier {
    unsigned* bar; unsigned x;
    volatile LAS unsigned* st;
};

__device__ __forceinline__ XcdBarrier xcd_barrier_post(unsigned* bar, volatile LAS unsigned* st) {
    XcdBarrier b; b.bar = bar; b.x = xb_xcc_id(); b.st = st;
    if (threadIdx.x == 0) (void)xb_add(&bar[XB_XCNT(b.x)], 1u);
    return b;
}
__device__ __forceinline__ void xcd_barrier_complete(unsigned* bar, unsigned x, unsigned& nloc, unsigned& nx) {
    const unsigned G = gridDim.x * gridDim.y * gridDim.z;
    unsigned sum, cnt, mine, sp = 0u;
    for (;;) {
        sum = 0u; cnt = 0u; mine = 0u;
#pragma unroll
        for (unsigned j = 0; j < 16; ++j) { const unsigned c = xb_ld(&bar[XB_XCNT(j)]); sum += c; cnt += (c > 0u) ? 1u : 0u; mine = (j == x) ? c : mine; }
        if (sum == G) break;
        __builtin_amdgcn_s_sleep(1);
        if ((++sp & 255u) == 0u) { if (xb_ld(&bar[XB_TMO])) break; if (sp > XB_SPIN_CAP) { atomicAdd(&bar[XB_TMO], 1u); break; } }
    }
    nloc = mine > 0u ? mine : 1u; nx = cnt > 0u ? cnt : 1u;
}

__device__ __forceinline__ void xcd_barrier(const XcdBarrier& b, bool leader  ) {
    asm volatile("s_waitcnt vmcnt(0)" ::: "memory");
    __syncthreads();
    if (leader) {
        unsigned* bar = b.bar;
        __builtin_amdgcn_s_waitcnt(0);
        unsigned nloc = b.st[0], nx = b.st[1];
        if (nloc == 0u) { xcd_barrier_complete(bar, b.x, nloc, nx); b.st[0] = nloc; b.st[1] = nx; }
        const unsigned old = xb_add(&bar[XB_XSUB(b.x)], 1u);
        const unsigned gen = old / nloc;
        if (old + 1u == (gen + 1u) * nloc) {
            __builtin_amdgcn_fence(__ATOMIC_RELEASE, "agent");
            asm volatile("s_waitcnt vmcnt(0)" ::: "memory");
            const unsigned og = xb_add(&bar[XB_TOP], 1u);
            const unsigned tg = og / nx;
            if (og + 1u == (tg + 1u) * nx) xb_add(&bar[XB_TOPGEN], 1u);
            else XB_SPIN(xb_ld(&bar[XB_TOPGEN]) == tg, bar);
            __builtin_amdgcn_fence(__ATOMIC_ACQUIRE, "agent");
            xb_add(&bar[XB_XGEN(b.x)], 1u);
            asm volatile("s_waitcnt vmcnt(0)" ::: "memory");
        } else {
            XB_SPIN(xb_ld(&bar[XB_XGEN(b.x)]) == gen, bar);
            __builtin_amdgcn_fence(__ATOMIC_ACQUIRE, "agent");
            asm volatile("s_waitcnt vmcnt(0)" ::: "memory");
        }
    }
    __syncthreads();
}
using pg8::f32x4; using pg8::bf16x8;
constexpr int NWAVES = 8;
constexpr int BATCH = 4, T = 8192, D = 1024, M = BATCH * T, NP = 4096, INW = 3864;
constexpr int DECB = 32, PAST = 16384, NPAGES = 128, NCS = 512  ;
constexpr float NORM_EPS = 1e-6f;
constexpr float LOG2E = 1.4426950408889634f;
constexpr float QSCALE = 0.125f * LOG2E;
constexpr size_t O_Y = 0, O_YS = 33554432, O_PCMP = 33587200, O_PSLC = 41975808, O_PWIN = 50364416, O_PCONV = 50888704,
                 O_SCMP = 50892800, O_SSLC = 50900992, O_SWIN = 50909184, O_SCONV = 55103488, O_END = 55136256;
constexpr int C_BG = 0, C_CG = 512, C_CI = 1024, C_ZC = 1536, C_Q = 2048, C_KV = 2560, C_GL = 3328, C_ZA = 3352;

constexpr size_t MiB = 1u << 20, KiB = 1u << 10;
constexpr size_t WS_CTL = 0, CTL_ZERO_BYTES = 1 * MiB;
constexpr size_t WS_BT1 = 2 * MiB;
constexpr size_t WS_BT2 = 10 * MiB;
constexpr size_t WS_BTC = 12 * MiB;
constexpr size_t WS_CBIAS = 12 * MiB + 512 * KiB;
constexpr size_t WS_CONST = WS_CBIAS + 4 * KiB;
constexpr size_t WS_ROPE = 13 * MiB;
constexpr size_t WS_RSTD = 16 * MiB;
constexpr size_t WS_XSB = 16 * MiB + 256 * KiB;
constexpr size_t WS_RSTDS = WS_XSB + 64 * KiB;
constexpr size_t WS_GATE = 17 * MiB;
constexpr size_t WS_KC = 20 * MiB;
constexpr size_t WS_PROJS = 21 * MiB;
constexpr size_t WS_QS = 22 * MiB;
constexpr size_t WS_KVN = WS_QS + 64 * KiB;
constexpr size_t WS_GS = WS_KVN + 96 * KiB;
constexpr size_t WS_ZAS = WS_GS + 4 * KiB;
constexpr size_t WS_MIXS = WS_ZAS + 64 * KiB;
constexpr size_t WS_KCS = 24 * MiB;
constexpr size_t WS_KS = 40 * MiB, WS_KW = 56 * MiB;
constexpr size_t WS_XB = 72 * MiB;
constexpr size_t WS_CG = 136 * MiB, WS_U = 168 * MiB, WS_ZA = 200 * MiB, WS_Q = 232 * MiB;
constexpr size_t WS_MIX = 264 * MiB;
constexpr size_t WS_TOT = 328 * MiB;
constexpr size_t WS_END = 344 * MiB;
constexpr int CW_TMO = 0, CW_CODE = 1;
constexpr int CW_BAR = 4096;
constexpr int CW_QUEUE = 16384;
constexpr int CW_P0CNT = 18432;
constexpr int CW_KCMAX = 20480;

constexpr int RING_OFF = 0, RING_BYTES = 131072;
constexpr int LDSCTL_OFF = RING_BYTES, MISC_OFF = LDSCTL_OFF + 320;
constexpr int LDS_BYTES = 147456;

__device__ __forceinline__ unsigned f2bf(float f) { unsigned u = __builtin_bit_cast(unsigned, f); return (u + 0x7fffu + ((u >> 16) & 1u)) >> 16; }
typedef __bf16 bf16x2_t __attribute__((ext_vector_type(2)));
__device__ __forceinline__ unsigned pk2(float lo, float hi) { return __builtin_bit_cast(unsigned, __builtin_convertvector((f32x2){lo, hi}, bf16x2_t)); }
__device__ __forceinline__ float bf2f(unsigned h) { return __builtin_bit_cast(float, h << 16); }
__device__ __forceinline__ float wave_sum(float v) {
#pragma unroll
    for (int o = 1; o < 64; o <<= 1) v += __shfl_xor(v, o);
    return v;
}
__device__ __forceinline__ float quad_sum(float v) {
    v += __builtin_bit_cast(float, __builtin_amdgcn_update_dpp(0, __builtin_bit_cast(int, v), 0xB1, 0xF, 0xF, true));
    v += __builtin_bit_cast(float, __builtin_amdgcn_update_dpp(0, __builtin_bit_cast(int, v), 0x4E, 0xF, 0xF, true));
    return v;
}
__device__ __forceinline__ float fast_exp2(float x) { return __builtin_amdgcn_exp2f(x); }
__device__ __forceinline__ float sigmoidf(float x) { return __builtin_amdgcn_rcpf(1.0f + fast_exp2(-x * LOG2E)); }
__device__ __forceinline__ float slc_vscale(float sh_slc) { return fast_exp2(floorf(18.0f - sh_slc)); }
__device__ __forceinline__ int kimg_off(int key, int d) { return ((((key >> 5) * 4 + (d >> 4)) * 64 + ((d >> 3) & 1) * 32 + (key & 31)) << 3) + (d & 7); }
__device__ __forceinline__ int vimg_off(int d, int pos) { return 4096 + ((((d >> 5) * 4 + (pos >> 4)) * 64 + ((pos >> 3) & 1) * 32 + (d & 31)) << 3) + (pos & 7); }
__device__ __forceinline__ int perm16(int kk) { return 8 * ((kk >> 2) & 1) + 4 * (kk >> 3) + (kk & 3); }

struct Ptrs {
    const float *xp, *xs, *cache_cmp, *cache_slc, *st_win, *st_conv; const int* page_table;
    const float *norm_g, *w_in, *conv_w, *conv_b, *q_gain, *k_gain, *cmp_pe, *cmp_w, *w_out;
    float* out; unsigned char* ws;
};
struct Frame {
    LAS unsigned char* lds;
    volatile LAS unsigned* MISC;
    gu32* ctl;
    int tid, lane, wave, G, gw, NGW;
};
__device__ __forceinline__ int bt1_src(int dg, int& nvalid) {
    const int pn = dg >> 3, gi = dg & 7, bj = gi >> 2, wc = gi & 3; nvalid = 32;
    if (pn < 4) return (bj ? C_ZC : C_BG) + 128 * pn + 32 * wc;
    if (pn < 8) return (bj ? C_CI : C_CG) + 128 * (pn - 4) + 32 * wc;
    if (pn < 10) return C_Q + (4 * (pn - 8) + wc) * 64 + 32 * bj;
    if (pn < 13) return C_KV + (pn - 10) * 256 + wc * 64 + 32 * bj;
    if (pn < 15) return C_ZA + 256 * (pn - 13) + 32 * gi;
    nvalid = (gi == 0) ? 24 : 0; return C_GL;
}
__device__ __forceinline__ void p0_transpose_item(const float* W, int ldw, int k0, int src0, int nvalid, const float* ksc, bf16* WT, int ldt, int drow0, LAS float* scr, int lane) {
    const int nn = lane & 31;
#pragma unroll 8
    for (int i = 0; i < 32; ++i) { const int kk = 2 * i + (lane >> 5); float v = 0.f;
        if (nn < nvalid) { v = W[(size_t)(k0 + kk) * ldw + src0 + nn]; if (ksc) v *= ksc[k0 + kk]; }
        scr[kk * 33 + nn] = v; }
    LDS_WAIT(); asm volatile("" ::: "memory");
    const int c = lane & 7;
#pragma unroll
    for (int j = 0; j < 4; ++j) { const int n = (lane >> 3) + 8 * j; const LAS float* s = scr + (8 * c) * 33 + n;
        v4u o; o.x = pk2(s[0 * 33], s[1 * 33]); o.y = pk2(s[2 * 33], s[3 * 33]); o.z = pk2(s[4 * 33], s[5 * 33]); o.w = pk2(s[6 * 33], s[7 * 33]);
        *(GAS v4u*)(WT + (size_t)(drow0 + n) * ldt + k0 + 8 * c) = o; }
    LDS_WAIT(); asm volatile("" ::: "memory");
}
template <int NR>
__device__ __forceinline__ void x_rows_to_bf16(const float* xrow, bf16* orow, float* rstd_out, int lane) {
    f32x4 v[NR][4]; float s[NR];
#pragma unroll
    for (int r = 0; r < NR; ++r)
#pragma unroll
        for (int j = 0; j < 4; ++j) v[r][j] = ((const GAS f32x4*)(xrow + (size_t)r * D) + lane)[64 * j];
#pragma unroll
    for (int r = 0; r < NR; ++r) { s[r] = 0.f;
#pragma unroll
        for (int j = 0; j < 4; ++j) s[r] += (v[r][j].x * v[r][j].x + v[r][j].y * v[r][j].y) + (v[r][j].z * v[r][j].z + v[r][j].w * v[r][j].w); }
#pragma unroll
    for (int o = 1; o < 64; o <<= 1)
#pragma unroll
        for (int r = 0; r < NR; ++r) s[r] += __shfl_xor(s[r], o);
#pragma unroll
    for (int r = 0; r < NR; ++r) { GAS unsigned long long* o8 = (GAS unsigned long long*)(orow + (size_t)r * D) + lane;
#pragma unroll
        for (int j = 0; j < 4; ++j) o8[64 * j] = (unsigned long long)pk2(v[r][j].x, v[r][j].y) | ((unsigned long long)pk2(v[r][j].z, v[r][j].w) << 32);
        if (lane == 0) rstd_out[r] = 1.0f / sqrtf(s[r] * (1.0f / D) + NORM_EPS); }
}
template <class Side>
__device__ __forceinline__ void compress_prompt_units(const Ptrs& P, Frame& F, LAS float* part  , const Side& side  ) {
    constexpr int NUNITS = BATCH * 32 * 2;
    const int lane = F.lane, w = F.wave, rho = lane & 15, kq = lane >> 4;
    const GAS v4u* bfr = (const GAS v4u*)(P.ws + WS_BTC) + lane;
    const float* cbias = (const float*)(P.ws + WS_CBIAS);
    for (int unit = blockIdx.x; unit < NUNITS; unit += F.G) {
        const int j = unit & 1, b = unit >> 6, c0 = ((unit >> 1) & 31) * 8;
        const float* rb = P.out + O_PCMP + ((size_t)b * T + (c0 + (rho >> 1)) * 32) * 256 + j * 128 + (rho & 1) * 64 + 4 * kq;
        f32x4 a[4][4]; bf16x8 bb[4][8];
#pragma unroll
        for (int rr = 0; rr < 4; ++rr) { const int r = 4 * w + rr;
#pragma unroll
            for (int dh = 0; dh < 2; ++dh) { a[rr][2 * dh] = *(const GAS f32x4*)(rb + r * 256 + dh * 32); a[rr][2 * dh + 1] = *(const GAS f32x4*)(rb + r * 256 + dh * 32 + 16); } }
        f32x4 acc[4];
#pragma unroll
        for (int e = 0; e < 4; ++e) acc[e] = (f32x4){0.f, 0.f, 0.f, 0.f};
        if (unit == (int)blockIdx.x) side();
#pragma unroll
        for (int rr = 0; rr < 4; ++rr) { const int r = 4 * w + rr;
#pragma unroll
            for (int dh = 0; dh < 2; ++dh)
#pragma unroll
                for (int et = 0; et < 4; ++et) bb[rr & 1][dh * 4 + et] = __builtin_bit_cast(bf16x8, bfr[(size_t)((((j * 32 + r) * 2 + dh) * 4 + et) * 64)]);
#pragma unroll
            for (int dh = 0; dh < 2; ++dh) { const f32x4 x0 = a[rr][2 * dh], x1 = a[rr][2 * dh + 1];
                v4u wv; wv.x = pk2(x0.x, x0.y); wv.y = pk2(x0.z, x0.w); wv.z = pk2(x1.x, x1.y); wv.w = pk2(x1.z, x1.w);
                const bf16x8 af = __builtin_bit_cast(bf16x8, wv);
#pragma unroll
                for (int et = 0; et < 4; ++et) acc[et] = __builtin_amdgcn_mfma_f32_16x16x32_bf16(af, bb[rr & 1][dh * 4 + et], acc[et], 0, 0, 0); } }
        __syncthreads();
#pragma unroll
        for (int et = 0; et < 4; ++et) *(LAS f32x4*)(part + ((w * 4 + et) * 64 + lane) * 4) = acc[et];
        __syncthreads();
        if (w < 4) { const int et = w, e = 16 * et + rho; f32x4 sum = *(const LAS f32x4*)(part + ((0 * 4 + et) * 64 + lane) * 4);
#pragma unroll
          for (int ww = 1; ww < 8; ++ww) sum = sum + *(const LAS f32x4*)(part + ((ww * 4 + et) * 64 + lane) * 4);
          const float bs = cbias[j * 64 + e];
          float nmax = 0.f;
#pragma unroll
          for (int i = 0; i < 4; ++i) { const int row = 4 * kq + i, c = c0 + (row >> 1), g = row & 1; const float val = sum[i] + bs;
              float q2 = val * val; q2 += __shfl_xor(q2, 1); q2 += __shfl_xor(q2, 2); q2 += __shfl_xor(q2, 4); q2 += __shfl_xor(q2, 8); nmax = fmaxf(nmax, q2);
              bf16* img = (bf16*)(P.ws + WS_KC) + ((size_t)(b * 2 + g) * 4 + (c >> 6)) * 8192;
              if (j == 0) img[kimg_off(c & 63, e)] = (bf16)f2bf(val); else img[vimg_off(e, (c & 48) + perm16(c & 15))] = (bf16)f2bf(val); }
          if (j == 0) { nmax = fmaxf(nmax, __shfl_xor(nmax, 16)); nmax = fmaxf(nmax, __shfl_xor(nmax, 32));
              if (lane == 0) atomicMax((unsigned*)(P.ws + WS_CTL) + CW_KCMAX + et, __builtin_bit_cast(unsigned, nmax)); } }
    }
}
constexpr int P0_PRODUCERS = 641;
__device__ __forceinline__ void p0_small_items(const Ptrs& P, Frame& F) {
    const int lane = F.lane, gw = F.gw;
    if (gw >= P0_PRODUCERS && F.NGW >= P0_PRODUCERS) return;
    for (int item = gw; item < P0_PRODUCERS; item += F.NGW) {
        if (item < 512) { const int it = item * 64 + lane; const int l = it & 63, et = (it >> 6) & 3, dh = (it >> 8) & 1, r = (it >> 9) & 31, j = it >> 14;
            const float* w = P.cmp_w + ((size_t)(r * 2 + j) * 64 + 32 * dh + 4 * (l >> 4)) * 64 + 16 * et + (l & 15);
            v4u o; o.x = pk2(w[0], w[64]); o.y = pk2(w[128], w[192]); o.z = pk2(w[16 * 64], w[17 * 64]); o.w = pk2(w[18 * 64], w[19 * 64]);
            __builtin_amdgcn_raw_buffer_store_b128(o, __builtin_amdgcn_make_buffer_rsrc((void*)(P.ws + WS_BTC), 0, 512 * 1024, 0x00020000), it * 16, 0, 16);
        } else if (item < 640) { const int it = item - 512, j = it >> 6, e = it & 63; float s = 0.f;
            for (int k = lane; k < 2048; k += 64) { const int r = k >> 6, d = k & 63; s += P.cmp_pe[(r * 2 + j) * 64 + d] * P.cmp_w[((size_t)(r * 2 + j) * 64 + d) * 64 + e]; }
            s = wave_sum(s); if (lane == 0) __hip_atomic_store((float*)(P.ws + WS_CBIAS) + it, s, RLX_AGENT);
        } else { float qm = fabsf(P.q_gain[lane]), k1 = fabsf(P.k_gain[64 + lane]), k2 = fabsf(P.k_gain[128 + lane]);
#pragma unroll
            for (int o = 1; o < 64; o <<= 1) { qm = fmaxf(qm, __shfl_xor(qm, o)); k1 = fmaxf(k1, __shfl_xor(k1, o)); k2 = fmaxf(k2, __shfl_xor(k2, o)); }
            if (lane == 0) { float* cst = (float*)(P.ws + WS_CONST); __hip_atomic_store(cst + 0, qm, RLX_AGENT); __hip_atomic_store(cst + 1, 8.0f * qm * k1 * LOG2E * 1.001f, RLX_AGENT); __hip_atomic_store(cst + 2, 8.0f * qm * k2 * LOG2E * 1.001f, RLX_AGENT); } }
        asm volatile("s_waitcnt vmcnt(0)" ::: "memory");
        if (lane == 0) __hip_atomic_fetch_add((unsigned*)(F.ctl + CW_P0CNT), 1u, RLX_AGENT);
    }
}
__device__ __forceinline__ void p0_rope(const Ptrs& P, Frame& F, int gw, int NGW) {
    const int lane = F.lane; const int i = lane & 31;
    const float inv = (float)pow(10000.0, -(double)i / 32.0);
    for (int it = gw * 64 + lane; it < 8193 * 32; it += NGW * 64) { const int p = it >> 5; const int pos = (p == 8192) ? PAST : p;
        const float ang = (float)pos * inv; const double rev = (double)ang * 0.15915494309189535; const float fr = (float)(rev - __builtin_rint(rev));
        float* rt = (float*)(P.ws + WS_ROPE) + (size_t)p * 64; rt[i] = __builtin_amdgcn_cosf(fr); rt[32 + i] = __builtin_amdgcn_sinf(fr); }
}
__device__ __forceinline__ void p0_other_slice(const Ptrs& P, Frame& F, int k, int gw, int NGW, LAS float* scr) {
    const int lane = F.lane;
    if (k < 2) { const int it = gw + k * NGW; if (it < 16 * 128) { const int kb = it >> 7, dg = it & 127; int nv; const int src0 = bt1_src(dg, nv);
        p0_transpose_item(P.w_in, INW, 64 * kb, src0, nv, P.norm_g, (bf16*)(P.ws + WS_BT1), D, 32 * dg, scr, lane); }
    } else if (k == 2) { for (int it = gw; it < 16 * 32; it += NGW) { const int kb = it >> 5, nb = it & 31;
        p0_transpose_item(P.w_out, D, 64 * kb, 32 * nb, 32, nullptr, (bf16*)(P.ws + WS_BT2), D, 32 * nb, scr, lane); }
    } else if (k < 11) { for (int m = (gw + (k - 3) * NGW) * 4; m < M; m += NGW * 4 * 8) x_rows_to_bf16<4>(P.xp + (size_t)m * D, (bf16*)(P.ws + WS_XB) + (size_t)m * D, (float*)(P.ws + WS_RSTD) + m, lane);
    } else if (k == 11) { for (int m = gw; m < DECB; m += NGW) x_rows_to_bf16<1>(P.xs + (size_t)m * D, (bf16*)(P.ws + WS_XSB) + (size_t)m * D, (float*)(P.ws + WS_RSTDS) + m, lane);
        for (int it = gw * 64 + lane; it < DECB * 512; it += NGW * 64) { const int b = it >> 9, ch = it & 511; P.out[O_SCONV + (size_t)b * 1024 + ch] = P.st_conv[(size_t)b * 1024 + 512 + ch]; }
    } else if (k == 12) {
        constexpr int PERB = 511 * 64, TOTAL = DECB * PERB; const GAS f32x4* src = (const GAS f32x4*)P.st_win; GAS f32x4* dst = (GAS f32x4*)(P.out + O_SWIN);
        for (int i0 = gw * 64 + lane; i0 < TOTAL; i0 += NGW * 64 * 8) { f32x4 t[8];
#pragma unroll
            for (int u = 0; u < 8; ++u) { const int i = i0 + u * NGW * 64; if (i < TOTAL) { const int b = i / PERB; t[u] = src[i + 64 * b + 64]; } }
#pragma unroll
            for (int u = 0; u < 8; ++u) { const int i = i0 + u * NGW * 64; if (i < TOTAL) { const int b = i / PERB; dst[i + 64 * b] = t[u]; } } }
    } else if (k == 13) p0_rope(P, F, gw, NGW);
}
constexpr int P0_OTHER_SLICES = 14;
__device__ __forceinline__ void p0_phase(const Ptrs& P, Frame& F) {
    p0_small_items(P, F);
    LAS float* scr = (LAS float*)(F.lds + RING_OFF + F.wave * 16384);
    for (int k = 0; k < P0_OTHER_SLICES; ++k) p0_other_slice(P, F, k, F.gw, F.NGW, scr);
}
constexpr int CW_NS = 4, CW_NPASS = DECB * 8;
#define CW_LOAD(dst, base, r) do { _Pragma("unroll") for (int q_ = 0; q_ < 4; ++q_) { dst[2 * q_] = *(const GAS f32x4*)((base) + (r) * 256 + (q_ >> 1) * 128 + (q_ & 1) * 32); dst[2 * q_ + 1] = *(const GAS f32x4*)((base) + (r) * 256 + (q_ >> 1) * 128 + (q_ & 1) * 32 + 16); } } while (0)
template <int S>
__device__ __forceinline__ void cw_step(f32x4 (&a)[CW_NS][8], v4u (&vb)[4], f32x4 (&acc)[2][4], const float*& rp, int& nr, const GAS v4u*& bp, int& nb, LAS v4u* bdst, const LAS v4u* bl_lane) {
    if constexpr ((S & 1) == 0) {
#pragma unroll
        for (int i = 0; i < 4; ++i) vb[i] = bp[i];
        if (nb < 15) { ++nb; bp += 1024; } asm volatile("" : "+v"(bp));
        __builtin_amdgcn_sched_barrier(0); }
    CW_LOAD(a[(S + CW_NS - 1) % CW_NS], rp, 0); if (nr < 31) { ++nr; rp += 256; } asm volatile("" : "+v"(rp)); __builtin_amdgcn_sched_barrier(0);
    { const LAS v4u* bf = bl_lane + (S >> 1) * 2048 + (S & 1) * 1024;
#pragma unroll
      for (int q_ = 0; q_ < 4; ++q_) { const int j = q_ >> 1; const f32x4 x0 = a[S][2 * q_], x1 = a[S][2 * q_ + 1];
          v4u wv; wv.x = pk2(x0.x, x0.y); wv.y = pk2(x0.z, x0.w); wv.z = pk2(x1.x, x1.y); wv.w = pk2(x1.z, x1.w);
          const bf16x8 af = __builtin_bit_cast(bf16x8, wv);
#pragma unroll
          for (int et = 0; et < 4; ++et) acc[j][et] = __builtin_amdgcn_mfma_f32_16x16x32_bf16(af, __builtin_bit_cast(bf16x8, bf[(q_ * 4 + et) * 64]), acc[j][et], 0, 0, 0); } }
    if constexpr ((S & 1) == 1) {
        LDS_WAIT(); LAS v4u* d_ = bdst + (((S >> 1) + 1) & 1) * 2048;
#pragma unroll
        for (int i = 0; i < 4; ++i) d_[i] = vb[i];
        LDS_WAIT(); asm volatile("" ::: "memory"); __builtin_amdgcn_s_barrier(); asm volatile("" ::: "memory"); }
}
__device__ __forceinline__ void compress_wg(const Ptrs& P, Frame& F, LAS unsigned char* bl  ) {
    const int lane = F.lane, w = F.wave, tid = w * 64 + lane, rho = lane & 15, kq = lane >> 4;
    const int sf = tid >> 4, ssr = sf >> 4, sj = (sf >> 3) & 1, sdh = (sf >> 2) & 1, set_ = sf & 3, sl = (tid & 15) * 4;
    const GAS v4u* bs0 = (const GAS v4u*)(P.ws + WS_BTC) + (size_t)((((sj * 32 + ssr) * 2 + sdh) * 4 + set_) * 64 + sl);
    LAS v4u* bdst = (LAS v4u*)bl + sf * 64 + sl; const LAS v4u* bl_lane = (const LAS v4u*)bl + lane;
    const float* cbias = (const float*)(P.ws + WS_CBIAS);
    for (int pass = blockIdx.x; pass < CW_NPASS; pass += F.G) {
        const int b = pass >> 3, c0 = (pass & 7) * 64 + w * 8;
        const float* rb; { const int c = c0 + (rho >> 1), g = rho & 1; const int page = P.page_table[b * NPAGES + (c >> 2)]; rb = P.cache_cmp + ((size_t)page * 128 + (c & 3) * 32) * 256 + g * 64 + 4 * kq; }
        f32x4 a[CW_NS][8]; v4u vb[4]; f32x4 acc[2][4];
#pragma unroll
        for (int i = 0; i < 4; ++i) vb[i] = bs0[i];
#pragma unroll
        for (int r = 0; r < CW_NS - 1; ++r) CW_LOAD(a[r], rb, r);
        const float* rp = rb + (CW_NS - 1) * 256; const GAS v4u* bp = bs0 + 1024; int nr = CW_NS - 1, nb = 1; asm volatile("" : "+v"(rp), "+v"(bp));
#pragma unroll
        for (int j = 0; j < 2; ++j)
#pragma unroll
            for (int e = 0; e < 4; ++e) acc[j][e] = (f32x4){0.f, 0.f, 0.f, 0.f};
        asm volatile("" ::: "memory"); __builtin_amdgcn_s_barrier(); asm volatile("" ::: "memory");
#pragma unroll
        for (int i = 0; i < 4; ++i) bdst[i] = vb[i];
        LDS_WAIT(); asm volatile("" ::: "memory"); __builtin_amdgcn_s_barrier(); asm volatile("" ::: "memory");
#pragma unroll 1
        for (int it = 0; it < 8; ++it) { cw_step<0>(a, vb, acc, rp, nr, bp, nb, bdst, bl_lane); cw_step<1>(a, vb, acc, rp, nr, bp, nb, bdst, bl_lane);
            cw_step<2>(a, vb, acc, rp, nr, bp, nb, bdst, bl_lane); cw_step<3>(a, vb, acc, rp, nr, bp, nb, bdst, bl_lane); }
        float nmax = 0.f;
#pragma unroll
        for (int i = 0; i < 4; ++i) { const int row = 4 * kq + i, c = c0 + (row >> 1), g = row & 1; float q2 = 0.f;
#pragma unroll
            for (int j = 0; j < 2; ++j)
#pragma unroll
                for (int et = 0; et < 4; ++et) { const int e = 16 * et + rho; const float val = acc[j][et][i] + cbias[j * 64 + e]; if (j == 0) q2 += val * val;
                    ((float*)(P.ws + WS_KCS))[((size_t)((b * 2 + g) * 2 + j) * NCS + c) * 64 + e] = val; }
            q2 += __shfl_xor(q2, 1); q2 += __shfl_xor(q2, 2); q2 += __shfl_xor(q2, 4); q2 += __shfl_xor(q2, 8); nmax = fmaxf(nmax, q2); }
        nmax = fmaxf(nmax, __shfl_xor(nmax, 16)); nmax = fmaxf(nmax, __shfl_xor(nmax, 32));
        if (lane == 0) atomicMax((unsigned*)(P.ws + WS_CTL) + CW_KCMAX + 64, __builtin_bit_cast(unsigned, nmax));
    }
}
struct EpiIn {
    static constexpr bool PERM = false, AFTER_DRAIN = false;
    const float *rstd, *rope, *qg, *kg; float* out; unsigned char* ws;
    __device__ __forceinline__ void operator()(const f32x4 (&acc)[2][2][4][2], const pg8::Unit& u, int wr, int wc, int fr, int fq) const {
        asm volatile("" : "+v"(fr), "+v"(fq));
        const int pn = u.pn; const int rbase = u.pm * 256 + wr * 64 + fr;
        if (pn < 8) {
            const bool bz = pn < 4; bf16* dst = (bf16*)(ws + (bz ? WS_CG : WS_U)); const int col0 = 128 * (pn & 3) + 32 * wc + 4 * fq;
#pragma unroll
            for (int ai = 0; ai < 2; ++ai)
#pragma unroll
                for (int m = 0; m < 4; ++m) { const int row = rbase + ai * 128 + m * 16; const float rs = rstd[row];
#pragma unroll
                    for (int n = 0; n < 2; ++n) { const f32x4 a = acc[ai][0][m][n] * rs, z = acc[ai][1][m][n] * rs; f32x4 o;
                        if (bz) { o.x = a.x * z.x * sigmoidf(z.x); o.y = a.y * z.y * sigmoidf(z.y); o.z = a.z * z.z * sigmoidf(z.z); o.w = a.w * z.w * sigmoidf(z.w); }
                        else o = a * z;
                        v2u w; w.x = pk2(o.x, o.y); w.y = pk2(o.z, o.w);
                        *(GAS v2u*)(dst + (size_t)row * 512 + col0 + 16 * n) = w;
                        if (!bz) { const int t = row & (T - 1); if (t >= T - 2) *(GAS f32x4*)(out + O_PCONV + ((size_t)(row >> 13) * 2 + (t - (T - 2))) * 512 + col0 + 16 * n) = o; } } }
        } else if (pn < 13) {
            const bool isq = pn < 10; const int br = pn - 10; const bool isk = !isq && wc < 2;
            if (isq || isk) {
                const float* gain = isq ? qg : kg + br * 64; float g1[2][4], g2[2][4];
#pragma unroll
                for (int n = 0; n < 2; ++n)
#pragma unroll
                    for (int e = 0; e < 4; ++e) { g1[n][e] = gain[16 * n + 4 * fq + e]; g2[n][e] = gain[32 + 16 * n + 4 * fq + e]; }
#pragma unroll
                for (int ai = 0; ai < 2; ++ai)
#pragma unroll
                    for (int m = 0; m < 4; ++m) { const int row = rbase + ai * 128 + m * 16; const float rs = rstd[row]; const int t = row & (T - 1), b = row >> 13;
                        f32x4 x1[2], x2[2]; float ss = 0.f;
#pragma unroll
                        for (int n = 0; n < 2; ++n) { x1[n] = acc[ai][0][m][n] * rs; x2[n] = acc[ai][1][m][n] * rs;
                            ss += (x1[n].x * x1[n].x + x1[n].y * x1[n].y) + (x1[n].z * x1[n].z + x1[n].w * x1[n].w) + (x2[n].x * x2[n].x + x2[n].y * x2[n].y) + (x2[n].z * x2[n].z + x2[n].w * x2[n].w); }
                        ss += __shfl_xor(ss, 16); ss += __shfl_xor(ss, 32);
                        const float inv = 1.0f / sqrtf(ss * (1.0f / 64.0f) + NORM_EPS);
                        const float* rp = rope + (size_t)t * 64 + 4 * fq;
#pragma unroll
                        for (int n = 0; n < 2; ++n) { const f32x4 cs = *(const GAS f32x4*)(rp + 16 * n), sn = *(const GAS f32x4*)(rp + 32 + 16 * n); f32x4 o1, o2;
#pragma unroll
                            for (int e = 0; e < 4; ++e) { const float a = x1[n][e] * inv * g1[n][e], c = x2[n][e] * inv * g2[n][e]; o1[e] = a * cs[e] - c * sn[e]; o2[e] = c * cs[e] + a * sn[e]; }
                            const int d1 = 16 * n + 4 * fq;
                            if (isq) { o1 = o1 * QSCALE; o2 = o2 * QSCALE; bf16* q = (bf16*)(ws + WS_Q) + (size_t)row * 512 + (4 * (pn - 8) + wc) * 64 + d1;
                                v2u w; w.x = pk2(o1.x, o1.y); w.y = pk2(o1.z, o1.w); *(GAS v2u*)q = w; w.x = pk2(o2.x, o2.y); w.y = pk2(o2.z, o2.w); *(GAS v2u*)(q + 32) = w; }
                            else { const int g = wc;
                                if (br > 0) { bf16* img = (bf16*)(ws + (br == 1 ? WS_KS : WS_KW)) + ((size_t)(b * 2 + g) * 128 + (t >> 6)) * 8192;
                                    v2u w; w.x = pk2(o1.x, o1.y); w.y = pk2(o1.z, o1.w); *(GAS v2u*)(img + kimg_off(t & 63, d1)) = w; w.x = pk2(o2.x, o2.y); w.y = pk2(o2.z, o2.w); *(GAS v2u*)(img + kimg_off(t & 63, d1 + 32)) = w; }
                                if (br < 2) { float* o = out + (br == 0 ? O_PCMP : O_PSLC) + (size_t)row * 256 + g * 64 + d1; *(GAS f32x4*)o = o1; *(GAS f32x4*)(o + 32) = o2; }
                                else if (t >= T - 512) { float* o = out + O_PWIN + ((size_t)b * 512 + (t - (T - 512))) * 256 + g * 64 + d1; *(GAS f32x4*)o = o1; *(GAS f32x4*)(o + 32) = o2; } } } }
            } else {
                const int g = wc - 2;
#pragma unroll
                for (int ai = 0; ai < 2; ++ai)
#pragma unroll
                    for (int m = 0; m < 4; ++m) { const int row = rbase + ai * 128 + m * 16; const float rs = rstd[row]; const int t = row & (T - 1), b = row >> 13;
                        const int tk = t & 63, vpos = (tk & ~15) + perm16(tk & 15);
                        bf16* vt = (br > 0) ? (bf16*)(ws + (br == 1 ? WS_KS : WS_KW)) + ((size_t)(b * 2 + g) * 128 + (t >> 6)) * 8192 : nullptr;
                        const float vsc = (br == 1) ? slc_vscale(((const float*)(ws + WS_CONST))[1]) : 1.0f;
#pragma unroll
                        for (int bj = 0; bj < 2; ++bj)
#pragma unroll
                            for (int n = 0; n < 2; ++n) { const f32x4 v = acc[ai][bj][m][n] * rs; const int d1 = 32 * bj + 16 * n + 4 * fq;
                                if (br > 0) {
#pragma unroll
                                    for (int e = 0; e < 4; ++e) vt[vimg_off(d1 + e, vpos)] = (bf16)f2bf(v[e] * vsc); }
                                if (br < 2) *(GAS f32x4*)(out + (br == 0 ? O_PCMP : O_PSLC) + (size_t)row * 256 + 128 + g * 64 + d1) = v;
                                else if (t >= T - 512) *(GAS f32x4*)(out + O_PWIN + ((size_t)b * 512 + (t - (T - 512))) * 256 + 128 + g * 64 + d1) = v; } }
            }
        } else if (pn < 15) {
            bf16* dst = (bf16*)(ws + WS_ZA);
#pragma unroll
            for (int ai = 0; ai < 2; ++ai)
#pragma unroll
                for (int m = 0; m < 4; ++m) { const int row = rbase + ai * 128 + m * 16; const float rs = rstd[row];
#pragma unroll
                    for (int bj = 0; bj < 2; ++bj)
#pragma unroll
                        for (int n = 0; n < 2; ++n) { const f32x4 z = acc[ai][bj][m][n] * rs; v2u w; w.x = pk2(z.x * sigmoidf(z.x), z.y * sigmoidf(z.y)); w.y = pk2(z.z * sigmoidf(z.z), z.w * sigmoidf(z.w));
                            *(GAS v2u*)(dst + (size_t)row * 512 + 256 * (pn - 13) + 128 * bj + 32 * wc + 16 * n + 4 * fq) = w; } }
        } else {
            if (wc == 0) { float* dst = (float*)(ws + WS_GATE);
#pragma unroll
                for (int ai = 0; ai < 2; ++ai)
#pragma unroll
                    for (int m = 0; m < 4; ++m) { const int row = rbase + ai * 128 + m * 16; const float rs = rstd[row];
#pragma unroll
                        for (int n = 0; n < 2; ++n) { const int c0 = 16 * n + 4 * fq; if (c0 < 24) { const f32x4 z = acc[ai][0][m][n] * rs;
                            *(GAS f32x4*)(dst + (size_t)row * 24 + c0) = (f32x4){sigmoidf(z.x), sigmoidf(z.y), sigmoidf(z.z), sigmoidf(z.w)}; } } } }
        }
    }
};
struct EpiOut {
    static constexpr bool PERM = false, AFTER_DRAIN = false;
    const bf16* x; float* y;
    __device__ __forceinline__ void operator()(const f32x4 (&acc)[2][2][4][2], const pg8::Unit& u, int wr, int wc, int fr, int fq) const {
        asm volatile("" : "+v"(fr), "+v"(fq));
#pragma unroll
        for (int ai = 0; ai < 2; ++ai)
#pragma unroll
            for (int m = 0; m < 4; ++m) { const size_t row = (size_t)u.pm * 256 + ai * 128 + wr * 64 + m * 16 + fr;
#pragma unroll
                for (int bj = 0; bj < 2; ++bj)
#pragma unroll
                    for (int n = 0; n < 2; ++n) { const size_t off = row * D + u.pn * 256 + 128 * bj + 32 * wc + 16 * n + 4 * fq;
                        const v2u xv = *(const GAS v2u*)(x + off);
                        *(GAS f32x4*)(y + off) = (f32x4){bf2f(xv.x & 0xffffu), bf2f(xv.x >> 16), bf2f(xv.y & 0xffffu), bf2f(xv.y >> 16)} + acc[ai][bj][m][n]; } }
    }
};
template <int MODE>
__device__ __forceinline__ void small_gemm_tile(const Ptrs& P, const bf16* A, const bf16* Bt, int ct, int lane) {
    const int rho = lane & 15, kq = lane >> 4;
    f32x4 acc[2] = {(f32x4){0.f, 0.f, 0.f, 0.f}, (f32x4){0.f, 0.f, 0.f, 0.f}};
    const GAS v4u* a0 = (const GAS v4u*)(A + (size_t)rho * D + 8 * kq); const GAS v4u* a1 = (const GAS v4u*)(A + (size_t)(16 + rho) * D + 8 * kq);
    const GAS v4u* bp = (const GAS v4u*)(Bt + (size_t)(16 * ct + rho) * D + 8 * kq);
#pragma unroll 8
    for (int ks = 0; ks < 32; ++ks) { const bf16x8 bb = __builtin_bit_cast(bf16x8, bp[ks * 4]);
        acc[0] = __builtin_amdgcn_mfma_f32_16x16x32_bf16(bb, __builtin_bit_cast(bf16x8, a0[ks * 4]), acc[0], 0, 0, 0);
        acc[1] = __builtin_amdgcn_mfma_f32_16x16x32_bf16(bb, __builtin_bit_cast(bf16x8, a1[ks * 4]), acc[1], 0, 0, 0); }
#pragma unroll
    for (int rt = 0; rt < 2; ++rt) { const int b = 16 * rt + rho; const int col = 16 * ct + 4 * kq;
        if (MODE == 0) { const float rs = ((const float*)(P.ws + WS_RSTDS))[b]; *(GAS f32x4*)((float*)(P.ws + WS_PROJS) + (size_t)b * NP + col) = acc[rt] * rs; }
        else *(GAS f32x4*)(P.out + O_YS + (size_t)b * D + col) = *(const GAS f32x4*)(P.xs + (size_t)b * D + col) + acc[rt]; }
}
__device__ __forceinline__ int projs_col(int pn, int wc, int d) { return 256 * pn + 128 * (d >> 5) + 32 * wc + (d & 31); }
__device__ __forceinline__ void p2_sample_item(const Ptrs& P, int it, int lane) {
    const int b = it / 37, ty = it - b * 37;
    const float* pr = (const float*)(P.ws + WS_PROJS) + (size_t)b * NP;
    const float* ropes = (const float*)(P.ws + WS_ROPE) + (size_t)8192 * 64;
    float* kvn = (float*)(P.ws + WS_KVN) + (size_t)b * 768;
    if (ty < 14) {
        const bool isq = ty < 8; const int br = isq ? 0 : (ty - 8) >> 1, g = (ty - 8) & 1;
        const int pn = isq ? 8 + (ty >> 2) : 10 + br, wc = isq ? (ty & 3) : g;
        const float v = pr[projs_col(pn, wc, lane)];
        const float ss = wave_sum(v * v); const float inv = 1.0f / sqrtf(ss * (1.0f / 64.0f) + NORM_EPS);
        const float gn = isq ? P.q_gain[lane] : P.k_gain[br * 64 + lane];
        const float xn = v * inv * gn; const float xo = __shfl_xor(xn, 32);
        const int i = lane & 31; const float cs = ropes[i], sn = ropes[32 + i];
        const float o = (lane < 32) ? xn * cs - xo * sn : xn * cs + xo * sn;
        if (isq) ((float*)(P.ws + WS_QS))[(size_t)b * 512 + ty * 64 + lane] = o * QSCALE;
        else { kvn[(br * 2 + 0) * 128 + g * 64 + lane] = o;
            if (br == 0) P.out[O_SCMP + (size_t)b * 256 + g * 64 + lane] = o; else if (br == 1) P.out[O_SSLC + (size_t)b * 256 + g * 64 + lane] = o;
            else P.out[O_SWIN + ((size_t)b * 512 + 511) * 256 + g * 64 + lane] = o; }
    } else if (ty < 20) {
        const int br = (ty - 14) >> 1, g = (ty - 14) & 1; const float v = pr[projs_col(10 + br, 2 + g, lane)];
        kvn[(br * 2 + 1) * 128 + g * 64 + lane] = v;
        if (br == 0) P.out[O_SCMP + (size_t)b * 256 + 128 + g * 64 + lane] = v; else if (br == 1) P.out[O_SSLC + (size_t)b * 256 + 128 + g * 64 + lane] = v;
        else P.out[O_SWIN + ((size_t)b * 512 + 511) * 256 + 128 + g * 64 + lane] = v;
    } else if (ty == 20) {
        if (lane < 24) ((float*)(P.ws + WS_GS))[b * 24 + lane] = sigmoidf(pr[256 * 15 + lane]);
    } else if (ty < 29) {
        const int ch = (ty - 21) * 64 + lane; const int pnb = ch >> 7, tc = ch & 127;
        const float bg = pr[256 * pnb + tc], zc = pr[256 * pnb + 128 + tc], cg = pr[256 * (4 + pnb) + tc], ci = pr[256 * (4 + pnb) + 128 + tc];
        const float u = cg * ci; const float s0 = P.st_conv[(size_t)b * 1024 + ch], s1 = P.st_conv[(size_t)b * 1024 + 512 + ch];
        const float cy = P.conv_w[ch] * s0 + P.conv_w[512 + ch] * s1 + P.conv_w[1024 + ch] * u + P.conv_b[ch];
        ((bf16*)(P.ws + WS_MIXS))[(size_t)b * 1024 + ch] = (bf16)f2bf(bg * cy * zc * sigmoidf(zc));
        P.out[O_SCONV + (size_t)b * 1024 + 512 + ch] = u;
    } else {
        const int col = (ty - 29) * 64 + lane; const float z = pr[256 * (13 + (col >> 8)) + (col & 255)];
        ((float*)(P.ws + WS_ZAS))[(size_t)b * 512 + col] = z * sigmoidf(z);
    }
}
__device__ __forceinline__ void p2_phase(const Ptrs& P, Frame& F) {
    compress_prompt_units(P, F, (LAS float*)(F.lds + RING_OFF), [&]() { for (int it = F.gw; it < DECB * 37; it += F.NGW) p2_sample_item(P, it, F.lane); });
    if ((int)blockIdx.x >= BATCH * 64) for (int it = F.gw; it < DECB * 37; it += F.NGW) p2_sample_item(P, it, F.lane);
}
#define MFMA32(a, b, c) __builtin_amdgcn_mfma_f32_32x32x16_bf16(a, b, c, 0, 0, 0)
constexpr int P3_IMP = 0, P3_QL = 32768;
constexpr int P3_NEXT = LDSCTL_OFF + 512, P3_CNT = LDSCTL_OFF + 1024, P3_LISTS = LDSCTL_OFF + 2048, P3_LACC = LDSCTL_OFF + 10240;
constexpr int P3_RING = 65536;
constexpr int P3_MISC = MISC_OFF + 64;
constexpr int SM_Q = 36864, SM_P = 40960, SM_RED = 57344, SM_IMP = 66048, SM_L = 67200, SM_SEL = 67328, SM_O = 67584, SM_VP = 71680  , SM_RED2 = 79872  ;

template <bool MASK>
__device__ __forceinline__ void attend_lds(const LAS unsigned char* blk, const bf16x8 (&qf)[4], f32x16 (&O)[2], float& lsum,
                                           int kbase, int lo, int hi, int lane, bool want_pv, f32x16 (*Sout)[2] = nullptr) {
    const int hh = lane >> 5;
    const LAS unsigned char* kb = blk + lane * 16; const LAS unsigned char* vb = blk + 8192 + lane * 16;
#pragma unroll
    for (int kt = 0; kt < 2; ++kt) {
        f32x16 S;
        { bf16x8 kf[4];
#pragma unroll
          for (int s = 0; s < 4; ++s) kf[s] = *(const LAS bf16x8*)(kb + (kt * 4 + s) * 1024);
#pragma unroll
          for (int i = 0; i < 16; ++i) S[i] = 0.f;
#pragma unroll
          for (int s = 0; s < 4; ++s) S = MFMA32(kf[s], qf[s], S); }
#pragma unroll
        for (int i = 0; i < 16; ++i) { float p = fast_exp2(S[i]);
            if (MASK) { const int kp = kbase + 32 * kt + (i & 3) + 8 * (i >> 2) + 4 * hh; p = (kp >= lo && kp <= hi) ? p : 0.f; }
            S[i] = p; lsum += p; }
        if (Sout) (*Sout)[kt] = S;
        if (want_pv) {
            bf16x8 pf[2];
#pragma unroll
            for (int sp = 0; sp < 2; ++sp) { v4u w; w.x = pk2(S[8 * sp + 0], S[8 * sp + 1]); w.y = pk2(S[8 * sp + 2], S[8 * sp + 3]);
                w.z = pk2(S[8 * sp + 4], S[8 * sp + 5]); w.w = pk2(S[8 * sp + 6], S[8 * sp + 7]); pf[sp] = __builtin_bit_cast(bf16x8, w); }
#pragma unroll
            for (int dt = 0; dt < 2; ++dt)
#pragma unroll
                for (int sp = 0; sp < 2; ++sp) { const bf16x8 vf = *(const LAS bf16x8*)(vb + (dt * 4 + 2 * kt + sp) * 1024);
                    O[dt] = MFMA32(vf, pf[sp], O[dt]); }
        }
    }
}
__device__ __forceinline__ void wave_topk(const LAS float* imp, int jmax, int nsel, int lane, int qbase, LAS unsigned* cnt, LAS unsigned char* lists) {
    if (jmax < 1) return;
    const bool c0 = lane >= 1 && lane <= jmax, c1 = 64 + lane <= jmax;
    unsigned k0[8], k1[8], Tv[8];
#pragma unroll
    for (int qi = 0; qi < 8; ++qi) { k0[qi] = c0 ? ((__builtin_bit_cast(unsigned, imp[qi * 128 + lane]) + 0x800u) & ~0x7ffu) : 0u; k1[qi] = c1 ? ((__builtin_bit_cast(unsigned, imp[qi * 128 + 64 + lane]) + 0x800u) & ~0x7ffu) : 0u; Tv[qi] = 0u; }
    if (jmax > nsel) {
        for (int bit = 30; bit >= 11; --bit) {
#pragma unroll
            for (int qi = 0; qi < 8; ++qi) { const unsigned cand = Tv[qi] | (1u << bit);
                const int cn = __popcll(__ballot(k0[qi] >= cand)) + __popcll(__ballot(k1[qi] >= cand)); Tv[qi] = cn >= nsel ? cand : Tv[qi]; } }
    }
    const unsigned long long below = (lane == 0) ? 0ull : (~0ull >> (64 - lane));
#pragma unroll
    for (int qi = 0; qi < 8; ++qi) {
        bool s0, s1;
        if (jmax > nsel) {
            const unsigned long long g0 = __ballot(k0[qi] > Tv[qi]), g1 = __ballot(k1[qi] > Tv[qi]), e0 = __ballot(k0[qi] == Tv[qi]), e1 = __ballot(k1[qi] == Tv[qi]);
            const int need = nsel - __popcll(g0) - __popcll(g1);
            const int rk0 = __popcll(e0 & below), rk1 = __popcll(e0) + __popcll(e1 & below);
            s0 = k0[qi] > Tv[qi] || (k0[qi] == Tv[qi] && rk0 < need); s1 = k1[qi] > Tv[qi] || (k1[qi] == Tv[qi] && rk1 < need);
        } else { s0 = c0; s1 = c1; }
        if (s0) { const unsigned pos = __hip_atomic_fetch_add(cnt + lane, 1u, __ATOMIC_RELAXED, __HIP_MEMORY_SCOPE_WORKGROUP); lists[lane * 64 + pos] = (unsigned char)(qbase + qi); }
        if (s1) { const unsigned pos = __hip_atomic_fetch_add(cnt + 64 + lane, 1u, __ATOMIC_RELAXED, __HIP_MEMORY_SCOPE_WORKGROUP); lists[(64 + lane) * 64 + pos] = (unsigned char)(qbase + qi); }
    }
}
struct BlkSrc { const bf16* img; };
#ifndef PROBE_SEG
#define PROBE_SEG 0
#endif
#define T_BEGIN(id) do { if (PROBE_SEG == (id)) tacc -= __builtin_readcyclecounter(); } while (0)
#define T_END(id) do { if (PROBE_SEG == (id)) tacc += __builtin_readcyclecounter(); } while (0)
__device__ __forceinline__ void p3_prompt_unit(const Ptrs& P, Frame& F, int b, int t, int g, float sh_cmp, float sh_slc, float sh_win, unsigned long long& tacc) {
    int lane = F.lane, w = F.wave, tid = F.tid; asm volatile("" : "+v"(lane), "+s"(w), "+v"(tid));
    const int col = lane & 31, hh = lane >> 5, qi = col >> 2, h = col & 3;
    const int tok = 64 * t + 8 * w + qi; const size_t row = (size_t)b * T + tok; const int qpos = tok;
    const int nck = (2 * t + 2 + 63) >> 6, nf = t >= 2 ? 3 : t + 1, nw = t >= 8 ? 9 : t + 1;
    const int n1 = nck, n2 = 2 * nck, n3 = n2 + nw, N1 = n3 + nf, wbase = t >= 8 ? t - 8 : 0;
    const bf16* KC = (const bf16*)(P.ws + WS_KC) + (size_t)(b * 2 + g) * 4 * 8192;
    const bf16* KS = (const bf16*)(P.ws + WS_KS) + (size_t)(b * 2 + g) * 128 * 8192;
    const bf16* KW = (const bf16*)(P.ws + WS_KW) + (size_t)(b * 2 + g) * 128 * 8192;
    auto src1 = [&](int n) -> BlkSrc {
        if (n < n2) { const int ck = n < n1 ? n : n - n1; return BlkSrc{KC + (size_t)ck * 8192}; }
        if (n < n3) return BlkSrc{KW + (size_t)(wbase + n - n2) * 8192};
        const int f = n - n3; const int j = f == 0 ? t : (f == 1 ? 0 : t - 1); return BlkSrc{KS + (size_t)j * 8192}; };
    LAS unsigned char* ring = F.lds + P3_RING;
#define ST_DMA(bs_, n) do { LAS unsigned char* d_ = ring + ((n) & 3) * 16384 + w * 2048; \
        __builtin_amdgcn_global_load_lds((const unsigned*)((bs_).img + (2 * w) * 512 + lane * 8), (LAS unsigned*)d_, 16, 0, 0); \
        __builtin_amdgcn_global_load_lds((const unsigned*)((bs_).img + (2 * w + 1) * 512 + lane * 8), (LAS unsigned*)(d_ + 1024), 16, 0, 0); } while (0)
#define BLK(n) (ring + ((n) & 3) * 16384)
#define STEP_BEGIN(SRC, n, NN) do { if (((n) & 1) == 0) { if ((n) + 2 < (NN)) { const BlkSrc b_ = SRC((n) + 2); ST_DMA(b_, (n) + 2); } if ((n) + 3 < (NN)) { const BlkSrc b_ = SRC((n) + 3); ST_DMA(b_, (n) + 3); } } } while (0)
#define STEP_END(n, NN) do { if (((n) & 1) == 1 || (n) == (NN) - 1) { asm volatile("s_waitcnt vmcnt(0)" ::: "memory"); __syncthreads(); } } while (0)
    LAS unsigned* cnt = (LAS unsigned*)(F.lds + P3_CNT); LAS unsigned char* lists = F.lds + P3_LISTS; LAS unsigned* nextb = (LAS unsigned*)(F.lds + P3_NEXT);
    LAS int* oacc = (LAS int*)ring; LAS int* lacc = (LAS int*)(F.lds + P3_LACC);
    const float FXS = slc_vscale(sh_slc), FXI = 1.0f / FXS;
    LAS unsigned char* ql = F.lds + P3_QL;
    T_BEGIN(1); T_BEGIN(8);
    __syncthreads();
    if (tid < 128) cnt[tid] = 0u; if (tid == 128) nextb[0] = 0u;
    { const BlkSrc b0 = src1(0); ST_DMA(b0, 0); if (N1 > 1) { const BlkSrc b1 = src1(1); ST_DMA(b1, 1); } }
    { const bf16* qg = (const bf16*)(P.ws + WS_Q) + ((size_t)b * T + 64 * t) * 512 + g * 256;
      v4u tq[4];
#pragma unroll
      for (int k = 0; k < 4; ++k) { const int c = tid + 512 * k, rq = c >> 3, ch = c & 7; tq[k] = *(const GAS v4u*)(qg + (size_t)(rq >> 2) * 512 + (rq & 3) * 64 + ch * 8); }
#pragma unroll
      for (int k = 0; k < 4; ++k) { const int c = tid + 512 * k, rq = c >> 3, ch = c & 7; *(LAS v4u*)(ql + rq * 128 + ((ch ^ ((rq >> 1) & 7)) << 4)) = tq[k]; } }
    bf16x8 qf[4];
    { const bf16* q = (const bf16*)(P.ws + WS_Q) + row * 512 + (g * 4 + h) * 64 + 8 * hh;
#pragma unroll
      for (int s = 0; s < 4; ++s) qf[s] = __builtin_bit_cast(bf16x8, *(const GAS v4u*)(q + 16 * s)); }
    const float* gate = (const float*)(P.ws + WS_GATE) + row * 24 + (g * 4 + h) * 3;
    const float g_cmp = gate[0], g_slc = gate[1], g_win = gate[2];
    asm volatile("s_waitcnt vmcnt(0)" ::: "memory"); __syncthreads();
    T_END(1); T_BEGIN(2);
    f32x16 O[2];
    LAS float* wl = (LAS float*)(F.lds + P3_IMP + w * 4096);
    LAS float* xw0 = (LAS float*)(F.lds + P3_IMP + w * 4096) + lane;
    f32x16 totr;
    const int nvis = (qpos + 1) >> 5;
    int n = 0;
    float lsum = 0.f;
    for (; n < n1; ++n) { STEP_BEGIN(src1, n, N1); attend_lds<true>(BLK(n), qf, O, lsum, 64 * n, 0, nvis - 1, lane, false); STEP_END(n, N1); }
    lsum += __shfl_xor(lsum, 32);
    const float rl = lsum > 0.f ? 1.0f / lsum : 0.f;
    for (int i = lane; i < 1024; i += 64) wl[i] = 0.f;
#pragma unroll
    for (int i = 0; i < 16; ++i) { O[0][i] = 0.f; O[1][i] = 0.f; }
    { float dummy = 0.f;
      for (; n < n2; ++n) { STEP_BEGIN(src1, n, N1); const int ck = n - n1; f32x16 Sn[2];
        attend_lds<true>(BLK(n), qf, O, dummy, 64 * ck, 0, nvis - 1, lane, true, &Sn);
#pragma unroll
        for (int kt = 0; kt < 2; ++kt)
#pragma unroll
            for (int i2 = 0; i2 < 8; ++i2) { const float v = quad_sum((Sn[kt][2 * i2] + Sn[kt][2 * i2 + 1]) * rl);
                if (h == 0) wl[qi * 128 + 32 * ck + 16 * kt + (i2 & 1) + 4 * (i2 >> 1) + 2 * hh] = v; }
        STEP_END(n, N1); } }
    LDS_WAIT(); asm volatile("" ::: "memory");
    T_END(2); T_BEGIN(3);
    wave_topk(wl, t - 2, 13, lane, 8 * w, cnt, lists);
    LDS_WAIT(); asm volatile("" ::: "memory");
#pragma unroll
    for (int i = 0; i < 16; ++i) { xw0[i * 64] = O[0][i] * (g_cmp * rl); totr[i] = O[1][i] * (g_cmp * rl); O[0][i] = 0.f; O[1][i] = 0.f; }
    T_END(3); T_BEGIN(6);
    lsum = 0.f;
    for (; n < n3; ++n) { STEP_BEGIN(src1, n, N1); const int j = wbase + n - n2;
        if (j == t || j + 8 == t) attend_lds<true>(BLK(n), qf, O, lsum, 64 * j, qpos - 511, qpos, lane, true);
        else attend_lds<false>(BLK(n), qf, O, lsum, 0, 0, 0, lane, true);
        STEP_END(n, N1); }
    lsum += __shfl_xor(lsum, 32);
    { const float sc = g_win / fmaxf(lsum, 1e-30f);
#pragma unroll
      for (int i = 0; i < 16; ++i) { xw0[i * 64] = xw0[i * 64] + O[0][i] * sc; totr[i] += O[1][i] * sc; O[0][i] = 0.f; O[1][i] = 0.f; } }
    T_END(6); T_BEGIN(4);
    lsum = 0.f;
    for (; n < N1; ++n) { STEP_BEGIN(src1, n, N1);
        if (n == n3) attend_lds<true>(BLK(n), qf, O, lsum, 64 * t, 0, qpos, lane, true);
        else attend_lds<false>(BLK(n), qf, O, lsum, 0, 0, 0, lane, true);
        STEP_END(n, N1); }
    lsum += __shfl_xor(lsum, 32);
#pragma unroll
    for (int dt = 0; dt < 2; ++dt)
#pragma unroll
        for (int i = 0; i < 16; ++i) oacc[(32 * dt + (i & 3) + 8 * (i >> 2) + 4 * hh) * 256 + 32 * w + col] = (int)O[dt][i];
    if (hh == 0) lacc[32 * w + col] = __float2int_rn(lsum * FXS);
    __syncthreads();
    T_END(4); T_BEGIN(5);
    if (t > 2) {
        const int r = lane & 31;
#define NEXT_BLOCK(jv_, nq_) do { for (;;) { unsigned t_ = 0u; if (lane == 0) t_ = __hip_atomic_fetch_add(nextb, 1u, __ATOMIC_RELAXED, __HIP_MEMORY_SCOPE_WORKGROUP); \
            jv_ = 1 + (int)__builtin_amdgcn_readfirstlane(t_); if (jv_ > t - 2) { nq_ = 0; break; } nq_ = (int)__builtin_amdgcn_readfirstlane(cnt[jv_]); if (nq_ > 0) break; } } while (0)
#define LOAD_K(kd_, jv_) do { const bf16* im_ = KS + (size_t)(jv_) * 8192 + lane * 8;     \
            _Pragma("unroll") for (int a_ = 0; a_ < 2; ++a_) _Pragma("unroll") for (int b_ = 0; b_ < 4; ++b_) kd_[a_][b_] = __builtin_bit_cast(bf16x8, *(const GAS v4u*)(im_ + (a_ * 4 + b_) * 512)); } while (0)
#define LOAD_V(vd_, jv_) do { const bf16* im_ = KS + (size_t)(jv_) * 8192 + 4096 + lane * 8; \
            _Pragma("unroll") for (int a_ = 0; a_ < 2; ++a_) _Pragma("unroll") for (int b_ = 0; b_ < 4; ++b_) vd_[a_][b_] = __builtin_bit_cast(bf16x8, *(const GAS v4u*)(im_ + (a_ * 4 + b_) * 512)); } while (0)
        bf16x8 kf[2][4], vf[2][4], kn[2][4];
        int j, nq; T_BEGIN(10); NEXT_BLOCK(j, nq); if (j <= t - 2) LOAD_K(kf, j); T_END(10);
        while (j <= t - 2) {
            T_BEGIN(10); LOAD_V(vf, j);
            int jn, nqn; NEXT_BLOCK(jn, nqn); LOAD_K(kn, (jn <= t - 2 ? jn : t - 2));
#pragma unroll
            for (int a_ = 0; a_ < 2; ++a_)
#pragma unroll
                for (int b_ = 0; b_ < 4; ++b_) asm volatile("" : "+v"(kf[a_][b_])); T_END(10);
            for (int c0 = 0; c0 < nq; c0 += 8) { T_BEGIN(11);
                const int sl = c0 + qi; const bool valid = sl < nq;
                const int rowq = (int)lists[j * 64 + (valid ? sl : nq - 1)] * 4 + h;
                const LAS unsigned char* qp = ql + rowq * 128; const int qsw = (rowq >> 1) & 7;
                bf16x8 q2[4];
#pragma unroll
                for (int s = 0; s < 4; ++s) q2[s] = *(const LAS bf16x8*)(qp + (((2 * s + hh) ^ qsw) << 4));
                float l2 = 0.f; bf16x8 pf[4]; f32x16 S0, S1;
#pragma unroll
                for (int i = 0; i < 16; ++i) { S0[i] = 0.f; S1[i] = 0.f; }
#pragma unroll
                for (int s = 0; s < 4; ++s) { S0 = MFMA32(kf[0][s], q2[s], S0); S1 = MFMA32(kf[1][s], q2[s], S1); }
#pragma unroll
                for (int i = 0; i < 16; ++i) { S0[i] = fast_exp2(S0[i]); l2 += S0[i]; }
#pragma unroll
                for (int sp = 0; sp < 2; ++sp) { v4u wv; wv.x = pk2(S0[8 * sp + 0], S0[8 * sp + 1]); wv.y = pk2(S0[8 * sp + 2], S0[8 * sp + 3]);
                    wv.z = pk2(S0[8 * sp + 4], S0[8 * sp + 5]); wv.w = pk2(S0[8 * sp + 6], S0[8 * sp + 7]); pf[sp] = __builtin_bit_cast(bf16x8, wv); }
#pragma unroll
                for (int i = 0; i < 16; ++i) { S1[i] = fast_exp2(S1[i]); l2 += S1[i]; }
#pragma unroll
                for (int sp = 0; sp < 2; ++sp) { v4u wv; wv.x = pk2(S1[8 * sp + 0], S1[8 * sp + 1]); wv.y = pk2(S1[8 * sp + 2], S1[8 * sp + 3]);
                    wv.z = pk2(S1[8 * sp + 4], S1[8 * sp + 5]); wv.w = pk2(S1[8 * sp + 6], S1[8 * sp + 7]); pf[2 + sp] = __builtin_bit_cast(bf16x8, wv); }
                T_END(11); T_BEGIN(9);
                __builtin_amdgcn_sched_barrier(0);
#pragma unroll
                for (int a_ = 0; a_ < 2; ++a_)
#pragma unroll
                    for (int b_ = 0; b_ < 4; ++b_) asm volatile("" : "+v"(vf[a_][b_]));
#pragma unroll
                for (int dt = 0; dt < 2; ++dt) { f32x16 O2;
#pragma unroll
                    for (int i = 0; i < 16; ++i) O2[i] = 0.f;
#pragma unroll
                    for (int ks = 0; ks < 4; ++ks) O2 = MFMA32(vf[dt][ks], pf[ks], O2);
                    if (valid) {
#pragma unroll
                        for (int i = 0; i < 16; ++i) (void)__hip_atomic_fetch_add(oacc + (32 * dt + (i & 3) + 8 * (i >> 2) + 4 * hh) * 256 + rowq, (int)O2[i], __ATOMIC_RELAXED, __HIP_MEMORY_SCOPE_WORKGROUP); } }
                if (valid) {
                    (void)__hip_atomic_fetch_add(lacc + rowq, __float2int_rn(l2 * FXS), __ATOMIC_RELAXED, __HIP_MEMORY_SCOPE_WORKGROUP); }
                if (PROBE_SEG == 9) LDS_WAIT(); T_END(9);
            }
#pragma unroll
            for (int a_ = 0; a_ < 2; ++a_)
#pragma unroll
                for (int b_ = 0; b_ < 4; ++b_) kf[a_][b_] = kn[a_][b_];
            j = jn; nq = nqn;
        }
#undef NEXT_BLOCK
#undef LOAD_K
#undef LOAD_V
    }
    __syncthreads();
    T_END(5);
    { const float sc = g_slc / fmaxf((float)lacc[32 * w + col] * FXI, 1e-30f);
#pragma unroll
      for (int i = 0; i < 16; ++i) { const int dr = (i & 3) + 8 * (i >> 2) + 4 * hh;
          O[0][i] = xw0[i * 64] + (float)oacc[dr * 256 + 32 * w + col] * (FXI * sc); O[1][i] = totr[i] + (float)oacc[(32 + dr) * 256 + 32 * w + col] * (FXI * sc); } }
#undef ST_DMA
#undef BLK
#undef STEP_BEGIN
#undef STEP_END
    T_BEGIN(7);
    asm volatile("" : "+v"(lane));
    const int col_ = lane & 31, hh_ = lane >> 5, h_ = col_ & 3; const size_t row_ = (size_t)b * T + 64 * t + 8 * w + (col_ >> 2);
    const bf16* za = (const bf16*)(P.ws + WS_ZA) + row_ * 512 + (g * 4 + h_) * 64; bf16* mx = (bf16*)(P.ws + WS_MIX) + row_ * 1024 + 512 + (g * 4 + h_) * 64;
#pragma unroll
    for (int dt = 0; dt < 2; ++dt)
#pragma unroll
        for (int i4 = 0; i4 < 4; ++i4) { const int d = 32 * dt + 8 * i4 + 4 * hh_; const v2u z = *(const GAS v2u*)(za + d);
            v2u o; o.x = pk2(O[dt][4 * i4] * bf2f(z.x & 0xffffu), O[dt][4 * i4 + 1] * bf2f(z.x >> 16)); o.y = pk2(O[dt][4 * i4 + 2] * bf2f(z.y & 0xffffu), O[dt][4 * i4 + 3] * bf2f(z.y >> 16));
            *(GAS v2u*)(mx + d) = o; }
    if (g == 0) { const int tq = w, c8 = lane * 8; const size_t r0 = (size_t)b * T + 64 * t + 8 * tq;
        const bf16* U = (const bf16*)(P.ws + WS_U) + c8; const bf16* CGp = (const bf16*)(P.ws + WS_CG) + c8; bf16* mo = (bf16*)(P.ws + WS_MIX) + c8;
        v4u ur[10], cr[8];
        const bool has_prev = (t > 0) || (tq > 0);
#pragma unroll
        for (int i = 0; i < 10; ++i) ur[i] = (i >= 2 || has_prev) ? *(const GAS v4u*)(U + (r0 + i - 2) * 512) : (v4u){0u, 0u, 0u, 0u};
#pragma unroll
        for (int i = 0; i < 8; ++i) cr[i] = *(const GAS v4u*)(CGp + (r0 + i) * 512);
        float w0[8], w1[8], w2[8], cb[8];
#pragma unroll
        for (int e = 0; e < 8; ++e) { w0[e] = P.conv_w[c8 + e]; w1[e] = P.conv_w[512 + c8 + e]; w2[e] = P.conv_w[1024 + c8 + e]; cb[e] = P.conv_b[c8 + e]; }
#pragma unroll
        for (int i = 0; i < 8; ++i) { float o[8];
#pragma unroll
            for (int e = 0; e < 8; ++e) { const int sh_ = (e & 1) * 16; const float a = bf2f((ur[i][e >> 1] >> sh_) & 0xffffu), bb = bf2f((ur[i + 1][e >> 1] >> sh_) & 0xffffu), c = bf2f((ur[i + 2][e >> 1] >> sh_) & 0xffffu);
                o[e] = bf2f((cr[i][e >> 1] >> sh_) & 0xffffu) * (w0[e] * a + w1[e] * bb + w2[e] * c + cb[e]); }
            v4u ov; ov.x = pk2(o[0], o[1]); ov.y = pk2(o[2], o[3]); ov.z = pk2(o[4], o[5]); ov.w = pk2(o[6], o[7]);
            *(GAS v4u*)(mo + (r0 + i) * 1024) = ov; } }
    T_END(7); T_END(8);
}
template <class KeyFn>
__device__ __forceinline__ void sample_branch(Frame& F, int nslots, float shift, const KeyFn& key, LAS float* obr) {
    LAS float* q = (LAS float*)(F.lds + SM_Q); LAS float* Pb = (LAS float*)(F.lds + SM_P); LAS float* red = (LAS float*)(F.lds + SM_RED); LAS float* lsm = (LAS float*)(F.lds + SM_L);
    LAS unsigned long long* vptr = (LAS unsigned long long*)(F.lds + SM_VP);
    float lacc[4] = {0.f, 0.f, 0.f, 0.f};
    for (int s = F.tid; s < nslots; s += 512) { const float* kp; const float* vp; const bool valid = key(s, kp, vp);
        float sc[4] = {0.f, 0.f, 0.f, 0.f};
        if (valid) {
#pragma unroll 8
            for (int d4 = 0; d4 < 16; ++d4) { const f32x4 kv = *(const GAS f32x4*)(kp + 4 * d4);
#pragma unroll
                for (int hq = 0; hq < 4; ++hq) { const f32x4 qv = *(const LAS f32x4*)(q + hq * 64 + 4 * d4); sc[hq] += (kv.x * qv.x + kv.y * qv.y) + (kv.z * qv.z + kv.w * qv.w); } } }
        f32x4 p;
#pragma unroll
        for (int hq = 0; hq < 4; ++hq) { p[hq] = valid ? fast_exp2(sc[hq] - shift) : 0.f; lacc[hq] += p[hq]; }
        *(LAS f32x4*)(Pb + 4 * s) = p; vptr[s] = (unsigned long long)(uintptr_t)vp; }
#pragma unroll
    for (int hq = 0; hq < 4; ++hq) { lacc[hq] = wave_sum(lacc[hq]); if (F.lane == 0) red[F.wave * 4 + hq] = lacc[hq]; }
    __syncthreads();
    if (F.tid < 4) { float s = 0.f; for (int ww = 0; ww < 8; ++ww) s += red[ww * 4 + F.tid]; lsm[F.tid] = s; }
    const int sg = F.tid >> 4, d4 = F.tid & 15;
    f32x4 oa[4];
#pragma unroll
    for (int hq = 0; hq < 4; ++hq) oa[hq] = (f32x4){0.f, 0.f, 0.f, 0.f};
    for (int s0 = sg; s0 < nslots; s0 += 256) {
        f32x4 vv[8], pp[8];
#pragma unroll
        for (int u = 0; u < 8; ++u) { const int s = s0 + 32 * u; const float* vp = (const float*)(uintptr_t)vptr[s]; vv[u] = *(const GAS f32x4*)(vp + 4 * d4); pp[u] = *(const LAS f32x4*)(Pb + 4 * s); }
#pragma unroll
        for (int u = 0; u < 8; ++u) { oa[0] = oa[0] + vv[u] * pp[u].x; oa[1] = oa[1] + vv[u] * pp[u].y; oa[2] = oa[2] + vv[u] * pp[u].z; oa[3] = oa[3] + vv[u] * pp[u].w; } }
    __syncthreads();
    LAS float* red2 = (LAS float*)(F.lds + SM_RED2);
#pragma unroll
    for (int hq = 0; hq < 4; ++hq) *(LAS f32x4*)(red2 + (sg * 4 + hq) * 64 + 4 * d4) = oa[hq];
    __syncthreads();
    if (F.tid < 256) { float s = 0.f;
#pragma unroll 8
        for (int g2 = 0; g2 < 32; ++g2) s += red2[g2 * 256 + F.tid]; obr[F.tid] = s; }
    __syncthreads();
}
__device__ __forceinline__ void p3_sample_unit(const Ptrs& P, Frame& F, int b, int g) {
    asm volatile("" : "+v"(F.tid), "+v"(F.lane), "+s"(F.wave));
    LAS float* q = (LAS float*)(F.lds + SM_Q); LAS float* Pb = (LAS float*)(F.lds + SM_P); LAS float* imp = (LAS float*)(F.lds + SM_IMP); LAS float* lsm = (LAS float*)(F.lds + SM_L);
    LAS int* sel = (LAS int*)(F.lds + SM_SEL); LAS float* osm = (LAS float*)(F.lds + SM_O);
    const float* cst = (const float*)(P.ws + WS_CONST);
    float kcmax = 0.f; for (int e_ = 0; e_ < 4; ++e_) kcmax += __builtin_bit_cast(float, __hip_atomic_load((unsigned*)(P.ws + WS_CTL) + CW_KCMAX + 64 + e_, RLX_AGENT));
    const float sh_cmp = cst[0] * sqrtf(kcmax) * LOG2E * 1.001f, sh_slc = cst[1], sh_win = cst[2];
    if (F.tid < 256) q[F.tid] = ((const float*)(P.ws + WS_QS))[(size_t)b * 512 + g * 256 + F.tid];
    __syncthreads();
    const float* kcs = (const float*)(P.ws + WS_KCS) + (size_t)(b * 2 + g) * 2 * NCS * 64;
    sample_branch(F, NCS, sh_cmp, [&](int s, const float*& kp, const float*& vp) { kp = kcs + (size_t)s * 64; vp = kcs + (size_t)(NCS + s) * 64; return true; }, osm);
    { const f32x4 p = *(const LAS f32x4*)(Pb + 4 * F.tid); float v = p.x / lsm[0] + p.y / lsm[1] + p.z / lsm[2] + p.w / lsm[3]; v += __shfl_xor(v, 1);
      if ((F.tid & 1) == 0) imp[F.tid >> 1] = v; if (F.tid < 4) imp[256 + F.tid] = 0.f; }
    if (F.tid < 256) osm[F.tid] = osm[F.tid] / lsm[F.tid >> 6];
    __syncthreads();
    if (F.wave == 0) { const int lane = F.lane; unsigned k[4];
#pragma unroll
        for (int i = 0; i < 4; ++i) { const int j = lane + 64 * i; k[i] = (j >= 1 && j <= 254) ? __builtin_bit_cast(unsigned, imp[j]) + 1u : 0u; }
        unsigned Tv = 0u;
        for (int bit = 30; bit >= 0; --bit) { const unsigned cand = Tv | (1u << bit); int cnt = 0;
#pragma unroll
            for (int i = 0; i < 4; ++i) cnt += __popcll(__ballot(k[i] >= cand));
            if (cnt >= 13) Tv = cand; }
        int ngt = 0;
#pragma unroll
        for (int i = 0; i < 4; ++i) ngt += __popcll(__ballot(k[i] > Tv));
        const int need = 13 - ngt; const unsigned long long below = (lane == 0) ? 0ull : (~0ull >> (64 - lane));
        int base = 3, eqbase = 0;
        if (lane == 0) { int z_ = 0; asm volatile("" : "+v"(z_)); sel[0] = z_; sel[1] = z_ + 255; sel[2] = z_ + 256; }
#pragma unroll
        for (int i = 0; i < 4; ++i) { const unsigned long long e = __ballot(k[i] == Tv); const int rk = eqbase + __popcll(e & below); const bool on = k[i] > Tv || (k[i] == Tv && rk < need);
            const unsigned long long m = __ballot(on); if (on) sel[base + __popcll(m & below)] = lane + 64 * i; base += __popcll(m); eqbase += __popcll(e); } }
    __syncthreads();
    const float* kvn = (const float*)(P.ws + WS_KVN) + (size_t)b * 768;
    const int* pt = P.page_table + b * NPAGES; const float* cs = P.cache_slc;
    sample_branch(F, 1024, sh_slc, [&](int s, const float*& kp, const float*& vp) { const int j = sel[s >> 6], rr = s & 63;
        if (j == 256) { kp = kvn + (1 * 2 + 0) * 128 + g * 64; vp = kvn + (1 * 2 + 1) * 128 + g * 64; return rr == 0; }
        const float* rowp = cs + ((size_t)pt[j >> 1] * 128 + (j & 1) * 64 + rr) * 256 + g * 64; kp = rowp; vp = rowp + 128; return true; }, osm + 256);
    if (F.tid < 256) osm[256 + F.tid] = osm[256 + F.tid] / lsm[F.tid >> 6];
    __syncthreads();
    const float* stw = P.st_win + (size_t)b * 512 * 256;
    sample_branch(F, 512, sh_win, [&](int s, const float*& kp, const float*& vp) {
        if (s == 511) { kp = kvn + (2 * 2 + 0) * 128 + g * 64; vp = kvn + (2 * 2 + 1) * 128 + g * 64; return true; }
        const float* rowp = stw + (size_t)(s + 1) * 256 + g * 64; kp = rowp; vp = rowp + 128; return true; }, osm + 512);
    if (F.tid < 256) { const int hq = F.tid >> 6, d = F.tid & 63; const float* gs = (const float*)(P.ws + WS_GS) + b * 24 + (g * 4 + hq) * 3;
        const float o = gs[0] * osm[F.tid] + gs[1] * osm[256 + F.tid] + gs[2] * osm[512 + F.tid] / lsm[hq];
        ((bf16*)(P.ws + WS_MIXS))[(size_t)b * 1024 + 512 + (g * 4 + hq) * 64 + d] = (bf16)f2bf(o * ((const float*)(P.ws + WS_ZAS))[(size_t)b * 512 + (g * 4 + hq) * 64 + d]); }
    __syncthreads();
}
__device__ __forceinline__ void p3_phase(const Ptrs& P, Frame& F, int rep) {
    const float* cst = (const float*)(P.ws + WS_CONST);
    float kcmax = 0.f; for (int e_ = 0; e_ < 4; ++e_) kcmax += __builtin_bit_cast(float, __hip_atomic_load((unsigned*)(P.ws + WS_CTL) + CW_KCMAX + e_, RLX_AGENT));
    const float sh_cmp = cst[0] * sqrtf(kcmax) * LOG2E * 1.001f, sh_slc = cst[1], sh_win = cst[2];
    unsigned long long tacc = 0ull;
    volatile LAS int* qw = (volatile LAS int*)(F.lds + P3_MISC);
#ifndef PROBE_P3
#define PROBE_P3 0
#endif
    constexpr int NS_ = PROBE_P3 == 1 ? 16 : 8, PSH_ = PROBE_P3 == 2 ? 1 : 0;
    constexpr int NQ = NS_ + (128 << PSH_);
    const int x0 = (int)(xb_xcc_id() & 7u);
    for (int xi = 0; xi < 8; ++xi) {
        const int x = (x0 + xi) & 7;
        for (;;) {
            __syncthreads();
            if (F.tid == 0) qw[0] = (int)__hip_atomic_fetch_add((unsigned*)(F.ctl + CW_QUEUE + 64 * (x + 8 * rep)), 1u, RLX_AGENT);
            __syncthreads();
            const int idx = qw[0];
            if (idx >= NQ) break;
            if (idx < NS_) p3_sample_unit(P, F, x * 4 + ((idx & 7) >> 1), idx & 1);
            else p3_prompt_unit(P, F, x >> 1, 127 - ((idx - NS_) >> PSH_), x & 1, sh_cmp, sh_slc, sh_win, tacc);
        }
    }
    if (PROBE_SEG != 0 && blockIdx.x == 0) { const unsigned long long t0_ = __builtin_readcyclecounter(); while (__builtin_readcyclecounter() - t0_ < tacc) __builtin_amdgcn_s_sleep(8); }
}
#ifndef MK_N_LAUNCHES
#define MK_N_LAUNCHES 1
#endif
constexpr int N_PHASES = 5;
constexpr int N_LAUNCHES = MK_N_LAUNCHES;
struct Args { Ptrs p; int ph_lo, ph_hi, rep, mode; };
__global__ void __launch_bounds__(NWAVES * 64, 2) nsa_fwd(Args args) {
    extern __shared__ __attribute__((aligned(16))) unsigned char lds[];
    const Ptrs& P = args.p;
    Frame F;
    F.lds = (LAS unsigned char*)lds;
    F.MISC = (volatile LAS unsigned*)(F.lds + MISC_OFF);
    F.tid = threadIdx.x; F.lane = F.tid & 63; F.wave = __builtin_amdgcn_readfirstlane(F.tid >> 6);
    F.G = gridDim.x; F.gw = blockIdx.x * NWAVES + F.wave; F.NGW = F.G * NWAVES;
    F.ctl = (gu32*)(P.ws + WS_CTL);
    for (int u = F.tid; u < (LDS_BYTES - LDSCTL_OFF) / 4; u += NWAVES * 64) ((LAS unsigned*)(F.lds + LDSCTL_OFF))[u] = 0u;
    __syncthreads();
    XcdBarrier bar; bar.bar = (unsigned*)(F.ctl + CW_BAR); bar.x = 0; bar.st = nullptr;
    if (N_LAUNCHES == 1) bar = xcd_barrier_post((unsigned*)(F.ctl + CW_BAR), F.MISC + 8);
    const int lo = args.ph_lo, hi = args.ph_hi;
    unsigned long long tprobe = 0ull;
#define IN(k) (lo <= (k) && (k) < hi)
#define FENCE() do { asm volatile("" : "+s"(F.wave), "+s"(F.gw)); F.lane = (int)__builtin_amdgcn_mbcnt_hi(~0u, __builtin_amdgcn_mbcnt_lo(~0u, 0u)); F.tid = F.wave * 64 + F.lane; asm volatile("" : "+v"(F.tid), "+v"(F.lane)); } while (0)
#define SEAM(k) do { if (IN(k) && IN((k) + 1)) xcd_barrier(bar, F.wave == 0 && (int)__builtin_amdgcn_mbcnt_hi(~0u, __builtin_amdgcn_mbcnt_lo(~0u, 0u)) == 0); } while (0)

    if (IN(0)) { FENCE(); p0_phase(P, F); } SEAM(0);
    if (IN(1)) { FENCE();
        pg8::Gemm g{(const pg8::bf16_t*)(P.ws + WS_XB), (const pg8::bf16_t*)(P.ws + WS_BT1), M, NP, D};
        EpiIn E{(const float*)(P.ws + WS_RSTD), (const float*)(P.ws + WS_ROPE), P.q_gain, P.k_gain, P.out, P.ws};
        const int nround = ((M / 256) * (NP / 256) + F.G - 1) / F.G, jx = (int)blockIdx.x >> 3,
                  kst = (((((int)blockIdx.x & 7) + 2 * (((jx >> 2) & 1) | ((jx >> 4) << 1))) & 7) * nround) >> 3;
        { pg8::StaticOrder S; S.init(M, NP, F.G, (int)blockIdx.x, 0, kst); pg8::gemm_phase<EpiIn, pg8::StaticOrder, true, true>(F.lds + RING_OFF, g, S, E, F.wave, tprobe); }
        FENCE(); __syncthreads();
#ifdef PROBE_CW
        const unsigned long long tc0_ = __builtin_readcyclecounter();
#endif
        compress_wg(P, F, F.lds + RING_OFF);
        __syncthreads(); FENCE();
#ifdef PROBE_CW
        asm volatile("s_waitcnt vmcnt(0)" ::: "memory"); tprobe = __builtin_readcyclecounter() - tc0_;
#endif
        { pg8::StaticOrder S; S.init(M, NP, F.G, (int)blockIdx.x, kst, nround - kst); pg8::gemm_phase<EpiIn, pg8::StaticOrder, true, true>(F.lds + RING_OFF, g, S, E, F.wave, tprobe); }
        FENCE();
        for (int ct = F.gw; ct < NP / 16; ct += F.NGW) small_gemm_tile<0>(P, (const bf16*)(P.ws + WS_XSB), (const bf16*)(P.ws + WS_BT1), ct, F.lane);
#ifdef PROBE_CW
        if (blockIdx.x == PROBE_CW) { const unsigned long long t0_ = __builtin_readcyclecounter(); while (__builtin_readcyclecounter() - t0_ < tprobe) __builtin_amdgcn_s_sleep(8); }
        tprobe = 0ull;
#endif
#if defined(PROBE_EPI)
        if (PROBE_EPI == 1 && blockIdx.x == 0) { const unsigned long long t0_ = __builtin_readcyclecounter(); while (__builtin_readcyclecounter() - t0_ < tprobe) __builtin_amdgcn_s_sleep(8); }
        tprobe = 0ull;
#endif
    } SEAM(1);
    if (IN(2)) { FENCE(); p2_phase(P, F); } SEAM(2);
    if (IN(3)) { FENCE(); p3_phase(P, F, args.rep); } SEAM(3);
    if (IN(4)) { FENCE();
        pg8::Gemm g{(const pg8::bf16_t*)(P.ws + WS_MIX), (const pg8::bf16_t*)(P.ws + WS_BT2), M, D, D}; pg8::StaticOrder S; S.init(M, D, F.G, (int)blockIdx.x);
        EpiOut E{(const bf16*)(P.ws + WS_XB), P.out + O_Y};
        pg8::gemm_phase<EpiOut, pg8::StaticOrder, true, true>(F.lds + RING_OFF, g, S, E, F.wave, tprobe);
        FENCE();
        for (int ct = F.gw; ct < D / 16; ct += F.NGW) small_gemm_tile<1>(P, (const bf16*)(P.ws + WS_MIXS), (const bf16*)(P.ws + WS_BT2), ct, F.lane);
#if defined(PROBE_EPI)
        if (PROBE_EPI == 2 && blockIdx.x == 0) { const unsigned long long t0_ = __builtin_readcyclecounter(); while (__builtin_readcyclecounter() - t0_ < tprobe) __builtin_amdgcn_s_sleep(8); }
#endif
    }
#undef IN
#undef SEAM
}

extern "C" void kernel_launch(void* const* d_in, const int* in_sizes, int n_in, void* d_out, int out_size, void* d_ws, size_t ws_size, hipStream_t stream) {
    static int grid = 0;
    if (grid == 0) {
        if (n_in != 16 || out_size != (int)O_END || ws_size < WS_END) { fprintf(stderr, "kernel_launch: unexpected shapes (n_in %d, out %d, ws %zu)\n", n_in, out_size, ws_size); grid = -1; return; }
        int dev = 0, cus = 0, per_cu = 0;
        if (hipGetDevice(&dev) != hipSuccess || hipDeviceGetAttribute(&cus, hipDeviceAttributeMultiprocessorCount, dev) != hipSuccess) { grid = -1; return; }
        if (hipFuncSetAttribute((const void*)nsa_fwd, hipFuncAttributeMaxDynamicSharedMemorySize, LDS_BYTES) != hipSuccess) { fprintf(stderr, "kernel_launch: hipFuncSetAttribute failed\n"); grid = -1; return; }
        if (hipOccupancyMaxActiveBlocksPerMultiprocessor(&per_cu, (const void*)nsa_fwd, NWAVES * 64, LDS_BYTES) != hipSuccess || per_cu < 1)
            fprintf(stderr, "kernel_launch: note: occupancy query reports %d workgroups per CU\n", per_cu);
        (void)hipGetLastError();
        grid = cus;
    }
    if (grid < 0) return;
    if (hipMemsetAsync((char*)d_ws + WS_CTL, 0, CTL_ZERO_BYTES, stream) != hipSuccess) return;
    Args a{}; a.mode = 3;
    a.p.xp = (const float*)d_in[0]; a.p.xs = (const float*)d_in[1]; a.p.cache_cmp = (const float*)d_in[2]; a.p.cache_slc = (const float*)d_in[3];
    a.p.st_win = (const float*)d_in[4]; a.p.st_conv = (const float*)d_in[5]; a.p.page_table = (const int*)d_in[6]; a.p.norm_g = (const float*)d_in[7];
    a.p.w_in = (const float*)d_in[8]; a.p.conv_w = (const float*)d_in[9]; a.p.conv_b = (const float*)d_in[10]; a.p.q_gain = (const float*)d_in[11];
    a.p.k_gain = (const float*)d_in[12]; a.p.cmp_pe = (const float*)d_in[13]; a.p.cmp_w = (const float*)d_in[14]; a.p.w_out = (const float*)d_in[15];
    a.p.out = (float*)d_out; a.p.ws = (unsigned char*)d_ws;
#ifndef PROBE_DUP
#define PROBE_DUP -1
#endif
    for (int li = 0; li < N_LAUNCHES; ++li) {
        a.ph_lo = (N_LAUNCHES == 1) ? 0 : li; a.ph_hi = (N_LAUNCHES == 1) ? N_PHASES : li + 1;
        for (int rep = 0; rep < ((N_LAUNCHES > 1 && li == PROBE_DUP) ? 2 : 1); ++rep) {
            a.rep = rep;
            hipLaunchKernelGGL(nsa_fwd, dim3(grid), dim3(NWAVES * 64), LDS_BYTES, stream, a);
            const hipError_t le = hipPeekAtLastError();
            if (le != hipSuccess) { fprintf(stderr, "kernel_launch: launch %d failed: %s\n", li, hipGetErrorName(le)); break; }
        }
    }
}
```

```cpp
#include <hip/hip_runtime.h>
#include <cstdio>
#include <cstdint>
#define GAS __attribute__((address_space(1)))
#define LAS __attribute__((address_space(3)))
typedef unsigned short bf16;
typedef unsigned v4u __attribute__((ext_vector_type(4)));
typedef unsigned v2u __attribute__((ext_vector_type(2)));
typedef float f32x2 __attribute__((ext_vector_type(2)));
typedef float f32x16 __attribute__((ext_vector_type(16)));
typedef GAS unsigned gu32;
typedef GAS unsigned long long gu64;
#define RLX_AGENT __ATOMIC_RELAXED, __HIP_MEMORY_SCOPE_AGENT
#define LDS_WAIT() asm volatile("s_waitcnt lgkmcnt(0)" ::: "memory")
#define VM_WAIT() asm volatile("s_waitcnt vmcnt(0)" ::: "memory")
#define MK_N_LAUNCHES 1
#define PROBE_DUP -1
#define PROBE_P3 0
#define PROBE_SEG 0
namespace pg8 {
#define PG8_LAS __attribute__((address_space(3)))
typedef unsigned short bf16_t;
typedef short bf16x8 __attribute__((ext_vector_type(8)));
typedef float f32x4 __attribute__((ext_vector_type(4)));
typedef unsigned u32x4 __attribute__((ext_vector_type(4)));
constexpr int BM = 256, BK = 64, HALF = 128, HTB = HALF * BK * 2  , STAGE_BYTES = 8 * HTB, NXCD = 8, WGM = 8;

__host__ __device__ __forceinline__ int lds_byte(int r, int c) { const int st = (r >> 4) * 2 + (c >> 5), rr = r & 15, cc = c & 31, ob = rr * 64 + cc * 2; return st * 1024 + (ob ^ (((ob >> 9) & 1) << 5)); }
__host__ __device__ __forceinline__ void stage_rc(int b, int& R, int& C) { const int st = b / 1024, sb = b % 1024, swz = sb ^ (((sb >> 9) & 1) << 5); R = (st >> 1) * 16 + swz / 64; C = (st & 1) * 32 + (swz % 64) / 2; }
__host__ __device__ __forceinline__ int perm32(int rho) { const int n = rho >> 4, i = rho & 15; return 8 * (i >> 2) + 4 * n + (i & 3); }

struct Unit { int pm, pn; };
struct Gemm { const bf16_t* A; const bf16_t* Bt; int M, N, K; };

struct StaticOrder {
    int nM, nN, nwg, G, c, i0, n;
    __host__ __device__ void init(int M, int N, int G_, int c_, int i0_ = 0, int n_ = 1 << 30) { nM = M / BM; nN = N / BM; nwg = nM * nN; G = G_; c = c_; i0 = i0_; n = n_; }
    __host__ __device__ bool next(int i, Unit& u) const {
        if (i >= n) return false;
        const long L = (long)(i + i0) * G + c; if (L >= nwg) return false;
        int wgid = (int)L; { const int q = nwg / NXCD, r = nwg % NXCD, xcd = wgid % NXCD, off = wgid / NXCD; wgid = (xcd < r ? xcd * (q + 1) : r * (q + 1) + (xcd - r) * q) + off; }
        const int nig = WGM * nN, gid = wgid / nig, fm = gid * WGM, gsz = (nM - fm) < WGM ? (nM - fm) : WGM;
        u.pm = fm + ((wgid % nig) % gsz); u.pn = (wgid % nig) / gsz; return true;
    }
    __device__ __forceinline__ void a_ready(const Unit&) const {}
    __device__ __forceinline__ void done(const Unit&) const {}
};


template <class Epi, class Sched, bool ALIGN_EPI = false, bool SP2 = false>
__device__ __forceinline__ void gemm_phase(PG8_LAS unsigned char* lds, const Gemm g, const Sched& S, const Epi& E, int wave_id  , unsigned long long& tacc_  ) {
    const int lane = (int)__builtin_amdgcn_mbcnt_hi(~0u, __builtin_amdgcn_mbcnt_lo(~0u, 0u)), wid = wave_id, tid = wid * 64 + lane, wr = wid >> 2, wc = wid & 3, fr = lane & 15, fq = lane >> 4;
    const int K = g.K, nt = K / BK;
    unsigned voffA[2], voffB[2];
#pragma unroll
    for (int i = 0; i < 2; ++i) { int R, C; stage_rc(tid * 16 + i * 8192, R, C); const int Rb = Epi::PERM ? ((R & ~31) + perm32(R & 31)) : R;
        voffA[i] = (unsigned)(R * K + C) * 2u; voffB[i] = (unsigned)(Rb * K + C) * 2u; }
    const size_t kstep = (size_t)(BK * 2);
    const size_t hstep = (size_t)HALF * K * 2;
    const size_t tstep = 2 * hstep;
    const unsigned ldsw = (unsigned)wid * 1024u;
    const int aoff = lds_byte(wr * 64 + fr, fq * 8), boff = lds_byte(wc * 32 + fr, fq * 8);
#define PG8_SA(b, h) (((b) * 2 + (h)) * HTB)
#define PG8_SB(b, h) ((4 + (b) * 2 + (h)) * HTB)
#define PG8_STAGE(bufoff, gbase, voff) do { _Pragma("unroll") for (int _i = 0; _i < 2; ++_i) \
        __builtin_amdgcn_global_load_lds((const unsigned*)((const char*)(gbase) + (voff)[_i]), (PG8_LAS unsigned*)(lds + (bufoff) + ldsw + _i * 8192), 16, 0, 0); } while (0)
#define PG8_LDA(dst, b, h) do { _Pragma("unroll") for (int m = 0; m < 4; ++m) _Pragma("unroll") for (int k = 0; k < 2; ++k) dst[m][k] = *(const PG8_LAS bf16x8*)(lds + PG8_SA(b, h) + aoff + m * 2048 + k * 1024); } while (0)
#define PG8_LDB(dst, b, h) do { _Pragma("unroll") for (int n = 0; n < 2; ++n) _Pragma("unroll") for (int k = 0; k < 2; ++k) dst[n][k] = *(const PG8_LAS bf16x8*)(lds + PG8_SB(b, h) + boff + n * 2048 + k * 1024); } while (0)
#define PG8_MMA(ai, bj, At, Bt) do { __builtin_amdgcn_s_setprio(1); _Pragma("unroll") for (int m = 0; m < 4; ++m) _Pragma("unroll") for (int n = 0; n < 2; ++n) _Pragma("unroll") for (int k = 0; k < 2; ++k) \
        acc[ai][bj][m][n] = __builtin_amdgcn_mfma_f32_16x16x32_bf16(Bt[n][k], At[m][k], acc[ai][bj][m][n], 0, 0, 0); __builtin_amdgcn_s_setprio(0); } while (0)
#define PG8_WAIT_V(n) asm volatile("s_waitcnt vmcnt(" #n ")" ::: "memory")
#define PG8_WAIT_L(n) asm volatile("s_waitcnt lgkmcnt(" #n ")" ::: "memory")
#define PG8_BAR __builtin_amdgcn_s_barrier()
#define PG8_SCHED __builtin_amdgcn_sched_barrier(0)
    Unit cur, nxt; int ui = 0;
    if (!S.next(0, cur)) return;
    f32x4 acc[2][2][4][2];
#pragma unroll
    for (int a = 0; a < 2; ++a)
#pragma unroll
        for (int b = 0; b < 2; ++b)
#pragma unroll
            for (int m = 0; m < 4; ++m)
#pragma unroll
                for (int n = 0; n < 2; ++n) acc[a][b][m][n] = (f32x4){0.f, 0.f, 0.f, 0.f};
    bf16x8 At[4][2], B0[2][2], B1[2][2];
    const char* cA = (const char*)g.A + (size_t)cur.pm * tstep; const char* cB = (const char*)g.Bt + (size_t)cur.pn * tstep;
    S.a_ready(cur);
    if constexpr (SP2) {
        PG8_STAGE(PG8_SB(0, 0), cB, voffB); PG8_STAGE(PG8_SB(0, 1), cB + hstep, voffB); PG8_STAGE(PG8_SA(0, 0), cA, voffA); PG8_STAGE(PG8_SA(0, 1), cA + hstep, voffA);
        if (wr == 1) PG8_BAR;
        PG8_WAIT_V(2); PG8_BAR;
        PG8_STAGE(PG8_SB(1, 0), cB + kstep, voffB); PG8_STAGE(PG8_SA(1, 0), cA + kstep, voffA); PG8_STAGE(PG8_SB(1, 1), cB + hstep + kstep, voffB);
        PG8_WAIT_V(6); PG8_BAR;
    } else {
        PG8_STAGE(PG8_SB(0, 0), cB, voffB); PG8_STAGE(PG8_SA(0, 0), cA, voffA); PG8_STAGE(PG8_SB(0, 1), cB + hstep, voffB); PG8_STAGE(PG8_SA(0, 1), cA + hstep, voffA);
        if (wr == 1) PG8_BAR;
        PG8_WAIT_V(4); PG8_BAR;
        PG8_STAGE(PG8_SB(1, 0), cB + kstep, voffB); PG8_STAGE(PG8_SA(1, 0), cA + kstep, voffA); PG8_STAGE(PG8_SB(1, 1), cB + hstep + kstep, voffB);
        PG8_WAIT_V(6); PG8_BAR;
    }
    for (;;) {
        const bool has_next = S.next(ui + 1, nxt);
        const char* nA = has_next ? (const char*)g.A + (size_t)nxt.pm * tstep : cA; const char* nB = has_next ? (const char*)g.Bt + (size_t)nxt.pn * tstep : cB;
        for (int t = 0; t < nt; t += 2) {
            const bool last = (t == nt - 2);
            const char* a1 = cA + (size_t)(t + 1) * kstep;
            const char* a2 = last ? nA : cA + (size_t)(t + 2) * kstep; const char* b2 = last ? nB : cB + (size_t)(t + 2) * kstep;
            const char* a3 = a2 + kstep; const char* b3 = b2 + kstep;
            if (last && has_next) S.a_ready(nxt);
            if constexpr (SP2) {
            PG8_LDB(B0, 0, 0); PG8_LDB(B1, 0, 1); PG8_SCHED; PG8_LDA(At, 0, 0); PG8_STAGE(PG8_SA(1, 1), a1 + hstep, voffA);
            PG8_WAIT_V(8); PG8_WAIT_L(0); PG8_BAR; PG8_MMA(0, 0, At, B0); PG8_MMA(0, 1, At, B1); PG8_BAR; PG8_SCHED;
            PG8_LDA(At, 0, 1); PG8_STAGE(PG8_SB(0, 0), b2, voffB); PG8_STAGE(PG8_SB(0, 1), b2 + hstep, voffB); PG8_STAGE(PG8_SA(0, 0), a2, voffA);
            PG8_WAIT_V(8); PG8_WAIT_L(0); PG8_BAR; PG8_MMA(1, 0, At, B0); PG8_MMA(1, 1, At, B1); PG8_BAR; PG8_SCHED;
            PG8_LDB(B0, 1, 0); PG8_LDB(B1, 1, 1); PG8_SCHED; PG8_LDA(At, 1, 0); PG8_STAGE(PG8_SA(0, 1), a2 + hstep, voffA);
            PG8_WAIT_V(8); PG8_WAIT_L(0); PG8_BAR; PG8_MMA(0, 0, At, B0); PG8_MMA(0, 1, At, B1); PG8_BAR; PG8_SCHED;
            PG8_LDA(At, 1, 1); PG8_STAGE(PG8_SB(1, 0), b3, voffB); PG8_STAGE(PG8_SB(1, 1), b3 + hstep, voffB); PG8_STAGE(PG8_SA(1, 0), a3, voffA);
            PG8_WAIT_V(8); PG8_WAIT_L(0); PG8_BAR; PG8_MMA(1, 0, At, B0); PG8_MMA(1, 1, At, B1); PG8_BAR; PG8_SCHED;
            } else {
            PG8_LDB(B0, 0, 0); PG8_SCHED; PG8_LDA(At, 0, 0); PG8_STAGE(PG8_SA(1, 1), a1 + hstep, voffA);
            PG8_WAIT_L(8); PG8_BAR; PG8_WAIT_L(0); PG8_MMA(0, 0, At, B0); PG8_BAR; PG8_SCHED;
            PG8_LDB(B1, 0, 1); PG8_STAGE(PG8_SB(0, 0), b2, voffB);
            PG8_BAR; PG8_WAIT_L(0); PG8_MMA(0, 1, At, B1); PG8_BAR;
            PG8_LDA(At, 0, 1); PG8_STAGE(PG8_SA(0, 0), a2, voffA);
            PG8_BAR; PG8_WAIT_L(0); PG8_MMA(1, 0, At, B0); PG8_BAR; PG8_SCHED;
            PG8_STAGE(PG8_SB(0, 1), b2 + hstep, voffB);
            PG8_WAIT_V(6); PG8_BAR; PG8_MMA(1, 1, At, B1); PG8_BAR;
            PG8_LDB(B0, 1, 0); PG8_SCHED; PG8_LDA(At, 1, 0); PG8_STAGE(PG8_SA(0, 1), a2 + hstep, voffA);
            PG8_WAIT_L(8); PG8_BAR; PG8_WAIT_L(0); PG8_MMA(0, 0, At, B0); PG8_BAR; PG8_SCHED;
            PG8_LDB(B1, 1, 1); PG8_STAGE(PG8_SB(1, 0), b3, voffB);
            PG8_BAR; PG8_WAIT_L(0); PG8_MMA(0, 1, At, B1); PG8_BAR;
            PG8_LDA(At, 1, 1); PG8_STAGE(PG8_SA(1, 0), a3, voffA);
            PG8_BAR; PG8_WAIT_L(0); PG8_MMA(1, 0, At, B0); PG8_BAR; PG8_SCHED;
            PG8_STAGE(PG8_SB(1, 1), b3 + hstep, voffB);
            PG8_WAIT_V(6); PG8_BAR; PG8_MMA(1, 1, At, B1); PG8_BAR;
            }
        }
        if constexpr (ALIGN_EPI) { if (wr == 0) PG8_BAR; }
#ifdef PROBE_EPI
        { const unsigned long long t0_ = __builtin_readcyclecounter(); E(acc, cur, wr, wc, fr, fq); asm volatile("s_waitcnt vmcnt(0)" ::: "memory"); tacc_ += __builtin_readcyclecounter() - t0_; S.done(cur); }
#else
        if constexpr (!Epi::AFTER_DRAIN) { E(acc, cur, wr, wc, fr, fq); S.done(cur); }
#endif
        if (!has_next) break;
#pragma unroll
        for (int a = 0; a < 2; ++a)
#pragma unroll
            for (int b = 0; b < 2; ++b)
#pragma unroll
                for (int m = 0; m < 4; ++m)
#pragma unroll
                    for (int n = 0; n < 2; ++n) acc[a][b][m][n] = (f32x4){0.f, 0.f, 0.f, 0.f};
        cur = nxt; cA = nA; cB = nB; ++ui;
        if constexpr (ALIGN_EPI) { if (wr == 1) PG8_BAR; }
    }
    PG8_WAIT_V(0);
    if constexpr (!ALIGN_EPI) { if (wr == 0) PG8_BAR; }
    PG8_BAR;
    if constexpr (Epi::AFTER_DRAIN) { E.fused(acc, cur, wr, wc, fr, fq, lds, wid, lane); S.done(cur); }
#undef PG8_SA
#undef PG8_SB
#undef PG8_STAGE
#undef PG8_LDA
#undef PG8_LDB
#undef PG8_MMA
#undef PG8_WAIT_V
#undef PG8_WAIT_L
#undef PG8_BAR
#undef PG8_SCHED
}
}
#define XB_TMO      128
#define XB_XCNT(j)  (256  + 64 * (j))
#define XB_XSUB(j)  (1280 + 64 * (j))
#define XB_XGEN(j)  (2304 + 64 * (j))
#define XB_TOP      3328
#define XB_TOPGEN   3392
#define XCD_BAR_WORDS 3456
#define XB_SPIN_CAP (1u << 18)

__device__ __forceinline__ unsigned xb_ld(unsigned* p)              { return __hip_atomic_load(p, __ATOMIC_RELAXED, __HIP_MEMORY_SCOPE_AGENT); }
__device__ __forceinline__ unsigned xb_add(unsigned* p, unsigned v) { return __hip_atomic_fetch_add(p, v, __ATOMIC_RELAXED, __HIP_MEMORY_SCOPE_AGENT); }
__device__ __forceinline__ unsigned xb_xcc_id() { return (unsigned)__builtin_amdgcn_s_getreg((3 << 11) | 20) & 0xFu; }
#define XB_SPIN(cond, bar) do { unsigned _sp = 0; while (cond) { __builtin_amdgcn_s_sleep(1); \
    if ((++_sp & 255u) == 0u) { if (xb_ld(&(bar)[XB_TMO])) break; if (_sp > XB_SPIN_CAP) { atomicAdd(&(bar)[XB_TMO], 1u); break; } } } } while (0)

struct XcdBarrier {
    unsigned* bar; unsigned x;
    volatile LAS unsigned* st;
};

__device__ __forceinline__ XcdBarrier xcd_barrier_post(unsigned* bar, volatile LAS unsigned* st) {
    XcdBarrier b; b.bar = bar; b.x = xb_xcc_id(); b.st = st;
    if (threadIdx.x == 0) (void)xb_add(&bar[XB_XCNT(b.x)], 1u);
    return b;
}
__device__ __forceinline__ void xcd_barrier_complete(unsigned* bar, unsigned x, unsigned& nloc, unsigned& nx) {
    const unsigned G = gridDim.x * gridDim.y * gridDim.z;
    unsigned sum, cnt, mine, sp = 0u;
    for (;;) {
        sum = 0u; cnt = 0u; mine = 0u;
#pragma unroll
        for (unsigned j = 0; j < 16; ++j) { const unsigned c = xb_ld(&bar[XB_XCNT(j)]); sum += c; cnt += (c > 0u) ? 1u : 0u; mine = (j == x) ? c : mine; }
        if (sum == G) break;
        __builtin_amdgcn_s_sleep(1);
        if ((++sp & 255u) == 0u) { if (xb_ld(&bar[XB_TMO])) break; if (sp > XB_SPIN_CAP) { atomicAdd(&bar[XB_TMO], 1u); break; } }
    }
    nloc = mine > 0u ? mine : 1u; nx = cnt > 0u ? cnt : 1u;
}

__device__ __forceinline__ void xcd_barrier(const XcdBarrier& b, bool leader  ) {
    asm volatile("s_waitcnt vmcnt(0)" ::: "memory");
    __syncthreads();
    if (leader) {
        unsigned* bar = b.bar;
        __builtin_amdgcn_s_waitcnt(0);
        unsigned nloc = b.st[0], nx = b.st[1];
        if (nloc == 0u) { xcd_barrier_complete(bar, b.x, nloc, nx); b.st[0] = nloc; b.st[1] = nx; }
        const unsigned old = xb_add(&bar[XB_XSUB(b.x)], 1u);
        const unsigned gen = old / nloc;
        if (old + 1u == (gen + 1u) * nloc) {
            __builtin_amdgcn_fence(__ATOMIC_RELEASE, "agent");
            asm volatile("s_waitcnt vmcnt(0)" ::: "memory");
            const unsigned og = xb_add(&bar[XB_TOP], 1u);
            const unsigned tg = og / nx;
            if (og + 1u == (tg + 1u) * nx) xb_add(&bar[XB_TOPGEN], 1u);
            else XB_SPIN(xb_ld(&bar[XB_TOPGEN]) == tg, bar);
            __builtin_amdgcn_fence(__ATOMIC_ACQUIRE, "agent");
            xb_add(&bar[XB_XGEN(b.x)], 1u);
            asm volatile("s_waitcnt vmcnt(0)" ::: "memory");
        } else {
            XB_SPIN(xb_ld(&bar[XB_XGEN(b.x)]) == gen, bar);
            __builtin_amdgcn_fence(__ATOMIC_ACQUIRE, "agent");
            asm volatile("s_waitcnt vmcnt(0)" ::: "memory");
        }
    }
    __syncthreads();
}
using pg8::f32x4; using pg8::bf16x8;
constexpr int NWAVES = 8;
constexpr int BATCH = 4, T = 8192, D = 1024, M = BATCH * T, NP = 4096, INW = 3864;
constexpr int DECB = 32, PAST = 16384, NPAGES = 128, NCS = 512  ;
constexpr float NORM_EPS = 1e-6f;
constexpr float LOG2E = 1.4426950408889634f;
constexpr float QSCALE = 0.125f * LOG2E;
constexpr size_t O_Y = 0, O_YS = 33554432, O_PCMP = 33587200, O_PSLC = 41975808, O_PWIN = 50364416, O_PCONV = 50888704,
                 O_SCMP = 50892800, O_SSLC = 50900992, O_SWIN = 50909184, O_SCONV = 55103488, O_END = 55136256;
constexpr int C_BG = 0, C_CG = 512, C_CI = 1024, C_ZC = 1536, C_Q = 2048, C_KV = 2560, C_GL = 3328, C_ZA = 3352;

constexpr size_t MiB = 1u << 20, KiB = 1u << 10;
constexpr size_t WS_CTL = 0, CTL_ZERO_BYTES = 1 * MiB;
constexpr size_t WS_BT1 = 2 * MiB;
constexpr size_t WS_BT2 = 10 * MiB;
constexpr size_t WS_BTC = 12 * MiB;
constexpr size_t WS_CBIAS = 12 * MiB + 512 * KiB;
constexpr size_t WS_CONST = WS_CBIAS + 4 * KiB;
constexpr size_t WS_ROPE = 13 * MiB;
constexpr size_t WS_RSTD = 16 * MiB;
constexpr size_t WS_XSB = 16 * MiB + 256 * KiB;
constexpr size_t WS_RSTDS = WS_XSB + 64 * KiB;
constexpr size_t WS_GATE = 17 * MiB;
constexpr size_t WS_KC = 20 * MiB;
constexpr size_t WS_PROJS = 21 * MiB;
constexpr size_t WS_QS = 22 * MiB;
constexpr size_t WS_KVN = WS_QS + 64 * KiB;
constexpr size_t WS_GS = WS_KVN + 96 * KiB;
constexpr size_t WS_ZAS = WS_GS + 4 * KiB;
constexpr size_t WS_MIXS = WS_ZAS + 64 * KiB;
constexpr size_t WS_KCS = 24 * MiB;
constexpr size_t WS_KS = 40 * MiB, WS_KW = 56 * MiB;
constexpr size_t WS_XB = 72 * MiB;
constexpr size_t WS_CG = 136 * MiB, WS_U = 168 * MiB, WS_ZA = 200 * MiB, WS_Q = 232 * MiB;
constexpr size_t WS_MIX = 264 * MiB;
constexpr size_t WS_TOT = 328 * MiB;
constexpr size_t WS_END = 344 * MiB;
constexpr int CW_TMO = 0, CW_CODE = 1;
constexpr int CW_BAR = 4096;
constexpr int CW_QUEUE = 16384;
constexpr int CW_P0CNT = 18432;
constexpr int CW_KCMAX = 20480;

constexpr int RING_OFF = 0, RING_BYTES = 131072;
constexpr int LDSCTL_OFF = RING_BYTES, MISC_OFF = LDSCTL_OFF + 320;
constexpr int LDS_BYTES = 147456;

__device__ __forceinline__ unsigned f2bf(float f) { unsigned u = __builtin_bit_cast(unsigned, f); return (u + 0x7fffu + ((u >> 16) & 1u)) >> 16; }
typedef __bf16 bf16x2_t __attribute__((ext_vector_type(2)));
__device__ __forceinline__ unsigned pk2(float lo, float hi) { return __builtin_bit_cast(unsigned, __builtin_convertvector((f32x2){lo, hi}, bf16x2_t)); }
__device__ __forceinline__ float bf2f(unsigned h) { return __builtin_bit_cast(float, h << 16); }
__device__ __forceinline__ float wave_sum(float v) {
#pragma unroll
    for (int o = 1; o < 64; o <<= 1) v += __shfl_xor(v, o);
    return v;
}
__device__ __forceinline__ float quad_sum(float v) {
    v += __builtin_bit_cast(float, __builtin_amdgcn_update_dpp(0, __builtin_bit_cast(int, v), 0xB1, 0xF, 0xF, true));
    v += __builtin_bit_cast(float, __builtin_amdgcn_update_dpp(0, __builtin_bit_cast(int, v), 0x4E, 0xF, 0xF, true));
    return v;
}
__device__ __forceinline__ float fast_exp2(float x) { return __builtin_amdgcn_exp2f(x); }
__device__ __forceinline__ float sigmoidf(float x) { return __builtin_amdgcn_rcpf(1.0f + fast_exp2(-x * LOG2E)); }
__device__ __forceinline__ float slc_vscale(float sh_slc) { return fast_exp2(floorf(18.0f - sh_slc)); }
__device__ __forceinline__ int kimg_off(int key, int d) { return ((((key >> 5) * 4 + (d >> 4)) * 64 + ((d >> 3) & 1) * 32 + (key & 31)) << 3) + (d & 7); }
__device__ __forceinline__ int vimg_off(int d, int pos) { return 4096 + ((((d >> 5) * 4 + (pos >> 4)) * 64 + ((pos >> 3) & 1) * 32 + (d & 31)) << 3) + (pos & 7); }
__device__ __forceinline__ int perm16(int kk) { return 8 * ((kk >> 2) & 1) + 4 * (kk >> 3) + (kk & 3); }

struct Ptrs {
    const float *xp, *xs, *cache_cmp, *cache_slc, *st_win, *st_conv; const int* page_table;
    const float *norm_g, *w_in, *conv_w, *conv_b, *q_gain, *k_gain, *cmp_pe, *cmp_w, *w_out;
    float* out; unsigned char* ws;
};
struct Frame {
    LAS unsigned char* lds;
    volatile LAS unsigned* MISC;
    gu32* ctl;
    int tid, lane, wave, G, gw, NGW;
};
__device__ __forceinline__ int bt1_src(int dg, int& nvalid) {
    const int pn = dg >> 3, gi = dg & 7, bj = gi >> 2, wc = gi & 3; nvalid = 32;
    if (pn < 4) return (bj ? C_ZC : C_BG) + 128 * pn + 32 * wc;
    if (pn < 8) return (bj ? C_CI : C_CG) + 128 * (pn - 4) + 32 * wc;
    if (pn < 10) return C_Q + (4 * (pn - 8) + wc) * 64 + 32 * bj;
    if (pn < 13) return C_KV + (pn - 10) * 256 + wc * 64 + 32 * bj;
    if (pn < 15) return C_ZA + 256 * (pn - 13) + 32 * gi;
    nvalid = (gi == 0) ? 24 : 0; return C_GL;
}
__device__ __forceinline__ void p0_transpose_item(const float* W, int ldw, int k0, int src0, int nvalid, const float* ksc, bf16* WT, int ldt, int drow0, LAS float* scr, int lane) {
    const int nn = lane & 31;
#pragma unroll 8
    for (int i = 0; i < 32; ++i) { const int kk = 2 * i + (lane >> 5); float v = 0.f;
        if (nn < nvalid) { v = W[(size_t)(k0 + kk) * ldw + src0 + nn]; if (ksc) v *= ksc[k0 + kk]; }
        scr[kk * 33 + nn] = v; }
    LDS_WAIT(); asm volatile("" ::: "memory");
    const int c = lane & 7;
#pragma unroll
    for (int j = 0; j < 4; ++j) { const int n = (lane >> 3) + 8 * j; const LAS float* s = scr + (8 * c) * 33 + n;
        v4u o; o.x = pk2(s[0 * 33], s[1 * 33]); o.y = pk2(s[2 * 33], s[3 * 33]); o.z = pk2(s[4 * 33], s[5 * 33]); o.w = pk2(s[6 * 33], s[7 * 33]);
        *(GAS v4u*)(WT + (size_t)(drow0 + n) * ldt + k0 + 8 * c) = o; }
    LDS_WAIT(); asm volatile("" ::: "memory");
}
template <int NR>
__device__ __forceinline__ void x_rows_load(f32x4 (&v)[NR][4], const float* xrow, int lane) {
#pragma unroll
    for (int r = 0; r < NR; ++r)
#pragma unroll
        for (int j = 0; j < 4; ++j) v[r][j] = ((const GAS f32x4*)(xrow + (size_t)r * D) + lane)[64 * j];
}
template <int NR>
__device__ __forceinline__ void x_rows_finish(const f32x4 (&v)[NR][4], bf16* orow, float* rstd_out, int lane) {
    float s[NR];
#pragma unroll
    for (int r = 0; r < NR; ++r) { s[r] = 0.f;
#pragma unroll
        for (int j = 0; j < 4; ++j) s[r] += (v[r][j].x * v[r][j].x + v[r][j].y * v[r][j].y) + (v[r][j].z * v[r][j].z + v[r][j].w * v[r][j].w); }
#pragma unroll
    for (int o = 1; o < 64; o <<= 1)
#pragma unroll
        for (int r = 0; r < NR; ++r) s[r] += __shfl_xor(s[r], o);
#pragma unroll
    for (int r = 0; r < NR; ++r) { GAS unsigned long long* o8 = (GAS unsigned long long*)(orow + (size_t)r * D) + lane;
#pragma unroll
        for (int j = 0; j < 4; ++j) o8[64 * j] = (unsigned long long)pk2(v[r][j].x, v[r][j].y) | ((unsigned long long)pk2(v[r][j].z, v[r][j].w) << 32);
        if (lane == 0) rstd_out[r] = 1.0f / sqrtf(s[r] * (1.0f / D) + NORM_EPS); }
}
template <int NR>
__device__ __forceinline__ void x_rows_to_bf16(const float* xrow, bf16* orow, float* rstd_out, int lane) {
    f32x4 v[NR][4]; x_rows_load<NR>(v, xrow, lane); x_rows_finish<NR>(v, orow, rstd_out, lane);
}
__device__ __forceinline__ void x_rows_stream(const Ptrs& P, int m0, int mstride, int lane) {
    if (m0 >= M) return;
    f32x4 va[4][4], vb[4][4];
    x_rows_load<4>(va, P.xp + (size_t)m0 * D, lane);
    for (int m = m0; m < M; m += 2 * mstride) {
        const int m1 = m + mstride, m2 = m + 2 * mstride;
        if (m1 < M) x_rows_load<4>(vb, P.xp + (size_t)m1 * D, lane);
        x_rows_finish<4>(va, (bf16*)(P.ws + WS_XB) + (size_t)m * D, (float*)(P.ws + WS_RSTD) + m, lane);
        if (m2 < M) x_rows_load<4>(va, P.xp + (size_t)m2 * D, lane);
        if (m1 < M) x_rows_finish<4>(vb, (bf16*)(P.ws + WS_XB) + (size_t)m1 * D, (float*)(P.ws + WS_RSTD) + m1, lane);
    }
}
template <class Side>
__device__ __forceinline__ void compress_prompt_units(const Ptrs& P, Frame& F, LAS float* part  , const Side& side  ) {
    constexpr int NUNITS = BATCH * 32 * 2;
    const int lane = F.lane, w = F.wave, rho = lane & 15, kq = lane >> 4;
    const GAS v4u* bfr = (const GAS v4u*)(P.ws + WS_BTC) + lane;
    const float* cbias = (const float*)(P.ws + WS_CBIAS);
    for (int unit = blockIdx.x; unit < NUNITS; unit += F.G) {
        const int j = unit & 1, b = unit >> 6, c0 = ((unit >> 1) & 31) * 8;
        const float* rb = P.out + O_PCMP + ((size_t)b * T + (c0 + (rho >> 1)) * 32) * 256 + j * 128 + (rho & 1) * 64 + 4 * kq;
        f32x4 a[4][4]; bf16x8 bb[4][8];
#pragma unroll
        for (int rr = 0; rr < 4; ++rr) { const int r = 4 * w + rr;
#pragma unroll
            for (int dh = 0; dh < 2; ++dh) { a[rr][2 * dh] = *(const GAS f32x4*)(rb + r * 256 + dh * 32); a[rr][2 * dh + 1] = *(const GAS f32x4*)(rb + r * 256 + dh * 32 + 16); } }
        f32x4 acc[4];
#pragma unroll
        for (int e = 0; e < 4; ++e) acc[e] = (f32x4){0.f, 0.f, 0.f, 0.f};
        if (unit == (int)blockIdx.x) side();
#pragma unroll
        for (int rr = 0; rr < 4; ++rr) { const int r = 4 * w + rr;
#pragma unroll
            for (int dh = 0; dh < 2; ++dh)
#pragma unroll
                for (int et = 0; et < 4; ++et) bb[rr & 1][dh * 4 + et] = __builtin_bit_cast(bf16x8, bfr[(size_t)((((j * 32 + r) * 2 + dh) * 4 + et) * 64)]);
#pragma unroll
            for (int dh = 0; dh < 2; ++dh) { const f32x4 x0 = a[rr][2 * dh], x1 = a[rr][2 * dh + 1];
                v4u wv; wv.x = pk2(x0.x, x0.y); wv.y = pk2(x0.z, x0.w); wv.z = pk2(x1.x, x1.y); wv.w = pk2(x1.z, x1.w);
                const bf16x8 af = __builtin_bit_cast(bf16x8, wv);
#pragma unroll
                for (int et = 0; et < 4; ++et) acc[et] = __builtin_amdgcn_mfma_f32_16x16x32_bf16(af, bb[rr & 1][dh * 4 + et], acc[et], 0, 0, 0); } }
        __syncthreads();
#pragma unroll
        for (int et = 0; et < 4; ++et) *(LAS f32x4*)(part + ((w * 4 + et) * 64 + lane) * 4) = acc[et];
        __syncthreads();
        if (w < 4) { const int et = w, e = 16 * et + rho; f32x4 sum = *(const LAS f32x4*)(part + ((0 * 4 + et) * 64 + lane) * 4);
#pragma unroll
          for (int ww = 1; ww < 8; ++ww) sum = sum + *(const LAS f32x4*)(part + ((ww * 4 + et) * 64 + lane) * 4);
          const float bs = cbias[j * 64 + e];
          float nmax = 0.f;
#pragma unroll
          for (int i = 0; i < 4; ++i) { const int row = 4 * kq + i, c = c0 + (row >> 1), g = row & 1; const float val = sum[i] + bs;
              float q2 = val * val; q2 += __shfl_xor(q2, 1); q2 += __shfl_xor(q2, 2); q2 += __shfl_xor(q2, 4); q2 += __shfl_xor(q2, 8); nmax = fmaxf(nmax, q2);
              bf16* img = (bf16*)(P.ws + WS_KC) + ((size_t)(b * 2 + g) * 4 + (c >> 6)) * 8192;
              if (j == 0) img[kimg_off(c & 63, e)] = (bf16)f2bf(val); else img[vimg_off(e, (c & 48) + perm16(c & 15))] = (bf16)f2bf(val); }
          if (j == 0) { nmax = fmaxf(nmax, __shfl_xor(nmax, 16)); nmax = fmaxf(nmax, __shfl_xor(nmax, 32));
              if (lane == 0) atomicMax((unsigned*)(P.ws + WS_CTL) + CW_KCMAX + et, __builtin_bit_cast(unsigned, nmax)); } }
    }
}
constexpr int P0_PRODUCERS = 641;
__device__ __forceinline__ void p0_small_items(const Ptrs& P, Frame& F) {
    const int lane = F.lane, gw = F.gw;
    if (gw >= P0_PRODUCERS && F.NGW >= P0_PRODUCERS) return;
    for (int item = gw; item < P0_PRODUCERS; item += F.NGW) {
        if (item < 512) { const int it = item * 64 + lane; const int l = it & 63, et = (it >> 6) & 3, dh = (it >> 8) & 1, r = (it >> 9) & 31, j = it >> 14;
            const float* w = P.cmp_w + ((size_t)(r * 2 + j) * 64 + 32 * dh + 4 * (l >> 4)) * 64 + 16 * et + (l & 15);
            v4u o; o.x = pk2(w[0], w[64]); o.y = pk2(w[128], w[192]); o.z = pk2(w[16 * 64], w[17 * 64]); o.w = pk2(w[18 * 64], w[19 * 64]);
            __builtin_amdgcn_raw_buffer_store_b128(o, __builtin_amdgcn_make_buffer_rsrc((void*)(P.ws + WS_BTC), 0, 512 * 1024, 0x00020000), it * 16, 0, 16);
        } else if (item < 640) { const int it = item - 512, j = it >> 6, e = it & 63; float s = 0.f;
            for (int k = lane; k < 2048; k += 64) { const int r = k >> 6, d = k & 63; s += P.cmp_pe[(r * 2 + j) * 64 + d] * P.cmp_w[((size_t)(r * 2 + j) * 64 + d) * 64 + e]; }
            s = wave_sum(s); if (lane == 0) __hip_atomic_store((float*)(P.ws + WS_CBIAS) + it, s, RLX_AGENT);
        } else { float qm = fabsf(P.q_gain[lane]), k1 = fabsf(P.k_gain[64 + lane]), k2 = fabsf(P.k_gain[128 + lane]);
#pragma unroll
            for (int o = 1; o < 64; o <<= 1) { qm = fmaxf(qm, __shfl_xor(qm, o)); k1 = fmaxf(k1, __shfl_xor(k1, o)); k2 = fmaxf(k2, __shfl_xor(k2, o)); }
            if (lane == 0) { float* cst = (float*)(P.ws + WS_CONST); __hip_atomic_store(cst + 0, qm, RLX_AGENT); __hip_atomic_store(cst + 1, 8.0f * qm * k1 * LOG2E * 1.001f, RLX_AGENT); __hip_atomic_store(cst + 2, 8.0f * qm * k2 * LOG2E * 1.001f, RLX_AGENT); } }
        asm volatile("s_waitcnt vmcnt(0)" ::: "memory");
        if (lane == 0) __hip_atomic_fetch_add((unsigned*)(F.ctl + CW_P0CNT), 1u, RLX_AGENT);
    }
}
__device__ __forceinline__ void p0_rope(const Ptrs& P, Frame& F, int gw, int NGW) {
    const int lane = F.lane; const int i = lane & 31;
    const float inv = (float)pow(10000.0, -(double)i / 32.0);
    for (int it = gw * 64 + lane; it < 8193 * 32; it += NGW * 64) { const int p = it >> 5; const int pos = (p == 8192) ? PAST : p;
        const float ang = (float)pos * inv; const double rev = (double)ang * 0.15915494309189535; const float fr = (float)(rev - __builtin_rint(rev));
        float* rt = (float*)(P.ws + WS_ROPE) + (size_t)p * 64; rt[i] = __builtin_amdgcn_cosf(fr); rt[32 + i] = __builtin_amdgcn_sinf(fr); }
}
__device__ __forceinline__ void p0_other_slice(const Ptrs& P, Frame& F, int k, int gw, int NGW, LAS float* scr) {
    const int lane = F.lane;
    if (k < 2) { const int it = gw + k * NGW; if (it < 16 * 128) { const int kb = it >> 7, dg = it & 127; int nv; const int src0 = bt1_src(dg, nv);
        p0_transpose_item(P.w_in, INW, 64 * kb, src0, nv, P.norm_g, (bf16*)(P.ws + WS_BT1), D, 32 * dg, scr, lane); }
    } else if (k == 2) { for (int it = gw; it < 16 * 32; it += NGW) { const int kb = it >> 5, nb = it & 31;
        p0_transpose_item(P.w_out, D, 64 * kb, 32 * nb, 32, nullptr, (bf16*)(P.ws + WS_BT2), D, 32 * nb, scr, lane); }
    } else if (k == 3) { x_rows_stream(P, gw * 4, NGW * 4, lane);
    } else if (k < 11) {
    } else if (k == 11) { for (int m = gw; m < DECB; m += NGW) x_rows_to_bf16<1>(P.xs + (size_t)m * D, (bf16*)(P.ws + WS_XSB) + (size_t)m * D, (float*)(P.ws + WS_RSTDS) + m, lane);
        for (int it = gw * 64 + lane; it < DECB * 512; it += NGW * 64) { const int b = it >> 9, ch = it & 511; P.out[O_SCONV + (size_t)b * 1024 + ch] = P.st_conv[(size_t)b * 1024 + 512 + ch]; }
    } else if (k == 12) {
        constexpr int PERB = 511 * 64, TOTAL = DECB * PERB; const GAS f32x4* src = (const GAS f32x4*)P.st_win; GAS f32x4* dst = (GAS f32x4*)(P.out + O_SWIN);
        for (int i0 = gw * 64 + lane; i0 < TOTAL; i0 += NGW * 64 * 8) { f32x4 t[8];
#pragma unroll
            for (int u = 0; u < 8; ++u) { const int i = i0 + u * NGW * 64; if (i < TOTAL) { const int b = i / PERB; t[u] = src[i + 64 * b + 64]; } }
#pragma unroll
            for (int u = 0; u < 8; ++u) { const int i = i0 + u * NGW * 64; if (i < TOTAL) { const int b = i / PERB; dst[i + 64 * b] = t[u]; } } }
    } else if (k == 13) p0_rope(P, F, gw, NGW);
}
constexpr int P0_OTHER_SLICES = 14;
__device__ __forceinline__ void p0_phase(const Ptrs& P, Frame& F) {
    p0_small_items(P, F);
    LAS float* scr = (LAS float*)(F.lds + RING_OFF + F.wave * 16384);
    for (int k = 0; k < P0_OTHER_SLICES; ++k) p0_other_slice(P, F, k, F.gw, F.NGW, scr);
}
constexpr int CW_NS = 4, CW_NPASS = DECB * 8;
#define CW_LOAD(dst, base, r) do { _Pragma("unroll") for (int q_ = 0; q_ < 4; ++q_) { dst[2 * q_] = *(const GAS f32x4*)((base) + (r) * 256 + (q_ >> 1) * 128 + (q_ & 1) * 32); dst[2 * q_ + 1] = *(const GAS f32x4*)((base) + (r) * 256 + (q_ >> 1) * 128 + (q_ & 1) * 32 + 16); } } while (0)
template <int S>
__device__ __forceinline__ void cw_step(f32x4 (&a)[CW_NS][8], v4u (&vb)[4], f32x4 (&acc)[2][4], const float*& rp, int& nr, const GAS v4u*& bp, int& nb, LAS v4u* bdst, const LAS v4u* bl_lane) {
    if constexpr ((S & 1) == 0) {
#pragma unroll
        for (int i = 0; i < 4; ++i) vb[i] = bp[i];
        if (nb < 15) { ++nb; bp += 1024; } asm volatile("" : "+v"(bp));
        __builtin_amdgcn_sched_barrier(0); }
    CW_LOAD(a[(S + CW_NS - 1) % CW_NS], rp, 0); if (nr < 31) { ++nr; rp += 256; } asm volatile("" : "+v"(rp)); __builtin_amdgcn_sched_barrier(0);
    { const LAS v4u* bf = bl_lane + (S >> 1) * 2048 + (S & 1) * 1024;
#pragma unroll
      for (int q_ = 0; q_ < 4; ++q_) { const int j = q_ >> 1; const f32x4 x0 = a[S][2 * q_], x1 = a[S][2 * q_ + 1];
          v4u wv; wv.x = pk2(x0.x, x0.y); wv.y = pk2(x0.z, x0.w); wv.z = pk2(x1.x, x1.y); wv.w = pk2(x1.z, x1.w);
          const bf16x8 af = __builtin_bit_cast(bf16x8, wv);
#pragma unroll
          for (int et = 0; et < 4; ++et) acc[j][et] = __builtin_amdgcn_mfma_f32_16x16x32_bf16(af, __builtin_bit_cast(bf16x8, bf[(q_ * 4 + et) * 64]), acc[j][et], 0, 0, 0); } }
    if constexpr ((S & 1) == 1) {
        LDS_WAIT(); LAS v4u* d_ = bdst + (((S >> 1) + 1) & 1) * 2048;
#pragma unroll
        for (int i = 0; i < 4; ++i) d_[i] = vb[i];
        LDS_WAIT(); asm volatile("" ::: "memory"); __builtin_amdgcn_s_barrier(); asm volatile("" ::: "memory"); }
}
__device__ __forceinline__ void compress_wg(const Ptrs& P, Frame& F, LAS unsigned char* bl  ) {
    const int lane = F.lane, w = F.wave, tid = w * 64 + lane, rho = lane & 15, kq = lane >> 4;
    const int sf = tid >> 4, ssr = sf >> 4, sj = (sf >> 3) & 1, sdh = (sf >> 2) & 1, set_ = sf & 3, sl = (tid & 15) * 4;
    const GAS v4u* bs0 = (const GAS v4u*)(P.ws + WS_BTC) + (size_t)((((sj * 32 + ssr) * 2 + sdh) * 4 + set_) * 64 + sl);
    LAS v4u* bdst = (LAS v4u*)bl + sf * 64 + sl; const LAS v4u* bl_lane = (const LAS v4u*)bl + lane;
    const float* cbias = (const float*)(P.ws + WS_CBIAS);
    for (int pass = blockIdx.x; pass < CW_NPASS; pass += F.G) {
        const int b = pass >> 3, c0 = (pass & 7) * 64 + w * 8;
        const float* rb; { const int c = c0 + (rho >> 1), g = rho & 1; const int page = P.page_table[b * NPAGES + (c >> 2)]; rb = P.cache_cmp + ((size_t)page * 128 + (c & 3) * 32) * 256 + g * 64 + 4 * kq; }
        f32x4 a[CW_NS][8]; v4u vb[4]; f32x4 acc[2][4];
#pragma unroll
        for (int i = 0; i < 4; ++i) vb[i] = bs0[i];
#pragma unroll
        for (int r = 0; r < CW_NS - 1; ++r) CW_LOAD(a[r], rb, r);
        const float* rp = rb + (CW_NS - 1) * 256; const GAS v4u* bp = bs0 + 1024; int nr = CW_NS - 1, nb = 1; asm volatile("" : "+v"(rp), "+v"(bp));
#pragma unroll
        for (int j = 0; j < 2; ++j)
#pragma unroll
            for (int e = 0; e < 4; ++e) acc[j][e] = (f32x4){0.f, 0.f, 0.f, 0.f};
        asm volatile("" ::: "memory"); __builtin_amdgcn_s_barrier(); asm volatile("" ::: "memory");
#pragma unroll
        for (int i = 0; i < 4; ++i) bdst[i] = vb[i];
        LDS_WAIT(); asm volatile("" ::: "memory"); __builtin_amdgcn_s_barrier(); asm volatile("" ::: "memory");
#pragma unroll 1
        for (int it = 0; it < 8; ++it) { cw_step<0>(a, vb, acc, rp, nr, bp, nb, bdst, bl_lane); cw_step<1>(a, vb, acc, rp, nr, bp, nb, bdst, bl_lane);
            cw_step<2>(a, vb, acc, rp, nr, bp, nb, bdst, bl_lane); cw_step<3>(a, vb, acc, rp, nr, bp, nb, bdst, bl_lane); }
        float nmax = 0.f;
#pragma unroll
        for (int i = 0; i < 4; ++i) { const int row = 4 * kq + i, c = c0 + (row >> 1), g = row & 1; float q2 = 0.f;
#pragma unroll
            for (int j = 0; j < 2; ++j)
#pragma unroll
                for (int et = 0; et < 4; ++et) { const int e = 16 * et + rho; const float val = acc[j][et][i] + cbias[j * 64 + e]; if (j == 0) q2 += val * val;
                    ((float*)(P.ws + WS_KCS))[((size_t)((b * 2 + g) * 2 + j) * NCS + c) * 64 + e] = val; }
            q2 += __shfl_xor(q2, 1); q2 += __shfl_xor(q2, 2); q2 += __shfl_xor(q2, 4); q2 += __shfl_xor(q2, 8); nmax = fmaxf(nmax, q2); }
        nmax = fmaxf(nmax, __shfl_xor(nmax, 16)); nmax = fmaxf(nmax, __shfl_xor(nmax, 32));
        if (lane == 0) atomicMax((unsigned*)(P.ws + WS_CTL) + CW_KCMAX + 64, __builtin_bit_cast(unsigned, nmax));
    }
}
struct EpiIn {
    static constexpr bool PERM = false, AFTER_DRAIN = false;
    const float *rstd, *rope, *qg, *kg; float* out; unsigned char* ws;
    __device__ __forceinline__ void operator()(const f32x4 (&acc)[2][2][4][2], const pg8::Unit& u, int wr, int wc, int fr, int fq) const {
        asm volatile("" : "+v"(fr), "+v"(fq));
        const int pn = u.pn; const int rbase = u.pm * 256 + wr * 64 + fr;
        if (pn < 8) {
            const bool bz = pn < 4; bf16* dst = (bf16*)(ws + (bz ? WS_CG : WS_U)); const int col0 = 128 * (pn & 3) + 32 * wc + 4 * fq;
#pragma unroll
            for (int ai = 0; ai < 2; ++ai)
#pragma unroll
                for (int m = 0; m < 4; ++m) { const int row = rbase + ai * 128 + m * 16; const float rs = rstd[row];
#pragma unroll
                    for (int n = 0; n < 2; ++n) { const f32x4 a = acc[ai][0][m][n] * rs, z = acc[ai][1][m][n] * rs; f32x4 o;
                        if (bz) { o.x = a.x * z.x * sigmoidf(z.x); o.y = a.y * z.y * sigmoidf(z.y); o.z = a.z * z.z * sigmoidf(z.z); o.w = a.w * z.w * sigmoidf(z.w); }
                        else o = a * z;
                        v2u w; w.x = pk2(o.x, o.y); w.y = pk2(o.z, o.w);
                        *(GAS v2u*)(dst + (size_t)row * 512 + col0 + 16 * n) = w;
                        if (!bz) { const int t = row & (T - 1); if (t >= T - 2) *(GAS f32x4*)(out + O_PCONV + ((size_t)(row >> 13) * 2 + (t - (T - 2))) * 512 + col0 + 16 * n) = o; } } }
        } else if (pn < 13) {
            const bool isq = pn < 10; const int br = pn - 10; const bool isk = !isq && wc < 2;
            if (isq || isk) {
                const float* gain = isq ? qg : kg + br * 64; float g1[2][4], g2[2][4];
#pragma unroll
                for (int n = 0; n < 2; ++n)
#pragma unroll
                    for (int e = 0; e < 4; ++e) { g1[n][e] = gain[16 * n + 4 * fq + e]; g2[n][e] = gain[32 + 16 * n + 4 * fq + e]; }
#pragma unroll
                for (int ai = 0; ai < 2; ++ai)
#pragma unroll
                    for (int m = 0; m < 4; ++m) { const int row = rbase + ai * 128 + m * 16; const float rs = rstd[row]; const int t = row & (T - 1), b = row >> 13;
                        f32x4 x1[2], x2[2]; float ss = 0.f;
#pragma unroll
                        for (int n = 0; n < 2; ++n) { x1[n] = acc[ai][0][m][n] * rs; x2[n] = acc[ai][1][m][n] * rs;
                            ss += (x1[n].x * x1[n].x + x1[n].y * x1[n].y) + (x1[n].z * x1[n].z + x1[n].w * x1[n].w) + (x2[n].x * x2[n].x + x2[n].y * x2[n].y) + (x2[n].z * x2[n].z + x2[n].w * x2[n].w); }
                        ss += __shfl_xor(ss, 16); ss += __shfl_xor(ss, 32);
                        const float inv = 1.0f / sqrtf(ss * (1.0f / 64.0f) + NORM_EPS);
                        const float* rp = rope + (size_t)t * 64 + 4 * fq;
#pragma unroll
                        for (int n = 0; n < 2; ++n) { const f32x4 cs = *(const GAS f32x4*)(rp + 16 * n), sn = *(const GAS f32x4*)(rp + 32 + 16 * n); f32x4 o1, o2;
#pragma unroll
                            for (int e = 0; e < 4; ++e) { const float a = x1[n][e] * inv * g1[n][e], c = x2[n][e] * inv * g2[n][e]; o1[e] = a * cs[e] - c * sn[e]; o2[e] = c * cs[e] + a * sn[e]; }
                            const int d1 = 16 * n + 4 * fq;
                            if (isq) { o1 = o1 * QSCALE; o2 = o2 * QSCALE; bf16* q = (bf16*)(ws + WS_Q) + (size_t)row * 512 + (4 * (pn - 8) + wc) * 64 + d1;
                                v2u w; w.x = pk2(o1.x, o1.y); w.y = pk2(o1.z, o1.w); *(GAS v2u*)q = w; w.x = pk2(o2.x, o2.y); w.y = pk2(o2.z, o2.w); *(GAS v2u*)(q + 32) = w; }
                            else { const int g = wc;
                                if (br > 0) { bf16* img = (bf16*)(ws + (br == 1 ? WS_KS : WS_KW)) + ((size_t)(b * 2 + g) * 128 + (t >> 6)) * 8192;
                                    v2u w; w.x = pk2(o1.x, o1.y); w.y = pk2(o1.z, o1.w); *(GAS v2u*)(img + kimg_off(t & 63, d1)) = w; w.x = pk2(o2.x, o2.y); w.y = pk2(o2.z, o2.w); *(GAS v2u*)(img + kimg_off(t & 63, d1 + 32)) = w; }
                                if (br < 2) { float* o = out + (br == 0 ? O_PCMP : O_PSLC) + (size_t)row * 256 + g * 64 + d1; *(GAS f32x4*)o = o1; *(GAS f32x4*)(o + 32) = o2; }
                                else if (t >= T - 512) { float* o = out + O_PWIN + ((size_t)b * 512 + (t - (T - 512))) * 256 + g * 64 + d1; *(GAS f32x4*)o = o1; *(GAS f32x4*)(o + 32) = o2; } } } }
            } else {
                const int g = wc - 2;
#pragma unroll
                for (int ai = 0; ai < 2; ++ai)
#pragma unroll
                    for (int m = 0; m < 4; ++m) { const int row = rbase + ai * 128 + m * 16; const float rs = rstd[row]; const int t = row & (T - 1), b = row >> 13;
                        const int tk = t & 63, vpos = (tk & ~15) + perm16(tk & 15);
                        bf16* vt = (br > 0) ? (bf16*)(ws + (br == 1 ? WS_KS : WS_KW)) + ((size_t)(b * 2 + g) * 128 + (t >> 6)) * 8192 : nullptr;
                        const float vsc = (br == 1) ? slc_vscale(((const float*)(ws + WS_CONST))[1]) : 1.0f;
#pragma unroll
                        for (int bj = 0; bj < 2; ++bj)
#pragma unroll
                            for (int n = 0; n < 2; ++n) { const f32x4 v = acc[ai][bj][m][n] * rs; const int d1 = 32 * bj + 16 * n + 4 * fq;
                                if (br > 0) {
#pragma unroll
                                    for (int e = 0; e < 4; ++e) vt[vimg_off(d1 + e, vpos)] = (bf16)f2bf(v[e] * vsc); }
                                if (br < 2) *(GAS f32x4*)(out + (br == 0 ? O_PCMP : O_PSLC) + (size_t)row * 256 + 128 + g * 64 + d1) = v;
                                else if (t >= T - 512) *(GAS f32x4*)(out + O_PWIN + ((size_t)b * 512 + (t - (T - 512))) * 256 + 128 + g * 64 + d1) = v; } }
            }
        } else if (pn < 15) {
            bf16* dst = (bf16*)(ws + WS_ZA);
#pragma unroll
            for (int ai = 0; ai < 2; ++ai)
#pragma unroll
                for (int m = 0; m < 4; ++m) { const int row = rbase + ai * 128 + m * 16; const float rs = rstd[row];
#pragma unroll
                    for (int bj = 0; bj < 2; ++bj)
#pragma unroll
                        for (int n = 0; n < 2; ++n) { const f32x4 z = acc[ai][bj][m][n] * rs; v2u w; w.x = pk2(z.x * sigmoidf(z.x), z.y * sigmoidf(z.y)); w.y = pk2(z.z * sigmoidf(z.z), z.w * sigmoidf(z.w));
                            *(GAS v2u*)(dst + (size_t)row * 512 + 256 * (pn - 13) + 128 * bj + 32 * wc + 16 * n + 4 * fq) = w; } }
        } else {
            if (wc == 0) { float* dst = (float*)(ws + WS_GATE);
#pragma unroll
                for (int ai = 0; ai < 2; ++ai)
#pragma unroll
                    for (int m = 0; m < 4; ++m) { const int row = rbase + ai * 128 + m * 16; const float rs = rstd[row];
#pragma unroll
                        for (int n = 0; n < 2; ++n) { const int c0 = 16 * n + 4 * fq; if (c0 < 24) { const f32x4 z = acc[ai][0][m][n] * rs;
                            *(GAS f32x4*)(dst + (size_t)row * 24 + c0) = (f32x4){sigmoidf(z.x), sigmoidf(z.y), sigmoidf(z.z), sigmoidf(z.w)}; } } } }
        }
    }
};
struct EpiOut {
    static constexpr bool PERM = false, AFTER_DRAIN = false;
    const bf16* x; float* y;
    __device__ __forceinline__ void operator()(const f32x4 (&acc)[2][2][4][2], const pg8::Unit& u, int wr, int wc, int fr, int fq) const {
        asm volatile("" : "+v"(fr), "+v"(fq));
#pragma unroll
        for (int ai = 0; ai < 2; ++ai)
#pragma unroll
            for (int m = 0; m < 4; ++m) { const size_t row = (size_t)u.pm * 256 + ai * 128 + wr * 64 + m * 16 + fr;
#pragma unroll
                for (int bj = 0; bj < 2; ++bj)
#pragma unroll
                    for (int n = 0; n < 2; ++n) { const size_t off = row * D + u.pn * 256 + 128 * bj + 32 * wc + 16 * n + 4 * fq;
                        const v2u xv = *(const GAS v2u*)(x + off);
                        *(GAS f32x4*)(y + off) = (f32x4){bf2f(xv.x & 0xffffu), bf2f(xv.x >> 16), bf2f(xv.y & 0xffffu), bf2f(xv.y >> 16)} + acc[ai][bj][m][n]; } }
    }
};
template <int MODE>
__device__ __forceinline__ void small_gemm_tile(const Ptrs& P, const bf16* A, const bf16* Bt, int ct, int lane) {
    const int rho = lane & 15, kq = lane >> 4;
    f32x4 acc[2] = {(f32x4){0.f, 0.f, 0.f, 0.f}, (f32x4){0.f, 0.f, 0.f, 0.f}};
    const GAS v4u* a0 = (const GAS v4u*)(A + (size_t)rho * D + 8 * kq); const GAS v4u* a1 = (const GAS v4u*)(A + (size_t)(16 + rho) * D + 8 * kq);
    const GAS v4u* bp = (const GAS v4u*)(Bt + (size_t)(16 * ct + rho) * D + 8 * kq);
#pragma unroll 8
    for (int ks = 0; ks < 32; ++ks) { const bf16x8 bb = __builtin_bit_cast(bf16x8, bp[ks * 4]);
        acc[0] = __builtin_amdgcn_mfma_f32_16x16x32_bf16(bb, __builtin_bit_cast(bf16x8, a0[ks * 4]), acc[0], 0, 0, 0);
        acc[1] = __builtin_amdgcn_mfma_f32_16x16x32_bf16(bb, __builtin_bit_cast(bf16x8, a1[ks * 4]), acc[1], 0, 0, 0); }
#pragma unroll
    for (int rt = 0; rt < 2; ++rt) { const int b = 16 * rt + rho; const int col = 16 * ct + 4 * kq;
        if (MODE == 0) { const float rs = ((const float*)(P.ws + WS_RSTDS))[b]; *(GAS f32x4*)((float*)(P.ws + WS_PROJS) + (size_t)b * NP + col) = acc[rt] * rs; }
        else *(GAS f32x4*)(P.out + O_YS + (size_t)b * D + col) = *(const GAS f32x4*)(P.xs + (size_t)b * D + col) + acc[rt]; }
}
__device__ __forceinline__ int projs_col(int pn, int wc, int d) { return 256 * pn + 128 * (d >> 5) + 32 * wc + (d & 31); }
__device__ __forceinline__ void p2_sample_item(const Ptrs& P, int it, int lane) {
    const int b = it / 37, ty = it - b * 37;
    const float* pr = (const float*)(P.ws + WS_PROJS) + (size_t)b * NP;
    const float* ropes = (const float*)(P.ws + WS_ROPE) + (size_t)8192 * 64;
    float* kvn = (float*)(P.ws + WS_KVN) + (size_t)b * 768;
    if (ty < 14) {
        const bool isq = ty < 8; const int br = isq ? 0 : (ty - 8) >> 1, g = (ty - 8) & 1;
        const int pn = isq ? 8 + (ty >> 2) : 10 + br, wc = isq ? (ty & 3) : g;
        const float v = pr[projs_col(pn, wc, lane)];
        const float ss = wave_sum(v * v); const float inv = 1.0f / sqrtf(ss * (1.0f / 64.0f) + NORM_EPS);
        const float gn = isq ? P.q_gain[lane] : P.k_gain[br * 64 + lane];
        const float xn = v * inv * gn; const float xo = __shfl_xor(xn, 32);
        const int i = lane & 31; const float cs = ropes[i], sn = ropes[32 + i];
        const float o = (lane < 32) ? xn * cs - xo * sn : xn * cs + xo * sn;
        if (isq) ((float*)(P.ws + WS_QS))[(size_t)b * 512 + ty * 64 + lane] = o * QSCALE;
        else { kvn[(br * 2 + 0) * 128 + g * 64 + lane] = o;
            if (br == 0) P.out[O_SCMP + (size_t)b * 256 + g * 64 + lane] = o; else if (br == 1) P.out[O_SSLC + (size_t)b * 256 + g * 64 + lane] = o;
            else P.out[O_SWIN + ((size_t)b * 512 + 511) * 256 + g * 64 + lane] = o; }
    } else if (ty < 20) {
        const int br = (ty - 14) >> 1, g = (ty - 14) & 1; const float v = pr[projs_col(10 + br, 2 + g, lane)];
        kvn[(br * 2 + 1) * 128 + g * 64 + lane] = v;
        if (br == 0) P.out[O_SCMP + (size_t)b * 256 + 128 + g * 64 + lane] = v; else if (br == 1) P.out[O_SSLC + (size_t)b * 256 + 128 + g * 64 + lane] = v;
        else P.out[O_SWIN + ((size_t)b * 512 + 511) * 256 + 128 + g * 64 + lane] = v;
    } else if (ty == 20) {
        if (lane < 24) ((float*)(P.ws + WS_GS))[b * 24 + lane] = sigmoidf(pr[256 * 15 + lane]);
    } else if (ty < 29) {
        const int ch = (ty - 21) * 64 + lane; const int pnb = ch >> 7, tc = ch & 127;
        const float bg = pr[256 * pnb + tc], zc = pr[256 * pnb + 128 + tc], cg = pr[256 * (4 + pnb) + tc], ci = pr[256 * (4 + pnb) + 128 + tc];
        const float u = cg * ci; const float s0 = P.st_conv[(size_t)b * 1024 + ch], s1 = P.st_conv[(size_t)b * 1024 + 512 + ch];
        const float cy = P.conv_w[ch] * s0 + P.conv_w[512 + ch] * s1 + P.conv_w[1024 + ch] * u + P.conv_b[ch];
        ((bf16*)(P.ws + WS_MIXS))[(size_t)b * 1024 + ch] = (bf16)f2bf(bg * cy * zc * sigmoidf(zc));
        P.out[O_SCONV + (size_t)b * 1024 + 512 + ch] = u;
    } else {
        const int col = (ty - 29) * 64 + lane; const float z = pr[256 * (13 + (col >> 8)) + (col & 255)];
        ((float*)(P.ws + WS_ZAS))[(size_t)b * 512 + col] = z * sigmoidf(z);
    }
}
__device__ __forceinline__ void p2_phase(const Ptrs& P, Frame& F) {
    compress_prompt_units(P, F, (LAS float*)(F.lds + RING_OFF), [&]() { for (int it = F.gw; it < DECB * 37; it += F.NGW) p2_sample_item(P, it, F.lane); });
    if ((int)blockIdx.x >= BATCH * 64) for (int it = F.gw; it < DECB * 37; it += F.NGW) p2_sample_item(P, it, F.lane);
}
#define MFMA32(a, b, c) __builtin_amdgcn_mfma_f32_32x32x16_bf16(a, b, c, 0, 0, 0)
constexpr int P3_IMP = 0, P3_QL = 32768;
constexpr int P3_NEXT = LDSCTL_OFF + 512, P3_CNT = LDSCTL_OFF + 1024, P3_LISTS = LDSCTL_OFF + 2048, P3_LACC = LDSCTL_OFF + 10240;
constexpr int P3_RING = 65536;
constexpr int P3_MISC = MISC_OFF + 64;
constexpr int SM_Q = 36864, SM_P = 40960, SM_RED = 57344, SM_IMP = 66048, SM_L = 67200, SM_SEL = 67328, SM_O = 67584, SM_VP = 71680  , SM_RED2 = 79872  ;

template <bool MASK>
__device__ __forceinline__ void attend_lds(const LAS unsigned char* blk, const bf16x8 (&qf)[4], f32x16 (&O)[2], float& lsum,
                                           int kbase, int lo, int hi, int lane, bool want_pv, f32x16 (*Sout)[2] = nullptr) {
    const int hh = lane >> 5;
    const LAS unsigned char* kb = blk + lane * 16; const LAS unsigned char* vb = blk + 8192 + lane * 16;
#pragma unroll
    for (int kt = 0; kt < 2; ++kt) {
        f32x16 S;
        { bf16x8 kf[4];
#pragma unroll
          for (int s = 0; s < 4; ++s) kf[s] = *(const LAS bf16x8*)(kb + (kt * 4 + s) * 1024);
#pragma unroll
          for (int i = 0; i < 16; ++i) S[i] = 0.f;
#pragma unroll
          for (int s = 0; s < 4; ++s) S = MFMA32(kf[s], qf[s], S); }
#pragma unroll
        for (int i = 0; i < 16; ++i) { float p = fast_exp2(S[i]);
            if (MASK) { const int kp = kbase + 32 * kt + (i & 3) + 8 * (i >> 2) + 4 * hh; p = (kp >= lo && kp <= hi) ? p : 0.f; }
            S[i] = p; lsum += p; }
        if (Sout) (*Sout)[kt] = S;
        if (want_pv) {
            bf16x8 pf[2];
#pragma unroll
            for (int sp = 0; sp < 2; ++sp) { v4u w; w.x = pk2(S[8 * sp + 0], S[8 * sp + 1]); w.y = pk2(S[8 * sp + 2], S[8 * sp + 3]);
                w.z = pk2(S[8 * sp + 4], S[8 * sp + 5]); w.w = pk2(S[8 * sp + 6], S[8 * sp + 7]); pf[sp] = __builtin_bit_cast(bf16x8, w); }
#pragma unroll
            for (int dt = 0; dt < 2; ++dt)
#pragma unroll
                for (int sp = 0; sp < 2; ++sp) { const bf16x8 vf = *(const LAS bf16x8*)(vb + (dt * 4 + 2 * kt + sp) * 1024);
                    O[dt] = MFMA32(vf, pf[sp], O[dt]); }
        }
    }
}
__device__ __forceinline__ void wave_topk(const LAS float* imp, int jmax, int nsel, int lane, int qbase, LAS unsigned* cnt, LAS unsigned char* lists) {
    if (jmax < 1) return;
    const bool c0 = lane >= 1 && lane <= jmax, c1 = 64 + lane <= jmax;
    unsigned k0[8], k1[8], Tv[8];
#pragma unroll
    for (int qi = 0; qi < 8; ++qi) { k0[qi] = c0 ? ((__builtin_bit_cast(unsigned, imp[qi * 128 + lane]) + 0x800u) & ~0x7ffu) : 0u; k1[qi] = c1 ? ((__builtin_bit_cast(unsigned, imp[qi * 128 + 64 + lane]) + 0x800u) & ~0x7ffu) : 0u; Tv[qi] = 0u; }
    if (jmax > nsel) {
        for (int bit = 30; bit >= 11; --bit) {
#pragma unroll
            for (int qi = 0; qi < 8; ++qi) { const unsigned cand = Tv[qi] | (1u << bit);
                const int cn = __popcll(__ballot(k0[qi] >= cand)) + __popcll(__ballot(k1[qi] >= cand)); Tv[qi] = cn >= nsel ? cand : Tv[qi]; } }
    }
    const unsigned long long below = (lane == 0) ? 0ull : (~0ull >> (64 - lane));
    bool s0[8], s1[8]; unsigned p0[8], p1[8];
#pragma unroll
    for (int qi = 0; qi < 8; ++qi) {
        if (jmax > nsel) {
            const unsigned long long g0 = __ballot(k0[qi] > Tv[qi]), g1 = __ballot(k1[qi] > Tv[qi]), e0 = __ballot(k0[qi] == Tv[qi]), e1 = __ballot(k1[qi] == Tv[qi]);
            const int need = nsel - __popcll(g0) - __popcll(g1);
            const int rk0 = __popcll(e0 & below), rk1 = __popcll(e0) + __popcll(e1 & below);
            s0[qi] = k0[qi] > Tv[qi] || (k0[qi] == Tv[qi] && rk0 < need); s1[qi] = k1[qi] > Tv[qi] || (k1[qi] == Tv[qi] && rk1 < need);
        } else { s0[qi] = c0; s1[qi] = c1; }
    }
#pragma unroll
    for (int qi = 0; qi < 8; ++qi) { p0[qi] = 0u; p1[qi] = 0u;
        if (s0[qi]) p0[qi] = __hip_atomic_fetch_add(cnt + lane, 1u, __ATOMIC_RELAXED, __HIP_MEMORY_SCOPE_WORKGROUP);
        if (s1[qi]) p1[qi] = __hip_atomic_fetch_add(cnt + 64 + lane, 1u, __ATOMIC_RELAXED, __HIP_MEMORY_SCOPE_WORKGROUP); }
#pragma unroll
    for (int qi = 0; qi < 8; ++qi) {
        if (s0[qi]) lists[lane * 64 + p0[qi]] = (unsigned char)(qbase + qi);
        if (s1[qi]) lists[(64 + lane) * 64 + p1[qi]] = (unsigned char)(qbase + qi); }
}
struct BlkSrc { const bf16* img; };
#ifndef PROBE_SEG
#define PROBE_SEG 0
#endif
#define T_BEGIN(id) do { if (PROBE_SEG == (id)) tacc -= __builtin_readcyclecounter(); } while (0)
#define T_END(id) do { if (PROBE_SEG == (id)) tacc += __builtin_readcyclecounter(); } while (0)
__device__ __forceinline__ void p3_prompt_unit(const Ptrs& P, Frame& F, int b, int t, int g, float sh_cmp, float sh_slc, float sh_win, unsigned long long& tacc) {
    int lane = F.lane, w = F.wave, tid = F.tid; asm volatile("" : "+v"(lane), "+s"(w), "+v"(tid));
    const int col = lane & 31, hh = lane >> 5, qi = col >> 2, h = col & 3;
    const int tok = 64 * t + 8 * w + qi; const size_t row = (size_t)b * T + tok; const int qpos = tok;
    const int nck = (2 * t + 2 + 63) >> 6, nf = t >= 2 ? 3 : t + 1, nw = t >= 8 ? 9 : t + 1;
    const int n1 = nck, n2 = 2 * nck, n3 = n2 + nw, N1 = n3 + nf, wbase = t >= 8 ? t - 8 : 0;
    const bf16* KC = (const bf16*)(P.ws + WS_KC) + (size_t)(b * 2 + g) * 4 * 8192;
    const bf16* KS = (const bf16*)(P.ws + WS_KS) + (size_t)(b * 2 + g) * 128 * 8192;
    const bf16* KW = (const bf16*)(P.ws + WS_KW) + (size_t)(b * 2 + g) * 128 * 8192;
    auto src1 = [&](int n) -> BlkSrc {
        if (n < n2) { const int ck = n < n1 ? n : n - n1; return BlkSrc{KC + (size_t)ck * 8192}; }
        if (n < n3) return BlkSrc{KW + (size_t)(wbase + n - n2) * 8192};
        const int f = n - n3; const int j = f == 0 ? t : (f == 1 ? 0 : t - 1); return BlkSrc{KS + (size_t)j * 8192}; };
    LAS unsigned char* ring = F.lds + P3_RING;
#define ST_DMA(bs_, n) do { LAS unsigned char* d_ = ring + ((n) & 3) * 16384 + w * 2048; \
        __builtin_amdgcn_global_load_lds((const unsigned*)((bs_).img + (2 * w) * 512 + lane * 8), (LAS unsigned*)d_, 16, 0, 0); \
        __builtin_amdgcn_global_load_lds((const unsigned*)((bs_).img + (2 * w + 1) * 512 + lane * 8), (LAS unsigned*)(d_ + 1024), 16, 0, 0); } while (0)
#define BLK(n) (ring + ((n) & 3) * 16384)
#define STEP_BEGIN(SRC, n, NN) do { if (((n) & 1) == 0) { if ((n) + 2 < (NN)) { const BlkSrc b_ = SRC((n) + 2); ST_DMA(b_, (n) + 2); } if ((n) + 3 < (NN)) { const BlkSrc b_ = SRC((n) + 3); ST_DMA(b_, (n) + 3); } } } while (0)
#define STEP_END(n, NN) do { if (((n) & 1) == 1 || (n) == (NN) - 1) { asm volatile("s_waitcnt vmcnt(0)" ::: "memory"); __syncthreads(); } } while (0)
    LAS unsigned* cnt = (LAS unsigned*)(F.lds + P3_CNT); LAS unsigned char* lists = F.lds + P3_LISTS; LAS unsigned* nextb = (LAS unsigned*)(F.lds + P3_NEXT);
    LAS int* oacc = (LAS int*)ring; LAS int* lacc = (LAS int*)(F.lds + P3_LACC);
    const float FXS = slc_vscale(sh_slc), FXI = 1.0f / FXS;
    LAS unsigned char* ql = F.lds + P3_QL;
    T_BEGIN(1); T_BEGIN(8);
    __syncthreads();
    if (tid < 128) cnt[tid] = 0u; if (tid == 128) nextb[0] = 0u;
    { const BlkSrc b0 = src1(0); ST_DMA(b0, 0); if (N1 > 1) { const BlkSrc b1 = src1(1); ST_DMA(b1, 1); } }
    { const bf16* qg = (const bf16*)(P.ws + WS_Q) + ((size_t)b * T + 64 * t) * 512 + g * 256;
      v4u tq[4];
#pragma unroll
      for (int k = 0; k < 4; ++k) { const int c = tid + 512 * k, rq = c >> 3, ch = c & 7; tq[k] = *(const GAS v4u*)(qg + (size_t)(rq >> 2) * 512 + (rq & 3) * 64 + ch * 8); }
#pragma unroll
      for (int k = 0; k < 4; ++k) { const int c = tid + 512 * k, rq = c >> 3, ch = c & 7; *(LAS v4u*)(ql + rq * 128 + ((ch ^ ((rq >> 1) & 7)) << 4)) = tq[k]; } }
    bf16x8 qf[4];
    { const bf16* q = (const bf16*)(P.ws + WS_Q) + row * 512 + (g * 4 + h) * 64 + 8 * hh;
#pragma unroll
      for (int s = 0; s < 4; ++s) qf[s] = __builtin_bit_cast(bf16x8, *(const GAS v4u*)(q + 16 * s)); }
    const float* gate = (const float*)(P.ws + WS_GATE) + row * 24 + (g * 4 + h) * 3;
    const float g_cmp = gate[0], g_slc = gate[1], g_win = gate[2];
    asm volatile("s_waitcnt vmcnt(0)" ::: "memory"); __syncthreads();
    T_END(1); T_BEGIN(2);
    f32x16 O[2];
    LAS float* wl = (LAS float*)(F.lds + P3_IMP + w * 4096);
    LAS float* xw0 = (LAS float*)(F.lds + P3_IMP + w * 4096) + lane;
    f32x16 totr;
    const int nvis = (qpos + 1) >> 5;
    int n = 0;
    float lsum = 0.f;
    for (; n < n1; ++n) { STEP_BEGIN(src1, n, N1); attend_lds<true>(BLK(n), qf, O, lsum, 64 * n, 0, nvis - 1, lane, false); STEP_END(n, N1); }
    lsum += __shfl_xor(lsum, 32);
    const float rl = lsum > 0.f ? 1.0f / lsum : 0.f;
    for (int i = lane; i < 1024; i += 64) wl[i] = 0.f;
#pragma unroll
    for (int i = 0; i < 16; ++i) { O[0][i] = 0.f; O[1][i] = 0.f; }
    { float dummy = 0.f;
      for (; n < n2; ++n) { STEP_BEGIN(src1, n, N1); const int ck = n - n1; f32x16 Sn[2];
        attend_lds<true>(BLK(n), qf, O, dummy, 64 * ck, 0, nvis - 1, lane, true, &Sn);
#pragma unroll
        for (int kt = 0; kt < 2; ++kt)
#pragma unroll
            for (int i2 = 0; i2 < 8; ++i2) { const float v = quad_sum((Sn[kt][2 * i2] + Sn[kt][2 * i2 + 1]) * rl);
                if (h == 0) wl[qi * 128 + 32 * ck + 16 * kt + (i2 & 1) + 4 * (i2 >> 1) + 2 * hh] = v; }
        STEP_END(n, N1); } }
    LDS_WAIT(); asm volatile("" ::: "memory");
    T_END(2); T_BEGIN(3);
    wave_topk(wl, t - 2, 13, lane, 8 * w, cnt, lists);
    LDS_WAIT(); asm volatile("" ::: "memory");
#pragma unroll
    for (int i = 0; i < 16; ++i) { xw0[i * 64] = O[0][i] * (g_cmp * rl); totr[i] = O[1][i] * (g_cmp * rl); O[0][i] = 0.f; O[1][i] = 0.f; }
    T_END(3); T_BEGIN(6);
    lsum = 0.f;
    for (; n < n3; ++n) { STEP_BEGIN(src1, n, N1); const int j = wbase + n - n2;
        if (j == t || j + 8 == t) attend_lds<true>(BLK(n), qf, O, lsum, 64 * j, qpos - 511, qpos, lane, true);
        else attend_lds<false>(BLK(n), qf, O, lsum, 0, 0, 0, lane, true);
        STEP_END(n, N1); }
    lsum += __shfl_xor(lsum, 32);
    { const float sc = g_win / fmaxf(lsum, 1e-30f);
#pragma unroll
      for (int i = 0; i < 16; ++i) { xw0[i * 64] = xw0[i * 64] + O[0][i] * sc; totr[i] += O[1][i] * sc; O[0][i] = 0.f; O[1][i] = 0.f; } }
    T_END(6); T_BEGIN(4);
    lsum = 0.f;
    for (; n < N1; ++n) { STEP_BEGIN(src1, n, N1);
        if (n == n3) attend_lds<true>(BLK(n), qf, O, lsum, 64 * t, 0, qpos, lane, true);
        else attend_lds<false>(BLK(n), qf, O, lsum, 0, 0, 0, lane, true);
        STEP_END(n, N1); }
    lsum += __shfl_xor(lsum, 32);
#pragma unroll
    for (int dt = 0; dt < 2; ++dt)
#pragma unroll
        for (int i = 0; i < 16; ++i) oacc[(32 * dt + (i & 3) + 8 * (i >> 2) + 4 * hh) * 256 + 32 * w + col] = (int)O[dt][i];
    if (hh == 0) lacc[32 * w + col] = __float2int_rn(lsum * FXS);
    __syncthreads();
    T_END(4); T_BEGIN(5);
    if (t > 2) {
        const int r = lane & 31;
#define NEXT_BLOCK(jv_, nq_) do { for (;;) { unsigned t_ = 0u; if (lane == 0) t_ = __hip_atomic_fetch_add(nextb, 1u, __ATOMIC_RELAXED, __HIP_MEMORY_SCOPE_WORKGROUP); \
            jv_ = 1 + (int)__builtin_amdgcn_readfirstlane(t_); if (jv_ > t - 2) { nq_ = 0; break; } nq_ = (int)__builtin_amdgcn_readfirstlane(cnt[jv_]); if (nq_ > 0) break; } } while (0)
#define LOAD_K(kd_, jv_) do { const bf16* im_ = KS + (size_t)(jv_) * 8192 + lane * 8;     \
            _Pragma("unroll") for (int a_ = 0; a_ < 2; ++a_) _Pragma("unroll") for (int b_ = 0; b_ < 4; ++b_) kd_[a_][b_] = __builtin_bit_cast(bf16x8, *(const GAS v4u*)(im_ + (a_ * 4 + b_) * 512)); } while (0)
#define LOAD_V(vd_, jv_) do { const bf16* im_ = KS + (size_t)(jv_) * 8192 + 4096 + lane * 8; \
            _Pragma("unroll") for (int a_ = 0; a_ < 2; ++a_) _Pragma("unroll") for (int b_ = 0; b_ < 4; ++b_) vd_[a_][b_] = __builtin_bit_cast(bf16x8, *(const GAS v4u*)(im_ + (a_ * 4 + b_) * 512)); } while (0)
        bf16x8 kf[2][4], vf[2][4], kn[2][4];
        int j, nq; T_BEGIN(10); NEXT_BLOCK(j, nq); if (j <= t - 2) LOAD_K(kf, j); T_END(10);
        while (j <= t - 2) {
            T_BEGIN(10); LOAD_V(vf, j);
            int jn, nqn; NEXT_BLOCK(jn, nqn); LOAD_K(kn, (jn <= t - 2 ? jn : t - 2));
#pragma unroll
            for (int a_ = 0; a_ < 2; ++a_)
#pragma unroll
                for (int b_ = 0; b_ < 4; ++b_) asm volatile("" : "+v"(kf[a_][b_])); T_END(10);
            for (int c0 = 0; c0 < nq; c0 += 8) { T_BEGIN(11);
                const int sl = c0 + qi; const bool valid = sl < nq;
                const int rowq = (int)lists[j * 64 + (valid ? sl : nq - 1)] * 4 + h;
                const LAS unsigned char* qp = ql + rowq * 128; const int qsw = (rowq >> 1) & 7;
                bf16x8 q2[4];
#pragma unroll
                for (int s = 0; s < 4; ++s) q2[s] = *(const LAS bf16x8*)(qp + (((2 * s + hh) ^ qsw) << 4));
                float l2 = 0.f; bf16x8 pf[4]; f32x16 S0, S1;
#pragma unroll
                for (int i = 0; i < 16; ++i) { S0[i] = 0.f; S1[i] = 0.f; }
#pragma unroll
                for (int s = 0; s < 4; ++s) { S0 = MFMA32(kf[0][s], q2[s], S0); S1 = MFMA32(kf[1][s], q2[s], S1); }
#pragma unroll
                for (int i = 0; i < 16; ++i) { S0[i] = fast_exp2(S0[i]); l2 += S0[i]; }
#pragma unroll
                for (int sp = 0; sp < 2; ++sp) { v4u wv; wv.x = pk2(S0[8 * sp + 0], S0[8 * sp + 1]); wv.y = pk2(S0[8 * sp + 2], S0[8 * sp + 3]);
                    wv.z = pk2(S0[8 * sp + 4], S0[8 * sp + 5]); wv.w = pk2(S0[8 * sp + 6], S0[8 * sp + 7]); pf[sp] = __builtin_bit_cast(bf16x8, wv); }
#pragma unroll
                for (int i = 0; i < 16; ++i) { S1[i] = fast_exp2(S1[i]); l2 += S1[i]; }
#pragma unroll
                for (int sp = 0; sp < 2; ++sp) { v4u wv; wv.x = pk2(S1[8 * sp + 0], S1[8 * sp + 1]); wv.y = pk2(S1[8 * sp + 2], S1[8 * sp + 3]);
                    wv.z = pk2(S1[8 * sp + 4], S1[8 * sp + 5]); wv.w = pk2(S1[8 * sp + 6], S1[8 * sp + 7]); pf[2 + sp] = __builtin_bit_cast(bf16x8, wv); }
                T_END(11); T_BEGIN(9);
                __builtin_amdgcn_sched_barrier(0);
#pragma unroll
                for (int a_ = 0; a_ < 2; ++a_)
#pragma unroll
                    for (int b_ = 0; b_ < 4; ++b_) asm volatile("" : "+v"(vf[a_][b_]));
#pragma unroll
                for (int dt = 0; dt < 2; ++dt) { f32x16 O2;
#pragma unroll
                    for (int i = 0; i < 16; ++i) O2[i] = 0.f;
#pragma unroll
                    for (int ks = 0; ks < 4; ++ks) O2 = MFMA32(vf[dt][ks], pf[ks], O2);
                    if (valid) {
#pragma unroll
                        for (int i = 0; i < 16; ++i) (void)__hip_atomic_fetch_add(oacc + (32 * dt + (i & 3) + 8 * (i >> 2) + 4 * hh) * 256 + rowq, (int)O2[i], __ATOMIC_RELAXED, __HIP_MEMORY_SCOPE_WORKGROUP); } }
                if (valid) {
                    (void)__hip_atomic_fetch_add(lacc + rowq, __float2int_rn(l2 * FXS), __ATOMIC_RELAXED, __HIP_MEMORY_SCOPE_WORKGROUP); }
                if (PROBE_SEG == 9) LDS_WAIT(); T_END(9);
            }
#pragma unroll
            for (int a_ = 0; a_ < 2; ++a_)
#pragma unroll
                for (int b_ = 0; b_ < 4; ++b_) kf[a_][b_] = kn[a_][b_];
            j = jn; nq = nqn;
        }
#undef NEXT_BLOCK
#undef LOAD_K
#undef LOAD_V
    }
    __syncthreads();
    T_END(5);
    { const float sc = g_slc / fmaxf((float)lacc[32 * w + col] * FXI, 1e-30f);
#pragma unroll
      for (int i = 0; i < 16; ++i) { const int dr = (i & 3) + 8 * (i >> 2) + 4 * hh;
          O[0][i] = xw0[i * 64] + (float)oacc[dr * 256 + 32 * w + col] * (FXI * sc); O[1][i] = totr[i] + (float)oacc[(32 + dr) * 256 + 32 * w + col] * (FXI * sc); } }
#undef ST_DMA
#undef BLK
#undef STEP_BEGIN
#undef STEP_END
    T_BEGIN(7);
    asm volatile("" : "+v"(lane));
    const int col_ = lane & 31, hh_ = lane >> 5, h_ = col_ & 3; const size_t row_ = (size_t)b * T + 64 * t + 8 * w + (col_ >> 2);
    const bf16* za = (const bf16*)(P.ws + WS_ZA) + row_ * 512 + (g * 4 + h_) * 64; bf16* mx = (bf16*)(P.ws + WS_MIX) + row_ * 1024 + 512 + (g * 4 + h_) * 64;
#pragma unroll
    for (int dt = 0; dt < 2; ++dt)
#pragma unroll
        for (int i4 = 0; i4 < 4; ++i4) { const int d = 32 * dt + 8 * i4 + 4 * hh_; const v2u z = *(const GAS v2u*)(za + d);
            v2u o; o.x = pk2(O[dt][4 * i4] * bf2f(z.x & 0xffffu), O[dt][4 * i4 + 1] * bf2f(z.x >> 16)); o.y = pk2(O[dt][4 * i4 + 2] * bf2f(z.y & 0xffffu), O[dt][4 * i4 + 3] * bf2f(z.y >> 16));
            *(GAS v2u*)(mx + d) = o; }
    if (g == 0) { const int tq = w, c8 = lane * 8; const size_t r0 = (size_t)b * T + 64 * t + 8 * tq;
        const bf16* U = (const bf16*)(P.ws + WS_U) + c8; const bf16* CGp = (const bf16*)(P.ws + WS_CG) + c8; bf16* mo = (bf16*)(P.ws + WS_MIX) + c8;
        v4u ur[10], cr[8];
        const bool has_prev = (t > 0) || (tq > 0);
#pragma unroll
        for (int i = 0; i < 10; ++i) ur[i] = (i >= 2 || has_prev) ? *(const GAS v4u*)(U + (r0 + i - 2) * 512) : (v4u){0u, 0u, 0u, 0u};
#pragma unroll
        for (int i = 0; i < 8; ++i) cr[i] = *(const GAS v4u*)(CGp + (r0 + i) * 512);
        float w0[8], w1[8], w2[8], cb[8];
#pragma unroll
        for (int e = 0; e < 8; ++e) { w0[e] = P.conv_w[c8 + e]; w1[e] = P.conv_w[512 + c8 + e]; w2[e] = P.conv_w[1024 + c8 + e]; cb[e] = P.conv_b[c8 + e]; }
#pragma unroll
        for (int i = 0; i < 8; ++i) { float o[8];
#pragma unroll
            for (int e = 0; e < 8; ++e) { const int sh_ = (e & 1) * 16; const float a = bf2f((ur[i][e >> 1] >> sh_) & 0xffffu), bb = bf2f((ur[i + 1][e >> 1] >> sh_) & 0xffffu), c = bf2f((ur[i + 2][e >> 1] >> sh_) & 0xffffu);
                o[e] = bf2f((cr[i][e >> 1] >> sh_) & 0xffffu) * (w0[e] * a + w1[e] * bb + w2[e] * c + cb[e]); }
            v4u ov; ov.x = pk2(o[0], o[1]); ov.y = pk2(o[2], o[3]); ov.z = pk2(o[4], o[5]); ov.w = pk2(o[6], o[7]);
            *(GAS v4u*)(mo + (r0 + i) * 1024) = ov; } }
    T_END(7); T_END(8);
}
template <class KeyFn>
__device__ __forceinline__ void sample_branch(Frame& F, int nslots, float shift, const KeyFn& key, LAS float* obr) {
    LAS float* q = (LAS float*)(F.lds + SM_Q); LAS float* Pb = (LAS float*)(F.lds + SM_P); LAS float* red = (LAS float*)(F.lds + SM_RED); LAS float* lsm = (LAS float*)(F.lds + SM_L);
    LAS unsigned long long* vptr = (LAS unsigned long long*)(F.lds + SM_VP);
    float lacc[4] = {0.f, 0.f, 0.f, 0.f};
    for (int s = F.tid; s < nslots; s += 512) { const float* kp; const float* vp; const bool valid = key(s, kp, vp);
        float sc[4] = {0.f, 0.f, 0.f, 0.f};
        if (valid) {
#pragma unroll 8
            for (int d4 = 0; d4 < 16; ++d4) { const f32x4 kv = *(const GAS f32x4*)(kp + 4 * d4);
#pragma unroll
                for (int hq = 0; hq < 4; ++hq) { const f32x4 qv = *(const LAS f32x4*)(q + hq * 64 + 4 * d4); sc[hq] += (kv.x * qv.x + kv.y * qv.y) + (kv.z * qv.z + kv.w * qv.w); } } }
        f32x4 p;
#pragma unroll
        for (int hq = 0; hq < 4; ++hq) { p[hq] = valid ? fast_exp2(sc[hq] - shift) : 0.f; lacc[hq] += p[hq]; }
        *(LAS f32x4*)(Pb + 4 * s) = p; vptr[s] = (unsigned long long)(uintptr_t)vp; }
#pragma unroll
    for (int hq = 0; hq < 4; ++hq) { lacc[hq] = wave_sum(lacc[hq]); if (F.lane == 0) red[F.wave * 4 + hq] = lacc[hq]; }
    __syncthreads();
    if (F.tid < 4) { float s = 0.f; for (int ww = 0; ww < 8; ++ww) s += red[ww * 4 + F.tid]; lsm[F.tid] = s; }
    const int sg = F.tid >> 4, d4 = F.tid & 15;
    f32x4 oa[4];
#pragma unroll
    for (int hq = 0; hq < 4; ++hq) oa[hq] = (f32x4){0.f, 0.f, 0.f, 0.f};
    for (int s0 = sg; s0 < nslots; s0 += 256) {
        f32x4 vv[8], pp[8];
#pragma unroll
        for (int u = 0; u < 8; ++u) { const int s = s0 + 32 * u; const float* vp = (const float*)(uintptr_t)vptr[s]; vv[u] = *(const GAS f32x4*)(vp + 4 * d4); pp[u] = *(const LAS f32x4*)(Pb + 4 * s); }
#pragma unroll
        for (int u = 0; u < 8; ++u) { oa[0] = oa[0] + vv[u] * pp[u].x; oa[1] = oa[1] + vv[u] * pp[u].y; oa[2] = oa[2] + vv[u] * pp[u].z; oa[3] = oa[3] + vv[u] * pp[u].w; } }
    __syncthreads();
    LAS float* red2 = (LAS float*)(F.lds + SM_RED2);
#pragma unroll
    for (int hq = 0; hq < 4; ++hq) *(LAS f32x4*)(red2 + (sg * 4 + hq) * 64 + 4 * d4) = oa[hq];
    __syncthreads();
    if (F.tid < 256) { float s = 0.f;
#pragma unroll 8
        for (int g2 = 0; g2 < 32; ++g2) s += red2[g2 * 256 + F.tid]; obr[F.tid] = s; }
    __syncthreads();
}
__device__ __forceinline__ void p3_sample_unit(const Ptrs& P, Frame& F, int b, int g) {
    asm volatile("" : "+v"(F.tid), "+v"(F.lane), "+s"(F.wave));
    LAS float* q = (LAS float*)(F.lds + SM_Q); LAS float* Pb = (LAS float*)(F.lds + SM_P); LAS float* imp = (LAS float*)(F.lds + SM_IMP); LAS float* lsm = (LAS float*)(F.lds + SM_L);
    LAS int* sel = (LAS int*)(F.lds + SM_SEL); LAS float* osm = (LAS float*)(F.lds + SM_O);
    const float* cst = (const float*)(P.ws + WS_CONST);
    float kcmax = 0.f; for (int e_ = 0; e_ < 4; ++e_) kcmax += __builtin_bit_cast(float, __hip_atomic_load((unsigned*)(P.ws + WS_CTL) + CW_KCMAX + 64 + e_, RLX_AGENT));
    const float sh_cmp = cst[0] * sqrtf(kcmax) * LOG2E * 1.001f, sh_slc = cst[1], sh_win = cst[2];
    if (F.tid < 256) q[F.tid] = ((const float*)(P.ws + WS_QS))[(size_t)b * 512 + g * 256 + F.tid];
    __syncthreads();
    const float* kcs = (const float*)(P.ws + WS_KCS) + (size_t)(b * 2 + g) * 2 * NCS * 64;
    sample_branch(F, NCS, sh_cmp, [&](int s, const float*& kp, const float*& vp) { kp = kcs + (size_t)s * 64; vp = kcs + (size_t)(NCS + s) * 64; return true; }, osm);
    { const f32x4 p = *(const LAS f32x4*)(Pb + 4 * F.tid); float v = p.x / lsm[0] + p.y / lsm[1] + p.z / lsm[2] + p.w / lsm[3]; v += __shfl_xor(v, 1);
      if ((F.tid & 1) == 0) imp[F.tid >> 1] = v; if (F.tid < 4) imp[256 + F.tid] = 0.f; }
    if (F.tid < 256) osm[F.tid] = osm[F.tid] / lsm[F.tid >> 6];
    __syncthreads();
    if (F.wave == 0) { const int lane = F.lane; unsigned k[4];
#pragma unroll
        for (int i = 0; i < 4; ++i) { const int j = lane + 64 * i; k[i] = (j >= 1 && j <= 254) ? __builtin_bit_cast(unsigned, imp[j]) + 1u : 0u; }
        unsigned Tv = 0u;
        for (int bit = 30; bit >= 0; --bit) { const unsigned cand = Tv | (1u << bit); int cnt = 0;
#pragma unroll
            for (int i = 0; i < 4; ++i) cnt += __popcll(__ballot(k[i] >= cand));
            if (cnt >= 13) Tv = cand; }
        int ngt = 0;
#pragma unroll
        for (int i = 0; i < 4; ++i) ngt += __popcll(__ballot(k[i] > Tv));
        const int need = 13 - ngt; const unsigned long long below = (lane == 0) ? 0ull : (~0ull >> (64 - lane));
        int base = 3, eqbase = 0;
        if (lane == 0) { int z_ = 0; asm volatile("" : "+v"(z_)); sel[0] = z_; sel[1] = z_ + 255; sel[2] = z_ + 256; }
#pragma unroll
        for (int i = 0; i < 4; ++i) { const unsigned long long e = __ballot(k[i] == Tv); const int rk = eqbase + __popcll(e & below); const bool on = k[i] > Tv || (k[i] == Tv && rk < need);
            const unsigned long long m = __ballot(on); if (on) sel[base + __popcll(m & below)] = lane + 64 * i; base += __popcll(m); eqbase += __popcll(e); } }
    __syncthreads();
    const float* kvn = (const float*)(P.ws + WS_KVN) + (size_t)b * 768;
    const int* pt = P.page_table + b * NPAGES; const float* cs = P.cache_slc;
    sample_branch(F, 1024, sh_slc, [&](int s, const float*& kp, const float*& vp) { const int j = sel[s >> 6], rr = s & 63;
        if (j == 256) { kp = kvn + (1 * 2 + 0) * 128 + g * 64; vp = kvn + (1 * 2 + 1) * 128 + g * 64; return rr == 0; }
        const float* rowp = cs + ((size_t)pt[j >> 1] * 128 + (j & 1) * 64 + rr) * 256 + g * 64; kp = rowp; vp = rowp + 128; return true; }, osm + 256);
    if (F.tid < 256) osm[256 + F.tid] = osm[256 + F.tid] / lsm[F.tid >> 6];
    __syncthreads();
    const float* stw = P.st_win + (size_t)b * 512 * 256;
    sample_branch(F, 512, sh_win, [&](int s, const float*& kp, const float*& vp) {
        if (s == 511) { kp = kvn + (2 * 2 + 0) * 128 + g * 64; vp = kvn + (2 * 2 + 1) * 128 + g * 64; return true; }
        const float* rowp = stw + (size_t)(s + 1) * 256 + g * 64; kp = rowp; vp = rowp + 128; return true; }, osm + 512);
    if (F.tid < 256) { const int hq = F.tid >> 6, d = F.tid & 63; const float* gs = (const float*)(P.ws + WS_GS) + b * 24 + (g * 4 + hq) * 3;
        const float o = gs[0] * osm[F.tid] + gs[1] * osm[256 + F.tid] + gs[2] * osm[512 + F.tid] / lsm[hq];
        ((bf16*)(P.ws + WS_MIXS))[(size_t)b * 1024 + 512 + (g * 4 + hq) * 64 + d] = (bf16)f2bf(o * ((const float*)(P.ws + WS_ZAS))[(size_t)b * 512 + (g * 4 + hq) * 64 + d]); }
    __syncthreads();
}
__device__ __forceinline__ void p3_phase(const Ptrs& P, Frame& F, int rep) {
    const float* cst = (const float*)(P.ws + WS_CONST);
    float kcmax = 0.f; for (int e_ = 0; e_ < 4; ++e_) kcmax += __builtin_bit_cast(float, __hip_atomic_load((unsigned*)(P.ws + WS_CTL) + CW_KCMAX + e_, RLX_AGENT));
    const float sh_cmp = cst[0] * sqrtf(kcmax) * LOG2E * 1.001f, sh_slc = cst[1], sh_win = cst[2];
    unsigned long long tacc = 0ull;
    volatile LAS int* qw = (volatile LAS int*)(F.lds + P3_MISC);
#ifndef PROBE_P3
#define PROBE_P3 0
#endif
    constexpr int NS_ = PROBE_P3 == 1 ? 16 : 8, PSH_ = PROBE_P3 == 2 ? 1 : 0;
    constexpr int NQ = NS_ + (128 << PSH_);
    const int x0 = (int)(xb_xcc_id() & 7u);
    for (int xi = 0; xi < 8; ++xi) {
        const int x = (x0 + xi) & 7;
        for (;;) {
            __syncthreads();
            if (F.tid == 0) qw[0] = (int)__hip_atomic_fetch_add((unsigned*)(F.ctl + CW_QUEUE + 64 * (x + 8 * rep)), 1u, RLX_AGENT);
            __syncthreads();
            const int idx = qw[0];
            if (idx >= NQ) break;
            if (idx < NS_) p3_sample_unit(P, F, x * 4 + ((idx & 7) >> 1), idx & 1);
            else p3_prompt_unit(P, F, x >> 1, 127 - ((idx - NS_) >> PSH_), x & 1, sh_cmp, sh_slc, sh_win, tacc);
        }
    }
    if (PROBE_SEG != 0 && blockIdx.x == 0) { const unsigned long long t0_ = __builtin_readcyclecounter(); while (__builtin_readcyclecounter() - t0_ < tacc) __builtin_amdgcn_s_sleep(8); }
}
#ifndef MK_N_LAUNCHES
#define MK_N_LAUNCHES 1
#endif
constexpr int N_PHASES = 5;
constexpr int N_LAUNCHES = MK_N_LAUNCHES;
struct Args { Ptrs p; int ph_lo, ph_hi, rep, mode; };
__global__ void __launch_bounds__(NWAVES * 64, 2) nsa_fwd(Args args) {
    extern __shared__ __attribute__((aligned(16))) unsigned char lds[];
    const Ptrs& P = args.p;
    Frame F;
    F.lds = (LAS unsigned char*)lds;
    F.MISC = (volatile LAS unsigned*)(F.lds + MISC_OFF);
    F.tid = threadIdx.x; F.lane = F.tid & 63; F.wave = __builtin_amdgcn_readfirstlane(F.tid >> 6);
    F.G = gridDim.x; F.gw = blockIdx.x * NWAVES + F.wave; F.NGW = F.G * NWAVES;
    F.ctl = (gu32*)(P.ws + WS_CTL);
    for (int u = F.tid; u < (LDS_BYTES - LDSCTL_OFF) / 4; u += NWAVES * 64) ((LAS unsigned*)(F.lds + LDSCTL_OFF))[u] = 0u;
    __syncthreads();
    XcdBarrier bar; bar.bar = (unsigned*)(F.ctl + CW_BAR); bar.x = 0; bar.st = nullptr;
    if (N_LAUNCHES == 1) bar = xcd_barrier_post((unsigned*)(F.ctl + CW_BAR), F.MISC + 8);
    const int lo = args.ph_lo, hi = args.ph_hi;
    unsigned long long tprobe = 0ull;
#define IN(k) (lo <= (k) && (k) < hi)
#define FENCE() do { asm volatile("" : "+s"(F.wave), "+s"(F.gw)); F.lane = (int)__builtin_amdgcn_mbcnt_hi(~0u, __builtin_amdgcn_mbcnt_lo(~0u, 0u)); F.tid = F.wave * 64 + F.lane; asm volatile("" : "+v"(F.tid), "+v"(F.lane)); } while (0)
#define SEAM(k) do { if (IN(k) && IN((k) + 1)) xcd_barrier(bar, F.wave == 0 && (int)__builtin_amdgcn_mbcnt_hi(~0u, __builtin_amdgcn_mbcnt_lo(~0u, 0u)) == 0); } while (0)

    if (IN(0)) { FENCE(); p0_phase(P, F); } SEAM(0);
    if (IN(1)) { FENCE();
        pg8::Gemm g{(const pg8::bf16_t*)(P.ws + WS_XB), (const pg8::bf16_t*)(P.ws + WS_BT1), M, NP, D};
        EpiIn E{(const float*)(P.ws + WS_RSTD), (const float*)(P.ws + WS_ROPE), P.q_gain, P.k_gain, P.out, P.ws};
        const int nround = ((M / 256) * (NP / 256) + F.G - 1) / F.G, jx = (int)blockIdx.x >> 3,
                  kst = (((((int)blockIdx.x & 7) + 2 * (((jx >> 2) & 1) | ((jx >> 4) << 1))) & 7) * nround) >> 3;
        { pg8::StaticOrder S; S.init(M, NP, F.G, (int)blockIdx.x, 0, kst); pg8::gemm_phase<EpiIn, pg8::StaticOrder, true, true>(F.lds + RING_OFF, g, S, E, F.wave, tprobe); }
        FENCE(); __syncthreads();
#ifdef PROBE_CW
        const unsigned long long tc0_ = __builtin_readcyclecounter();
#endif
        compress_wg(P, F, F.lds + RING_OFF);
        __syncthreads(); FENCE();
#ifdef PROBE_CW
        asm volatile("s_waitcnt vmcnt(0)" ::: "memory"); tprobe = __builtin_readcyclecounter() - tc0_;
#endif
        { pg8::StaticOrder S; S.init(M, NP, F.G, (int)blockIdx.x, kst, nround - kst); pg8::gemm_phase<EpiIn, pg8::StaticOrder, true, true>(F.lds + RING_OFF, g, S, E, F.wave, tprobe); }
        FENCE();
        for (int ct = F.gw; ct < NP / 16; ct += F.NGW) small_gemm_tile<0>(P, (const bf16*)(P.ws + WS_XSB), (const bf16*)(P.ws + WS_BT1), ct, F.lane);
#ifdef PROBE_CW
        if (blockIdx.x == PROBE_CW) { const unsigned long long t0_ = __builtin_readcyclecounter(); while (__builtin_readcyclecounter() - t0_ < tprobe) __builtin_amdgcn_s_sleep(8); }
        tprobe = 0ull;
#endif
#if defined(PROBE_EPI)
        if (PROBE_EPI == 1 && blockIdx.x == 0) { const unsigned long long t0_ = __builtin_readcyclecounter(); while (__builtin_readcyclecounter() - t0_ < tprobe) __builtin_amdgcn_s_sleep(8); }
        tprobe = 0ull;
#endif
    } SEAM(1);
    if (IN(2)) { FENCE(); p2_phase(P, F); } SEAM(2);
    if (IN(3)) { FENCE(); p3_phase(P, F, args.rep); } SEAM(3);
    if (IN(4)) { FENCE();
        pg8::Gemm g{(const pg8::bf16_t*)(P.ws + WS_MIX), (const pg8::bf16_t*)(P.ws + WS_BT2), M, D, D}; pg8::StaticOrder S; S.init(M, D, F.G, (int)blockIdx.x);
        EpiOut E{(const bf16*)(P.ws + WS_XB), P.out + O_Y};
        pg8::gemm_phase<EpiOut, pg8::StaticOrder, true, true>(F.lds + RING_OFF, g, S, E, F.wave, tprobe);
        FENCE();
        for (int ct = F.gw; ct < D / 16; ct += F.NGW) small_gemm_tile<1>(P, (const bf16*)(P.ws + WS_MIXS), (const bf16*)(P.ws + WS_BT2), ct, F.lane);
#if defined(PROBE_EPI)
        if (PROBE_EPI == 2 && blockIdx.x == 0) { const unsigned long long t0_ = __builtin_readcyclecounter(); while (__builtin_readcyclecounter() - t0_ < tprobe) __builtin_amdgcn_s_sleep(8); }
#endif
    }
#undef IN
#undef SEAM
}

extern "C" void kernel_launch(void* const* d_in, const int* in_sizes, int n_in, void* d_out, int out_size, void* d_ws, size_t ws_size, hipStream_t stream) {
    static int grid = 0;
    if (grid == 0) {
        if (n_in != 16 || out_size != (int)O_END || ws_size < WS_END) { fprintf(stderr, "kernel_launch: unexpected shapes (n_in %d, out %d, ws %zu)\n", n_in, out_size, ws_size); grid = -1; return; }
        int dev = 0, cus = 0, per_cu = 0;
        if (hipGetDevice(&dev) != hipSuccess || hipDeviceGetAttribute(&cus, hipDeviceAttributeMultiprocessorCount, dev) != hipSuccess) { grid = -1; return; }
        if (hipFuncSetAttribute((const void*)nsa_fwd, hipFuncAttributeMaxDynamicSharedMemorySize, LDS_BYTES) != hipSuccess) { fprintf(stderr, "kernel_launch: hipFuncSetAttribute failed\n"); grid = -1; return; }
        if (hipOccupancyMaxActiveBlocksPerMultiprocessor(&per_cu, (const void*)nsa_fwd, NWAVES * 64, LDS_BYTES) != hipSuccess || per_cu < 1)
            fprintf(stderr, "kernel_launch: note: occupancy query reports %d workgroups per CU\n", per_cu);
        (void)hipGetLastError();
        grid = cus;
    }
    if (grid < 0) return;
    if (hipMemsetAsync((char*)d_ws + WS_CTL, 0, CTL_ZERO_BYTES, stream) != hipSuccess) return;
    Args a{}; a.mode = 3;
    a.p.xp = (const float*)d_in[0]; a.p.xs = (const float*)d_in[1]; a.p.cache_cmp = (const float*)d_in[2]; a.p.cache_slc = (const float*)d_in[3];
    a.p.st_win = (const float*)d_in[4]; a.p.st_conv = (const float*)d_in[5]; a.p.page_table = (const int*)d_in[6]; a.p.norm_g = (const float*)d_in[7];
    a.p.w_in = (const float*)d_in[8]; a.p.conv_w = (const float*)d_in[9]; a.p.conv_b = (const float*)d_in[10]; a.p.q_gain = (const float*)d_in[11];
    a.p.k_gain = (const float*)d_in[12]; a.p.cmp_pe = (const float*)d_in[13]; a.p.cmp_w = (const float*)d_in[14]; a.p.w_out = (const float*)d_in[15];
    a.p.out = (float*)d_out; a.p.ws = (unsigned char*)d_ws;
#ifndef PROBE_DUP
#define PROBE_DUP -1
#endif
    for (int li = 0; li < N_LAUNCHES; ++li) {
        a.ph_lo = (N_LAUNCHES == 1) ? 0 : li; a.ph_hi = (N_LAUNCHES == 1) ? N_PHASES : li + 1;
        for (int rep = 0; rep < ((N_LAUNCHES > 1 && li == PROBE_DUP) ? 2 : 1); ++rep) {
            a.rep = rep;
            hipLaunchKernelGGL(nsa_fwd, dim3(grid), dim3(NWAVES * 64), LDS_BYTES, stream, a);
            const hipError_t le = hipPeekAtLastError();
            if (le != hipSuccess) { fprintf(stderr, "kernel_launch: launch %d failed: %s\n", li, hipGetErrorName(le)); break; }
        }
    }
}
```

```cpp
#include <hip/hip_runtime.h>
#include <cstdio>
#include <cstdint>
#define GAS __attribute__((address_space(1)))
#define LAS __attribute__((address_space(3)))
typedef unsigned short bf16;
typedef unsigned v4u __attribute__((ext_vector_type(4)));
typedef unsigned v2u __attribute__((ext_vector_type(2)));
typedef float f32x2 __attribute__((ext_vector_type(2)));
typedef float f32x16 __attribute__((ext_vector_type(16)));
typedef GAS unsigned gu32;
typedef GAS unsigned long long gu64;
#define RLX_AGENT __ATOMIC_RELAXED, __HIP_MEMORY_SCOPE_AGENT
#define LDS_WAIT() asm volatile("s_waitcnt lgkmcnt(0)" ::: "memory")
#define VM_WAIT() asm volatile("s_waitcnt vmcnt(0)" ::: "memory")
#define MK_N_LAUNCHES 1
#define PROBE_DUP -1
#define PROBE_P3 0
#define PROBE_SEG 0
namespace pg8 {
#define PG8_LAS __attribute__((address_space(3)))
typedef unsigned short bf16_t;
typedef short bf16x8 __attribute__((ext_vector_type(8)));
typedef float f32x4 __attribute__((ext_vector_type(4)));
typedef unsigned u32x4 __attribute__((ext_vector_type(4)));
constexpr int BM = 256, BK = 64, HALF = 128, HTB = HALF * BK * 2  , STAGE_BYTES = 8 * HTB, NXCD = 8, WGM = 8;

__host__ __device__ __forceinline__ int lds_byte(int r, int c) { const int st = (r >> 4) * 2 + (c >> 5), rr = r & 15, cc = c & 31, ob = rr * 64 + cc * 2; return st * 1024 + (ob ^ (((ob >> 9) & 1) << 5)); }
__host__ __device__ __forceinline__ void stage_rc(int b, int& R, int& C) { const int st = b / 1024, sb = b % 1024, swz = sb ^ (((sb >> 9) & 1) << 5); R = (st >> 1) * 16 + swz / 64; C = (st & 1) * 32 + (swz % 64) / 2; }
__host__ __device__ __forceinline__ int perm32(int rho) { const int n = rho >> 4, i = rho & 15; return 8 * (i >> 2) + 4 * n + (i & 3); }

struct Unit { int pm, pn; };
struct Gemm { const bf16_t* A; const bf16_t* Bt; int M, N, K; };

struct StaticOrder {
    int nM, nN, nwg, G, c, i0, n;
    __host__ __device__ void init(int M, int N, int G_, int c_, int i0_ = 0, int n_ = 1 << 30) { nM = M / BM; nN = N / BM; nwg = nM * nN; G = G_; c = c_; i0 = i0_; n = n_; }
    __host__ __device__ bool next(int i, Unit& u) const {
        if (i >= n) return false;
        const long L = (long)(i + i0) * G + c; if (L >= nwg) return false;
        int wgid = (int)L; { const int q = nwg / NXCD, r = nwg % NXCD, xcd = wgid % NXCD, off = wgid / NXCD; wgid = (xcd < r ? xcd * (q + 1) : r * (q + 1) + (xcd - r) * q) + off; }
        const int nig = WGM * nN, gid = wgid / nig, fm = gid * WGM, gsz = (nM - fm) < WGM ? (nM - fm) : WGM;
        u.pm = fm + ((wgid % nig) % gsz); u.pn = (wgid % nig) / gsz; return true;
    }
    __device__ __forceinline__ void a_ready(const Unit&) const {}
    __device__ __forceinline__ void done(const Unit&) const {}
};


template <class Epi, class Sched, bool ALIGN_EPI = false, bool SP2 = false>
__device__ __forceinline__ void gemm_phase(PG8_LAS unsigned char* lds, const Gemm g, const Sched& S, const Epi& E, int wave_id  , unsigned long long& tacc_  ) {
    const int lane = (int)__builtin_amdgcn_mbcnt_hi(~0u, __builtin_amdgcn_mbcnt_lo(~0u, 0u)), wid = wave_id, tid = wid * 64 + lane, wr = wid >> 2, wc = wid & 3, fr = lane & 15, fq = lane >> 4;
    const int K = g.K, nt = K / BK;
    unsigned voffA[2], voffB[2];
#pragma unroll
    for (int i = 0; i < 2; ++i) { int R, C; stage_rc(tid * 16 + i * 8192, R, C); const int Rb = Epi::PERM ? ((R & ~31) + perm32(R & 31)) : R;
        voffA[i] = (unsigned)(R * K + C) * 2u; voffB[i] = (unsigned)(Rb * K + C) * 2u; }
    const size_t kstep = (size_t)(BK * 2);
    const size_t hstep = (size_t)HALF * K * 2;
    const size_t tstep = 2 * hstep;
    const unsigned ldsw = (unsigned)wid * 1024u;
    const int aoff = lds_byte(wr * 64 + fr, fq * 8), boff = lds_byte(wc * 32 + fr, fq * 8);
#define PG8_SA(b, h) (((b) * 2 + (h)) * HTB)
#define PG8_SB(b, h) ((4 + (b) * 2 + (h)) * HTB)
#define PG8_STAGE(bufoff, gbase, voff) do { _Pragma("unroll") for (int _i = 0; _i < 2; ++_i) \
        __builtin_amdgcn_global_load_lds((const unsigned*)((const char*)(gbase) + (voff)[_i]), (PG8_LAS unsigned*)(lds + (bufoff) + ldsw + _i * 8192), 16, 0, 0); } while (0)
#define PG8_LDA(dst, b, h) do { _Pragma("unroll") for (int m = 0; m < 4; ++m) _Pragma("unroll") for (int k = 0; k < 2; ++k) dst[m][k] = *(const PG8_LAS bf16x8*)(lds + PG8_SA(b, h) + aoff + m * 2048 + k * 1024); } while (0)
#define PG8_LDB(dst, b, h) do { _Pragma("unroll") for (int n = 0; n < 2; ++n) _Pragma("unroll") for (int k = 0; k < 2; ++k) dst[n][k] = *(const PG8_LAS bf16x8*)(lds + PG8_SB(b, h) + boff + n * 2048 + k * 1024); } while (0)
#define PG8_MMA(ai, bj, At, Bt) do { __builtin_amdgcn_s_setprio(1); _Pragma("unroll") for (int m = 0; m < 4; ++m) _Pragma("unroll") for (int n = 0; n < 2; ++n) _Pragma("unroll") for (int k = 0; k < 2; ++k) \
        acc[ai][bj][m][n] = __builtin_amdgcn_mfma_f32_16x16x32_bf16(Bt[n][k], At[m][k], acc[ai][bj][m][n], 0, 0, 0); __builtin_amdgcn_s_setprio(0); } while (0)
#define PG8_WAIT_V(n) asm volatile("s_waitcnt vmcnt(" #n ")" ::: "memory")
#define PG8_WAIT_L(n) asm volatile("s_waitcnt lgkmcnt(" #n ")" ::: "memory")
#define PG8_BAR __builtin_amdgcn_s_barrier()
#define PG8_SCHED __builtin_amdgcn_sched_barrier(0)
    Unit cur, nxt; int ui = 0;
    if (!S.next(0, cur)) return;
    f32x4 acc[2][2][4][2];
#pragma unroll
    for (int a = 0; a < 2; ++a)
#pragma unroll
        for (int b = 0; b < 2; ++b)
#pragma unroll
            for (int m = 0; m < 4; ++m)
#pragma unroll
                for (int n = 0; n < 2; ++n) acc[a][b][m][n] = (f32x4){0.f, 0.f, 0.f, 0.f};
    bf16x8 At[4][2], B0[2][2], B1[2][2];
    const char* cA = (const char*)g.A + (size_t)cur.pm * tstep; const char* cB = (const char*)g.Bt + (size_t)cur.pn * tstep;
    S.a_ready(cur);
    if constexpr (SP2) {
        PG8_STAGE(PG8_SB(0, 0), cB, voffB); PG8_STAGE(PG8_SB(0, 1), cB + hstep, voffB); PG8_STAGE(PG8_SA(0, 0), cA, voffA); PG8_STAGE(PG8_SA(0, 1), cA + hstep, voffA);
        if (wr == 1) PG8_BAR;
        PG8_WAIT_V(2); PG8_BAR;
        PG8_STAGE(PG8_SB(1, 0), cB + kstep, voffB); PG8_STAGE(PG8_SA(1, 0), cA + kstep, voffA); PG8_STAGE(PG8_SB(1, 1), cB + hstep + kstep, voffB);
        PG8_WAIT_V(6); PG8_BAR;
    } else {
        PG8_STAGE(PG8_SB(0, 0), cB, voffB); PG8_STAGE(PG8_SA(0, 0), cA, voffA); PG8_STAGE(PG8_SB(0, 1), cB + hstep, voffB); PG8_STAGE(PG8_SA(0, 1), cA + hstep, voffA);
        if (wr == 1) PG8_BAR;
        PG8_WAIT_V(4); PG8_BAR;
        PG8_STAGE(PG8_SB(1, 0), cB + kstep, voffB); PG8_STAGE(PG8_SA(1, 0), cA + kstep, voffA); PG8_STAGE(PG8_SB(1, 1), cB + hstep + kstep, voffB);
        PG8_WAIT_V(6); PG8_BAR;
    }
    for (;;) {
        const bool has_next = S.next(ui + 1, nxt);
        const char* nA = has_next ? (const char*)g.A + (size_t)nxt.pm * tstep : cA; const char* nB = has_next ? (const char*)g.Bt + (size_t)nxt.pn * tstep : cB;
        for (int t = 0; t < nt; t += 2) {
            const bool last = (t == nt - 2);
            const char* a1 = cA + (size_t)(t + 1) * kstep;
            const char* a2 = last ? nA : cA + (size_t)(t + 2) * kstep; const char* b2 = last ? nB : cB + (size_t)(t + 2) * kstep;
            const char* a3 = a2 + kstep; const char* b3 = b2 + kstep;
            if (last && has_next) S.a_ready(nxt);
            if constexpr (SP2) {
            PG8_LDB(B0, 0, 0); PG8_LDB(B1, 0, 1); PG8_SCHED; PG8_LDA(At, 0, 0); PG8_STAGE(PG8_SA(1, 1), a1 + hstep, voffA);
            PG8_WAIT_V(8); PG8_WAIT_L(0); PG8_BAR; PG8_MMA(0, 0, At, B0); PG8_MMA(0, 1, At, B1); PG8_BAR; PG8_SCHED;
            PG8_LDA(At, 0, 1); PG8_STAGE(PG8_SB(0, 0), b2, voffB); PG8_STAGE(PG8_SB(0, 1), b2 + hstep, voffB); PG8_STAGE(PG8_SA(0, 0), a2, voffA);
            PG8_WAIT_V(8); PG8_WAIT_L(0); PG8_BAR; PG8_MMA(1, 0, At, B0); PG8_MMA(1, 1, At, B1); PG8_BAR; PG8_SCHED;
            PG8_LDB(B0, 1, 0); PG8_LDB(B1, 1, 1); PG8_SCHED; PG8_LDA(At, 1, 0); PG8_STAGE(PG8_SA(0, 1), a2 + hstep, voffA);
            PG8_WAIT_V(8); PG8_WAIT_L(0); PG8_BAR; PG8_MMA(0, 0, At, B0); PG8_MMA(0, 1, At, B1); PG8_BAR; PG8_SCHED;
            PG8_LDA(At, 1, 1); PG8_STAGE(PG8_SB(1, 0), b3, voffB); PG8_STAGE(PG8_SB(1, 1), b3 + hstep, voffB); PG8_STAGE(PG8_SA(1, 0), a3, voffA);
            PG8_WAIT_V(8); PG8_WAIT_L(0); PG8_BAR; PG8_MMA(1, 0, At, B0); PG8_MMA(1, 1, At, B1); PG8_BAR; PG8_SCHED;
            } else {
            PG8_LDB(B0, 0, 0); PG8_SCHED; PG8_LDA(At, 0, 0); PG8_STAGE(PG8_SA(1, 1), a1 + hstep, voffA);
            PG8_WAIT_L(8); PG8_BAR; PG8_WAIT_L(0); PG8_MMA(0, 0, At, B0); PG8_BAR; PG8_SCHED;
            PG8_LDB(B1, 0, 1); PG8_STAGE(PG8_SB(0, 0), b2, voffB);
            PG8_BAR; PG8_WAIT_L(0); PG8_MMA(0, 1, At, B1); PG8_BAR;
            PG8_LDA(At, 0, 1); PG8_STAGE(PG8_SA(0, 0), a2, voffA);
            PG8_BAR; PG8_WAIT_L(0); PG8_MMA(1, 0, At, B0); PG8_BAR; PG8_SCHED;
            PG8_STAGE(PG8_SB(0, 1), b2 + hstep, voffB);
            PG8_WAIT_V(6); PG8_BAR; PG8_MMA(1, 1, At, B1); PG8_BAR;
            PG8_LDB(B0, 1, 0); PG8_SCHED; PG8_LDA(At, 1, 0); PG8_STAGE(PG8_SA(0, 1), a2 + hstep, voffA);
            PG8_WAIT_L(8); PG8_BAR; PG8_WAIT_L(0); PG8_MMA(0, 0, At, B0); PG8_BAR; PG8_SCHED;
            PG8_LDB(B1, 1, 1); PG8_STAGE(PG8_SB(1, 0), b3, voffB);
            PG8_BAR; PG8_WAIT_L(0); PG8_MMA(0, 1, At, B1); PG8_BAR;
            PG8_LDA(At, 1, 1); PG8_STAGE(PG8_SA(1, 0), a3, voffA);
            PG8_BAR; PG8_WAIT_L(0); PG8_MMA(1, 0, At, B0); PG8_BAR; PG8_SCHED;
            PG8_STAGE(PG8_SB(1, 1), b3 + hstep, voffB);
            PG8_WAIT_V(6); PG8_BAR; PG8_MMA(1, 1, At, B1); PG8_BAR;
            }
        }
        if constexpr (ALIGN_EPI) { if (wr == 0) PG8_BAR; }
#ifdef PROBE_EPI
        { const unsigned long long t0_ = __builtin_readcyclecounter(); E(acc, cur, wr, wc, fr, fq); asm volatile("s_waitcnt vmcnt(0)" ::: "memory"); tacc_ += __builtin_readcyclecounter() - t0_; S.done(cur); }
#else
        if constexpr (!Epi::AFTER_DRAIN) { E(acc, cur, wr, wc, fr, fq); S.done(cur); }
#endif
        if (!has_next) break;
#pragma unroll
        for (int a = 0; a < 2; ++a)
#pragma unroll
            for (int b = 0; b < 2; ++b)
#pragma unroll
                for (int m = 0; m < 4; ++m)
#pragma unroll
                    for (int n = 0; n < 2; ++n) acc[a][b][m][n] = (f32x4){0.f, 0.f, 0.f, 0.f};
        cur = nxt; cA = nA; cB = nB; ++ui;
        if constexpr (ALIGN_EPI) { if (wr == 1) PG8_BAR; }
    }
    PG8_WAIT_V(0);
    if constexpr (!ALIGN_EPI) { if (wr == 0) PG8_BAR; }
    PG8_BAR;
    if constexpr (Epi::AFTER_DRAIN) { E.fused(acc, cur, wr, wc, fr, fq, lds, wid, lane); S.done(cur); }
#undef PG8_SA
#undef PG8_SB
#undef PG8_STAGE
#undef PG8_LDA
#undef PG8_LDB
#undef PG8_MMA
#undef PG8_WAIT_V
#undef PG8_WAIT_L
#undef PG8_BAR
#undef PG8_SCHED
}
}
#define XB_TMO      128
#define XB_XCNT(j)  (256  + 64 * (j))
#define XB_XSUB(j)  (1280 + 64 * (j))
#define XB_XGEN(j)  (2304 + 64 * (j))
#define XB_TOP      3328
#define XB_TOPGEN   3392
#define XCD_BAR_WORDS 3456
#define XB_SPIN_CAP (1u << 18)

__device__ __forceinline__ unsigned xb_ld(unsigned* p)              { return __hip_atomic_load(p, __ATOMIC_RELAXED, __HIP_MEMORY_SCOPE_AGENT); }
__device__ __forceinline__ unsigned xb_add(unsigned* p, unsigned v) { return __hip_atomic_fetch_add(p, v, __ATOMIC_RELAXED, __HIP_MEMORY_SCOPE_AGENT); }
__device__ __forceinline__ unsigned xb_xcc_id() { return (unsigned)__builtin_amdgcn_s_getreg((3 << 11) | 20) & 0xFu; }
#define XB_SPIN(cond, bar) do { unsigned _sp = 0; while (cond) { __builtin_amdgcn_s_sleep(1); \
    if ((++_sp & 255u) == 0u) { if (xb_ld(&(bar)[XB_TMO])) break; if (_sp > XB_SPIN_CAP) { atomicAdd(&(bar)[XB_TMO], 1u); break; } } } } while (0)

struct XcdBarrier {
    unsigned* bar; unsigned x;
    volatile LAS unsigned* st;
};

__device__ __forceinline__ XcdBarrier xcd_barrier_post(unsigned* bar, volatile LAS unsigned* st) {
    XcdBarrier b; b.bar = bar; b.x = xb_xcc_id(); b.st = st;
    if (threadIdx.x == 0) (void)xb_add(&bar[XB_XCNT(b.x)], 1u);
    return b;
}
__device__ __forceinline__ void xcd_barrier_complete(unsigned* bar, unsigned x, unsigned& nloc, unsigned& nx) {
    const unsigned G = gridDim.x * gridDim.y * gridDim.z;
    unsigned sum, cnt, mine, sp = 0u;
    for (;;) {
        sum = 0u; cnt = 0u; mine = 0u;
#pragma unroll
        for (unsigned j = 0; j < 16; ++j) { const unsigned c = xb_ld(&bar[XB_XCNT(j)]); sum += c; cnt += (c > 0u) ? 1u : 0u; mine = (j == x) ? c : mine; }
        if (sum == G) break;
        __builtin_amdgcn_s_sleep(1);
        if ((++sp & 255u) == 0u) { if (xb_ld(&bar[XB_TMO])) break; if (sp > XB_SPIN_CAP) { atomicAdd(&bar[XB_TMO], 1u); break; } }
    }
    nloc = mine > 0u ? mine : 1u; nx = cnt > 0u ? cnt : 1u;
}

__device__ __forceinline__ void xcd_barrier(const XcdBarrier& b, bool leader  ) {
    asm volatile("s_waitcnt vmcnt(0)" ::: "memory");
    __syncthreads();
    if (leader) {
        unsigned* bar = b.bar;
        __builtin_amdgcn_s_waitcnt(0);
        unsigned nloc = b.st[0], nx = b.st[1];
        if (nloc == 0u) { xcd_barrier_complete(bar, b.x, nloc, nx); b.st[0] = nloc; b.st[1] = nx; }
        const unsigned old = xb_add(&bar[XB_XSUB(b.x)], 1u);
        const unsigned gen = old / nloc;
        if (old + 1u == (gen + 1u) * nloc) {
            __builtin_amdgcn_fence(__ATOMIC_RELEASE, "agent");
            asm volatile("s_waitcnt vmcnt(0)" ::: "memory");
            const unsigned og = xb_add(&bar[XB_TOP], 1u);
            const unsigned tg = og / nx;
            if (og + 1u == (tg + 1u) * nx) xb_add(&bar[XB_TOPGEN], 1u);
            else XB_SPIN(xb_ld(&bar[XB_TOPGEN]) == tg, bar);
            __builtin_amdgcn_fence(__ATOMIC_ACQUIRE, "agent");
            xb_add(&bar[XB_XGEN(b.x)], 1u);
            asm volatile("s_waitcnt vmcnt(0)" ::: "memory");
        } else {
            XB_SPIN(xb_ld(&bar[XB_XGEN(b.x)]) == gen, bar);
            __builtin_amdgcn_fence(__ATOMIC_ACQUIRE, "agent");
            asm volatile("s_waitcnt vmcnt(0)" ::: "memory");
        }
    }
    __syncthreads();
}
using pg8::f32x4; using pg8::bf16x8;
constexpr int NWAVES = 8;
constexpr int BATCH = 4, T = 8192, D = 1024, M = BATCH * T, NP = 4096, INW = 3864;
constexpr int DECB = 32, PAST = 16384, NPAGES = 128, NCS = 512  ;
constexpr float NORM_EPS = 1e-6f;
constexpr float LOG2E = 1.4426950408889634f;
constexpr float QSCALE = 0.125f * LOG2E;
constexpr size_t O_Y = 0, O_YS = 33554432, O_PCMP = 33587200, O_PSLC = 41975808, O_PWIN = 50364416, O_PCONV = 50888704,
                 O_SCMP = 50892800, O_SSLC = 50900992, O_SWIN = 50909184, O_SCONV = 55103488, O_END = 55136256;
constexpr int C_BG = 0, C_CG = 512, C_CI = 1024, C_ZC = 1536, C_Q = 2048, C_KV = 2560, C_GL = 3328, C_ZA = 3352;

constexpr size_t MiB = 1u << 20, KiB = 1u << 10;
constexpr size_t WS_CTL = 0, CTL_ZERO_BYTES = 128 * KiB;
constexpr size_t WS_BT1 = 2 * MiB;
constexpr size_t WS_BT2 = 10 * MiB;
constexpr size_t WS_BTC = 12 * MiB;
constexpr size_t WS_CBIAS = 12 * MiB + 512 * KiB;
constexpr size_t WS_CONST = WS_CBIAS + 4 * KiB;
constexpr size_t WS_ROPE = 13 * MiB;
constexpr size_t WS_RSTD = 16 * MiB;
constexpr size_t WS_XSB = 16 * MiB + 256 * KiB;
constexpr size_t WS_RSTDS = WS_XSB + 64 * KiB;
constexpr size_t WS_GATE = 17 * MiB;
constexpr size_t WS_KC = 20 * MiB;
constexpr size_t WS_PROJS = 21 * MiB;
constexpr size_t WS_QS = 22 * MiB;
constexpr size_t WS_KVN = WS_QS + 64 * KiB;
constexpr size_t WS_GS = WS_KVN + 96 * KiB;
constexpr size_t WS_ZAS = WS_GS + 4 * KiB;
constexpr size_t WS_MIXS = WS_ZAS + 64 * KiB;
constexpr size_t WS_KCS = 24 * MiB;
constexpr size_t WS_KS = 40 * MiB, WS_KW = 56 * MiB;
constexpr size_t WS_XB = 72 * MiB;
constexpr size_t WS_CG = 136 * MiB, WS_U = 168 * MiB, WS_ZA = 200 * MiB, WS_Q = 232 * MiB;
constexpr size_t WS_MIX = 264 * MiB;
constexpr size_t WS_TOT = 328 * MiB;
constexpr size_t WS_END = 344 * MiB;
constexpr int CW_TMO = 0, CW_CODE = 1;
constexpr int CW_BAR = 4096;
constexpr int CW_QUEUE = 16384;
constexpr int CW_P0CNT = 18432;
constexpr int CW_KCMAX = 20480;

constexpr int RING_OFF = 0, RING_BYTES = 131072;
constexpr int LDSCTL_OFF = RING_BYTES, MISC_OFF = LDSCTL_OFF + 320;
constexpr int LDS_BYTES = 147456;

__device__ __forceinline__ unsigned f2bf(float f) { unsigned u = __builtin_bit_cast(unsigned, f); return (u + 0x7fffu + ((u >> 16) & 1u)) >> 16; }
typedef __bf16 bf16x2_t __attribute__((ext_vector_type(2)));
__device__ __forceinline__ unsigned pk2(float lo, float hi) { return __builtin_bit_cast(unsigned, __builtin_convertvector((f32x2){lo, hi}, bf16x2_t)); }
__device__ __forceinline__ float bf2f(unsigned h) { return __builtin_bit_cast(float, h << 16); }
__device__ __forceinline__ float wave_sum(float v) {
#pragma unroll
    for (int o = 1; o < 64; o <<= 1) v += __shfl_xor(v, o);
    return v;
}
__device__ __forceinline__ float quad_sum(float v) {
    v += __builtin_bit_cast(float, __builtin_amdgcn_update_dpp(0, __builtin_bit_cast(int, v), 0xB1, 0xF, 0xF, true));
    v += __builtin_bit_cast(float, __builtin_amdgcn_update_dpp(0, __builtin_bit_cast(int, v), 0x4E, 0xF, 0xF, true));
    return v;
}
__device__ __forceinline__ float fast_exp2(float x) { return __builtin_amdgcn_exp2f(x); }
__device__ __forceinline__ float sigmoidf(float x) { return __builtin_amdgcn_rcpf(1.0f + fast_exp2(-x * LOG2E)); }
__device__ __forceinline__ float slc_vscale(float sh_slc) { return fast_exp2(floorf(18.0f - sh_slc)); }
__device__ __forceinline__ int kimg_off(int key, int d) { return ((((key >> 5) * 4 + (d >> 4)) * 64 + ((d >> 3) & 1) * 32 + (key & 31)) << 3) + (d & 7); }
__device__ __forceinline__ int vimg_off(int d, int pos) { return 4096 + ((((d >> 5) * 4 + (pos >> 4)) * 64 + ((pos >> 3) & 1) * 32 + (d & 31)) << 3) + (pos & 7); }
__device__ __forceinline__ int perm16(int kk) { return 8 * ((kk >> 2) & 1) + 4 * (kk >> 3) + (kk & 3); }

struct Ptrs {
    const float *xp, *xs, *cache_cmp, *cache_slc, *st_win, *st_conv; const int* page_table;
    const float *norm_g, *w_in, *conv_w, *conv_b, *q_gain, *k_gain, *cmp_pe, *cmp_w, *w_out;
    float* out; unsigned char* ws;
};
struct Frame {
    LAS unsigned char* lds;
    volatile LAS unsigned* MISC;
    gu32* ctl;
    int tid, lane, wave, G, gw, NGW;
};
__device__ __forceinline__ int bt1_src(int dg, int& nvalid) {
    const int pn = dg >> 3, gi = dg & 7, bj = gi >> 2, wc = gi & 3; nvalid = 32;
    if (pn < 4) return (bj ? C_ZC : C_BG) + 128 * pn + 32 * wc;
    if (pn < 8) return (bj ? C_CI : C_CG) + 128 * (pn - 4) + 32 * wc;
    if (pn < 10) return C_Q + (4 * (pn - 8) + wc) * 64 + 32 * bj;
    if (pn < 13) return C_KV + (pn - 10) * 256 + wc * 64 + 32 * bj;
    if (pn < 15) return C_ZA + 256 * (pn - 13) + 32 * gi;
    nvalid = (gi == 0) ? 24 : 0; return C_GL;
}
__device__ __forceinline__ void p0_transpose_item(const float* W, int ldw, int k0, int src0, int nvalid, const float* ksc, bf16* WT, int ldt, int drow0, LAS float* scr, int lane) {
    const int nn = lane & 31;
#pragma unroll 8
    for (int i = 0; i < 32; ++i) { const int kk = 2 * i + (lane >> 5); float v = 0.f;
        if (nn < nvalid) { v = W[(size_t)(k0 + kk) * ldw + src0 + nn]; if (ksc) v *= ksc[k0 + kk]; }
        scr[kk * 33 + nn] = v; }
    LDS_WAIT(); asm volatile("" ::: "memory");
    const int c = lane & 7;
#pragma unroll
    for (int j = 0; j < 4; ++j) { const int n = (lane >> 3) + 8 * j; const LAS float* s = scr + (8 * c) * 33 + n;
        v4u o; o.x = pk2(s[0 * 33], s[1 * 33]); o.y = pk2(s[2 * 33], s[3 * 33]); o.z = pk2(s[4 * 33], s[5 * 33]); o.w = pk2(s[6 * 33], s[7 * 33]);
        *(GAS v4u*)(WT + (size_t)(drow0 + n) * ldt + k0 + 8 * c) = o; }
    LDS_WAIT(); asm volatile("" ::: "memory");
}
template <int NR>
__device__ __forceinline__ void x_rows_load(f32x4 (&v)[NR][4], const float* xrow, int lane) {
#pragma unroll
    for (int r = 0; r < NR; ++r)
#pragma unroll
        for (int j = 0; j < 4; ++j) v[r][j] = ((const GAS f32x4*)(xrow + (size_t)r * D) + lane)[64 * j];
}
template <int NR>
__device__ __forceinline__ void x_rows_finish(const f32x4 (&v)[NR][4], bf16* orow, float* rstd_out, int lane) {
    float s[NR];
#pragma unroll
    for (int r = 0; r < NR; ++r) { s[r] = 0.f;
#pragma unroll
        for (int j = 0; j < 4; ++j) s[r] += (v[r][j].x * v[r][j].x + v[r][j].y * v[r][j].y) + (v[r][j].z * v[r][j].z + v[r][j].w * v[r][j].w); }
#pragma unroll
    for (int o = 1; o < 64; o <<= 1)
#pragma unroll
        for (int r = 0; r < NR; ++r) s[r] += __shfl_xor(s[r], o);
#pragma unroll
    for (int r = 0; r < NR; ++r) { GAS unsigned long long* o8 = (GAS unsigned long long*)(orow + (size_t)r * D) + lane;
#pragma unroll
        for (int j = 0; j < 4; ++j) o8[64 * j] = (unsigned long long)pk2(v[r][j].x, v[r][j].y) | ((unsigned long long)pk2(v[r][j].z, v[r][j].w) << 32);
        if (lane == 0) rstd_out[r] = 1.0f / sqrtf(s[r] * (1.0f / D) + NORM_EPS); }
}
template <int NR>
__device__ __forceinline__ void x_rows_to_bf16(const float* xrow, bf16* orow, float* rstd_out, int lane) {
    f32x4 v[NR][4]; x_rows_load<NR>(v, xrow, lane); x_rows_finish<NR>(v, orow, rstd_out, lane);
}
__device__ __forceinline__ void x_rows_stream(const Ptrs& P, int m0, int mstride, int lane) {
    if (m0 >= M) return;
    f32x4 va[4][4], vb[4][4];
    x_rows_load<4>(va, P.xp + (size_t)m0 * D, lane);
    for (int m = m0; m < M; m += 2 * mstride) {
        const int m1 = m + mstride, m2 = m + 2 * mstride;
        if (m1 < M) x_rows_load<4>(vb, P.xp + (size_t)m1 * D, lane);
        x_rows_finish<4>(va, (bf16*)(P.ws + WS_XB) + (size_t)m * D, (float*)(P.ws + WS_RSTD) + m, lane);
        if (m2 < M) x_rows_load<4>(va, P.xp + (size_t)m2 * D, lane);
        if (m1 < M) x_rows_finish<4>(vb, (bf16*)(P.ws + WS_XB) + (size_t)m1 * D, (float*)(P.ws + WS_RSTD) + m1, lane);
    }
}
template <class Side>
__device__ __forceinline__ void compress_prompt_units(const Ptrs& P, Frame& F, LAS float* part  , const Side& side  ) {
    constexpr int NUNITS = BATCH * 32 * 2;
    const int lane = F.lane, w = F.wave, rho = lane & 15, kq = lane >> 4;
    const GAS v4u* bfr = (const GAS v4u*)(P.ws + WS_BTC) + lane;
    const float* cbias = (const float*)(P.ws + WS_CBIAS);
    for (int unit = blockIdx.x; unit < NUNITS; unit += F.G) {
        const int j = unit & 1, b = unit >> 6, c0 = ((unit >> 1) & 31) * 8;
        const float* rb = P.out + O_PCMP + ((size_t)b * T + (c0 + (rho >> 1)) * 32) * 256 + j * 128 + (rho & 1) * 64 + 4 * kq;
        f32x4 a[4][4]; bf16x8 bb[4][8];
#pragma unroll
        for (int rr = 0; rr < 4; ++rr) { const int r = 4 * w + rr;
#pragma unroll
            for (int dh = 0; dh < 2; ++dh) { a[rr][2 * dh] = *(const GAS f32x4*)(rb + r * 256 + dh * 32); a[rr][2 * dh + 1] = *(const GAS f32x4*)(rb + r * 256 + dh * 32 + 16); } }
        f32x4 acc[4];
#pragma unroll
        for (int e = 0; e < 4; ++e) acc[e] = (f32x4){0.f, 0.f, 0.f, 0.f};
        if (unit == (int)blockIdx.x) side();
#pragma unroll
        for (int rr = 0; rr < 4; ++rr) { const int r = 4 * w + rr;
#pragma unroll
            for (int dh = 0; dh < 2; ++dh)
#pragma unroll
                for (int et = 0; et < 4; ++et) bb[rr & 1][dh * 4 + et] = __builtin_bit_cast(bf16x8, bfr[(size_t)((((j * 32 + r) * 2 + dh) * 4 + et) * 64)]);
#pragma unroll
            for (int dh = 0; dh < 2; ++dh) { const f32x4 x0 = a[rr][2 * dh], x1 = a[rr][2 * dh + 1];
                v4u wv; wv.x = pk2(x0.x, x0.y); wv.y = pk2(x0.z, x0.w); wv.z = pk2(x1.x, x1.y); wv.w = pk2(x1.z, x1.w);
                const bf16x8 af = __builtin_bit_cast(bf16x8, wv);
#pragma unroll
                for (int et = 0; et < 4; ++et) acc[et] = __builtin_amdgcn_mfma_f32_16x16x32_bf16(af, bb[rr & 1][dh * 4 + et], acc[et], 0, 0, 0); } }
        __syncthreads();
#pragma unroll
        for (int et = 0; et < 4; ++et) *(LAS f32x4*)(part + ((w * 4 + et) * 64 + lane) * 4) = acc[et];
        __syncthreads();
        if (w < 4) { const int et = w, e = 16 * et + rho; f32x4 sum = *(const LAS f32x4*)(part + ((0 * 4 + et) * 64 + lane) * 4);
#pragma unroll
          for (int ww = 1; ww < 8; ++ww) sum = sum + *(const LAS f32x4*)(part + ((ww * 4 + et) * 64 + lane) * 4);
          const float bs = cbias[j * 64 + e];
          float nmax = 0.f;
#pragma unroll
          for (int i = 0; i < 4; ++i) { const int row = 4 * kq + i, c = c0 + (row >> 1), g = row & 1; const float val = sum[i] + bs;
              float q2 = val * val; q2 += __shfl_xor(q2, 1); q2 += __shfl_xor(q2, 2); q2 += __shfl_xor(q2, 4); q2 += __shfl_xor(q2, 8); nmax = fmaxf(nmax, q2);
              bf16* img = (bf16*)(P.ws + WS_KC) + ((size_t)(b * 2 + g) * 4 + (c >> 6)) * 8192;
              if (j == 0) img[kimg_off(c & 63, e)] = (bf16)f2bf(val); else img[vimg_off(e, (c & 48) + perm16(c & 15))] = (bf16)f2bf(val); }
          if (j == 0) { nmax = fmaxf(nmax, __shfl_xor(nmax, 16)); nmax = fmaxf(nmax, __shfl_xor(nmax, 32));
              if (lane == 0) atomicMax((unsigned*)(P.ws + WS_CTL) + CW_KCMAX + et, __builtin_bit_cast(unsigned, nmax)); } }
    }
}
constexpr int P0_PRODUCERS = 641;
__device__ __forceinline__ void p0_small_items(const Ptrs& P, Frame& F) {
    const int lane = F.lane, gw = F.gw;
    if (gw >= P0_PRODUCERS && F.NGW >= P0_PRODUCERS) return;
    for (int item = gw; item < P0_PRODUCERS; item += F.NGW) {
        if (item < 512) { const int it = item * 64 + lane; const int l = it & 63, et = (it >> 6) & 3, dh = (it >> 8) & 1, r = (it >> 9) & 31, j = it >> 14;
            const float* w = P.cmp_w + ((size_t)(r * 2 + j) * 64 + 32 * dh + 4 * (l >> 4)) * 64 + 16 * et + (l & 15);
            v4u o; o.x = pk2(w[0], w[64]); o.y = pk2(w[128], w[192]); o.z = pk2(w[16 * 64], w[17 * 64]); o.w = pk2(w[18 * 64], w[19 * 64]);
            __builtin_amdgcn_raw_buffer_store_b128(o, __builtin_amdgcn_make_buffer_rsrc((void*)(P.ws + WS_BTC), 0, 512 * 1024, 0x00020000), it * 16, 0, 16);
        } else if (item < 640) { const int it = item - 512, j = it >> 6, e = it & 63; float s = 0.f;
            for (int k = lane; k < 2048; k += 64) { const int r = k >> 6, d = k & 63; s += P.cmp_pe[(r * 2 + j) * 64 + d] * P.cmp_w[((size_t)(r * 2 + j) * 64 + d) * 64 + e]; }
            s = wave_sum(s); if (lane == 0) __hip_atomic_store((float*)(P.ws + WS_CBIAS) + it, s, RLX_AGENT);
        } else { float qm = fabsf(P.q_gain[lane]), k1 = fabsf(P.k_gain[64 + lane]), k2 = fabsf(P.k_gain[128 + lane]);
#pragma unroll
            for (int o = 1; o < 64; o <<= 1) { qm = fmaxf(qm, __shfl_xor(qm, o)); k1 = fmaxf(k1, __shfl_xor(k1, o)); k2 = fmaxf(k2, __shfl_xor(k2, o)); }
            if (lane == 0) { float* cst = (float*)(P.ws + WS_CONST); __hip_atomic_store(cst + 0, qm, RLX_AGENT); __hip_atomic_store(cst + 1, 8.0f * qm * k1 * LOG2E * 1.001f, RLX_AGENT); __hip_atomic_store(cst + 2, 8.0f * qm * k2 * LOG2E * 1.001f, RLX_AGENT); } }
        asm volatile("s_waitcnt vmcnt(0)" ::: "memory");
        if (lane == 0) __hip_atomic_fetch_add((unsigned*)(F.ctl + CW_P0CNT), 1u, RLX_AGENT);
    }
}
__device__ __forceinline__ void p0_rope(const Ptrs& P, Frame& F, int gw, int NGW) {
    const int lane = F.lane; const int i = lane & 31;
    const float inv = (float)pow(10000.0, -(double)i / 32.0);
    for (int it = gw * 64 + lane; it < 8193 * 32; it += NGW * 64) { const int p = it >> 5; const int pos = (p == 8192) ? PAST : p;
        const float ang = (float)pos * inv; const double rev = (double)ang * 0.15915494309189535; const float fr = (float)(rev - __builtin_rint(rev));
        float* rt = (float*)(P.ws + WS_ROPE) + (size_t)p * 64; rt[i] = __builtin_amdgcn_cosf(fr); rt[32 + i] = __builtin_amdgcn_sinf(fr); }
}
__device__ __forceinline__ void p0_other_slice(const Ptrs& P, Frame& F, int k, int gw, int NGW, LAS float* scr) {
    const int lane = F.lane;
    if (k < 2) { const int it = gw + k * NGW; if (it < 16 * 128) { const int kb = it >> 7, dg = it & 127; int nv; const int src0 = bt1_src(dg, nv);
        p0_transpose_item(P.w_in, INW, 64 * kb, src0, nv, P.norm_g, (bf16*)(P.ws + WS_BT1), D, 32 * dg, scr, lane); }
    } else if (k == 2) { for (int it = gw; it < 16 * 32; it += NGW) { const int kb = it >> 5, nb = it & 31;
        p0_transpose_item(P.w_out, D, 64 * kb, 32 * nb, 32, nullptr, (bf16*)(P.ws + WS_BT2), D, 32 * nb, scr, lane); }
    } else if (k == 3) { x_rows_stream(P, gw * 4, NGW * 4, lane);
    } else if (k < 11) {
    } else if (k == 11) { for (int m = gw; m < DECB; m += NGW) x_rows_to_bf16<1>(P.xs + (size_t)m * D, (bf16*)(P.ws + WS_XSB) + (size_t)m * D, (float*)(P.ws + WS_RSTDS) + m, lane);
        for (int it = gw * 64 + lane; it < DECB * 512; it += NGW * 64) { const int b = it >> 9, ch = it & 511; P.out[O_SCONV + (size_t)b * 1024 + ch] = P.st_conv[(size_t)b * 1024 + 512 + ch]; }
    } else if (k == 12) {
        constexpr int PERB = 511 * 64, TOTAL = DECB * PERB; const GAS f32x4* src = (const GAS f32x4*)P.st_win; GAS f32x4* dst = (GAS f32x4*)(P.out + O_SWIN);
        for (int i0 = gw * 64 + lane; i0 < TOTAL; i0 += NGW * 64 * 8) { f32x4 t[8];
#pragma unroll
            for (int u = 0; u < 8; ++u) { const int i = i0 + u * NGW * 64; if (i < TOTAL) { const int b = i / PERB; t[u] = src[i + 64 * b + 64]; } }
#pragma unroll
            for (int u = 0; u < 8; ++u) { const int i = i0 + u * NGW * 64; if (i < TOTAL) { const int b = i / PERB; dst[i + 64 * b] = t[u]; } } }
    } else if (k == 13) p0_rope(P, F, gw, NGW);
}
constexpr int P0_OTHER_SLICES = 14;
__device__ __forceinline__ void p0_phase(const Ptrs& P, Frame& F) {
    p0_small_items(P, F);
    LAS float* scr = (LAS float*)(F.lds + RING_OFF + F.wave * 16384);
    for (int k = 0; k < P0_OTHER_SLICES; ++k) p0_other_slice(P, F, k, F.gw, F.NGW, scr);
}
constexpr int CW_NS = 4, CW_NPASS = DECB * 8;
#define CW_LOAD(dst, base, r) do { _Pragma("unroll") for (int q_ = 0; q_ < 4; ++q_) { dst[2 * q_] = *(const GAS f32x4*)((base) + (r) * 256 + (q_ >> 1) * 128 + (q_ & 1) * 32); dst[2 * q_ + 1] = *(const GAS f32x4*)((base) + (r) * 256 + (q_ >> 1) * 128 + (q_ & 1) * 32 + 16); } } while (0)
template <int S>
__device__ __forceinline__ void cw_step(f32x4 (&a)[CW_NS][8], v4u (&vb)[4], f32x4 (&acc)[2][4], const float*& rp, int& nr, const GAS v4u*& bp, int& nb, LAS v4u* bdst, const LAS v4u* bl_lane) {
    if constexpr ((S & 1) == 0) {
#pragma unroll
        for (int i = 0; i < 4; ++i) vb[i] = bp[i];
        if (nb < 15) { ++nb; bp += 1024; } asm volatile("" : "+v"(bp));
        __builtin_amdgcn_sched_barrier(0); }
    CW_LOAD(a[(S + CW_NS - 1) % CW_NS], rp, 0); if (nr < 31) { ++nr; rp += 256; } asm volatile("" : "+v"(rp)); __builtin_amdgcn_sched_barrier(0);
    { const LAS v4u* bf = bl_lane + (S >> 1) * 2048 + (S & 1) * 1024;
#pragma unroll
      for (int q_ = 0; q_ < 4; ++q_) { const int j = q_ >> 1; const f32x4 x0 = a[S][2 * q_], x1 = a[S][2 * q_ + 1];
          v4u wv; wv.x = pk2(x0.x, x0.y); wv.y = pk2(x0.z, x0.w); wv.z = pk2(x1.x, x1.y); wv.w = pk2(x1.z, x1.w);
          const bf16x8 af = __builtin_bit_cast(bf16x8, wv);
#pragma unroll
          for (int et = 0; et < 4; ++et) acc[j][et] = __builtin_amdgcn_mfma_f32_16x16x32_bf16(af, __builtin_bit_cast(bf16x8, bf[(q_ * 4 + et) * 64]), acc[j][et], 0, 0, 0); } }
    if constexpr ((S & 1) == 1) {
        LDS_WAIT(); LAS v4u* d_ = bdst + (((S >> 1) + 1) & 1) * 2048;
#pragma unroll
        for (int i = 0; i < 4; ++i) d_[i] = vb[i];
        LDS_WAIT(); asm volatile("" ::: "memory"); __builtin_amdgcn_s_barrier(); asm volatile("" ::: "memory"); }
}
__device__ __forceinline__ void compress_wg(const Ptrs& P, Frame& F, LAS unsigned char* bl  ) {
    const int lane = F.lane, w = F.wave, tid = w * 64 + lane, rho = lane & 15, kq = lane >> 4;
    const int sf = tid >> 4, ssr = sf >> 4, sj = (sf >> 3) & 1, sdh = (sf >> 2) & 1, set_ = sf & 3, sl = (tid & 15) * 4;
    const GAS v4u* bs0 = (const GAS v4u*)(P.ws + WS_BTC) + (size_t)((((sj * 32 + ssr) * 2 + sdh) * 4 + set_) * 64 + sl);
    LAS v4u* bdst = (LAS v4u*)bl + sf * 64 + sl; const LAS v4u* bl_lane = (const LAS v4u*)bl + lane;
    const float* cbias = (const float*)(P.ws + WS_CBIAS);
    for (int pass = blockIdx.x; pass < CW_NPASS; pass += F.G) {
        const int b = pass >> 3, c0 = (pass & 7) * 64 + w * 8;
        const float* rb; { const int c = c0 + (rho >> 1), g = rho & 1; const int page = P.page_table[b * NPAGES + (c >> 2)]; rb = P.cache_cmp + ((size_t)page * 128 + (c & 3) * 32) * 256 + g * 64 + 4 * kq; }
        f32x4 a[CW_NS][8]; v4u vb[4]; f32x4 acc[2][4];
#pragma unroll
        for (int i = 0; i < 4; ++i) vb[i] = bs0[i];
#pragma unroll
        for (int r = 0; r < CW_NS - 1; ++r) CW_LOAD(a[r], rb, r);
        const float* rp = rb + (CW_NS - 1) * 256; const GAS v4u* bp = bs0 + 1024; int nr = CW_NS - 1, nb = 1; asm volatile("" : "+v"(rp), "+v"(bp));
#pragma unroll
        for (int j = 0; j < 2; ++j)
#pragma unroll
            for (int e = 0; e < 4; ++e) acc[j][e] = (f32x4){0.f, 0.f, 0.f, 0.f};
        asm volatile("" ::: "memory"); __builtin_amdgcn_s_barrier(); asm volatile("" ::: "memory");
#pragma unroll
        for (int i = 0; i < 4; ++i) bdst[i] = vb[i];
        LDS_WAIT(); asm volatile("" ::: "memory"); __builtin_amdgcn_s_barrier(); asm volatile("" ::: "memory");
#pragma unroll 1
        for (int it = 0; it < 8; ++it) { cw_step<0>(a, vb, acc, rp, nr, bp, nb, bdst, bl_lane); cw_step<1>(a, vb, acc, rp, nr, bp, nb, bdst, bl_lane);
            cw_step<2>(a, vb, acc, rp, nr, bp, nb, bdst, bl_lane); cw_step<3>(a, vb, acc, rp, nr, bp, nb, bdst, bl_lane); }
        float nmax = 0.f;
#pragma unroll
        for (int i = 0; i < 4; ++i) { const int row = 4 * kq + i, c = c0 + (row >> 1), g = row & 1; float q2 = 0.f;
#pragma unroll
            for (int j = 0; j < 2; ++j)
#pragma unroll
                for (int et = 0; et < 4; ++et) { const int e = 16 * et + rho; const float val = acc[j][et][i] + cbias[j * 64 + e]; if (j == 0) q2 += val * val;
                    ((float*)(P.ws + WS_KCS))[((size_t)((b * 2 + g) * 2 + j) * NCS + c) * 64 + e] = val; }
            q2 += __shfl_xor(q2, 1); q2 += __shfl_xor(q2, 2); q2 += __shfl_xor(q2, 4); q2 += __shfl_xor(q2, 8); nmax = fmaxf(nmax, q2); }
        nmax = fmaxf(nmax, __shfl_xor(nmax, 16)); nmax = fmaxf(nmax, __shfl_xor(nmax, 32));
        if (lane == 0) atomicMax((unsigned*)(P.ws + WS_CTL) + CW_KCMAX + 64, __builtin_bit_cast(unsigned, nmax));
    }
}
struct EpiIn {
    static constexpr bool PERM = false, AFTER_DRAIN = false;
    const float *rstd, *rope, *qg, *kg; float* out; unsigned char* ws;
    __device__ __forceinline__ void operator()(const f32x4 (&acc)[2][2][4][2], const pg8::Unit& u, int wr, int wc, int fr, int fq) const {
        asm volatile("" : "+v"(fr), "+v"(fq));
        const int pn = u.pn; const int rbase = u.pm * 256 + wr * 64 + fr;
        if (pn < 8) {
            const bool bz = pn < 4; bf16* dst = (bf16*)(ws + (bz ? WS_CG : WS_U)); const int col0 = 128 * (pn & 3) + 32 * wc + 4 * fq;
#pragma unroll
            for (int ai = 0; ai < 2; ++ai)
#pragma unroll
                for (int m = 0; m < 4; ++m) { const int row = rbase + ai * 128 + m * 16; const float rs = rstd[row];
#pragma unroll
                    for (int n = 0; n < 2; ++n) { const f32x4 a = acc[ai][0][m][n] * rs, z = acc[ai][1][m][n] * rs; f32x4 o;
                        if (bz) { o.x = a.x * z.x * sigmoidf(z.x); o.y = a.y * z.y * sigmoidf(z.y); o.z = a.z * z.z * sigmoidf(z.z); o.w = a.w * z.w * sigmoidf(z.w); }
                        else o = a * z;
                        v2u w; w.x = pk2(o.x, o.y); w.y = pk2(o.z, o.w);
                        *(GAS v2u*)(dst + (size_t)row * 512 + col0 + 16 * n) = w;
                        if (!bz) { const int t = row & (T - 1); if (t >= T - 2) *(GAS f32x4*)(out + O_PCONV + ((size_t)(row >> 13) * 2 + (t - (T - 2))) * 512 + col0 + 16 * n) = o; } } }
        } else if (pn < 13) {
            const bool isq = pn < 10; const int br = pn - 10; const bool isk = !isq && wc < 2;
            if (isq || isk) {
                const float* gain = isq ? qg : kg + br * 64; float g1[2][4], g2[2][4];
#pragma unroll
                for (int n = 0; n < 2; ++n)
#pragma unroll
                    for (int e = 0; e < 4; ++e) { g1[n][e] = gain[16 * n + 4 * fq + e]; g2[n][e] = gain[32 + 16 * n + 4 * fq + e]; }
#pragma unroll
                for (int ai = 0; ai < 2; ++ai)
#pragma unroll
                    for (int m = 0; m < 4; ++m) { const int row = rbase + ai * 128 + m * 16; const float rs = rstd[row]; const int t = row & (T - 1), b = row >> 13;
                        f32x4 x1[2], x2[2]; float ss = 0.f;
#pragma unroll
                        for (int n = 0; n < 2; ++n) { x1[n] = acc[ai][0][m][n] * rs; x2[n] = acc[ai][1][m][n] * rs;
                            ss += (x1[n].x * x1[n].x + x1[n].y * x1[n].y) + (x1[n].z * x1[n].z + x1[n].w * x1[n].w) + (x2[n].x * x2[n].x + x2[n].y * x2[n].y) + (x2[n].z * x2[n].z + x2[n].w * x2[n].w); }
                        ss += __shfl_xor(ss, 16); ss += __shfl_xor(ss, 32);
                        const float inv = 1.0f / sqrtf(ss * (1.0f / 64.0f) + NORM_EPS);
                        const float* rp = rope + (size_t)t * 64 + 4 * fq;
#pragma unroll
                        for (int n = 0; n < 2; ++n) { const f32x4 cs = *(const GAS f32x4*)(rp + 16 * n), sn = *(const GAS f32x4*)(rp + 32 + 16 * n); f32x4 o1, o2;
#pragma unroll
                            for (int e = 0; e < 4; ++e) { const float a = x1[n][e] * inv * g1[n][e], c = x2[n][e] * inv * g2[n][e]; o1[e] = a * cs[e] - c * sn[e]; o2[e] = c * cs[e] + a * sn[e]; }
                            const int d1 = 16 * n + 4 * fq;
                            if (isq) { o1 = o1 * QSCALE; o2 = o2 * QSCALE; bf16* q = (bf16*)(ws + WS_Q) + (size_t)row * 512 + (4 * (pn - 8) + wc) * 64 + d1;
                                v2u w; w.x = pk2(o1.x, o1.y); w.y = pk2(o1.z, o1.w); *(GAS v2u*)q = w; w.x = pk2(o2.x, o2.y); w.y = pk2(o2.z, o2.w); *(GAS v2u*)(q + 32) = w; }
                            else { const int g = wc;
                                if (br > 0) { bf16* img = (bf16*)(ws + (br == 1 ? WS_KS : WS_KW)) + ((size_t)(b * 2 + g) * 128 + (t >> 6)) * 8192;
                                    v2u w; w.x = pk2(o1.x, o1.y); w.y = pk2(o1.z, o1.w); *(GAS v2u*)(img + kimg_off(t & 63, d1)) = w; w.x = pk2(o2.x, o2.y); w.y = pk2(o2.z, o2.w); *(GAS v2u*)(img + kimg_off(t & 63, d1 + 32)) = w; }
                                if (br < 2) { float* o = out + (br == 0 ? O_PCMP : O_PSLC) + (size_t)row * 256 + g * 64 + d1; *(GAS f32x4*)o = o1; *(GAS f32x4*)(o + 32) = o2; }
                                else if (t >= T - 512) { float* o = out + O_PWIN + ((size_t)b * 512 + (t - (T - 512))) * 256 + g * 64 + d1; *(GAS f32x4*)o = o1; *(GAS f32x4*)(o + 32) = o2; } } } }
            } else {
                const int g = wc - 2;
#pragma unroll
                for (int ai = 0; ai < 2; ++ai)
#pragma unroll
                    for (int m = 0; m < 4; ++m) { const int row = rbase + ai * 128 + m * 16; const float rs = rstd[row]; const int t = row & (T - 1), b = row >> 13;
                        const int tk = t & 63, vpos = (tk & ~15) + perm16(tk & 15);
                        bf16* vt = (br > 0) ? (bf16*)(ws + (br == 1 ? WS_KS : WS_KW)) + ((size_t)(b * 2 + g) * 128 + (t >> 6)) * 8192 : nullptr;
                        const float vsc = (br == 1) ? slc_vscale(((const float*)(ws + WS_CONST))[1]) : 1.0f;
#pragma unroll
                        for (int bj = 0; bj < 2; ++bj)
#pragma unroll
                            for (int n = 0; n < 2; ++n) { const f32x4 v = acc[ai][bj][m][n] * rs; const int d1 = 32 * bj + 16 * n + 4 * fq;
                                if (br > 0) {
#pragma unroll
                                    for (int e = 0; e < 4; ++e) vt[vimg_off(d1 + e, vpos)] = (bf16)f2bf(v[e] * vsc); }
                                if (br < 2) *(GAS f32x4*)(out + (br == 0 ? O_PCMP : O_PSLC) + (size_t)row * 256 + 128 + g * 64 + d1) = v;
                                else if (t >= T - 512) *(GAS f32x4*)(out + O_PWIN + ((size_t)b * 512 + (t - (T - 512))) * 256 + 128 + g * 64 + d1) = v; } }
            }
        } else if (pn < 15) {
            bf16* dst = (bf16*)(ws + WS_ZA);
#pragma unroll
            for (int ai = 0; ai < 2; ++ai)
#pragma unroll
                for (int m = 0; m < 4; ++m) { const int row = rbase + ai * 128 + m * 16; const float rs = rstd[row];
#pragma unroll
                    for (int bj = 0; bj < 2; ++bj)
#pragma unroll
                        for (int n = 0; n < 2; ++n) { const f32x4 z = acc[ai][bj][m][n] * rs; v2u w; w.x = pk2(z.x * sigmoidf(z.x), z.y * sigmoidf(z.y)); w.y = pk2(z.z * sigmoidf(z.z), z.w * sigmoidf(z.w));
                            *(GAS v2u*)(dst + (size_t)row * 512 + 256 * (pn - 13) + 128 * bj + 32 * wc + 16 * n + 4 * fq) = w; } }
        } else {
            if (wc == 0) { float* dst = (float*)(ws + WS_GATE);
#pragma unroll
                for (int ai = 0; ai < 2; ++ai)
#pragma unroll
                    for (int m = 0; m < 4; ++m) { const int row = rbase + ai * 128 + m * 16; const float rs = rstd[row];
#pragma unroll
                        for (int n = 0; n < 2; ++n) { const int c0 = 16 * n + 4 * fq; if (c0 < 24) { const f32x4 z = acc[ai][0][m][n] * rs;
                            *(GAS f32x4*)(dst + (size_t)row * 24 + c0) = (f32x4){sigmoidf(z.x), sigmoidf(z.y), sigmoidf(z.z), sigmoidf(z.w)}; } } } }
        }
    }
};
struct EpiOut {
    static constexpr bool PERM = false, AFTER_DRAIN = false;
    const bf16* x; float* y;
    __device__ __forceinline__ void operator()(const f32x4 (&acc)[2][2][4][2], const pg8::Unit& u, int wr, int wc, int fr, int fq) const {
        asm volatile("" : "+v"(fr), "+v"(fq));
#pragma unroll
        for (int ai = 0; ai < 2; ++ai)
#pragma unroll
            for (int m = 0; m < 4; ++m) { const size_t row = (size_t)u.pm * 256 + ai * 128 + wr * 64 + m * 16 + fr;
#pragma unroll
                for (int bj = 0; bj < 2; ++bj)
#pragma unroll
                    for (int n = 0; n < 2; ++n) { const size_t off = row * D + u.pn * 256 + 128 * bj + 32 * wc + 16 * n + 4 * fq;
                        const v2u xv = *(const GAS v2u*)(x + off);
                        *(GAS f32x4*)(y + off) = (f32x4){bf2f(xv.x & 0xffffu), bf2f(xv.x >> 16), bf2f(xv.y & 0xffffu), bf2f(xv.y >> 16)} + acc[ai][bj][m][n]; } }
    }
};
template <int MODE>
__device__ __forceinline__ void small_gemm_tile(const Ptrs& P, const bf16* A, const bf16* Bt, int ct, int lane) {
    const int rho = lane & 15, kq = lane >> 4;
    f32x4 acc[2] = {(f32x4){0.f, 0.f, 0.f, 0.f}, (f32x4){0.f, 0.f, 0.f, 0.f}};
    const GAS v4u* a0 = (const GAS v4u*)(A + (size_t)rho * D + 8 * kq); const GAS v4u* a1 = (const GAS v4u*)(A + (size_t)(16 + rho) * D + 8 * kq);
    const GAS v4u* bp = (const GAS v4u*)(Bt + (size_t)(16 * ct + rho) * D + 8 * kq);
#pragma unroll 8
    for (int ks = 0; ks < 32; ++ks) { const bf16x8 bb = __builtin_bit_cast(bf16x8, bp[ks * 4]);
        acc[0] = __builtin_amdgcn_mfma_f32_16x16x32_bf16(bb, __builtin_bit_cast(bf16x8, a0[ks * 4]), acc[0], 0, 0, 0);
        acc[1] = __builtin_amdgcn_mfma_f32_16x16x32_bf16(bb, __builtin_bit_cast(bf16x8, a1[ks * 4]), acc[1], 0, 0, 0); }
#pragma unroll
    for (int rt = 0; rt < 2; ++rt) { const int b = 16 * rt + rho; const int col = 16 * ct + 4 * kq;
        if (MODE == 0) { const float rs = ((const float*)(P.ws + WS_RSTDS))[b]; *(GAS f32x4*)((float*)(P.ws + WS_PROJS) + (size_t)b * NP + col) = acc[rt] * rs; }
        else *(GAS f32x4*)(P.out + O_YS + (size_t)b * D + col) = *(const GAS f32x4*)(P.xs + (size_t)b * D + col) + acc[rt]; }
}
__device__ __forceinline__ int projs_col(int pn, int wc, int d) { return 256 * pn + 128 * (d >> 5) + 32 * wc + (d & 31); }
__device__ __forceinline__ void p2_sample_item(const Ptrs& P, int it, int lane) {
    const int b = it / 37, ty = it - b * 37;
    const float* pr = (const float*)(P.ws + WS_PROJS) + (size_t)b * NP;
    const float* ropes = (const float*)(P.ws + WS_ROPE) + (size_t)8192 * 64;
    float* kvn = (float*)(P.ws + WS_KVN) + (size_t)b * 768;
    if (ty < 14) {
        const bool isq = ty < 8; const int br = isq ? 0 : (ty - 8) >> 1, g = (ty - 8) & 1;
        const int pn = isq ? 8 + (ty >> 2) : 10 + br, wc = isq ? (ty & 3) : g;
        const float v = pr[projs_col(pn, wc, lane)];
        const float ss = wave_sum(v * v); const float inv = 1.0f / sqrtf(ss * (1.0f / 64.0f) + NORM_EPS);
        const float gn = isq ? P.q_gain[lane] : P.k_gain[br * 64 + lane];
        const float xn = v * inv * gn; const float xo = __shfl_xor(xn, 32);
        const int i = lane & 31; const float cs = ropes[i], sn = ropes[32 + i];
        const float o = (lane < 32) ? xn * cs - xo * sn : xn * cs + xo * sn;
        if (isq) ((float*)(P.ws + WS_QS))[(size_t)b * 512 + ty * 64 + lane] = o * QSCALE;
        else { kvn[(br * 2 + 0) * 128 + g * 64 + lane] = o;
            if (br == 0) P.out[O_SCMP + (size_t)b * 256 + g * 64 + lane] = o; else if (br == 1) P.out[O_SSLC + (size_t)b * 256 + g * 64 + lane] = o;
            else P.out[O_SWIN + ((size_t)b * 512 + 511) * 256 + g * 64 + lane] = o; }
    } else if (ty < 20) {
        const int br = (ty - 14) >> 1, g = (ty - 14) & 1; const float v = pr[projs_col(10 + br, 2 + g, lane)];
        kvn[(br * 2 + 1) * 128 + g * 64 + lane] = v;
        if (br == 0) P.out[O_SCMP + (size_t)b * 256 + 128 + g * 64 + lane] = v; else if (br == 1) P.out[O_SSLC + (size_t)b * 256 + 128 + g * 64 + lane] = v;
        else P.out[O_SWIN + ((size_t)b * 512 + 511) * 256 + 128 + g * 64 + lane] = v;
    } else if (ty == 20) {
        if (lane < 24) ((float*)(P.ws + WS_GS))[b * 24 + lane] = sigmoidf(pr[256 * 15 + lane]);
    } else if (ty < 29) {
        const int ch = (ty - 21) * 64 + lane; const int pnb = ch >> 7, tc = ch & 127;
        const float bg = pr[256 * pnb + tc], zc = pr[256 * pnb + 128 + tc], cg = pr[256 * (4 + pnb) + tc], ci = pr[256 * (4 + pnb) + 128 + tc];
        const float u = cg * ci; const float s0 = P.st_conv[(size_t)b * 1024 + ch], s1 = P.st_conv[(size_t)b * 1024 + 512 + ch];
        const float cy = P.conv_w[ch] * s0 + P.conv_w[512 + ch] * s1 + P.conv_w[1024 + ch] * u + P.conv_b[ch];
        ((bf16*)(P.ws + WS_MIXS))[(size_t)b * 1024 + ch] = (bf16)f2bf(bg * cy * zc * sigmoidf(zc));
        P.out[O_SCONV + (size_t)b * 1024 + 512 + ch] = u;
    } else {
        const int col = (ty - 29) * 64 + lane; const float z = pr[256 * (13 + (col >> 8)) + (col & 255)];
        ((float*)(P.ws + WS_ZAS))[(size_t)b * 512 + col] = z * sigmoidf(z);
    }
}
__device__ __forceinline__ void p2_phase(const Ptrs& P, Frame& F) {
    compress_prompt_units(P, F, (LAS float*)(F.lds + RING_OFF), [&]() { for (int it = F.gw; it < DECB * 37; it += F.NGW) p2_sample_item(P, it, F.lane); });
    if ((int)blockIdx.x >= BATCH * 64) for (int it = F.gw; it < DECB * 37; it += F.NGW) p2_sample_item(P, it, F.lane);
}
#define MFMA32(a, b, c) __builtin_amdgcn_mfma_f32_32x32x16_bf16(a, b, c, 0, 0, 0)
constexpr int P3_IMP = 0, P3_QL = 32768;
constexpr int P3_NEXT = LDSCTL_OFF + 512, P3_CNT = LDSCTL_OFF + 1024, P3_LISTS = LDSCTL_OFF + 2048, P3_LACC = LDSCTL_OFF + 10240;
constexpr int P3_RING = 65536;
constexpr int P3_MISC = MISC_OFF + 64;
constexpr int SM_Q = 36864, SM_P = 40960, SM_RED = 57344, SM_IMP = 66048, SM_L = 67200, SM_SEL = 67328, SM_O = 67584, SM_VP = 71680  , SM_RED2 = 79872  ;

template <bool MASK>
__device__ __forceinline__ void attend_lds(const LAS unsigned char* blk, const bf16x8 (&qf)[4], f32x16 (&O)[2], float& lsum,
                                           int kbase, int lo, int hi, int lane, bool want_pv, f32x16 (*Sout)[2] = nullptr) {
    const int hh = lane >> 5;
    const LAS unsigned char* kb = blk + lane * 16; const LAS unsigned char* vb = blk + 8192 + lane * 16;
#pragma unroll
    for (int kt = 0; kt < 2; ++kt) {
        f32x16 S;
        { bf16x8 kf[4];
#pragma unroll
          for (int s = 0; s < 4; ++s) kf[s] = *(const LAS bf16x8*)(kb + (kt * 4 + s) * 1024);
#pragma unroll
          for (int i = 0; i < 16; ++i) S[i] = 0.f;
#pragma unroll
          for (int s = 0; s < 4; ++s) S = MFMA32(kf[s], qf[s], S); }
#pragma unroll
        for (int i = 0; i < 16; ++i) { float p = fast_exp2(S[i]);
            if (MASK) { const int kp = kbase + 32 * kt + (i & 3) + 8 * (i >> 2) + 4 * hh; p = (kp >= lo && kp <= hi) ? p : 0.f; }
            S[i] = p; lsum += p; }
        if (Sout) (*Sout)[kt] = S;
        if (want_pv) {
            bf16x8 pf[2];
#pragma unroll
            for (int sp = 0; sp < 2; ++sp) { v4u w; w.x = pk2(S[8 * sp + 0], S[8 * sp + 1]); w.y = pk2(S[8 * sp + 2], S[8 * sp + 3]);
                w.z = pk2(S[8 * sp + 4], S[8 * sp + 5]); w.w = pk2(S[8 * sp + 6], S[8 * sp + 7]); pf[sp] = __builtin_bit_cast(bf16x8, w); }
#pragma unroll
            for (int dt = 0; dt < 2; ++dt)
#pragma unroll
                for (int sp = 0; sp < 2; ++sp) { const bf16x8 vf = *(const LAS bf16x8*)(vb + (dt * 4 + 2 * kt + sp) * 1024);
                    O[dt] = MFMA32(vf, pf[sp], O[dt]); }
        }
    }
}
__device__ __forceinline__ void wave_topk(const LAS float* imp, int jmax, int nsel, int lane, int qbase, LAS unsigned* cnt, LAS unsigned char* lists) {
    if (jmax < 1) return;
    const bool c0 = lane >= 1 && lane <= jmax, c1 = 64 + lane <= jmax;
    unsigned k0[8], k1[8], Tv[8];
#pragma unroll
    for (int qi = 0; qi < 8; ++qi) { k0[qi] = c0 ? ((__builtin_bit_cast(unsigned, imp[qi * 128 + lane]) + 0x800u) & ~0x7ffu) : 0u; k1[qi] = c1 ? ((__builtin_bit_cast(unsigned, imp[qi * 128 + 64 + lane]) + 0x800u) & ~0x7ffu) : 0u; Tv[qi] = 0u; }
    if (jmax > nsel) {
        for (int bit = 30; bit >= 11; --bit) {
#pragma unroll
            for (int qi = 0; qi < 8; ++qi) { const unsigned cand = Tv[qi] | (1u << bit);
                const int cn = __popcll(__ballot(k0[qi] >= cand)) + __popcll(__ballot(k1[qi] >= cand)); Tv[qi] = cn >= nsel ? cand : Tv[qi]; } }
    }
    const unsigned long long below = (lane == 0) ? 0ull : (~0ull >> (64 - lane));
    bool s0[8], s1[8]; unsigned p0[8], p1[8];
#pragma unroll
    for (int qi = 0; qi < 8; ++qi) {
        if (jmax > nsel) {
            const unsigned long long g0 = __ballot(k0[qi] > Tv[qi]), g1 = __ballot(k1[qi] > Tv[qi]), e0 = __ballot(k0[qi] == Tv[qi]), e1 = __ballot(k1[qi] == Tv[qi]);
            const int need = nsel - __popcll(g0) - __popcll(g1);
            const int rk0 = __popcll(e0 & below), rk1 = __popcll(e0) + __popcll(e1 & below);
            s0[qi] = k0[qi] > Tv[qi] || (k0[qi] == Tv[qi] && rk0 < need); s1[qi] = k1[qi] > Tv[qi] || (k1[qi] == Tv[qi] && rk1 < need);
        } else { s0[qi] = c0; s1[qi] = c1; }
    }
#pragma unroll
    for (int qi = 0; qi < 8; ++qi) { p0[qi] = 0u; p1[qi] = 0u;
        if (s0[qi]) p0[qi] = __hip_atomic_fetch_add(cnt + lane, 1u, __ATOMIC_RELAXED, __HIP_MEMORY_SCOPE_WORKGROUP);
        if (s1[qi]) p1[qi] = __hip_atomic_fetch_add(cnt + 64 + lane, 1u, __ATOMIC_RELAXED, __HIP_MEMORY_SCOPE_WORKGROUP); }
#pragma unroll
    for (int qi = 0; qi < 8; ++qi) {
        if (s0[qi]) lists[lane * 64 + p0[qi]] = (unsigned char)(qbase + qi);
        if (s1[qi]) lists[(64 + lane) * 64 + p1[qi]] = (unsigned char)(qbase + qi); }
}
struct BlkSrc { const bf16* img; };
#ifndef PROBE_SEG
#define PROBE_SEG 0
#endif
#define T_BEGIN(id) do { if (PROBE_SEG == (id)) tacc -= __builtin_readcyclecounter(); } while (0)
#define T_END(id) do { if (PROBE_SEG == (id)) tacc += __builtin_readcyclecounter(); } while (0)
__device__ __forceinline__ void p3_prompt_unit(const Ptrs& P, Frame& F, int b, int t, int g, float sh_cmp, float sh_slc, float sh_win, unsigned long long& tacc) {
    int lane = F.lane, w = F.wave, tid = F.tid; asm volatile("" : "+v"(lane), "+s"(w), "+v"(tid));
    const int col = lane & 31, hh = lane >> 5, qi = col >> 2, h = col & 3;
    const int tok = 64 * t + 8 * w + qi; const size_t row = (size_t)b * T + tok; const int qpos = tok;
    const int nck = (2 * t + 2 + 63) >> 6, nf = t >= 2 ? 3 : t + 1, nw = t >= 8 ? 9 : t + 1;
    const int n1 = nck, n2 = 2 * nck, n3 = n2 + nw, N1 = n3 + nf, wbase = t >= 8 ? t - 8 : 0;
    const bf16* KC = (const bf16*)(P.ws + WS_KC) + (size_t)(b * 2 + g) * 4 * 8192;
    const bf16* KS = (const bf16*)(P.ws + WS_KS) + (size_t)(b * 2 + g) * 128 * 8192;
    const bf16* KW = (const bf16*)(P.ws + WS_KW) + (size_t)(b * 2 + g) * 128 * 8192;
    auto src1 = [&](int n) -> BlkSrc {
        if (n < n2) { const int ck = n < n1 ? n : n - n1; return BlkSrc{KC + (size_t)ck * 8192}; }
        if (n < n3) return BlkSrc{KW + (size_t)(wbase + n - n2) * 8192};
        const int f = n - n3; const int j = f == 0 ? t : (f == 1 ? 0 : t - 1); return BlkSrc{KS + (size_t)j * 8192}; };
    LAS unsigned char* ring = F.lds + P3_RING;
#define ST_DMA(bs_, n) do { LAS unsigned char* d_ = ring + ((n) & 3) * 16384 + w * 2048; \
        __builtin_amdgcn_global_load_lds((const unsigned*)((bs_).img + (2 * w) * 512 + lane * 8), (LAS unsigned*)d_, 16, 0, 0); \
        __builtin_amdgcn_global_load_lds((const unsigned*)((bs_).img + (2 * w + 1) * 512 + lane * 8), (LAS unsigned*)(d_ + 1024), 16, 0, 0); } while (0)
#define BLK(n) (ring + ((n) & 3) * 16384)
#define STEP_BEGIN(SRC, n, NN) do { if (((n) & 1) == 0) { if ((n) + 2 < (NN)) { const BlkSrc b_ = SRC((n) + 2); ST_DMA(b_, (n) + 2); } if ((n) + 3 < (NN)) { const BlkSrc b_ = SRC((n) + 3); ST_DMA(b_, (n) + 3); } } } while (0)
#define STEP_END(n, NN) do { if (((n) & 1) == 1 || (n) == (NN) - 1) { asm volatile("s_waitcnt vmcnt(0)" ::: "memory"); __syncthreads(); } } while (0)
    LAS unsigned* cnt = (LAS unsigned*)(F.lds + P3_CNT); LAS unsigned char* lists = F.lds + P3_LISTS; LAS unsigned* nextb = (LAS unsigned*)(F.lds + P3_NEXT);
    LAS int* oacc = (LAS int*)ring; LAS int* lacc = (LAS int*)(F.lds + P3_LACC);
    const float FXS = slc_vscale(sh_slc), FXI = 1.0f / FXS;
    LAS unsigned char* ql = F.lds + P3_QL;
    T_BEGIN(1); T_BEGIN(8);
    __syncthreads();
    if (tid < 128) cnt[tid] = 0u; if (tid == 128) nextb[0] = 0u;
    { const BlkSrc b0 = src1(0); ST_DMA(b0, 0); if (N1 > 1) { const BlkSrc b1 = src1(1); ST_DMA(b1, 1); } }
    { const bf16* qg = (const bf16*)(P.ws + WS_Q) + ((size_t)b * T + 64 * t) * 512 + g * 256;
      v4u tq[4];
#pragma unroll
      for (int k = 0; k < 4; ++k) { const int c = tid + 512 * k, rq = c >> 3, ch = c & 7; tq[k] = *(const GAS v4u*)(qg + (size_t)(rq >> 2) * 512 + (rq & 3) * 64 + ch * 8); }
#pragma unroll
      for (int k = 0; k < 4; ++k) { const int c = tid + 512 * k, rq = c >> 3, ch = c & 7; *(LAS v4u*)(ql + rq * 128 + ((ch ^ ((rq >> 1) & 7)) << 4)) = tq[k]; } }
    bf16x8 qf[4];
    { const bf16* q = (const bf16*)(P.ws + WS_Q) + row * 512 + (g * 4 + h) * 64 + 8 * hh;
#pragma unroll
      for (int s = 0; s < 4; ++s) qf[s] = __builtin_bit_cast(bf16x8, *(const GAS v4u*)(q + 16 * s)); }
    const float* gate = (const float*)(P.ws + WS_GATE) + row * 24 + (g * 4 + h) * 3;
    const float g_cmp = gate[0], g_slc = gate[1], g_win = gate[2];
    asm volatile("s_waitcnt vmcnt(0)" ::: "memory"); __syncthreads();
    T_END(1); T_BEGIN(2);
    f32x16 O[2];
    LAS float* wl = (LAS float*)(F.lds + P3_IMP + w * 4096);
    LAS float* xw0 = (LAS float*)(F.lds + P3_IMP + w * 4096) + lane;
    f32x16 totr;
    const int nvis = (qpos + 1) >> 5;
    int n = 0;
    float lsum = 0.f;
    for (; n < n1; ++n) { STEP_BEGIN(src1, n, N1); attend_lds<true>(BLK(n), qf, O, lsum, 64 * n, 0, nvis - 1, lane, false); STEP_END(n, N1); }
    lsum += __shfl_xor(lsum, 32);
    const float rl = lsum > 0.f ? 1.0f / lsum : 0.f;
    for (int i = lane; i < 1024; i += 64) wl[i] = 0.f;
#pragma unroll
    for (int i = 0; i < 16; ++i) { O[0][i] = 0.f; O[1][i] = 0.f; }
    { float dummy = 0.f;
      for (; n < n2; ++n) { STEP_BEGIN(src1, n, N1); const int ck = n - n1; f32x16 Sn[2];
        attend_lds<true>(BLK(n), qf, O, dummy, 64 * ck, 0, nvis - 1, lane, true, &Sn);
#pragma unroll
        for (int kt = 0; kt < 2; ++kt)
#pragma unroll
            for (int i2 = 0; i2 < 8; ++i2) { const float v = quad_sum((Sn[kt][2 * i2] + Sn[kt][2 * i2 + 1]) * rl);
                if (h == 0) wl[qi * 128 + 32 * ck + 16 * kt + (i2 & 1) + 4 * (i2 >> 1) + 2 * hh] = v; }
        STEP_END(n, N1); } }
    LDS_WAIT(); asm volatile("" ::: "memory");
    T_END(2); T_BEGIN(3);
    wave_topk(wl, t - 2, 13, lane, 8 * w, cnt, lists);
    LDS_WAIT(); asm volatile("" ::: "memory");
#pragma unroll
    for (int i = 0; i < 16; ++i) { xw0[i * 64] = O[0][i] * (g_cmp * rl); totr[i] = O[1][i] * (g_cmp * rl); O[0][i] = 0.f; O[1][i] = 0.f; }
    T_END(3); T_BEGIN(6);
    lsum = 0.f;
    for (; n < n3; ++n) { STEP_BEGIN(src1, n, N1); const int j = wbase + n - n2;
        if (j == t || j + 8 == t) attend_lds<true>(BLK(n), qf, O, lsum, 64 * j, qpos - 511, qpos, lane, true);
        else attend_lds<false>(BLK(n), qf, O, lsum, 0, 0, 0, lane, true);
        STEP_END(n, N1); }
    lsum += __shfl_xor(lsum, 32);
    { const float sc = g_win / fmaxf(lsum, 1e-30f);
#pragma unroll
      for (int i = 0; i < 16; ++i) { xw0[i * 64] = xw0[i * 64] + O[0][i] * sc; totr[i] += O[1][i] * sc; O[0][i] = 0.f; O[1][i] = 0.f; } }
    T_END(6); T_BEGIN(4);
    lsum = 0.f;
    for (; n < N1; ++n) { STEP_BEGIN(src1, n, N1);
        if (n == n3) attend_lds<true>(BLK(n), qf, O, lsum, 64 * t, 0, qpos, lane, true);
        else attend_lds<false>(BLK(n), qf, O, lsum, 0, 0, 0, lane, true);
        STEP_END(n, N1); }
    lsum += __shfl_xor(lsum, 32);
#pragma unroll
    for (int dt = 0; dt < 2; ++dt)
#pragma unroll
        for (int i = 0; i < 16; ++i) oacc[(32 * dt + (i & 3) + 8 * (i >> 2) + 4 * hh) * 256 + 32 * w + col] = (int)O[dt][i];
    if (hh == 0) lacc[32 * w + col] = __float2int_rn(lsum * FXS);
    __syncthreads();
    T_END(4); T_BEGIN(5);
    if (t > 2) {
        const int r = lane & 31;
#define NEXT_BLOCK(jv_, nq_) do { for (;;) { unsigned t_ = 0u; if (lane == 0) t_ = __hip_atomic_fetch_add(nextb, 1u, __ATOMIC_RELAXED, __HIP_MEMORY_SCOPE_WORKGROUP); \
            jv_ = 1 + (int)__builtin_amdgcn_readfirstlane(t_); if (jv_ > t - 2) { nq_ = 0; break; } nq_ = (int)__builtin_amdgcn_readfirstlane(cnt[jv_]); if (nq_ > 0) break; } } while (0)
#define LOAD_K(kd_, jv_) do { const bf16* im_ = KS + (size_t)(jv_) * 8192 + lane * 8;     \
            _Pragma("unroll") for (int a_ = 0; a_ < 2; ++a_) _Pragma("unroll") for (int b_ = 0; b_ < 4; ++b_) kd_[a_][b_] = __builtin_bit_cast(bf16x8, *(const GAS v4u*)(im_ + (a_ * 4 + b_) * 512)); } while (0)
#define LOAD_V(vd_, jv_) do { const bf16* im_ = KS + (size_t)(jv_) * 8192 + 4096 + lane * 8; \
            _Pragma("unroll") for (int a_ = 0; a_ < 2; ++a_) _Pragma("unroll") for (int b_ = 0; b_ < 4; ++b_) vd_[a_][b_] = __builtin_bit_cast(bf16x8, *(const GAS v4u*)(im_ + (a_ * 4 + b_) * 512)); } while (0)
        bf16x8 kf[2][4], vf[2][4], kn[2][4];
        int j, nq; T_BEGIN(10); NEXT_BLOCK(j, nq); if (j <= t - 2) LOAD_K(kf, j); T_END(10);
        while (j <= t - 2) {
            T_BEGIN(10); LOAD_V(vf, j);
            int jn, nqn; NEXT_BLOCK(jn, nqn); LOAD_K(kn, (jn <= t - 2 ? jn : t - 2));
#pragma unroll
            for (int a_ = 0; a_ < 2; ++a_)
#pragma unroll
                for (int b_ = 0; b_ < 4; ++b_) asm volatile("" : "+v"(kf[a_][b_])); T_END(10);
            for (int c0 = 0; c0 < nq; c0 += 8) { T_BEGIN(11);
                const int sl = c0 + qi; const bool valid = sl < nq;
                const int rowq = (int)lists[j * 64 + (valid ? sl : nq - 1)] * 4 + h;
                const LAS unsigned char* qp = ql + rowq * 128; const int qsw = (rowq >> 1) & 7;
                bf16x8 q2[4];
#pragma unroll
                for (int s = 0; s < 4; ++s) q2[s] = *(const LAS bf16x8*)(qp + (((2 * s + hh) ^ qsw) << 4));
                float l2 = 0.f; bf16x8 pf[4]; f32x16 S0, S1;
#pragma unroll
                for (int i = 0; i < 16; ++i) { S0[i] = 0.f; S1[i] = 0.f; }
#pragma unroll
                for (int s = 0; s < 4; ++s) { S0 = MFMA32(kf[0][s], q2[s], S0); S1 = MFMA32(kf[1][s], q2[s], S1); }
#pragma unroll
                for (int i = 0; i < 16; ++i) { S0[i] = fast_exp2(S0[i]); l2 += S0[i]; }
#pragma unroll
                for (int sp = 0; sp < 2; ++sp) { v4u wv; wv.x = pk2(S0[8 * sp + 0], S0[8 * sp + 1]); wv.y = pk2(S0[8 * sp + 2], S0[8 * sp + 3]);
                    wv.z = pk2(S0[8 * sp + 4], S0[8 * sp + 5]); wv.w = pk2(S0[8 * sp + 6], S0[8 * sp + 7]); pf[sp] = __builtin_bit_cast(bf16x8, wv); }
#pragma unroll
                for (int i = 0; i < 16; ++i) { S1[i] = fast_exp2(S1[i]); l2 += S1[i]; }
#pragma unroll
                for (int sp = 0; sp < 2; ++sp) { v4u wv; wv.x = pk2(S1[8 * sp + 0], S1[8 * sp + 1]); wv.y = pk2(S1[8 * sp + 2], S1[8 * sp + 3]);
                    wv.z = pk2(S1[8 * sp + 4], S1[8 * sp + 5]); wv.w = pk2(S1[8 * sp + 6], S1[8 * sp + 7]); pf[2 + sp] = __builtin_bit_cast(bf16x8, wv); }
                T_END(11); T_BEGIN(9);
                __builtin_amdgcn_sched_barrier(0);
#pragma unroll
                for (int a_ = 0; a_ < 2; ++a_)
#pragma unroll
                    for (int b_ = 0; b_ < 4; ++b_) asm volatile("" : "+v"(vf[a_][b_]));
#pragma unroll
                for (int dt = 0; dt < 2; ++dt) { f32x16 O2;
#pragma unroll
                    for (int i = 0; i < 16; ++i) O2[i] = 0.f;
#pragma unroll
                    for (int ks = 0; ks < 4; ++ks) O2 = MFMA32(vf[dt][ks], pf[ks], O2);
                    if (valid) {
#pragma unroll
                        for (int i = 0; i < 16; ++i) (void)__hip_atomic_fetch_add(oacc + (32 * dt + (i & 3) + 8 * (i >> 2) + 4 * hh) * 256 + rowq, (int)O2[i], __ATOMIC_RELAXED, __HIP_MEMORY_SCOPE_WORKGROUP); } }
                if (valid) {
                    (void)__hip_atomic_fetch_add(lacc + rowq, __float2int_rn(l2 * FXS), __ATOMIC_RELAXED, __HIP_MEMORY_SCOPE_WORKGROUP); }
                if (PROBE_SEG == 9) LDS_WAIT(); T_END(9);
            }
#pragma unroll
            for (int a_ = 0; a_ < 2; ++a_)
#pragma unroll
                for (int b_ = 0; b_ < 4; ++b_) kf[a_][b_] = kn[a_][b_];
            j = jn; nq = nqn;
        }
#undef NEXT_BLOCK
#undef LOAD_K
#undef LOAD_V
    }
    __syncthreads();
    T_END(5);
    { const float sc = g_slc / fmaxf((float)lacc[32 * w + col] * FXI, 1e-30f);
#pragma unroll
      for (int i = 0; i < 16; ++i) { const int dr = (i & 3) + 8 * (i >> 2) + 4 * hh;
          O[0][i] = xw0[i * 64] + (float)oacc[dr * 256 + 32 * w + col] * (FXI * sc); O[1][i] = totr[i] + (float)oacc[(32 + dr) * 256 + 32 * w + col] * (FXI * sc); } }
#undef ST_DMA
#undef BLK
#undef STEP_BEGIN
#undef STEP_END
    T_BEGIN(7);
    asm volatile("" : "+v"(lane));
    const int col_ = lane & 31, hh_ = lane >> 5, h_ = col_ & 3; const size_t row_ = (size_t)b * T + 64 * t + 8 * w + (col_ >> 2);
    const bf16* za = (const bf16*)(P.ws + WS_ZA) + row_ * 512 + (g * 4 + h_) * 64; bf16* mx = (bf16*)(P.ws + WS_MIX) + row_ * 1024 + 512 + (g * 4 + h_) * 64;
#pragma unroll
    for (int dt = 0; dt < 2; ++dt)
#pragma unroll
        for (int i4 = 0; i4 < 4; ++i4) { const int d = 32 * dt + 8 * i4 + 4 * hh_; const v2u z = *(const GAS v2u*)(za + d);
            v2u o; o.x = pk2(O[dt][4 * i4] * bf2f(z.x & 0xffffu), O[dt][4 * i4 + 1] * bf2f(z.x >> 16)); o.y = pk2(O[dt][4 * i4 + 2] * bf2f(z.y & 0xffffu), O[dt][4 * i4 + 3] * bf2f(z.y >> 16));
            *(GAS v2u*)(mx + d) = o; }
    if (g == 0) { const int tq = w, c8 = lane * 8; const size_t r0 = (size_t)b * T + 64 * t + 8 * tq;
        const bf16* U = (const bf16*)(P.ws + WS_U) + c8; const bf16* CGp = (const bf16*)(P.ws + WS_CG) + c8; bf16* mo = (bf16*)(P.ws + WS_MIX) + c8;
        v4u ur[10], cr[8];
        const bool has_prev = (t > 0) || (tq > 0);
#pragma unroll
        for (int i = 0; i < 10; ++i) ur[i] = (i >= 2 || has_prev) ? *(const GAS v4u*)(U + (r0 + i - 2) * 512) : (v4u){0u, 0u, 0u, 0u};
#pragma unroll
        for (int i = 0; i < 8; ++i) cr[i] = *(const GAS v4u*)(CGp + (r0 + i) * 512);
        float w0[8], w1[8], w2[8], cb[8];
#pragma unroll
        for (int e = 0; e < 8; ++e) { w0[e] = P.conv_w[c8 + e]; w1[e] = P.conv_w[512 + c8 + e]; w2[e] = P.conv_w[1024 + c8 + e]; cb[e] = P.conv_b[c8 + e]; }
#pragma unroll
        for (int i = 0; i < 8; ++i) { float o[8];
#pragma unroll
            for (int e = 0; e < 8; ++e) { const int sh_ = (e & 1) * 16; const float a = bf2f((ur[i][e >> 1] >> sh_) & 0xffffu), bb = bf2f((ur[i + 1][e >> 1] >> sh_) & 0xffffu), c = bf2f((ur[i + 2][e >> 1] >> sh_) & 0xffffu);
                o[e] = bf2f((cr[i][e >> 1] >> sh_) & 0xffffu) * (w0[e] * a + w1[e] * bb + w2[e] * c + cb[e]); }
            v4u ov; ov.x = pk2(o[0], o[1]); ov.y = pk2(o[2], o[3]); ov.z = pk2(o[4], o[5]); ov.w = pk2(o[6], o[7]);
            *(GAS v4u*)(mo + (r0 + i) * 1024) = ov; } }
    T_END(7); T_END(8);
}
template <class KeyFn>
__device__ __forceinline__ void sample_branch(Frame& F, int nslots, float shift, const KeyFn& key, LAS float* obr) {
    LAS float* q = (LAS float*)(F.lds + SM_Q); LAS float* Pb = (LAS float*)(F.lds + SM_P); LAS float* red = (LAS float*)(F.lds + SM_RED); LAS float* lsm = (LAS float*)(F.lds + SM_L);
    LAS unsigned long long* vptr = (LAS unsigned long long*)(F.lds + SM_VP);
    float lacc[4] = {0.f, 0.f, 0.f, 0.f};
    for (int s = F.tid; s < nslots; s += 512) { const float* kp; const float* vp; const bool valid = key(s, kp, vp);
        float sc[4] = {0.f, 0.f, 0.f, 0.f};
        if (valid) {
#pragma unroll 8
            for (int d4 = 0; d4 < 16; ++d4) { const f32x4 kv = *(const GAS f32x4*)(kp + 4 * d4);
#pragma unroll
                for (int hq = 0; hq < 4; ++hq) { const f32x4 qv = *(const LAS f32x4*)(q + hq * 64 + 4 * d4); sc[hq] += (kv.x * qv.x + kv.y * qv.y) + (kv.z * qv.z + kv.w * qv.w); } } }
        f32x4 p;
#pragma unroll
        for (int hq = 0; hq < 4; ++hq) { p[hq] = valid ? fast_exp2(sc[hq] - shift) : 0.f; lacc[hq] += p[hq]; }
        *(LAS f32x4*)(Pb + 4 * s) = p; vptr[s] = (unsigned long long)(uintptr_t)vp; }
#pragma unroll
    for (int hq = 0; hq < 4; ++hq) { lacc[hq] = wave_sum(lacc[hq]); if (F.lane == 0) red[F.wave * 4 + hq] = lacc[hq]; }
    __syncthreads();
    if (F.tid < 4) { float s = 0.f; for (int ww = 0; ww < 8; ++ww) s += red[ww * 4 + F.tid]; lsm[F.tid] = s; }
    const int sg = F.tid >> 4, d4 = F.tid & 15;
    f32x4 oa[4];
#pragma unroll
    for (int hq = 0; hq < 4; ++hq) oa[hq] = (f32x4){0.f, 0.f, 0.f, 0.f};
    for (int s0 = sg; s0 < nslots; s0 += 256) {
        f32x4 vv[8], pp[8];
#pragma unroll
        for (int u = 0; u < 8; ++u) { const int s = s0 + 32 * u; const float* vp = (const float*)(uintptr_t)vptr[s]; vv[u] = *(const GAS f32x4*)(vp + 4 * d4); pp[u] = *(const LAS f32x4*)(Pb + 4 * s); }
#pragma unroll
        for (int u = 0; u < 8; ++u) { oa[0] = oa[0] + vv[u] * pp[u].x; oa[1] = oa[1] + vv[u] * pp[u].y; oa[2] = oa[2] + vv[u] * pp[u].z; oa[3] = oa[3] + vv[u] * pp[u].w; } }
    __syncthreads();
    LAS float* red2 = (LAS float*)(F.lds + SM_RED2);
#pragma unroll
    for (int hq = 0; hq < 4; ++hq) *(LAS f32x4*)(red2 + (sg * 4 + hq) * 64 + 4 * d4) = oa[hq];
    __syncthreads();
    if (F.tid < 256) { float s = 0.f;
#pragma unroll 8
        for (int g2 = 0; g2 < 32; ++g2) s += red2[g2 * 256 + F.tid]; obr[F.tid] = s; }
    __syncthreads();
}
__device__ __forceinline__ void p3_sample_unit(const Ptrs& P, Frame& F, int b, int g) {
    asm volatile("" : "+v"(F.tid), "+v"(F.lane), "+s"(F.wave));
    LAS float* q = (LAS float*)(F.lds + SM_Q); LAS float* Pb = (LAS float*)(F.lds + SM_P); LAS float* imp = (LAS float*)(F.lds + SM_IMP); LAS float* lsm = (LAS float*)(F.lds + SM_L);
    LAS int* sel = (LAS int*)(F.lds + SM_SEL); LAS float* osm = (LAS float*)(F.lds + SM_O);
    const float* cst = (const float*)(P.ws + WS_CONST);
    float kcmax = 0.f; for (int e_ = 0; e_ < 4; ++e_) kcmax += __builtin_bit_cast(float, __hip_atomic_load((unsigned*)(P.ws + WS_CTL) + CW_KCMAX + 64 + e_, RLX_AGENT));
    const float sh_cmp = cst[0] * sqrtf(kcmax) * LOG2E * 1.001f, sh_slc = cst[1], sh_win = cst[2];
    if (F.tid < 256) q[F.tid] = ((const float*)(P.ws + WS_QS))[(size_t)b * 512 + g * 256 + F.tid];
    __syncthreads();
    const float* kcs = (const float*)(P.ws + WS_KCS) + (size_t)(b * 2 + g) * 2 * NCS * 64;
    sample_branch(F, NCS, sh_cmp, [&](int s, const float*& kp, const float*& vp) { kp = kcs + (size_t)s * 64; vp = kcs + (size_t)(NCS + s) * 64; return true; }, osm);
    { const f32x4 p = *(const LAS f32x4*)(Pb + 4 * F.tid); float v = p.x / lsm[0] + p.y / lsm[1] + p.z / lsm[2] + p.w / lsm[3]; v += __shfl_xor(v, 1);
      if ((F.tid & 1) == 0) imp[F.tid >> 1] = v; if (F.tid < 4) imp[256 + F.tid] = 0.f; }
    if (F.tid < 256) osm[F.tid] = osm[F.tid] / lsm[F.tid >> 6];
    __syncthreads();
    if (F.wave == 0) { const int lane = F.lane; unsigned k[4];
#pragma unroll
        for (int i = 0; i < 4; ++i) { const int j = lane + 64 * i; k[i] = (j >= 1 && j <= 254) ? __builtin_bit_cast(unsigned, imp[j]) + 1u : 0u; }
        unsigned Tv = 0u;
        for (int bit = 30; bit >= 0; --bit) { const unsigned cand = Tv | (1u << bit); int cnt = 0;
#pragma unroll
            for (int i = 0; i < 4; ++i) cnt += __popcll(__ballot(k[i] >= cand));
            if (cnt >= 13) Tv = cand; }
        int ngt = 0;
#pragma unroll
        for (int i = 0; i < 4; ++i) ngt += __popcll(__ballot(k[i] > Tv));
        const int need = 13 - ngt; const unsigned long long below = (lane == 0) ? 0ull : (~0ull >> (64 - lane));
        int base = 3, eqbase = 0;
        if (lane == 0) { int z_ = 0; asm volatile("" : "+v"(z_)); sel[0] = z_; sel[1] = z_ + 255; sel[2] = z_ + 256; }
#pragma unroll
        for (int i = 0; i < 4; ++i) { const unsigned long long e = __ballot(k[i] == Tv); const int rk = eqbase + __popcll(e & below); const bool on = k[i] > Tv || (k[i] == Tv && rk < need);
            const unsigned long long m = __ballot(on); if (on) sel[base + __popcll(m & below)] = lane + 64 * i; base += __popcll(m); eqbase += __popcll(e); } }
    __syncthreads();
    const float* kvn = (const float*)(P.ws + WS_KVN) + (size_t)b * 768;
    const int* pt = P.page_table + b * NPAGES; const float* cs = P.cache_slc;
    sample_branch(F, 1024, sh_slc, [&](int s, const float*& kp, const float*& vp) { const int j = sel[s >> 6], rr = s & 63;
        if (j == 256) { kp = kvn + (1 * 2 + 0) * 128 + g * 64; vp = kvn + (1 * 2 + 1) * 128 + g * 64; return rr == 0; }
        const float* rowp = cs + ((size_t)pt[j >> 1] * 128 + (j & 1) * 64 + rr) * 256 + g * 64; kp = rowp; vp = rowp + 128; return true; }, osm + 256);
    if (F.tid < 256) osm[256 + F.tid] = osm[256 + F.tid] / lsm[F.tid >> 6];
    __syncthreads();
    const float* stw = P.st_win + (size_t)b * 512 * 256;
    sample_branch(F, 512, sh_win, [&](int s, const float*& kp, const float*& vp) {
        if (s == 511) { kp = kvn + (2 * 2 + 0) * 128 + g * 64; vp = kvn + (2 * 2 + 1) * 128 + g * 64; return true; }
        const float* rowp = stw + (size_t)(s + 1) * 256 + g * 64; kp = rowp; vp = rowp + 128; return true; }, osm + 512);
    if (F.tid < 256) { const int hq = F.tid >> 6, d = F.tid & 63; const float* gs = (const float*)(P.ws + WS_GS) + b * 24 + (g * 4 + hq) * 3;
        const float o = gs[0] * osm[F.tid] + gs[1] * osm[256 + F.tid] + gs[2] * osm[512 + F.tid] / lsm[hq];
        ((bf16*)(P.ws + WS_MIXS))[(size_t)b * 1024 + 512 + (g * 4 + hq) * 64 + d] = (bf16)f2bf(o * ((const float*)(P.ws + WS_ZAS))[(size_t)b * 512 + (g * 4 + hq) * 64 + d]); }
    __syncthreads();
}
__device__ __forceinline__ void p3_phase(const Ptrs& P, Frame& F, int rep) {
    const float* cst = (const float*)(P.ws + WS_CONST);
    float kcmax = 0.f; for (int e_ = 0; e_ < 4; ++e_) kcmax += __builtin_bit_cast(float, __hip_atomic_load((unsigned*)(P.ws + WS_CTL) + CW_KCMAX + e_, RLX_AGENT));
    const float sh_cmp = cst[0] * sqrtf(kcmax) * LOG2E * 1.001f, sh_slc = cst[1], sh_win = cst[2];
    unsigned long long tacc = 0ull;
    volatile LAS int* qw = (volatile LAS int*)(F.lds + P3_MISC);
#ifndef PROBE_P3
#define PROBE_P3 0
#endif
    constexpr int NS_ = PROBE_P3 == 1 ? 16 : 8, PSH_ = PROBE_P3 == 2 ? 1 : 0;
    constexpr int NQ = NS_ + (128 << PSH_);
    const int x0 = (int)(xb_xcc_id() & 7u);
    for (int xi = 0; xi < 8; ++xi) {
        const int x = (x0 + xi) & 7;
        for (;;) {
            __syncthreads();
            if (F.tid == 0) qw[0] = (int)__hip_atomic_fetch_add((unsigned*)(F.ctl + CW_QUEUE + 64 * (x + 8 * rep)), 1u, RLX_AGENT);
            __syncthreads();
            const int idx = qw[0];
            if (idx >= NQ) break;
            if (idx < NS_) p3_sample_unit(P, F, x * 4 + ((idx & 7) >> 1), idx & 1);
            else p3_prompt_unit(P, F, x >> 1, 127 - ((idx - NS_) >> PSH_), x & 1, sh_cmp, sh_slc, sh_win, tacc);
        }
    }
    if (PROBE_SEG != 0 && blockIdx.x == 0) { const unsigned long long t0_ = __builtin_readcyclecounter(); while (__builtin_readcyclecounter() - t0_ < tacc) __builtin_amdgcn_s_sleep(8); }
}
#ifndef MK_N_LAUNCHES
#define MK_N_LAUNCHES 1
#endif
constexpr int N_PHASES = 5;
constexpr int N_LAUNCHES = MK_N_LAUNCHES;
struct Args { Ptrs p; int ph_lo, ph_hi, rep, mode; };
__global__ void __launch_bounds__(NWAVES * 64, 2) nsa_fwd(Args args) {
    extern __shared__ __attribute__((aligned(16))) unsigned char lds[];
    const Ptrs& P = args.p;
    Frame F;
    F.lds = (LAS unsigned char*)lds;
    F.MISC = (volatile LAS unsigned*)(F.lds + MISC_OFF);
    F.tid = threadIdx.x; F.lane = F.tid & 63; F.wave = __builtin_amdgcn_readfirstlane(F.tid >> 6);
    F.G = gridDim.x; F.gw = blockIdx.x * NWAVES + F.wave; F.NGW = F.G * NWAVES;
    F.ctl = (gu32*)(P.ws + WS_CTL);
    for (int u = F.tid; u < (LDS_BYTES - LDSCTL_OFF) / 4; u += NWAVES * 64) ((LAS unsigned*)(F.lds + LDSCTL_OFF))[u] = 0u;
    __syncthreads();
    XcdBarrier bar; bar.bar = (unsigned*)(F.ctl + CW_BAR); bar.x = 0; bar.st = nullptr;
    if (N_LAUNCHES == 1) bar = xcd_barrier_post((unsigned*)(F.ctl + CW_BAR), F.MISC + 8);
    const int lo = args.ph_lo, hi = args.ph_hi;
    unsigned long long tprobe = 0ull;
#define IN(k) (lo <= (k) && (k) < hi)
#define FENCE() do { asm volatile("" : "+s"(F.wave), "+s"(F.gw)); F.lane = (int)__builtin_amdgcn_mbcnt_hi(~0u, __builtin_amdgcn_mbcnt_lo(~0u, 0u)); F.tid = F.wave * 64 + F.lane; asm volatile("" : "+v"(F.tid), "+v"(F.lane)); } while (0)
#define SEAM(k) do { if (IN(k) && IN((k) + 1)) xcd_barrier(bar, F.wave == 0 && (int)__builtin_amdgcn_mbcnt_hi(~0u, __builtin_amdgcn_mbcnt_lo(~0u, 0u)) == 0); } while (0)

    if (IN(0)) { FENCE(); p0_phase(P, F); } SEAM(0);
    if (IN(1)) { FENCE();
        pg8::Gemm g{(const pg8::bf16_t*)(P.ws + WS_XB), (const pg8::bf16_t*)(P.ws + WS_BT1), M, NP, D};
        EpiIn E{(const float*)(P.ws + WS_RSTD), (const float*)(P.ws + WS_ROPE), P.q_gain, P.k_gain, P.out, P.ws};
        const int nround = ((M / 256) * (NP / 256) + F.G - 1) / F.G, jx = (int)blockIdx.x >> 3,
                  kst = (((((int)blockIdx.x & 7) + 2 * (((jx >> 2) & 1) | ((jx >> 4) << 1))) & 7) * nround) >> 3;
        { pg8::StaticOrder S; S.init(M, NP, F.G, (int)blockIdx.x, 0, kst); pg8::gemm_phase<EpiIn, pg8::StaticOrder, true, true>(F.lds + RING_OFF, g, S, E, F.wave, tprobe); }
        FENCE(); __syncthreads();
#ifdef PROBE_CW
        const unsigned long long tc0_ = __builtin_readcyclecounter();
#endif
        compress_wg(P, F, F.lds + RING_OFF);
        __syncthreads(); FENCE();
#ifdef PROBE_CW
        asm volatile("s_waitcnt vmcnt(0)" ::: "memory"); tprobe = __builtin_readcyclecounter() - tc0_;
#endif
        { pg8::StaticOrder S; S.init(M, NP, F.G, (int)blockIdx.x, kst, nround - kst); pg8::gemm_phase<EpiIn, pg8::StaticOrder, true, true>(F.lds + RING_OFF, g, S, E, F.wave, tprobe); }
        FENCE();
        for (int ct = F.gw; ct < NP / 16; ct += F.NGW) small_gemm_tile<0>(P, (const bf16*)(P.ws + WS_XSB), (const bf16*)(P.ws + WS_BT1), ct, F.lane);
#ifdef PROBE_CW
        if (blockIdx.x == PROBE_CW) { const unsigned long long t0_ = __builtin_readcyclecounter(); while (__builtin_readcyclecounter() - t0_ < tprobe) __builtin_amdgcn_s_sleep(8); }
        tprobe = 0ull;
#endif
#if defined(PROBE_EPI)
        if (PROBE_EPI == 1 && blockIdx.x == 0) { const unsigned long long t0_ = __builtin_readcyclecounter(); while (__builtin_readcyclecounter() - t0_ < tprobe) __builtin_amdgcn_s_sleep(8); }
        tprobe = 0ull;
#endif
    } SEAM(1);
    if (IN(2)) { FENCE(); p2_phase(P, F); } SEAM(2);
    if (IN(3)) { FENCE(); p3_phase(P, F, args.rep); } SEAM(3);
    if (IN(4)) { FENCE();
        pg8::Gemm g{(const pg8::bf16_t*)(P.ws + WS_MIX), (const pg8::bf16_t*)(P.ws + WS_BT2), M, D, D}; pg8::StaticOrder S; S.init(M, D, F.G, (int)blockIdx.x);
        EpiOut E{(const bf16*)(P.ws + WS_XB), P.out + O_Y};
        pg8::gemm_phase<EpiOut, pg8::StaticOrder, true, true>(F.lds + RING_OFF, g, S, E, F.wave, tprobe);
        FENCE();
        for (int ct = F.gw; ct < D / 16; ct += F.NGW) small_gemm_tile<1>(P, (const bf16*)(P.ws + WS_MIXS), (const bf16*)(P.ws + WS_BT2), ct, F.lane);
#if defined(PROBE_EPI)
        if (PROBE_EPI == 2 && blockIdx.x == 0) { const unsigned long long t0_ = __builtin_readcyclecounter(); while (__builtin_readcyclecounter() - t0_ < tprobe) __builtin_amdgcn_s_sleep(8); }
#endif
    }
#undef IN
#undef SEAM
}

extern "C" void kernel_launch(void* const* d_in, const int* in_sizes, int n_in, void* d_out, int out_size, void* d_ws, size_t ws_size, hipStream_t stream) {
    static int grid = 0;
    if (grid == 0) {
        if (n_in != 16 || out_size != (int)O_END || ws_size < WS_END) { fprintf(stderr, "kernel_launch: unexpected shapes (n_in %d, out %d, ws %zu)\n", n_in, out_size, ws_size); grid = -1; return; }
        int dev = 0, cus = 0, per_cu = 0;
        if (hipGetDevice(&dev) != hipSuccess || hipDeviceGetAttribute(&cus, hipDeviceAttributeMultiprocessorCount, dev) != hipSuccess) { grid = -1; return; }
        if (hipFuncSetAttribute((const void*)nsa_fwd, hipFuncAttributeMaxDynamicSharedMemorySize, LDS_BYTES) != hipSuccess) { fprintf(stderr, "kernel_launch: hipFuncSetAttribute failed\n"); grid = -1; return; }
        if (hipOccupancyMaxActiveBlocksPerMultiprocessor(&per_cu, (const void*)nsa_fwd, NWAVES * 64, LDS_BYTES) != hipSuccess || per_cu < 1)
            fprintf(stderr, "kernel_launch: note: occupancy query reports %d workgroups per CU\n", per_cu);
        (void)hipGetLastError();
        grid = cus;
    }
    if (grid < 0) return;
    if (hipMemsetAsync((char*)d_ws + WS_CTL, 0, CTL_ZERO_BYTES, stream) != hipSuccess) return;
    Args a{}; a.mode = 3;
    a.p.xp = (const float*)d_in[0]; a.p.xs = (const float*)d_in[1]; a.p.cache_cmp = (const float*)d_in[2]; a.p.cache_slc = (const float*)d_in[3];
    a.p.st_win = (const float*)d_in[4]; a.p.st_conv = (const float*)d_in[5]; a.p.page_table = (const int*)d_in[6]; a.p.norm_g = (const float*)d_in[7];
    a.p.w_in = (const float*)d_in[8]; a.p.conv_w = (const float*)d_in[9]; a.p.conv_b = (const float*)d_in[10]; a.p.q_gain = (const float*)d_in[11];
    a.p.k_gain = (const float*)d_in[12]; a.p.cmp_pe = (const float*)d_in[13]; a.p.cmp_w = (const float*)d_in[14]; a.p.w_out = (const float*)d_in[15];
    a.p.out = (float*)d_out; a.p.ws = (unsigned char*)d_ws;
#ifndef PROBE_DUP
#define PROBE_DUP -1
#endif
    for (int li = 0; li < N_LAUNCHES; ++li) {
        a.ph_lo = (N_LAUNCHES == 1) ? 0 : li; a.ph_hi = (N_LAUNCHES == 1) ? N_PHASES : li + 1;
        for (int rep = 0; rep < ((N_LAUNCHES > 1 && li == PROBE_DUP) ? 2 : 1); ++rep) {
            a.rep = rep;
            hipLaunchKernelGGL(nsa_fwd, dim3(grid), dim3(NWAVES * 64), LDS_BYTES, stream, a);
            const hipError_t le = hipPeekAtLastError();
            if (le != hipSuccess) { fprintf(stderr, "kernel_launch: launch %d failed: %s\n", li, hipGetErrorName(le)); break; }
        }
    }
}
```

```cpp
#include <hip/hip_runtime.h>
#include <cstdio>
#include <cstdint>
#define GAS __attribute__((address_space(1)))
#define LAS __attribute__((address_space(3)))
typedef unsigned short bf16;
typedef unsigned v4u __attribute__((ext_vector_type(4)));
typedef unsigned v2u __attribute__((ext_vector_type(2)));
typedef float f32x2 __attribute__((ext_vector_type(2)));
typedef float f32x16 __attribute__((ext_vector_type(16)));
typedef GAS unsigned gu32;
typedef GAS unsigned long long gu64;
#define RLX_AGENT __ATOMIC_RELAXED, __HIP_MEMORY_SCOPE_AGENT
#define LDS_WAIT() asm volatile("s_waitcnt lgkmcnt(0)" ::: "memory")
#define VM_WAIT() asm volatile("s_waitcnt vmcnt(0)" ::: "memory")
#define MK_N_LAUNCHES 1
#define PROBE_DUP -1
#define PROBE_P3 0
#define PROBE_SEG 0
namespace pg8 {
#define PG8_LAS __attribute__((address_space(3)))
typedef unsigned short bf16_t;
typedef short bf16x8 __attribute__((ext_vector_type(8)));
typedef float f32x4 __attribute__((ext_vector_type(4)));
typedef unsigned u32x4 __attribute__((ext_vector_type(4)));
constexpr int BM = 256, BK = 64, HALF = 128, HTB = HALF * BK * 2  , STAGE_BYTES = 8 * HTB, NXCD = 8, WGM = 8;

__host__ __device__ __forceinline__ int lds_byte(int r, int c) { const int st = (r >> 4) * 2 + (c >> 5), rr = r & 15, cc = c & 31, ob = rr * 64 + cc * 2; return st * 1024 + (ob ^ (((ob >> 9) & 1) << 5)); }
__host__ __device__ __forceinline__ void stage_rc(int b, int& R, int& C) { const int st = b / 1024, sb = b % 1024, swz = sb ^ (((sb >> 9) & 1) << 5); R = (st >> 1) * 16 + swz / 64; C = (st & 1) * 32 + (swz % 64) / 2; }
__host__ __device__ __forceinline__ int perm32(int rho) { const int n = rho >> 4, i = rho & 15; return 8 * (i >> 2) + 4 * n + (i & 3); }

struct Unit { int pm, pn; };
struct Gemm { const bf16_t* A; const bf16_t* Bt; int M, N, K; };

struct StaticOrder {
    int nM, nN, nwg, G, c, i0, n;
    __host__ __device__ void init(int M, int N, int G_, int c_, int i0_ = 0, int n_ = 1 << 30) { nM = M / BM; nN = N / BM; nwg = nM * nN; G = G_; c = c_; i0 = i0_; n = n_; }
    __host__ __device__ bool next(int i, Unit& u) const {
        if (i >= n) return false;
        const long L = (long)(i + i0) * G + c; if (L >= nwg) return false;
        int wgid = (int)L; { const int q = nwg / NXCD, r = nwg % NXCD, xcd = wgid % NXCD, off = wgid / NXCD; wgid = (xcd < r ? xcd * (q + 1) : r * (q + 1) + (xcd - r) * q) + off; }
        const int nig = WGM * nN, gid = wgid / nig, fm = gid * WGM, gsz = (nM - fm) < WGM ? (nM - fm) : WGM;
        u.pm = fm + ((wgid % nig) % gsz); u.pn = (wgid % nig) / gsz; return true;
    }
    __device__ __forceinline__ void a_ready(const Unit&) const {}
    __device__ __forceinline__ void done(const Unit&) const {}
};


template <class Epi, class Sched, bool ALIGN_EPI = false, bool SP2 = false>
__device__ __forceinline__ void gemm_phase(PG8_LAS unsigned char* lds, const Gemm g, const Sched& S, const Epi& E, int wave_id  , unsigned long long& tacc_  ) {
    const int lane = (int)__builtin_amdgcn_mbcnt_hi(~0u, __builtin_amdgcn_mbcnt_lo(~0u, 0u)), wid = wave_id, tid = wid * 64 + lane, wr = wid >> 2, wc = wid & 3, fr = lane & 15, fq = lane >> 4;
    const int K = g.K, nt = K / BK;
    unsigned voffA[2], voffB[2];
#pragma unroll
    for (int i = 0; i < 2; ++i) { int R, C; stage_rc(tid * 16 + i * 8192, R, C); const int Rb = Epi::PERM ? ((R & ~31) + perm32(R & 31)) : R;
        voffA[i] = (unsigned)(R * K + C) * 2u; voffB[i] = (unsigned)(Rb * K + C) * 2u; }
    const size_t kstep = (size_t)(BK * 2);
    const size_t hstep = (size_t)HALF * K * 2;
    const size_t tstep = 2 * hstep;
    const unsigned ldsw = (unsigned)wid * 1024u;
    const int aoff = lds_byte(wr * 64 + fr, fq * 8), boff = lds_byte(wc * 32 + fr, fq * 8);
#define PG8_SA(b, h) (((b) * 2 + (h)) * HTB)
#define PG8_SB(b, h) ((4 + (b) * 2 + (h)) * HTB)
#define PG8_STAGE(bufoff, gbase, voff) do { _Pragma("unroll") for (int _i = 0; _i < 2; ++_i) \
        __builtin_amdgcn_global_load_lds((const unsigned*)((const char*)(gbase) + (voff)[_i]), (PG8_LAS unsigned*)(lds + (bufoff) + ldsw + _i * 8192), 16, 0, 0); } while (0)
#define PG8_LDA(dst, b, h) do { _Pragma("unroll") for (int m = 0; m < 4; ++m) _Pragma("unroll") for (int k = 0; k < 2; ++k) dst[m][k] = *(const PG8_LAS bf16x8*)(lds + PG8_SA(b, h) + aoff + m * 2048 + k * 1024); } while (0)
#define PG8_LDB(dst, b, h) do { _Pragma("unroll") for (int n = 0; n < 2; ++n) _Pragma("unroll") for (int k = 0; k < 2; ++k) dst[n][k] = *(const PG8_LAS bf16x8*)(lds + PG8_SB(b, h) + boff + n * 2048 + k * 1024); } while (0)
#define PG8_MMA(ai, bj, At, Bt) do { __builtin_amdgcn_s_setprio(1); _Pragma("unroll") for (int m = 0; m < 4; ++m) _Pragma("unroll") for (int n = 0; n < 2; ++n) _Pragma("unroll") for (int k = 0; k < 2; ++k) \
        acc[ai][bj][m][n] = __builtin_amdgcn_mfma_f32_16x16x32_bf16(Bt[n][k], At[m][k], acc[ai][bj][m][n], 0, 0, 0); __builtin_amdgcn_s_setprio(0); } while (0)
#define PG8_WAIT_V(n) asm volatile("s_waitcnt vmcnt(" #n ")" ::: "memory")
#define PG8_WAIT_L(n) asm volatile("s_waitcnt lgkmcnt(" #n ")" ::: "memory")
#define PG8_BAR __builtin_amdgcn_s_barrier()
#define PG8_SCHED __builtin_amdgcn_sched_barrier(0)
    Unit cur, nxt; int ui = 0;
    if (!S.next(0, cur)) return;
    f32x4 acc[2][2][4][2];
#pragma unroll
    for (int a = 0; a < 2; ++a)
#pragma unroll
        for (int b = 0; b < 2; ++b)
#pragma unroll
            for (int m = 0; m < 4; ++m)
#pragma unroll
                for (int n = 0; n < 2; ++n) acc[a][b][m][n] = (f32x4){0.f, 0.f, 0.f, 0.f};
    bf16x8 At[4][2], B0[2][2], B1[2][2];
    const char* cA = (const char*)g.A + (size_t)cur.pm * tstep; const char* cB = (const char*)g.Bt + (size_t)cur.pn * tstep;
    S.a_ready(cur);
    if constexpr (SP2) {
        PG8_STAGE(PG8_SB(0, 0), cB, voffB); PG8_STAGE(PG8_SB(0, 1), cB + hstep, voffB); PG8_STAGE(PG8_SA(0, 0), cA, voffA); PG8_STAGE(PG8_SA(0, 1), cA + hstep, voffA);
        if (wr == 1) PG8_BAR;
        PG8_WAIT_V(2); PG8_BAR;
        PG8_STAGE(PG8_SB(1, 0), cB + kstep, voffB); PG8_STAGE(PG8_SA(1, 0), cA + kstep, voffA); PG8_STAGE(PG8_SB(1, 1), cB + hstep + kstep, voffB);
        PG8_WAIT_V(6); PG8_BAR;
    } else {
        PG8_STAGE(PG8_SB(0, 0), cB, voffB); PG8_STAGE(PG8_SA(0, 0), cA, voffA); PG8_STAGE(PG8_SB(0, 1), cB + hstep, voffB); PG8_STAGE(PG8_SA(0, 1), cA + hstep, voffA);
        if (wr == 1) PG8_BAR;
        PG8_WAIT_V(4); PG8_BAR;
        PG8_STAGE(PG8_SB(1, 0), cB + kstep, voffB); PG8_STAGE(PG8_SA(1, 0), cA + kstep, voffA); PG8_STAGE(PG8_SB(1, 1), cB + hstep + kstep, voffB);
        PG8_WAIT_V(6); PG8_BAR;
    }
    for (;;) {
        const bool has_next = S.next(ui + 1, nxt);
        const char* nA = has_next ? (const char*)g.A + (size_t)nxt.pm * tstep : cA; const char* nB = has_next ? (const char*)g.Bt + (size_t)nxt.pn * tstep : cB;
        for (int t = 0; t < nt; t += 2) {
            const bool last = (t == nt - 2);
            const char* a1 = cA + (size_t)(t + 1) * kstep;
            const char* a2 = last ? nA : cA + (size_t)(t + 2) * kstep; const char* b2 = last ? nB : cB + (size_t)(t + 2) * kstep;
            const char* a3 = a2 + kstep; const char* b3 = b2 + kstep;
            if (last && has_next) S.a_ready(nxt);
            if constexpr (SP2) {
            PG8_LDB(B0, 0, 0); PG8_LDB(B1, 0, 1); PG8_SCHED; PG8_LDA(At, 0, 0); PG8_STAGE(PG8_SA(1, 1), a1 + hstep, voffA);
            PG8_WAIT_V(8); PG8_WAIT_L(0); PG8_BAR; PG8_MMA(0, 0, At, B0); PG8_MMA(0, 1, At, B1); PG8_BAR; PG8_SCHED;
            PG8_LDA(At, 0, 1); PG8_STAGE(PG8_SB(0, 0), b2, voffB); PG8_STAGE(PG8_SB(0, 1), b2 + hstep, voffB); PG8_STAGE(PG8_SA(0, 0), a2, voffA);
            PG8_WAIT_V(8); PG8_WAIT_L(0); PG8_BAR; PG8_MMA(1, 0, At, B0); PG8_MMA(1, 1, At, B1); PG8_BAR; PG8_SCHED;
            PG8_LDB(B0, 1, 0); PG8_LDB(B1, 1, 1); PG8_SCHED; PG8_LDA(At, 1, 0); PG8_STAGE(PG8_SA(0, 1), a2 + hstep, voffA);
            PG8_WAIT_V(8); PG8_WAIT_L(0); PG8_BAR; PG8_MMA(0, 0, At, B0); PG8_MMA(0, 1, At, B1); PG8_BAR; PG8_SCHED;
            PG8_LDA(At, 1, 1); PG8_STAGE(PG8_SB(1, 0), b3, voffB); PG8_STAGE(PG8_SB(1, 1), b3 + hstep, voffB); PG8_STAGE(PG8_SA(1, 0), a3, voffA);
            PG8_WAIT_V(8); PG8_WAIT_L(0); PG8_BAR; PG8_MMA(1, 0, At, B0); PG8_MMA(1, 1, At, B1); PG8_BAR; PG8_SCHED;
            } else {
            PG8_LDB(B0, 0, 0); PG8_SCHED; PG8_LDA(At, 0, 0); PG8_STAGE(PG8_SA(1, 1), a1 + hstep, voffA);
            PG8_WAIT_L(8); PG8_BAR; PG8_WAIT_L(0); PG8_MMA(0, 0, At, B0); PG8_BAR; PG8_SCHED;
            PG8_LDB(B1, 0, 1); PG8_STAGE(PG8_SB(0, 0), b2, voffB);
            PG8_BAR; PG8_WAIT_L(0); PG8_MMA(0, 1, At, B1); PG8_BAR;
            PG8_LDA(At, 0, 1); PG8_STAGE(PG8_SA(0, 0), a2, voffA);
            PG8_BAR; PG8_WAIT_L(0); PG8_MMA(1, 0, At, B0); PG8_BAR; PG8_SCHED;
            PG8_STAGE(PG8_SB(0, 1), b2 + hstep, voffB);
            PG8_WAIT_V(6); PG8_BAR; PG8_MMA(1, 1, At, B1); PG8_BAR;
            PG8_LDB(B0, 1, 0); PG8_SCHED; PG8_LDA(At, 1, 0); PG8_STAGE(PG8_SA(0, 1), a2 + hstep, voffA);
            PG8_WAIT_L(8); PG8_BAR; PG8_WAIT_L(0); PG8_MMA(0, 0, At, B0); PG8_BAR; PG8_SCHED;
            PG8_LDB(B1, 1, 1); PG8_STAGE(PG8_SB(1, 0), b3, voffB);
            PG8_BAR; PG8_WAIT_L(0); PG8_MMA(0, 1, At, B1); PG8_BAR;
            PG8_LDA(At, 1, 1); PG8_STAGE(PG8_SA(1, 0), a3, voffA);
            PG8_BAR; PG8_WAIT_L(0); PG8_MMA(1, 0, At, B0); PG8_BAR; PG8_SCHED;
            PG8_STAGE(PG8_SB(1, 1), b3 + hstep, voffB);
            PG8_WAIT_V(6); PG8_BAR; PG8_MMA(1, 1, At, B1); PG8_BAR;
            }
        }
        if constexpr (ALIGN_EPI) { if (wr == 0) PG8_BAR; }
#ifdef PROBE_EPI
        { const unsigned long long t0_ = __builtin_readcyclecounter(); E(acc, cur, wr, wc, fr, fq); asm volatile("s_waitcnt vmcnt(0)" ::: "memory"); tacc_ += __builtin_readcyclecounter() - t0_; S.done(cur); }
#else
        if constexpr (!Epi::AFTER_DRAIN) { E(acc, cur, wr, wc, fr, fq); S.done(cur); }
#endif
        if (!has_next) break;
#pragma unroll
        for (int a = 0; a < 2; ++a)
#pragma unroll
            for (int b = 0; b < 2; ++b)
#pragma unroll
                for (int m = 0; m < 4; ++m)
#pragma unroll
                    for (int n = 0; n < 2; ++n) acc[a][b][m][n] = (f32x4){0.f, 0.f, 0.f, 0.f};
        cur = nxt; cA = nA; cB = nB; ++ui;
        if constexpr (ALIGN_EPI) { if (wr == 1) PG8_BAR; }
    }
    PG8_WAIT_V(0);
    if constexpr (!ALIGN_EPI) { if (wr == 0) PG8_BAR; }
    PG8_BAR;
    if constexpr (Epi::AFTER_DRAIN) { E.fused(acc, cur, wr, wc, fr, fq, lds, wid, lane); S.done(cur); }
#undef PG8_SA
#undef PG8_SB
#undef PG8_STAGE
#undef PG8_LDA
#undef PG8_LDB
#undef PG8_MMA
#undef PG8_WAIT_V
#undef PG8_WAIT_L
#undef PG8_BAR
#undef PG8_SCHED
}
}
#define XB_TMO      128
#define XB_XCNT(j)  (256  + 64 * (j))
#define XB_XSUB(j)  (1280 + 64 * (j))
#define XB_XGEN(j)  (2304 + 64 * (j))
#define XB_TOP      3328
#define XB_TOPGEN   3392
#define XCD_BAR_WORDS 3456
#define XB_SPIN_CAP (1u << 18)

__device__ __forceinline__ unsigned xb_ld(unsigned* p)              { return __hip_atomic_load(p, __ATOMIC_RELAXED, __HIP_MEMORY_SCOPE_AGENT); }
__device__ __forceinline__ unsigned xb_add(unsigned* p, unsigned v) { return __hip_atomic_fetch_add(p, v, __ATOMIC_RELAXED, __HIP_MEMORY_SCOPE_AGENT); }
__device__ __forceinline__ unsigned xb_xcc_id() { return (unsigned)__builtin_amdgcn_s_getreg((3 << 11) | 20) & 0xFu; }
#define XB_SPIN(cond, bar) do { unsigned _sp = 0; while (cond) { __builtin_amdgcn_s_sleep(1); \
    if ((++_sp & 255u) == 0u) { if (xb_ld(&(bar)[XB_TMO])) break; if (_sp > XB_SPIN_CAP) { atomicAdd(&(bar)[XB_TMO], 1u); break; } } } } while (0)

struct XcdBarrier {
    unsigned* bar; unsigned x;
    volatile LAS unsigned* st;
};

__device__ __forceinline__ XcdBarrier xcd_barrier_post(unsigned* bar, volatile LAS unsigned* st) {
    XcdBarrier b; b.bar = bar; b.x = xb_xcc_id(); b.st = st;
    if (threadIdx.x == 0) (void)xb_add(&bar[XB_XCNT(b.x)], 1u);
    return b;
}
__device__ __forceinline__ void xcd_barrier_complete(unsigned* bar, unsigned x, unsigned& nloc, unsigned& nx) {
    const unsigned G = gridDim.x * gridDim.y * gridDim.z;
    unsigned sum, cnt, mine, sp = 0u;
    for (;;) {
        sum = 0u; cnt = 0u; mine = 0u;
#pragma unroll
        for (unsigned j = 0; j < 16; ++j) { const unsigned c = xb_ld(&bar[XB_XCNT(j)]); sum += c; cnt += (c > 0u) ? 1u : 0u; mine = (j == x) ? c : mine; }
        if (sum == G) break;
        __builtin_amdgcn_s_sleep(1);
        if ((++sp & 255u) == 0u) { if (xb_ld(&bar[XB_TMO])) break; if (sp > XB_SPIN_CAP) { atomicAdd(&bar[XB_TMO], 1u); break; } }
    }
    nloc = mine > 0u ? mine : 1u; nx = cnt > 0u ? cnt : 1u;
}

__device__ __forceinline__ void xcd_barrier(const XcdBarrier& b, bool leader  ) {
    asm volatile("s_waitcnt vmcnt(0)" ::: "memory");
    __syncthreads();
    if (leader) {
        unsigned* bar = b.bar;
        __builtin_amdgcn_s_waitcnt(0);
        unsigned nloc = b.st[0], nx = b.st[1];
        if (nloc == 0u) { xcd_barrier_complete(bar, b.x, nloc, nx); b.st[0] = nloc; b.st[1] = nx; }
        const unsigned old = xb_add(&bar[XB_XSUB(b.x)], 1u);
        const unsigned gen = old / nloc;
        if (old + 1u == (gen + 1u) * nloc) {
            __builtin_amdgcn_fence(__ATOMIC_RELEASE, "agent");
            asm volatile("s_waitcnt vmcnt(0)" ::: "memory");
            const unsigned og = xb_add(&bar[XB_TOP], 1u);
            const unsigned tg = og / nx;
            if (og + 1u == (tg + 1u) * nx) xb_add(&bar[XB_TOPGEN], 1u);
            else XB_SPIN(xb_ld(&bar[XB_TOPGEN]) == tg, bar);
            __builtin_amdgcn_fence(__ATOMIC_ACQUIRE, "agent");
            xb_add(&bar[XB_XGEN(b.x)], 1u);
            asm volatile("s_waitcnt vmcnt(0)" ::: "memory");
        } else {
            XB_SPIN(xb_ld(&bar[XB_XGEN(b.x)]) == gen, bar);
            __builtin_amdgcn_fence(__ATOMIC_ACQUIRE, "agent");
            asm volatile("s_waitcnt vmcnt(0)" ::: "memory");
        }
    }
    __syncthreads();
}
using pg8::f32x4; using pg8::bf16x8;
constexpr int NWAVES = 8;
constexpr int BATCH = 4, T = 8192, D = 1024, M = BATCH * T, NP = 4096, INW = 3864;
constexpr int DECB = 32, PAST = 16384, NPAGES = 128, NCS = 512  ;
constexpr float NORM_EPS = 1e-6f;
constexpr float LOG2E = 1.4426950408889634f;
constexpr float QSCALE = 0.125f * LOG2E;
constexpr size_t O_Y = 0, O_YS = 33554432, O_PCMP = 33587200, O_PSLC = 41975808, O_PWIN = 50364416, O_PCONV = 50888704,
                 O_SCMP = 50892800, O_SSLC = 50900992, O_SWIN = 50909184, O_SCONV = 55103488, O_END = 55136256;
constexpr int C_BG = 0, C_CG = 512, C_CI = 1024, C_ZC = 1536, C_Q = 2048, C_KV = 2560, C_GL = 3328, C_ZA = 3352;

constexpr size_t MiB = 1u << 20, KiB = 1u << 10;
constexpr size_t WS_CTL = 0, CTL_ZERO_BYTES = 128 * KiB;
constexpr size_t WS_BT1 = 2 * MiB;
constexpr size_t WS_BT2 = 10 * MiB;
constexpr size_t WS_BTC = 12 * MiB;
constexpr size_t WS_CBIAS = 12 * MiB + 512 * KiB;
constexpr size_t WS_CONST = WS_CBIAS + 4 * KiB;
constexpr size_t WS_ROPE = 13 * MiB;
constexpr size_t WS_RSTD = 16 * MiB;
constexpr size_t WS_XSB = 16 * MiB + 256 * KiB;
constexpr size_t WS_RSTDS = WS_XSB + 64 * KiB;
constexpr size_t WS_GATE = 17 * MiB;
constexpr size_t WS_KC = 20 * MiB;
constexpr size_t WS_PROJS = 21 * MiB;
constexpr size_t WS_QS = 22 * MiB;
constexpr size_t WS_KVN = WS_QS + 64 * KiB;
constexpr size_t WS_GS = WS_KVN + 96 * KiB;
constexpr size_t WS_ZAS = WS_GS + 4 * KiB;
constexpr size_t WS_MIXS = WS_ZAS + 64 * KiB;
constexpr size_t WS_KCS = 24 * MiB;
constexpr size_t WS_KS = 40 * MiB, WS_KW = 56 * MiB;
constexpr size_t WS_XB = 72 * MiB;
constexpr size_t WS_CG = 136 * MiB, WS_U = 168 * MiB, WS_ZA = 200 * MiB, WS_Q = 232 * MiB;
constexpr size_t WS_MIX = 264 * MiB;
constexpr size_t WS_TOT = 328 * MiB;
constexpr size_t WS_END = 344 * MiB;
constexpr int CW_TMO = 0, CW_CODE = 1;
constexpr int CW_BAR = 4096;
constexpr int CW_QUEUE = 16384;
constexpr int CW_P0CNT = 18432;
constexpr int CW_KCMAX = 20480;

constexpr int RING_OFF = 0, RING_BYTES = 131072;
constexpr int LDSCTL_OFF = RING_BYTES, MISC_OFF = LDSCTL_OFF + 320;
constexpr int LDS_BYTES = 147456;

__device__ __forceinline__ unsigned f2bf(float f) { unsigned u = __builtin_bit_cast(unsigned, f); return (u + 0x7fffu + ((u >> 16) & 1u)) >> 16; }
typedef __bf16 bf16x2_t __attribute__((ext_vector_type(2)));
__device__ __forceinline__ unsigned pk2(float lo, float hi) { return __builtin_bit_cast(unsigned, __builtin_convertvector((f32x2){lo, hi}, bf16x2_t)); }
__device__ __forceinline__ float bf2f(unsigned h) { return __builtin_bit_cast(float, h << 16); }
__device__ __forceinline__ float wave_sum(float v) {
#pragma unroll
    for (int o = 1; o < 64; o <<= 1) v += __shfl_xor(v, o);
    return v;
}
__device__ __forceinline__ float quad_sum(float v) {
    v += __builtin_bit_cast(float, __builtin_amdgcn_update_dpp(0, __builtin_bit_cast(int, v), 0xB1, 0xF, 0xF, true));
    v += __builtin_bit_cast(float, __builtin_amdgcn_update_dpp(0, __builtin_bit_cast(int, v), 0x4E, 0xF, 0xF, true));
    return v;
}
__device__ __forceinline__ float fast_exp2(float x) { return __builtin_amdgcn_exp2f(x); }
__device__ __forceinline__ float sigmoidf(float x) { return __builtin_amdgcn_rcpf(1.0f + fast_exp2(-x * LOG2E)); }
__device__ __forceinline__ float slc_vscale(float sh_slc) { return fast_exp2(floorf(18.0f - sh_slc)); }
__device__ __forceinline__ int kimg_off(int key, int d) { return ((((key >> 5) * 4 + (d >> 4)) * 64 + ((d >> 3) & 1) * 32 + (key & 31)) << 3) + (d & 7); }
__device__ __forceinline__ int vimg_off(int d, int pos) { return 4096 + ((((d >> 5) * 4 + (pos >> 4)) * 64 + ((pos >> 3) & 1) * 32 + (d & 31)) << 3) + (pos & 7); }
__device__ __forceinline__ int perm16(int kk) { return 8 * ((kk >> 2) & 1) + 4 * (kk >> 3) + (kk & 3); }

struct Ptrs {
    const float *xp, *xs, *cache_cmp, *cache_slc, *st_win, *st_conv; const int* page_table;
    const float *norm_g, *w_in, *conv_w, *conv_b, *q_gain, *k_gain, *cmp_pe, *cmp_w, *w_out;
    float* out; unsigned char* ws;
};
struct Frame {
    LAS unsigned char* lds;
    volatile LAS unsigned* MISC;
    gu32* ctl;
    int tid, lane, wave, G, gw, NGW;
};
__device__ __forceinline__ int bt1_src(int dg, int& nvalid) {
    const int pn = dg >> 3, gi = dg & 7, bj = gi >> 2, wc = gi & 3; nvalid = 32;
    if (pn < 4) return (bj ? C_ZC : C_BG) + 128 * pn + 32 * wc;
    if (pn < 8) return (bj ? C_CI : C_CG) + 128 * (pn - 4) + 32 * wc;
    if (pn < 10) return C_Q + (4 * (pn - 8) + wc) * 64 + 32 * bj;
    if (pn < 13) return C_KV + (pn - 10) * 256 + wc * 64 + 32 * bj;
    if (pn < 15) return C_ZA + 256 * (pn - 13) + 32 * gi;
    nvalid = (gi == 0) ? 24 : 0; return C_GL;
}
__device__ __forceinline__ void p0_transpose_item(const float* W, int ldw, int k0, int src0, int nvalid, const float* ksc, bf16* WT, int ldt, int drow0, LAS float* scr, int lane) {
    const int nn = lane & 31;
#pragma unroll 8
    for (int i = 0; i < 32; ++i) { const int kk = 2 * i + (lane >> 5); float v = 0.f;
        if (nn < nvalid) { v = W[(size_t)(k0 + kk) * ldw + src0 + nn]; if (ksc) v *= ksc[k0 + kk]; }
        scr[kk * 33 + nn] = v; }
    LDS_WAIT(); asm volatile("" ::: "memory");
    const int c = lane & 7;
#pragma unroll
    for (int j = 0; j < 4; ++j) { const int n = (lane >> 3) + 8 * j; const LAS float* s = scr + (8 * c) * 33 + n;
        v4u o; o.x = pk2(s[0 * 33], s[1 * 33]); o.y = pk2(s[2 * 33], s[3 * 33]); o.z = pk2(s[4 * 33], s[5 * 33]); o.w = pk2(s[6 * 33], s[7 * 33]);
        *(GAS v4u*)(WT + (size_t)(drow0 + n) * ldt + k0 + 8 * c) = o; }
    LDS_WAIT(); asm volatile("" ::: "memory");
}
template <int NR>
__device__ __forceinline__ void x_rows_load(f32x4 (&v)[NR][4], const float* xrow, int lane) {
#pragma unroll
    for (int r = 0; r < NR; ++r)
#pragma unroll
        for (int j = 0; j < 4; ++j) v[r][j] = ((const GAS f32x4*)(xrow + (size_t)r * D) + lane)[64 * j];
}
template <int NR>
__device__ __forceinline__ void x_rows_finish(const f32x4 (&v)[NR][4], bf16* orow, float* rstd_out, int lane) {
    float s[NR];
#pragma unroll
    for (int r = 0; r < NR; ++r) { s[r] = 0.f;
#pragma unroll
        for (int j = 0; j < 4; ++j) s[r] += (v[r][j].x * v[r][j].x + v[r][j].y * v[r][j].y) + (v[r][j].z * v[r][j].z + v[r][j].w * v[r][j].w); }
#pragma unroll
    for (int o = 1; o < 64; o <<= 1)
#pragma unroll
        for (int r = 0; r < NR; ++r) s[r] += __shfl_xor(s[r], o);
#pragma unroll
    for (int r = 0; r < NR; ++r) { GAS unsigned long long* o8 = (GAS unsigned long long*)(orow + (size_t)r * D) + lane;
#pragma unroll
        for (int j = 0; j < 4; ++j) o8[64 * j] = (unsigned long long)pk2(v[r][j].x, v[r][j].y) | ((unsigned long long)pk2(v[r][j].z, v[r][j].w) << 32);
        if (lane == 0) rstd_out[r] = 1.0f / sqrtf(s[r] * (1.0f / D) + NORM_EPS); }
}
template <int NR>
__device__ __forceinline__ void x_rows_to_bf16(const float* xrow, bf16* orow, float* rstd_out, int lane) {
    f32x4 v[NR][4]; x_rows_load<NR>(v, xrow, lane); x_rows_finish<NR>(v, orow, rstd_out, lane);
}
__device__ __forceinline__ void x_rows_stream(const Ptrs& P, int m0, int mstride, int lane) {
    if (m0 >= M) return;
    f32x4 va[4][4], vb[4][4];
    x_rows_load<4>(va, P.xp + (size_t)m0 * D, lane);
    for (int m = m0; m < M; m += 2 * mstride) {
        const int m1 = m + mstride, m2 = m + 2 * mstride;
        if (m1 < M) x_rows_load<4>(vb, P.xp + (size_t)m1 * D, lane);
        x_rows_finish<4>(va, (bf16*)(P.ws + WS_XB) + (size_t)m * D, (float*)(P.ws + WS_RSTD) + m, lane);
        if (m2 < M) x_rows_load<4>(va, P.xp + (size_t)m2 * D, lane);
        if (m1 < M) x_rows_finish<4>(vb, (bf16*)(P.ws + WS_XB) + (size_t)m1 * D, (float*)(P.ws + WS_RSTD) + m1, lane);
    }
}
template <class Side>
__device__ __forceinline__ void compress_prompt_units(const Ptrs& P, Frame& F, LAS float* part  , const Side& side  ) {
    constexpr int NUNITS = BATCH * 32 * 2;
    const int lane = F.lane, w = F.wave, rho = lane & 15, kq = lane >> 4;
    const GAS v4u* bfr = (const GAS v4u*)(P.ws + WS_BTC) + lane;
    const float* cbias = (const float*)(P.ws + WS_CBIAS);
    for (int unit = blockIdx.x; unit < NUNITS; unit += F.G) {
        const int j = unit & 1, b = unit >> 6, c0 = ((unit >> 1) & 31) * 8;
        const float* rb = P.out + O_PCMP + ((size_t)b * T + (c0 + (rho >> 1)) * 32) * 256 + j * 128 + (rho & 1) * 64 + 4 * kq;
        f32x4 a[4][4]; bf16x8 bb[4][8];
#pragma unroll
        for (int rr = 0; rr < 4; ++rr) { const int r = 4 * w + rr;
#pragma unroll
            for (int dh = 0; dh < 2; ++dh) { a[rr][2 * dh] = *(const GAS f32x4*)(rb + r * 256 + dh * 32); a[rr][2 * dh + 1] = *(const GAS f32x4*)(rb + r * 256 + dh * 32 + 16); } }
        f32x4 acc[4];
#pragma unroll
        for (int e = 0; e < 4; ++e) acc[e] = (f32x4){0.f, 0.f, 0.f, 0.f};
        if (unit == (int)blockIdx.x) side();
#pragma unroll
        for (int rr = 0; rr < 4; ++rr) { const int r = 4 * w + rr;
#pragma unroll
            for (int dh = 0; dh < 2; ++dh)
#pragma unroll
                for (int et = 0; et < 4; ++et) bb[rr & 1][dh * 4 + et] = __builtin_bit_cast(bf16x8, bfr[(size_t)((((j * 32 + r) * 2 + dh) * 4 + et) * 64)]);
#pragma unroll
            for (int dh = 0; dh < 2; ++dh) { const f32x4 x0 = a[rr][2 * dh], x1 = a[rr][2 * dh + 1];
                v4u wv; wv.x = pk2(x0.x, x0.y); wv.y = pk2(x0.z, x0.w); wv.z = pk2(x1.x, x1.y); wv.w = pk2(x1.z, x1.w);
                const bf16x8 af = __builtin_bit_cast(bf16x8, wv);
#pragma unroll
                for (int et = 0; et < 4; ++et) acc[et] = __builtin_amdgcn_mfma_f32_16x16x32_bf16(af, bb[rr & 1][dh * 4 + et], acc[et], 0, 0, 0); } }
        __syncthreads();
#pragma unroll
        for (int et = 0; et < 4; ++et) *(LAS f32x4*)(part + ((w * 4 + et) * 64 + lane) * 4) = acc[et];
        __syncthreads();
        if (w < 4) { const int et = w, e = 16 * et + rho; f32x4 sum = *(const LAS f32x4*)(part + ((0 * 4 + et) * 64 + lane) * 4);
#pragma unroll
          for (int ww = 1; ww < 8; ++ww) sum = sum + *(const LAS f32x4*)(part + ((ww * 4 + et) * 64 + lane) * 4);
          const float bs = cbias[j * 64 + e];
          float nmax = 0.f;
#pragma unroll
          for (int i = 0; i < 4; ++i) { const int row = 4 * kq + i, c = c0 + (row >> 1), g = row & 1; const float val = sum[i] + bs;
              float q2 = val * val; q2 += __shfl_xor(q2, 1); q2 += __shfl_xor(q2, 2); q2 += __shfl_xor(q2, 4); q2 += __shfl_xor(q2, 8); nmax = fmaxf(nmax, q2);
              bf16* img = (bf16*)(P.ws + WS_KC) + ((size_t)(b * 2 + g) * 4 + (c >> 6)) * 8192;
              if (j == 0) img[kimg_off(c & 63, e)] = (bf16)f2bf(val); else img[vimg_off(e, (c & 48) + perm16(c & 15))] = (bf16)f2bf(val); }
          if (j == 0) { nmax = fmaxf(nmax, __shfl_xor(nmax, 16)); nmax = fmaxf(nmax, __shfl_xor(nmax, 32));
              if (lane == 0) atomicMax((unsigned*)(P.ws + WS_CTL) + CW_KCMAX + et, __builtin_bit_cast(unsigned, nmax)); } }
    }
}
constexpr int P0_PRODUCERS = 641;
__device__ __forceinline__ void p0_small_items(const Ptrs& P, Frame& F) {
    const int lane = F.lane, gw = F.gw;
    if (gw >= P0_PRODUCERS && F.NGW >= P0_PRODUCERS) return;
    for (int item = gw; item < P0_PRODUCERS; item += F.NGW) {
        if (item < 512) { const int it = item * 64 + lane; const int l = it & 63, et = (it >> 6) & 3, dh = (it >> 8) & 1, r = (it >> 9) & 31, j = it >> 14;
            const float* w = P.cmp_w + ((size_t)(r * 2 + j) * 64 + 32 * dh + 4 * (l >> 4)) * 64 + 16 * et + (l & 15);
            v4u o; o.x = pk2(w[0], w[64]); o.y = pk2(w[128], w[192]); o.z = pk2(w[16 * 64], w[17 * 64]); o.w = pk2(w[18 * 64], w[19 * 64]);
            __builtin_amdgcn_raw_buffer_store_b128(o, __builtin_amdgcn_make_buffer_rsrc((void*)(P.ws + WS_BTC), 0, 512 * 1024, 0x00020000), it * 16, 0, 16);
        } else if (item < 640) { const int it = item - 512, j = it >> 6, e = it & 63; float s = 0.f;
            for (int k = lane; k < 2048; k += 64) { const int r = k >> 6, d = k & 63; s += P.cmp_pe[(r * 2 + j) * 64 + d] * P.cmp_w[((size_t)(r * 2 + j) * 64 + d) * 64 + e]; }
            s = wave_sum(s); if (lane == 0) __hip_atomic_store((float*)(P.ws + WS_CBIAS) + it, s, RLX_AGENT);
        } else { float qm = fabsf(P.q_gain[lane]), k1 = fabsf(P.k_gain[64 + lane]), k2 = fabsf(P.k_gain[128 + lane]);
#pragma unroll
            for (int o = 1; o < 64; o <<= 1) { qm = fmaxf(qm, __shfl_xor(qm, o)); k1 = fmaxf(k1, __shfl_xor(k1, o)); k2 = fmaxf(k2, __shfl_xor(k2, o)); }
            if (lane == 0) { float* cst = (float*)(P.ws + WS_CONST); __hip_atomic_store(cst + 0, qm, RLX_AGENT); __hip_atomic_store(cst + 1, 8.0f * qm * k1 * LOG2E * 1.001f, RLX_AGENT); __hip_atomic_store(cst + 2, 8.0f * qm * k2 * LOG2E * 1.001f, RLX_AGENT); } }
        asm volatile("s_waitcnt vmcnt(0)" ::: "memory");
        if (lane == 0) __hip_atomic_fetch_add((unsigned*)(F.ctl + CW_P0CNT), 1u, RLX_AGENT);
    }
}
__device__ __forceinline__ void p0_rope(const Ptrs& P, Frame& F, int gw, int NGW) {
    const int lane = F.lane; const int i = lane & 31;
    const float inv = (float)pow(10000.0, -(double)i / 32.0);
    for (int it = gw * 64 + lane; it < 8193 * 32; it += NGW * 64) { const int p = it >> 5; const int pos = (p == 8192) ? PAST : p;
        const float ang = (float)pos * inv; const double rev = (double)ang * 0.15915494309189535; const float fr = (float)(rev - __builtin_rint(rev));
        float* rt = (float*)(P.ws + WS_ROPE) + (size_t)p * 64; rt[i] = __builtin_amdgcn_cosf(fr); rt[32 + i] = __builtin_amdgcn_sinf(fr); }
}
__device__ __forceinline__ void p0_other_slice(const Ptrs& P, Frame& F, int k, int gw, int NGW, LAS float* scr) {
    const int lane = F.lane;
    if (k < 2) { const int it = gw + k * NGW; if (it < 16 * 128) { const int kb = it >> 7, dg = it & 127; int nv; const int src0 = bt1_src(dg, nv);
        p0_transpose_item(P.w_in, INW, 64 * kb, src0, nv, P.norm_g, (bf16*)(P.ws + WS_BT1), D, 32 * dg, scr, lane); }
    } else if (k == 2) { for (int it = gw; it < 16 * 32; it += NGW) { const int kb = it >> 5, nb = it & 31;
        p0_transpose_item(P.w_out, D, 64 * kb, 32 * nb, 32, nullptr, (bf16*)(P.ws + WS_BT2), D, 32 * nb, scr, lane); }
    } else if (k == 3) { x_rows_stream(P, gw * 4, NGW * 4, lane);
    } else if (k < 11) {
    } else if (k == 11) { for (int m = gw; m < DECB; m += NGW) x_rows_to_bf16<1>(P.xs + (size_t)m * D, (bf16*)(P.ws + WS_XSB) + (size_t)m * D, (float*)(P.ws + WS_RSTDS) + m, lane);
        for (int it = gw * 64 + lane; it < DECB * 512; it += NGW * 64) { const int b = it >> 9, ch = it & 511; P.out[O_SCONV + (size_t)b * 1024 + ch] = P.st_conv[(size_t)b * 1024 + 512 + ch]; }
    } else if (k == 12) {
        constexpr int PERB = 511 * 64, TOTAL = DECB * PERB; const GAS f32x4* src = (const GAS f32x4*)P.st_win; GAS f32x4* dst = (GAS f32x4*)(P.out + O_SWIN);
        for (int i0 = gw * 64 + lane; i0 < TOTAL; i0 += NGW * 64 * 8) { f32x4 t[8];
#pragma unroll
            for (int u = 0; u < 8; ++u) { const int i = i0 + u * NGW * 64; if (i < TOTAL) { const int b = i / PERB; t[u] = src[i + 64 * b + 64]; } }
#pragma unroll
            for (int u = 0; u < 8; ++u) { const int i = i0 + u * NGW * 64; if (i < TOTAL) { const int b = i / PERB; dst[i + 64 * b] = t[u]; } } }
    } else if (k == 13) p0_rope(P, F, gw, NGW);
}
constexpr int P0_OTHER_SLICES = 14;
__device__ __forceinline__ void p0_phase(const Ptrs& P, Frame& F) {
    p0_small_items(P, F);
    LAS float* scr = (LAS float*)(F.lds + RING_OFF + F.wave * 16384);
    for (int k = 0; k < P0_OTHER_SLICES; ++k) p0_other_slice(P, F, k, F.gw, F.NGW, scr);
}
constexpr int CW_NS = 4, CW_NPASS = DECB * 8;
#define CW_LOAD(dst, base, r) do { _Pragma("unroll") for (int q_ = 0; q_ < 4; ++q_) { dst[2 * q_] = *(const GAS f32x4*)((base) + (r) * 256 + (q_ >> 1) * 128 + (q_ & 1) * 32); dst[2 * q_ + 1] = *(const GAS f32x4*)((base) + (r) * 256 + (q_ >> 1) * 128 + (q_ & 1) * 32 + 16); } } while (0)
template <int S>
__device__ __forceinline__ void cw_step(f32x4 (&a)[CW_NS][8], v4u (&vb)[4], f32x4 (&acc)[2][4], const float*& rp, int& nr, const GAS v4u*& bp, int& nb, LAS v4u* bdst, const LAS v4u* bl_lane) {
    if constexpr ((S & 1) == 0) {
#pragma unroll
        for (int i = 0; i < 4; ++i) vb[i] = bp[i];
        if (nb < 15) { ++nb; bp += 1024; } asm volatile("" : "+v"(bp));
        __builtin_amdgcn_sched_barrier(0); }
    CW_LOAD(a[(S + CW_NS - 1) % CW_NS], rp, 0); if (nr < 31) { ++nr; rp += 256; } asm volatile("" : "+v"(rp)); __builtin_amdgcn_sched_barrier(0);
    { const LAS v4u* bf = bl_lane + (S >> 1) * 2048 + (S & 1) * 1024;
#pragma unroll
      for (int q_ = 0; q_ < 4; ++q_) { const int j = q_ >> 1; const f32x4 x0 = a[S][2 * q_], x1 = a[S][2 * q_ + 1];
          v4u wv; wv.x = pk2(x0.x, x0.y); wv.y = pk2(x0.z, x0.w); wv.z = pk2(x1.x, x1.y); wv.w = pk2(x1.z, x1.w);
          const bf16x8 af = __builtin_bit_cast(bf16x8, wv);
#pragma unroll
          for (int et = 0; et < 4; ++et) acc[j][et] = __builtin_amdgcn_mfma_f32_16x16x32_bf16(af, __builtin_bit_cast(bf16x8, bf[(q_ * 4 + et) * 64]), acc[j][et], 0, 0, 0); } }
    if constexpr ((S & 1) == 1) {
        LDS_WAIT(); LAS v4u* d_ = bdst + (((S >> 1) + 1) & 1) * 2048;
#pragma unroll
        for (int i = 0; i < 4; ++i) d_[i] = vb[i];
        LDS_WAIT(); asm volatile("" ::: "memory"); __builtin_amdgcn_s_barrier(); asm volatile("" ::: "memory"); }
}
__device__ __forceinline__ void compress_wg(const Ptrs& P, Frame& F, LAS unsigned char* bl  ) {
    const int lane = F.lane, w = F.wave, tid = w * 64 + lane, rho = lane & 15, kq = lane >> 4;
    const int sf = tid >> 4, ssr = sf >> 4, sj = (sf >> 3) & 1, sdh = (sf >> 2) & 1, set_ = sf & 3, sl = (tid & 15) * 4;
    const GAS v4u* bs0 = (const GAS v4u*)(P.ws + WS_BTC) + (size_t)((((sj * 32 + ssr) * 2 + sdh) * 4 + set_) * 64 + sl);
    LAS v4u* bdst = (LAS v4u*)bl + sf * 64 + sl; const LAS v4u* bl_lane = (const LAS v4u*)bl + lane;
    const float* cbias = (const float*)(P.ws + WS_CBIAS);
    for (int pass = blockIdx.x; pass < CW_NPASS; pass += F.G) {
        const int b = pass >> 3, c0 = (pass & 7) * 64 + w * 8;
        const float* rb; { const int c = c0 + (rho >> 1), g = rho & 1; const int page = P.page_table[b * NPAGES + (c >> 2)]; rb = P.cache_cmp + ((size_t)page * 128 + (c & 3) * 32) * 256 + g * 64 + 4 * kq; }
        f32x4 a[CW_NS][8]; v4u vb[4]; f32x4 acc[2][4];
#pragma unroll
        for (int i = 0; i < 4; ++i) vb[i] = bs0[i];
#pragma unroll
        for (int r = 0; r < CW_NS - 1; ++r) CW_LOAD(a[r], rb, r);
        const float* rp = rb + (CW_NS - 1) * 256; const GAS v4u* bp = bs0 + 1024; int nr = CW_NS - 1, nb = 1; asm volatile("" : "+v"(rp), "+v"(bp));
#pragma unroll
        for (int j = 0; j < 2; ++j)
#pragma unroll
            for (int e = 0; e < 4; ++e) acc[j][e] = (f32x4){0.f, 0.f, 0.f, 0.f};
        asm volatile("" ::: "memory"); __builtin_amdgcn_s_barrier(); asm volatile("" ::: "memory");
#pragma unroll
        for (int i = 0; i < 4; ++i) bdst[i] = vb[i];
        LDS_WAIT(); asm volatile("" ::: "memory"); __builtin_amdgcn_s_barrier(); asm volatile("" ::: "memory");
#pragma unroll 1
        for (int it = 0; it < 8; ++it) { cw_step<0>(a, vb, acc, rp, nr, bp, nb, bdst, bl_lane); cw_step<1>(a, vb, acc, rp, nr, bp, nb, bdst, bl_lane);
            cw_step<2>(a, vb, acc, rp, nr, bp, nb, bdst, bl_lane); cw_step<3>(a, vb, acc, rp, nr, bp, nb, bdst, bl_lane); }
        float nmax = 0.f;
#pragma unroll
        for (int i = 0; i < 4; ++i) { const int row = 4 * kq + i, c = c0 + (row >> 1), g = row & 1; float q2 = 0.f;
#pragma unroll
            for (int j = 0; j < 2; ++j)
#pragma unroll
                for (int et = 0; et < 4; ++et) { const int e = 16 * et + rho; const float val = acc[j][et][i] + cbias[j * 64 + e]; if (j == 0) q2 += val * val;
                    ((float*)(P.ws + WS_KCS))[((size_t)((b * 2 + g) * 2 + j) * NCS + c) * 64 + e] = val; }
            q2 += __shfl_xor(q2, 1); q2 += __shfl_xor(q2, 2); q2 += __shfl_xor(q2, 4); q2 += __shfl_xor(q2, 8); nmax = fmaxf(nmax, q2); }
        nmax = fmaxf(nmax, __shfl_xor(nmax, 16)); nmax = fmaxf(nmax, __shfl_xor(nmax, 32));
        if (lane == 0) atomicMax((unsigned*)(P.ws + WS_CTL) + CW_KCMAX + 64, __builtin_bit_cast(unsigned, nmax));
    }
}
struct EpiIn {
    static constexpr bool PERM = false, AFTER_DRAIN = false;
    const float *rstd, *rope, *qg, *kg; float* out; unsigned char* ws;
    __device__ __forceinline__ void operator()(const f32x4 (&acc)[2][2][4][2], const pg8::Unit& u, int wr, int wc, int fr, int fq) const {
        asm volatile("" : "+v"(fr), "+v"(fq));
        const int pn = u.pn; const int rbase = u.pm * 256 + wr * 64 + fr;
        if (pn < 8) {
            const bool bz = pn < 4; bf16* dst = (bf16*)(ws + (bz ? WS_CG : WS_U)); const int col0 = 128 * (pn & 3) + 32 * wc + 4 * fq;
#pragma unroll
            for (int ai = 0; ai < 2; ++ai)
#pragma unroll
                for (int m = 0; m < 4; ++m) { const int row = rbase + ai * 128 + m * 16; const float rs = rstd[row];
#pragma unroll
                    for (int n = 0; n < 2; ++n) { const f32x4 a = acc[ai][0][m][n] * rs, z = acc[ai][1][m][n] * rs; f32x4 o;
                        if (bz) { o.x = a.x * z.x * sigmoidf(z.x); o.y = a.y * z.y * sigmoidf(z.y); o.z = a.z * z.z * sigmoidf(z.z); o.w = a.w * z.w * sigmoidf(z.w); }
                        else o = a * z;
                        v2u w; w.x = pk2(o.x, o.y); w.y = pk2(o.z, o.w);
                        *(GAS v2u*)(dst + (size_t)row * 512 + col0 + 16 * n) = w;
                        if (!bz) { const int t = row & (T - 1); if (t >= T - 2) *(GAS f32x4*)(out + O_PCONV + ((size_t)(row >> 13) * 2 + (t - (T - 2))) * 512 + col0 + 16 * n) = o; } } }
        } else if (pn < 13) {
            const bool isq = pn < 10; const int br = pn - 10; const bool isk = !isq && wc < 2;
            if (isq || isk) {
                const float* gain = isq ? qg : kg + br * 64; float g1[2][4], g2[2][4];
#pragma unroll
                for (int n = 0; n < 2; ++n)
#pragma unroll
                    for (int e = 0; e < 4; ++e) { g1[n][e] = gain[16 * n + 4 * fq + e]; g2[n][e] = gain[32 + 16 * n + 4 * fq + e]; }
#pragma unroll
                for (int ai = 0; ai < 2; ++ai)
#pragma unroll
                    for (int m = 0; m < 4; ++m) { const int row = rbase + ai * 128 + m * 16; const float rs = rstd[row]; const int t = row & (T - 1), b = row >> 13;
                        f32x4 x1[2], x2[2]; float ss = 0.f;
#pragma unroll
                        for (int n = 0; n < 2; ++n) { x1[n] = acc[ai][0][m][n] * rs; x2[n] = acc[ai][1][m][n] * rs;
                            ss += (x1[n].x * x1[n].x + x1[n].y * x1[n].y) + (x1[n].z * x1[n].z + x1[n].w * x1[n].w) + (x2[n].x * x2[n].x + x2[n].y * x2[n].y) + (x2[n].z * x2[n].z + x2[n].w * x2[n].w); }
                        ss += __shfl_xor(ss, 16); ss += __shfl_xor(ss, 32);
                        const float inv = 1.0f / sqrtf(ss * (1.0f / 64.0f) + NORM_EPS);
                        const float* rp = rope + (size_t)t * 64 + 4 * fq;
#pragma unroll
                        for (int n = 0; n < 2; ++n) { const f32x4 cs = *(const GAS f32x4*)(rp + 16 * n), sn = *(const GAS f32x4*)(rp + 32 + 16 * n); f32x4 o1, o2;
#pragma unroll
                            for (int e = 0; e < 4; ++e) { const float a = x1[n][e] * inv * g1[n][e], c = x2[n][e] * inv * g2[n][e]; o1[e] = a * cs[e] - c * sn[e]; o2[e] = c * cs[e] + a * sn[e]; }
                            const int d1 = 16 * n + 4 * fq;
                            if (isq) { o1 = o1 * QSCALE; o2 = o2 * QSCALE; bf16* q = (bf16*)(ws + WS_Q) + (size_t)row * 512 + (4 * (pn - 8) + wc) * 64 + d1;
                                v2u w; w.x = pk2(o1.x, o1.y); w.y = pk2(o1.z, o1.w); *(GAS v2u*)q = w; w.x = pk2(o2.x, o2.y); w.y = pk2(o2.z, o2.w); *(GAS v2u*)(q + 32) = w; }
                            else { const int g = wc;
                                if (br > 0) { bf16* img = (bf16*)(ws + (br == 1 ? WS_KS : WS_KW)) + ((size_t)(b * 2 + g) * 128 + (t >> 6)) * 8192;
                                    v2u w; w.x = pk2(o1.x, o1.y); w.y = pk2(o1.z, o1.w); *(GAS v2u*)(img + kimg_off(t & 63, d1)) = w; w.x = pk2(o2.x, o2.y); w.y = pk2(o2.z, o2.w); *(GAS v2u*)(img + kimg_off(t & 63, d1 + 32)) = w; }
                                if (br < 2) { float* o = out + (br == 0 ? O_PCMP : O_PSLC) + (size_t)row * 256 + g * 64 + d1; *(GAS f32x4*)o = o1; *(GAS f32x4*)(o + 32) = o2; }
                                else if (t >= T - 512) { float* o = out + O_PWIN + ((size_t)b * 512 + (t - (T - 512))) * 256 + g * 64 + d1; *(GAS f32x4*)o = o1; *(GAS f32x4*)(o + 32) = o2; } } } }
            } else {
                const int g = wc - 2;
#pragma unroll
                for (int ai = 0; ai < 2; ++ai)
#pragma unroll
                    for (int m = 0; m < 4; ++m) { const int row = rbase + ai * 128 + m * 16; const float rs = rstd[row]; const int t = row & (T - 1), b = row >> 13;
                        const int tk = t & 63, vpos = (tk & ~15) + perm16(tk & 15);
                        bf16* vt = (br > 0) ? (bf16*)(ws + (br == 1 ? WS_KS : WS_KW)) + ((size_t)(b * 2 + g) * 128 + (t >> 6)) * 8192 : nullptr;
                        const float vsc = (br == 1) ? slc_vscale(((const float*)(ws + WS_CONST))[1]) : 1.0f;
#pragma unroll
                        for (int bj = 0; bj < 2; ++bj)
#pragma unroll
                            for (int n = 0; n < 2; ++n) { const f32x4 v = acc[ai][bj][m][n] * rs; const int d1 = 32 * bj + 16 * n + 4 * fq;
                                if (br > 0) {
#pragma unroll
                                    for (int e = 0; e < 4; ++e) vt[vimg_off(d1 + e, vpos)] = (bf16)f2bf(v[e] * vsc); }
                                if (br < 2) *(GAS f32x4*)(out + (br == 0 ? O_PCMP : O_PSLC) + (size_t)row * 256 + 128 + g * 64 + d1) = v;
                                else if (t >= T - 512) *(GAS f32x4*)(out + O_PWIN + ((size_t)b * 512 + (t - (T - 512))) * 256 + 128 + g * 64 + d1) = v; } }
            }
        } else if (pn < 15) {
            bf16* dst = (bf16*)(ws + WS_ZA);
#pragma unroll
            for (int ai = 0; ai < 2; ++ai)
#pragma unroll
                for (int m = 0; m < 4; ++m) { const int row = rbase + ai * 128 + m * 16; const float rs = rstd[row];
#pragma unroll
                    for (int bj = 0; bj < 2; ++bj)
#pragma unroll
                        for (int n = 0; n < 2; ++n) { const f32x4 z = acc[ai][bj][m][n] * rs; v2u w; w.x = pk2(z.x * sigmoidf(z.x), z.y * sigmoidf(z.y)); w.y = pk2(z.z * sigmoidf(z.z), z.w * sigmoidf(z.w));
                            *(GAS v2u*)(dst + (size_t)row * 512 + 256 * (pn - 13) + 128 * bj + 32 * wc + 16 * n + 4 * fq) = w; } }
        } else {
            if (wc == 0) { float* dst = (float*)(ws + WS_GATE);
#pragma unroll
                for (int ai = 0; ai < 2; ++ai)
#pragma unroll
                    for (int m = 0; m < 4; ++m) { const int row = rbase + ai * 128 + m * 16; const float rs = rstd[row];
#pragma unroll
                        for (int n = 0; n < 2; ++n) { const int c0 = 16 * n + 4 * fq; if (c0 < 24) { const f32x4 z = acc[ai][0][m][n] * rs;
                            *(GAS f32x4*)(dst + (size_t)row * 24 + c0) = (f32x4){sigmoidf(z.x), sigmoidf(z.y), sigmoidf(z.z), sigmoidf(z.w)}; } } } }
        }
    }
};
struct EpiOut {
    static constexpr bool PERM = false, AFTER_DRAIN = false;
    const bf16* x; float* y;
    __device__ __forceinline__ void operator()(const f32x4 (&acc)[2][2][4][2], const pg8::Unit& u, int wr, int wc, int fr, int fq) const {
        asm volatile("" : "+v"(fr), "+v"(fq));
#pragma unroll
        for (int ai = 0; ai < 2; ++ai)
#pragma unroll
            for (int m = 0; m < 4; ++m) { const size_t row = (size_t)u.pm * 256 + ai * 128 + wr * 64 + m * 16 + fr;
#pragma unroll
                for (int bj = 0; bj < 2; ++bj)
#pragma unroll
                    for (int n = 0; n < 2; ++n) { const size_t off = row * D + u.pn * 256 + 128 * bj + 32 * wc + 16 * n + 4 * fq;
                        const v2u xv = *(const GAS v2u*)(x + off);
                        *(GAS f32x4*)(y + off) = (f32x4){bf2f(xv.x & 0xffffu), bf2f(xv.x >> 16), bf2f(xv.y & 0xffffu), bf2f(xv.y >> 16)} + acc[ai][bj][m][n]; } }
    }
};
template <int MODE>
__device__ __forceinline__ void small_gemm_tile(const Ptrs& P, const bf16* A, const bf16* Bt, int ct, int lane) {
    const int rho = lane & 15, kq = lane >> 4;
    f32x4 acc[2] = {(f32x4){0.f, 0.f, 0.f, 0.f}, (f32x4){0.f, 0.f, 0.f, 0.f}};
    const GAS v4u* a0 = (const GAS v4u*)(A + (size_t)rho * D + 8 * kq); const GAS v4u* a1 = (const GAS v4u*)(A + (size_t)(16 + rho) * D + 8 * kq);
    const GAS v4u* bp = (const GAS v4u*)(Bt + (size_t)(16 * ct + rho) * D + 8 * kq);
#pragma unroll 8
    for (int ks = 0; ks < 32; ++ks) { const bf16x8 bb = __builtin_bit_cast(bf16x8, bp[ks * 4]);
        acc[0] = __builtin_amdgcn_mfma_f32_16x16x32_bf16(bb, __builtin_bit_cast(bf16x8, a0[ks * 4]), acc[0], 0, 0, 0);
        acc[1] = __builtin_amdgcn_mfma_f32_16x16x32_bf16(bb, __builtin_bit_cast(bf16x8, a1[ks * 4]), acc[1], 0, 0, 0); }
#pragma unroll
    for (int rt = 0; rt < 2; ++rt) { const int b = 16 * rt + rho; const int col = 16 * ct + 4 * kq;
        if (MODE == 0) { const float rs = ((const float*)(P.ws + WS_RSTDS))[b]; *(GAS f32x4*)((float*)(P.ws + WS_PROJS) + (size_t)b * NP + col) = acc[rt] * rs; }
        else *(GAS f32x4*)(P.out + O_YS + (size_t)b * D + col) = *(const GAS f32x4*)(P.xs + (size_t)b * D + col) + acc[rt]; }
}
template <int MODE>
__device__ __forceinline__ void small_gemm_tile_ksplit(const Ptrs& P, const bf16* A, const bf16* Bt, int ct, Frame& F, LAS float* red  ) {
    const int lane = F.lane, w = F.wave, rho = lane & 15, kq = lane >> 4;
    const GAS v4u* a0 = (const GAS v4u*)(A + (size_t)rho * D + 8 * kq) + 16 * w; const GAS v4u* a1 = (const GAS v4u*)(A + (size_t)(16 + rho) * D + 8 * kq) + 16 * w;
    const GAS v4u* bp = (const GAS v4u*)(Bt + (size_t)(16 * ct + rho) * D + 8 * kq) + 16 * w;
    v4u av0[4], av1[4], bv[4];
#pragma unroll
    for (int ks = 0; ks < 4; ++ks) { bv[ks] = bp[ks * 4]; av0[ks] = a0[ks * 4]; av1[ks] = a1[ks * 4]; }
    f32x4 acc[2] = {(f32x4){0.f, 0.f, 0.f, 0.f}, (f32x4){0.f, 0.f, 0.f, 0.f}};
#pragma unroll
    for (int ks = 0; ks < 4; ++ks) { const bf16x8 bb = __builtin_bit_cast(bf16x8, bv[ks]);
        acc[0] = __builtin_amdgcn_mfma_f32_16x16x32_bf16(bb, __builtin_bit_cast(bf16x8, av0[ks]), acc[0], 0, 0, 0);
        acc[1] = __builtin_amdgcn_mfma_f32_16x16x32_bf16(bb, __builtin_bit_cast(bf16x8, av1[ks]), acc[1], 0, 0, 0); }
    __syncthreads();
#pragma unroll
    for (int rt = 0; rt < 2; ++rt) *(LAS f32x4*)(red + ((w * 2 + rt) * 64 + lane) * 4) = acc[rt];
    __syncthreads();
    if (w == 0) {
#pragma unroll
        for (int rt = 0; rt < 2; ++rt) { f32x4 sum = *(const LAS f32x4*)(red + (rt * 64 + lane) * 4);
#pragma unroll
            for (int ww = 1; ww < 8; ++ww) sum = sum + *(const LAS f32x4*)(red + ((ww * 2 + rt) * 64 + lane) * 4);
            const int b = 16 * rt + rho; const int col = 16 * ct + 4 * kq;
            if (MODE == 0) { const float rs = ((const float*)(P.ws + WS_RSTDS))[b]; *(GAS f32x4*)((float*)(P.ws + WS_PROJS) + (size_t)b * NP + col) = sum * rs; }
            else *(GAS f32x4*)(P.out + O_YS + (size_t)b * D + col) = *(const GAS f32x4*)(P.xs + (size_t)b * D + col) + sum; } }
}
__device__ __forceinline__ int projs_col(int pn, int wc, int d) { return 256 * pn + 128 * (d >> 5) + 32 * wc + (d & 31); }
__device__ __forceinline__ void p2_sample_item(const Ptrs& P, int it, int lane) {
    const int b = it / 37, ty = it - b * 37;
    const float* pr = (const float*)(P.ws + WS_PROJS) + (size_t)b * NP;
    const float* ropes = (const float*)(P.ws + WS_ROPE) + (size_t)8192 * 64;
    float* kvn = (float*)(P.ws + WS_KVN) + (size_t)b * 768;
    if (ty < 14) {
        const bool isq = ty < 8; const int br = isq ? 0 : (ty - 8) >> 1, g = (ty - 8) & 1;
        const int pn = isq ? 8 + (ty >> 2) : 10 + br, wc = isq ? (ty & 3) : g;
        const float v = pr[projs_col(pn, wc, lane)];
        const float ss = wave_sum(v * v); const float inv = 1.0f / sqrtf(ss * (1.0f / 64.0f) + NORM_EPS);
        const float gn = isq ? P.q_gain[lane] : P.k_gain[br * 64 + lane];
        const float xn = v * inv * gn; const float xo = __shfl_xor(xn, 32);
        const int i = lane & 31; const float cs = ropes[i], sn = ropes[32 + i];
        const float o = (lane < 32) ? xn * cs - xo * sn : xn * cs + xo * sn;
        if (isq) ((float*)(P.ws + WS_QS))[(size_t)b * 512 + ty * 64 + lane] = o * QSCALE;
        else { kvn[(br * 2 + 0) * 128 + g * 64 + lane] = o;
            if (br == 0) P.out[O_SCMP + (size_t)b * 256 + g * 64 + lane] = o; else if (br == 1) P.out[O_SSLC + (size_t)b * 256 + g * 64 + lane] = o;
            else P.out[O_SWIN + ((size_t)b * 512 + 511) * 256 + g * 64 + lane] = o; }
    } else if (ty < 20) {
        const int br = (ty - 14) >> 1, g = (ty - 14) & 1; const float v = pr[projs_col(10 + br, 2 + g, lane)];
        kvn[(br * 2 + 1) * 128 + g * 64 + lane] = v;
        if (br == 0) P.out[O_SCMP + (size_t)b * 256 + 128 + g * 64 + lane] = v; else if (br == 1) P.out[O_SSLC + (size_t)b * 256 + 128 + g * 64 + lane] = v;
        else P.out[O_SWIN + ((size_t)b * 512 + 511) * 256 + 128 + g * 64 + lane] = v;
    } else if (ty == 20) {
        if (lane < 24) ((float*)(P.ws + WS_GS))[b * 24 + lane] = sigmoidf(pr[256 * 15 + lane]);
    } else if (ty < 29) {
        const int ch = (ty - 21) * 64 + lane; const int pnb = ch >> 7, tc = ch & 127;
        const float bg = pr[256 * pnb + tc], zc = pr[256 * pnb + 128 + tc], cg = pr[256 * (4 + pnb) + tc], ci = pr[256 * (4 + pnb) + 128 + tc];
        const float u = cg * ci; const float s0 = P.st_conv[(size_t)b * 1024 + ch], s1 = P.st_conv[(size_t)b * 1024 + 512 + ch];
        const float cy = P.conv_w[ch] * s0 + P.conv_w[512 + ch] * s1 + P.conv_w[1024 + ch] * u + P.conv_b[ch];
        ((bf16*)(P.ws + WS_MIXS))[(size_t)b * 1024 + ch] = (bf16)f2bf(bg * cy * zc * sigmoidf(zc));
        P.out[O_SCONV + (size_t)b * 1024 + 512 + ch] = u;
    } else {
        const int col = (ty - 29) * 64 + lane; const float z = pr[256 * (13 + (col >> 8)) + (col & 255)];
        ((float*)(P.ws + WS_ZAS))[(size_t)b * 512 + col] = z * sigmoidf(z);
    }
}
__device__ __forceinline__ void p2_phase(const Ptrs& P, Frame& F) {
    compress_prompt_units(P, F, (LAS float*)(F.lds + RING_OFF), [&]() { for (int it = F.gw; it < DECB * 37; it += F.NGW) p2_sample_item(P, it, F.lane); });
    if ((int)blockIdx.x >= BATCH * 64) for (int it = F.gw; it < DECB * 37; it += F.NGW) p2_sample_item(P, it, F.lane);
}
#define MFMA32(a, b, c) __builtin_amdgcn_mfma_f32_32x32x16_bf16(a, b, c, 0, 0, 0)
constexpr int P3_IMP = 0, P3_QL = 32768;
constexpr int P3_NEXT = LDSCTL_OFF + 512, P3_CNT = LDSCTL_OFF + 1024, P3_LISTS = LDSCTL_OFF + 2048, P3_LACC = LDSCTL_OFF + 10240;
constexpr int P3_RING = 65536;
constexpr int P3_MISC = MISC_OFF + 64;
constexpr int SM_Q = 36864, SM_P = 40960, SM_RED = 57344, SM_IMP = 66048, SM_L = 67200, SM_SEL = 67328, SM_O = 67584, SM_VP = 71680  , SM_RED2 = 79872  ;

template <bool MASK>
__device__ __forceinline__ void attend_lds(const LAS unsigned char* blk, const bf16x8 (&qf)[4], f32x16 (&O)[2], float& lsum,
                                           int kbase, int lo, int hi, int lane, bool want_pv, f32x16 (*Sout)[2] = nullptr) {
    const int hh = lane >> 5;
    const LAS unsigned char* kb = blk + lane * 16; const LAS unsigned char* vb = blk + 8192 + lane * 16;
#pragma unroll
    for (int kt = 0; kt < 2; ++kt) {
        f32x16 S;
        { bf16x8 kf[4];
#pragma unroll
          for (int s = 0; s < 4; ++s) kf[s] = *(const LAS bf16x8*)(kb + (kt * 4 + s) * 1024);
#pragma unroll
          for (int i = 0; i < 16; ++i) S[i] = 0.f;
#pragma unroll
          for (int s = 0; s < 4; ++s) S = MFMA32(kf[s], qf[s], S); }
#pragma unroll
        for (int i = 0; i < 16; ++i) { float p = fast_exp2(S[i]);
            if (MASK) { const int kp = kbase + 32 * kt + (i & 3) + 8 * (i >> 2) + 4 * hh; p = (kp >= lo && kp <= hi) ? p : 0.f; }
            S[i] = p; lsum += p; }
        if (Sout) (*Sout)[kt] = S;
        if (want_pv) {
            bf16x8 pf[2];
#pragma unroll
            for (int sp = 0; sp < 2; ++sp) { v4u w; w.x = pk2(S[8 * sp + 0], S[8 * sp + 1]); w.y = pk2(S[8 * sp + 2], S[8 * sp + 3]);
                w.z = pk2(S[8 * sp + 4], S[8 * sp + 5]); w.w = pk2(S[8 * sp + 6], S[8 * sp + 7]); pf[sp] = __builtin_bit_cast(bf16x8, w); }
#pragma unroll
            for (int dt = 0; dt < 2; ++dt)
#pragma unroll
                for (int sp = 0; sp < 2; ++sp) { const bf16x8 vf = *(const LAS bf16x8*)(vb + (dt * 4 + 2 * kt + sp) * 1024);
                    O[dt] = MFMA32(vf, pf[sp], O[dt]); }
        }
    }
}
__device__ __forceinline__ void wave_topk(const LAS float* imp, int jmax, int nsel, int lane, int qbase, LAS unsigned* cnt, LAS unsigned char* lists) {
    if (jmax < 1) return;
    const bool c0 = lane >= 1 && lane <= jmax, c1 = 64 + lane <= jmax;
    unsigned k0[8], k1[8], Tv[8];
#pragma unroll
    for (int qi = 0; qi < 8; ++qi) { k0[qi] = c0 ? ((__builtin_bit_cast(unsigned, imp[qi * 128 + lane]) + 0x800u) & ~0x7ffu) : 0u; k1[qi] = c1 ? ((__builtin_bit_cast(unsigned, imp[qi * 128 + 64 + lane]) + 0x800u) & ~0x7ffu) : 0u; Tv[qi] = 0u; }
    if (jmax > nsel) {
        for (int bit = 30; bit >= 11; --bit) {
#pragma unroll
            for (int qi = 0; qi < 8; ++qi) { const unsigned cand = Tv[qi] | (1u << bit);
                const int cn = __popcll(__ballot(k0[qi] >= cand)) + __popcll(__ballot(k1[qi] >= cand)); Tv[qi] = cn >= nsel ? cand : Tv[qi]; } }
    }
    const unsigned long long below = (lane == 0) ? 0ull : (~0ull >> (64 - lane));
    bool s0[8], s1[8]; unsigned p0[8], p1[8];
#pragma unroll
    for (int qi = 0; qi < 8; ++qi) {
        if (jmax > nsel) {
            const unsigned long long g0 = __ballot(k0[qi] > Tv[qi]), g1 = __ballot(k1[qi] > Tv[qi]), e0 = __ballot(k0[qi] == Tv[qi]), e1 = __ballot(k1[qi] == Tv[qi]);
            const int need = nsel - __popcll(g0) - __popcll(g1);
            const int rk0 = __popcll(e0 & below), rk1 = __popcll(e0) + __popcll(e1 & below);
            s0[qi] = k0[qi] > Tv[qi] || (k0[qi] == Tv[qi] && rk0 < need); s1[qi] = k1[qi] > Tv[qi] || (k1[qi] == Tv[qi] && rk1 < need);
        } else { s0[qi] = c0; s1[qi] = c1; }
    }
#pragma unroll
    for (int qi = 0; qi < 8; ++qi) { p0[qi] = 0u; p1[qi] = 0u;
        if (s0[qi]) p0[qi] = __hip_atomic_fetch_add(cnt + lane, 1u, __ATOMIC_RELAXED, __HIP_MEMORY_SCOPE_WORKGROUP);
        if (s1[qi]) p1[qi] = __hip_atomic_fetch_add(cnt + 64 + lane, 1u, __ATOMIC_RELAXED, __HIP_MEMORY_SCOPE_WORKGROUP); }
#pragma unroll
    for (int qi = 0; qi < 8; ++qi) {
        if (s0[qi]) lists[lane * 64 + p0[qi]] = (unsigned char)(qbase + qi);
        if (s1[qi]) lists[(64 + lane) * 64 + p1[qi]] = (unsigned char)(qbase + qi); }
}
struct BlkSrc { const bf16* img; };
#ifndef PROBE_SEG
#define PROBE_SEG 0
#endif
#define T_BEGIN(id) do { if (PROBE_SEG == (id)) tacc -= __builtin_readcyclecounter(); } while (0)
#define T_END(id) do { if (PROBE_SEG == (id)) tacc += __builtin_readcyclecounter(); } while (0)
__device__ __forceinline__ void p3_prompt_unit(const Ptrs& P, Frame& F, int b, int t, int g, float sh_cmp, float sh_slc, float sh_win, unsigned long long& tacc) {
    int lane = F.lane, w = F.wave, tid = F.tid; asm volatile("" : "+v"(lane), "+s"(w), "+v"(tid));
    const int col = lane & 31, hh = lane >> 5, qi = col >> 2, h = col & 3;
    const int tok = 64 * t + 8 * w + qi; const size_t row = (size_t)b * T + tok; const int qpos = tok;
    const int nck = (2 * t + 2 + 63) >> 6, nf = t >= 2 ? 3 : t + 1, nw = t >= 8 ? 9 : t + 1;
    const int n1 = nck, n2 = 2 * nck, n3 = n2 + nw, N1 = n3 + nf, wbase = t >= 8 ? t - 8 : 0;
    const bf16* KC = (const bf16*)(P.ws + WS_KC) + (size_t)(b * 2 + g) * 4 * 8192;
    const bf16* KS = (const bf16*)(P.ws + WS_KS) + (size_t)(b * 2 + g) * 128 * 8192;
    const bf16* KW = (const bf16*)(P.ws + WS_KW) + (size_t)(b * 2 + g) * 128 * 8192;
    auto src1 = [&](int n) -> BlkSrc {
        if (n < n2) { const int ck = n < n1 ? n : n - n1; return BlkSrc{KC + (size_t)ck * 8192}; }
        if (n < n3) return BlkSrc{KW + (size_t)(wbase + n - n2) * 8192};
        const int f = n - n3; const int j = f == 0 ? t : (f == 1 ? 0 : t - 1); return BlkSrc{KS + (size_t)j * 8192}; };
    LAS unsigned char* ring = F.lds + P3_RING;
#define ST_DMA(bs_, n) do { LAS unsigned char* d_ = ring + ((n) & 3) * 16384 + w * 2048; \
        __builtin_amdgcn_global_load_lds((const unsigned*)((bs_).img + (2 * w) * 512 + lane * 8), (LAS unsigned*)d_, 16, 0, 0); \
        __builtin_amdgcn_global_load_lds((const unsigned*)((bs_).img + (2 * w + 1) * 512 + lane * 8), (LAS unsigned*)(d_ + 1024), 16, 0, 0); } while (0)
#define BLK(n) (ring + ((n) & 3) * 16384)
#define STEP_BEGIN(SRC, n, NN) do { if (((n) & 1) == 0) { if ((n) + 2 < (NN)) { const BlkSrc b_ = SRC((n) + 2); ST_DMA(b_, (n) + 2); } if ((n) + 3 < (NN)) { const BlkSrc b_ = SRC((n) + 3); ST_DMA(b_, (n) + 3); } } } while (0)
#define STEP_END(n, NN) do { if (((n) & 1) == 1 || (n) == (NN) - 1) { asm volatile("s_waitcnt vmcnt(0)" ::: "memory"); __syncthreads(); } } while (0)
    LAS unsigned* cnt = (LAS unsigned*)(F.lds + P3_CNT); LAS unsigned char* lists = F.lds + P3_LISTS; LAS unsigned* nextb = (LAS unsigned*)(F.lds + P3_NEXT);
    LAS int* oacc = (LAS int*)ring; LAS int* lacc = (LAS int*)(F.lds + P3_LACC);
    const float FXS = slc_vscale(sh_slc), FXI = 1.0f / FXS;
    LAS unsigned char* ql = F.lds + P3_QL;
    T_BEGIN(1); T_BEGIN(8);
    __syncthreads();
    if (tid < 128) cnt[tid] = 0u; if (tid == 128) nextb[0] = 0u;
    { const BlkSrc b0 = src1(0); ST_DMA(b0, 0); if (N1 > 1) { const BlkSrc b1 = src1(1); ST_DMA(b1, 1); } }
    { const bf16* qg = (const bf16*)(P.ws + WS_Q) + ((size_t)b * T + 64 * t) * 512 + g * 256;
      v4u tq[4];
#pragma unroll
      for (int k = 0; k < 4; ++k) { const int c = tid + 512 * k, rq = c >> 3, ch = c & 7; tq[k] = *(const GAS v4u*)(qg + (size_t)(rq >> 2) * 512 + (rq & 3) * 64 + ch * 8); }
#pragma unroll
      for (int k = 0; k < 4; ++k) { const int c = tid + 512 * k, rq = c >> 3, ch = c & 7; *(LAS v4u*)(ql + rq * 128 + ((ch ^ ((rq >> 1) & 7)) << 4)) = tq[k]; } }
    bf16x8 qf[4];
    { const bf16* q = (const bf16*)(P.ws + WS_Q) + row * 512 + (g * 4 + h) * 64 + 8 * hh;
#pragma unroll
      for (int s = 0; s < 4; ++s) qf[s] = __builtin_bit_cast(bf16x8, *(const GAS v4u*)(q + 16 * s)); }
    const float* gate = (const float*)(P.ws + WS_GATE) + row * 24 + (g * 4 + h) * 3;
    const float g_cmp = gate[0], g_slc = gate[1], g_win = gate[2];
    asm volatile("s_waitcnt vmcnt(0)" ::: "memory"); __syncthreads();
    T_END(1); T_BEGIN(2);
    f32x16 O[2];
    LAS float* wl = (LAS float*)(F.lds + P3_IMP + w * 4096);
    LAS float* xw0 = (LAS float*)(F.lds + P3_IMP + w * 4096) + lane;
    f32x16 totr;
    const int nvis = (qpos + 1) >> 5;
    int n = 0;
    float lsum = 0.f;
    for (; n < n1; ++n) { STEP_BEGIN(src1, n, N1); attend_lds<true>(BLK(n), qf, O, lsum, 64 * n, 0, nvis - 1, lane, false); STEP_END(n, N1); }
    lsum += __shfl_xor(lsum, 32);
    const float rl = lsum > 0.f ? 1.0f / lsum : 0.f;
    for (int i = lane; i < 1024; i += 64) wl[i] = 0.f;
#pragma unroll
    for (int i = 0; i < 16; ++i) { O[0][i] = 0.f; O[1][i] = 0.f; }
    { float dummy = 0.f;
      for (; n < n2; ++n) { STEP_BEGIN(src1, n, N1); const int ck = n - n1; f32x16 Sn[2];
        attend_lds<true>(BLK(n), qf, O, dummy, 64 * ck, 0, nvis - 1, lane, true, &Sn);
#pragma unroll
        for (int kt = 0; kt < 2; ++kt)
#pragma unroll
            for (int i2 = 0; i2 < 8; ++i2) { const float v = quad_sum((Sn[kt][2 * i2] + Sn[kt][2 * i2 + 1]) * rl);
                if (h == 0) wl[qi * 128 + 32 * ck + 16 * kt + (i2 & 1) + 4 * (i2 >> 1) + 2 * hh] = v; }
        STEP_END(n, N1); } }
    LDS_WAIT(); asm volatile("" ::: "memory");
    T_END(2); T_BEGIN(3);
    wave_topk(wl, t - 2, 13, lane, 8 * w, cnt, lists);
    LDS_WAIT(); asm volatile("" ::: "memory");
#pragma unroll
    for (int i = 0; i < 16; ++i) { xw0[i * 64] = O[0][i] * (g_cmp * rl); totr[i] = O[1][i] * (g_cmp * rl); O[0][i] = 0.f; O[1][i] = 0.f; }
    T_END(3); T_BEGIN(6);
    lsum = 0.f;
    for (; n < n3; ++n) { STEP_BEGIN(src1, n, N1); const int j = wbase + n - n2;
        if (j == t || j + 8 == t) attend_lds<true>(BLK(n), qf, O, lsum, 64 * j, qpos - 511, qpos, lane, true);
        else attend_lds<false>(BLK(n), qf, O, lsum, 0, 0, 0, lane, true);
        STEP_END(n, N1); }
    lsum += __shfl_xor(lsum, 32);
    { const float sc = g_win / fmaxf(lsum, 1e-30f);
#pragma unroll
      for (int i = 0; i < 16; ++i) { xw0[i * 64] = xw0[i * 64] + O[0][i] * sc; totr[i] += O[1][i] * sc; O[0][i] = 0.f; O[1][i] = 0.f; } }
    T_END(6); T_BEGIN(4);
    lsum = 0.f;
    for (; n < N1; ++n) { STEP_BEGIN(src1, n, N1);
        if (n == n3) attend_lds<true>(BLK(n), qf, O, lsum, 64 * t, 0, qpos, lane, true);
        else attend_lds<false>(BLK(n), qf, O, lsum, 0, 0, 0, lane, true);
        STEP_END(n, N1); }
    lsum += __shfl_xor(lsum, 32);
#pragma unroll
    for (int dt = 0; dt < 2; ++dt)
#pragma unroll
        for (int i = 0; i < 16; ++i) oacc[(32 * dt + (i & 3) + 8 * (i >> 2) + 4 * hh) * 256 + 32 * w + col] = (int)O[dt][i];
    if (hh == 0) lacc[32 * w + col] = __float2int_rn(lsum * FXS);
    __syncthreads();
    T_END(4); T_BEGIN(5);
    if (t > 2) {
        const int r = lane & 31;
#define NEXT_BLOCK(jv_, nq_) do { for (;;) { unsigned t_ = 0u; if (lane == 0) t_ = __hip_atomic_fetch_add(nextb, 1u, __ATOMIC_RELAXED, __HIP_MEMORY_SCOPE_WORKGROUP); \
            jv_ = 1 + (int)__builtin_amdgcn_readfirstlane(t_); if (jv_ > t - 2) { nq_ = 0; break; } nq_ = (int)__builtin_amdgcn_readfirstlane(cnt[jv_]); if (nq_ > 0) break; } } while (0)
#define LOAD_K(kd_, jv_) do { const bf16* im_ = KS + (size_t)(jv_) * 8192 + lane * 8;     \
            _Pragma("unroll") for (int a_ = 0; a_ < 2; ++a_) _Pragma("unroll") for (int b_ = 0; b_ < 4; ++b_) kd_[a_][b_] = __builtin_bit_cast(bf16x8, *(const GAS v4u*)(im_ + (a_ * 4 + b_) * 512)); } while (0)
#define LOAD_V(vd_, jv_) do { const bf16* im_ = KS + (size_t)(jv_) * 8192 + 4096 + lane * 8; \
            _Pragma("unroll") for (int a_ = 0; a_ < 2; ++a_) _Pragma("unroll") for (int b_ = 0; b_ < 4; ++b_) vd_[a_][b_] = __builtin_bit_cast(bf16x8, *(const GAS v4u*)(im_ + (a_ * 4 + b_) * 512)); } while (0)
        bf16x8 kf[2][4], vf[2][4], kn[2][4];
        int j, nq; T_BEGIN(10); NEXT_BLOCK(j, nq); if (j <= t - 2) LOAD_K(kf, j); T_END(10);
        while (j <= t - 2) {
            T_BEGIN(10); LOAD_V(vf, j);
            int jn, nqn; NEXT_BLOCK(jn, nqn); LOAD_K(kn, (jn <= t - 2 ? jn : t - 2));
#pragma unroll
            for (int a_ = 0; a_ < 2; ++a_)
#pragma unroll
                for (int b_ = 0; b_ < 4; ++b_) asm volatile("" : "+v"(kf[a_][b_])); T_END(10);
            for (int c0 = 0; c0 < nq; c0 += 8) { T_BEGIN(11);
                const int sl = c0 + qi; const bool valid = sl < nq;
                const int rowq = (int)lists[j * 64 + (valid ? sl : nq - 1)] * 4 + h;
                const LAS unsigned char* qp = ql + rowq * 128; const int qsw = (rowq >> 1) & 7;
                bf16x8 q2[4];
#pragma unroll
                for (int s = 0; s < 4; ++s) q2[s] = *(const LAS bf16x8*)(qp + (((2 * s + hh) ^ qsw) << 4));
                float l2 = 0.f; bf16x8 pf[4]; f32x16 S0, S1;
#pragma unroll
                for (int i = 0; i < 16; ++i) { S0[i] = 0.f; S1[i] = 0.f; }
#pragma unroll
                for (int s = 0; s < 4; ++s) { S0 = MFMA32(kf[0][s], q2[s], S0); S1 = MFMA32(kf[1][s], q2[s], S1); }
#pragma unroll
                for (int i = 0; i < 16; ++i) { S0[i] = fast_exp2(S0[i]); l2 += S0[i]; }
#pragma unroll
                for (int sp = 0; sp < 2; ++sp) { v4u wv; wv.x = pk2(S0[8 * sp + 0], S0[8 * sp + 1]); wv.y = pk2(S0[8 * sp + 2], S0[8 * sp + 3]);
                    wv.z = pk2(S0[8 * sp + 4], S0[8 * sp + 5]); wv.w = pk2(S0[8 * sp + 6], S0[8 * sp + 7]); pf[sp] = __builtin_bit_cast(bf16x8, wv); }
#pragma unroll
                for (int i = 0; i < 16; ++i) { S1[i] = fast_exp2(S1[i]); l2 += S1[i]; }
#pragma unroll
                for (int sp = 0; sp < 2; ++sp) { v4u wv; wv.x = pk2(S1[8 * sp + 0], S1[8 * sp + 1]); wv.y = pk2(S1[8 * sp + 2], S1[8 * sp + 3]);
                    wv.z = pk2(S1[8 * sp + 4], S1[8 * sp + 5]); wv.w = pk2(S1[8 * sp + 6], S1[8 * sp + 7]); pf[2 + sp] = __builtin_bit_cast(bf16x8, wv); }
                T_END(11); T_BEGIN(9);
                __builtin_amdgcn_sched_barrier(0);
#pragma unroll
                for (int a_ = 0; a_ < 2; ++a_)
#pragma unroll
                    for (int b_ = 0; b_ < 4; ++b_) asm volatile("" : "+v"(vf[a_][b_]));
#pragma unroll
                for (int dt = 0; dt < 2; ++dt) { f32x16 O2;
#pragma unroll
                    for (int i = 0; i < 16; ++i) O2[i] = 0.f;
#pragma unroll
                    for (int ks = 0; ks < 4; ++ks) O2 = MFMA32(vf[dt][ks], pf[ks], O2);
                    if (valid) {
#pragma unroll
                        for (int i = 0; i < 16; ++i) (void)__hip_atomic_fetch_add(oacc + (32 * dt + (i & 3) + 8 * (i >> 2) + 4 * hh) * 256 + rowq, (int)O2[i], __ATOMIC_RELAXED, __HIP_MEMORY_SCOPE_WORKGROUP); } }
                if (valid) {
                    (void)__hip_atomic_fetch_add(lacc + rowq, __float2int_rn(l2 * FXS), __ATOMIC_RELAXED, __HIP_MEMORY_SCOPE_WORKGROUP); }
                if (PROBE_SEG == 9) LDS_WAIT(); T_END(9);
            }
#pragma unroll
            for (int a_ = 0; a_ < 2; ++a_)
#pragma unroll
                for (int b_ = 0; b_ < 4; ++b_) kf[a_][b_] = kn[a_][b_];
            j = jn; nq = nqn;
        }
#undef NEXT_BLOCK
#undef LOAD_K
#undef LOAD_V
    }
    __syncthreads();
    T_END(5);
    { const float sc = g_slc / fmaxf((float)lacc[32 * w + col] * FXI, 1e-30f);
#pragma unroll
      for (int i = 0; i < 16; ++i) { const int dr = (i & 3) + 8 * (i >> 2) + 4 * hh;
          O[0][i] = xw0[i * 64] + (float)oacc[dr * 256 + 32 * w + col] * (FXI * sc); O[1][i] = totr[i] + (float)oacc[(32 + dr) * 256 + 32 * w + col] * (FXI * sc); } }
#undef ST_DMA
#undef BLK
#undef STEP_BEGIN
#undef STEP_END
    T_BEGIN(7);
    asm volatile("" : "+v"(lane));
    const int col_ = lane & 31, hh_ = lane >> 5, h_ = col_ & 3; const size_t row_ = (size_t)b * T + 64 * t + 8 * w + (col_ >> 2);
    const bf16* za = (const bf16*)(P.ws + WS_ZA) + row_ * 512 + (g * 4 + h_) * 64; bf16* mx = (bf16*)(P.ws + WS_MIX) + row_ * 1024 + 512 + (g * 4 + h_) * 64;
#pragma unroll
    for (int dt = 0; dt < 2; ++dt)
#pragma unroll
        for (int i4 = 0; i4 < 4; ++i4) { const int d = 32 * dt + 8 * i4 + 4 * hh_; const v2u z = *(const GAS v2u*)(za + d);
            v2u o; o.x = pk2(O[dt][4 * i4] * bf2f(z.x & 0xffffu), O[dt][4 * i4 + 1] * bf2f(z.x >> 16)); o.y = pk2(O[dt][4 * i4 + 2] * bf2f(z.y & 0xffffu), O[dt][4 * i4 + 3] * bf2f(z.y >> 16));
            *(GAS v2u*)(mx + d) = o; }
    if (g == 0) { const int tq = w, c8 = lane * 8; const size_t r0 = (size_t)b * T + 64 * t + 8 * tq;
        const bf16* U = (const bf16*)(P.ws + WS_U) + c8; const bf16* CGp = (const bf16*)(P.ws + WS_CG) + c8; bf16* mo = (bf16*)(P.ws + WS_MIX) + c8;
        v4u ur[10], cr[8];
        const bool has_prev = (t > 0) || (tq > 0);
#pragma unroll
        for (int i = 0; i < 10; ++i) ur[i] = (i >= 2 || has_prev) ? *(const GAS v4u*)(U + (r0 + i - 2) * 512) : (v4u){0u, 0u, 0u, 0u};
#pragma unroll
        for (int i = 0; i < 8; ++i) cr[i] = *(const GAS v4u*)(CGp + (r0 + i) * 512);
        float w0[8], w1[8], w2[8], cb[8];
#pragma unroll
        for (int e = 0; e < 8; ++e) { w0[e] = P.conv_w[c8 + e]; w1[e] = P.conv_w[512 + c8 + e]; w2[e] = P.conv_w[1024 + c8 + e]; cb[e] = P.conv_b[c8 + e]; }
#pragma unroll
        for (int i = 0; i < 8; ++i) { float o[8];
#pragma unroll
            for (int e = 0; e < 8; ++e) { const int sh_ = (e & 1) * 16; const float a = bf2f((ur[i][e >> 1] >> sh_) & 0xffffu), bb = bf2f((ur[i + 1][e >> 1] >> sh_) & 0xffffu), c = bf2f((ur[i + 2][e >> 1] >> sh_) & 0xffffu);
                o[e] = bf2f((cr[i][e >> 1] >> sh_) & 0xffffu) * (w0[e] * a + w1[e] * bb + w2[e] * c + cb[e]); }
            v4u ov; ov.x = pk2(o[0], o[1]); ov.y = pk2(o[2], o[3]); ov.z = pk2(o[4], o[5]); ov.w = pk2(o[6], o[7]);
            *(GAS v4u*)(mo + (r0 + i) * 1024) = ov; } }
    T_END(7); T_END(8);
}
template <class KeyFn>
__device__ __forceinline__ void sample_branch(Frame& F, int nslots, float shift, const KeyFn& key, LAS float* obr) {
    LAS float* q = (LAS float*)(F.lds + SM_Q); LAS float* Pb = (LAS float*)(F.lds + SM_P); LAS float* red = (LAS float*)(F.lds + SM_RED); LAS float* lsm = (LAS float*)(F.lds + SM_L);
    LAS unsigned long long* vptr = (LAS unsigned long long*)(F.lds + SM_VP);
    float lacc[4] = {0.f, 0.f, 0.f, 0.f};
    for (int s = F.tid; s < nslots; s += 512) { const float* kp; const float* vp; const bool valid = key(s, kp, vp);
        float sc[4] = {0.f, 0.f, 0.f, 0.f};
        if (valid) {
#pragma unroll 8
            for (int d4 = 0; d4 < 16; ++d4) { const f32x4 kv = *(const GAS f32x4*)(kp + 4 * d4);
#pragma unroll
                for (int hq = 0; hq < 4; ++hq) { const f32x4 qv = *(const LAS f32x4*)(q + hq * 64 + 4 * d4); sc[hq] += (kv.x * qv.x + kv.y * qv.y) + (kv.z * qv.z + kv.w * qv.w); } } }
        f32x4 p;
#pragma unroll
        for (int hq = 0; hq < 4; ++hq) { p[hq] = valid ? fast_exp2(sc[hq] - shift) : 0.f; lacc[hq] += p[hq]; }
        *(LAS f32x4*)(Pb + 4 * s) = p; vptr[s] = (unsigned long long)(uintptr_t)vp; }
#pragma unroll
    for (int hq = 0; hq < 4; ++hq) { lacc[hq] = wave_sum(lacc[hq]); if (F.lane == 0) red[F.wave * 4 + hq] = lacc[hq]; }
    __syncthreads();
    if (F.tid < 4) { float s = 0.f; for (int ww = 0; ww < 8; ++ww) s += red[ww * 4 + F.tid]; lsm[F.tid] = s; }
    const int sg = F.tid >> 4, d4 = F.tid & 15;
    f32x4 oa[4];
#pragma unroll
    for (int hq = 0; hq < 4; ++hq) oa[hq] = (f32x4){0.f, 0.f, 0.f, 0.f};
    for (int s0 = sg; s0 < nslots; s0 += 256) {
        f32x4 vv[8], pp[8];
#pragma unroll
        for (int u = 0; u < 8; ++u) { const int s = s0 + 32 * u; const float* vp = (const float*)(uintptr_t)vptr[s]; vv[u] = *(const GAS f32x4*)(vp + 4 * d4); pp[u] = *(const LAS f32x4*)(Pb + 4 * s); }
#pragma unroll
        for (int u = 0; u < 8; ++u) { oa[0] = oa[0] + vv[u] * pp[u].x; oa[1] = oa[1] + vv[u] * pp[u].y; oa[2] = oa[2] + vv[u] * pp[u].z; oa[3] = oa[3] + vv[u] * pp[u].w; } }
    __syncthreads();
    LAS float* red2 = (LAS float*)(F.lds + SM_RED2);
#pragma unroll
    for (int hq = 0; hq < 4; ++hq) *(LAS f32x4*)(red2 + (sg * 4 + hq) * 64 + 4 * d4) = oa[hq];
    __syncthreads();
    if (F.tid < 256) { float s = 0.f;
#pragma unroll 8
        for (int g2 = 0; g2 < 32; ++g2) s += red2[g2 * 256 + F.tid]; obr[F.tid] = s; }
    __syncthreads();
}
__device__ __forceinline__ void p3_sample_unit(const Ptrs& P, Frame& F, int b, int g) {
    asm volatile("" : "+v"(F.tid), "+v"(F.lane), "+s"(F.wave));
    LAS float* q = (LAS float*)(F.lds + SM_Q); LAS float* Pb = (LAS float*)(F.lds + SM_P); LAS float* imp = (LAS float*)(F.lds + SM_IMP); LAS float* lsm = (LAS float*)(F.lds + SM_L);
    LAS int* sel = (LAS int*)(F.lds + SM_SEL); LAS float* osm = (LAS float*)(F.lds + SM_O);
    const float* cst = (const float*)(P.ws + WS_CONST);
    float kcmax = 0.f; for (int e_ = 0; e_ < 4; ++e_) kcmax += __builtin_bit_cast(float, __hip_atomic_load((unsigned*)(P.ws + WS_CTL) + CW_KCMAX + 64 + e_, RLX_AGENT));
    const float sh_cmp = cst[0] * sqrtf(kcmax) * LOG2E * 1.001f, sh_slc = cst[1], sh_win = cst[2];
    if (F.tid < 256) q[F.tid] = ((const float*)(P.ws + WS_QS))[(size_t)b * 512 + g * 256 + F.tid];
    __syncthreads();
    const float* kcs = (const float*)(P.ws + WS_KCS) + (size_t)(b * 2 + g) * 2 * NCS * 64;
    sample_branch(F, NCS, sh_cmp, [&](int s, const float*& kp, const float*& vp) { kp = kcs + (size_t)s * 64; vp = kcs + (size_t)(NCS + s) * 64; return true; }, osm);
    { const f32x4 p = *(const LAS f32x4*)(Pb + 4 * F.tid); float v = p.x / lsm[0] + p.y / lsm[1] + p.z / lsm[2] + p.w / lsm[3]; v += __shfl_xor(v, 1);
      if ((F.tid & 1) == 0) imp[F.tid >> 1] = v; if (F.tid < 4) imp[256 + F.tid] = 0.f; }
    if (F.tid < 256) osm[F.tid] = osm[F.tid] / lsm[F.tid >> 6];
    __syncthreads();
    if (F.wave == 0) { const int lane = F.lane; unsigned k[4];
#pragma unroll
        for (int i = 0; i < 4; ++i) { const int j = lane + 64 * i; k[i] = (j >= 1 && j <= 254) ? __builtin_bit_cast(unsigned, imp[j]) + 1u : 0u; }
        unsigned Tv = 0u;
        for (int bit = 30; bit >= 0; --bit) { const unsigned cand = Tv | (1u << bit); int cnt = 0;
#pragma unroll
            for (int i = 0; i < 4; ++i) cnt += __popcll(__ballot(k[i] >= cand));
            if (cnt >= 13) Tv = cand; }
        int ngt = 0;
#pragma unroll
        for (int i = 0; i < 4; ++i) ngt += __popcll(__ballot(k[i] > Tv));
        const int need = 13 - ngt; const unsigned long long below = (lane == 0) ? 0ull : (~0ull >> (64 - lane));
        int base = 3, eqbase = 0;
        if (lane == 0) { int z_ = 0; asm volatile("" : "+v"(z_)); sel[0] = z_; sel[1] = z_ + 255; sel[2] = z_ + 256; }
#pragma unroll
        for (int i = 0; i < 4; ++i) { const unsigned long long e = __ballot(k[i] == Tv); const int rk = eqbase + __popcll(e & below); const bool on = k[i] > Tv || (k[i] == Tv && rk < need);
            const unsigned long long m = __ballot(on); if (on) sel[base + __popcll(m & below)] = lane + 64 * i; base += __popcll(m); eqbase += __popcll(e); } }
    __syncthreads();
    const float* kvn = (const float*)(P.ws + WS_KVN) + (size_t)b * 768;
    const int* pt = P.page_table + b * NPAGES; const float* cs = P.cache_slc;
    sample_branch(F, 1024, sh_slc, [&](int s, const float*& kp, const float*& vp) { const int j = sel[s >> 6], rr = s & 63;
        if (j == 256) { kp = kvn + (1 * 2 + 0) * 128 + g * 64; vp = kvn + (1 * 2 + 1) * 128 + g * 64; return rr == 0; }
        const float* rowp = cs + ((size_t)pt[j >> 1] * 128 + (j & 1) * 64 + rr) * 256 + g * 64; kp = rowp; vp = rowp + 128; return true; }, osm + 256);
    if (F.tid < 256) osm[256 + F.tid] = osm[256 + F.tid] / lsm[F.tid >> 6];
    __syncthreads();
    const float* stw = P.st_win + (size_t)b * 512 * 256;
    sample_branch(F, 512, sh_win, [&](int s, const float*& kp, const float*& vp) {
        if (s == 511) { kp = kvn + (2 * 2 + 0) * 128 + g * 64; vp = kvn + (2 * 2 + 1) * 128 + g * 64; return true; }
        const float* rowp = stw + (size_t)(s + 1) * 256 + g * 64; kp = rowp; vp = rowp + 128; return true; }, osm + 512);
    if (F.tid < 256) { const int hq = F.tid >> 6, d = F.tid & 63; const float* gs = (const float*)(P.ws + WS_GS) + b * 24 + (g * 4 + hq) * 3;
        const float o = gs[0] * osm[F.tid] + gs[1] * osm[256 + F.tid] + gs[2] * osm[512 + F.tid] / lsm[hq];
        ((bf16*)(P.ws + WS_MIXS))[(size_t)b * 1024 + 512 + (g * 4 + hq) * 64 + d] = (bf16)f2bf(o * ((const float*)(P.ws + WS_ZAS))[(size_t)b * 512 + (g * 4 + hq) * 64 + d]); }
    __syncthreads();
}
__device__ __forceinline__ void p3_phase(const Ptrs& P, Frame& F, int rep) {
    const float* cst = (const float*)(P.ws + WS_CONST);
    float kcmax = 0.f; for (int e_ = 0; e_ < 4; ++e_) kcmax += __builtin_bit_cast(float, __hip_atomic_load((unsigned*)(P.ws + WS_CTL) + CW_KCMAX + e_, RLX_AGENT));
    const float sh_cmp = cst[0] * sqrtf(kcmax) * LOG2E * 1.001f, sh_slc = cst[1], sh_win = cst[2];
    unsigned long long tacc = 0ull;
    volatile LAS int* qw = (volatile LAS int*)(F.lds + P3_MISC);
#ifndef PROBE_P3
#define PROBE_P3 0
#endif
    constexpr int NS_ = PROBE_P3 == 1 ? 16 : 8, PSH_ = PROBE_P3 == 2 ? 1 : 0;
    constexpr int NQ = NS_ + (128 << PSH_);
    const int x0 = (int)(xb_xcc_id() & 7u);
    for (int xi = 0; xi < 8; ++xi) {
        const int x = (x0 + xi) & 7;
        for (;;) {
            __syncthreads();
            if (F.tid == 0) qw[0] = (int)__hip_atomic_fetch_add((unsigned*)(F.ctl + CW_QUEUE + 64 * (x + 8 * rep)), 1u, RLX_AGENT);
            __syncthreads();
            const int idx = qw[0];
            if (idx >= NQ) break;
            if (idx < NS_) p3_sample_unit(P, F, x * 4 + ((idx & 7) >> 1), idx & 1);
            else p3_prompt_unit(P, F, x >> 1, 127 - ((idx - NS_) >> PSH_), x & 1, sh_cmp, sh_slc, sh_win, tacc);
        }
    }
    if (PROBE_SEG != 0 && blockIdx.x == 0) { const unsigned long long t0_ = __builtin_readcyclecounter(); while (__builtin_readcyclecounter() - t0_ < tacc) __builtin_amdgcn_s_sleep(8); }
}
#ifndef MK_N_LAUNCHES
#define MK_N_LAUNCHES 1
#endif
constexpr int N_PHASES = 5;
constexpr int N_LAUNCHES = MK_N_LAUNCHES;
struct Args { Ptrs p; int ph_lo, ph_hi, rep, mode; };
__global__ void __launch_bounds__(NWAVES * 64, 2) nsa_fwd(Args args) {
    extern __shared__ __attribute__((aligned(16))) unsigned char lds[];
    const Ptrs& P = args.p;
    Frame F;
    F.lds = (LAS unsigned char*)lds;
    F.MISC = (volatile LAS unsigned*)(F.lds + MISC_OFF);
    F.tid = threadIdx.x; F.lane = F.tid & 63; F.wave = __builtin_amdgcn_readfirstlane(F.tid >> 6);
    F.G = gridDim.x; F.gw = blockIdx.x * NWAVES + F.wave; F.NGW = F.G * NWAVES;
    F.ctl = (gu32*)(P.ws + WS_CTL);
    for (int u = F.tid; u < (LDS_BYTES - LDSCTL_OFF) / 4; u += NWAVES * 64) ((LAS unsigned*)(F.lds + LDSCTL_OFF))[u] = 0u;
    __syncthreads();
    XcdBarrier bar; bar.bar = (unsigned*)(F.ctl + CW_BAR); bar.x = 0; bar.st = nullptr;
    if (N_LAUNCHES == 1) bar = xcd_barrier_post((unsigned*)(F.ctl + CW_BAR), F.MISC + 8);
    const int lo = args.ph_lo, hi = args.ph_hi;
    unsigned long long tprobe = 0ull;
#define IN(k) (lo <= (k) && (k) < hi)
#define FENCE() do { asm volatile("" : "+s"(F.wave), "+s"(F.gw)); F.lane = (int)__builtin_amdgcn_mbcnt_hi(~0u, __builtin_amdgcn_mbcnt_lo(~0u, 0u)); F.tid = F.wave * 64 + F.lane; asm volatile("" : "+v"(F.tid), "+v"(F.lane)); } while (0)
#define SEAM(k) do { if (IN(k) && IN((k) + 1)) xcd_barrier(bar, F.wave == 0 && (int)__builtin_amdgcn_mbcnt_hi(~0u, __builtin_amdgcn_mbcnt_lo(~0u, 0u)) == 0); } while (0)

    if (IN(0)) { FENCE(); p0_phase(P, F); } SEAM(0);
    if (IN(1)) { FENCE();
        pg8::Gemm g{(const pg8::bf16_t*)(P.ws + WS_XB), (const pg8::bf16_t*)(P.ws + WS_BT1), M, NP, D};
        EpiIn E{(const float*)(P.ws + WS_RSTD), (const float*)(P.ws + WS_ROPE), P.q_gain, P.k_gain, P.out, P.ws};
        const int nround = ((M / 256) * (NP / 256) + F.G - 1) / F.G, jx = (int)blockIdx.x >> 3,
                  kst = (((((int)blockIdx.x & 7) + 2 * (((jx >> 2) & 1) | ((jx >> 4) << 1))) & 7) * nround) >> 3;
        { pg8::StaticOrder S; S.init(M, NP, F.G, (int)blockIdx.x, 0, kst); pg8::gemm_phase<EpiIn, pg8::StaticOrder, true, true>(F.lds + RING_OFF, g, S, E, F.wave, tprobe); }
        FENCE(); __syncthreads();
#ifdef PROBE_CW
        const unsigned long long tc0_ = __builtin_readcyclecounter();
#endif
        compress_wg(P, F, F.lds + RING_OFF);
        __syncthreads(); FENCE();
#ifdef PROBE_CW
        asm volatile("s_waitcnt vmcnt(0)" ::: "memory"); tprobe = __builtin_readcyclecounter() - tc0_;
#endif
        { pg8::StaticOrder S; S.init(M, NP, F.G, (int)blockIdx.x, kst, nround - kst); pg8::gemm_phase<EpiIn, pg8::StaticOrder, true, true>(F.lds + RING_OFF, g, S, E, F.wave, tprobe); }
        FENCE();
        for (int ct = (int)blockIdx.x; ct < NP / 16; ct += F.G) small_gemm_tile_ksplit<0>(P, (const bf16*)(P.ws + WS_XSB), (const bf16*)(P.ws + WS_BT1), ct, F, (LAS float*)(F.lds + RING_OFF));
#ifdef PROBE_CW
        if (blockIdx.x == PROBE_CW) { const unsigned long long t0_ = __builtin_readcyclecounter(); while (__builtin_readcyclecounter() - t0_ < tprobe) __builtin_amdgcn_s_sleep(8); }
        tprobe = 0ull;
#endif
#if defined(PROBE_EPI)
        if (PROBE_EPI == 1 && blockIdx.x == 0) { const unsigned long long t0_ = __builtin_readcyclecounter(); while (__builtin_readcyclecounter() - t0_ < tprobe) __builtin_amdgcn_s_sleep(8); }
        tprobe = 0ull;
#endif
    } SEAM(1);
    if (IN(2)) { FENCE(); p2_phase(P, F); } SEAM(2);
    if (IN(3)) { FENCE(); p3_phase(P, F, args.rep); } SEAM(3);
    if (IN(4)) { FENCE();
        pg8::Gemm g{(const pg8::bf16_t*)(P.ws + WS_MIX), (const pg8::bf16_t*)(P.ws + WS_BT2), M, D, D}; pg8::StaticOrder S; S.init(M, D, F.G, (int)blockIdx.x);
        EpiOut E{(const bf16*)(P.ws + WS_XB), P.out + O_Y};
        pg8::gemm_phase<EpiOut, pg8::StaticOrder, true, true>(F.lds + RING_OFF, g, S, E, F.wave, tprobe);
        FENCE();
        for (int ct = (int)blockIdx.x; ct < D / 16; ct += F.G) small_gemm_tile_ksplit<1>(P, (const bf16*)(P.ws + WS_MIXS), (const bf16*)(P.ws + WS_BT2), ct, F, (LAS float*)(F.lds + RING_OFF));
#if defined(PROBE_EPI)
        if (PROBE_EPI == 2 && blockIdx.x == 0) { const unsigned long long t0_ = __builtin_readcyclecounter(); while (__builtin_readcyclecounter() - t0_ < tprobe) __builtin_amdgcn_s_sleep(8); }
#endif
    }
#undef IN
#undef SEAM
}

extern "C" void kernel_launch(void* const* d_in, const int* in_sizes, int n_in, void* d_out, int out_size, void* d_ws, size_t ws_size, hipStream_t stream) {
    static int grid = 0;
    if (grid == 0) {
        if (n_in != 16 || out_size != (int)O_END || ws_size < WS_END) { fprintf(stderr, "kernel_launch: unexpected shapes (n_in %d, out %d, ws %zu)\n", n_in, out_size, ws_size); grid = -1; return; }
        int dev = 0, cus = 0, per_cu = 0;
        if (hipGetDevice(&dev) != hipSuccess || hipDeviceGetAttribute(&cus, hipDeviceAttributeMultiprocessorCount, dev) != hipSuccess) { grid = -1; return; }
        if (hipFuncSetAttribute((const void*)nsa_fwd, hipFuncAttributeMaxDynamicSharedMemorySize, LDS_BYTES) != hipSuccess) { fprintf(stderr, "kernel_launch: hipFuncSetAttribute failed\n"); grid = -1; return; }
        if (hipOccupancyMaxActiveBlocksPerMultiprocessor(&per_cu, (const void*)nsa_fwd, NWAVES * 64, LDS_BYTES) != hipSuccess || per_cu < 1)
            fprintf(stderr, "kernel_launch: note: occupancy query reports %d workgroups per CU\n", per_cu);
        (void)hipGetLastError();
        grid = cus;
    }
    if (grid < 0) return;
    if (hipMemsetAsync((char*)d_ws + WS_CTL, 0, CTL_ZERO_BYTES, stream) != hipSuccess) return;
    Args a{}; a.mode = 3;
    a.p.xp = (const float*)d_in[0]; a.p.xs = (const float*)d_in[1]; a.p.cache_cmp = (const float*)d_in[2]; a.p.cache_slc = (const float*)d_in[3];
    a.p.st_win = (const float*)d_in[4]; a.p.st_conv = (const float*)d_in[5]; a.p.page_table = (const int*)d_in[6]; a.p.norm_g = (const float*)d_in[7];
    a.p.w_in = (const float*)d_in[8]; a.p.conv_w = (const float*)d_in[9]; a.p.conv_b = (const float*)d_in[10]; a.p.q_gain = (const float*)d_in[11];
    a.p.k_gain = (const float*)d_in[12]; a.p.cmp_pe = (const float*)d_in[13]; a.p.cmp_w = (const float*)d_in[14]; a.p.w_out = (const float*)d_in[15];
    a.p.out = (float*)d_out; a.p.ws = (unsigned char*)d_ws;
#ifndef PROBE_DUP
#define PROBE_DUP -1
#endif
    for (int li = 0; li < N_LAUNCHES; ++li) {
        a.ph_lo = (N_LAUNCHES == 1) ? 0 : li; a.ph_hi = (N_LAUNCHES == 1) ? N_PHASES : li + 1;
        for (int rep = 0; rep < ((N_LAUNCHES > 1 && li == PROBE_DUP) ? 2 : 1); ++rep) {
            a.rep = rep;
            hipLaunchKernelGGL(nsa_fwd, dim3(grid), dim3(NWAVES * 64), LDS_BYTES, stream, a);
            const hipError_t le = hipPeekAtLastError();
            if (le != hipSuccess) { fprintf(stderr, "kernel_launch: launch %d failed: %s\n", li, hipGetErrorName(le)); break; }
        }
    }
}
```
